# Optimizing an MI355X kernel written in HIP

```python
import jax, jax.numpy as jnp
from jax import lax
import numpy as np

D_MODEL = 1024
BATCH = 4
SEQ = 4096
DEPTH = 1
DEC_BATCH = 32
DEC_SEQ = 16
PAST_LEN = 1024

CHUNK = 64
Q_BLOCK = 2 * CHUNK
H_A = 16
D_HEAD_A = 64
D_A = H_A * D_HEAD_A
H_B = 16
D_HEAD_B = 64
D_B = H_B * D_HEAD_B
W_LORA = 64
A_LORA = 64
C_A = 4 * D_A
C_GATE = 2 * D_MODEL
C_SHIFT = 3 * D_B + W_LORA + A_LORA + D_B
N_IN = C_A + C_GATE + C_SHIFT
B_SPLITS = (D_B, 2 * D_B, 3 * D_B, 3 * D_B + W_LORA, 3 * D_B + W_LORA + A_LORA)
EPS = 1e-6
LNX_EPS = 64e-5

kernel_name = "hybrid_stickbreak_rwkv7_stream_step"


def _rmsnorm(x, g):
    xf = x.astype(jnp.float32)
    y = xf * lax.rsqrt(jnp.mean(xf * xf, axis=-1, keepdims=True) + EPS)
    return (y * g.astype(jnp.float32)).astype(x.dtype)


def _sb_attend(q, k, v, q_pos, k_pos):
    z = jnp.einsum('bhqd,bhkd->bhqk', q.astype(jnp.float32), k.astype(jnp.float32)) * (D_HEAD_A ** -0.5)
    valid = k_pos[None, :] < q_pos[:, None]
    log_keep = jnp.where(valid, jax.nn.log_sigmoid(-z), 0.0)
    later = lax.cumsum(log_keep, axis=3, reverse=True) - log_keep
    weight = jnp.where(valid, jnp.exp(jax.nn.log_sigmoid(z) + later), 0.0)
    o = jnp.einsum('bhqk,bhkd->bhqd', weight, v.astype(jnp.float32))
    return o.astype(q.dtype)


def _sb_prompt(q, k, v):
    T = q.shape[2]
    outs = []
    for i in range(T // Q_BLOCK):
        start, end = i * Q_BLOCK, (i + 1) * Q_BLOCK
        outs.append(_sb_attend(q[:, :, start:end], k[:, :, :end], v[:, :, :end],
                               jnp.arange(start, end), jnp.arange(end)))
    return jnp.concatenate(outs, axis=2)


def _wkv_scan(r, w, k, v, kk, a, S0):
    def step(S, inp):
        r_t, w_t, k_t, v_t, kk_t, a_t = inp
        sa = jnp.einsum('bhvk,bhk->bhv', S, -kk_t)
        S = (S * w_t[:, :, None, :] + sa[..., None] * (kk_t * a_t)[:, :, None, :]
             + v_t[..., None] * k_t[:, :, None, :])
        return S, jnp.einsum('bhvk,bhk->bhv', S, r_t)
    xs = (r.swapaxes(0, 1), w.swapaxes(0, 1), k.swapaxes(0, 1), v.swapaxes(0, 1),
          kk.swapaxes(0, 1), a.swapaxes(0, 1))
    S, o = lax.scan(step, S0, xs)
    return S, o.swapaxes(0, 1)


def _layer(x, shift_prev, k_past, v_past, wkv_prev, norm_g, w_in, mu_shift, w0, w2, a0, a2,
           k_k, k_a, r_k, lnx_g, lnx_b, w_o_a, w_o_b, w_out):
    B, T, _ = x.shape
    f32 = jnp.float32
    h = _rmsnorm(x, norm_g)
    proj = jnp.einsum('btd,dc->btc', h, w_in)
    p_a = proj[..., :C_A]
    p_gate = proj[..., C_A:C_A + C_GATE]
    p_b = proj[..., C_A + C_GATE:]

    q, k, v, z_a = jnp.split(p_a, 4, axis=-1)
    q = q.reshape(B, T, H_A, D_HEAD_A).transpose(0, 2, 1, 3)
    k = k.reshape(B, T, H_A, D_HEAD_A).transpose(0, 2, 1, 3)
    v = v.reshape(B, T, H_A, D_HEAD_A).transpose(0, 2, 1, 3)
    if k_past is None:
        o_a = _sb_prompt(q, k, v)
    else:
        past = k_past.shape[2]
        k_all = jnp.concatenate([k_past.astype(k.dtype), k], axis=2)
        v_all = jnp.concatenate([v_past.astype(v.dtype), v], axis=2)
        o_a = _sb_attend(q, k_all, v_all, past + jnp.arange(T), jnp.arange(past + T))
    o_a = o_a.transpose(0, 2, 1, 3).reshape(B, T, D_A)
    y_a = jnp.einsum('btc,cd->btd', o_a * jax.nn.silu(z_a), w_o_a)

    p_prev = jnp.concatenate([shift_prev.astype(p_b.dtype), p_b[:, :-1]], axis=1)
    p_mix = p_b + mu_shift * (p_prev - p_b)
    shift_new = p_b[:, -1:]
    r, kb, vb, lat_w, lat_a, z_b = jnp.split(p_mix, B_SPLITS, axis=-1)
    w_raw = -jax.nn.softplus(-(w0 + jnp.einsum('btr,rc->btc', jnp.tanh(lat_w), w2))) - 0.5
    decay = jnp.exp(-jnp.exp(w_raw.astype(f32)))
    a = jax.nn.sigmoid(a0 + jnp.einsum('btr,rc->btc', lat_a, a2))
    kk = (kb * k_k).reshape(B, T, H_B, D_HEAD_B).astype(f32)
    kk = kk / jnp.maximum(jnp.sqrt(jnp.sum(kk * kk, axis=-1, keepdims=True)), 1e-12)
    kb = kb * (1.0 + (a - 1.0) * k_a)
    r_h = r.reshape(B, T, H_B, D_HEAD_B).astype(f32)
    k_h = kb.reshape(B, T, H_B, D_HEAD_B).astype(f32)
    v_h = vb.reshape(B, T, H_B, D_HEAD_B).astype(f32)
    a_h = a.reshape(B, T, H_B, D_HEAD_B).astype(f32)
    w_h = decay.reshape(B, T, H_B, D_HEAD_B)
    wkv_new, o_b = _wkv_scan(r_h, w_h, k_h, v_h, kk, a_h, wkv_prev.astype(f32))
    mean = jnp.mean(o_b, axis=-1, keepdims=True)
    var = jnp.mean(jnp.square(o_b - mean), axis=-1, keepdims=True)
    o_b = ((o_b - mean) * lax.rsqrt(var + LNX_EPS)).reshape(B, T, D_B)
    o_b = o_b * lnx_g.astype(f32) + lnx_b.astype(f32)
    bonus = jnp.sum(r_h * k_h * r_k.astype(f32), axis=-1, keepdims=True) * v_h
    o_b = (o_b + bonus.reshape(B, T, D_B)).astype(x.dtype)
    y_b = jnp.einsum('btc,cd->btd', o_b * jax.nn.silu(z_b), w_o_b)

    g_a, g_b = jnp.split(jax.nn.sigmoid(p_gate), 2, axis=-1)
    y = jnp.einsum('btd,de->bte', g_a * y_a + g_b * y_b, w_out)
    return x + y, k, v, shift_new, wkv_new


def setup_inputs(seed: int = 0) -> dict:
    key = jax.random.key(seed)
    ks = jax.random.split(key, 24)
    nrm = lambda k, shape, s: jax.random.normal(k, shape, jnp.float32) * s
    L = DEPTH
    return {
        "x_prompt": nrm(ks[0], (BATCH, SEQ, D_MODEL), 1.0),
        "x_sample": nrm(ks[1], (DEC_BATCH, DEC_SEQ, D_MODEL), 1.0),
        "cache_sb_k": nrm(ks[2], (L, DEC_BATCH, H_A, PAST_LEN, D_HEAD_A), 1.0),
        "cache_sb_v": nrm(ks[3], (L, DEC_BATCH, H_A, PAST_LEN, D_HEAD_A), 1.0),
        "state_shift": nrm(ks[4], (L, DEC_BATCH, 1, C_SHIFT), 1.0),
        "state_wkv": nrm(ks[5], (L, DEC_BATCH, H_B, D_HEAD_B, D_HEAD_B), 0.5),
        "norm_g": 1.0 + nrm(ks[6], (L, D_MODEL), 0.02),
        "w_in": nrm(ks[7], (L, D_MODEL, N_IN), D_MODEL ** -0.5),
        "mu_shift": jax.random.uniform(ks[8], (L, C_SHIFT), jnp.float32),
        "w0": jax.random.uniform(ks[9], (L, D_B), jnp.float32, -4.0, 0.0),
        "w2": nrm(ks[10], (L, W_LORA, D_B), 0.1 * W_LORA ** -0.5),
        "a0": nrm(ks[11], (L, D_B), 0.1),
        "a2": nrm(ks[12], (L, A_LORA, D_B), 0.1 * A_LORA ** -0.5),
        "k_k": 0.85 + nrm(ks[13], (L, D_B), 0.02),
        "k_a": 1.0 + nrm(ks[14], (L, D_B), 0.02),
        "r_k": nrm(ks[15], (L, H_B, D_HEAD_B), 0.1),
        "lnx_g": 1.0 + nrm(ks[16], (L, D_B), 0.02),
        "lnx_b": nrm(ks[17], (L, D_B), 0.02),
        "w_o_a": nrm(ks[18], (L, D_A, D_MODEL), D_A ** -0.5),
        "w_o_b": nrm(ks[19], (L, D_B, D_MODEL), D_B ** -0.5),
        "w_out": nrm(ks[20], (L, D_MODEL, D_MODEL), D_MODEL ** -0.5),
        "final_norm_g": 1.0 + nrm(ks[21], (D_MODEL,), 0.02),
    }


def reference(x_prompt, x_sample, cache_sb_k, cache_sb_v, state_shift, state_wkv,
              norm_g, w_in, mu_shift, w0, w2, a0, a2, k_k, k_a, r_k, lnx_g, lnx_b,
              w_o_a, w_o_b, w_out, final_norm_g):
    xp, xs = x_prompt, x_sample
    B = xp.shape[0]
    kp_l, vp_l, sp_l, wp_l = [], [], [], []
    ks_l, vs_l, ss_l, ws_l = [], [], [], []
    for l in range(DEPTH):
        params = (norm_g[l], w_in[l], mu_shift[l], w0[l], w2[l], a0[l], a2[l], k_k[l], k_a[l],
                  r_k[l], lnx_g[l], lnx_b[l], w_o_a[l], w_o_b[l], w_out[l])
        zero_shift = jnp.zeros((B, 1, C_SHIFT), xp.dtype)
        zero_wkv = jnp.zeros((B, H_B, D_HEAD_B, D_HEAD_B), jnp.float32)
        xp, kp, vp, sp, wp = _layer(xp, zero_shift, None, None, zero_wkv, *params)
        xs, kss, vss, sss, wss = _layer(xs, state_shift[l], cache_sb_k[l], cache_sb_v[l],
                                        state_wkv[l], *params)
        kp_l.append(kp); vp_l.append(vp); sp_l.append(sp); wp_l.append(wp)
        ks_l.append(kss); vs_l.append(vss); ss_l.append(sss); ws_l.append(wss)
    y_prompt = _rmsnorm(xp, final_norm_g)
    y_sample = _rmsnorm(xs, final_norm_g)
    return (y_prompt, y_sample,
            jnp.stack(kp_l), jnp.stack(vp_l), jnp.stack(sp_l), jnp.stack(wp_l),
            jnp.stack(ks_l), jnp.stack(vs_l), jnp.stack(ss_l), jnp.stack(ws_l))
```

```cpp
#include <hip/hip_runtime.h>
#include <hip/hip_cooperative_groups.h>
#include <cstdio>
#include <cstdint>
namespace cg = cooperative_groups;

#define DI __device__ __forceinline__
typedef unsigned short bf16_t;
typedef short bf16x8 __attribute__((ext_vector_type(8)));
typedef float f32x16 __attribute__((ext_vector_type(16)));
typedef unsigned u32x4 __attribute__((ext_vector_type(4)));
#define MFMA32(a, b, c) __builtin_amdgcn_mfma_f32_32x32x16_bf16((a), (b), (c), 0, 0, 0)

constexpr int DM = 1024, TP = 4096, MP = 16384, MS = 512, MT = 16896;
constexpr int NIN = 10368, CSH = 4224;
constexpr float EPS = 1e-6f, LNX_EPS = 64e-5f;
constexpr float QSCALE = 0.18033688011112042f;

constexpr size_t OUT_YP = 0, OUT_KP = 17301504, OUT_VP = 34078720, OUT_SHP = 50855936, OUT_WP = 50872832,
                 OUT_KS = 51134976, OUT_VS = 51659264, OUT_SHS = 52183552, OUT_WS = 52318720;

constexpr size_t SZ_ACT = (size_t)MT * 1024 * 2;
constexpr size_t WS_R1 = 0;
constexpr size_t WS_H = WS_R1, WS_WINT = WS_R1 + SZ_ACT, WS_ORAW = WS_R1;
constexpr size_t WS_R2 = (size_t)MT * 1024 * 4;
constexpr size_t WS_PB = WS_R2, WS_QB = WS_R2, WS_KB = WS_QB + SZ_ACT, WS_VT = WS_KB + (size_t)MP * 1024 * 2,
                 WS_SZA = WS_VT + (size_t)MP * 1024 * 2;
constexpr size_t WS_SCAN = WS_R2 + (size_t)MT * CSH * 2;
constexpr size_t WS_SW = WS_SCAN, WS_SR = WS_SW + (size_t)MT * 1024 * 4, WS_SK = WS_SR + SZ_ACT, WS_SV = WS_SK + SZ_ACT,
                 WS_SKK = WS_SV + SZ_ACT, WS_SB = WS_SKK + SZ_ACT;
constexpr size_t WS_OB = WS_SR, WS_MG = WS_SK;
constexpr size_t WS_SZB = WS_SB + SZ_ACT;
constexpr size_t WS_BONUS = WS_SZB + SZ_ACT;
constexpr size_t WS_WT = WS_BONUS + (size_t)MT * 16 * 4;
constexpr size_t WS_CTL = WS_WT + 3 * (size_t)1024 * 1024 * 2;
constexpr size_t WS_END = WS_CTL + 65536;
static_assert(WS_SZA + SZ_ACT <= WS_SCAN, "R2 overflow");
static_assert(WS_WINT + (size_t)NIN * 1024 * 2 <= WS_R2, "R1 overflow");

constexpr int SMEM_BYTES = 73728;
constexpr int LDS_ROW = 144;
constexpr int LDS_TILE = 128 * LDS_ROW;

struct Params { const float* in[22]; float* out; unsigned char* ws; };

DI float bf2f(bf16_t u) { return __uint_as_float((unsigned)u << 16); }
DI unsigned cvtpk(float lo, float hi) { unsigned r; asm volatile("v_cvt_pk_bf16_f32 %0, %1, %2" : "=v"(r) : "v"(lo), "v"(hi)); return r; }
DI bf16_t f2bf(float x) { return (bf16_t)(cvtpk(x, 0.f) & 0xffffu); }
DI float bflo(unsigned u) { return __uint_as_float(u << 16); }
DI float bfhi(unsigned u) { return __uint_as_float(u & 0xffff0000u); }
DI int crow(int i, int h) { return (i & 3) + 8 * (i >> 2) + 4 * h; }
DI float sigmoidf_(float x) { return 1.f / (1.f + __expf(-x)); }
DI float wave_sum(float x) {
#pragma unroll
  for (int o = 32; o > 0; o >>= 1) x += __shfl_xor(x, o);
  return x;
}
DI float sum16(float x) { x += __shfl_xor(x, 1); x += __shfl_xor(x, 2); x += __shfl_xor(x, 4); x += __shfl_xor(x, 8); return x; }
template <int CTRL> DI float dppf(float x) { return __builtin_bit_cast(float, __builtin_amdgcn_mov_dpp(__builtin_bit_cast(int, x), CTRL, 0xf, 0xf, true)); }
DI float row16_sum(float x) {
  x += dppf<0xB1>(x);
  x += dppf<0x4E>(x);
  x += dppf<0x124>(x);
  x += dppf<0x128>(x);
  return x;
}
DI size_t hm_base(int row) {
  if (row < MP) { const int b = row >> 12, t = row & 4095; return ((size_t)(b * 16) * 4096 + t) * 64; }
  const int rs = row - MP, b = rs >> 4, t = rs & 15; return (size_t)MP * 1024 + ((size_t)(b * 16) * 16 + t) * 64;
}
DI size_t hm_hstride(int row) { return row < MP ? (size_t)4096 * 64 : (size_t)16 * 64; }

DI void p0_rmsnorm_rows(const Params& p, int item) {
  const int lane = threadIdx.x & 63, wid = threadIdx.x >> 6;
  const int row = item * 4 + wid;
  const float* x = row < MP ? p.in[0] + (size_t)row * DM : p.in[1] + (size_t)(row - MP) * DM;
  const float* g = p.in[6];
  float4 v[4]; float ss = 0.f;
#pragma unroll
  for (int i = 0; i < 4; ++i) { v[i] = *(const float4*)(x + i * 256 + lane * 4); ss += v[i].x * v[i].x + v[i].y * v[i].y + v[i].z * v[i].z + v[i].w * v[i].w; }
  ss = wave_sum(ss);
  const float inv = rsqrtf(ss * (1.f / DM) + EPS);
  bf16_t* H = (bf16_t*)(p.ws + WS_H) + (size_t)row * DM;
#pragma unroll
  for (int i = 0; i < 4; ++i) {
    const float4 gg = *(const float4*)(g + i * 256 + lane * 4);
    uint2 o; o.x = cvtpk(v[i].x * inv * gg.x, v[i].y * inv * gg.y); o.y = cvtpk(v[i].z * inv * gg.z, v[i].w * inv * gg.w);
    *(uint2*)(H + i * 256 + lane * 4) = o;
  }
}
DI void p0_transpose_tile(const float* src, bf16_t* dst, int N, int kt, int nt, float* lds) {
  const int tid = threadIdx.x;
  const int k0 = kt * 64, n0 = nt * 64;
#pragma unroll
  for (int i = 0; i < 4; ++i) {
    const int row = (tid >> 4) + 16 * i, c4 = (tid & 15) * 4;
    const float4 v = *(const float4*)(src + (size_t)(k0 + row) * N + n0 + c4);
    lds[row * 65 + c4 + 0] = v.x; lds[row * 65 + c4 + 1] = v.y; lds[row * 65 + c4 + 2] = v.z; lds[row * 65 + c4 + 3] = v.w;
  }
  __syncthreads();
  const int n = tid >> 2, kc = (tid & 3) * 16;
  unsigned w[8];
#pragma unroll
  for (int j = 0; j < 8; ++j) w[j] = cvtpk(lds[(kc + 2 * j) * 65 + n], lds[(kc + 2 * j + 1) * 65 + n]);
  uint4* d = (uint4*)(dst + (size_t)(n0 + n) * 1024 + k0 + kc);
  d[0] = make_uint4(w[0], w[1], w[2], w[3]); d[1] = make_uint4(w[4], w[5], w[6], w[7]);
  __syncthreads();
}
DI void phase0(const Params& p, char* smem) {
  if (blockIdx.x == 0) { unsigned* ctl = (unsigned*)(p.ws + WS_CTL); for (int i = threadIdx.x; i < 16384; i += 256) ctl[i] = 0u; }
  constexpr int N_ROWS = MT / 4, N_TIN = 16 * 162, N_TSQ = 256;
  constexpr int N_ITEMS = N_ROWS + N_TIN + 3 * N_TSQ;
  for (int it = blockIdx.x; it < N_ITEMS; it += gridDim.x) {
    if (it < N_ROWS) { p0_rmsnorm_rows(p, it); continue; }
    int j = it - N_ROWS;
    if (j < N_TIN) { p0_transpose_tile(p.in[7], (bf16_t*)(p.ws + WS_WINT), NIN, j / 162, j % 162, (float*)smem); continue; }
    j -= N_TIN;
    const int w = j / N_TSQ; j %= N_TSQ;
    p0_transpose_tile(p.in[18 + w], (bf16_t*)(p.ws + WS_WT) + (size_t)w * 1024 * 1024, 1024, j >> 4, j & 15, (float*)smem);
  }
}

template <int AKIND>
DI void gemm_mainloop(f32x16 (&acc)[2][2], const bf16_t* __restrict__ A, const bf16_t* __restrict__ Bt, int row0, int col0, char* smem) {
  const int tid = threadIdx.x, lane = tid & 63, wid = tid >> 6, wm = wid >> 1, wn = wid & 1, r = lane & 31, h = lane >> 5;
  const bf16_t* pa[4]; const bf16_t* pb[4]; size_t astep[4]; int soff[4];
#pragma unroll
  for (int i = 0; i < 4; ++i) {
    const int c = tid + 256 * i, lr = c >> 3, kc = c & 7;
    if (AKIND == 0) { pa[i] = A + (size_t)(row0 + lr) * 1024 + kc * 8; astep[i] = 64; }
    else { pa[i] = A + hm_base(row0 + lr) + kc * 8; astep[i] = hm_hstride(row0 + lr); }
    pb[i] = Bt + (size_t)(col0 + lr) * 1024 + kc * 8;
    soff[i] = lr * LDS_ROW + kc * 16;
  }
  uint4 ra[4], rb[4];
#pragma unroll
  for (int i = 0; i < 4; ++i) { ra[i] = *(const uint4*)pa[i]; rb[i] = *(const uint4*)pb[i]; }
#pragma unroll
  for (int i = 0; i < 4; ++i) { *(uint4*)(smem + soff[i]) = ra[i]; *(uint4*)(smem + LDS_TILE + soff[i]) = rb[i]; }
  __syncthreads();
  for (int kt = 0; kt < 16; ++kt) {
    if (kt + 1 < 16) {
#pragma unroll
      for (int i = 0; i < 4; ++i) { ra[i] = *(const uint4*)(pa[i] + (size_t)(kt + 1) * astep[i]); rb[i] = *(const uint4*)(pb[i] + (kt + 1) * 64); }
    }
    const char* sa = smem + (kt & 1) * (2 * LDS_TILE);
    const char* sb = sa + LDS_TILE;
#pragma unroll
    for (int s = 0; s < 4; ++s) {
      bf16x8 af[2], bfr[2];
#pragma unroll
      for (int q = 0; q < 2; ++q) {
        af[q] = *(const bf16x8*)(sa + (wm * 64 + q * 32 + r) * LDS_ROW + (16 * s + 8 * h) * 2);
        bfr[q] = *(const bf16x8*)(sb + (wn * 64 + q * 32 + r) * LDS_ROW + (16 * s + 8 * h) * 2);
      }
#pragma unroll
      for (int q = 0; q < 2; ++q)
#pragma unroll
        for (int c = 0; c < 2; ++c) acc[q][c] = MFMA32(af[q], bfr[c], acc[q][c]);
    }
    if (kt + 1 < 16) {
      char* d = smem + ((kt + 1) & 1) * (2 * LDS_TILE);
#pragma unroll
      for (int i = 0; i < 4; ++i) { *(uint4*)(d + soff[i]) = ra[i]; *(uint4*)(d + LDS_TILE + soff[i]) = rb[i]; }
    }
    __syncthreads();
  }
}
DI void zero_acc(f32x16 (&acc)[2][2]) {
#pragma unroll
  for (int q = 0; q < 2; ++q)
#pragma unroll
    for (int c = 0; c < 2; ++c)
#pragma unroll
      for (int i = 0; i < 16; ++i) acc[q][c][i] = 0.f;
}

constexpr int CLD = 132;
DI void acc_to_lds(const f32x16 (&acc)[2][2], float* C) {
  const int lane = threadIdx.x & 63, wid = threadIdx.x >> 6, wm = wid >> 1, wn = wid & 1, r = lane & 31, h = lane >> 5;
  float* b = C + (wm * 64 + 4 * h) * CLD + wn * 64 + r;
#pragma unroll
  for (int q = 0; q < 2; ++q)
#pragma unroll
    for (int cb = 0; cb < 2; ++cb)
#pragma unroll
      for (int i = 0; i < 16; ++i) b[(q * 32 + (i & 3) + 8 * (i >> 2)) * CLD + cb * 32] = acc[q][cb][i];
}
DI uint2 pack4(float4 v) { return make_uint2(cvtpk(v.x, v.y), cvtpk(v.z, v.w)); }

DI void p1_tile(const Params& p, int mt, int nt, char* smem) {
  f32x16 acc[2][2]; zero_acc(acc);
  const int row0 = mt * 128, col0 = nt * 128;
  gemm_mainloop<0>(acc, (const bf16_t*)(p.ws + WS_H), (const bf16_t*)(p.ws + WS_WINT), row0, col0, smem);
  float* C = (float*)smem;
  acc_to_lds(acc, C);
  __syncthreads();
  const int tid = threadIdx.x;
  const int region = nt >> 3;
  const bool prompt = row0 < MP;
  const int lc = (tid & 31) * 4;
#pragma unroll 2
  for (int pass = 0; pass < 16; ++pass) {
    const int lr = pass * 8 + (tid >> 5);
    const float4 v = *(const float4*)(C + lr * CLD + lc);
    const int row = row0 + lr, col = col0 + lc;
    if (region >= 6) {
      const int pc = col - 6144;
      *(uint2*)((bf16_t*)(p.ws + WS_PB) + (size_t)row * CSH + pc) = pack4(v);
      if (prompt) { if ((row & 4095) == 4095) *(float4*)(p.out + OUT_SHP + (size_t)(row >> 12) * CSH + pc) = v; }
      else { const int rs = row - MP; if ((rs & 15) == 15) *(float4*)(p.out + OUT_SHS + (size_t)(rs >> 4) * CSH + pc) = v; }
    } else if (region == 0) {
      const int hh = col >> 6, d = col & 63;
      *(uint2*)((bf16_t*)(p.ws + WS_QB) + hm_base(row) + hh * hm_hstride(row) + d) = pack4(make_float4(v.x * QSCALE, v.y * QSCALE, v.z * QSCALE, v.w * QSCALE));
    } else if (region == 1) {
      const int c = col - 1024, hh = c >> 6, d = c & 63;
      if (prompt) {
        const size_t o = (((size_t)(row >> 12) * 16 + hh) * 4096 + (row & 4095)) * 64 + d;
        *(float4*)(p.out + OUT_KP + o) = v; *(uint2*)((bf16_t*)(p.ws + WS_KB) + o) = pack4(v);
      } else { const int rs = row - MP; *(float4*)(p.out + OUT_KS + (((size_t)(rs >> 4) * 16 + hh) * 16 + (rs & 15)) * 64 + d) = v; }
    } else if (region == 2) {
      const int c = col - 2048, hh = c >> 6, d = c & 63;
      if (prompt) *(float4*)(p.out + OUT_VP + (((size_t)(row >> 12) * 16 + hh) * 4096 + (row & 4095)) * 64 + d) = v;
      else { const int rs = row - MP; *(float4*)(p.out + OUT_VS + (((size_t)(rs >> 4) * 16 + hh) * 16 + (rs & 15)) * 64 + d) = v; }
    } else if (region == 3) {
      const int c = col - 3072;
      *(uint2*)((bf16_t*)(p.ws + WS_SZA) + (size_t)row * 1024 + c) = pack4(make_float4(v.x * sigmoidf_(v.x), v.y * sigmoidf_(v.y), v.z * sigmoidf_(v.z), v.w * sigmoidf_(v.w)));
    } else {
      const int c = col - 4096;
      *(uint2*)((bf16_t*)p.out + (size_t)row * 2048 + c) = pack4(make_float4(sigmoidf_(v.x), sigmoidf_(v.y), sigmoidf_(v.z), sigmoidf_(v.w)));
    }
  }
  if (region == 2 && prompt) {
    bf16_t* VT = (bf16_t*)(p.ws + WS_VT);
    const int lcol = tid & 127, c = col0 - 2048 + lcol, hh = c >> 6, d = c & 63;
    const size_t sh = (size_t)(row0 >> 12) * 16 + hh; const int t0 = row0 & 4095;
#pragma unroll 2
    for (int pass = 0; pass < 8; ++pass) {
      const int lr = pass * 16 + (tid >> 7) * 8;
      float x[8];
#pragma unroll
      for (int m = 0; m < 8; ++m) x[m] = C[(lr + m) * CLD + lcol];
      *(uint4*)(VT + (sh * 64 + d) * 4096 + t0 + lr) = make_uint4(cvtpk(x[0], x[1]), cvtpk(x[2], x[3]), cvtpk(x[4], x[5]), cvtpk(x[6], x[7]));
    }
  }
  __syncthreads();
}

DI void phase1(const Params& p, int nt0, int nnt, char* smem) {
  const int ntiles = 132 * nnt;
  for (int t = blockIdx.x; t < ntiles; t += gridDim.x) p1_tile(p, t / nnt, nt0 + t % nnt, smem);
}

DI void prep_tile(const Params& p, int tile, float* lds) {
  const int tid = threadIdx.x;
  const int row0 = tile * 8;
  const bool prompt = row0 < MP;
  const int t0 = prompt ? (row0 & 4095) : ((row0 - MP) & 15);
  const int sb = prompt ? 0 : ((row0 - MP) >> 4);
  const bf16_t* PB = (const bf16_t*)(p.ws + WS_PB);
  const float* mu = p.in[8];
  const float* sshift = p.in[4] + (size_t)sb * CSH;
#pragma unroll
  for (int i = 0; i < 4; ++i) {
    const int v = tid + 256 * i, tok = v >> 7, j = v & 127, col = 3072 + j;
    const float cur = bf2f(PB[(size_t)(row0 + tok) * CSH + col]);
    float prev;
    if (t0 + tok == 0) prev = prompt ? 0.f : sshift[col];
    else prev = bf2f(PB[(size_t)(row0 + tok - 1) * CSH + col]);
    const float m = cur + mu[col] * (prev - cur);
    if (j < 64) lds[tok * 64 + j] = tanhf(m); else lds[(8 + tok) * 64 + (j - 64)] = m;
  }
  __syncthreads();
  const int c = tid * 4, hh = c >> 6;
  float aw[8][4], aa[8][4];
#pragma unroll
  for (int t = 0; t < 8; ++t)
#pragma unroll
    for (int x = 0; x < 4; ++x) { aw[t][x] = 0.f; aa[t][x] = 0.f; }
  const float* w2 = p.in[10]; const float* a2 = p.in[12];
  for (int r = 0; r < 64; r += 4) {
    float4 wr[4], ar[4];
#pragma unroll
    for (int q = 0; q < 4; ++q) { wr[q] = *(const float4*)(w2 + (size_t)(r + q) * 1024 + c); ar[q] = *(const float4*)(a2 + (size_t)(r + q) * 1024 + c); }
#pragma unroll
    for (int t = 0; t < 8; ++t) {
      const float4 lw = *(const float4*)(lds + t * 64 + r);
      const float4 la = *(const float4*)(lds + (8 + t) * 64 + r);
      aw[t][0] += lw.x * wr[0].x + lw.y * wr[1].x + lw.z * wr[2].x + lw.w * wr[3].x;
      aw[t][1] += lw.x * wr[0].y + lw.y * wr[1].y + lw.z * wr[2].y + lw.w * wr[3].y;
      aw[t][2] += lw.x * wr[0].z + lw.y * wr[1].z + lw.z * wr[2].z + lw.w * wr[3].z;
      aw[t][3] += lw.x * wr[0].w + lw.y * wr[1].w + lw.z * wr[2].w + lw.w * wr[3].w;
      aa[t][0] += la.x * ar[0].x + la.y * ar[1].x + la.z * ar[2].x + la.w * ar[3].x;
      aa[t][1] += la.x * ar[0].y + la.y * ar[1].y + la.z * ar[2].y + la.w * ar[3].y;
      aa[t][2] += la.x * ar[0].z + la.y * ar[1].z + la.z * ar[2].z + la.w * ar[3].z;
      aa[t][3] += la.x * ar[0].w + la.y * ar[1].w + la.z * ar[2].w + la.w * ar[3].w;
    }
  }
  const float4 w0 = *(const float4*)(p.in[9] + c), a0 = *(const float4*)(p.in[11] + c);
  const float4 kkw = *(const float4*)(p.in[13] + c), kaw = *(const float4*)(p.in[14] + c), rkw = *(const float4*)(p.in[15] + c);
  const float4 mur = *(const float4*)(mu + c), muk = *(const float4*)(mu + 1024 + c), muv = *(const float4*)(mu + 2048 + c), muz = *(const float4*)(mu + 3200 + c);
  const float w0a[4] = {w0.x, w0.y, w0.z, w0.w}, a0a[4] = {a0.x, a0.y, a0.z, a0.w};
  const float kka[4] = {kkw.x, kkw.y, kkw.z, kkw.w}, kaa[4] = {kaw.x, kaw.y, kaw.z, kaw.w}, rka[4] = {rkw.x, rkw.y, rkw.z, rkw.w};
  const float mura[4] = {mur.x, mur.y, mur.z, mur.w}, muka[4] = {muk.x, muk.y, muk.z, muk.w}, muva[4] = {muv.x, muv.y, muv.z, muv.w}, muza[4] = {muz.x, muz.y, muz.z, muz.w};
  float* SW = (float*)(p.ws + WS_SW);
  bf16_t* SR = (bf16_t*)(p.ws + WS_SR); bf16_t* SK = (bf16_t*)(p.ws + WS_SK); bf16_t* SV = (bf16_t*)(p.ws + WS_SV);
  bf16_t* SKK = (bf16_t*)(p.ws + WS_SKK); bf16_t* SB = (bf16_t*)(p.ws + WS_SB); bf16_t* SZB = (bf16_t*)(p.ws + WS_SZB);
  float* BONUS = (float*)(p.ws + WS_BONUS);
#pragma unroll
  for (int t = 0; t < 8; ++t) {
    const int row = row0 + t;
    const bf16_t* pc = PB + (size_t)row * CSH;
    const uint2 cr = *(const uint2*)(pc + c), ck = *(const uint2*)(pc + 1024 + c), cv = *(const uint2*)(pc + 2048 + c), cz = *(const uint2*)(pc + 3200 + c);
    float curr[4] = {bflo(cr.x), bfhi(cr.x), bflo(cr.y), bfhi(cr.y)}, curk[4] = {bflo(ck.x), bfhi(ck.x), bflo(ck.y), bfhi(ck.y)};
    float curv[4] = {bflo(cv.x), bfhi(cv.x), bflo(cv.y), bfhi(cv.y)}, curz[4] = {bflo(cz.x), bfhi(cz.x), bflo(cz.y), bfhi(cz.y)};
    float pr[4], pk[4], pv[4], pz[4];
    if (t0 + t == 0) {
      if (prompt) {
#pragma unroll
        for (int x = 0; x < 4; ++x) { pr[x] = 0.f; pk[x] = 0.f; pv[x] = 0.f; pz[x] = 0.f; }
      } else {
        const float4 a = *(const float4*)(sshift + c), b = *(const float4*)(sshift + 1024 + c), d = *(const float4*)(sshift + 2048 + c), e = *(const float4*)(sshift + 3200 + c);
        pr[0] = a.x; pr[1] = a.y; pr[2] = a.z; pr[3] = a.w; pk[0] = b.x; pk[1] = b.y; pk[2] = b.z; pk[3] = b.w;
        pv[0] = d.x; pv[1] = d.y; pv[2] = d.z; pv[3] = d.w; pz[0] = e.x; pz[1] = e.y; pz[2] = e.z; pz[3] = e.w;
      }
    } else {
      const bf16_t* pp = pc - CSH;
      const uint2 qr = *(const uint2*)(pp + c), qk = *(const uint2*)(pp + 1024 + c), qv = *(const uint2*)(pp + 2048 + c), qz = *(const uint2*)(pp + 3200 + c);
      pr[0] = bflo(qr.x); pr[1] = bfhi(qr.x); pr[2] = bflo(qr.y); pr[3] = bfhi(qr.y);
      pk[0] = bflo(qk.x); pk[1] = bfhi(qk.x); pk[2] = bflo(qk.y); pk[3] = bfhi(qk.y);
      pv[0] = bflo(qv.x); pv[1] = bfhi(qv.x); pv[2] = bflo(qv.y); pv[3] = bfhi(qv.y);
      pz[0] = bflo(qz.x); pz[1] = bfhi(qz.x); pz[2] = bflo(qz.y); pz[3] = bfhi(qz.y);
    }
    float rm[4], km[4], vm[4], dec[4], kkv[4], bb[4], kmod[4], szb[4];
    float ssq = 0.f, bon = 0.f;
#pragma unroll
    for (int x = 0; x < 4; ++x) {
      rm[x] = curr[x] + mura[x] * (pr[x] - curr[x]);
      km[x] = curk[x] + muka[x] * (pk[x] - curk[x]);
      vm[x] = curv[x] + muva[x] * (pv[x] - curv[x]);
      const float zm = curz[x] + muza[x] * (pz[x] - curz[x]);
      szb[x] = zm * sigmoidf_(zm);
      const float u = -(w0a[x] + aw[t][x]);
      const float sp = fmaxf(u, 0.f) + log1pf(expf(-fabsf(u)));
      const float wraw = -sp - 0.5f;
      dec[x] = expf(-expf(wraw));
      const float a = sigmoidf_(a0a[x] + aa[t][x]);
      kkv[x] = km[x] * kka[x];
      ssq += kkv[x] * kkv[x];
      kmod[x] = km[x] * (1.f + (a - 1.f) * kaa[x]);
      bb[x] = a;
      bon += rm[x] * kmod[x] * rka[x];
    }
    ssq = sum16(ssq); bon = sum16(bon);
    const float inv = 1.f / fmaxf(sqrtf(ssq), 1e-12f);
#pragma unroll
    for (int x = 0; x < 4; ++x) { kkv[x] *= inv; bb[x] *= kkv[x]; }
    const size_t idx = hm_base(row) + hh * hm_hstride(row) + (c & 63);
    *(float4*)(SW + idx) = make_float4(dec[0], dec[1], dec[2], dec[3]);
    *(uint2*)(SR + idx) = make_uint2(cvtpk(rm[0], rm[1]), cvtpk(rm[2], rm[3]));
    *(uint2*)(SK + idx) = make_uint2(cvtpk(kmod[0], kmod[1]), cvtpk(kmod[2], kmod[3]));
    *(uint2*)(SV + idx) = make_uint2(cvtpk(vm[0], vm[1]), cvtpk(vm[2], vm[3]));
    *(uint2*)(SKK + idx) = make_uint2(cvtpk(-kkv[0], -kkv[1]), cvtpk(-kkv[2], -kkv[3]));
    *(uint2*)(SB + idx) = make_uint2(cvtpk(bb[0], bb[1]), cvtpk(bb[2], bb[3]));
    *(uint2*)(SZB + (size_t)row * 1024 + c) = make_uint2(cvtpk(szb[0], szb[1]), cvtpk(szb[2], szb[3]));
    if ((tid & 15) == 0) BONUS[(size_t)row * 16 + hh] = bon;
  }
  __syncthreads();
}
DI void phase1b(const Params& p, char* smem) {
  for (int t = blockIdx.x; t < MT / 8; t += gridDim.x) prep_tile(p, t, (float*)smem);
}

template <bool SAMPLE>
DI void attn_wave(const Params& p, int sh, int qt) {
  const int lane = threadIdx.x & 63, r = lane & 31, h = lane >> 5;
  bf16_t* QB = (bf16_t*)(p.ws + WS_QB);
  bf16_t* Qp = SAMPLE ? QB + (size_t)MP * 1024 + (size_t)sh * 16 * 64 : QB + ((size_t)sh * 4096 + qt * 32) * 64;
  const int qrow = SAMPLE ? (r < 15 ? r : 15) : r;
  bf16x8 qf[4];
#pragma unroll
  for (int s = 0; s < 4; ++s) qf[s] = *(const bf16x8*)(Qp + qrow * 64 + 16 * s + 8 * h);
  f32x16 z0, z1;
#pragma unroll
  for (int i = 0; i < 16; ++i) { z0[i] = 0.f; z1[i] = 0.f; }
  float carry = 1.f;
  const int ntiles = SAMPLE ? 33 : qt + 1;
  const bf16_t* KB = (const bf16_t*)(p.ws + WS_KB); const bf16_t* VT = (const bf16_t*)(p.ws + WS_VT);
  for (int it = 0; it < ntiles; ++it) {
    const bool diag = (it == 0);
    const int kt = SAMPLE ? 32 - it : qt - it;
    bf16x8 kf[4];
    if (!SAMPLE) {
      const bf16_t* Kp = KB + ((size_t)sh * 4096 + kt * 32 + r) * 64;
#pragma unroll
      for (int s = 0; s < 4; ++s) kf[s] = *(const bf16x8*)(Kp + 16 * s + 8 * h);
    } else {
      const float* Kp = diag ? p.out + OUT_KS + ((size_t)sh * 16 + (r < 15 ? r : 15)) * 64 : p.in[2] + ((size_t)sh * 1024 + kt * 32 + r) * 64;
#pragma unroll
      for (int s = 0; s < 4; ++s) {
        const float4 a = *(const float4*)(Kp + 16 * s + 8 * h), b = *(const float4*)(Kp + 16 * s + 8 * h + 4);
        u32x4 w; w[0] = cvtpk(a.x, a.y); w[1] = cvtpk(a.z, a.w); w[2] = cvtpk(b.x, b.y); w[3] = cvtpk(b.z, b.w);
        kf[s] = __builtin_bit_cast(bf16x8, w);
      }
    }
    f32x16 st;
#pragma unroll
    for (int i = 0; i < 16; ++i) st[i] = 0.f;
#pragma unroll
    for (int s = 0; s < 4; ++s) st = MFMA32(kf[s], qf[s], st);
    float keep[16], wgt[16];
#pragma unroll
    for (int i = 0; i < 16; ++i) {
      const float e = __builtin_amdgcn_exp2f(st[i]);
      const float kp = __builtin_amdgcn_rcpf(1.f + e);
      bool valid = true;
      if (diag) { const int kr = crow(i, h); valid = SAMPLE ? (kr < r && kr < 16) : (kr < r); }
      keep[i] = valid ? kp : 1.f;
      wgt[i] = valid ? 1.f - kp : 0.f;
    }
    float pp[4], hif[4];
#pragma unroll
    for (int g = 0; g < 4; ++g) {
      const float p4 = (keep[4 * g] * keep[4 * g + 1]) * (keep[4 * g + 2] * keep[4 * g + 3]);
      const auto sw = __builtin_amdgcn_permlane32_swap(__float_as_uint(p4), __float_as_uint(p4), false, false);
      const float lo = __uint_as_float(sw[0]), hi = __uint_as_float(sw[1]);
      pp[g] = lo * hi;
      hif[g] = h ? 1.f : hi;
    }
    float T[4];
    T[3] = carry; T[2] = T[3] * pp[3]; T[1] = T[2] * pp[2]; T[0] = T[1] * pp[1];
    carry = T[0] * pp[0];
#pragma unroll
    for (int g = 0; g < 4; ++g) {
      const float w3 = T[g] * hif[g], w2 = w3 * keep[4 * g + 3], w1 = w2 * keep[4 * g + 2], w0 = w1 * keep[4 * g + 1];
      wgt[4 * g + 3] *= w3; wgt[4 * g + 2] *= w2; wgt[4 * g + 1] *= w1; wgt[4 * g] *= w0;
    }
#pragma unroll
    for (int s = 0; s < 2; ++s) {
      u32x4 pw;
#pragma unroll
      for (int j = 0; j < 4; ++j) pw[j] = cvtpk(wgt[8 * s + 2 * j], wgt[8 * s + 2 * j + 1]);
      const bf16x8 pf = __builtin_bit_cast(bf16x8, pw);
#pragma unroll
      for (int db = 0; db < 2; ++db) {
        bf16x8 vf;
        if (!SAMPLE) {
          const bf16_t* vp = VT + ((size_t)sh * 64 + db * 32 + r) * 4096 + kt * 32 + 16 * s + 4 * h;
          const uint2 lo = *(const uint2*)vp, hi = *(const uint2*)(vp + 8);
          u32x4 w; w[0] = lo.x; w[1] = lo.y; w[2] = hi.x; w[3] = hi.y;
          vf = __builtin_bit_cast(bf16x8, w);
        } else {
          float vv[8];
#pragma unroll
          for (int j = 0; j < 8; ++j) {
            const int kr = 16 * s + 8 * (j >> 2) + 4 * h + (j & 3);
            const float* vp = diag ? p.out + OUT_VS + ((size_t)sh * 16 + (kr < 15 ? kr : 15)) * 64 : p.in[3] + ((size_t)sh * 1024 + kt * 32 + kr) * 64;
            vv[j] = vp[db * 32 + r];
          }
          u32x4 w; w[0] = cvtpk(vv[0], vv[1]); w[1] = cvtpk(vv[2], vv[3]); w[2] = cvtpk(vv[4], vv[5]); w[3] = cvtpk(vv[6], vv[7]);
          vf = __builtin_bit_cast(bf16x8, w);
        }
        if (db == 0) z0 = MFMA32(pf, vf, z0); else z1 = MFMA32(pf, vf, z1);
      }
    }
    if (__ballot(carry != 0.f) == 0ull) break;
  }
  const bf16_t* SZA = (const bf16_t*)(p.ws + WS_SZA);
  const int hh = sh & 15, b = sh >> 4;
#pragma unroll
  for (int i = 0; i < 16; ++i) {
    const int q = crow(i, h);
    if (SAMPLE && q >= 16) continue;
    const int row = SAMPLE ? MP + b * 16 + q : b * 4096 + qt * 32 + q;
    const bf16_t* zp = SZA + (size_t)row * 1024 + hh * 64 + r;
    Qp[q * 64 + r] = f2bf(z0[i] * bf2f(zp[0]));
    Qp[q * 64 + 32 + r] = f2bf(z1[i] * bf2f(zp[32]));
  }
}

DI void scan_unit(const Params& p, int shg, int quarter, float* lds) {
  const int tid = threadIdx.x, lane = tid & 63, wid = tid >> 6, cc = lane & 15;
  const bool prompt = shg < 64;
  const int T = prompt ? 4096 : 16;
  const size_t base = prompt ? (size_t)shg * 4096 * 64 : (size_t)MP * 1024 + (size_t)(shg - 64) * 16 * 64;
  const int v = quarter * 16 + wid * 4 + (lane >> 4);
  const float* SW = (const float*)(p.ws + WS_SW) + base;
  const bf16_t* SARR = (const bf16_t*)(p.ws + WS_SR) + base;
  float* ORAW = (float*)(p.ws + WS_ORAW) + base;
  float4 S;
  float* wout;
  if (prompt) { S = make_float4(0.f, 0.f, 0.f, 0.f); wout = p.out + OUT_WP + ((size_t)shg * 64 + v) * 64 + 4 * cc; }
  else { S = *(const float4*)(p.in[5] + ((size_t)(shg - 64) * 64 + v) * 64 + 4 * cc); wout = p.out + OUT_WS + ((size_t)(shg - 64) * 64 + v) * 64 + 4 * cc; }
  const int nch = T / 16;
  float4 gw; uint4 gb[3];
  auto gload = [&](int ch) {
    gw = *(const float4*)(SW + (size_t)ch * 1024 + tid * 4);
#pragma unroll
    for (int i = 0; i < 3; ++i) {
      const int idx = tid + 256 * i;
      if (idx < 640) { const int arr = idx >> 7, c = idx & 127; gb[i] = *(const uint4*)(SARR + (size_t)arr * (SZ_ACT / 2) + (size_t)ch * 1024 + c * 8); }
    }
  };
  auto lstore = [&](int buf) {
    float* L = lds + buf * (16 * 6 * 64);
    *(float4*)(L + ((tid >> 4) * 6 + 2) * 64 + (tid & 15) * 4) = gw;
#pragma unroll
    for (int i = 0; i < 3; ++i) {
      const int idx = tid + 256 * i;
      if (idx < 640) {
        const int arr = idx >> 7, c = idx & 127;
        const int slot = arr == 0 ? 4 : arr == 1 ? 3 : arr == 2 ? 5 : arr == 3 ? 0 : 1;
        float* d = L + ((c >> 3) * 6 + slot) * 64 + (c & 7) * 8;
        *(float4*)d = make_float4(bflo(gb[i].x), bfhi(gb[i].x), bflo(gb[i].y), bfhi(gb[i].y));
        *(float4*)(d + 4) = make_float4(bflo(gb[i].z), bfhi(gb[i].z), bflo(gb[i].w), bfhi(gb[i].w));
      }
    }
  };
  gload(0); lstore(0); __syncthreads();
  for (int ch = 0; ch < nch; ++ch) {
    if (ch + 1 < nch) gload(ch + 1);
    const float* L = lds + (ch & 1) * (16 * 6 * 64);
#pragma unroll 4
    for (int st = 0; st < 16; ++st) {
      const float* Ls = L + st * 6 * 64;
      const float4 nk = *(const float4*)(Ls + 0 * 64 + 4 * cc), bb = *(const float4*)(Ls + 1 * 64 + 4 * cc), ww = *(const float4*)(Ls + 2 * 64 + 4 * cc);
      const float4 kv = *(const float4*)(Ls + 3 * 64 + 4 * cc), rr = *(const float4*)(Ls + 4 * 64 + 4 * cc);
      const float vt = Ls[5 * 64 + v];
      float d = (S.x * nk.x + S.y * nk.y) + (S.z * nk.z + S.w * nk.w);
      const float sa = row16_sum(d);
      S.x = S.x * ww.x + (sa * bb.x + vt * kv.x);
      S.y = S.y * ww.y + (sa * bb.y + vt * kv.y);
      S.z = S.z * ww.z + (sa * bb.z + vt * kv.z);
      S.w = S.w * ww.w + (sa * bb.w + vt * kv.w);
      float o = (S.x * rr.x + S.y * rr.y) + (S.z * rr.z + S.w * rr.w);
      o = row16_sum(o);
      if (cc == 0) ORAW[(size_t)(ch * 16 + st) * 64 + v] = o;
    }
    if (ch + 1 < nch) lstore((ch + 1) & 1);
    __syncthreads();
  }
  *(float4*)wout = S;
}

constexpr int NQ_LONG = 256, NQ_ATT_P = 2048, NQ_ATT_S = 128, NQ_SCAN_S = 2048, NQ_SHORT = NQ_ATT_P + NQ_ATT_S + NQ_SCAN_S;
DI void phase2(const Params& p, char* smem) {
  __shared__ int s_role, s_unit;
  unsigned* ctl = (unsigned*)(p.ws + WS_CTL);
  if (threadIdx.x == 0) {
    const unsigned xcc = (unsigned)__builtin_amdgcn_s_getreg((3 << 11) | 20) & 0xFu;
    const unsigned cu = ((unsigned)__builtin_amdgcn_s_getreg(63492) >> 8) & 0xFFu;
    s_role = (int)(atomicAdd(&ctl[64 + xcc * 256 + cu], 1u) & 1u);
  }
  __syncthreads();
  const int role = s_role;
  for (int pass = 0; pass < 2; ++pass) {
    const bool longq = (pass == 0) == (role == 0);
    for (;;) {
      __syncthreads();
      if (threadIdx.x == 0) s_unit = (int)atomicAdd(&ctl[longq ? 0 : 1], 1u);
      __syncthreads();
      const int u = s_unit;
      if (longq) {
        if (u >= NQ_LONG) break;
        scan_unit(p, u >> 2, u & 3, (float*)smem);
      } else {
        if (u >= NQ_SHORT) break;
        const int wid = threadIdx.x >> 6;
        if (u < NQ_ATT_P) attn_wave<false>(p, u >> 5, (u & 31) * 4 + wid);
        else if (u < NQ_ATT_P + NQ_ATT_S) attn_wave<true>(p, (u - NQ_ATT_P) * 4 + wid, 0);
        else { const int s = u - NQ_ATT_P - NQ_ATT_S; scan_unit(p, 64 + (s >> 2), s & 3, (float*)smem); }
      }
    }
  }
}

DI void phase2c(const Params& p) {
  const int tid = threadIdx.x, c = tid * 4, hh = c >> 6;
  const float4 lg = *(const float4*)(p.in[16] + c), lb = *(const float4*)(p.in[17] + c);
  const float* ORAW = (const float*)(p.ws + WS_ORAW); const bf16_t* SV = (const bf16_t*)(p.ws + WS_SV);
  const bf16_t* SZB = (const bf16_t*)(p.ws + WS_SZB); const float* BONUS = (const float*)(p.ws + WS_BONUS);
  bf16_t* OB = (bf16_t*)(p.ws + WS_OB);
  for (int row = blockIdx.x; row < MT; row += gridDim.x) {
    const size_t idx = hm_base(row) + hh * hm_hstride(row) + (c & 63);
    const float4 o = *(const float4*)(ORAW + idx);
    const float mean = sum16((o.x + o.y) + (o.z + o.w)) * (1.f / 64.f);
    const float dx = o.x - mean, dy = o.y - mean, dz = o.z - mean, dw = o.w - mean;
    const float var = sum16((dx * dx + dy * dy) + (dz * dz + dw * dw)) * (1.f / 64.f);
    const float inv = rsqrtf(var + LNX_EPS);
    const float bon = BONUS[(size_t)row * 16 + hh];
    const uint2 vv = *(const uint2*)(SV + idx), zz = *(const uint2*)(SZB + (size_t)row * 1024 + c);
    const float r0 = (dx * inv * lg.x + lb.x + bon * bflo(vv.x)) * bflo(zz.x);
    const float r1 = (dy * inv * lg.y + lb.y + bon * bfhi(vv.x)) * bfhi(zz.x);
    const float r2 = (dz * inv * lg.z + lb.z + bon * bflo(vv.y)) * bflo(zz.y);
    const float r3 = (dw * inv * lg.w + lb.w + bon * bfhi(vv.y)) * bfhi(zz.y);
    *(uint2*)(OB + (size_t)row * 1024 + c) = make_uint2(cvtpk(r0, r1), cvtpk(r2, r3));
  }
}

DI void p3a_tile(const Params& p, int mt, int nt, char* smem) {
  const int row0 = mt * 128, col0 = nt * 128, tid = threadIdx.x, lc = (tid & 31) * 4;
  const bf16_t* G = (const bf16_t*)p.out;
  bf16_t* MG = (bf16_t*)(p.ws + WS_MG);
  float* C = (float*)smem;
  f32x16 acc[2][2];
  zero_acc(acc);
  gemm_mainloop<1>(acc, (const bf16_t*)(p.ws + WS_QB), (const bf16_t*)(p.ws + WS_WT), row0, col0, smem);
  acc_to_lds(acc, C);
  __syncthreads();
#pragma unroll 2
  for (int pass = 0; pass < 16; ++pass) {
    const int lr = pass * 8 + (tid >> 5);
    const float4 v = *(const float4*)(C + lr * CLD + lc);
    const size_t row = row0 + lr; const int col = col0 + lc;
    const uint2 g = *(const uint2*)(G + row * 2048 + col);
    *(uint2*)(MG + row * 1024 + col) = pack4(make_float4(v.x * bflo(g.x), v.y * bfhi(g.x), v.z * bflo(g.y), v.w * bfhi(g.y)));
  }
  __syncthreads();
  zero_acc(acc);
  gemm_mainloop<0>(acc, (const bf16_t*)(p.ws + WS_OB), (const bf16_t*)(p.ws + WS_WT) + (size_t)1024 * 1024, row0, col0, smem);
  acc_to_lds(acc, C);
  __syncthreads();
#pragma unroll 2
  for (int pass = 0; pass < 16; ++pass) {
    const int lr = pass * 8 + (tid >> 5);
    const float4 v = *(const float4*)(C + lr * CLD + lc);
    const size_t row = row0 + lr; const int col = col0 + lc;
    const uint2 g = *(const uint2*)(G + row * 2048 + 1024 + col);
    const uint2 m = *(const uint2*)(MG + row * 1024 + col);
    *(uint2*)(MG + row * 1024 + col) = pack4(make_float4(bflo(m.x) + v.x * bflo(g.x), bfhi(m.x) + v.y * bfhi(g.x), bflo(m.y) + v.z * bflo(g.y), bfhi(m.y) + v.w * bfhi(g.y)));
  }
  __syncthreads();
}
DI void p3b_tile(const Params& p, int mt, int nt, char* smem) {
  const int row0 = mt * 128, col0 = nt * 128, tid = threadIdx.x, lc = (tid & 31) * 4;
  float* C = (float*)smem;
  f32x16 acc[2][2];
  zero_acc(acc);
  gemm_mainloop<0>(acc, (const bf16_t*)(p.ws + WS_MG), (const bf16_t*)(p.ws + WS_WT) + (size_t)2 * 1024 * 1024, row0, col0, smem);
  acc_to_lds(acc, C);
  __syncthreads();
#pragma unroll 2
  for (int pass = 0; pass < 16; ++pass) {
    const int lr = pass * 8 + (tid >> 5);
    const float4 v = *(const float4*)(C + lr * CLD + lc);
    const int row = row0 + lr, col = col0 + lc;
    const float4 x = row < MP ? *(const float4*)(p.in[0] + (size_t)row * 1024 + col) : *(const float4*)(p.in[1] + (size_t)(row - MP) * 1024 + col);
    *(float4*)(p.out + OUT_YP + (size_t)row * 1024 + col) = make_float4(x.x + v.x, x.y + v.y, x.z + v.z, x.w + v.w);
  }
  __syncthreads();
}
DI void phase4(const Params& p) {
  const int lane = threadIdx.x & 63, wid = threadIdx.x >> 6;
  const float* g = p.in[21];
  for (int row = blockIdx.x * 4 + wid; row < MT; row += gridDim.x * 4) {
    float* x = p.out + OUT_YP + (size_t)row * 1024;
    float4 v[4]; float ss = 0.f;
#pragma unroll
    for (int i = 0; i < 4; ++i) { v[i] = *(const float4*)(x + i * 256 + lane * 4); ss += v[i].x * v[i].x + v[i].y * v[i].y + v[i].z * v[i].z + v[i].w * v[i].w; }
    ss = wave_sum(ss);
    const float inv = rsqrtf(ss * (1.f / DM) + EPS);
#pragma unroll
    for (int i = 0; i < 4; ++i) {
      const float4 gg = *(const float4*)(g + i * 256 + lane * 4);
      *(float4*)(x + i * 256 + lane * 4) = make_float4(v[i].x * inv * gg.x, v[i].y * inv * gg.y, v[i].z * inv * gg.z, v[i].w * inv * gg.w);
    }
  }
}

__global__ void __launch_bounds__(256, 2) mega(Params p) {
  extern __shared__ __attribute__((aligned(16))) char smem[];
  cg::grid_group grid = cg::this_grid();
  phase0(p, smem);
  grid.sync();
  phase1(p, 48, 33, smem);
  grid.sync();
  phase1b(p, smem);
  grid.sync();
  phase1(p, 0, 48, smem);
  grid.sync();
  phase2(p, smem);
  grid.sync();
  phase2c(p);
  grid.sync();
  for (int t = blockIdx.x; t < 132 * 8; t += gridDim.x) p3a_tile(p, t >> 3, t & 7, smem);
  grid.sync();
  for (int t = blockIdx.x; t < 132 * 8; t += gridDim.x) p3b_tile(p, t >> 3, t & 7, smem);
  grid.sync();
  phase4(p);
}

extern "C" void kernel_launch(void* const* d_in, const int* in_sizes, int n_in, void* d_out, int out_size, void* d_ws, size_t ws_size, hipStream_t stream) {
  static int grid_blocks = 0;
  if (grid_blocks == 0) {
    if (n_in != 22 || ws_size < WS_END) { fprintf(stderr, "kernel_launch: unexpected n_in %d / ws_size %zu (need %zu)\n", n_in, ws_size, (size_t)WS_END); grid_blocks = -1; return; }
    int dev = 0, cus = 0, per_cu = 0;
    hipGetDevice(&dev);
    hipDeviceGetAttribute(&cus, hipDeviceAttributeMultiprocessorCount, dev);
    hipFuncSetAttribute((const void*)mega, hipFuncAttributeMaxDynamicSharedMemorySize, SMEM_BYTES);
    hipOccupancyMaxActiveBlocksPerMultiprocessor(&per_cu, (const void*)mega, 256, SMEM_BYTES);
    if (per_cu < 1) per_cu = 1;
    if (per_cu > 2) per_cu = 2;
    grid_blocks = cus * per_cu;
  }
  if (grid_blocks < 0) return;
  Params p{};
  for (int i = 0; i < 22; ++i) p.in[i] = (const float*)d_in[i];
  p.out = (float*)d_out; p.ws = (unsigned char*)d_ws;
  void* args[] = {&p};
  hipError_t e = hipLaunchCooperativeKernel((const void*)mega, dim3(grid_blocks), dim3(256), args, SMEM_BYTES, stream);
  if (e != hipSuccess) fprintf(stderr, "cooperative launch failed: %s (grid %d)\n", hipGetErrorString(e), grid_blocks);
}
```

```cpp
#include <hip/hip_runtime.h>
#include <hip/hip_cooperative_groups.h>
#include <cstdio>
#include <cstdint>
namespace cg = cooperative_groups;

namespace pg8 {
#define PG8_LAS __attribute__((address_space(3)))
typedef unsigned short bf16_t;
typedef short bf16x8 __attribute__((ext_vector_type(8)));
typedef float f32x4 __attribute__((ext_vector_type(4)));
typedef unsigned u32x4 __attribute__((ext_vector_type(4)));
constexpr int BM = 256, BK = 64, HALF = 128, HTB = HALF * BK * 2  , STAGE_BYTES = 8 * HTB, NXCD = 8, WGM = 8;

__host__ __device__ __forceinline__ int lds_byte(int r, int c) { const int st = (r >> 4) * 2 + (c >> 5), rr = r & 15, cc = c & 31, ob = rr * 64 + cc * 2; return st * 1024 + (ob ^ (((ob >> 9) & 1) << 5)); }
__host__ __device__ __forceinline__ void stage_rc(int b, int& R, int& C) { const int st = b / 1024, sb = b % 1024, swz = sb ^ (((sb >> 9) & 1) << 5); R = (st >> 1) * 16 + swz / 64; C = (st & 1) * 32 + (swz % 64) / 2; }
__host__ __device__ __forceinline__ int perm32(int rho) { const int n = rho >> 4, i = rho & 15; return 8 * (i >> 2) + 4 * n + (i & 3); }

struct Unit { int pm, pn; };
struct Gemm { const bf16_t* A; const bf16_t* Bt; int M, N, K; };

struct StaticOrder {
    int nM, nN, nwg, G, c;
    __host__ __device__ void init(int M, int N, int G_, int c_) { nM = M / BM; nN = N / BM; nwg = nM * nN; G = G_; c = c_; }
    __host__ __device__ bool next(int i, Unit& u) const {
        const long L = (long)i * G + c; if (L >= nwg) return false;
        int wgid = (int)L; { const int q = nwg / NXCD, r = nwg % NXCD, xcd = wgid % NXCD, off = wgid / NXCD; wgid = (xcd < r ? xcd * (q + 1) : r * (q + 1) + (xcd - r) * q) + off; }
        const int nig = WGM * nN, gid = wgid / nig, fm = gid * WGM, gsz = (nM - fm) < WGM ? (nM - fm) : WGM;
        u.pm = fm + ((wgid % nig) % gsz); u.pn = (wgid % nig) / gsz; return true;
    }
    __device__ __forceinline__ void a_ready(const Unit&) const {}
    __device__ __forceinline__ void done(const Unit&) const {}
};


template <class Epi, class Sched, bool ALIGN_EPI = false, bool SP2 = false>
__device__ __forceinline__ void gemm_phase(PG8_LAS unsigned char* lds, const Gemm g, const Sched& S, const Epi& E) {
    int tid_ = threadIdx.x; asm volatile("" : "+v"(tid_));
    const int tid = tid_, wid = __builtin_amdgcn_readfirstlane(tid >> 6), lane = tid & 63, wr = wid >> 2, wc = wid & 3, fr = lane & 15, fq = lane >> 4;
    const int K = g.K, nt = K / BK;
    unsigned voffA[2], voffB[2];
#pragma unroll
    for (int i = 0; i < 2; ++i) { int R, C; stage_rc(tid * 16 + i * 8192, R, C); const int Rb = Epi::PERM ? ((R & ~31) + perm32(R & 31)) : R;
        voffA[i] = (unsigned)(R * K + C) * 2u; voffB[i] = (unsigned)(Rb * K + C) * 2u; }
    const size_t kstep = (size_t)(BK * 2);
    const size_t hstep = (size_t)HALF * K * 2;
    const size_t tstep = 2 * hstep;
    const unsigned ldsw = (unsigned)wid * 1024u;
    const int aoff = lds_byte(wr * 64 + fr, fq * 8), boff = lds_byte(wc * 32 + fr, fq * 8);
#define PG8_SA(b, h) (((b) * 2 + (h)) * HTB)
#define PG8_SB(b, h) ((4 + (b) * 2 + (h)) * HTB)
#define PG8_STAGE(bufoff, gbase, voff) do { _Pragma("unroll") for (int _i = 0; _i < 2; ++_i) \
        __builtin_amdgcn_global_load_lds((const unsigned*)((const char*)(gbase) + (voff)[_i]), (PG8_LAS unsigned*)(lds + (bufoff) + ldsw + _i * 8192), 16, 0, 0); } while (0)
#define PG8_LDA(dst, b, h) do { _Pragma("unroll") for (int m = 0; m < 4; ++m) _Pragma("unroll") for (int k = 0; k < 2; ++k) dst[m][k] = *(const PG8_LAS bf16x8*)(lds + PG8_SA(b, h) + aoff + m * 2048 + k * 1024); } while (0)
#define PG8_LDB(dst, b, h) do { _Pragma("unroll") for (int n = 0; n < 2; ++n) _Pragma("unroll") for (int k = 0; k < 2; ++k) dst[n][k] = *(const PG8_LAS bf16x8*)(lds + PG8_SB(b, h) + boff + n * 2048 + k * 1024); } while (0)
#define PG8_MMA(ai, bj, At, Bt) do { __builtin_amdgcn_s_setprio(1); _Pragma("unroll") for (int m = 0; m < 4; ++m) _Pragma("unroll") for (int n = 0; n < 2; ++n) _Pragma("unroll") for (int k = 0; k < 2; ++k) \
        acc[ai][bj][m][n] = __builtin_amdgcn_mfma_f32_16x16x32_bf16(Bt[n][k], At[m][k], acc[ai][bj][m][n], 0, 0, 0); __builtin_amdgcn_s_setprio(0); } while (0)
#define PG8_WAIT_V(n) asm volatile("s_waitcnt vmcnt(" #n ")" ::: "memory")
#define PG8_WAIT_L(n) asm volatile("s_waitcnt lgkmcnt(" #n ")" ::: "memory")
#define PG8_BAR __builtin_amdgcn_s_barrier()
#define PG8_SCHED __builtin_amdgcn_sched_barrier(0)
    Unit cur, nxt; int ui = 0;
    if (!S.next(0, cur)) return;
    f32x4 acc[2][2][4][2];
#pragma unroll
    for (int a = 0; a < 2; ++a)
#pragma unroll
        for (int b = 0; b < 2; ++b)
#pragma unroll
            for (int m = 0; m < 4; ++m)
#pragma unroll
                for (int n = 0; n < 2; ++n) acc[a][b][m][n] = (f32x4){0.f, 0.f, 0.f, 0.f};
    bf16x8 At[4][2], B0[2][2], B1[2][2];
    const char* cA = (const char*)g.A + (size_t)cur.pm * tstep; const char* cB = (const char*)g.Bt + (size_t)cur.pn * tstep;
    S.a_ready(cur);
    if constexpr (SP2) {
        PG8_STAGE(PG8_SB(0, 0), cB, voffB); PG8_STAGE(PG8_SB(0, 1), cB + hstep, voffB); PG8_STAGE(PG8_SA(0, 0), cA, voffA); PG8_STAGE(PG8_SA(0, 1), cA + hstep, voffA);
        if (wr == 1) PG8_BAR;
        PG8_WAIT_V(2); PG8_BAR;
        PG8_STAGE(PG8_SB(1, 0), cB + kstep, voffB); PG8_STAGE(PG8_SA(1, 0), cA + kstep, voffA); PG8_STAGE(PG8_SB(1, 1), cB + hstep + kstep, voffB);
        PG8_WAIT_V(6); PG8_BAR;
    } else {
        PG8_STAGE(PG8_SB(0, 0), cB, voffB); PG8_STAGE(PG8_SA(0, 0), cA, voffA); PG8_STAGE(PG8_SB(0, 1), cB + hstep, voffB); PG8_STAGE(PG8_SA(0, 1), cA + hstep, voffA);
        if (wr == 1) PG8_BAR;
        PG8_WAIT_V(4); PG8_BAR;
        PG8_STAGE(PG8_SB(1, 0), cB + kstep, voffB); PG8_STAGE(PG8_SA(1, 0), cA + kstep, voffA); PG8_STAGE(PG8_SB(1, 1), cB + hstep + kstep, voffB);
        PG8_WAIT_V(6); PG8_BAR;
    }
    for (;;) {
        const bool has_next = S.next(ui + 1, nxt);
        const char* nA = has_next ? (const char*)g.A + (size_t)nxt.pm * tstep : cA; const char* nB = has_next ? (const char*)g.Bt + (size_t)nxt.pn * tstep : cB;
        for (int t = 0; t < nt; t += 2) {
            const bool last = (t == nt - 2);
            const char* a1 = cA + (size_t)(t + 1) * kstep;
            const char* a2 = last ? nA : cA + (size_t)(t + 2) * kstep; const char* b2 = last ? nB : cB + (size_t)(t + 2) * kstep;
            const char* a3 = a2 + kstep; const char* b3 = b2 + kstep;
            if (last && has_next) S.a_ready(nxt);
            if constexpr (SP2) {
            PG8_LDB(B0, 0, 0); PG8_LDB(B1, 0, 1); PG8_SCHED; PG8_LDA(At, 0, 0); PG8_STAGE(PG8_SA(1, 1), a1 + hstep, voffA);
            PG8_WAIT_V(8); PG8_WAIT_L(0); PG8_BAR; PG8_MMA(0, 0, At, B0); PG8_MMA(0, 1, At, B1); PG8_BAR; PG8_SCHED;
            PG8_LDA(At, 0, 1); PG8_STAGE(PG8_SB(0, 0), b2, voffB); PG8_STAGE(PG8_SB(0, 1), b2 + hstep, voffB); PG8_STAGE(PG8_SA(0, 0), a2, voffA);
            PG8_WAIT_V(8); PG8_WAIT_L(0); PG8_BAR; PG8_MMA(1, 0, At, B0); PG8_MMA(1, 1, At, B1); PG8_BAR; PG8_SCHED;
            PG8_LDB(B0, 1, 0); PG8_LDB(B1, 1, 1); PG8_SCHED; PG8_LDA(At, 1, 0); PG8_STAGE(PG8_SA(0, 1), a2 + hstep, voffA);
            PG8_WAIT_V(8); PG8_WAIT_L(0); PG8_BAR; PG8_MMA(0, 0, At, B0); PG8_MMA(0, 1, At, B1); PG8_BAR; PG8_SCHED;
            PG8_LDA(At, 1, 1); PG8_STAGE(PG8_SB(1, 0), b3, voffB); PG8_STAGE(PG8_SB(1, 1), b3 + hstep, voffB); PG8_STAGE(PG8_SA(1, 0), a3, voffA);
            PG8_WAIT_V(8); PG8_WAIT_L(0); PG8_BAR; PG8_MMA(1, 0, At, B0); PG8_MMA(1, 1, At, B1); PG8_BAR; PG8_SCHED;
            } else {
            PG8_LDB(B0, 0, 0); PG8_SCHED; PG8_LDA(At, 0, 0); PG8_STAGE(PG8_SA(1, 1), a1 + hstep, voffA);
            PG8_WAIT_L(8); PG8_BAR; PG8_WAIT_L(0); PG8_MMA(0, 0, At, B0); PG8_BAR; PG8_SCHED;
            PG8_LDB(B1, 0, 1); PG8_STAGE(PG8_SB(0, 0), b2, voffB);
            PG8_BAR; PG8_WAIT_L(0); PG8_MMA(0, 1, At, B1); PG8_BAR;
            PG8_LDA(At, 0, 1); PG8_STAGE(PG8_SA(0, 0), a2, voffA);
            PG8_BAR; PG8_WAIT_L(0); PG8_MMA(1, 0, At, B0); PG8_BAR; PG8_SCHED;
            PG8_STAGE(PG8_SB(0, 1), b2 + hstep, voffB);
            PG8_WAIT_V(6); PG8_BAR; PG8_MMA(1, 1, At, B1); PG8_BAR;
            PG8_LDB(B0, 1, 0); PG8_SCHED; PG8_LDA(At, 1, 0); PG8_STAGE(PG8_SA(0, 1), a2 + hstep, voffA);
            PG8_WAIT_L(8); PG8_BAR; PG8_WAIT_L(0); PG8_MMA(0, 0, At, B0); PG8_BAR; PG8_SCHED;
            PG8_LDB(B1, 1, 1); PG8_STAGE(PG8_SB(1, 0), b3, voffB);
            PG8_BAR; PG8_WAIT_L(0); PG8_MMA(0, 1, At, B1); PG8_BAR;
            PG8_LDA(At, 1, 1); PG8_STAGE(PG8_SA(1, 0), a3, voffA);
            PG8_BAR; PG8_WAIT_L(0); PG8_MMA(1, 0, At, B0); PG8_BAR; PG8_SCHED;
            PG8_STAGE(PG8_SB(1, 1), b3 + hstep, voffB);
            PG8_WAIT_V(6); PG8_BAR; PG8_MMA(1, 1, At, B1); PG8_BAR;
            }
        }
        if constexpr (ALIGN_EPI) { if (wr == 0) PG8_BAR; }
        if constexpr (!Epi::AFTER_DRAIN) { E(acc, cur, wr, wc, fr, fq); S.done(cur); }
        if (!has_next) break;
#pragma unroll
        for (int a = 0; a < 2; ++a)
#pragma unroll
            for (int b = 0; b < 2; ++b)
#pragma unroll
                for (int m = 0; m < 4; ++m)
#pragma unroll
                    for (int n = 0; n < 2; ++n) acc[a][b][m][n] = (f32x4){0.f, 0.f, 0.f, 0.f};
        cur = nxt; cA = nA; cB = nB; ++ui;
        if constexpr (ALIGN_EPI) { if (wr == 1) PG8_BAR; }
    }
    PG8_WAIT_V(0);
    if constexpr (!ALIGN_EPI) { if (wr == 0) PG8_BAR; }
    PG8_BAR;
    if constexpr (Epi::AFTER_DRAIN) { E.fused(acc, cur, wr, wc, fr, fq, lds, wid, lane); S.done(cur); }
#undef PG8_SA
#undef PG8_SB
#undef PG8_STAGE
#undef PG8_LDA
#undef PG8_LDB
#undef PG8_MMA
#undef PG8_WAIT_V
#undef PG8_WAIT_L
#undef PG8_BAR
#undef PG8_SCHED
}
}


#define DI __device__ __forceinline__
typedef unsigned short bf16_t;
typedef short bf16x8 __attribute__((ext_vector_type(8)));
typedef float f32x4 __attribute__((ext_vector_type(4)));
typedef float f32x16 __attribute__((ext_vector_type(16)));
typedef unsigned u32x4 __attribute__((ext_vector_type(4)));
#define MFMA32(a, b, c) __builtin_amdgcn_mfma_f32_32x32x16_bf16((a), (b), (c), 0, 0, 0)
#define LAS __attribute__((address_space(3)))

constexpr int NT = 512;
constexpr int DM = 1024, MP = 16384, MT = 16896;
constexpr int NIN = 10368, NINP = 10496, CSH = 4224;
constexpr float EPS = 1e-6f, LNX_EPS = 64e-5f;
constexpr float QSCALE = 0.18033688011112042f;

constexpr size_t OUT_YP = 0, OUT_KP = 17301504, OUT_VP = 34078720, OUT_SHP = 50855936, OUT_WP = 50872832,
                 OUT_KS = 51134976, OUT_VS = 51659264, OUT_SHS = 52183552, OUT_WS = 52318720;

constexpr size_t SZ_ACT = (size_t)MT * 1024 * 2;
constexpr size_t WS_R1 = 0;
constexpr size_t WS_H = WS_R1, WS_WINT = WS_R1 + SZ_ACT, WS_SW = WS_R1;
constexpr size_t WS_R2 = (size_t)MT * 1024 * 4;
constexpr size_t WS_PB = WS_R2, WS_ORAW = WS_R2, WS_OB = WS_ORAW + (size_t)MT * 1024 * 4, WS_MG = WS_OB + SZ_ACT;
constexpr size_t WS_R3 = WS_R2 + (size_t)MT * CSH * 2;
constexpr size_t WS_QB = WS_R3, WS_VT = WS_QB + SZ_ACT, WS_SZA = WS_VT + (size_t)MP * 1024 * 2;
constexpr size_t WS_SR = WS_SZA + SZ_ACT, WS_SK = WS_SR + SZ_ACT, WS_SV = WS_SK + SZ_ACT, WS_SKK = WS_SV + SZ_ACT, WS_SB = WS_SKK + SZ_ACT;
constexpr size_t WS_SZB = WS_SB + SZ_ACT;
constexpr size_t WS_BONUS = WS_SZB + SZ_ACT;
constexpr size_t WS_WT = WS_BONUS + (size_t)MT * 16 * 4;
constexpr size_t WS_CTL = WS_WT + 3 * (size_t)1024 * 1024 * 2;
constexpr size_t WS_END = WS_CTL + 65536;
static_assert(WS_MG + SZ_ACT <= WS_R3, "R2 overflow");
static_assert(WS_WINT + (size_t)NINP * 1024 * 2 <= WS_R2, "R1 overflow");
static_assert(WS_END <= (size_t)512 * 1024 * 1024, "workspace");

constexpr int SMEM_BYTES = 147456;

struct Params { const float* in[22]; float* out; unsigned char* ws; };

DI float bf2f(bf16_t u) { return __uint_as_float((unsigned)u << 16); }
DI unsigned cvtpk(float lo, float hi) { unsigned r; asm volatile("v_cvt_pk_bf16_f32 %0, %1, %2" : "=v"(r) : "v"(lo), "v"(hi)); return r; }
DI bf16_t f2bf(float x) { return (bf16_t)(cvtpk(x, 0.f) & 0xffffu); }
DI float bflo(unsigned u) { return __uint_as_float(u << 16); }
DI float bfhi(unsigned u) { return __uint_as_float(u & 0xffff0000u); }
DI int crow(int i, int h) { return (i & 3) + 8 * (i >> 2) + 4 * h; }
DI float sigmoidf_(float x) { return 1.f / (1.f + __expf(-x)); }
DI uint4 pack8(f32x4 a, f32x4 b) { return make_uint4(cvtpk(a[0], a[1]), cvtpk(a[2], a[3]), cvtpk(b[0], b[1]), cvtpk(b[2], b[3])); }
DI float wave_sum(float x) {
#pragma unroll
  for (int o = 32; o > 0; o >>= 1) x += __shfl_xor(x, o);
  return x;
}
DI float sum16(float x) { x += __shfl_xor(x, 1); x += __shfl_xor(x, 2); x += __shfl_xor(x, 4); x += __shfl_xor(x, 8); return x; }
template <int CTRL> DI float dppf(float x) { return __builtin_bit_cast(float, __builtin_amdgcn_mov_dpp(__builtin_bit_cast(int, x), CTRL, 0xf, 0xf, true)); }
DI float row32_sum(float x) {
  x += dppf<0xB1>(x);
  x += dppf<0x4E>(x);
  x += dppf<0x124>(x);
  x += dppf<0x128>(x);
  const auto s = __builtin_amdgcn_permlane16_swap(__float_as_uint(x), __float_as_uint(x), false, false);
  return __uint_as_float(s[0]) + __uint_as_float(s[1]);
}
DI size_t hm_base(int row) {
  if (row < MP) { const int b = row >> 12, t = row & 4095; return ((size_t)(b * 16) * 4096 + t) * 64; }
  const int rs = row - MP, b = rs >> 4, t = rs & 15; return (size_t)MP * 1024 + ((size_t)(b * 16) * 16 + t) * 64;
}
DI size_t hm_hstride(int row) { return row < MP ? (size_t)4096 * 64 : (size_t)16 * 64; }

DI void p0_rmsnorm_rows(const Params& p, int item) {
  const int lane = threadIdx.x & 63, wid = threadIdx.x >> 6;
  const int row = item * 8 + wid;
  const float* x = row < MP ? p.in[0] + (size_t)row * DM : p.in[1] + (size_t)(row - MP) * DM;
  const float* g = p.in[6];
  float4 v[4]; float ss = 0.f;
#pragma unroll
  for (int i = 0; i < 4; ++i) { v[i] = *(const float4*)(x + i * 256 + lane * 4); ss += v[i].x * v[i].x + v[i].y * v[i].y + v[i].z * v[i].z + v[i].w * v[i].w; }
  ss = wave_sum(ss);
  const float inv = rsqrtf(ss * (1.f / DM) + EPS);
  bf16_t* H = (bf16_t*)(p.ws + WS_H) + (size_t)row * DM;
#pragma unroll
  for (int i = 0; i < 4; ++i) {
    const float4 gg = *(const float4*)(g + i * 256 + lane * 4);
    uint2 o; o.x = cvtpk(v[i].x * inv * gg.x, v[i].y * inv * gg.y); o.y = cvtpk(v[i].z * inv * gg.z, v[i].w * inv * gg.w);
    *(uint2*)(H + i * 256 + lane * 4) = o;
  }
}
DI void p0_transpose_tile(const float* src, bf16_t* dst, int N, int kt, int nt, float* lds) {
  const int tid = threadIdx.x & 255;
  const int k0 = kt * 64, n0 = nt * 64;
#pragma unroll
  for (int i = 0; i < 4; ++i) {
    const int row = (tid >> 4) + 16 * i, c4 = (tid & 15) * 4;
    const float4 v = *(const float4*)(src + (size_t)(k0 + row) * N + n0 + c4);
    lds[row * 65 + c4 + 0] = v.x; lds[row * 65 + c4 + 1] = v.y; lds[row * 65 + c4 + 2] = v.z; lds[row * 65 + c4 + 3] = v.w;
  }
  __syncthreads();
  const int n = tid >> 2, kc = (tid & 3) * 16;
  unsigned w[8];
#pragma unroll
  for (int j = 0; j < 8; ++j) w[j] = cvtpk(lds[(kc + 2 * j) * 65 + n], lds[(kc + 2 * j + 1) * 65 + n]);
  uint4* d = (uint4*)(dst + (size_t)(n0 + n) * 1024 + k0 + kc);
  d[0] = make_uint4(w[0], w[1], w[2], w[3]); d[1] = make_uint4(w[4], w[5], w[6], w[7]);
  __syncthreads();
}
DI void phase0(const Params& p, char* smem) {
  if (blockIdx.x == 0) { unsigned* ctl = (unsigned*)(p.ws + WS_CTL); for (int i = threadIdx.x; i < 16384; i += NT) ctl[i] = 0u; }
  constexpr int N_ROWS = MT / 8, N_TIN = 16 * 162 / 2, N_TSQ = 256 / 2;
  constexpr int N_ITEMS = N_ROWS + N_TIN + 3 * N_TSQ;
  const int half = threadIdx.x >> 8;
  float* scr = (float*)smem + half * (64 * 65);
  for (int it = blockIdx.x; it < N_ITEMS; it += gridDim.x) {
    if (it < N_ROWS) { p0_rmsnorm_rows(p, it); continue; }
    int j = it - N_ROWS;
    if (j < N_TIN) { const int t = 2 * j + half; p0_transpose_tile(p.in[7], (bf16_t*)(p.ws + WS_WINT), NIN, t / 162, t % 162, scr); continue; }
    j -= N_TIN;
    const int w = j / N_TSQ; const int t = 2 * (j % N_TSQ) + half;
    p0_transpose_tile(p.in[18 + w], (bf16_t*)(p.ws + WS_WT) + (size_t)w * 1024 * 1024, 1024, t >> 4, t & 15, scr);
  }
}

struct EpiP1 {
  static constexpr bool PERM = true, AFTER_DRAIN = false;
  Params p;
  DI void operator()(const pg8::f32x4 (&acc)[2][2][4][2], const pg8::Unit& u, int wr, int wc, int fr, int fq) const {
    const int colt = u.pn * 256;
    const int region = colt >> 10;
#pragma unroll
    for (int ai = 0; ai < 2; ++ai)
#pragma unroll
      for (int m = 0; m < 4; ++m) {
        const int row = u.pm * 256 + ai * 128 + wr * 64 + m * 16 + fr;
        const bool prompt = row < MP;
        const int rs = row - MP;
#pragma unroll
        for (int bj = 0; bj < 2; ++bj) {
          const int col = colt + bj * 128 + wc * 32 + 8 * fq;
          const f32x4 v0 = acc[ai][bj][m][0], v1 = acc[ai][bj][m][1];
          if (region >= 6) {
            const int pc = col - 6144;
            if (pc < CSH) {
              *(uint4*)((bf16_t*)(p.ws + WS_PB) + (size_t)row * CSH + pc) = pack8(v0, v1);
              float* so = nullptr;
              if (prompt) { if ((row & 4095) == 4095) so = p.out + OUT_SHP + (size_t)(row >> 12) * CSH + pc; }
              else if ((rs & 15) == 15) so = p.out + OUT_SHS + (size_t)(rs >> 4) * CSH + pc;
              if (so) { *(f32x4*)so = v0; *(f32x4*)(so + 4) = v1; }
            }
          } else if (region == 0) {
            *(uint4*)((bf16_t*)(p.ws + WS_QB) + (size_t)row * 1024 + col) = pack8(v0 * QSCALE, v1 * QSCALE);
          } else if (region == 1) {
            const int c = col - 1024, hh = c >> 6, d = c & 63;
            float* o = prompt ? p.out + OUT_KP + (((size_t)(row >> 12) * 16 + hh) * 4096 + (row & 4095)) * 64 + d
                              : p.out + OUT_KS + (((size_t)(rs >> 4) * 16 + hh) * 16 + (rs & 15)) * 64 + d;
            *(f32x4*)o = v0; *(f32x4*)(o + 4) = v1;
          } else if (region == 2) {
            const int c = col - 2048, hh = c >> 6, d = c & 63;
            float* o = prompt ? p.out + OUT_VP + (((size_t)(row >> 12) * 16 + hh) * 4096 + (row & 4095)) * 64 + d
                              : p.out + OUT_VS + (((size_t)(rs >> 4) * 16 + hh) * 16 + (rs & 15)) * 64 + d;
            *(f32x4*)o = v0; *(f32x4*)(o + 4) = v1;
            if (prompt) {
              bf16_t* vt = (bf16_t*)(p.ws + WS_VT) + (((size_t)(row >> 12) * 16 + hh) * 64 + d) * 4096 + (row & 4095);
              const uint4 w = pack8(v0, v1);
              vt[0] = (bf16_t)(w.x & 0xffff); vt[4096] = (bf16_t)(w.x >> 16); vt[2 * 4096] = (bf16_t)(w.y & 0xffff); vt[3 * 4096] = (bf16_t)(w.y >> 16);
              vt[4 * 4096] = (bf16_t)(w.z & 0xffff); vt[5 * 4096] = (bf16_t)(w.z >> 16); vt[6 * 4096] = (bf16_t)(w.w & 0xffff); vt[7 * 4096] = (bf16_t)(w.w >> 16);
            }
          } else if (region == 3) {
            f32x4 a, b;
#pragma unroll
            for (int j = 0; j < 4; ++j) { a[j] = v0[j] * sigmoidf_(v0[j]); b[j] = v1[j] * sigmoidf_(v1[j]); }
            *(uint4*)((bf16_t*)(p.ws + WS_SZA) + (size_t)row * 1024 + (col - 3072)) = pack8(a, b);
          } else {
            f32x4 a, b;
#pragma unroll
            for (int j = 0; j < 4; ++j) { a[j] = sigmoidf_(v0[j]); b[j] = sigmoidf_(v1[j]); }
            *(uint4*)((bf16_t*)p.out + (size_t)row * 2048 + (col - 4096)) = pack8(a, b);
          }
        }
      }
  }
};
struct EpiGate {
  static constexpr bool PERM = true, AFTER_DRAIN = false;
  Params p; int goff; bool first;
  DI void operator()(const pg8::f32x4 (&acc)[2][2][4][2], const pg8::Unit& u, int wr, int wc, int fr, int fq) const {
    const bf16_t* G = (const bf16_t*)p.out; bf16_t* MG = (bf16_t*)(p.ws + WS_MG);
#pragma unroll
    for (int ai = 0; ai < 2; ++ai)
#pragma unroll
      for (int m = 0; m < 4; ++m) {
        const size_t row = u.pm * 256 + ai * 128 + wr * 64 + m * 16 + fr;
#pragma unroll
        for (int bj = 0; bj < 2; ++bj) {
          const int col = u.pn * 256 + bj * 128 + wc * 32 + 8 * fq;
          const uint4 g = *(const uint4*)(G + row * 2048 + goff + col);
          f32x4 a = acc[ai][bj][m][0], b = acc[ai][bj][m][1];
          a[0] *= bflo(g.x); a[1] *= bfhi(g.x); a[2] *= bflo(g.y); a[3] *= bfhi(g.y);
          b[0] *= bflo(g.z); b[1] *= bfhi(g.z); b[2] *= bflo(g.w); b[3] *= bfhi(g.w);
          if (!first) {
            const uint4 o = *(const uint4*)(MG + row * 1024 + col);
            a[0] += bflo(o.x); a[1] += bfhi(o.x); a[2] += bflo(o.y); a[3] += bfhi(o.y);
            b[0] += bflo(o.z); b[1] += bfhi(o.z); b[2] += bflo(o.w); b[3] += bfhi(o.w);
          }
          *(uint4*)(MG + row * 1024 + col) = pack8(a, b);
        }
      }
  }
};
struct EpiOut {
  static constexpr bool PERM = true, AFTER_DRAIN = false;
  Params p;
  DI void operator()(const pg8::f32x4 (&acc)[2][2][4][2], const pg8::Unit& u, int wr, int wc, int fr, int fq) const {
#pragma unroll
    for (int ai = 0; ai < 2; ++ai)
#pragma unroll
      for (int m = 0; m < 4; ++m) {
        const int row = u.pm * 256 + ai * 128 + wr * 64 + m * 16 + fr;
        const float* xr = row < MP ? p.in[0] + (size_t)row * 1024 : p.in[1] + (size_t)(row - MP) * 1024;
        float* orow = p.out + OUT_YP + (size_t)row * 1024;
#pragma unroll
        for (int bj = 0; bj < 2; ++bj) {
          const int col = u.pn * 256 + bj * 128 + wc * 32 + 8 * fq;
          const f32x4 x0 = *(const f32x4*)(xr + col), x1 = *(const f32x4*)(xr + col + 4);
          *(f32x4*)(orow + col) = x0 + acc[ai][bj][m][0]; *(f32x4*)(orow + col + 4) = x1 + acc[ai][bj][m][1];
        }
      }
  }
};
template <class Epi>
DI void run_gemm(char* smem, const bf16_t* A, const bf16_t* Bt, int N, const Epi& E) {
  pg8::Gemm g; g.A = A; g.Bt = Bt; g.M = MT; g.N = N; g.K = 1024;
  pg8::StaticOrder S; S.init(MT, N, (int)gridDim.x, (int)blockIdx.x);
  pg8::gemm_phase<Epi, pg8::StaticOrder, true, true>((LAS unsigned char*)smem, g, S, E);
  __syncthreads();
}

DI void prep_tile(const Params& p, int tile, float* lds) {
  const int tid = threadIdx.x & 255;
  const int row0 = tile * 8;
  const bool prompt = row0 < MP;
  const int t0 = prompt ? (row0 & 4095) : ((row0 - MP) & 15);
  const int sb = prompt ? 0 : ((row0 - MP) >> 4);
  const bf16_t* PB = (const bf16_t*)(p.ws + WS_PB);
  const float* mu = p.in[8];
  const float* sshift = p.in[4] + (size_t)sb * CSH;
#pragma unroll
  for (int i = 0; i < 4; ++i) {
    const int v = tid + 256 * i, tok = v >> 7, j = v & 127, col = 3072 + j;
    const float cur = bf2f(PB[(size_t)(row0 + tok) * CSH + col]);
    float prev;
    if (t0 + tok == 0) prev = prompt ? 0.f : sshift[col];
    else prev = bf2f(PB[(size_t)(row0 + tok - 1) * CSH + col]);
    const float m = cur + mu[col] * (prev - cur);
    if (j < 64) lds[tok * 64 + j] = 1.f - 2.f / (1.f + __expf(2.f * m)); else lds[(8 + tok) * 64 + (j - 64)] = m;
  }
  __syncthreads();
  const int c = tid * 4, hh = c >> 6;
  float aw[8][4], aa[8][4];
#pragma unroll
  for (int t = 0; t < 8; ++t)
#pragma unroll
    for (int x = 0; x < 4; ++x) { aw[t][x] = 0.f; aa[t][x] = 0.f; }
  const float* w2 = p.in[10]; const float* a2 = p.in[12];
  for (int r = 0; r < 64; r += 4) {
    float4 wr[4], ar[4];
#pragma unroll
    for (int q = 0; q < 4; ++q) { wr[q] = *(const float4*)(w2 + (size_t)(r + q) * 1024 + c); ar[q] = *(const float4*)(a2 + (size_t)(r + q) * 1024 + c); }
#pragma unroll
    for (int t = 0; t < 8; ++t) {
      const float4 lw = *(const float4*)(lds + t * 64 + r);
      const float4 la = *(const float4*)(lds + (8 + t) * 64 + r);
      aw[t][0] += lw.x * wr[0].x + lw.y * wr[1].x + lw.z * wr[2].x + lw.w * wr[3].x;
      aw[t][1] += lw.x * wr[0].y + lw.y * wr[1].y + lw.z * wr[2].y + lw.w * wr[3].y;
      aw[t][2] += lw.x * wr[0].z + lw.y * wr[1].z + lw.z * wr[2].z + lw.w * wr[3].z;
      aw[t][3] += lw.x * wr[0].w + lw.y * wr[1].w + lw.z * wr[2].w + lw.w * wr[3].w;
      aa[t][0] += la.x * ar[0].x + la.y * ar[1].x + la.z * ar[2].x + la.w * ar[3].x;
      aa[t][1] += la.x * ar[0].y + la.y * ar[1].y + la.z * ar[2].y + la.w * ar[3].y;
      aa[t][2] += la.x * ar[0].z + la.y * ar[1].z + la.z * ar[2].z + la.w * ar[3].z;
      aa[t][3] += la.x * ar[0].w + la.y * ar[1].w + la.z * ar[2].w + la.w * ar[3].w;
    }
  }
  const float4 w0 = *(const float4*)(p.in[9] + c), a0 = *(const float4*)(p.in[11] + c);
  const float4 kkw = *(const float4*)(p.in[13] + c), kaw = *(const float4*)(p.in[14] + c), rkw = *(const float4*)(p.in[15] + c);
  const float4 mur = *(const float4*)(mu + c), muk = *(const float4*)(mu + 1024 + c), muv = *(const float4*)(mu + 2048 + c), muz = *(const float4*)(mu + 3200 + c);
  const float w0a[4] = {w0.x, w0.y, w0.z, w0.w}, a0a[4] = {a0.x, a0.y, a0.z, a0.w};
  const float kka[4] = {kkw.x, kkw.y, kkw.z, kkw.w}, kaa[4] = {kaw.x, kaw.y, kaw.z, kaw.w}, rka[4] = {rkw.x, rkw.y, rkw.z, rkw.w};
  const float mura[4] = {mur.x, mur.y, mur.z, mur.w}, muka[4] = {muk.x, muk.y, muk.z, muk.w}, muva[4] = {muv.x, muv.y, muv.z, muv.w}, muza[4] = {muz.x, muz.y, muz.z, muz.w};
  float* SW = (float*)(p.ws + WS_SW);
  bf16_t* SR = (bf16_t*)(p.ws + WS_SR); bf16_t* SK = (bf16_t*)(p.ws + WS_SK); bf16_t* SV = (bf16_t*)(p.ws + WS_SV);
  bf16_t* SKK = (bf16_t*)(p.ws + WS_SKK); bf16_t* SB = (bf16_t*)(p.ws + WS_SB); bf16_t* SZB = (bf16_t*)(p.ws + WS_SZB);
  float* BONUS = (float*)(p.ws + WS_BONUS);
#pragma unroll
  for (int t = 0; t < 8; ++t) {
    const int row = row0 + t;
    const bf16_t* pc = PB + (size_t)row * CSH;
    const uint2 cr = *(const uint2*)(pc + c), ck = *(const uint2*)(pc + 1024 + c), cv = *(const uint2*)(pc + 2048 + c), cz = *(const uint2*)(pc + 3200 + c);
    float curr[4] = {bflo(cr.x), bfhi(cr.x), bflo(cr.y), bfhi(cr.y)}, curk[4] = {bflo(ck.x), bfhi(ck.x), bflo(ck.y), bfhi(ck.y)};
    float curv[4] = {bflo(cv.x), bfhi(cv.x), bflo(cv.y), bfhi(cv.y)}, curz[4] = {bflo(cz.x), bfhi(cz.x), bflo(cz.y), bfhi(cz.y)};
    float pr[4], pk[4], pv[4], pz[4];
    if (t0 + t == 0) {
      if (prompt) {
#pragma unroll
        for (int x = 0; x < 4; ++x) { pr[x] = 0.f; pk[x] = 0.f; pv[x] = 0.f; pz[x] = 0.f; }
      } else {
        const float4 a = *(const float4*)(sshift + c), b = *(const float4*)(sshift + 1024 + c), d = *(const float4*)(sshift + 2048 + c), e = *(const float4*)(sshift + 3200 + c);
        pr[0] = a.x; pr[1] = a.y; pr[2] = a.z; pr[3] = a.w; pk[0] = b.x; pk[1] = b.y; pk[2] = b.z; pk[3] = b.w;
        pv[0] = d.x; pv[1] = d.y; pv[2] = d.z; pv[3] = d.w; pz[0] = e.x; pz[1] = e.y; pz[2] = e.z; pz[3] = e.w;
      }
    } else {
      const bf16_t* pp = pc - CSH;
      const uint2 qr = *(const uint2*)(pp + c), qk = *(const uint2*)(pp + 1024 + c), qv = *(const uint2*)(pp + 2048 + c), qz = *(const uint2*)(pp + 3200 + c);
      pr[0] = bflo(qr.x); pr[1] = bfhi(qr.x); pr[2] = bflo(qr.y); pr[3] = bfhi(qr.y);
      pk[0] = bflo(qk.x); pk[1] = bfhi(qk.x); pk[2] = bflo(qk.y); pk[3] = bfhi(qk.y);
      pv[0] = bflo(qv.x); pv[1] = bfhi(qv.x); pv[2] = bflo(qv.y); pv[3] = bfhi(qv.y);
      pz[0] = bflo(qz.x); pz[1] = bfhi(qz.x); pz[2] = bflo(qz.y); pz[3] = bfhi(qz.y);
    }
    float rm[4], km[4], vm[4], dec[4], kkv[4], bb[4], kmod[4], szb[4];
    float ssq = 0.f, bon = 0.f;
#pragma unroll
    for (int x = 0; x < 4; ++x) {
      rm[x] = curr[x] + mura[x] * (pr[x] - curr[x]);
      km[x] = curk[x] + muka[x] * (pk[x] - curk[x]);
      vm[x] = curv[x] + muva[x] * (pv[x] - curv[x]);
      const float zm = curz[x] + muza[x] * (pz[x] - curz[x]);
      szb[x] = zm * sigmoidf_(zm);
      const float u = -(w0a[x] + aw[t][x]);
      const float sp = fmaxf(u, 0.f) + __logf(1.f + __expf(-fabsf(u)));
      const float wraw = -sp - 0.5f;
      dec[x] = __expf(-__expf(wraw));
      const float a = sigmoidf_(a0a[x] + aa[t][x]);
      kkv[x] = km[x] * kka[x];
      ssq += kkv[x] * kkv[x];
      kmod[x] = km[x] * (1.f + (a - 1.f) * kaa[x]);
      bb[x] = a;
      bon += rm[x] * kmod[x] * rka[x];
    }
    ssq = sum16(ssq); bon = sum16(bon);
    const float inv = 1.f / fmaxf(sqrtf(ssq), 1e-12f);
#pragma unroll
    for (int x = 0; x < 4; ++x) { kkv[x] *= inv; bb[x] *= kkv[x]; }
    const size_t idx = hm_base(row) + hh * hm_hstride(row) + (c & 63);
    *(float4*)(SW + idx) = make_float4(dec[0], dec[1], dec[2], dec[3]);
    *(uint2*)(SR + idx) = make_uint2(cvtpk(rm[0], rm[1]), cvtpk(rm[2], rm[3]));
    *(uint2*)(SK + idx) = make_uint2(cvtpk(kmod[0], kmod[1]), cvtpk(kmod[2], kmod[3]));
    *(uint2*)(SV + idx) = make_uint2(cvtpk(vm[0], vm[1]), cvtpk(vm[2], vm[3]));
    *(uint2*)(SKK + idx) = make_uint2(cvtpk(-kkv[0], -kkv[1]), cvtpk(-kkv[2], -kkv[3]));
    *(uint2*)(SB + idx) = make_uint2(cvtpk(bb[0], bb[1]), cvtpk(bb[2], bb[3]));
    *(uint2*)(SZB + (size_t)row * 1024 + c) = make_uint2(cvtpk(szb[0], szb[1]), cvtpk(szb[2], szb[3]));
    if ((tid & 15) == 0) BONUS[(size_t)row * 16 + hh] = bon;
  }
  __syncthreads();
}
DI void phase1b(const Params& p, char* smem) {
  const int half = threadIdx.x >> 8;
  for (int t = blockIdx.x; t < MT / 16; t += gridDim.x) prep_tile(p, 2 * t + half, (float*)smem + half * 1024);
}

template <bool SAMPLE>
DI void attn_wave(const Params& p, int sh, int qt) {
  const int lane = threadIdx.x & 63, r = lane & 31, h = lane >> 5;
  const int hh = sh & 15, b = sh >> 4;
  bf16_t* QB = (bf16_t*)(p.ws + WS_QB);
  const int row0 = SAMPLE ? MP + b * 16 : b * 4096 + qt * 32;
  bf16_t* Qp = QB + (size_t)row0 * 1024 + hh * 64;
  const int qrow = SAMPLE ? (r < 15 ? r : 15) : r;
  bf16x8 qf[4];
#pragma unroll
  for (int s = 0; s < 4; ++s) qf[s] = *(const bf16x8*)(Qp + (size_t)qrow * 1024 + 16 * s + 8 * h);
  f32x16 z0, z1;
#pragma unroll
  for (int i = 0; i < 16; ++i) { z0[i] = 0.f; z1[i] = 0.f; }
  float carry = 1.f;
  const int ntiles = SAMPLE ? 33 : qt + 1;
  const bf16_t* VT = (const bf16_t*)(p.ws + WS_VT);
  for (int it = 0; it < ntiles; ++it) {
    const bool diag = (it == 0);
    const int kt = SAMPLE ? 32 - it : qt - it;
    bf16x8 kf[4];
    {
      const float* Kp;
      if (!SAMPLE) Kp = p.out + OUT_KP + ((size_t)sh * 4096 + kt * 32 + r) * 64;
      else Kp = diag ? p.out + OUT_KS + ((size_t)sh * 16 + (r < 15 ? r : 15)) * 64 : p.in[2] + ((size_t)sh * 1024 + kt * 32 + r) * 64;
#pragma unroll
      for (int s = 0; s < 4; ++s) {
        const float4 a = *(const float4*)(Kp + 16 * s + 8 * h), bq = *(const float4*)(Kp + 16 * s + 8 * h + 4);
        u32x4 w; w[0] = cvtpk(a.x, a.y); w[1] = cvtpk(a.z, a.w); w[2] = cvtpk(bq.x, bq.y); w[3] = cvtpk(bq.z, bq.w);
        kf[s] = __builtin_bit_cast(bf16x8, w);
      }
    }
    f32x16 st;
#pragma unroll
    for (int i = 0; i < 16; ++i) st[i] = 0.f;
#pragma unroll
    for (int s = 0; s < 4; ++s) st = MFMA32(kf[s], qf[s], st);
    float keep[16], wgt[16];
#pragma unroll
    for (int i = 0; i < 16; ++i) {
      const float e = __builtin_amdgcn_exp2f(st[i]);
      const float kp = __builtin_amdgcn_rcpf(1.f + e);
      bool valid = true;
      if (diag) { const int kr = crow(i, h); valid = SAMPLE ? (kr < r && kr < 16) : (kr < r); }
      keep[i] = valid ? kp : 1.f;
      wgt[i] = valid ? 1.f - kp : 0.f;
    }
    float pp[4], hif[4];
#pragma unroll
    for (int g = 0; g < 4; ++g) {
      const float p4 = (keep[4 * g] * keep[4 * g + 1]) * (keep[4 * g + 2] * keep[4 * g + 3]);
      const auto sw = __builtin_amdgcn_permlane32_swap(__float_as_uint(p4), __float_as_uint(p4), false, false);
      const float lo = __uint_as_float(sw[0]), hi = __uint_as_float(sw[1]);
      pp[g] = lo * hi;
      hif[g] = h ? 1.f : hi;
    }
    float T[4];
    T[3] = carry; T[2] = T[3] * pp[3]; T[1] = T[2] * pp[2]; T[0] = T[1] * pp[1];
    carry = T[0] * pp[0];
#pragma unroll
    for (int g = 0; g < 4; ++g) {
      const float w3 = T[g] * hif[g], w2 = w3 * keep[4 * g + 3], w1 = w2 * keep[4 * g + 2], w0 = w1 * keep[4 * g + 1];
      wgt[4 * g + 3] *= w3; wgt[4 * g + 2] *= w2; wgt[4 * g + 1] *= w1; wgt[4 * g] *= w0;
    }
#pragma unroll
    for (int s = 0; s < 2; ++s) {
      u32x4 pw;
#pragma unroll
      for (int j = 0; j < 4; ++j) pw[j] = cvtpk(wgt[8 * s + 2 * j], wgt[8 * s + 2 * j + 1]);
      const bf16x8 pf = __builtin_bit_cast(bf16x8, pw);
#pragma unroll
      for (int db = 0; db < 2; ++db) {
        bf16x8 vf;
        if (!SAMPLE) {
          const bf16_t* vp = VT + ((size_t)sh * 64 + db * 32 + r) * 4096 + kt * 32 + 16 * s + 4 * h;
          const uint2 lo = *(const uint2*)vp, hi = *(const uint2*)(vp + 8);
          u32x4 w; w[0] = lo.x; w[1] = lo.y; w[2] = hi.x; w[3] = hi.y;
          vf = __builtin_bit_cast(bf16x8, w);
        } else {
          float vv[8];
#pragma unroll
          for (int j = 0; j < 8; ++j) {
            const int kr = 16 * s + 8 * (j >> 2) + 4 * h + (j & 3);
            const float* vp = diag ? p.out + OUT_VS + ((size_t)sh * 16 + (kr < 15 ? kr : 15)) * 64 : p.in[3] + ((size_t)sh * 1024 + kt * 32 + kr) * 64;
            vv[j] = vp[db * 32 + r];
          }
          u32x4 w; w[0] = cvtpk(vv[0], vv[1]); w[1] = cvtpk(vv[2], vv[3]); w[2] = cvtpk(vv[4], vv[5]); w[3] = cvtpk(vv[6], vv[7]);
          vf = __builtin_bit_cast(bf16x8, w);
        }
        if (db == 0) z0 = MFMA32(pf, vf, z0); else z1 = MFMA32(pf, vf, z1);
      }
    }
    if (__ballot(carry != 0.f) == 0ull) break;
  }
  const bf16_t* SZA = (const bf16_t*)(p.ws + WS_SZA);
#pragma unroll
  for (int i = 0; i < 16; ++i) {
    const int q = crow(i, h);
    if (SAMPLE && q >= 16) continue;
    const size_t o = (size_t)(row0 + q) * 1024 + hh * 64 + r;
    QB[o] = f2bf(z0[i] * bf2f(SZA[o]));
    QB[o + 32] = f2bf(z1[i] * bf2f(SZA[o + 32]));
  }
}

DI float row16_sum(float x) {
  x += dppf<0xB1>(x); x += dppf<0x4E>(x); x += dppf<0x124>(x); x += dppf<0x128>(x);
  return x;
}
DI void scan_wave(const Params& p, int shg, int slice, float* L) {
  const int lane = threadIdx.x & 63, cc = lane & 15;
  const bool prompt = shg < 64;
  const int T = prompt ? 4096 : 16;
  const size_t base = prompt ? (size_t)shg * 4096 * 64 : (size_t)MP * 1024 + (size_t)(shg - 64) * 16 * 64;
  const int v = slice * 4 + (lane >> 4);
  const float* SW = (const float*)(p.ws + WS_SW) + base;
  const bf16_t* SARR = (const bf16_t*)(p.ws + WS_SR) + base;
  float* ORAW = (float*)(p.ws + WS_ORAW) + base;
  float4 S;
  float* wout;
  if (prompt) { S = make_float4(0.f, 0.f, 0.f, 0.f); wout = p.out + OUT_WP + ((size_t)shg * 64 + v) * 64 + 4 * cc; }
  else { S = *(const float4*)(p.in[5] + ((size_t)(shg - 64) * 64 + v) * 64 + 4 * cc); wout = p.out + OUT_WS + ((size_t)(shg - 64) * 64 + v) * 64 + 4 * cc; }
  const int nch = T / 8;
  const int dw0 = ((lane >> 4) * 6 + 2) * 64 + (lane & 15) * 4, dw1 = dw0 + 4 * 384;
  const int db = (lane >> 3) * 384 + (lane & 7) * 8;
  uint4 gw0, gw1, gr, gk, gv, gn, gb;
#define SCAN_GLOAD(ch) do { const float* w_ = SW + (size_t)(ch) * 512; gw0 = *(const uint4*)(w_ + lane * 4); gw1 = *(const uint4*)(w_ + 256 + lane * 4); \
    const bf16_t* a_ = SARR + (size_t)(ch) * 512 + lane * 8; gr = *(const uint4*)a_; gk = *(const uint4*)(a_ + SZ_ACT / 2); gv = *(const uint4*)(a_ + 2 * (SZ_ACT / 2)); \
    gn = *(const uint4*)(a_ + 3 * (SZ_ACT / 2)); gb = *(const uint4*)(a_ + 4 * (SZ_ACT / 2)); } while (0)
#define SCAN_PUT(slot, g) do { float* d_ = L + db + (slot) * 64; *(float4*)d_ = make_float4(bflo(g.x), bfhi(g.x), bflo(g.y), bfhi(g.y)); *(float4*)(d_ + 4) = make_float4(bflo(g.z), bfhi(g.z), bflo(g.w), bfhi(g.w)); } while (0)
#define SCAN_LSTORE() do { *(uint4*)(L + dw0) = gw0; *(uint4*)(L + dw1) = gw1; SCAN_PUT(4, gr); SCAN_PUT(3, gk); SCAN_PUT(5, gv); SCAN_PUT(0, gn); SCAN_PUT(1, gb); \
    asm volatile("s_waitcnt lgkmcnt(0)" ::: "memory"); } while (0)
  SCAN_GLOAD(0);
  asm volatile("s_waitcnt lgkmcnt(0)" ::: "memory");
  SCAN_LSTORE();
  for (int ch = 0; ch < nch; ++ch) {
    if (ch + 1 < nch) SCAN_GLOAD(ch + 1);
    float okeep = 0.f;
    const float* Lc = L + 4 * cc;
    float4 nk = *(const float4*)(Lc), bb = *(const float4*)(Lc + 64), ww = *(const float4*)(Lc + 128), kv = *(const float4*)(Lc + 192), rr = *(const float4*)(Lc + 256);
    float vt = L[320 + v];
#pragma unroll 4
    for (int st = 0; st < 8; ++st) {
      const int sn = ((st + 1) & 7) * 384;
      const float4 nk2 = *(const float4*)(Lc + sn), bb2 = *(const float4*)(Lc + sn + 64), ww2 = *(const float4*)(Lc + sn + 128);
      const float4 kv2 = *(const float4*)(Lc + sn + 192), rr2 = *(const float4*)(Lc + sn + 256);
      const float vt2 = L[sn + 320 + v];
      float d = (S.x * nk.x + S.y * nk.y) + (S.z * nk.z + S.w * nk.w);
      const float sa = row16_sum(d);
      S.x = S.x * ww.x + (sa * bb.x + vt * kv.x);
      S.y = S.y * ww.y + (sa * bb.y + vt * kv.y);
      S.z = S.z * ww.z + (sa * bb.z + vt * kv.z);
      S.w = S.w * ww.w + (sa * bb.w + vt * kv.w);
      float o = (S.x * rr.x + S.y * rr.y) + (S.z * rr.z + S.w * rr.w);
      o = row16_sum(o);
      okeep = (cc == st) ? o : okeep;
      nk = nk2; bb = bb2; ww = ww2; kv = kv2; rr = rr2; vt = vt2;
    }
    if (cc < 8) ORAW[(size_t)(ch * 8 + cc) * 64 + v] = okeep;
    asm volatile("s_waitcnt lgkmcnt(0)" ::: "memory");
    if (ch + 1 < nch) SCAN_LSTORE();
  }
  *(float4*)wout = S;
#undef SCAN_GLOAD
#undef SCAN_PUT
#undef SCAN_LSTORE
}

DI void sgroup_barrier(volatile LAS unsigned* cnt, unsigned target) {
  asm volatile("s_waitcnt lgkmcnt(0)" ::: "memory");
  if ((threadIdx.x & 63) == 0) __hip_atomic_fetch_add((LAS unsigned*)cnt, 1u, __ATOMIC_RELAXED, __HIP_MEMORY_SCOPE_WORKGROUP);
  while (*cnt < target) __builtin_amdgcn_s_sleep(1);
  asm volatile("" ::: "memory");
}
DI void scan_group(const Params& p, int sh, int quarter, float* lds, volatile LAS unsigned* cnt, unsigned& nbar) {
  const int tid = threadIdx.x & 255, lane = tid & 63, wid = tid >> 6, cc = lane & 15;
  const size_t base = (size_t)sh * 4096 * 64;
  const int v = quarter * 16 + wid * 4 + (lane >> 4);
  const float* SW = (const float*)(p.ws + WS_SW) + base;
  const bf16_t* SARR = (const bf16_t*)(p.ws + WS_SR) + base;
  float* ORAW = (float*)(p.ws + WS_ORAW) + base;
  float4 S = make_float4(0.f, 0.f, 0.f, 0.f);
  float4 gw; uint4 gb0, gb1, gb2;
  const int dstw = ((tid >> 4) * 6 + 2) * 64 + (tid & 15) * 4;
  const bf16_t* sb0; const bf16_t* sb1; const bf16_t* sb2; int db0, db1, db2;
  { const int idx = tid, arr = idx >> 7, c = idx & 127, slot = arr == 0 ? 4 : 3; sb0 = SARR + (size_t)arr * (SZ_ACT / 2) + c * 8; db0 = ((c >> 3) * 6 + slot) * 64 + (c & 7) * 8; }
  { const int idx = tid + 256, arr = idx >> 7, c = idx & 127, slot = arr == 2 ? 5 : 0; sb1 = SARR + (size_t)arr * (SZ_ACT / 2) + c * 8; db1 = ((c >> 3) * 6 + slot) * 64 + (c & 7) * 8; }
  { const int idx = (tid & 127) + 512, arr = 4, c = idx & 127; sb2 = SARR + (size_t)arr * (SZ_ACT / 2) + c * 8; db2 = ((c >> 3) * 6 + 1) * 64 + (c & 7) * 8; }
#define SG_GLOAD(ch) do { gw = *(const float4*)(SW + (size_t)(ch) * 1024 + tid * 4); gb0 = *(const uint4*)(sb0 + (size_t)(ch) * 1024); gb1 = *(const uint4*)(sb1 + (size_t)(ch) * 1024); \
    if (tid < 128) gb2 = *(const uint4*)(sb2 + (size_t)(ch) * 1024); } while (0)
#define SG_PUT(d_, g) do { *(float4*)(d_) = make_float4(bflo(g.x), bfhi(g.x), bflo(g.y), bfhi(g.y)); *(float4*)((d_) + 4) = make_float4(bflo(g.z), bfhi(g.z), bflo(g.w), bfhi(g.w)); } while (0)
#define SG_LSTORE(buf) do { float* L_ = lds + (buf) * (16 * 384); *(float4*)(L_ + dstw) = gw; SG_PUT(L_ + db0, gb0); SG_PUT(L_ + db1, gb1); if (tid < 128) SG_PUT(L_ + db2, gb2); } while (0)
  SG_GLOAD(0); SG_LSTORE(0); sgroup_barrier(cnt, 4u * (++nbar));
  for (int ch = 0; ch < 256; ++ch) {
    if (ch + 1 < 256) SG_GLOAD(ch + 1);
    const float* L = lds + (ch & 1) * (16 * 384);
    float okeep = 0.f;
    const float* Lc = L + 4 * cc;
    float4 nk = *(const float4*)(Lc), bb = *(const float4*)(Lc + 64), ww = *(const float4*)(Lc + 128), kv = *(const float4*)(Lc + 192), rr = *(const float4*)(Lc + 256);
    float vt = L[320 + v];
#pragma unroll 4
    for (int st = 0; st < 16; ++st) {
      const int sn = ((st + 1) & 15) * 384;
      const float4 nk2 = *(const float4*)(Lc + sn), bb2 = *(const float4*)(Lc + sn + 64), ww2 = *(const float4*)(Lc + sn + 128);
      const float4 kv2 = *(const float4*)(Lc + sn + 192), rr2 = *(const float4*)(Lc + sn + 256);
      const float vt2 = L[sn + 320 + v];
      float d = (S.x * nk.x + S.y * nk.y) + (S.z * nk.z + S.w * nk.w);
      const float sa = row16_sum(d);
      S.x = S.x * ww.x + (sa * bb.x + vt * kv.x);
      S.y = S.y * ww.y + (sa * bb.y + vt * kv.y);
      S.z = S.z * ww.z + (sa * bb.z + vt * kv.z);
      S.w = S.w * ww.w + (sa * bb.w + vt * kv.w);
      float o = (S.x * rr.x + S.y * rr.y) + (S.z * rr.z + S.w * rr.w);
      o = row16_sum(o);
      okeep = (cc == st) ? o : okeep;
      nk = nk2; bb = bb2; ww = ww2; kv = kv2; rr = rr2; vt = vt2;
    }
    ORAW[(size_t)(ch * 16 + cc) * 64 + v] = okeep;
    if (ch + 1 < 256) SG_LSTORE((ch + 1) & 1);
    sgroup_barrier(cnt, 4u * (++nbar));
  }
  *(float4*)(p.out + OUT_WP + ((size_t)sh * 64 + v) * 64 + 4 * cc) = S;
#undef SG_GLOAD
#undef SG_PUT
#undef SG_LSTORE
}

constexpr int NQ_ATT_P = 8192, NQ_ATT_S = 512, NQ_SCAN_S = 8192, NQ_DYN = NQ_ATT_P + NQ_ATT_S + NQ_SCAN_S;
DI int wave_grab(unsigned* ctr) { int v = 0; if ((threadIdx.x & 63) == 0) v = (int)atomicAdd(ctr, 1u); return __builtin_amdgcn_readfirstlane(v); }
DI void phase2(const Params& p, char* smem) {
  __shared__ unsigned s_cnt;
  unsigned* ctl = (unsigned*)(p.ws + WS_CTL);
  const int wid = threadIdx.x >> 6;
  if (threadIdx.x == 0) s_cnt = 0u;
  __syncthreads();
  float* L = (float*)smem + wid * (8 * 384);
  if (wid < 4) {
    unsigned nbar = 0;
    for (int bu = blockIdx.x; bu < 256; bu += gridDim.x) scan_group(p, bu >> 2, bu & 3, (float*)smem + 8 * 8 * 384, (volatile LAS unsigned*)&s_cnt, nbar);
  }
  for (;;) {
    int u = wave_grab(&ctl[0]);
    if (u >= NQ_DYN) break;
    if (u < NQ_ATT_P) { attn_wave<false>(p, u >> 7, u & 127); continue; }
    u -= NQ_ATT_P;
    if (u < NQ_ATT_S) { attn_wave<true>(p, u, 0); continue; }
    u -= NQ_ATT_S;
    scan_wave(p, 64 + (u >> 4), u & 15, L);
  }
}

DI void phase2c(const Params& p) {
  const int tid = threadIdx.x & 255, half = threadIdx.x >> 8, c = tid * 4, hh = c >> 6;
  const float4 lg = *(const float4*)(p.in[16] + c), lb = *(const float4*)(p.in[17] + c);
  const float* ORAW = (const float*)(p.ws + WS_ORAW); const bf16_t* SV = (const bf16_t*)(p.ws + WS_SV);
  const bf16_t* SZB = (const bf16_t*)(p.ws + WS_SZB); const float* BONUS = (const float*)(p.ws + WS_BONUS);
  bf16_t* OB = (bf16_t*)(p.ws + WS_OB);
  for (int row = blockIdx.x * 2 + half; row < MT; row += gridDim.x * 2) {
    const size_t idx = hm_base(row) + hh * hm_hstride(row) + (c & 63);
    const float4 o = *(const float4*)(ORAW + idx);
    const float mean = sum16((o.x + o.y) + (o.z + o.w)) * (1.f / 64.f);
    const float dx = o.x - mean, dy = o.y - mean, dz = o.z - mean, dw = o.w - mean;
    const float var = sum16((dx * dx + dy * dy) + (dz * dz + dw * dw)) * (1.f / 64.f);
    const float inv = rsqrtf(var + LNX_EPS);
    const float bon = BONUS[(size_t)row * 16 + hh];
    const uint2 vv = *(const uint2*)(SV + idx), zz = *(const uint2*)(SZB + (size_t)row * 1024 + c);
    const float r0 = (dx * inv * lg.x + lb.x + bon * bflo(vv.x)) * bflo(zz.x);
    const float r1 = (dy * inv * lg.y + lb.y + bon * bfhi(vv.x)) * bfhi(zz.x);
    const float r2 = (dz * inv * lg.z + lb.z + bon * bflo(vv.y)) * bflo(zz.y);
    const float r3 = (dw * inv * lg.w + lb.w + bon * bfhi(vv.y)) * bfhi(zz.y);
    *(uint2*)(OB + (size_t)row * 1024 + c) = make_uint2(cvtpk(r0, r1), cvtpk(r2, r3));
  }
}

DI void phase4(const Params& p) {
  const int lane = threadIdx.x & 63, wid = threadIdx.x >> 6;
  const float* g = p.in[21];
  for (int row = blockIdx.x * 8 + wid; row < MT; row += gridDim.x * 8) {
    float* x = p.out + OUT_YP + (size_t)row * 1024;
    float4 v[4]; float ss = 0.f;
#pragma unroll
    for (int i = 0; i < 4; ++i) { v[i] = *(const float4*)(x + i * 256 + lane * 4); ss += v[i].x * v[i].x + v[i].y * v[i].y + v[i].z * v[i].z + v[i].w * v[i].w; }
    ss = wave_sum(ss);
    const float inv = rsqrtf(ss * (1.f / DM) + EPS);
#pragma unroll
    for (int i = 0; i < 4; ++i) {
      const float4 gg = *(const float4*)(g + i * 256 + lane * 4);
      *(float4*)(x + i * 256 + lane * 4) = make_float4(v[i].x * inv * gg.x, v[i].y * inv * gg.y, v[i].z * inv * gg.z, v[i].w * inv * gg.w);
    }
  }
}

#define XB_TMO      128
#define XB_XCNT(j)  (256  + 64 * (j))
#define XB_XSUB(j)  (1280 + 64 * (j))
#define XB_XGEN(j)  (2304 + 64 * (j))
#define XB_TOP      3328
#define XB_TOPGEN   3392
#define XCD_BAR_WORDS 3456
#define XB_SPIN_CAP (1u << 18)

__device__ __forceinline__ unsigned xb_ld(unsigned* p)              { return __hip_atomic_load(p, __ATOMIC_RELAXED, __HIP_MEMORY_SCOPE_AGENT); }
__device__ __forceinline__ unsigned xb_add(unsigned* p, unsigned v) { return __hip_atomic_fetch_add(p, v, __ATOMIC_RELAXED, __HIP_MEMORY_SCOPE_AGENT); }
__device__ __forceinline__ unsigned xb_xcc_id() { return (unsigned)__builtin_amdgcn_s_getreg((3 << 11) | 20) & 0xFu; }
#define XB_SPIN(cond, bar) do { unsigned _sp = 0; while (cond) { __builtin_amdgcn_s_sleep(1); \
    if ((++_sp & 255u) == 0u) { if (xb_ld(&(bar)[XB_TMO])) break; if (_sp > XB_SPIN_CAP) { atomicAdd(&(bar)[XB_TMO], 1u); break; } } } } while (0)

struct XcdBarrier {
    unsigned* bar; unsigned x;
    volatile LAS unsigned* st;
};

__device__ __forceinline__ XcdBarrier xcd_barrier_post(unsigned* bar, volatile LAS unsigned* st) {
    XcdBarrier b; b.bar = bar; b.x = xb_xcc_id(); b.st = st;
    if (threadIdx.x == 0) (void)xb_add(&bar[XB_XCNT(b.x)], 1u);
    return b;
}
__device__ __forceinline__ void xcd_barrier_complete(unsigned* bar, unsigned x, unsigned& nloc, unsigned& nx) {
    const unsigned G = gridDim.x * gridDim.y * gridDim.z;
    unsigned sum, cnt, mine, sp = 0u;
    for (;;) {
        sum = 0u; cnt = 0u; mine = 0u;
#pragma unroll
        for (unsigned j = 0; j < 16; ++j) { const unsigned c = xb_ld(&bar[XB_XCNT(j)]); sum += c; cnt += (c > 0u) ? 1u : 0u; mine = (j == x) ? c : mine; }
        if (sum == G) break;
        __builtin_amdgcn_s_sleep(1);
        if ((++sp & 255u) == 0u) { if (xb_ld(&bar[XB_TMO])) break; if (sp > XB_SPIN_CAP) { atomicAdd(&bar[XB_TMO], 1u); break; } }
    }
    nloc = mine > 0u ? mine : 1u; nx = cnt > 0u ? cnt : 1u;
}

__device__ __forceinline__ void xcd_barrier(const XcdBarrier& b) {
    asm volatile("s_waitcnt vmcnt(0)" ::: "memory");
    __syncthreads();
    if (threadIdx.x == 0) {
        unsigned* bar = b.bar;
        __builtin_amdgcn_s_waitcnt(0);
        unsigned nloc = b.st[0], nx = b.st[1];
        if (nloc == 0u) { xcd_barrier_complete(bar, b.x, nloc, nx); b.st[0] = nloc; b.st[1] = nx; }
        const unsigned old = xb_add(&bar[XB_XSUB(b.x)], 1u);
        const unsigned gen = old / nloc;
        if (old + 1u == (gen + 1u) * nloc) {
            __builtin_amdgcn_fence(__ATOMIC_RELEASE, "agent");
            asm volatile("s_waitcnt vmcnt(0)" ::: "memory");
            const unsigned og = xb_add(&bar[XB_TOP], 1u);
            const unsigned tg = og / nx;
            if (og + 1u == (tg + 1u) * nx) xb_add(&bar[XB_TOPGEN], 1u);
            else XB_SPIN(xb_ld(&bar[XB_TOPGEN]) == tg, bar);
            __builtin_amdgcn_fence(__ATOMIC_ACQUIRE, "agent");
            xb_add(&bar[XB_XGEN(b.x)], 1u);
            asm volatile("s_waitcnt vmcnt(0)" ::: "memory");
        } else {
            XB_SPIN(xb_ld(&bar[XB_XGEN(b.x)]) == gen, bar);
            __builtin_amdgcn_fence(__ATOMIC_ACQUIRE, "agent");
            asm volatile("s_waitcnt vmcnt(0)" ::: "memory");
        }
    }
    __syncthreads();
}

__global__ void __launch_bounds__(NT, 2) mega(Params p) {
  extern __shared__ __attribute__((aligned(16))) char smem[];
  cg::grid_group grid = cg::this_grid();
  phase0(p, smem);
  grid.sync();
  __shared__ unsigned xb_st[2];
  if (threadIdx.x == 0) { xb_st[0] = 0u; xb_st[1] = 0u; }
  __syncthreads();
  (void)xcd_barrier_post((unsigned*)(p.ws + WS_CTL) + 8192, (volatile LAS unsigned*)xb_st);
#define XBAR() do { XcdBarrier xb_; xb_.bar = (unsigned*)(p.ws + WS_CTL) + 8192; xb_.x = xb_xcc_id(); xb_.st = (volatile LAS unsigned*)xb_st; xcd_barrier(xb_); } while (0)
  { EpiP1 E; E.p = p; run_gemm(smem, (const bf16_t*)(p.ws + WS_H), (const bf16_t*)(p.ws + WS_WINT), NINP, E); }
  XBAR();
  phase1b(p, smem);
  XBAR();
  phase2(p, smem);
  XBAR();
  phase2c(p);
  XBAR();
  { EpiGate E; E.p = p; E.goff = 0; E.first = true; run_gemm(smem, (const bf16_t*)(p.ws + WS_QB), (const bf16_t*)(p.ws + WS_WT), 1024, E); }
  { EpiGate E; E.p = p; E.goff = 1024; E.first = false; run_gemm(smem, (const bf16_t*)(p.ws + WS_OB), (const bf16_t*)(p.ws + WS_WT) + (size_t)1024 * 1024, 1024, E); }
  XBAR();
  { EpiOut E; E.p = p; run_gemm(smem, (const bf16_t*)(p.ws + WS_MG), (const bf16_t*)(p.ws + WS_WT) + (size_t)2 * 1024 * 1024, 1024, E); }
  XBAR();
  phase4(p);
}

extern "C" void kernel_launch(void* const* d_in, const int* in_sizes, int n_in, void* d_out, int out_size, void* d_ws, size_t ws_size, hipStream_t stream) {
  static int grid_blocks = 0;
  if (grid_blocks == 0) {
    if (n_in != 22 || ws_size < WS_END) { fprintf(stderr, "kernel_launch: unexpected n_in %d / ws_size %zu (need %zu)\n", n_in, ws_size, (size_t)WS_END); grid_blocks = -1; return; }
    int dev = 0, cus = 0, per_cu = 0;
    (void)hipGetDevice(&dev);
    (void)hipDeviceGetAttribute(&cus, hipDeviceAttributeMultiprocessorCount, dev);
    (void)hipFuncSetAttribute((const void*)mega, hipFuncAttributeMaxDynamicSharedMemorySize, SMEM_BYTES);
    (void)hipOccupancyMaxActiveBlocksPerMultiprocessor(&per_cu, (const void*)mega, NT, SMEM_BYTES);
    (void)hipGetLastError();
    grid_blocks = cus;
  }
  if (grid_blocks < 0) return;
  Params p{};
  for (int i = 0; i < 22; ++i) p.in[i] = (const float*)d_in[i];
  p.out = (float*)d_out; p.ws = (unsigned char*)d_ws;
  void* args[] = {&p};
  hipError_t e = hipLaunchCooperativeKernel((const void*)mega, dim3(grid_blocks), dim3(NT), args, SMEM_BYTES, stream);
  if (e != hipSuccess) fprintf(stderr, "cooperative launch failed: %s (grid %d)\n", hipGetErrorString(e), grid_blocks);
}
```

```cpp
#include <hip/hip_runtime.h>
#include <hip/hip_cooperative_groups.h>
#include <cstdio>
#include <cstdint>
namespace cg = cooperative_groups;
__device__ __forceinline__ int lane_id_() { return (int)__builtin_amdgcn_mbcnt_hi(~0u, __builtin_amdgcn_mbcnt_lo(~0u, 0u)); }
#define TIDX (__builtin_amdgcn_readfirstlane((int)(threadIdx.x >> 6)) * 64 + lane_id_())

namespace pg8 {
#define PG8_LAS __attribute__((address_space(3)))
typedef unsigned short bf16_t;
typedef short bf16x8 __attribute__((ext_vector_type(8)));
typedef float f32x4 __attribute__((ext_vector_type(4)));
typedef unsigned u32x4 __attribute__((ext_vector_type(4)));
constexpr int BM = 256, BK = 64, HALF = 128, HTB = HALF * BK * 2  , STAGE_BYTES = 8 * HTB, NXCD = 8, WGM = 8;

__host__ __device__ __forceinline__ int lds_byte(int r, int c) { const int st = (r >> 4) * 2 + (c >> 5), rr = r & 15, cc = c & 31, ob = rr * 64 + cc * 2; return st * 1024 + (ob ^ (((ob >> 9) & 1) << 5)); }
__host__ __device__ __forceinline__ void stage_rc(int b, int& R, int& C) { const int st = b / 1024, sb = b % 1024, swz = sb ^ (((sb >> 9) & 1) << 5); R = (st >> 1) * 16 + swz / 64; C = (st & 1) * 32 + (swz % 64) / 2; }
__host__ __device__ __forceinline__ int perm32(int rho) { const int n = rho >> 4, i = rho & 15; return 8 * (i >> 2) + 4 * n + (i & 3); }

struct Unit { int pm, pn; };
struct Gemm { const bf16_t* A; const bf16_t* Bt; int M, N, K; };

struct StaticOrder {
    int nM, nN, nwg, G, c;
    __host__ __device__ void init(int M, int N, int G_, int c_) { nM = M / BM; nN = N / BM; nwg = nM * nN; G = G_; c = c_; }
    __host__ __device__ bool next(int i, Unit& u) const {
        const long L = (long)i * G + c; if (L >= nwg) return false;
        int wgid = (int)L; { const int q = nwg / NXCD, r = nwg % NXCD, xcd = wgid % NXCD, off = wgid / NXCD; wgid = (xcd < r ? xcd * (q + 1) : r * (q + 1) + (xcd - r) * q) + off; }
        const int nig = WGM * nN, gid = wgid / nig, fm = gid * WGM, gsz = (nM - fm) < WGM ? (nM - fm) : WGM;
        u.pm = fm + ((wgid % nig) % gsz); u.pn = (wgid % nig) / gsz; return true;
    }
    __device__ __forceinline__ void a_ready(const Unit&) const {}
    __device__ __forceinline__ void done(const Unit&) const {}
};


template <class Epi, class Sched, bool ALIGN_EPI = false, bool SP2 = false>
__device__ __forceinline__ void gemm_phase(PG8_LAS unsigned char* lds, const Gemm g, const Sched& S, const Epi& E) {
    int tid_ = TIDX; asm volatile("" : "+v"(tid_));
    const int tid = tid_, wid = __builtin_amdgcn_readfirstlane(tid >> 6), lane = tid & 63, wr = wid >> 2, wc = wid & 3, fr = lane & 15, fq = lane >> 4;
    const int K = g.K, nt = K / BK;
    unsigned voffA[2], voffB[2];
#pragma unroll
    for (int i = 0; i < 2; ++i) { int R, C; stage_rc(tid * 16 + i * 8192, R, C); const int Rb = Epi::PERM ? ((R & ~31) + perm32(R & 31)) : R;
        voffA[i] = (unsigned)(R * K + C) * 2u; voffB[i] = (unsigned)(Rb * K + C) * 2u; }
    const size_t kstep = (size_t)(BK * 2);
    const size_t hstep = (size_t)HALF * K * 2;
    const size_t tstep = 2 * hstep;
    const unsigned ldsw = (unsigned)wid * 1024u;
    const int aoff = lds_byte(wr * 64 + fr, fq * 8), boff = lds_byte(wc * 32 + fr, fq * 8);
#define PG8_SA(b, h) (((b) * 2 + (h)) * HTB)
#define PG8_SB(b, h) ((4 + (b) * 2 + (h)) * HTB)
#define PG8_STAGE(bufoff, gbase, voff) do { _Pragma("unroll") for (int _i = 0; _i < 2; ++_i) \
        __builtin_amdgcn_global_load_lds((const unsigned*)((const char*)(gbase) + (voff)[_i]), (PG8_LAS unsigned*)(lds + (bufoff) + ldsw + _i * 8192), 16, 0, 0); } while (0)
#define PG8_LDA(dst, b, h) do { _Pragma("unroll") for (int m = 0; m < 4; ++m) _Pragma("unroll") for (int k = 0; k < 2; ++k) dst[m][k] = *(const PG8_LAS bf16x8*)(lds + PG8_SA(b, h) + aoff + m * 2048 + k * 1024); } while (0)
#define PG8_LDB(dst, b, h) do { _Pragma("unroll") for (int n = 0; n < 2; ++n) _Pragma("unroll") for (int k = 0; k < 2; ++k) dst[n][k] = *(const PG8_LAS bf16x8*)(lds + PG8_SB(b, h) + boff + n * 2048 + k * 1024); } while (0)
#define PG8_MMA(ai, bj, At, Bt) do { __builtin_amdgcn_s_setprio(1); _Pragma("unroll") for (int m = 0; m < 4; ++m) _Pragma("unroll") for (int n = 0; n < 2; ++n) _Pragma("unroll") for (int k = 0; k < 2; ++k) \
        acc[ai][bj][m][n] = __builtin_amdgcn_mfma_f32_16x16x32_bf16(Bt[n][k], At[m][k], acc[ai][bj][m][n], 0, 0, 0); __builtin_amdgcn_s_setprio(0); } while (0)
#define PG8_WAIT_V(n) asm volatile("s_waitcnt vmcnt(" #n ")" ::: "memory")
#define PG8_WAIT_L(n) asm volatile("s_waitcnt lgkmcnt(" #n ")" ::: "memory")
#define PG8_BAR __builtin_amdgcn_s_barrier()
#define PG8_SCHED __builtin_amdgcn_sched_barrier(0)
    Unit cur, nxt; int ui = 0;
    if (!S.next(0, cur)) return;
    f32x4 acc[2][2][4][2];
#pragma unroll
    for (int a = 0; a < 2; ++a)
#pragma unroll
        for (int b = 0; b < 2; ++b)
#pragma unroll
            for (int m = 0; m < 4; ++m)
#pragma unroll
                for (int n = 0; n < 2; ++n) acc[a][b][m][n] = (f32x4){0.f, 0.f, 0.f, 0.f};
    bf16x8 At[4][2], B0[2][2], B1[2][2];
    const char* cA = (const char*)g.A + (size_t)cur.pm * tstep; const char* cB = (const char*)g.Bt + (size_t)cur.pn * tstep;
    S.a_ready(cur);
    if constexpr (SP2) {
        PG8_STAGE(PG8_SB(0, 0), cB, voffB); PG8_STAGE(PG8_SB(0, 1), cB + hstep, voffB); PG8_STAGE(PG8_SA(0, 0), cA, voffA); PG8_STAGE(PG8_SA(0, 1), cA + hstep, voffA);
        if (wr == 1) PG8_BAR;
        PG8_WAIT_V(2); PG8_BAR;
        PG8_STAGE(PG8_SB(1, 0), cB + kstep, voffB); PG8_STAGE(PG8_SA(1, 0), cA + kstep, voffA); PG8_STAGE(PG8_SB(1, 1), cB + hstep + kstep, voffB);
        PG8_WAIT_V(6); PG8_BAR;
    } else {
        PG8_STAGE(PG8_SB(0, 0), cB, voffB); PG8_STAGE(PG8_SA(0, 0), cA, voffA); PG8_STAGE(PG8_SB(0, 1), cB + hstep, voffB); PG8_STAGE(PG8_SA(0, 1), cA + hstep, voffA);
        if (wr == 1) PG8_BAR;
        PG8_WAIT_V(4); PG8_BAR;
        PG8_STAGE(PG8_SB(1, 0), cB + kstep, voffB); PG8_STAGE(PG8_SA(1, 0), cA + kstep, voffA); PG8_STAGE(PG8_SB(1, 1), cB + hstep + kstep, voffB);
        PG8_WAIT_V(6); PG8_BAR;
    }
    for (;;) {
        const bool has_next = S.next(ui + 1, nxt);
        const char* nA = has_next ? (const char*)g.A + (size_t)nxt.pm * tstep : cA; const char* nB = has_next ? (const char*)g.Bt + (size_t)nxt.pn * tstep : cB;
        for (int t = 0; t < nt; t += 2) {
            const bool last = (t == nt - 2);
            const char* a1 = cA + (size_t)(t + 1) * kstep;
            const char* a2 = last ? nA : cA + (size_t)(t + 2) * kstep; const char* b2 = last ? nB : cB + (size_t)(t + 2) * kstep;
            const char* a3 = a2 + kstep; const char* b3 = b2 + kstep;
            if (last && has_next) S.a_ready(nxt);
            if constexpr (SP2) {
            PG8_LDB(B0, 0, 0); PG8_LDB(B1, 0, 1); PG8_SCHED; PG8_LDA(At, 0, 0); PG8_STAGE(PG8_SA(1, 1), a1 + hstep, voffA);
            PG8_WAIT_V(8); PG8_WAIT_L(0); PG8_BAR; PG8_MMA(0, 0, At, B0); PG8_MMA(0, 1, At, B1); PG8_BAR; PG8_SCHED;
            PG8_LDA(At, 0, 1); PG8_STAGE(PG8_SB(0, 0), b2, voffB); PG8_STAGE(PG8_SB(0, 1), b2 + hstep, voffB); PG8_STAGE(PG8_SA(0, 0), a2, voffA);
            PG8_WAIT_V(8); PG8_WAIT_L(0); PG8_BAR; PG8_MMA(1, 0, At, B0); PG8_MMA(1, 1, At, B1); PG8_BAR; PG8_SCHED;
            PG8_LDB(B0, 1, 0); PG8_LDB(B1, 1, 1); PG8_SCHED; PG8_LDA(At, 1, 0); PG8_STAGE(PG8_SA(0, 1), a2 + hstep, voffA);
            PG8_WAIT_V(8); PG8_WAIT_L(0); PG8_BAR; PG8_MMA(0, 0, At, B0); PG8_MMA(0, 1, At, B1); PG8_BAR; PG8_SCHED;
            PG8_LDA(At, 1, 1); PG8_STAGE(PG8_SB(1, 0), b3, voffB); PG8_STAGE(PG8_SB(1, 1), b3 + hstep, voffB); PG8_STAGE(PG8_SA(1, 0), a3, voffA);
            PG8_WAIT_V(8); PG8_WAIT_L(0); PG8_BAR; PG8_MMA(1, 0, At, B0); PG8_MMA(1, 1, At, B1); PG8_BAR; PG8_SCHED;
            } else {
            PG8_LDB(B0, 0, 0); PG8_SCHED; PG8_LDA(At, 0, 0); PG8_STAGE(PG8_SA(1, 1), a1 + hstep, voffA);
            PG8_WAIT_L(8); PG8_BAR; PG8_WAIT_L(0); PG8_MMA(0, 0, At, B0); PG8_BAR; PG8_SCHED;
            PG8_LDB(B1, 0, 1); PG8_STAGE(PG8_SB(0, 0), b2, voffB);
            PG8_BAR; PG8_WAIT_L(0); PG8_MMA(0, 1, At, B1); PG8_BAR;
            PG8_LDA(At, 0, 1); PG8_STAGE(PG8_SA(0, 0), a2, voffA);
            PG8_BAR; PG8_WAIT_L(0); PG8_MMA(1, 0, At, B0); PG8_BAR; PG8_SCHED;
            PG8_STAGE(PG8_SB(0, 1), b2 + hstep, voffB);
            PG8_WAIT_V(6); PG8_BAR; PG8_MMA(1, 1, At, B1); PG8_BAR;
            PG8_LDB(B0, 1, 0); PG8_SCHED; PG8_LDA(At, 1, 0); PG8_STAGE(PG8_SA(0, 1), a2 + hstep, voffA);
            PG8_WAIT_L(8); PG8_BAR; PG8_WAIT_L(0); PG8_MMA(0, 0, At, B0); PG8_BAR; PG8_SCHED;
            PG8_LDB(B1, 1, 1); PG8_STAGE(PG8_SB(1, 0), b3, voffB);
            PG8_BAR; PG8_WAIT_L(0); PG8_MMA(0, 1, At, B1); PG8_BAR;
            PG8_LDA(At, 1, 1); PG8_STAGE(PG8_SA(1, 0), a3, voffA);
            PG8_BAR; PG8_WAIT_L(0); PG8_MMA(1, 0, At, B0); PG8_BAR; PG8_SCHED;
            PG8_STAGE(PG8_SB(1, 1), b3 + hstep, voffB);
            PG8_WAIT_V(6); PG8_BAR; PG8_MMA(1, 1, At, B1); PG8_BAR;
            }
        }
        if constexpr (ALIGN_EPI) { if (wr == 0) PG8_BAR; }
        if constexpr (!Epi::AFTER_DRAIN) { E(acc, cur, wr, wc, fr, fq); S.done(cur); }
        if (!has_next) break;
#pragma unroll
        for (int a = 0; a < 2; ++a)
#pragma unroll
            for (int b = 0; b < 2; ++b)
#pragma unroll
                for (int m = 0; m < 4; ++m)
#pragma unroll
                    for (int n = 0; n < 2; ++n) acc[a][b][m][n] = (f32x4){0.f, 0.f, 0.f, 0.f};
        cur = nxt; cA = nA; cB = nB; ++ui;
        if constexpr (ALIGN_EPI) { if (wr == 1) PG8_BAR; }
    }
    PG8_WAIT_V(0);
    if constexpr (!ALIGN_EPI) { if (wr == 0) PG8_BAR; }
    PG8_BAR;
    if constexpr (Epi::AFTER_DRAIN) { E.fused(acc, cur, wr, wc, fr, fq, lds, wid, lane); S.done(cur); }
#undef PG8_SA
#undef PG8_SB
#undef PG8_STAGE
#undef PG8_LDA
#undef PG8_LDB
#undef PG8_MMA
#undef PG8_WAIT_V
#undef PG8_WAIT_L
#undef PG8_BAR
#undef PG8_SCHED
}
}


#define DI __device__ __forceinline__
typedef unsigned short bf16_t;
typedef short bf16x8 __attribute__((ext_vector_type(8)));
typedef float f32x4 __attribute__((ext_vector_type(4)));
typedef float f32x16 __attribute__((ext_vector_type(16)));
typedef unsigned u32x4 __attribute__((ext_vector_type(4)));
#define MFMA32(a, b, c) __builtin_amdgcn_mfma_f32_32x32x16_bf16((a), (b), (c), 0, 0, 0)
#define LAS __attribute__((address_space(3)))

constexpr int NT = 512;
constexpr int DM = 1024, MP = 16384, MT = 16896;
constexpr int NIN = 10368, NINP = 10496, CSH = 4224;
constexpr float EPS = 1e-6f, LNX_EPS = 64e-5f;
constexpr float QSCALE = 0.18033688011112042f;

constexpr size_t OUT_YP = 0, OUT_KP = 17301504, OUT_VP = 34078720, OUT_SHP = 50855936, OUT_WP = 50872832,
                 OUT_KS = 51134976, OUT_VS = 51659264, OUT_SHS = 52183552, OUT_WS = 52318720;

constexpr size_t SZ_ACT = (size_t)MT * 1024 * 2;
constexpr size_t WS_R1 = 0;
constexpr size_t WS_H = WS_R1, WS_WINT = WS_R1 + SZ_ACT, WS_SW = WS_R1;
constexpr size_t WS_R2 = (size_t)MT * 1024 * 4;
constexpr size_t WS_PB = WS_R2, WS_ORAW = WS_R2, WS_OB = WS_ORAW + (size_t)MT * 1024 * 4, WS_MG = WS_OB + SZ_ACT;
constexpr size_t WS_R3 = WS_R2 + (size_t)MT * CSH * 2;
constexpr size_t WS_QB = WS_R3, WS_X = WS_QB + SZ_ACT  , WS_BTL = WS_X + (size_t)MT * 256 * 2  , WS_SZA = WS_X + (size_t)MP * 1024 * 2;
static_assert(WS_BTL + (size_t)2048 * 256 * 2 <= WS_SZA, "LoRA buffers");
constexpr size_t WS_SR = WS_SZA + SZ_ACT, WS_SK = WS_SR + SZ_ACT, WS_SV = WS_SK + SZ_ACT, WS_SKK = WS_SV + SZ_ACT, WS_SB = WS_SKK + SZ_ACT;
constexpr size_t WS_SZB = WS_SB + SZ_ACT;
constexpr size_t WS_BONUS = WS_SZB + SZ_ACT;
constexpr size_t WS_WT = WS_BONUS + (size_t)MT * 16 * 4;
constexpr size_t WS_CTL = WS_WT + 3 * (size_t)1024 * 1024 * 2;
constexpr size_t WS_END = WS_CTL + 65536;
static_assert(WS_MG + SZ_ACT <= WS_R3, "R2 overflow");
static_assert(WS_WINT + (size_t)NINP * 1024 * 2 <= WS_R2, "R1 overflow");
static_assert(WS_END <= (size_t)512 * 1024 * 1024, "workspace");

constexpr int SMEM_BYTES = 147456;

struct Params { const float* in[22]; float* out; unsigned char* ws; };

DI float bf2f(bf16_t u) { return __uint_as_float((unsigned)u << 16); }
DI unsigned cvtpk(float lo, float hi) { unsigned r; asm volatile("v_cvt_pk_bf16_f32 %0, %1, %2" : "=v"(r) : "v"(lo), "v"(hi)); return r; }
DI bf16_t f2bf(float x) { return (bf16_t)(cvtpk(x, 0.f) & 0xffffu); }
DI float bflo(unsigned u) { return __uint_as_float(u << 16); }
DI float bfhi(unsigned u) { return __uint_as_float(u & 0xffff0000u); }
DI int crow(int i, int h) { return (i & 3) + 8 * (i >> 2) + 4 * h; }
DI float sigmoidf_(float x) { return 1.f / (1.f + __expf(-x)); }
DI uint4 pack8(f32x4 a, f32x4 b) { return make_uint4(cvtpk(a[0], a[1]), cvtpk(a[2], a[3]), cvtpk(b[0], b[1]), cvtpk(b[2], b[3])); }
DI float wave_sum(float x) {
#pragma unroll
  for (int o = 32; o > 0; o >>= 1) x += __shfl_xor(x, o);
  return x;
}
DI float sum16(float x) { x += __shfl_xor(x, 1); x += __shfl_xor(x, 2); x += __shfl_xor(x, 4); x += __shfl_xor(x, 8); return x; }
template <int CTRL> DI float dppf(float x) { return __builtin_bit_cast(float, __builtin_amdgcn_mov_dpp(__builtin_bit_cast(int, x), CTRL, 0xf, 0xf, true)); }
DI float row32_sum(float x) {
  x += dppf<0xB1>(x);
  x += dppf<0x4E>(x);
  x += dppf<0x124>(x);
  x += dppf<0x128>(x);
  const auto s = __builtin_amdgcn_permlane16_swap(__float_as_uint(x), __float_as_uint(x), false, false);
  return __uint_as_float(s[0]) + __uint_as_float(s[1]);
}
DI size_t hm_base(int row) {
  if (row < MP) { const int b = row >> 12, t = row & 4095; return ((size_t)(b * 16) * 4096 + t) * 64; }
  const int rs = row - MP, b = rs >> 4, t = rs & 15; return (size_t)MP * 1024 + ((size_t)(b * 16) * 16 + t) * 64;
}
DI size_t hm_hstride(int row) { return row < MP ? (size_t)4096 * 64 : (size_t)16 * 64; }

DI void p0_rmsnorm_rows(const Params& p, int item) {
  const int lane = TIDX & 63, wid = TIDX >> 6;
  const int row = item * 8 + wid;
  const float* x = row < MP ? p.in[0] + (size_t)row * DM : p.in[1] + (size_t)(row - MP) * DM;
  const float* g = p.in[6];
  float4 v[4]; float ss = 0.f;
#pragma unroll
  for (int i = 0; i < 4; ++i) { v[i] = *(const float4*)(x + i * 256 + lane * 4); ss += v[i].x * v[i].x + v[i].y * v[i].y + v[i].z * v[i].z + v[i].w * v[i].w; }
  ss = wave_sum(ss);
  const float inv = rsqrtf(ss * (1.f / DM) + EPS);
  bf16_t* H = (bf16_t*)(p.ws + WS_H) + (size_t)row * DM;
#pragma unroll
  for (int i = 0; i < 4; ++i) {
    const float4 gg = *(const float4*)(g + i * 256 + lane * 4);
    uint2 o; o.x = cvtpk(v[i].x * inv * gg.x, v[i].y * inv * gg.y); o.y = cvtpk(v[i].z * inv * gg.z, v[i].w * inv * gg.w);
    *(uint2*)(H + i * 256 + lane * 4) = o;
  }
}
DI void p0_transpose_tile(const float* src, bf16_t* dst, int N, int kt, int nt, float* lds) {
  const int tid = TIDX & 255;
  const int k0 = kt * 64, n0 = nt * 64;
#pragma unroll
  for (int i = 0; i < 4; ++i) {
    const int row = (tid >> 4) + 16 * i, c4 = (tid & 15) * 4;
    const float4 v = *(const float4*)(src + (size_t)(k0 + row) * N + n0 + c4);
    lds[row * 65 + c4 + 0] = v.x; lds[row * 65 + c4 + 1] = v.y; lds[row * 65 + c4 + 2] = v.z; lds[row * 65 + c4 + 3] = v.w;
  }
  __syncthreads();
  const int n = tid >> 2, kc = (tid & 3) * 16;
  unsigned w[8];
#pragma unroll
  for (int j = 0; j < 8; ++j) w[j] = cvtpk(lds[(kc + 2 * j) * 65 + n], lds[(kc + 2 * j + 1) * 65 + n]);
  uint4* d = (uint4*)(dst + (size_t)(n0 + n) * 1024 + k0 + kc);
  d[0] = make_uint4(w[0], w[1], w[2], w[3]); d[1] = make_uint4(w[4], w[5], w[6], w[7]);
  __syncthreads();
}
DI void phase0(const Params& p, char* smem) {
  if (blockIdx.x == 0) { unsigned* ctl = (unsigned*)(p.ws + WS_CTL); for (int i = TIDX; i < 16384; i += NT) ctl[i] = 0u; }
  {
    bf16_t* BL = (bf16_t*)(p.ws + WS_BTL);
    for (int i = blockIdx.x * NT + TIDX; i < 2048 * 256; i += gridDim.x * NT) {
      const int n = i >> 8, k = i & 255;
      float v = 0.f;
      if (n < 1024) { if (k < 64) v = p.in[10][(size_t)k * 1024 + n]; }
      else if (k >= 64 && k < 128) v = p.in[12][(size_t)(k - 64) * 1024 + (n - 1024)];
      BL[i] = f2bf(v);
    }
  }
  constexpr int N_ROWS = MT / 8, N_TIN = 16 * 162 / 2, N_TSQ = 256 / 2;
  constexpr int N_ITEMS = N_ROWS + N_TIN + 3 * N_TSQ;
  const int half = TIDX >> 8;
  float* scr = (float*)smem + half * (64 * 65);
  for (int it = blockIdx.x; it < N_ITEMS; it += gridDim.x) {
    if (it < N_ROWS) { p0_rmsnorm_rows(p, it); continue; }
    int j = it - N_ROWS;
    if (j < N_TIN) { const int t = 2 * j + half; p0_transpose_tile(p.in[7], (bf16_t*)(p.ws + WS_WINT), NIN, t / 162, t % 162, scr); continue; }
    j -= N_TIN;
    const int w = j / N_TSQ; const int t = 2 * (j % N_TSQ) + half;
    p0_transpose_tile(p.in[18 + w], (bf16_t*)(p.ws + WS_WT) + (size_t)w * 1024 * 1024, 1024, t >> 4, t & 15, scr);
  }
}

struct EpiP1 {
  static constexpr bool PERM = true, AFTER_DRAIN = false;
  Params p;
  DI void operator()(const pg8::f32x4 (&acc)[2][2][4][2], const pg8::Unit& u, int wr, int wc, int fr, int fq) const {
    const int colt = u.pn * 256;
    const int region = colt >> 10;
#pragma unroll
    for (int ai = 0; ai < 2; ++ai)
#pragma unroll
      for (int m = 0; m < 4; ++m) {
        const int row = u.pm * 256 + ai * 128 + wr * 64 + m * 16 + fr;
        const bool prompt = row < MP;
        const int rs = row - MP;
#pragma unroll
        for (int bj = 0; bj < 2; ++bj) {
          const int col = colt + bj * 128 + wc * 32 + 8 * fq;
          const f32x4 v0 = acc[ai][bj][m][0], v1 = acc[ai][bj][m][1];
          if (region >= 6) {
            const int pc = col - 6144;
            if (pc < CSH) {
              *(uint4*)((bf16_t*)(p.ws + WS_PB) + (size_t)row * CSH + pc) = pack8(v0, v1);
              float* so = nullptr;
              if (prompt) { if ((row & 4095) == 4095) so = p.out + OUT_SHP + (size_t)(row >> 12) * CSH + pc; }
              else if ((rs & 15) == 15) so = p.out + OUT_SHS + (size_t)(rs >> 4) * CSH + pc;
              if (so) { *(f32x4*)so = v0; *(f32x4*)(so + 4) = v1; }
            }
          } else if (region == 0) {
            *(uint4*)((bf16_t*)(p.ws + WS_QB) + (size_t)row * 1024 + col) = pack8(v0 * QSCALE, v1 * QSCALE);
          } else if (region == 1) {
            const int c = col - 1024, hh = c >> 6, d = c & 63;
            float* o = prompt ? p.out + OUT_KP + (((size_t)(row >> 12) * 16 + hh) * 4096 + (row & 4095)) * 64 + d
                              : p.out + OUT_KS + (((size_t)(rs >> 4) * 16 + hh) * 16 + (rs & 15)) * 64 + d;
            *(f32x4*)o = v0; *(f32x4*)(o + 4) = v1;
          } else if (region == 2) {
            const int c = col - 2048, hh = c >> 6, d = c & 63;
            float* o = prompt ? p.out + OUT_VP + (((size_t)(row >> 12) * 16 + hh) * 4096 + (row & 4095)) * 64 + d
                              : p.out + OUT_VS + (((size_t)(rs >> 4) * 16 + hh) * 16 + (rs & 15)) * 64 + d;
            *(f32x4*)o = v0; *(f32x4*)(o + 4) = v1;
          } else if (region == 3) {
            f32x4 a, b;
#pragma unroll
            for (int j = 0; j < 4; ++j) { a[j] = v0[j] * sigmoidf_(v0[j]); b[j] = v1[j] * sigmoidf_(v1[j]); }
            *(uint4*)((bf16_t*)(p.ws + WS_SZA) + (size_t)row * 1024 + (col - 3072)) = pack8(a, b);
          } else {
            f32x4 a, b;
#pragma unroll
            for (int j = 0; j < 4; ++j) { a[j] = sigmoidf_(v0[j]); b[j] = sigmoidf_(v1[j]); }
            *(uint4*)((bf16_t*)p.out + (size_t)row * 2048 + (col - 4096)) = pack8(a, b);
          }
        }
      }
  }
};
struct EpiGate {
  static constexpr bool PERM = true, AFTER_DRAIN = false;
  Params p; int goff; bool first;
  DI void operator()(const pg8::f32x4 (&acc)[2][2][4][2], const pg8::Unit& u, int wr, int wc, int fr, int fq) const {
    const bf16_t* G = (const bf16_t*)p.out; bf16_t* MG = (bf16_t*)(p.ws + WS_MG);
#pragma unroll
    for (int ai = 0; ai < 2; ++ai)
#pragma unroll
      for (int m = 0; m < 4; ++m) {
        const size_t row = u.pm * 256 + ai * 128 + wr * 64 + m * 16 + fr;
#pragma unroll
        for (int bj = 0; bj < 2; ++bj) {
          const int col = u.pn * 256 + bj * 128 + wc * 32 + 8 * fq;
          const uint4 g = *(const uint4*)(G + row * 2048 + goff + col);
          f32x4 a = acc[ai][bj][m][0], b = acc[ai][bj][m][1];
          a[0] *= bflo(g.x); a[1] *= bfhi(g.x); a[2] *= bflo(g.y); a[3] *= bfhi(g.y);
          b[0] *= bflo(g.z); b[1] *= bfhi(g.z); b[2] *= bflo(g.w); b[3] *= bfhi(g.w);
          if (!first) {
            const uint4 o = *(const uint4*)(MG + row * 1024 + col);
            a[0] += bflo(o.x); a[1] += bfhi(o.x); a[2] += bflo(o.y); a[3] += bfhi(o.y);
            b[0] += bflo(o.z); b[1] += bfhi(o.z); b[2] += bflo(o.w); b[3] += bfhi(o.w);
          }
          *(uint4*)(MG + row * 1024 + col) = pack8(a, b);
        }
      }
  }
};
struct EpiOut {
  static constexpr bool PERM = true, AFTER_DRAIN = false;
  Params p;
  DI void operator()(const pg8::f32x4 (&acc)[2][2][4][2], const pg8::Unit& u, int wr, int wc, int fr, int fq) const {
#pragma unroll
    for (int ai = 0; ai < 2; ++ai)
#pragma unroll
      for (int m = 0; m < 4; ++m) {
        const int row = u.pm * 256 + ai * 128 + wr * 64 + m * 16 + fr;
        const float* xr = row < MP ? p.in[0] + (size_t)row * 1024 : p.in[1] + (size_t)(row - MP) * 1024;
        float* orow = p.out + OUT_YP + (size_t)row * 1024;
#pragma unroll
        for (int bj = 0; bj < 2; ++bj) {
          const int col = u.pn * 256 + bj * 128 + wc * 32 + 8 * fq;
          const f32x4 x0 = *(const f32x4*)(xr + col), x1 = *(const f32x4*)(xr + col + 4);
          *(f32x4*)(orow + col) = x0 + acc[ai][bj][m][0]; *(f32x4*)(orow + col + 4) = x1 + acc[ai][bj][m][1];
        }
      }
  }
};
template <class Epi>
DI void run_gemm(char* smem, const bf16_t* A, const bf16_t* Bt, int M, int N, const Epi& E, int K = 1024) {
  pg8::Gemm g; g.A = A; g.Bt = Bt; g.M = M; g.N = N; g.K = K;
  pg8::StaticOrder S; S.init(M, N, (int)gridDim.x, (int)blockIdx.x);
  pg8::gemm_phase<Epi, pg8::StaticOrder, true, true>((LAS unsigned char*)smem, g, S, E);
  __syncthreads();
}

template <int MODE>
DI void small_gemm(const Params& p, const bf16_t* A, const bf16_t* Bt) {
  const int lane = TIDX & 63, wid = TIDX >> 6, r = lane & 31, h = lane >> 5;
  for (int tile = wid * gridDim.x + blockIdx.x; tile < 512; tile += 8 * gridDim.x) {
    const int row0 = MP + (tile >> 5) * 32, col0 = (tile & 31) * 32;
    const bf16_t* pa = A + (size_t)(row0 + r) * 1024 + 8 * h;
    const bf16_t* pb = Bt + (size_t)(col0 + r) * 1024 + 8 * h;
    f32x16 acc;
#pragma unroll
    for (int i = 0; i < 16; ++i) acc[i] = 0.f;
#pragma unroll 8
    for (int s = 0; s < 64; ++s) acc = MFMA32(*(const bf16x8*)(pa + 16 * s), *(const bf16x8*)(pb + 16 * s), acc);
    const int col = col0 + r;
#pragma unroll
    for (int i = 0; i < 16; ++i) {
      const size_t row = row0 + crow(i, h);
      if (MODE == 2) p.out[OUT_YP + row * 1024 + col] = p.in[1][(row - MP) * 1024 + col] + acc[i];
      else {
        bf16_t* mg = (bf16_t*)(p.ws + WS_MG) + row * 1024 + col;
        const float g = bf2f(((const bf16_t*)p.out)[row * 2048 + (MODE == 1 ? 1024 : 0) + col]);
        *mg = f2bf((MODE == 1 ? bf2f(*mg) : 0.f) + acc[i] * g);
      }
    }
  }
}

DI float tanh_fast(float x) { return 1.f - 2.f / (1.f + __expf(2.f * x)); }
DI void phase_x(const Params& p) {
  const bf16_t* PB = (const bf16_t*)(p.ws + WS_PB);
  bf16_t* X = (bf16_t*)(p.ws + WS_X);
  const float* mu = p.in[8];
  for (int i = blockIdx.x * NT + TIDX; i < MT * 32; i += gridDim.x * NT) {
    const int row = i >> 5, g = i & 31;
    uint4 o = make_uint4(0u, 0u, 0u, 0u);
    if (g < 16) {
      const int col = 3072 + g * 8;
      const bool prompt = row < MP;
      const int t = prompt ? (row & 4095) : ((row - MP) & 15);
      const uint4 a = *(const uint4*)(PB + (size_t)row * CSH + col);
      float c[8] = {bflo(a.x), bfhi(a.x), bflo(a.y), bfhi(a.y), bflo(a.z), bfhi(a.z), bflo(a.w), bfhi(a.w)}, q[8];
      if (t != 0) { const uint4 b = *(const uint4*)(PB + (size_t)(row - 1) * CSH + col); q[0] = bflo(b.x); q[1] = bfhi(b.x); q[2] = bflo(b.y); q[3] = bfhi(b.y); q[4] = bflo(b.z); q[5] = bfhi(b.z); q[6] = bflo(b.w); q[7] = bfhi(b.w); }
      else if (prompt) {
#pragma unroll
        for (int j = 0; j < 8; ++j) q[j] = 0.f;
      } else { const float* s = p.in[4] + (size_t)((row - MP) >> 4) * CSH + col; const float4 b0 = *(const float4*)s, b1 = *(const float4*)(s + 4); q[0] = b0.x; q[1] = b0.y; q[2] = b0.z; q[3] = b0.w; q[4] = b1.x; q[5] = b1.y; q[6] = b1.z; q[7] = b1.w; }
      const float4 u0 = *(const float4*)(mu + col), u1 = *(const float4*)(mu + col + 4);
      const float u[8] = {u0.x, u0.y, u0.z, u0.w, u1.x, u1.y, u1.z, u1.w};
      float m[8];
#pragma unroll
      for (int j = 0; j < 8; ++j) { m[j] = c[j] + u[j] * (q[j] - c[j]); if (g < 8) m[j] = tanh_fast(m[j]); }
      o = make_uint4(cvtpk(m[0], m[1]), cvtpk(m[2], m[3]), cvtpk(m[4], m[5]), cvtpk(m[6], m[7]));
    }
    *(uint4*)(X + (size_t)row * 256 + g * 8) = o;
  }
}
struct EpiLora {
  static constexpr bool PERM = true, AFTER_DRAIN = false;
  Params p;
  DI void operator()(const pg8::f32x4 (&acc)[2][2][4][2], const pg8::Unit& u, int wr, int wc, int fr, int fq) const {
    const bool isw = u.pn < 4;
#pragma unroll
    for (int ai = 0; ai < 2; ++ai)
#pragma unroll
      for (int m = 0; m < 4; ++m) {
        const int row = u.pm * 256 + ai * 128 + wr * 64 + m * 16 + fr;
        const size_t hb = hm_base(row), hs = hm_hstride(row);
#pragma unroll
        for (int bj = 0; bj < 2; ++bj) {
          const int c = (u.pn & 3) * 256 + bj * 128 + wc * 32 + 8 * fq;
          const size_t idx = hb + (c >> 6) * hs + (c & 63);
          const f32x4 v0 = acc[ai][bj][m][0], v1 = acc[ai][bj][m][1];
          if (isw) {
            const f32x4 b0 = *(const f32x4*)(p.in[9] + c), b1 = *(const f32x4*)(p.in[9] + c + 4);
            f32x4 d0, d1;
#pragma unroll
            for (int j = 0; j < 4; ++j) {
              const float x0 = -(b0[j] + v0[j]), x1 = -(b1[j] + v1[j]);
              const float s0 = fmaxf(x0, 0.f) + __logf(1.f + __expf(-fabsf(x0))), s1 = fmaxf(x1, 0.f) + __logf(1.f + __expf(-fabsf(x1)));
              d0[j] = __expf(-__expf(-s0 - 0.5f)); d1[j] = __expf(-__expf(-s1 - 0.5f));
            }
            float* o = (float*)(p.ws + WS_SW) + idx; *(f32x4*)o = d0; *(f32x4*)(o + 4) = d1;
          } else {
            const f32x4 b0 = *(const f32x4*)(p.in[11] + c), b1 = *(const f32x4*)(p.in[11] + c + 4);
            f32x4 d0, d1;
#pragma unroll
            for (int j = 0; j < 4; ++j) { d0[j] = sigmoidf_(b0[j] + v0[j]); d1[j] = sigmoidf_(b1[j] + v1[j]); }
            *(uint4*)((bf16_t*)(p.ws + WS_SB) + idx) = pack8(d0, d1);
          }
        }
      }
  }
};
DI void phase1c(const Params& p) {
  const int tid = TIDX & 255, half = TIDX >> 8, c = tid * 4, hh = c >> 6;
  const bf16_t* PB = (const bf16_t*)(p.ws + WS_PB);
  const float* mu = p.in[8];
  const float4 kkw = *(const float4*)(p.in[13] + c), kaw = *(const float4*)(p.in[14] + c), rkw = *(const float4*)(p.in[15] + c);
  const float4 mur = *(const float4*)(mu + c), muk = *(const float4*)(mu + 1024 + c), muv = *(const float4*)(mu + 2048 + c), muz = *(const float4*)(mu + 3200 + c);
  const float kka[4] = {kkw.x, kkw.y, kkw.z, kkw.w}, kaa[4] = {kaw.x, kaw.y, kaw.z, kaw.w}, rka[4] = {rkw.x, rkw.y, rkw.z, rkw.w};
  const float mura[4] = {mur.x, mur.y, mur.z, mur.w}, muka[4] = {muk.x, muk.y, muk.z, muk.w}, muva[4] = {muv.x, muv.y, muv.z, muv.w}, muza[4] = {muz.x, muz.y, muz.z, muz.w};
  bf16_t* SR = (bf16_t*)(p.ws + WS_SR); bf16_t* SK = (bf16_t*)(p.ws + WS_SK); bf16_t* SV = (bf16_t*)(p.ws + WS_SV);
  bf16_t* SKK = (bf16_t*)(p.ws + WS_SKK); bf16_t* SB = (bf16_t*)(p.ws + WS_SB); bf16_t* SZB = (bf16_t*)(p.ws + WS_SZB);
  float* BONUS = (float*)(p.ws + WS_BONUS);
  for (int r4 = blockIdx.x * 2 + half; r4 < MT / 4; r4 += gridDim.x * 2) {
    const int row0 = r4 * 4;
    const bool prompt = row0 < MP;
    const int t0 = prompt ? (row0 & 4095) : ((row0 - MP) & 15);
    uint2 gr[5], gk[5], gv[5], gz[5], ga[4];
#pragma unroll
    for (int t = 0; t < 5; ++t) {
      const int rr_ = (t == 0 && t0 == 0) ? row0 : row0 + t - 1;
      const bf16_t* pc = PB + (size_t)rr_ * CSH;
      gr[t] = *(const uint2*)(pc + c); gk[t] = *(const uint2*)(pc + 1024 + c); gv[t] = *(const uint2*)(pc + 2048 + c); gz[t] = *(const uint2*)(pc + 3200 + c);
    }
    size_t idx[4];
#pragma unroll
    for (int t = 0; t < 4; ++t) { idx[t] = hm_base(row0 + t) + hh * hm_hstride(row0 + t) + (c & 63); ga[t] = *(const uint2*)(SB + idx[t]); }
    float pr[4], pk[4], pv[4], pz[4];
    if (t0 == 0) {
      if (prompt) {
#pragma unroll
        for (int x = 0; x < 4; ++x) { pr[x] = 0.f; pk[x] = 0.f; pv[x] = 0.f; pz[x] = 0.f; }
      } else {
        const float* s = p.in[4] + (size_t)((row0 - MP) >> 4) * CSH;
        const float4 a = *(const float4*)(s + c), b = *(const float4*)(s + 1024 + c), d = *(const float4*)(s + 2048 + c), e = *(const float4*)(s + 3200 + c);
        pr[0] = a.x; pr[1] = a.y; pr[2] = a.z; pr[3] = a.w; pk[0] = b.x; pk[1] = b.y; pk[2] = b.z; pk[3] = b.w;
        pv[0] = d.x; pv[1] = d.y; pv[2] = d.z; pv[3] = d.w; pz[0] = e.x; pz[1] = e.y; pz[2] = e.z; pz[3] = e.w;
      }
    } else {
      pr[0] = bflo(gr[0].x); pr[1] = bfhi(gr[0].x); pr[2] = bflo(gr[0].y); pr[3] = bfhi(gr[0].y);
      pk[0] = bflo(gk[0].x); pk[1] = bfhi(gk[0].x); pk[2] = bflo(gk[0].y); pk[3] = bfhi(gk[0].y);
      pv[0] = bflo(gv[0].x); pv[1] = bfhi(gv[0].x); pv[2] = bflo(gv[0].y); pv[3] = bfhi(gv[0].y);
      pz[0] = bflo(gz[0].x); pz[1] = bfhi(gz[0].x); pz[2] = bflo(gz[0].y); pz[3] = bfhi(gz[0].y);
    }
#pragma unroll
    for (int t = 0; t < 4; ++t) {
      const int row = row0 + t;
      const float curr[4] = {bflo(gr[t + 1].x), bfhi(gr[t + 1].x), bflo(gr[t + 1].y), bfhi(gr[t + 1].y)}, curk[4] = {bflo(gk[t + 1].x), bfhi(gk[t + 1].x), bflo(gk[t + 1].y), bfhi(gk[t + 1].y)};
      const float curv[4] = {bflo(gv[t + 1].x), bfhi(gv[t + 1].x), bflo(gv[t + 1].y), bfhi(gv[t + 1].y)}, curz[4] = {bflo(gz[t + 1].x), bfhi(gz[t + 1].x), bflo(gz[t + 1].y), bfhi(gz[t + 1].y)};
      const float av[4] = {bflo(ga[t].x), bfhi(ga[t].x), bflo(ga[t].y), bfhi(ga[t].y)};
      float rm[4], km[4], vm[4], kkv[4], bb[4], kmod[4], szb[4];
      float ssq = 0.f, bon = 0.f;
#pragma unroll
      for (int x = 0; x < 4; ++x) {
        rm[x] = curr[x] + mura[x] * (pr[x] - curr[x]);
        km[x] = curk[x] + muka[x] * (pk[x] - curk[x]);
        vm[x] = curv[x] + muva[x] * (pv[x] - curv[x]);
        const float zm = curz[x] + muza[x] * (pz[x] - curz[x]);
        szb[x] = zm * sigmoidf_(zm);
        kkv[x] = km[x] * kka[x];
        ssq += kkv[x] * kkv[x];
        kmod[x] = km[x] * (1.f + (av[x] - 1.f) * kaa[x]);
        bon += rm[x] * kmod[x] * rka[x];
        pr[x] = curr[x]; pk[x] = curk[x]; pv[x] = curv[x]; pz[x] = curz[x];
      }
      ssq = sum16(ssq); bon = sum16(bon);
      const float inv = 1.f / fmaxf(sqrtf(ssq), 1e-12f);
#pragma unroll
      for (int x = 0; x < 4; ++x) { kkv[x] *= inv; bb[x] = kkv[x] * av[x]; }
      *(uint2*)(SR + idx[t]) = make_uint2(cvtpk(rm[0], rm[1]), cvtpk(rm[2], rm[3]));
      *(uint2*)(SK + idx[t]) = make_uint2(cvtpk(kmod[0], kmod[1]), cvtpk(kmod[2], kmod[3]));
      *(uint2*)(SV + idx[t]) = make_uint2(cvtpk(vm[0], vm[1]), cvtpk(vm[2], vm[3]));
      *(uint2*)(SKK + idx[t]) = make_uint2(cvtpk(-kkv[0], -kkv[1]), cvtpk(-kkv[2], -kkv[3]));
      *(uint2*)(SB + idx[t]) = make_uint2(cvtpk(bb[0], bb[1]), cvtpk(bb[2], bb[3]));
      *(uint2*)(SZB + (size_t)row * 1024 + c) = make_uint2(cvtpk(szb[0], szb[1]), cvtpk(szb[2], szb[3]));
      if ((tid & 15) == 0) BONUS[(size_t)row * 16 + hh] = bon;
    }
  }
}

template <bool SAMPLE>
DI void attn_wave(const Params& p, int sh, int qt) {
  const int lane = TIDX & 63, r = lane & 31, h = lane >> 5;
  const int hh = sh & 15, b = sh >> 4;
  bf16_t* QB = (bf16_t*)(p.ws + WS_QB);
  const int row0 = SAMPLE ? MP + b * 16 : b * 4096 + qt * 32;
  bf16_t* Qp = QB + (size_t)row0 * 1024 + hh * 64;
  const int qrow = SAMPLE ? (r < 15 ? r : 15) : r;
  bf16x8 qf[4];
#pragma unroll
  for (int s = 0; s < 4; ++s) qf[s] = *(const bf16x8*)(Qp + (size_t)qrow * 1024 + 16 * s + 8 * h);
  f32x16 z0, z1;
#pragma unroll
  for (int i = 0; i < 16; ++i) { z0[i] = 0.f; z1[i] = 0.f; }
  float carry = 1.f;
  const int ntiles = SAMPLE ? 33 : qt + 1;
  for (int it = 0; it < ntiles; ++it) {
    const bool diag = (it == 0);
    const int kt = SAMPLE ? 32 - it : qt - it;
    bf16x8 kf[4];
    {
      const float* Kp;
      if (!SAMPLE) Kp = p.out + OUT_KP + ((size_t)sh * 4096 + kt * 32 + r) * 64;
      else Kp = diag ? p.out + OUT_KS + ((size_t)sh * 16 + (r < 15 ? r : 15)) * 64 : p.in[2] + ((size_t)sh * 1024 + kt * 32 + r) * 64;
#pragma unroll
      for (int s = 0; s < 4; ++s) {
        const float4 a = *(const float4*)(Kp + 16 * s + 8 * h), bq = *(const float4*)(Kp + 16 * s + 8 * h + 4);
        u32x4 w; w[0] = cvtpk(a.x, a.y); w[1] = cvtpk(a.z, a.w); w[2] = cvtpk(bq.x, bq.y); w[3] = cvtpk(bq.z, bq.w);
        kf[s] = __builtin_bit_cast(bf16x8, w);
      }
    }
    f32x16 st;
#pragma unroll
    for (int i = 0; i < 16; ++i) st[i] = 0.f;
#pragma unroll
    for (int s = 0; s < 4; ++s) st = MFMA32(kf[s], qf[s], st);
    float keep[16], wgt[16];
#pragma unroll
    for (int i = 0; i < 16; ++i) {
      const float e = __builtin_amdgcn_exp2f(st[i]);
      const float kp = __builtin_amdgcn_rcpf(1.f + e);
      bool valid = true;
      if (diag) { const int kr = crow(i, h); valid = SAMPLE ? (kr < r && kr < 16) : (kr < r); }
      keep[i] = valid ? kp : 1.f;
      wgt[i] = valid ? 1.f - kp : 0.f;
    }
    float pp[4], hif[4];
#pragma unroll
    for (int g = 0; g < 4; ++g) {
      const float p4 = (keep[4 * g] * keep[4 * g + 1]) * (keep[4 * g + 2] * keep[4 * g + 3]);
      const auto sw = __builtin_amdgcn_permlane32_swap(__float_as_uint(p4), __float_as_uint(p4), false, false);
      const float lo = __uint_as_float(sw[0]), hi = __uint_as_float(sw[1]);
      pp[g] = lo * hi;
      hif[g] = h ? 1.f : hi;
    }
    float T[4];
    T[3] = carry; T[2] = T[3] * pp[3]; T[1] = T[2] * pp[2]; T[0] = T[1] * pp[1];
    carry = T[0] * pp[0];
#pragma unroll
    for (int g = 0; g < 4; ++g) {
      const float w3 = T[g] * hif[g], w2 = w3 * keep[4 * g + 3], w1 = w2 * keep[4 * g + 2], w0 = w1 * keep[4 * g + 1];
      wgt[4 * g + 3] *= w3; wgt[4 * g + 2] *= w2; wgt[4 * g + 1] *= w1; wgt[4 * g] *= w0;
    }
#pragma unroll
    for (int s = 0; s < 2; ++s) {
      u32x4 pw;
#pragma unroll
      for (int j = 0; j < 4; ++j) pw[j] = cvtpk(wgt[8 * s + 2 * j], wgt[8 * s + 2 * j + 1]);
      const bf16x8 pf = __builtin_bit_cast(bf16x8, pw);
#pragma unroll
      for (int db = 0; db < 2; ++db) {
        bf16x8 vf;
        {
          float vv[8];
#pragma unroll
          for (int j = 0; j < 8; ++j) {
            const int kr = 16 * s + 8 * (j >> 2) + 4 * h + (j & 3);
            const float* vp;
            if (!SAMPLE) vp = p.out + OUT_VP + ((size_t)sh * 4096 + kt * 32 + kr) * 64;
            else vp = diag ? p.out + OUT_VS + ((size_t)sh * 16 + (kr < 15 ? kr : 15)) * 64 : p.in[3] + ((size_t)sh * 1024 + kt * 32 + kr) * 64;
            vv[j] = vp[db * 32 + r];
          }
          u32x4 w; w[0] = cvtpk(vv[0], vv[1]); w[1] = cvtpk(vv[2], vv[3]); w[2] = cvtpk(vv[4], vv[5]); w[3] = cvtpk(vv[6], vv[7]);
          vf = __builtin_bit_cast(bf16x8, w);
        }
        if (db == 0) z0 = MFMA32(pf, vf, z0); else z1 = MFMA32(pf, vf, z1);
      }
    }
    if (__ballot(carry != 0.f) == 0ull) break;
  }
  const bf16_t* SZA = (const bf16_t*)(p.ws + WS_SZA);
#pragma unroll
  for (int i = 0; i < 16; ++i) {
    const int q = crow(i, h);
    if (SAMPLE && q >= 16) continue;
    const size_t o = (size_t)(row0 + q) * 1024 + hh * 64 + r;
    QB[o] = f2bf(z0[i] * bf2f(SZA[o]));
    QB[o + 32] = f2bf(z1[i] * bf2f(SZA[o + 32]));
  }
}

DI float row16_sum(float x) {
  x += dppf<0xB1>(x); x += dppf<0x4E>(x); x += dppf<0x124>(x); x += dppf<0x128>(x);
  return x;
}
DI void scan_wave(const Params& p, int shg, int slice, float* L) {
  const int lane = TIDX & 63, cc = lane & 15;
  const bool prompt = shg < 64;
  const int T = prompt ? 4096 : 16;
  const size_t base = prompt ? (size_t)shg * 4096 * 64 : (size_t)MP * 1024 + (size_t)(shg - 64) * 16 * 64;
  const int v = slice * 4 + (lane >> 4);
  const float* SW = (const float*)(p.ws + WS_SW) + base;
  const bf16_t* SARR = (const bf16_t*)(p.ws + WS_SR) + base;
  float* ORAW = (float*)(p.ws + WS_ORAW) + base;
  float4 S;
  float* wout;
  if (prompt) { S = make_float4(0.f, 0.f, 0.f, 0.f); wout = p.out + OUT_WP + ((size_t)shg * 64 + v) * 64 + 4 * cc; }
  else { S = *(const float4*)(p.in[5] + ((size_t)(shg - 64) * 64 + v) * 64 + 4 * cc); wout = p.out + OUT_WS + ((size_t)(shg - 64) * 64 + v) * 64 + 4 * cc; }
  const int nch = T / 8;
  const int dw0 = ((lane >> 4) * 6 + 2) * 64 + (lane & 15) * 4, dw1 = dw0 + 4 * 384;
  const int db = (lane >> 3) * 384 + (lane & 7) * 8;
  uint4 gw0, gw1, gr, gk, gv, gn, gb;
#define SCAN_GLOAD(ch) do { const float* w_ = SW + (size_t)(ch) * 512; gw0 = *(const uint4*)(w_ + lane * 4); gw1 = *(const uint4*)(w_ + 256 + lane * 4); \
    const bf16_t* a_ = SARR + (size_t)(ch) * 512 + lane * 8; gr = *(const uint4*)a_; gk = *(const uint4*)(a_ + SZ_ACT / 2); gv = *(const uint4*)(a_ + 2 * (SZ_ACT / 2)); \
    gn = *(const uint4*)(a_ + 3 * (SZ_ACT / 2)); gb = *(const uint4*)(a_ + 4 * (SZ_ACT / 2)); } while (0)
#define SCAN_PUT(slot, g) do { float* d_ = L + db + (slot) * 64; *(float4*)d_ = make_float4(bflo(g.x), bfhi(g.x), bflo(g.y), bfhi(g.y)); *(float4*)(d_ + 4) = make_float4(bflo(g.z), bfhi(g.z), bflo(g.w), bfhi(g.w)); } while (0)
#define SCAN_LSTORE() do { *(uint4*)(L + dw0) = gw0; *(uint4*)(L + dw1) = gw1; SCAN_PUT(4, gr); SCAN_PUT(3, gk); SCAN_PUT(5, gv); SCAN_PUT(0, gn); SCAN_PUT(1, gb); \
    asm volatile("s_waitcnt lgkmcnt(0)" ::: "memory"); } while (0)
  SCAN_GLOAD(0);
  asm volatile("s_waitcnt lgkmcnt(0)" ::: "memory");
  SCAN_LSTORE();
  for (int ch = 0; ch < nch; ++ch) {
    if (ch + 1 < nch) SCAN_GLOAD(ch + 1);
    float okeep = 0.f;
    const float* Lc = L + 4 * cc;
    float4 nk = *(const float4*)(Lc), bb = *(const float4*)(Lc + 64), ww = *(const float4*)(Lc + 128), kv = *(const float4*)(Lc + 192), rr = *(const float4*)(Lc + 256);
    float vt = L[320 + v];
#pragma unroll 4
    for (int st = 0; st < 8; ++st) {
      const int sn = ((st + 1) & 7) * 384;
      const float4 nk2 = *(const float4*)(Lc + sn), bb2 = *(const float4*)(Lc + sn + 64), ww2 = *(const float4*)(Lc + sn + 128);
      const float4 kv2 = *(const float4*)(Lc + sn + 192), rr2 = *(const float4*)(Lc + sn + 256);
      const float vt2 = L[sn + 320 + v];
      float d = (S.x * nk.x + S.y * nk.y) + (S.z * nk.z + S.w * nk.w);
      const float sa = row16_sum(d);
      S.x = S.x * ww.x + (sa * bb.x + vt * kv.x);
      S.y = S.y * ww.y + (sa * bb.y + vt * kv.y);
      S.z = S.z * ww.z + (sa * bb.z + vt * kv.z);
      S.w = S.w * ww.w + (sa * bb.w + vt * kv.w);
      float o = (S.x * rr.x + S.y * rr.y) + (S.z * rr.z + S.w * rr.w);
      o = row16_sum(o);
      okeep = (cc == st) ? o : okeep;
      nk = nk2; bb = bb2; ww = ww2; kv = kv2; rr = rr2; vt = vt2;
    }
    if (cc < 8) ORAW[(size_t)(ch * 8 + cc) * 64 + v] = okeep;
    asm volatile("s_waitcnt lgkmcnt(0)" ::: "memory");
    if (ch + 1 < nch) SCAN_LSTORE();
  }
  *(float4*)wout = S;
#undef SCAN_GLOAD
#undef SCAN_PUT
#undef SCAN_LSTORE
}

DI void sgroup_barrier(volatile LAS unsigned* cnt, unsigned target) {
  asm volatile("s_waitcnt lgkmcnt(0)" ::: "memory");
  if ((TIDX & 63) == 0) __hip_atomic_fetch_add((LAS unsigned*)cnt, 1u, __ATOMIC_RELAXED, __HIP_MEMORY_SCOPE_WORKGROUP);
  while (*cnt < target) __builtin_amdgcn_s_sleep(1);
  asm volatile("" ::: "memory");
}
DI void scan_group(const Params& p, int sh, int quarter, float* lds, volatile LAS unsigned* cnt, unsigned& nbar) {
  const int tid = TIDX & 255, lane = tid & 63, wid = tid >> 6, cc = lane & 15;
  const size_t base = (size_t)sh * 4096 * 64;
  const int v = quarter * 16 + wid * 4 + (lane >> 4);
  const float* SW = (const float*)(p.ws + WS_SW) + base;
  const bf16_t* SARR = (const bf16_t*)(p.ws + WS_SR) + base;
  float* ORAW = (float*)(p.ws + WS_ORAW) + base;
  float4 S = make_float4(0.f, 0.f, 0.f, 0.f);
  float4 gw; uint4 gb0, gb1, gb2;
  const int dstw = ((tid >> 4) * 6 + 2) * 64 + (tid & 15) * 4;
  const bf16_t* sb0; const bf16_t* sb1; const bf16_t* sb2; int db0, db1, db2;
  { const int idx = tid, arr = idx >> 7, c = idx & 127, slot = arr == 0 ? 4 : 3; sb0 = SARR + (size_t)arr * (SZ_ACT / 2) + c * 8; db0 = ((c >> 3) * 6 + slot) * 64 + (c & 7) * 8; }
  { const int idx = tid + 256, arr = idx >> 7, c = idx & 127, slot = arr == 2 ? 5 : 0; sb1 = SARR + (size_t)arr * (SZ_ACT / 2) + c * 8; db1 = ((c >> 3) * 6 + slot) * 64 + (c & 7) * 8; }
  { const int idx = (tid & 127) + 512, arr = 4, c = idx & 127; sb2 = SARR + (size_t)arr * (SZ_ACT / 2) + c * 8; db2 = ((c >> 3) * 6 + 1) * 64 + (c & 7) * 8; }
#define SG_GLOAD(ch) do { gw = *(const float4*)(SW + (size_t)(ch) * 1024 + tid * 4); gb0 = *(const uint4*)(sb0 + (size_t)(ch) * 1024); gb1 = *(const uint4*)(sb1 + (size_t)(ch) * 1024); \
    if (tid < 128) gb2 = *(const uint4*)(sb2 + (size_t)(ch) * 1024); } while (0)
#define SG_PUT(d_, g) do { *(float4*)(d_) = make_float4(bflo(g.x), bfhi(g.x), bflo(g.y), bfhi(g.y)); *(float4*)((d_) + 4) = make_float4(bflo(g.z), bfhi(g.z), bflo(g.w), bfhi(g.w)); } while (0)
#define SG_LSTORE(buf) do { float* L_ = lds + (buf) * (16 * 384); *(float4*)(L_ + dstw) = gw; SG_PUT(L_ + db0, gb0); SG_PUT(L_ + db1, gb1); if (tid < 128) SG_PUT(L_ + db2, gb2); } while (0)
  SG_GLOAD(0); SG_LSTORE(0); sgroup_barrier(cnt, 4u * (++nbar));
  for (int ch = 0; ch < 256; ++ch) {
    if (ch + 1 < 256) SG_GLOAD(ch + 1);
    const float* L = lds + (ch & 1) * (16 * 384);
    float okeep = 0.f;
    const float* Lc = L + 4 * cc;
    float4 nk = *(const float4*)(Lc), bb = *(const float4*)(Lc + 64), ww = *(const float4*)(Lc + 128), kv = *(const float4*)(Lc + 192), rr = *(const float4*)(Lc + 256);
    float vt = L[320 + v];
#pragma unroll 4
    for (int st = 0; st < 16; ++st) {
      const int sn = ((st + 1) & 15) * 384;
      const float4 nk2 = *(const float4*)(Lc + sn), bb2 = *(const float4*)(Lc + sn + 64), ww2 = *(const float4*)(Lc + sn + 128);
      const float4 kv2 = *(const float4*)(Lc + sn + 192), rr2 = *(const float4*)(Lc + sn + 256);
      const float vt2 = L[sn + 320 + v];
      float d = (S.x * nk.x + S.y * nk.y) + (S.z * nk.z + S.w * nk.w);
      const float sa = row16_sum(d);
      S.x = S.x * ww.x + (sa * bb.x + vt * kv.x);
      S.y = S.y * ww.y + (sa * bb.y + vt * kv.y);
      S.z = S.z * ww.z + (sa * bb.z + vt * kv.z);
      S.w = S.w * ww.w + (sa * bb.w + vt * kv.w);
      float o = (S.x * rr.x + S.y * rr.y) + (S.z * rr.z + S.w * rr.w);
      o = row16_sum(o);
      okeep = (cc == st) ? o : okeep;
      nk = nk2; bb = bb2; ww = ww2; kv = kv2; rr = rr2; vt = vt2;
    }
    ORAW[(size_t)(ch * 16 + cc) * 64 + v] = okeep;
    if (ch + 1 < 256) SG_LSTORE((ch + 1) & 1);
    sgroup_barrier(cnt, 4u * (++nbar));
  }
  *(float4*)(p.out + OUT_WP + ((size_t)sh * 64 + v) * 64 + 4 * cc) = S;
#undef SG_GLOAD
#undef SG_PUT
#undef SG_LSTORE
}

constexpr int NQ_ATT_P = 8192, NQ_ATT_S = 512, NQ_SCAN_S = 8192, NQ_DYN = NQ_ATT_P + NQ_ATT_S + NQ_SCAN_S;
DI int wave_grab(unsigned* ctr) { int v = 0; if ((TIDX & 63) == 0) v = (int)atomicAdd(ctr, 1u); return __builtin_amdgcn_readfirstlane(v); }
DI void phase2(const Params& p, char* smem) {
  __shared__ unsigned s_cnt;
  unsigned* ctl = (unsigned*)(p.ws + WS_CTL);
  const int wid = TIDX >> 6;
  if (TIDX == 0) s_cnt = 0u;
  __syncthreads();
  float* L = (float*)smem + wid * (8 * 384);
  if (wid < 4) {
    unsigned nbar = 0;
    for (int bu = blockIdx.x; bu < 256; bu += gridDim.x) scan_group(p, bu >> 2, bu & 3, (float*)smem + 8 * 8 * 384, (volatile LAS unsigned*)&s_cnt, nbar);
  }
  for (;;) {
    int u = wave_grab(&ctl[0]);
    if (u >= NQ_DYN) break;
    if (u < NQ_ATT_P) { attn_wave<false>(p, u >> 7, u & 127); continue; }
    u -= NQ_ATT_P;
    if (u < NQ_ATT_S) { attn_wave<true>(p, u, 0); continue; }
    u -= NQ_ATT_S;
    scan_wave(p, 64 + (u >> 4), u & 15, L);
  }
}

DI void phase2c(const Params& p) {
  const int tid = TIDX & 255, half = TIDX >> 8, c = tid * 4, hh = c >> 6;
  const float4 lg = *(const float4*)(p.in[16] + c), lb = *(const float4*)(p.in[17] + c);
  const float* ORAW = (const float*)(p.ws + WS_ORAW); const bf16_t* SV = (const bf16_t*)(p.ws + WS_SV);
  const bf16_t* SZB = (const bf16_t*)(p.ws + WS_SZB); const float* BONUS = (const float*)(p.ws + WS_BONUS);
  bf16_t* OB = (bf16_t*)(p.ws + WS_OB);
  for (int row = blockIdx.x * 2 + half; row < MT; row += gridDim.x * 2) {
    const size_t idx = hm_base(row) + hh * hm_hstride(row) + (c & 63);
    const float4 o = *(const float4*)(ORAW + idx);
    const float mean = sum16((o.x + o.y) + (o.z + o.w)) * (1.f / 64.f);
    const float dx = o.x - mean, dy = o.y - mean, dz = o.z - mean, dw = o.w - mean;
    const float var = sum16((dx * dx + dy * dy) + (dz * dz + dw * dw)) * (1.f / 64.f);
    const float inv = rsqrtf(var + LNX_EPS);
    const float bon = BONUS[(size_t)row * 16 + hh];
    const uint2 vv = *(const uint2*)(SV + idx), zz = *(const uint2*)(SZB + (size_t)row * 1024 + c);
    const float r0 = (dx * inv * lg.x + lb.x + bon * bflo(vv.x)) * bflo(zz.x);
    const float r1 = (dy * inv * lg.y + lb.y + bon * bfhi(vv.x)) * bfhi(zz.x);
    const float r2 = (dz * inv * lg.z + lb.z + bon * bflo(vv.y)) * bflo(zz.y);
    const float r3 = (dw * inv * lg.w + lb.w + bon * bfhi(vv.y)) * bfhi(zz.y);
    *(uint2*)(OB + (size_t)row * 1024 + c) = make_uint2(cvtpk(r0, r1), cvtpk(r2, r3));
  }
}

DI void phase4(const Params& p) {
  const int lane = TIDX & 63, wid = TIDX >> 6;
  const float* g = p.in[21];
  for (int row = blockIdx.x * 8 + wid; row < MT; row += gridDim.x * 8) {
    float* x = p.out + OUT_YP + (size_t)row * 1024;
    float4 v[4]; float ss = 0.f;
#pragma unroll
    for (int i = 0; i < 4; ++i) { v[i] = *(const float4*)(x + i * 256 + lane * 4); ss += v[i].x * v[i].x + v[i].y * v[i].y + v[i].z * v[i].z + v[i].w * v[i].w; }
    ss = wave_sum(ss);
    const float inv = rsqrtf(ss * (1.f / DM) + EPS);
#pragma unroll
    for (int i = 0; i < 4; ++i) {
      const float4 gg = *(const float4*)(g + i * 256 + lane * 4);
      *(float4*)(x + i * 256 + lane * 4) = make_float4(v[i].x * inv * gg.x, v[i].y * inv * gg.y, v[i].z * inv * gg.z, v[i].w * inv * gg.w);
    }
  }
}

#define XB_TMO      128
#define XB_XCNT(j)  (256  + 64 * (j))
#define XB_XSUB(j)  (1280 + 64 * (j))
#define XB_XGEN(j)  (2304 + 64 * (j))
#define XB_TOP      3328
#define XB_TOPGEN   3392
#define XCD_BAR_WORDS 3456
#define XB_SPIN_CAP (1u << 18)

__device__ __forceinline__ unsigned xb_ld(unsigned* p)              { return __hip_atomic_load(p, __ATOMIC_RELAXED, __HIP_MEMORY_SCOPE_AGENT); }
__device__ __forceinline__ unsigned xb_add(unsigned* p, unsigned v) { return __hip_atomic_fetch_add(p, v, __ATOMIC_RELAXED, __HIP_MEMORY_SCOPE_AGENT); }
__device__ __forceinline__ unsigned xb_xcc_id() { return (unsigned)__builtin_amdgcn_s_getreg((3 << 11) | 20) & 0xFu; }
#define XB_SPIN(cond, bar) do { unsigned _sp = 0; while (cond) { __builtin_amdgcn_s_sleep(1); \
    if ((++_sp & 255u) == 0u) { if (xb_ld(&(bar)[XB_TMO])) break; if (_sp > XB_SPIN_CAP) { atomicAdd(&(bar)[XB_TMO], 1u); break; } } } } while (0)

struct XcdBarrier {
    unsigned* bar; unsigned x;
    volatile LAS unsigned* st;
};

__device__ __forceinline__ XcdBarrier xcd_barrier_post(unsigned* bar, volatile LAS unsigned* st) {
    XcdBarrier b; b.bar = bar; b.x = xb_xcc_id(); b.st = st;
    if (TIDX == 0) (void)xb_add(&bar[XB_XCNT(b.x)], 1u);
    return b;
}
__device__ __forceinline__ void xcd_barrier_complete(unsigned* bar, unsigned x, unsigned& nloc, unsigned& nx) {
    const unsigned G = gridDim.x * gridDim.y * gridDim.z;
    unsigned sum, cnt, mine, sp = 0u;
    for (;;) {
        sum = 0u; cnt = 0u; mine = 0u;
#pragma unroll
        for (unsigned j = 0; j < 16; ++j) { const unsigned c = xb_ld(&bar[XB_XCNT(j)]); sum += c; cnt += (c > 0u) ? 1u : 0u; mine = (j == x) ? c : mine; }
        if (sum == G) break;
        __builtin_amdgcn_s_sleep(1);
        if ((++sp & 255u) == 0u) { if (xb_ld(&bar[XB_TMO])) break; if (sp > XB_SPIN_CAP) { atomicAdd(&bar[XB_TMO], 1u); break; } }
    }
    nloc = mine > 0u ? mine : 1u; nx = cnt > 0u ? cnt : 1u;
}

__device__ __forceinline__ void xcd_barrier(const XcdBarrier& b) {
    asm volatile("s_waitcnt vmcnt(0)" ::: "memory");
    __syncthreads();
    if (TIDX == 0) {
        unsigned* bar = b.bar;
        __builtin_amdgcn_s_waitcnt(0);
        unsigned nloc = b.st[0], nx = b.st[1];
        if (nloc == 0u) { xcd_barrier_complete(bar, b.x, nloc, nx); b.st[0] = nloc; b.st[1] = nx; }
        const unsigned old = xb_add(&bar[XB_XSUB(b.x)], 1u);
        const unsigned gen = old / nloc;
        if (old + 1u == (gen + 1u) * nloc) {
            __builtin_amdgcn_fence(__ATOMIC_RELEASE, "agent");
            asm volatile("s_waitcnt vmcnt(0)" ::: "memory");
            const unsigned og = xb_add(&bar[XB_TOP], 1u);
            const unsigned tg = og / nx;
            if (og + 1u == (tg + 1u) * nx) xb_add(&bar[XB_TOPGEN], 1u);
            else XB_SPIN(xb_ld(&bar[XB_TOPGEN]) == tg, bar);
            __builtin_amdgcn_fence(__ATOMIC_ACQUIRE, "agent");
            xb_add(&bar[XB_XGEN(b.x)], 1u);
            asm volatile("s_waitcnt vmcnt(0)" ::: "memory");
        } else {
            XB_SPIN(xb_ld(&bar[XB_XGEN(b.x)]) == gen, bar);
            __builtin_amdgcn_fence(__ATOMIC_ACQUIRE, "agent");
            asm volatile("s_waitcnt vmcnt(0)" ::: "memory");
        }
    }
    __syncthreads();
}

__global__ void __launch_bounds__(NT, 2) mega(Params p) {
  extern __shared__ __attribute__((aligned(16))) char smem[];
  cg::grid_group grid = cg::this_grid();
  phase0(p, smem);
  grid.sync();
  __shared__ unsigned xb_st[2];
  if (TIDX == 0) { xb_st[0] = 0u; xb_st[1] = 0u; }
  __syncthreads();
  (void)xcd_barrier_post((unsigned*)(p.ws + WS_CTL) + 8192, (volatile LAS unsigned*)xb_st);
#define XBAR() do { XcdBarrier xb_; xb_.bar = (unsigned*)(p.ws + WS_CTL) + 8192; xb_.x = xb_xcc_id(); xb_.st = (volatile LAS unsigned*)xb_st; xcd_barrier(xb_); } while (0)
  { EpiP1 E; E.p = p; run_gemm(smem, (const bf16_t*)(p.ws + WS_H), (const bf16_t*)(p.ws + WS_WINT), MT, NINP, E); }
  XBAR();
  phase_x(p);
  XBAR();
  { EpiLora E; E.p = p; run_gemm(smem, (const bf16_t*)(p.ws + WS_X), (const bf16_t*)(p.ws + WS_BTL), MT, 2048, E, 256); }
  XBAR();
  phase1c(p);
  XBAR();
  phase2(p, smem);
  XBAR();
  phase2c(p);
  XBAR();
  { EpiGate E; E.p = p; E.goff = 0; E.first = true; run_gemm(smem, (const bf16_t*)(p.ws + WS_QB), (const bf16_t*)(p.ws + WS_WT), MP, 1024, E); }
  small_gemm<0>(p, (const bf16_t*)(p.ws + WS_QB), (const bf16_t*)(p.ws + WS_WT));
  { EpiGate E; E.p = p; E.goff = 1024; E.first = false; run_gemm(smem, (const bf16_t*)(p.ws + WS_OB), (const bf16_t*)(p.ws + WS_WT) + (size_t)1024 * 1024, MP, 1024, E); }
  small_gemm<1>(p, (const bf16_t*)(p.ws + WS_OB), (const bf16_t*)(p.ws + WS_WT) + (size_t)1024 * 1024);
  XBAR();
  { EpiOut E; E.p = p; run_gemm(smem, (const bf16_t*)(p.ws + WS_MG), (const bf16_t*)(p.ws + WS_WT) + (size_t)2 * 1024 * 1024, MP, 1024, E); }
  small_gemm<2>(p, (const bf16_t*)(p.ws + WS_MG), (const bf16_t*)(p.ws + WS_WT) + (size_t)2 * 1024 * 1024);
  XBAR();
  phase4(p);
}

extern "C" void kernel_launch(void* const* d_in, const int* in_sizes, int n_in, void* d_out, int out_size, void* d_ws, size_t ws_size, hipStream_t stream) {
  static int grid_blocks = 0;
  if (grid_blocks == 0) {
    if (n_in != 22 || ws_size < WS_END) { fprintf(stderr, "kernel_launch: unexpected n_in %d / ws_size %zu (need %zu)\n", n_in, ws_size, (size_t)WS_END); grid_blocks = -1; return; }
    int dev = 0, cus = 0, per_cu = 0;
    (void)hipGetDevice(&dev);
    (void)hipDeviceGetAttribute(&cus, hipDeviceAttributeMultiprocessorCount, dev);
    (void)hipFuncSetAttribute((const void*)mega, hipFuncAttributeMaxDynamicSharedMemorySize, SMEM_BYTES);
    (void)hipOccupancyMaxActiveBlocksPerMultiprocessor(&per_cu, (const void*)mega, NT, SMEM_BYTES);
    (void)hipGetLastError();
    grid_blocks = cus;
  }
  if (grid_blocks < 0) return;
  Params p{};
  for (int i = 0; i < 22; ++i) p.in[i] = (const float*)d_in[i];
  p.out = (float*)d_out; p.ws = (unsigned char*)d_ws;
  void* args[] = {&p};
  hipError_t e = hipLaunchCooperativeKernel((const void*)mega, dim3(grid_blocks), dim3(NT), args, SMEM_BYTES, stream);
  if (e != hipSuccess) fprintf(stderr, "cooperative launch failed: %s (grid %d)\n", hipGetErrorString(e), grid_blocks);
}
```

```cpp
#include <hip/hip_runtime.h>
#include <hip/hip_cooperative_groups.h>
#include <cstdio>
#include <cstdint>
namespace cg = cooperative_groups;
__device__ __forceinline__ int lane_id_() { return (int)__builtin_amdgcn_mbcnt_hi(~0u, __builtin_amdgcn_mbcnt_lo(~0u, 0u)); }
#define TIDX (__builtin_amdgcn_readfirstlane((int)(threadIdx.x >> 6)) * 64 + lane_id_())

namespace pg8 {
#define PG8_LAS __attribute__((address_space(3)))
typedef unsigned short bf16_t;
typedef short bf16x8 __attribute__((ext_vector_type(8)));
typedef float f32x4 __attribute__((ext_vector_type(4)));
typedef unsigned u32x4 __attribute__((ext_vector_type(4)));
constexpr int BM = 256, BK = 64, HALF = 128, HTB = HALF * BK * 2  , STAGE_BYTES = 8 * HTB, NXCD = 8, WGM = 8;

__host__ __device__ __forceinline__ int lds_byte(int r, int c) { const int st = (r >> 4) * 2 + (c >> 5), rr = r & 15, cc = c & 31, ob = rr * 64 + cc * 2; return st * 1024 + (ob ^ (((ob >> 9) & 1) << 5)); }
__host__ __device__ __forceinline__ void stage_rc(int b, int& R, int& C) { const int st = b / 1024, sb = b % 1024, swz = sb ^ (((sb >> 9) & 1) << 5); R = (st >> 1) * 16 + swz / 64; C = (st & 1) * 32 + (swz % 64) / 2; }
__host__ __device__ __forceinline__ int perm32(int rho) { const int n = rho >> 4, i = rho & 15; return 8 * (i >> 2) + 4 * n + (i & 3); }

struct Unit { int pm, pn; };
struct Gemm { const bf16_t* A; const bf16_t* Bt; int M, N, K; };

struct StaticOrder {
    int nM, nN, nwg, G, c;
    __host__ __device__ void init(int M, int N, int G_, int c_) { nM = M / BM; nN = N / BM; nwg = nM * nN; G = G_; c = c_; }
    __host__ __device__ bool next(int i, Unit& u) const {
        const long L = (long)i * G + c; if (L >= nwg) return false;
        int wgid = (int)L; { const int q = nwg / NXCD, r = nwg % NXCD, xcd = wgid % NXCD, off = wgid / NXCD; wgid = (xcd < r ? xcd * (q + 1) : r * (q + 1) + (xcd - r) * q) + off; }
        const int nig = WGM * nN, gid = wgid / nig, fm = gid * WGM, gsz = (nM - fm) < WGM ? (nM - fm) : WGM;
        u.pm = fm + ((wgid % nig) % gsz); u.pn = (wgid % nig) / gsz; return true;
    }
    __device__ __forceinline__ void a_ready(const Unit&) const {}
    __device__ __forceinline__ void done(const Unit&) const {}
};


template <class Epi, class Sched, bool ALIGN_EPI = false, bool SP2 = false>
__device__ __forceinline__ void gemm_phase(PG8_LAS unsigned char* lds, const Gemm g, const Sched& S, const Epi& E) {
    int tid_ = TIDX; asm volatile("" : "+v"(tid_));
    const int tid = tid_, wid = __builtin_amdgcn_readfirstlane(tid >> 6), lane = tid & 63, wr = wid >> 2, wc = wid & 3, fr = lane & 15, fq = lane >> 4;
    const int K = g.K, nt = K / BK;
    unsigned voffA[2], voffB[2];
#pragma unroll
    for (int i = 0; i < 2; ++i) { int R, C; stage_rc(tid * 16 + i * 8192, R, C); const int Rb = Epi::PERM ? ((R & ~31) + perm32(R & 31)) : R;
        voffA[i] = (unsigned)(R * K + C) * 2u; voffB[i] = (unsigned)(Rb * K + C) * 2u; }
    const size_t kstep = (size_t)(BK * 2);
    const size_t hstep = (size_t)HALF * K * 2;
    const size_t tstep = 2 * hstep;
    const unsigned ldsw = (unsigned)wid * 1024u;
    const int aoff = lds_byte(wr * 64 + fr, fq * 8), boff = lds_byte(wc * 32 + fr, fq * 8);
#define PG8_SA(b, h) (((b) * 2 + (h)) * HTB)
#define PG8_SB(b, h) ((4 + (b) * 2 + (h)) * HTB)
#define PG8_STAGE(bufoff, gbase, voff) do { _Pragma("unroll") for (int _i = 0; _i < 2; ++_i) \
        __builtin_amdgcn_global_load_lds((const unsigned*)((const char*)(gbase) + (voff)[_i]), (PG8_LAS unsigned*)(lds + (bufoff) + ldsw + _i * 8192), 16, 0, 0); } while (0)
#define PG8_LDA(dst, b, h) do { _Pragma("unroll") for (int m = 0; m < 4; ++m) _Pragma("unroll") for (int k = 0; k < 2; ++k) dst[m][k] = *(const PG8_LAS bf16x8*)(lds + PG8_SA(b, h) + aoff + m * 2048 + k * 1024); } while (0)
#define PG8_LDB(dst, b, h) do { _Pragma("unroll") for (int n = 0; n < 2; ++n) _Pragma("unroll") for (int k = 0; k < 2; ++k) dst[n][k] = *(const PG8_LAS bf16x8*)(lds + PG8_SB(b, h) + boff + n * 2048 + k * 1024); } while (0)
#define PG8_MMA(ai, bj, At, Bt) do { __builtin_amdgcn_s_setprio(1); _Pragma("unroll") for (int m = 0; m < 4; ++m) _Pragma("unroll") for (int n = 0; n < 2; ++n) _Pragma("unroll") for (int k = 0; k < 2; ++k) \
        acc[ai][bj][m][n] = __builtin_amdgcn_mfma_f32_16x16x32_bf16(Bt[n][k], At[m][k], acc[ai][bj][m][n], 0, 0, 0); __builtin_amdgcn_s_setprio(0); } while (0)
#define PG8_WAIT_V(n) asm volatile("s_waitcnt vmcnt(" #n ")" ::: "memory")
#define PG8_WAIT_L(n) asm volatile("s_waitcnt lgkmcnt(" #n ")" ::: "memory")
#define PG8_BAR __builtin_amdgcn_s_barrier()
#define PG8_SCHED __builtin_amdgcn_sched_barrier(0)
    Unit cur, nxt; int ui = 0;
    if (!S.next(0, cur)) return;
    f32x4 acc[2][2][4][2];
#pragma unroll
    for (int a = 0; a < 2; ++a)
#pragma unroll
        for (int b = 0; b < 2; ++b)
#pragma unroll
            for (int m = 0; m < 4; ++m)
#pragma unroll
                for (int n = 0; n < 2; ++n) acc[a][b][m][n] = (f32x4){0.f, 0.f, 0.f, 0.f};
    bf16x8 At[4][2], B0[2][2], B1[2][2];
    const char* cA = (const char*)g.A + (size_t)cur.pm * tstep; const char* cB = (const char*)g.Bt + (size_t)cur.pn * tstep;
    S.a_ready(cur);
    if constexpr (SP2) {
        PG8_STAGE(PG8_SB(0, 0), cB, voffB); PG8_STAGE(PG8_SB(0, 1), cB + hstep, voffB); PG8_STAGE(PG8_SA(0, 0), cA, voffA); PG8_STAGE(PG8_SA(0, 1), cA + hstep, voffA);
        if (wr == 1) PG8_BAR;
        PG8_WAIT_V(2); PG8_BAR;
        PG8_STAGE(PG8_SB(1, 0), cB + kstep, voffB); PG8_STAGE(PG8_SA(1, 0), cA + kstep, voffA); PG8_STAGE(PG8_SB(1, 1), cB + hstep + kstep, voffB);
        PG8_WAIT_V(6); PG8_BAR;
    } else {
        PG8_STAGE(PG8_SB(0, 0), cB, voffB); PG8_STAGE(PG8_SA(0, 0), cA, voffA); PG8_STAGE(PG8_SB(0, 1), cB + hstep, voffB); PG8_STAGE(PG8_SA(0, 1), cA + hstep, voffA);
        if (wr == 1) PG8_BAR;
        PG8_WAIT_V(4); PG8_BAR;
        PG8_STAGE(PG8_SB(1, 0), cB + kstep, voffB); PG8_STAGE(PG8_SA(1, 0), cA + kstep, voffA); PG8_STAGE(PG8_SB(1, 1), cB + hstep + kstep, voffB);
        PG8_WAIT_V(6); PG8_BAR;
    }
    for (;;) {
        const bool has_next = S.next(ui + 1, nxt);
        const char* nA = has_next ? (const char*)g.A + (size_t)nxt.pm * tstep : cA; const char* nB = has_next ? (const char*)g.Bt + (size_t)nxt.pn * tstep : cB;
        for (int t = 0; t < nt; t += 2) {
            const bool last = (t == nt - 2);
            const char* a1 = cA + (size_t)(t + 1) * kstep;
            const char* a2 = last ? nA : cA + (size_t)(t + 2) * kstep; const char* b2 = last ? nB : cB + (size_t)(t + 2) * kstep;
            const char* a3 = a2 + kstep; const char* b3 = b2 + kstep;
            if (last && has_next) S.a_ready(nxt);
            if constexpr (SP2) {
            PG8_LDB(B0, 0, 0); PG8_LDB(B1, 0, 1); PG8_SCHED; PG8_LDA(At, 0, 0); PG8_STAGE(PG8_SA(1, 1), a1 + hstep, voffA);
            PG8_WAIT_V(8); PG8_WAIT_L(0); PG8_BAR; PG8_MMA(0, 0, At, B0); PG8_MMA(0, 1, At, B1); PG8_BAR; PG8_SCHED;
            PG8_LDA(At, 0, 1); PG8_STAGE(PG8_SB(0, 0), b2, voffB); PG8_STAGE(PG8_SB(0, 1), b2 + hstep, voffB); PG8_STAGE(PG8_SA(0, 0), a2, voffA);
            PG8_WAIT_V(8); PG8_WAIT_L(0); PG8_BAR; PG8_MMA(1, 0, At, B0); PG8_MMA(1, 1, At, B1); PG8_BAR; PG8_SCHED;
            PG8_LDB(B0, 1, 0); PG8_LDB(B1, 1, 1); PG8_SCHED; PG8_LDA(At, 1, 0); PG8_STAGE(PG8_SA(0, 1), a2 + hstep, voffA);
            PG8_WAIT_V(8); PG8_WAIT_L(0); PG8_BAR; PG8_MMA(0, 0, At, B0); PG8_MMA(0, 1, At, B1); PG8_BAR; PG8_SCHED;
            PG8_LDA(At, 1, 1); PG8_STAGE(PG8_SB(1, 0), b3, voffB); PG8_STAGE(PG8_SB(1, 1), b3 + hstep, voffB); PG8_STAGE(PG8_SA(1, 0), a3, voffA);
            PG8_WAIT_V(8); PG8_WAIT_L(0); PG8_BAR; PG8_MMA(1, 0, At, B0); PG8_MMA(1, 1, At, B1); PG8_BAR; PG8_SCHED;
            } else {
            PG8_LDB(B0, 0, 0); PG8_SCHED; PG8_LDA(At, 0, 0); PG8_STAGE(PG8_SA(1, 1), a1 + hstep, voffA);
            PG8_WAIT_L(8); PG8_BAR; PG8_WAIT_L(0); PG8_MMA(0, 0, At, B0); PG8_BAR; PG8_SCHED;
            PG8_LDB(B1, 0, 1); PG8_STAGE(PG8_SB(0, 0), b2, voffB);
            PG8_BAR; PG8_WAIT_L(0); PG8_MMA(0, 1, At, B1); PG8_BAR;
            PG8_LDA(At, 0, 1); PG8_STAGE(PG8_SA(0, 0), a2, voffA);
            PG8_BAR; PG8_WAIT_L(0); PG8_MMA(1, 0, At, B0); PG8_BAR; PG8_SCHED;
            PG8_STAGE(PG8_SB(0, 1), b2 + hstep, voffB);
            PG8_WAIT_V(6); PG8_BAR; PG8_MMA(1, 1, At, B1); PG8_BAR;
            PG8_LDB(B0, 1, 0); PG8_SCHED; PG8_LDA(At, 1, 0); PG8_STAGE(PG8_SA(0, 1), a2 + hstep, voffA);
            PG8_WAIT_L(8); PG8_BAR; PG8_WAIT_L(0); PG8_MMA(0, 0, At, B0); PG8_BAR; PG8_SCHED;
            PG8_LDB(B1, 1, 1); PG8_STAGE(PG8_SB(1, 0), b3, voffB);
            PG8_BAR; PG8_WAIT_L(0); PG8_MMA(0, 1, At, B1); PG8_BAR;
            PG8_LDA(At, 1, 1); PG8_STAGE(PG8_SA(1, 0), a3, voffA);
            PG8_BAR; PG8_WAIT_L(0); PG8_MMA(1, 0, At, B0); PG8_BAR; PG8_SCHED;
            PG8_STAGE(PG8_SB(1, 1), b3 + hstep, voffB);
            PG8_WAIT_V(6); PG8_BAR; PG8_MMA(1, 1, At, B1); PG8_BAR;
            }
        }
        if constexpr (ALIGN_EPI) { if (wr == 0) PG8_BAR; }
        if constexpr (!Epi::AFTER_DRAIN) { E(acc, cur, wr, wc, fr, fq); S.done(cur); }
        if (!has_next) break;
#pragma unroll
        for (int a = 0; a < 2; ++a)
#pragma unroll
            for (int b = 0; b < 2; ++b)
#pragma unroll
                for (int m = 0; m < 4; ++m)
#pragma unroll
                    for (int n = 0; n < 2; ++n) acc[a][b][m][n] = (f32x4){0.f, 0.f, 0.f, 0.f};
        cur = nxt; cA = nA; cB = nB; ++ui;
        if constexpr (ALIGN_EPI) { if (wr == 1) PG8_BAR; }
    }
    PG8_WAIT_V(0);
    if constexpr (!ALIGN_EPI) { if (wr == 0) PG8_BAR; }
    PG8_BAR;
    if constexpr (Epi::AFTER_DRAIN) { E.fused(acc, cur, wr, wc, fr, fq, lds, wid, lane); S.done(cur); }
#undef PG8_SA
#undef PG8_SB
#undef PG8_STAGE
#undef PG8_LDA
#undef PG8_LDB
#undef PG8_MMA
#undef PG8_WAIT_V
#undef PG8_WAIT_L
#undef PG8_BAR
#undef PG8_SCHED
}
}


#define DI __device__ __forceinline__
typedef unsigned short bf16_t;
typedef short bf16x8 __attribute__((ext_vector_type(8)));
typedef float f32x4 __attribute__((ext_vector_type(4)));
typedef float f32x2 __attribute__((ext_vector_type(2)));
typedef float f32x16 __attribute__((ext_vector_type(16)));
typedef unsigned u32x4 __attribute__((ext_vector_type(4)));
#define MFMA32(a, b, c) __builtin_amdgcn_mfma_f32_32x32x16_bf16((a), (b), (c), 0, 0, 0)
#define LAS __attribute__((address_space(3)))

constexpr int NT = 512;
constexpr int DM = 1024, MP = 16384, MT = 16896;
constexpr int NIN = 10368, NINP = 10496, CSH = 4224;
constexpr float EPS = 1e-6f, LNX_EPS = 64e-5f;
constexpr float QSCALE = 0.18033688011112042f;

constexpr size_t OUT_YP = 0, OUT_KP = 17301504, OUT_VP = 34078720, OUT_SHP = 50855936, OUT_WP = 50872832,
                 OUT_KS = 51134976, OUT_VS = 51659264, OUT_SHS = 52183552, OUT_WS = 52318720;

constexpr size_t SZ_ACT = (size_t)MT * 1024 * 2;
constexpr size_t WS_R1 = 0;
constexpr size_t WS_H = WS_R1, WS_WINT = WS_R1 + SZ_ACT, WS_SW = WS_R1;
constexpr size_t WS_R2 = (size_t)MT * 1024 * 4;
constexpr size_t WS_PB = WS_R2, WS_ORAW = WS_R2, WS_OB = WS_ORAW + (size_t)MT * 1024 * 4, WS_MG = WS_OB + SZ_ACT;
constexpr size_t WS_R3 = WS_R2 + (size_t)MT * CSH * 2;
constexpr size_t WS_QB = WS_R3, WS_X = WS_QB + SZ_ACT  , WS_BTL = WS_X + (size_t)MT * 256 * 2  , WS_SZA = WS_X + (size_t)MP * 1024 * 2;
static_assert(WS_BTL + (size_t)2048 * 256 * 2 <= WS_SZA, "LoRA buffers");
constexpr size_t WS_SR = WS_SZA + SZ_ACT, WS_SK = WS_SR + SZ_ACT, WS_SV = WS_SK + SZ_ACT, WS_SKK = WS_SV + SZ_ACT, WS_SB = WS_SKK + SZ_ACT;
constexpr size_t WS_SZB = WS_SB + SZ_ACT;
constexpr size_t WS_BONUS = WS_SZB + SZ_ACT;
constexpr size_t WS_WT = WS_BONUS + (size_t)MT * 16 * 4;
constexpr size_t WS_CTL = WS_WT + 3 * (size_t)1024 * 1024 * 2;
constexpr size_t WS_END = WS_CTL + 65536;
static_assert(WS_MG + SZ_ACT <= WS_R3, "R2 overflow");
static_assert(WS_WINT + (size_t)NINP * 1024 * 2 <= WS_R2, "R1 overflow");
static_assert(WS_END <= (size_t)512 * 1024 * 1024, "workspace");

constexpr int SMEM_BYTES = 147456;

struct Params { const float* in[22]; float* out; unsigned char* ws; };

DI float bf2f(bf16_t u) { return __uint_as_float((unsigned)u << 16); }
DI unsigned cvtpk(float lo, float hi) { unsigned r; asm volatile("v_cvt_pk_bf16_f32 %0, %1, %2" : "=v"(r) : "v"(lo), "v"(hi)); return r; }
DI bf16_t f2bf(float x) { return (bf16_t)(cvtpk(x, 0.f) & 0xffffu); }
DI float bflo(unsigned u) { return __uint_as_float(u << 16); }
DI float bfhi(unsigned u) { return __uint_as_float(u & 0xffff0000u); }
DI int crow(int i, int h) { return (i & 3) + 8 * (i >> 2) + 4 * h; }
DI float sigmoidf_(float x) { return 1.f / (1.f + __expf(-x)); }
DI uint4 pack8(f32x4 a, f32x4 b) { return make_uint4(cvtpk(a[0], a[1]), cvtpk(a[2], a[3]), cvtpk(b[0], b[1]), cvtpk(b[2], b[3])); }
DI float wave_sum(float x) {
#pragma unroll
  for (int o = 32; o > 0; o >>= 1) x += __shfl_xor(x, o);
  return x;
}
DI float sum16(float x) { x += __shfl_xor(x, 1); x += __shfl_xor(x, 2); x += __shfl_xor(x, 4); x += __shfl_xor(x, 8); return x; }
template <int CTRL> DI float dppf(float x) { return __builtin_bit_cast(float, __builtin_amdgcn_mov_dpp(__builtin_bit_cast(int, x), CTRL, 0xf, 0xf, true)); }
DI float row32_sum(float x) {
  x += dppf<0xB1>(x);
  x += dppf<0x4E>(x);
  x += dppf<0x124>(x);
  x += dppf<0x128>(x);
  const auto s = __builtin_amdgcn_permlane16_swap(__float_as_uint(x), __float_as_uint(x), false, false);
  return __uint_as_float(s[0]) + __uint_as_float(s[1]);
}
DI size_t hm_base(int row) {
  if (row < MP) { const int b = row >> 12, t = row & 4095; return ((size_t)(b * 16) * 4096 + t) * 64; }
  const int rs = row - MP, b = rs >> 4, t = rs & 15; return (size_t)MP * 1024 + ((size_t)(b * 16) * 16 + t) * 64;
}
DI size_t hm_hstride(int row) { return row < MP ? (size_t)4096 * 64 : (size_t)16 * 64; }

DI void p0_rmsnorm_rows(const Params& p, int item) {
  const int lane = TIDX & 63, wid = TIDX >> 6;
  const int row = item * 8 + wid;
  const float* x = row < MP ? p.in[0] + (size_t)row * DM : p.in[1] + (size_t)(row - MP) * DM;
  const float* g = p.in[6];
  float4 v[4]; float ss = 0.f;
#pragma unroll
  for (int i = 0; i < 4; ++i) { v[i] = *(const float4*)(x + i * 256 + lane * 4); ss += v[i].x * v[i].x + v[i].y * v[i].y + v[i].z * v[i].z + v[i].w * v[i].w; }
  ss = wave_sum(ss);
  const float inv = rsqrtf(ss * (1.f / DM) + EPS);
  bf16_t* H = (bf16_t*)(p.ws + WS_H) + (size_t)row * DM;
#pragma unroll
  for (int i = 0; i < 4; ++i) {
    const float4 gg = *(const float4*)(g + i * 256 + lane * 4);
    uint2 o; o.x = cvtpk(v[i].x * inv * gg.x, v[i].y * inv * gg.y); o.y = cvtpk(v[i].z * inv * gg.z, v[i].w * inv * gg.w);
    *(uint2*)(H + i * 256 + lane * 4) = o;
  }
}
DI void p0_transpose_tile(const float* src, bf16_t* dst, int N, int kt, int nt, float* lds) {
  const int tid = TIDX & 255;
  const int k0 = kt * 64, n0 = nt * 64;
#pragma unroll
  for (int i = 0; i < 4; ++i) {
    const int row = (tid >> 4) + 16 * i, c4 = (tid & 15) * 4;
    const float4 v = *(const float4*)(src + (size_t)(k0 + row) * N + n0 + c4);
    lds[row * 65 + c4 + 0] = v.x; lds[row * 65 + c4 + 1] = v.y; lds[row * 65 + c4 + 2] = v.z; lds[row * 65 + c4 + 3] = v.w;
  }
  __syncthreads();
  const int n = tid >> 2, kc = (tid & 3) * 16;
  unsigned w[8];
#pragma unroll
  for (int j = 0; j < 8; ++j) w[j] = cvtpk(lds[(kc + 2 * j) * 65 + n], lds[(kc + 2 * j + 1) * 65 + n]);
  uint4* d = (uint4*)(dst + (size_t)(n0 + n) * 1024 + k0 + kc);
  d[0] = make_uint4(w[0], w[1], w[2], w[3]); d[1] = make_uint4(w[4], w[5], w[6], w[7]);
  __syncthreads();
}
DI void phase0(const Params& p, char* smem) {
  {
    bf16_t* BL = (bf16_t*)(p.ws + WS_BTL);
    for (int i = blockIdx.x * NT + TIDX; i < 2048 * 256; i += gridDim.x * NT) {
      const int n = i >> 8, k = i & 255;
      float v = 0.f;
      if (n < 1024) { if (k < 64) v = p.in[10][(size_t)k * 1024 + n]; }
      else if (k >= 64 && k < 128) v = p.in[12][(size_t)(k - 64) * 1024 + (n - 1024)];
      BL[i] = f2bf(v);
    }
  }
  constexpr int N_ROWS = MT / 8, N_TIN = 16 * 162 / 2, N_TSQ = 256 / 2;
  constexpr int N_ITEMS = N_ROWS + N_TIN + 3 * N_TSQ;
  const int half = TIDX >> 8;
  float* scr = (float*)smem + half * (64 * 65);
  for (int it = blockIdx.x; it < N_ITEMS; it += gridDim.x) {
    if (it < N_ROWS) { p0_rmsnorm_rows(p, it); continue; }
    int j = it - N_ROWS;
    if (j < N_TIN) { const int t = 2 * j + half; p0_transpose_tile(p.in[7], (bf16_t*)(p.ws + WS_WINT), NIN, t / 162, t % 162, scr); continue; }
    j -= N_TIN;
    const int w = j / N_TSQ; const int t = 2 * (j % N_TSQ) + half;
    p0_transpose_tile(p.in[18 + w], (bf16_t*)(p.ws + WS_WT) + (size_t)w * 1024 * 1024, 1024, t >> 4, t & 15, scr);
  }
}

struct EpiP1 {
  static constexpr bool PERM = true, AFTER_DRAIN = false;
  Params p;
  DI void operator()(const pg8::f32x4 (&acc)[2][2][4][2], const pg8::Unit& u, int wr, int wc, int fr, int fq) const {
    const int colt = u.pn * 256;
    const int region = colt >> 10;
#pragma unroll
    for (int ai = 0; ai < 2; ++ai)
#pragma unroll
      for (int m = 0; m < 4; ++m) {
        const int row = u.pm * 256 + ai * 128 + wr * 64 + m * 16 + fr;
        const bool prompt = row < MP;
        const int rs = row - MP;
#pragma unroll
        for (int bj = 0; bj < 2; ++bj) {
          const int col = colt + bj * 128 + wc * 32 + 8 * fq;
          const f32x4 v0 = acc[ai][bj][m][0], v1 = acc[ai][bj][m][1];
          if (region >= 6) {
            const int pc = col - 6144;
            if (pc < CSH) {
              *(uint4*)((bf16_t*)(p.ws + WS_PB) + (size_t)row * CSH + pc) = pack8(v0, v1);
              float* so = nullptr;
              if (prompt) { if ((row & 4095) == 4095) so = p.out + OUT_SHP + (size_t)(row >> 12) * CSH + pc; }
              else if ((rs & 15) == 15) so = p.out + OUT_SHS + (size_t)(rs >> 4) * CSH + pc;
              if (so) { *(f32x4*)so = v0; *(f32x4*)(so + 4) = v1; }
            }
          } else if (region == 0) {
            *(uint4*)((bf16_t*)(p.ws + WS_QB) + (size_t)row * 1024 + col) = pack8(v0 * QSCALE, v1 * QSCALE);
          } else if (region == 1) {
            const int c = col - 1024, hh = c >> 6, d = c & 63;
            float* o = prompt ? p.out + OUT_KP + (((size_t)(row >> 12) * 16 + hh) * 4096 + (row & 4095)) * 64 + d
                              : p.out + OUT_KS + (((size_t)(rs >> 4) * 16 + hh) * 16 + (rs & 15)) * 64 + d;
            *(f32x4*)o = v0; *(f32x4*)(o + 4) = v1;
          } else if (region == 2) {
            const int c = col - 2048, hh = c >> 6, d = c & 63;
            float* o = prompt ? p.out + OUT_VP + (((size_t)(row >> 12) * 16 + hh) * 4096 + (row & 4095)) * 64 + d
                              : p.out + OUT_VS + (((size_t)(rs >> 4) * 16 + hh) * 16 + (rs & 15)) * 64 + d;
            *(f32x4*)o = v0; *(f32x4*)(o + 4) = v1;
          } else if (region == 3) {
            f32x4 a, b;
#pragma unroll
            for (int j = 0; j < 4; ++j) { a[j] = v0[j] * sigmoidf_(v0[j]); b[j] = v1[j] * sigmoidf_(v1[j]); }
            *(uint4*)((bf16_t*)(p.ws + WS_SZA) + (size_t)row * 1024 + (col - 3072)) = pack8(a, b);
          } else {
            f32x4 a, b;
#pragma unroll
            for (int j = 0; j < 4; ++j) { a[j] = sigmoidf_(v0[j]); b[j] = sigmoidf_(v1[j]); }
            *(uint4*)((bf16_t*)p.out + (size_t)row * 2048 + (col - 4096)) = pack8(a, b);
          }
        }
      }
  }
};
struct EpiGate {
  static constexpr bool PERM = true, AFTER_DRAIN = false;
  Params p; int goff; bool first;
  DI void operator()(const pg8::f32x4 (&acc)[2][2][4][2], const pg8::Unit& u, int wr, int wc, int fr, int fq) const {
    const bf16_t* G = (const bf16_t*)p.out; bf16_t* MG = (bf16_t*)(p.ws + WS_MG);
#pragma unroll
    for (int ai = 0; ai < 2; ++ai)
#pragma unroll
      for (int m = 0; m < 4; ++m) {
        const size_t row = u.pm * 256 + ai * 128 + wr * 64 + m * 16 + fr;
#pragma unroll
        for (int bj = 0; bj < 2; ++bj) {
          const int col = u.pn * 256 + bj * 128 + wc * 32 + 8 * fq;
          const uint4 g = *(const uint4*)(G + row * 2048 + goff + col);
          f32x4 a = acc[ai][bj][m][0], b = acc[ai][bj][m][1];
          a[0] *= bflo(g.x); a[1] *= bfhi(g.x); a[2] *= bflo(g.y); a[3] *= bfhi(g.y);
          b[0] *= bflo(g.z); b[1] *= bfhi(g.z); b[2] *= bflo(g.w); b[3] *= bfhi(g.w);
          if (!first) {
            const uint4 o = *(const uint4*)(MG + row * 1024 + col);
            a[0] += bflo(o.x); a[1] += bfhi(o.x); a[2] += bflo(o.y); a[3] += bfhi(o.y);
            b[0] += bflo(o.z); b[1] += bfhi(o.z); b[2] += bflo(o.w); b[3] += bfhi(o.w);
          }
          *(uint4*)(MG + row * 1024 + col) = pack8(a, b);
        }
      }
  }
};
struct EpiOut {
  static constexpr bool PERM = true, AFTER_DRAIN = false;
  Params p;
  DI void operator()(const pg8::f32x4 (&acc)[2][2][4][2], const pg8::Unit& u, int wr, int wc, int fr, int fq) const {
#pragma unroll
    for (int ai = 0; ai < 2; ++ai)
#pragma unroll
      for (int m = 0; m < 4; ++m) {
        const int row = u.pm * 256 + ai * 128 + wr * 64 + m * 16 + fr;
        const float* xr = row < MP ? p.in[0] + (size_t)row * 1024 : p.in[1] + (size_t)(row - MP) * 1024;
        float* orow = p.out + OUT_YP + (size_t)row * 1024;
#pragma unroll
        for (int bj = 0; bj < 2; ++bj) {
          const int col = u.pn * 256 + bj * 128 + wc * 32 + 8 * fq;
          const f32x4 x0 = *(const f32x4*)(xr + col), x1 = *(const f32x4*)(xr + col + 4);
          *(f32x4*)(orow + col) = x0 + acc[ai][bj][m][0]; *(f32x4*)(orow + col + 4) = x1 + acc[ai][bj][m][1];
        }
      }
  }
};
template <class Epi>
DI void run_gemm(char* smem, const bf16_t* A, const bf16_t* Bt, int M, int N, const Epi& E, int K = 1024) {
  pg8::Gemm g; g.A = A; g.Bt = Bt; g.M = M; g.N = N; g.K = K;
  pg8::StaticOrder S; S.init(M, N, (int)gridDim.x, (int)blockIdx.x);
  pg8::gemm_phase<Epi, pg8::StaticOrder, true, true>((LAS unsigned char*)smem, g, S, E);
  __syncthreads();
}

template <int MODE>
DI void small_gemm(const Params& p, const bf16_t* A, const bf16_t* Bt) {
  const int lane = TIDX & 63, wid = TIDX >> 6, r = lane & 31, h = lane >> 5;
  for (int tile = wid * gridDim.x + blockIdx.x; tile < 512; tile += 8 * gridDim.x) {
    const int row0 = MP + (tile >> 5) * 32, col0 = (tile & 31) * 32;
    const bf16_t* pa = A + (size_t)(row0 + r) * 1024 + 8 * h;
    const bf16_t* pb = Bt + (size_t)(col0 + r) * 1024 + 8 * h;
    f32x16 acc;
#pragma unroll
    for (int i = 0; i < 16; ++i) acc[i] = 0.f;
#pragma unroll 8
    for (int s = 0; s < 64; ++s) acc = MFMA32(*(const bf16x8*)(pa + 16 * s), *(const bf16x8*)(pb + 16 * s), acc);
    const int col = col0 + r;
#pragma unroll
    for (int i = 0; i < 16; ++i) {
      const size_t row = row0 + crow(i, h);
      if (MODE == 2) p.out[OUT_YP + row * 1024 + col] = p.in[1][(row - MP) * 1024 + col] + acc[i];
      else {
        bf16_t* mg = (bf16_t*)(p.ws + WS_MG) + row * 1024 + col;
        const float g = bf2f(((const bf16_t*)p.out)[row * 2048 + (MODE == 1 ? 1024 : 0) + col]);
        *mg = f2bf((MODE == 1 ? bf2f(*mg) : 0.f) + acc[i] * g);
      }
    }
  }
}

DI float tanh_fast(float x) { return 1.f - 2.f / (1.f + __expf(2.f * x)); }
DI void phase_x(const Params& p) {
  const bf16_t* PB = (const bf16_t*)(p.ws + WS_PB);
  bf16_t* X = (bf16_t*)(p.ws + WS_X);
  const float* mu = p.in[8];
  for (int i = blockIdx.x * NT + TIDX; i < MT * 32; i += gridDim.x * NT) {
    const int row = i >> 5, g = i & 31;
    uint4 o = make_uint4(0u, 0u, 0u, 0u);
    if (g < 16) {
      const int col = 3072 + g * 8;
      const bool prompt = row < MP;
      const int t = prompt ? (row & 4095) : ((row - MP) & 15);
      const uint4 a = *(const uint4*)(PB + (size_t)row * CSH + col);
      float c[8] = {bflo(a.x), bfhi(a.x), bflo(a.y), bfhi(a.y), bflo(a.z), bfhi(a.z), bflo(a.w), bfhi(a.w)}, q[8];
      if (t != 0) { const uint4 b = *(const uint4*)(PB + (size_t)(row - 1) * CSH + col); q[0] = bflo(b.x); q[1] = bfhi(b.x); q[2] = bflo(b.y); q[3] = bfhi(b.y); q[4] = bflo(b.z); q[5] = bfhi(b.z); q[6] = bflo(b.w); q[7] = bfhi(b.w); }
      else if (prompt) {
#pragma unroll
        for (int j = 0; j < 8; ++j) q[j] = 0.f;
      } else { const float* s = p.in[4] + (size_t)((row - MP) >> 4) * CSH + col; const float4 b0 = *(const float4*)s, b1 = *(const float4*)(s + 4); q[0] = b0.x; q[1] = b0.y; q[2] = b0.z; q[3] = b0.w; q[4] = b1.x; q[5] = b1.y; q[6] = b1.z; q[7] = b1.w; }
      const float4 u0 = *(const float4*)(mu + col), u1 = *(const float4*)(mu + col + 4);
      const float u[8] = {u0.x, u0.y, u0.z, u0.w, u1.x, u1.y, u1.z, u1.w};
      float m[8];
#pragma unroll
      for (int j = 0; j < 8; ++j) { m[j] = c[j] + u[j] * (q[j] - c[j]); if (g < 8) m[j] = tanh_fast(m[j]); }
      o = make_uint4(cvtpk(m[0], m[1]), cvtpk(m[2], m[3]), cvtpk(m[4], m[5]), cvtpk(m[6], m[7]));
    }
    *(uint4*)(X + (size_t)row * 256 + g * 8) = o;
  }
}
struct EpiLora {
  static constexpr bool PERM = true, AFTER_DRAIN = false;
  Params p;
  DI void operator()(const pg8::f32x4 (&acc)[2][2][4][2], const pg8::Unit& u, int wr, int wc, int fr, int fq) const {
    const bool isw = u.pn < 4;
#pragma unroll
    for (int ai = 0; ai < 2; ++ai)
#pragma unroll
      for (int m = 0; m < 4; ++m) {
        const int row = u.pm * 256 + ai * 128 + wr * 64 + m * 16 + fr;
        const size_t hb = hm_base(row), hs = hm_hstride(row);
#pragma unroll
        for (int bj = 0; bj < 2; ++bj) {
          const int c = (u.pn & 3) * 256 + bj * 128 + wc * 32 + 8 * fq;
          const size_t idx = hb + (c >> 6) * hs + (c & 63);
          const f32x4 v0 = acc[ai][bj][m][0], v1 = acc[ai][bj][m][1];
          if (isw) {
            const f32x4 b0 = *(const f32x4*)(p.in[9] + c), b1 = *(const f32x4*)(p.in[9] + c + 4);
            f32x4 d0, d1;
#pragma unroll
            for (int j = 0; j < 4; ++j) {
              const float x0 = -(b0[j] + v0[j]), x1 = -(b1[j] + v1[j]);
              const float s0 = fmaxf(x0, 0.f) + __logf(1.f + __expf(-fabsf(x0))), s1 = fmaxf(x1, 0.f) + __logf(1.f + __expf(-fabsf(x1)));
              d0[j] = __expf(-__expf(-s0 - 0.5f)); d1[j] = __expf(-__expf(-s1 - 0.5f));
            }
            float* o = (float*)(p.ws + WS_SW) + idx; *(f32x4*)o = d0; *(f32x4*)(o + 4) = d1;
          } else {
            const f32x4 b0 = *(const f32x4*)(p.in[11] + c), b1 = *(const f32x4*)(p.in[11] + c + 4);
            f32x4 d0, d1;
#pragma unroll
            for (int j = 0; j < 4; ++j) { d0[j] = sigmoidf_(b0[j] + v0[j]); d1[j] = sigmoidf_(b1[j] + v1[j]); }
            *(uint4*)((bf16_t*)(p.ws + WS_SB) + idx) = pack8(d0, d1);
          }
        }
      }
  }
};
DI void phase1c(const Params& p) {
  const int tid = TIDX & 255, half = TIDX >> 8, c = tid * 4, hh = c >> 6;
  const bf16_t* PB = (const bf16_t*)(p.ws + WS_PB);
  const float* mu = p.in[8];
  const float4 kkw = *(const float4*)(p.in[13] + c), kaw = *(const float4*)(p.in[14] + c), rkw = *(const float4*)(p.in[15] + c);
  const float4 mur = *(const float4*)(mu + c), muk = *(const float4*)(mu + 1024 + c), muv = *(const float4*)(mu + 2048 + c), muz = *(const float4*)(mu + 3200 + c);
  const float kka[4] = {kkw.x, kkw.y, kkw.z, kkw.w}, kaa[4] = {kaw.x, kaw.y, kaw.z, kaw.w}, rka[4] = {rkw.x, rkw.y, rkw.z, rkw.w};
  const float mura[4] = {mur.x, mur.y, mur.z, mur.w}, muka[4] = {muk.x, muk.y, muk.z, muk.w}, muva[4] = {muv.x, muv.y, muv.z, muv.w}, muza[4] = {muz.x, muz.y, muz.z, muz.w};
  bf16_t* SR = (bf16_t*)(p.ws + WS_SR); bf16_t* SK = (bf16_t*)(p.ws + WS_SK); bf16_t* SV = (bf16_t*)(p.ws + WS_SV);
  bf16_t* SKK = (bf16_t*)(p.ws + WS_SKK); bf16_t* SB = (bf16_t*)(p.ws + WS_SB); bf16_t* SZB = (bf16_t*)(p.ws + WS_SZB);
  float* BONUS = (float*)(p.ws + WS_BONUS);
  for (int r4 = blockIdx.x * 2 + half; r4 < MT / 4; r4 += gridDim.x * 2) {
    const int row0 = r4 * 4;
    const bool prompt = row0 < MP;
    const int t0 = prompt ? (row0 & 4095) : ((row0 - MP) & 15);
    uint2 gr[5], gk[5], gv[5], gz[5], ga[4];
#pragma unroll
    for (int t = 0; t < 5; ++t) {
      const int rr_ = (t == 0 && t0 == 0) ? row0 : row0 + t - 1;
      const bf16_t* pc = PB + (size_t)rr_ * CSH;
      gr[t] = *(const uint2*)(pc + c); gk[t] = *(const uint2*)(pc + 1024 + c); gv[t] = *(const uint2*)(pc + 2048 + c); gz[t] = *(const uint2*)(pc + 3200 + c);
    }
    size_t idx[4];
#pragma unroll
    for (int t = 0; t < 4; ++t) { idx[t] = hm_base(row0 + t) + hh * hm_hstride(row0 + t) + (c & 63); ga[t] = *(const uint2*)(SB + idx[t]); }
    float pr[4], pk[4], pv[4], pz[4];
    if (t0 == 0) {
      if (prompt) {
#pragma unroll
        for (int x = 0; x < 4; ++x) { pr[x] = 0.f; pk[x] = 0.f; pv[x] = 0.f; pz[x] = 0.f; }
      } else {
        const float* s = p.in[4] + (size_t)((row0 - MP) >> 4) * CSH;
        const float4 a = *(const float4*)(s + c), b = *(const float4*)(s + 1024 + c), d = *(const float4*)(s + 2048 + c), e = *(const float4*)(s + 3200 + c);
        pr[0] = a.x; pr[1] = a.y; pr[2] = a.z; pr[3] = a.w; pk[0] = b.x; pk[1] = b.y; pk[2] = b.z; pk[3] = b.w;
        pv[0] = d.x; pv[1] = d.y; pv[2] = d.z; pv[3] = d.w; pz[0] = e.x; pz[1] = e.y; pz[2] = e.z; pz[3] = e.w;
      }
    } else {
      pr[0] = bflo(gr[0].x); pr[1] = bfhi(gr[0].x); pr[2] = bflo(gr[0].y); pr[3] = bfhi(gr[0].y);
      pk[0] = bflo(gk[0].x); pk[1] = bfhi(gk[0].x); pk[2] = bflo(gk[0].y); pk[3] = bfhi(gk[0].y);
      pv[0] = bflo(gv[0].x); pv[1] = bfhi(gv[0].x); pv[2] = bflo(gv[0].y); pv[3] = bfhi(gv[0].y);
      pz[0] = bflo(gz[0].x); pz[1] = bfhi(gz[0].x); pz[2] = bflo(gz[0].y); pz[3] = bfhi(gz[0].y);
    }
#pragma unroll
    for (int t = 0; t < 4; ++t) {
      const int row = row0 + t;
      const float curr[4] = {bflo(gr[t + 1].x), bfhi(gr[t + 1].x), bflo(gr[t + 1].y), bfhi(gr[t + 1].y)}, curk[4] = {bflo(gk[t + 1].x), bfhi(gk[t + 1].x), bflo(gk[t + 1].y), bfhi(gk[t + 1].y)};
      const float curv[4] = {bflo(gv[t + 1].x), bfhi(gv[t + 1].x), bflo(gv[t + 1].y), bfhi(gv[t + 1].y)}, curz[4] = {bflo(gz[t + 1].x), bfhi(gz[t + 1].x), bflo(gz[t + 1].y), bfhi(gz[t + 1].y)};
      const float av[4] = {bflo(ga[t].x), bfhi(ga[t].x), bflo(ga[t].y), bfhi(ga[t].y)};
      float rm[4], km[4], vm[4], kkv[4], bb[4], kmod[4], szb[4];
      float ssq = 0.f, bon = 0.f;
#pragma unroll
      for (int x = 0; x < 4; ++x) {
        rm[x] = curr[x] + mura[x] * (pr[x] - curr[x]);
        km[x] = curk[x] + muka[x] * (pk[x] - curk[x]);
        vm[x] = curv[x] + muva[x] * (pv[x] - curv[x]);
        const float zm = curz[x] + muza[x] * (pz[x] - curz[x]);
        szb[x] = zm * sigmoidf_(zm);
        kkv[x] = km[x] * kka[x];
        ssq += kkv[x] * kkv[x];
        kmod[x] = km[x] * (1.f + (av[x] - 1.f) * kaa[x]);
        bon += rm[x] * kmod[x] * rka[x];
        pr[x] = curr[x]; pk[x] = curk[x]; pv[x] = curv[x]; pz[x] = curz[x];
      }
      ssq = sum16(ssq); bon = sum16(bon);
      const float inv = 1.f / fmaxf(sqrtf(ssq), 1e-12f);
#pragma unroll
      for (int x = 0; x < 4; ++x) { kkv[x] *= inv; bb[x] = kkv[x] * av[x]; }
      *(uint2*)(SR + idx[t]) = make_uint2(cvtpk(rm[0], rm[1]), cvtpk(rm[2], rm[3]));
      *(uint2*)(SK + idx[t]) = make_uint2(cvtpk(kmod[0], kmod[1]), cvtpk(kmod[2], kmod[3]));
      *(uint2*)(SV + idx[t]) = make_uint2(cvtpk(vm[0], vm[1]), cvtpk(vm[2], vm[3]));
      *(uint2*)(SKK + idx[t]) = make_uint2(cvtpk(-kkv[0], -kkv[1]), cvtpk(-kkv[2], -kkv[3]));
      *(uint2*)(SB + idx[t]) = make_uint2(cvtpk(bb[0], bb[1]), cvtpk(bb[2], bb[3]));
      *(uint2*)(SZB + (size_t)row * 1024 + c) = make_uint2(cvtpk(szb[0], szb[1]), cvtpk(szb[2], szb[3]));
      if ((tid & 15) == 0) BONUS[(size_t)row * 16 + hh] = bon;
    }
  }
}

template <bool SAMPLE>
DI void attn_wave(const Params& p, int sh, int qt) {
  const int lane = TIDX & 63, r = lane & 31, h = lane >> 5;
  const int hh = sh & 15, b = sh >> 4;
  bf16_t* QB = (bf16_t*)(p.ws + WS_QB);
  const int row0 = SAMPLE ? MP + b * 16 : b * 4096 + qt * 32;
  bf16_t* Qp = QB + (size_t)row0 * 1024 + hh * 64;
  const int qrow = SAMPLE ? (r < 15 ? r : 15) : r;
  bf16x8 qf[4];
#pragma unroll
  for (int s = 0; s < 4; ++s) qf[s] = *(const bf16x8*)(Qp + (size_t)qrow * 1024 + 16 * s + 8 * h);
  f32x16 z0, z1;
#pragma unroll
  for (int i = 0; i < 16; ++i) { z0[i] = 0.f; z1[i] = 0.f; }
  float carry = 1.f;
  const int ntiles = SAMPLE ? 33 : qt + 1;
  for (int it = 0; it < ntiles; ++it) {
    const bool diag = (it == 0);
    const int kt = SAMPLE ? 32 - it : qt - it;
    bf16x8 kf[4];
    {
      const float* Kp;
      if (!SAMPLE) Kp = p.out + OUT_KP + ((size_t)sh * 4096 + kt * 32 + r) * 64;
      else Kp = diag ? p.out + OUT_KS + ((size_t)sh * 16 + (r < 15 ? r : 15)) * 64 : p.in[2] + ((size_t)sh * 1024 + kt * 32 + r) * 64;
#pragma unroll
      for (int s = 0; s < 4; ++s) {
        const float4 a = *(const float4*)(Kp + 16 * s + 8 * h), bq = *(const float4*)(Kp + 16 * s + 8 * h + 4);
        u32x4 w; w[0] = cvtpk(a.x, a.y); w[1] = cvtpk(a.z, a.w); w[2] = cvtpk(bq.x, bq.y); w[3] = cvtpk(bq.z, bq.w);
        kf[s] = __builtin_bit_cast(bf16x8, w);
      }
    }
    f32x16 st;
#pragma unroll
    for (int i = 0; i < 16; ++i) st[i] = 0.f;
#pragma unroll
    for (int s = 0; s < 4; ++s) st = MFMA32(kf[s], qf[s], st);
    float keep[16], wgt[16];
#pragma unroll
    for (int i = 0; i < 16; ++i) {
      const float e = __builtin_amdgcn_exp2f(st[i]);
      const float kp = __builtin_amdgcn_rcpf(1.f + e);
      bool valid = true;
      if (diag) { const int kr = crow(i, h); valid = SAMPLE ? (kr < r && kr < 16) : (kr < r); }
      keep[i] = valid ? kp : 1.f;
      wgt[i] = valid ? 1.f - kp : 0.f;
    }
    float pp[4], hif[4];
#pragma unroll
    for (int g = 0; g < 4; ++g) {
      const float p4 = (keep[4 * g] * keep[4 * g + 1]) * (keep[4 * g + 2] * keep[4 * g + 3]);
      const auto sw = __builtin_amdgcn_permlane32_swap(__float_as_uint(p4), __float_as_uint(p4), false, false);
      const float lo = __uint_as_float(sw[0]), hi = __uint_as_float(sw[1]);
      pp[g] = lo * hi;
      hif[g] = h ? 1.f : hi;
    }
    float T[4];
    T[3] = carry; T[2] = T[3] * pp[3]; T[1] = T[2] * pp[2]; T[0] = T[1] * pp[1];
    carry = T[0] * pp[0];
#pragma unroll
    for (int g = 0; g < 4; ++g) {
      const float w3 = T[g] * hif[g], w2 = w3 * keep[4 * g + 3], w1 = w2 * keep[4 * g + 2], w0 = w1 * keep[4 * g + 1];
      wgt[4 * g + 3] *= w3; wgt[4 * g + 2] *= w2; wgt[4 * g + 1] *= w1; wgt[4 * g] *= w0;
    }
#pragma unroll
    for (int s = 0; s < 2; ++s) {
      u32x4 pw;
#pragma unroll
      for (int j = 0; j < 4; ++j) pw[j] = cvtpk(wgt[8 * s + 2 * j], wgt[8 * s + 2 * j + 1]);
      const bf16x8 pf = __builtin_bit_cast(bf16x8, pw);
#pragma unroll
      for (int db = 0; db < 2; ++db) {
        bf16x8 vf;
        {
          float vv[8];
#pragma unroll
          for (int j = 0; j < 8; ++j) {
            const int kr = 16 * s + 8 * (j >> 2) + 4 * h + (j & 3);
            const float* vp;
            if (!SAMPLE) vp = p.out + OUT_VP + ((size_t)sh * 4096 + kt * 32 + kr) * 64;
            else vp = diag ? p.out + OUT_VS + ((size_t)sh * 16 + (kr < 15 ? kr : 15)) * 64 : p.in[3] + ((size_t)sh * 1024 + kt * 32 + kr) * 64;
            vv[j] = vp[db * 32 + r];
          }
          u32x4 w; w[0] = cvtpk(vv[0], vv[1]); w[1] = cvtpk(vv[2], vv[3]); w[2] = cvtpk(vv[4], vv[5]); w[3] = cvtpk(vv[6], vv[7]);
          vf = __builtin_bit_cast(bf16x8, w);
        }
        if (db == 0) z0 = MFMA32(pf, vf, z0); else z1 = MFMA32(pf, vf, z1);
      }
    }
    if (__ballot(carry != 0.f) == 0ull) break;
  }
  const bf16_t* SZA = (const bf16_t*)(p.ws + WS_SZA);
#pragma unroll
  for (int i = 0; i < 16; ++i) {
    const int q = crow(i, h);
    if (SAMPLE && q >= 16) continue;
    const size_t o = (size_t)(row0 + q) * 1024 + hh * 64 + r;
    QB[o] = f2bf(z0[i] * bf2f(SZA[o]));
    QB[o + 32] = f2bf(z1[i] * bf2f(SZA[o + 32]));
  }
}

DI float row16_sum(float x) {
  x += dppf<0xB1>(x); x += dppf<0x4E>(x); x += dppf<0x124>(x); x += dppf<0x128>(x);
  return x;
}
DI void scan_wave(const Params& p, int shg, int slice, float* L) {
  const int lane = TIDX & 63, cc = lane & 15;
  const bool prompt = shg < 64;
  const int T = prompt ? 4096 : 16;
  const size_t base = prompt ? (size_t)shg * 4096 * 64 : (size_t)MP * 1024 + (size_t)(shg - 64) * 16 * 64;
  const int v = slice * 4 + (lane >> 4);
  const float* SW = (const float*)(p.ws + WS_SW) + base;
  const bf16_t* SARR = (const bf16_t*)(p.ws + WS_SR) + base;
  float* ORAW = (float*)(p.ws + WS_ORAW) + base;
  float4 S;
  float* wout;
  if (prompt) { S = make_float4(0.f, 0.f, 0.f, 0.f); wout = p.out + OUT_WP + ((size_t)shg * 64 + v) * 64 + 4 * cc; }
  else { S = *(const float4*)(p.in[5] + ((size_t)(shg - 64) * 64 + v) * 64 + 4 * cc); wout = p.out + OUT_WS + ((size_t)(shg - 64) * 64 + v) * 64 + 4 * cc; }
  const int nch = T / 8;
  const int dw0 = ((lane >> 4) * 6 + 2) * 64 + (lane & 15) * 4, dw1 = dw0 + 4 * 384;
  const int db = (lane >> 3) * 384 + (lane & 7) * 8;
  uint4 gw0, gw1, gr, gk, gv, gn, gb;
#define SCAN_GLOAD(ch) do { const float* w_ = SW + (size_t)(ch) * 512; gw0 = *(const uint4*)(w_ + lane * 4); gw1 = *(const uint4*)(w_ + 256 + lane * 4); \
    const bf16_t* a_ = SARR + (size_t)(ch) * 512 + lane * 8; gr = *(const uint4*)a_; gk = *(const uint4*)(a_ + SZ_ACT / 2); gv = *(const uint4*)(a_ + 2 * (SZ_ACT / 2)); \
    gn = *(const uint4*)(a_ + 3 * (SZ_ACT / 2)); gb = *(const uint4*)(a_ + 4 * (SZ_ACT / 2)); } while (0)
#define SCAN_PUT(slot, g) do { float* d_ = L + db + (slot) * 64; *(float4*)d_ = make_float4(bflo(g.x), bfhi(g.x), bflo(g.y), bfhi(g.y)); *(float4*)(d_ + 4) = make_float4(bflo(g.z), bfhi(g.z), bflo(g.w), bfhi(g.w)); } while (0)
#define SCAN_LSTORE() do { *(uint4*)(L + dw0) = gw0; *(uint4*)(L + dw1) = gw1; SCAN_PUT(4, gr); SCAN_PUT(3, gk); SCAN_PUT(5, gv); SCAN_PUT(0, gn); SCAN_PUT(1, gb); \
    asm volatile("s_waitcnt lgkmcnt(0)" ::: "memory"); } while (0)
  SCAN_GLOAD(0);
  asm volatile("s_waitcnt lgkmcnt(0)" ::: "memory");
  SCAN_LSTORE();
  for (int ch = 0; ch < nch; ++ch) {
    if (ch + 1 < nch) SCAN_GLOAD(ch + 1);
    float okeep = 0.f;
    const float* Lc = L + 4 * cc;
    float4 nk = *(const float4*)(Lc), bb = *(const float4*)(Lc + 64), ww = *(const float4*)(Lc + 128), kv = *(const float4*)(Lc + 192), rr = *(const float4*)(Lc + 256);
    float vt = L[320 + v];
#pragma unroll 4
    for (int st = 0; st < 8; ++st) {
      const int sn = ((st + 1) & 7) * 384;
      const float4 nk2 = *(const float4*)(Lc + sn), bb2 = *(const float4*)(Lc + sn + 64), ww2 = *(const float4*)(Lc + sn + 128);
      const float4 kv2 = *(const float4*)(Lc + sn + 192), rr2 = *(const float4*)(Lc + sn + 256);
      const float vt2 = L[sn + 320 + v];
      float d = (S.x * nk.x + S.y * nk.y) + (S.z * nk.z + S.w * nk.w);
      const float sa = row16_sum(d);
      S.x = S.x * ww.x + (sa * bb.x + vt * kv.x);
      S.y = S.y * ww.y + (sa * bb.y + vt * kv.y);
      S.z = S.z * ww.z + (sa * bb.z + vt * kv.z);
      S.w = S.w * ww.w + (sa * bb.w + vt * kv.w);
      float o = (S.x * rr.x + S.y * rr.y) + (S.z * rr.z + S.w * rr.w);
      o = row16_sum(o);
      okeep = (cc == st) ? o : okeep;
      nk = nk2; bb = bb2; ww = ww2; kv = kv2; rr = rr2; vt = vt2;
    }
    if (cc < 8) ORAW[(size_t)(ch * 8 + cc) * 64 + v] = okeep;
    asm volatile("s_waitcnt lgkmcnt(0)" ::: "memory");
    if (ch + 1 < nch) SCAN_LSTORE();
  }
  *(float4*)wout = S;
#undef SCAN_GLOAD
#undef SCAN_PUT
#undef SCAN_LSTORE
}

DI void sgroup_barrier(volatile LAS unsigned* cnt, unsigned target) {
  asm volatile("s_waitcnt lgkmcnt(0)" ::: "memory");
  if ((TIDX & 63) == 0) __hip_atomic_fetch_add((LAS unsigned*)cnt, 1u, __ATOMIC_RELAXED, __HIP_MEMORY_SCOPE_WORKGROUP);
  while (*cnt < target) __builtin_amdgcn_s_sleep(1);
  asm volatile("" ::: "memory");
}
DI void scan_group(const Params& p, int sh, int quarter, float* lds, volatile LAS unsigned* cnt, unsigned& nbar) {
  const int tid = TIDX & 255, lane = tid & 63, wid = tid >> 6, cc = lane & 15;
  const size_t base = (size_t)sh * 4096 * 64;
  const int v = quarter * 16 + wid * 4 + (lane >> 4);
  const float* SW = (const float*)(p.ws + WS_SW) + base;
  const bf16_t* SARR = (const bf16_t*)(p.ws + WS_SR) + base;
  float* ORAW = (float*)(p.ws + WS_ORAW) + base;
  f32x2 S01 = {0.f, 0.f}, S23 = {0.f, 0.f};
  const bool b0 = (lane & 1) != 0, b1 = (lane & 2) != 0;
  float4 gw; uint4 gb0, gb1, gb2;
  const int dstw = ((tid >> 4) * 6 + 2) * 64 + (tid & 15) * 4;
  const bf16_t* sb0; const bf16_t* sb1; const bf16_t* sb2; int db0, db1, db2;
  { const int idx = tid, arr = idx >> 7, c = idx & 127, slot = arr == 0 ? 4 : 3; sb0 = SARR + (size_t)arr * (SZ_ACT / 2) + c * 8; db0 = ((c >> 3) * 6 + slot) * 64 + (c & 7) * 8; }
  { const int idx = tid + 256, arr = idx >> 7, c = idx & 127, slot = arr == 2 ? 5 : 0; sb1 = SARR + (size_t)arr * (SZ_ACT / 2) + c * 8; db1 = ((c >> 3) * 6 + slot) * 64 + (c & 7) * 8; }
  { const int idx = (tid & 127) + 512, arr = 4, c = idx & 127; sb2 = SARR + (size_t)arr * (SZ_ACT / 2) + c * 8; db2 = ((c >> 3) * 6 + 1) * 64 + (c & 7) * 8; }
#define SG_GLOAD(ch) do { gw = *(const float4*)(SW + (size_t)(ch) * 1024 + tid * 4); gb0 = *(const uint4*)(sb0 + (size_t)(ch) * 1024); gb1 = *(const uint4*)(sb1 + (size_t)(ch) * 1024); \
    if (tid < 128) gb2 = *(const uint4*)(sb2 + (size_t)(ch) * 1024); } while (0)
#define SG_PUT(d_, g) do { *(float4*)(d_) = make_float4(bflo(g.x), bfhi(g.x), bflo(g.y), bfhi(g.y)); *(float4*)((d_) + 4) = make_float4(bflo(g.z), bfhi(g.z), bflo(g.w), bfhi(g.w)); } while (0)
#define SG_LSTORE(buf) do { float* L_ = lds + (buf) * (16 * 384); *(float4*)(L_ + dstw) = gw; SG_PUT(L_ + db0, gb0); SG_PUT(L_ + db1, gb1); if (tid < 128) SG_PUT(L_ + db2, gb2); } while (0)
  SG_GLOAD(0); SG_LSTORE(0); sgroup_barrier(cnt, 4u * (++nbar));
  for (int ch = 0; ch < 256; ++ch) {
    if (ch + 1 < 256) SG_GLOAD(ch + 1);
    const float* L = lds + (ch & 1) * (16 * 384);
    float okeep = 0.f;
    const float* Lc = L + 4 * cc;
    f32x4 nk = *(const f32x4*)(Lc), bb = *(const f32x4*)(Lc + 64), ww = *(const f32x4*)(Lc + 128), kv = *(const f32x4*)(Lc + 192), rr = *(const f32x4*)(Lc + 256);
    float vt = L[320 + v];
    f32x4 rrp = rr;
    float po[4];
#pragma unroll
    for (int st = 0; st <= 16; ++st) {
      if (st > 0) { const f32x2 o2 = S01 * rrp.xy + S23 * rrp.zw; po[(st - 1) & 3] = o2.x + o2.y; }
      if (st > 0 && (st & 3) == 0) {
        const float u0 = (b0 ? po[1] : po[0]) + dppf<0xB1>(b0 ? po[0] : po[1]);
        const float u1 = (b0 ? po[3] : po[2]) + dppf<0xB1>(b0 ? po[2] : po[3]);
        float w = (b1 ? u1 : u0) + dppf<0x4E>(b1 ? u0 : u1);
        w += dppf<0x124>(w); w += dppf<0x128>(w);
        okeep = ((cc >> 2) == (st >> 2) - 1) ? w : okeep;
      }
      if (st < 16) {
        const int sn = ((st + 1) & 15) * 384;
        const f32x2 d2 = S01 * nk.xy + S23 * nk.zw;
        float x = d2.x + d2.y;
        const f32x2 vt_2 = {vt, vt};
        const f32x2 t01 = vt_2 * kv.xy, t23 = vt_2 * kv.zw;
        __builtin_amdgcn_sched_barrier(0);
        x += dppf<0xB1>(x);
        const f32x4 nk2 = *(const f32x4*)(Lc + sn), bb2 = *(const f32x4*)(Lc + sn + 64);
        __builtin_amdgcn_sched_barrier(0);
        x += dppf<0x4E>(x);
        const f32x4 ww2 = *(const f32x4*)(Lc + sn + 128), kv2 = *(const f32x4*)(Lc + sn + 192);
        __builtin_amdgcn_sched_barrier(0);
        x += dppf<0x124>(x);
        const f32x4 rr2 = *(const f32x4*)(Lc + sn + 256);
        const float vt2 = L[sn + 320 + v];
        __builtin_amdgcn_sched_barrier(0);
        x += dppf<0x128>(x);
        __builtin_amdgcn_sched_barrier(0);
        const f32x2 sa2 = {x, x};
        S01 = S01 * ww.xy + (sa2 * bb.xy + t01);
        S23 = S23 * ww.zw + (sa2 * bb.zw + t23);
        rrp = rr;
        nk = nk2; bb = bb2; ww = ww2; kv = kv2; rr = rr2; vt = vt2;
      }
    }
    ORAW[(size_t)(ch * 16 + cc) * 64 + v] = okeep;
    if (ch + 1 < 256) SG_LSTORE((ch + 1) & 1);
    sgroup_barrier(cnt, 4u * (++nbar));
  }
  *(float4*)(p.out + OUT_WP + ((size_t)sh * 64 + v) * 64 + 4 * cc) = make_float4(S01.x, S01.y, S23.x, S23.y);
#undef SG_GLOAD
#undef SG_PUT
#undef SG_LSTORE
}

constexpr int NQ_ATT_P = 8192, NQ_ATT_S = 512, NQ_SCAN_S = 8192, NQ_DYN = NQ_ATT_P + NQ_ATT_S + NQ_SCAN_S;
DI int wave_grab(unsigned* ctr) { int v = 0; if ((TIDX & 63) == 0) v = (int)atomicAdd(ctr, 1u); return __builtin_amdgcn_readfirstlane(v); }
DI void phase2(const Params& p, char* smem) {
  __shared__ unsigned s_cnt;
  unsigned* ctl = (unsigned*)(p.ws + WS_CTL);
  const int wid = TIDX >> 6;
  if (TIDX == 0) s_cnt = 0u;
  __syncthreads();
  float* L = (float*)smem + wid * (8 * 384);
  if (wid < 4) {
    unsigned nbar = 0;
    __builtin_amdgcn_s_setprio(3);
    for (int bu = blockIdx.x; bu < 256; bu += gridDim.x) scan_group(p, bu >> 2, bu & 3, (float*)smem + 8 * 8 * 384, (volatile LAS unsigned*)&s_cnt, nbar);
    __builtin_amdgcn_s_setprio(0);
  }
  for (;;) {
    int u = wave_grab(&ctl[0]);
    if (u >= NQ_DYN) break;
    if (u < NQ_ATT_P) { attn_wave<false>(p, u >> 7, u & 127); continue; }
    u -= NQ_ATT_P;
    if (u < NQ_ATT_S) { attn_wave<true>(p, u, 0); continue; }
    u -= NQ_ATT_S;
    scan_wave(p, 64 + (u >> 4), u & 15, L);
  }
}

DI void phase2c(const Params& p) {
  const int tid = TIDX & 255, half = TIDX >> 8, c = tid * 4, hh = c >> 6;
  const float4 lg = *(const float4*)(p.in[16] + c), lb = *(const float4*)(p.in[17] + c);
  const float* ORAW = (const float*)(p.ws + WS_ORAW); const bf16_t* SV = (const bf16_t*)(p.ws + WS_SV);
  const bf16_t* SZB = (const bf16_t*)(p.ws + WS_SZB); const float* BONUS = (const float*)(p.ws + WS_BONUS);
  bf16_t* OB = (bf16_t*)(p.ws + WS_OB);
  for (int row = blockIdx.x * 2 + half; row < MT; row += gridDim.x * 2) {
    const size_t idx = hm_base(row) + hh * hm_hstride(row) + (c & 63);
    const float4 o = *(const float4*)(ORAW + idx);
    const float mean = sum16((o.x + o.y) + (o.z + o.w)) * (1.f / 64.f);
    const float dx = o.x - mean, dy = o.y - mean, dz = o.z - mean, dw = o.w - mean;
    const float var = sum16((dx * dx + dy * dy) + (dz * dz + dw * dw)) * (1.f / 64.f);
    const float inv = rsqrtf(var + LNX_EPS);
    const float bon = BONUS[(size_t)row * 16 + hh];
    const uint2 vv = *(const uint2*)(SV + idx), zz = *(const uint2*)(SZB + (size_t)row * 1024 + c);
    const float r0 = (dx * inv * lg.x + lb.x + bon * bflo(vv.x)) * bflo(zz.x);
    const float r1 = (dy * inv * lg.y + lb.y + bon * bfhi(vv.x)) * bfhi(zz.x);
    const float r2 = (dz * inv * lg.z + lb.z + bon * bflo(vv.y)) * bflo(zz.y);
    const float r3 = (dw * inv * lg.w + lb.w + bon * bfhi(vv.y)) * bfhi(zz.y);
    *(uint2*)(OB + (size_t)row * 1024 + c) = make_uint2(cvtpk(r0, r1), cvtpk(r2, r3));
  }
}

DI void phase4(const Params& p) {
  const int lane = TIDX & 63, wid = TIDX >> 6;
  const float* g = p.in[21];
  for (int row = blockIdx.x * 8 + wid; row < MT; row += gridDim.x * 8) {
    float* x = p.out + OUT_YP + (size_t)row * 1024;
    float4 v[4]; float ss = 0.f;
#pragma unroll
    for (int i = 0; i < 4; ++i) { v[i] = *(const float4*)(x + i * 256 + lane * 4); ss += v[i].x * v[i].x + v[i].y * v[i].y + v[i].z * v[i].z + v[i].w * v[i].w; }
    ss = wave_sum(ss);
    const float inv = rsqrtf(ss * (1.f / DM) + EPS);
#pragma unroll
    for (int i = 0; i < 4; ++i) {
      const float4 gg = *(const float4*)(g + i * 256 + lane * 4);
      *(float4*)(x + i * 256 + lane * 4) = make_float4(v[i].x * inv * gg.x, v[i].y * inv * gg.y, v[i].z * inv * gg.z, v[i].w * inv * gg.w);
    }
  }
}

#define XB_TMO      128
#define XB_XCNT(j)  (256  + 64 * (j))
#define XB_XSUB(j)  (1280 + 64 * (j))
#define XB_XGEN(j)  (2304 + 64 * (j))
#define XB_TOP      3328
#define XB_TOPGEN   3392
#define XCD_BAR_WORDS 3456
#define XB_SPIN_CAP (1u << 18)

__device__ __forceinline__ unsigned xb_ld(unsigned* p)              { return __hip_atomic_load(p, __ATOMIC_RELAXED, __HIP_MEMORY_SCOPE_AGENT); }
__device__ __forceinline__ unsigned xb_add(unsigned* p, unsigned v) { return __hip_atomic_fetch_add(p, v, __ATOMIC_RELAXED, __HIP_MEMORY_SCOPE_AGENT); }
__device__ __forceinline__ unsigned xb_xcc_id() { return (unsigned)__builtin_amdgcn_s_getreg((3 << 11) | 20) & 0xFu; }
#define XB_SPIN(cond, bar) do { unsigned _sp = 0; while (cond) { __builtin_amdgcn_s_sleep(1); \
    if ((++_sp & 255u) == 0u) { if (xb_ld(&(bar)[XB_TMO])) break; if (_sp > XB_SPIN_CAP) { atomicAdd(&(bar)[XB_TMO], 1u); break; } } } } while (0)

struct XcdBarrier {
    unsigned* bar; unsigned x;
    volatile LAS unsigned* st;
};

__device__ __forceinline__ XcdBarrier xcd_barrier_post(unsigned* bar, volatile LAS unsigned* st) {
    XcdBarrier b; b.bar = bar; b.x = xb_xcc_id(); b.st = st;
    if (TIDX == 0) (void)xb_add(&bar[XB_XCNT(b.x)], 1u);
    return b;
}
__device__ __forceinline__ void xcd_barrier_complete(unsigned* bar, unsigned x, unsigned& nloc, unsigned& nx) {
    const unsigned G = gridDim.x * gridDim.y * gridDim.z;
    unsigned sum, cnt, mine, sp = 0u;
    for (;;) {
        sum = 0u; cnt = 0u; mine = 0u;
#pragma unroll
        for (unsigned j = 0; j < 16; ++j) { const unsigned c = xb_ld(&bar[XB_XCNT(j)]); sum += c; cnt += (c > 0u) ? 1u : 0u; mine = (j == x) ? c : mine; }
        if (sum == G) break;
        __builtin_amdgcn_s_sleep(1);
        if ((++sp & 255u) == 0u) { if (xb_ld(&bar[XB_TMO])) break; if (sp > XB_SPIN_CAP) { atomicAdd(&bar[XB_TMO], 1u); break; } }
    }
    nloc = mine > 0u ? mine : 1u; nx = cnt > 0u ? cnt : 1u;
}

__device__ __forceinline__ void xcd_barrier(const XcdBarrier& b) {
    asm volatile("s_waitcnt vmcnt(0)" ::: "memory");
    __syncthreads();
    if (TIDX == 0) {
        unsigned* bar = b.bar;
        __builtin_amdgcn_s_waitcnt(0);
        unsigned nloc = b.st[0], nx = b.st[1];
        if (nloc == 0u) { xcd_barrier_complete(bar, b.x, nloc, nx); b.st[0] = nloc; b.st[1] = nx; }
        const unsigned old = xb_add(&bar[XB_XSUB(b.x)], 1u);
        const unsigned gen = old / nloc;
        if (old + 1u == (gen + 1u) * nloc) {
            __builtin_amdgcn_fence(__ATOMIC_RELEASE, "agent");
            asm volatile("s_waitcnt vmcnt(0)" ::: "memory");
            const unsigned og = xb_add(&bar[XB_TOP], 1u);
            const unsigned tg = og / nx;
            if (og + 1u == (tg + 1u) * nx) xb_add(&bar[XB_TOPGEN], 1u);
            else XB_SPIN(xb_ld(&bar[XB_TOPGEN]) == tg, bar);
            __builtin_amdgcn_fence(__ATOMIC_ACQUIRE, "agent");
            xb_add(&bar[XB_XGEN(b.x)], 1u);
            asm volatile("s_waitcnt vmcnt(0)" ::: "memory");
        } else {
            XB_SPIN(xb_ld(&bar[XB_XGEN(b.x)]) == gen, bar);
            __builtin_amdgcn_fence(__ATOMIC_ACQUIRE, "agent");
            asm volatile("s_waitcnt vmcnt(0)" ::: "memory");
        }
    }
    __syncthreads();
}

__global__ void __launch_bounds__(NT, 2) mega(Params p) {
  extern __shared__ __attribute__((aligned(16))) char smem[];
  cg::grid_group grid = cg::this_grid();
  if (blockIdx.x == 0) { unsigned* ctl = (unsigned*)(p.ws + WS_CTL); for (int i = TIDX; i < 16384; i += NT) ctl[i] = 0u; }
  grid.sync();
  __shared__ unsigned xb_st[2];
  if (TIDX == 0) { xb_st[0] = 0u; xb_st[1] = 0u; }
  __syncthreads();
  (void)xcd_barrier_post((unsigned*)(p.ws + WS_CTL) + 8192, (volatile LAS unsigned*)xb_st);
#define XBAR() do { XcdBarrier xb_; xb_.bar = (unsigned*)(p.ws + WS_CTL) + 8192; xb_.x = xb_xcc_id(); xb_.st = (volatile LAS unsigned*)xb_st; xcd_barrier(xb_); } while (0)
  phase0(p, smem);
  XBAR();
  { EpiP1 E; E.p = p; run_gemm(smem, (const bf16_t*)(p.ws + WS_H), (const bf16_t*)(p.ws + WS_WINT), MT, NINP, E); }
  XBAR();
  phase_x(p);
  XBAR();
  { EpiLora E; E.p = p; run_gemm(smem, (const bf16_t*)(p.ws + WS_X), (const bf16_t*)(p.ws + WS_BTL), MT, 2048, E, 256); }
  XBAR();
  phase1c(p);
  XBAR();
  phase2(p, smem);
  XBAR();
  phase2c(p);
  XBAR();
  { EpiGate E; E.p = p; E.goff = 0; E.first = true; run_gemm(smem, (const bf16_t*)(p.ws + WS_QB), (const bf16_t*)(p.ws + WS_WT), MP, 1024, E); }
  small_gemm<0>(p, (const bf16_t*)(p.ws + WS_QB), (const bf16_t*)(p.ws + WS_WT));
  { EpiGate E; E.p = p; E.goff = 1024; E.first = false; run_gemm(smem, (const bf16_t*)(p.ws + WS_OB), (const bf16_t*)(p.ws + WS_WT) + (size_t)1024 * 1024, MP, 1024, E); }
  small_gemm<1>(p, (const bf16_t*)(p.ws + WS_OB), (const bf16_t*)(p.ws + WS_WT) + (size_t)1024 * 1024);
  XBAR();
  { EpiOut E; E.p = p; run_gemm(smem, (const bf16_t*)(p.ws + WS_MG), (const bf16_t*)(p.ws + WS_WT) + (size_t)2 * 1024 * 1024, MP, 1024, E); }
  small_gemm<2>(p, (const bf16_t*)(p.ws + WS_MG), (const bf16_t*)(p.ws + WS_WT) + (size_t)2 * 1024 * 1024);
  XBAR();
  phase4(p);
}

extern "C" void kernel_launch(void* const* d_in, const int* in_sizes, int n_in, void* d_out, int out_size, void* d_ws, size_t ws_size, hipStream_t stream) {
  static int grid_blocks = 0;
  if (grid_blocks == 0) {
    if (n_in != 22 || ws_size < WS_END) { fprintf(stderr, "kernel_launch: unexpected n_in %d / ws_size %zu (need %zu)\n", n_in, ws_size, (size_t)WS_END); grid_blocks = -1; return; }
    int dev = 0, cus = 0, per_cu = 0;
    (void)hipGetDevice(&dev);
    (void)hipDeviceGetAttribute(&cus, hipDeviceAttributeMultiprocessorCount, dev);
    (void)hipFuncSetAttribute((const void*)mega, hipFuncAttributeMaxDynamicSharedMemorySize, SMEM_BYTES);
    (void)hipOccupancyMaxActiveBlocksPerMultiprocessor(&per_cu, (const void*)mega, NT, SMEM_BYTES);
    (void)hipGetLastError();
    grid_blocks = cus;
  }
  if (grid_blocks < 0) return;
  Params p{};
  for (int i = 0; i < 22; ++i) p.in[i] = (const float*)d_in[i];
  p.out = (float*)d_out; p.ws = (unsigned char*)d_ws;
  void* args[] = {&p};
  hipError_t e = hipLaunchCooperativeKernel((const void*)mega, dim3(grid_blocks), dim3(NT), args, SMEM_BYTES, stream);
  if (e != hipSuccess) fprintf(stderr, "cooperative launch failed: %s (grid %d)\n", hipGetErrorString(e), grid_blocks);
}
```

```cpp
#include <hip/hip_runtime.h>
#include <hip/hip_cooperative_groups.h>
#include <cstdio>
#include <cstdint>
namespace cg = cooperative_groups;
__device__ __forceinline__ int lane_id_() { return (int)__builtin_amdgcn_mbcnt_hi(~0u, __builtin_amdgcn_mbcnt_lo(~0u, 0u)); }
#define TIDX (__builtin_amdgcn_readfirstlane((int)(threadIdx.x >> 6)) * 64 + lane_id_())

namespace pg8 {
#define PG8_LAS __attribute__((address_space(3)))
typedef unsigned short bf16_t;
typedef short bf16x8 __attribute__((ext_vector_type(8)));
typedef float f32x4 __attribute__((ext_vector_type(4)));
typedef unsigned u32x4 __attribute__((ext_vector_type(4)));
constexpr int BM = 256, BK = 64, HALF = 128, HTB = HALF * BK * 2  , STAGE_BYTES = 8 * HTB, NXCD = 8, WGM = 8;

__host__ __device__ __forceinline__ int lds_byte(int r, int c) { const int st = (r >> 4) * 2 + (c >> 5), rr = r & 15, cc = c & 31, ob = rr * 64 + cc * 2; return st * 1024 + (ob ^ (((ob >> 9) & 1) << 5)); }
__host__ __device__ __forceinline__ void stage_rc(int b, int& R, int& C) { const int st = b / 1024, sb = b % 1024, swz = sb ^ (((sb >> 9) & 1) << 5); R = (st >> 1) * 16 + swz / 64; C = (st & 1) * 32 + (swz % 64) / 2; }
__host__ __device__ __forceinline__ int perm32(int rho) { const int n = rho >> 4, i = rho & 15; return 8 * (i >> 2) + 4 * n + (i & 3); }

struct Unit { int pm, pn; };
struct Gemm { const bf16_t* A; const bf16_t* Bt; int M, N, K; };

struct StaticOrder {
    int nM, nN, nwg, G, c;
    __host__ __device__ void init(int M, int N, int G_, int c_) { nM = M / BM; nN = N / BM; nwg = nM * nN; G = G_; c = c_; }
    __host__ __device__ bool next(int i, Unit& u) const {
        const long L = (long)i * G + c; if (L >= nwg) return false;
        int wgid = (int)L; { const int q = nwg / NXCD, r = nwg % NXCD, xcd = wgid % NXCD, off = wgid / NXCD; wgid = (xcd < r ? xcd * (q + 1) : r * (q + 1) + (xcd - r) * q) + off; }
        const int nig = WGM * nN, gid = wgid / nig, fm = gid * WGM, gsz = (nM - fm) < WGM ? (nM - fm) : WGM;
        u.pm = fm + ((wgid % nig) % gsz); u.pn = (wgid % nig) / gsz; return true;
    }
    __device__ __forceinline__ void a_ready(const Unit&) const {}
    __device__ __forceinline__ void done(const Unit&) const {}
};


template <class Epi, class Sched, bool ALIGN_EPI = false, bool SP2 = false>
__device__ __forceinline__ void gemm_phase(PG8_LAS unsigned char* lds, const Gemm g, const Sched& S, const Epi& E) {
    int tid_ = TIDX; asm volatile("" : "+v"(tid_));
    const int tid = tid_, wid = __builtin_amdgcn_readfirstlane(tid >> 6), lane = tid & 63, wr = wid >> 2, wc = wid & 3, fr = lane & 15, fq = lane >> 4;
    const int K = g.K, nt = K / BK;
    unsigned voffA[2], voffB[2];
#pragma unroll
    for (int i = 0; i < 2; ++i) { int R, C; stage_rc(tid * 16 + i * 8192, R, C); const int Rb = Epi::PERM ? ((R & ~31) + perm32(R & 31)) : R;
        voffA[i] = (unsigned)(R * K + C) * 2u; voffB[i] = (unsigned)(Rb * K + C) * 2u; }
    const size_t kstep = (size_t)(BK * 2);
    const size_t hstep = (size_t)HALF * K * 2;
    const size_t tstep = 2 * hstep;
    const unsigned ldsw = (unsigned)wid * 1024u;
    const int aoff = lds_byte(wr * 64 + fr, fq * 8), boff = lds_byte(wc * 32 + fr, fq * 8);
#define PG8_SA(b, h) (((b) * 2 + (h)) * HTB)
#define PG8_SB(b, h) ((4 + (b) * 2 + (h)) * HTB)
#define PG8_STAGE(bufoff, gbase, voff) do { _Pragma("unroll") for (int _i = 0; _i < 2; ++_i) \
        __builtin_amdgcn_global_load_lds((const unsigned*)((const char*)(gbase) + (voff)[_i]), (PG8_LAS unsigned*)(lds + (bufoff) + ldsw + _i * 8192), 16, 0, 0); } while (0)
#define PG8_LDA(dst, b, h) do { _Pragma("unroll") for (int m = 0; m < 4; ++m) _Pragma("unroll") for (int k = 0; k < 2; ++k) dst[m][k] = *(const PG8_LAS bf16x8*)(lds + PG8_SA(b, h) + aoff + m * 2048 + k * 1024); } while (0)
#define PG8_LDB(dst, b, h) do { _Pragma("unroll") for (int n = 0; n < 2; ++n) _Pragma("unroll") for (int k = 0; k < 2; ++k) dst[n][k] = *(const PG8_LAS bf16x8*)(lds + PG8_SB(b, h) + boff + n * 2048 + k * 1024); } while (0)
#define PG8_MMA(ai, bj, At, Bt) do { __builtin_amdgcn_s_setprio(1); _Pragma("unroll") for (int m = 0; m < 4; ++m) _Pragma("unroll") for (int n = 0; n < 2; ++n) _Pragma("unroll") for (int k = 0; k < 2; ++k) \
        acc[ai][bj][m][n] = __builtin_amdgcn_mfma_f32_16x16x32_bf16(Bt[n][k], At[m][k], acc[ai][bj][m][n], 0, 0, 0); __builtin_amdgcn_s_setprio(0); } while (0)
#define PG8_WAIT_V(n) asm volatile("s_waitcnt vmcnt(" #n ")" ::: "memory")
#define PG8_WAIT_L(n) asm volatile("s_waitcnt lgkmcnt(" #n ")" ::: "memory")
#define PG8_BAR __builtin_amdgcn_s_barrier()
#define PG8_SCHED __builtin_amdgcn_sched_barrier(0)
    Unit cur, nxt; int ui = 0;
    if (!S.next(0, cur)) return;
    f32x4 acc[2][2][4][2];
#pragma unroll
    for (int a = 0; a < 2; ++a)
#pragma unroll
        for (int b = 0; b < 2; ++b)
#pragma unroll
            for (int m = 0; m < 4; ++m)
#pragma unroll
                for (int n = 0; n < 2; ++n) acc[a][b][m][n] = (f32x4){0.f, 0.f, 0.f, 0.f};
    bf16x8 At[4][2], B0[2][2], B1[2][2];
    const char* cA = (const char*)g.A + (size_t)cur.pm * tstep; const char* cB = (const char*)g.Bt + (size_t)cur.pn * tstep;
    S.a_ready(cur);
    if constexpr (SP2) {
        PG8_STAGE(PG8_SB(0, 0), cB, voffB); PG8_STAGE(PG8_SB(0, 1), cB + hstep, voffB); PG8_STAGE(PG8_SA(0, 0), cA, voffA); PG8_STAGE(PG8_SA(0, 1), cA + hstep, voffA);
        if (wr == 1) PG8_BAR;
        PG8_WAIT_V(2); PG8_BAR;
        PG8_STAGE(PG8_SB(1, 0), cB + kstep, voffB); PG8_STAGE(PG8_SA(1, 0), cA + kstep, voffA); PG8_STAGE(PG8_SB(1, 1), cB + hstep + kstep, voffB);
        PG8_WAIT_V(6); PG8_BAR;
    } else {
        PG8_STAGE(PG8_SB(0, 0), cB, voffB); PG8_STAGE(PG8_SA(0, 0), cA, voffA); PG8_STAGE(PG8_SB(0, 1), cB + hstep, voffB); PG8_STAGE(PG8_SA(0, 1), cA + hstep, voffA);
        if (wr == 1) PG8_BAR;
        PG8_WAIT_V(4); PG8_BAR;
        PG8_STAGE(PG8_SB(1, 0), cB + kstep, voffB); PG8_STAGE(PG8_SA(1, 0), cA + kstep, voffA); PG8_STAGE(PG8_SB(1, 1), cB + hstep + kstep, voffB);
        PG8_WAIT_V(6); PG8_BAR;
    }
    for (;;) {
        const bool has_next = S.next(ui + 1, nxt);
        const char* nA = has_next ? (const char*)g.A + (size_t)nxt.pm * tstep : cA; const char* nB = has_next ? (const char*)g.Bt + (size_t)nxt.pn * tstep : cB;
        for (int t = 0; t < nt; t += 2) {
            const bool last = (t == nt - 2);
            const char* a1 = cA + (size_t)(t + 1) * kstep;
            const char* a2 = last ? nA : cA + (size_t)(t + 2) * kstep; const char* b2 = last ? nB : cB + (size_t)(t + 2) * kstep;
            const char* a3 = a2 + kstep; const char* b3 = b2 + kstep;
            if (last && has_next) S.a_ready(nxt);
            if constexpr (SP2) {
            PG8_LDB(B0, 0, 0); PG8_LDB(B1, 0, 1); PG8_SCHED; PG8_LDA(At, 0, 0); PG8_STAGE(PG8_SA(1, 1), a1 + hstep, voffA);
            PG8_WAIT_V(8); PG8_WAIT_L(0); PG8_BAR; PG8_MMA(0, 0, At, B0); PG8_MMA(0, 1, At, B1); PG8_BAR; PG8_SCHED;
            PG8_LDA(At, 0, 1); PG8_STAGE(PG8_SB(0, 0), b2, voffB); PG8_STAGE(PG8_SB(0, 1), b2 + hstep, voffB); PG8_STAGE(PG8_SA(0, 0), a2, voffA);
            PG8_WAIT_V(8); PG8_WAIT_L(0); PG8_BAR; PG8_MMA(1, 0, At, B0); PG8_MMA(1, 1, At, B1); PG8_BAR; PG8_SCHED;
            PG8_LDB(B0, 1, 0); PG8_LDB(B1, 1, 1); PG8_SCHED; PG8_LDA(At, 1, 0); PG8_STAGE(PG8_SA(0, 1), a2 + hstep, voffA);
            PG8_WAIT_V(8); PG8_WAIT_L(0); PG8_BAR; PG8_MMA(0, 0, At, B0); PG8_MMA(0, 1, At, B1); PG8_BAR; PG8_SCHED;
            PG8_LDA(At, 1, 1); PG8_STAGE(PG8_SB(1, 0), b3, voffB); PG8_STAGE(PG8_SB(1, 1), b3 + hstep, voffB); PG8_STAGE(PG8_SA(1, 0), a3, voffA);
            PG8_WAIT_V(8); PG8_WAIT_L(0); PG8_BAR; PG8_MMA(1, 0, At, B0); PG8_MMA(1, 1, At, B1); PG8_BAR; PG8_SCHED;
            } else {
            PG8_LDB(B0, 0, 0); PG8_SCHED; PG8_LDA(At, 0, 0); PG8_STAGE(PG8_SA(1, 1), a1 + hstep, voffA);
            PG8_WAIT_L(8); PG8_BAR; PG8_WAIT_L(0); PG8_MMA(0, 0, At, B0); PG8_BAR; PG8_SCHED;
            PG8_LDB(B1, 0, 1); PG8_STAGE(PG8_SB(0, 0), b2, voffB);
            PG8_BAR; PG8_WAIT_L(0); PG8_MMA(0, 1, At, B1); PG8_BAR;
            PG8_LDA(At, 0, 1); PG8_STAGE(PG8_SA(0, 0), a2, voffA);
            PG8_BAR; PG8_WAIT_L(0); PG8_MMA(1, 0, At, B0); PG8_BAR; PG8_SCHED;
            PG8_STAGE(PG8_SB(0, 1), b2 + hstep, voffB);
            PG8_WAIT_V(6); PG8_BAR; PG8_MMA(1, 1, At, B1); PG8_BAR;
            PG8_LDB(B0, 1, 0); PG8_SCHED; PG8_LDA(At, 1, 0); PG8_STAGE(PG8_SA(0, 1), a2 + hstep, voffA);
            PG8_WAIT_L(8); PG8_BAR; PG8_WAIT_L(0); PG8_MMA(0, 0, At, B0); PG8_BAR; PG8_SCHED;
            PG8_LDB(B1, 1, 1); PG8_STAGE(PG8_SB(1, 0), b3, voffB);
            PG8_BAR; PG8_WAIT_L(0); PG8_MMA(0, 1, At, B1); PG8_BAR;
            PG8_LDA(At, 1, 1); PG8_STAGE(PG8_SA(1, 0), a3, voffA);
            PG8_BAR; PG8_WAIT_L(0); PG8_MMA(1, 0, At, B0); PG8_BAR; PG8_SCHED;
            PG8_STAGE(PG8_SB(1, 1), b3 + hstep, voffB);
            PG8_WAIT_V(6); PG8_BAR; PG8_MMA(1, 1, At, B1); PG8_BAR;
            }
        }
        if constexpr (ALIGN_EPI) { if (wr == 0) PG8_BAR; }
        if constexpr (!Epi::AFTER_DRAIN) { E(acc, cur, wr, wc, fr, fq); S.done(cur); }
        if (!has_next) break;
#pragma unroll
        for (int a = 0; a < 2; ++a)
#pragma unroll
            for (int b = 0; b < 2; ++b)
#pragma unroll
                for (int m = 0; m < 4; ++m)
#pragma unroll
                    for (int n = 0; n < 2; ++n) acc[a][b][m][n] = (f32x4){0.f, 0.f, 0.f, 0.f};
        cur = nxt; cA = nA; cB = nB; ++ui;
        if constexpr (ALIGN_EPI) { if (wr == 1) PG8_BAR; }
    }
    PG8_WAIT_V(0);
    if constexpr (!ALIGN_EPI) { if (wr == 0) PG8_BAR; }
    PG8_BAR;
    if constexpr (Epi::AFTER_DRAIN) { E.fused(acc, cur, wr, wc, fr, fq, lds, wid, lane); S.done(cur); }
#undef PG8_SA
#undef PG8_SB
#undef PG8_STAGE
#undef PG8_LDA
#undef PG8_LDB
#undef PG8_MMA
#undef PG8_WAIT_V
#undef PG8_WAIT_L
#undef PG8_BAR
#undef PG8_SCHED
}
}


#define DI __device__ __forceinline__
typedef unsigned short bf16_t;
typedef short bf16x8 __attribute__((ext_vector_type(8)));
typedef float f32x4 __attribute__((ext_vector_type(4)));
typedef float f32x2 __attribute__((ext_vector_type(2)));
typedef float f32x16 __attribute__((ext_vector_type(16)));
typedef unsigned u32x4 __attribute__((ext_vector_type(4)));
#define MFMA32(a, b, c) __builtin_amdgcn_mfma_f32_32x32x16_bf16((a), (b), (c), 0, 0, 0)
#define LAS __attribute__((address_space(3)))

constexpr int NT = 512;
constexpr int DM = 1024, MP = 16384, MT = 16896;
constexpr int NIN = 10368, NINP = 10496, CSH = 4224;
constexpr float EPS = 1e-6f, LNX_EPS = 64e-5f;
constexpr float QSCALE = 0.18033688011112042f;

constexpr size_t OUT_YP = 0, OUT_KP = 17301504, OUT_VP = 34078720, OUT_SHP = 50855936, OUT_WP = 50872832,
                 OUT_KS = 51134976, OUT_VS = 51659264, OUT_SHS = 52183552, OUT_WS = 52318720;

constexpr size_t SZ_ACT = (size_t)MT * 1024 * 2;
constexpr size_t WS_R1 = 0;
constexpr size_t WS_H = WS_R1, WS_WINT = WS_R1 + SZ_ACT, WS_SW = WS_R1;
constexpr size_t WS_R2 = (size_t)MT * 1024 * 4;
constexpr size_t WS_PB = WS_R2, WS_ORAW = WS_R2, WS_OB = WS_ORAW + (size_t)MT * 1024 * 4, WS_MG = WS_OB + SZ_ACT;
constexpr size_t WS_R3 = WS_R2 + (size_t)MT * CSH * 2;
constexpr size_t WS_QB = WS_R3, WS_X = WS_QB + SZ_ACT  , WS_BTL = WS_X + (size_t)MT * 256 * 2  , WS_SZA = WS_X + (size_t)MP * 1024 * 2;
static_assert(WS_BTL + (size_t)2048 * 256 * 2 <= WS_SZA, "LoRA buffers");
constexpr size_t WS_SR = WS_SZA + SZ_ACT, WS_SK = WS_SR + SZ_ACT, WS_SV = WS_SK + SZ_ACT, WS_SKK = WS_SV + SZ_ACT, WS_SB = WS_SKK + SZ_ACT;
constexpr size_t WS_SZB = WS_SB + SZ_ACT;
constexpr size_t WS_BONUS = WS_SZB + SZ_ACT;
constexpr size_t WS_WT = WS_BONUS + (size_t)MT * 16 * 4;
constexpr size_t WS_CTL = WS_WT + 3 * (size_t)1024 * 1024 * 2;
constexpr size_t WS_END = WS_CTL + 65536;
static_assert(WS_MG + SZ_ACT <= WS_R3, "R2 overflow");
static_assert(WS_WINT + (size_t)NINP * 1024 * 2 <= WS_R2, "R1 overflow");
static_assert(WS_END <= (size_t)512 * 1024 * 1024, "workspace");

constexpr int SMEM_BYTES = 147456;

struct Params { const float* in[22]; float* out; unsigned char* ws; };

DI float bf2f(bf16_t u) { return __uint_as_float((unsigned)u << 16); }
DI unsigned cvtpk(float lo, float hi) { unsigned r; asm volatile("v_cvt_pk_bf16_f32 %0, %1, %2" : "=v"(r) : "v"(lo), "v"(hi)); return r; }
DI bf16_t f2bf(float x) { return (bf16_t)(cvtpk(x, 0.f) & 0xffffu); }
DI float bflo(unsigned u) { return __uint_as_float(u << 16); }
DI float bfhi(unsigned u) { return __uint_as_float(u & 0xffff0000u); }
DI int crow(int i, int h) { return (i & 3) + 8 * (i >> 2) + 4 * h; }
DI float sigmoidf_(float x) { return 1.f / (1.f + __expf(-x)); }
DI uint4 pack8(f32x4 a, f32x4 b) { return make_uint4(cvtpk(a[0], a[1]), cvtpk(a[2], a[3]), cvtpk(b[0], b[1]), cvtpk(b[2], b[3])); }
DI float wave_sum(float x) {
#pragma unroll
  for (int o = 32; o > 0; o >>= 1) x += __shfl_xor(x, o);
  return x;
}
DI float sum16(float x) { x += __shfl_xor(x, 1); x += __shfl_xor(x, 2); x += __shfl_xor(x, 4); x += __shfl_xor(x, 8); return x; }
template <int CTRL> DI float dppf(float x) { return __builtin_bit_cast(float, __builtin_amdgcn_mov_dpp(__builtin_bit_cast(int, x), CTRL, 0xf, 0xf, true)); }
DI float row32_sum(float x) {
  x += dppf<0xB1>(x);
  x += dppf<0x4E>(x);
  x += dppf<0x124>(x);
  x += dppf<0x128>(x);
  const auto s = __builtin_amdgcn_permlane16_swap(__float_as_uint(x), __float_as_uint(x), false, false);
  return __uint_as_float(s[0]) + __uint_as_float(s[1]);
}
DI size_t hm_base(int row) {
  if (row < MP) { const int b = row >> 12, t = row & 4095; return ((size_t)(b * 16) * 4096 + t) * 64; }
  const int rs = row - MP, b = rs >> 4, t = rs & 15; return (size_t)MP * 1024 + ((size_t)(b * 16) * 16 + t) * 64;
}
DI size_t hm_hstride(int row) { return row < MP ? (size_t)4096 * 64 : (size_t)16 * 64; }

DI void p0_rmsnorm_rows(const Params& p, int item) {
  const int lane = TIDX & 63, wid = TIDX >> 6;
  const int row = item * 8 + wid;
  const float* x = row < MP ? p.in[0] + (size_t)row * DM : p.in[1] + (size_t)(row - MP) * DM;
  const float* g = p.in[6];
  float4 v[4]; float ss = 0.f;
#pragma unroll
  for (int i = 0; i < 4; ++i) { v[i] = *(const float4*)(x + i * 256 + lane * 4); ss += v[i].x * v[i].x + v[i].y * v[i].y + v[i].z * v[i].z + v[i].w * v[i].w; }
  ss = wave_sum(ss);
  const float inv = rsqrtf(ss * (1.f / DM) + EPS);
  bf16_t* H = (bf16_t*)(p.ws + WS_H) + (size_t)row * DM;
#pragma unroll
  for (int i = 0; i < 4; ++i) {
    const float4 gg = *(const float4*)(g + i * 256 + lane * 4);
    uint2 o; o.x = cvtpk(v[i].x * inv * gg.x, v[i].y * inv * gg.y); o.y = cvtpk(v[i].z * inv * gg.z, v[i].w * inv * gg.w);
    *(uint2*)(H + i * 256 + lane * 4) = o;
  }
}
DI void p0_transpose_tile(const float* src, bf16_t* dst, int N, int kt, int nt, float* lds) {
  const int tid = TIDX & 255;
  const int k0 = kt * 64, n0 = nt * 64;
#pragma unroll
  for (int i = 0; i < 4; ++i) {
    const int row = (tid >> 4) + 16 * i, c4 = (tid & 15) * 4;
    const float4 v = *(const float4*)(src + (size_t)(k0 + row) * N + n0 + c4);
    lds[row * 65 + c4 + 0] = v.x; lds[row * 65 + c4 + 1] = v.y; lds[row * 65 + c4 + 2] = v.z; lds[row * 65 + c4 + 3] = v.w;
  }
  __syncthreads();
  const int n = tid >> 2, kc = (tid & 3) * 16;
  unsigned w[8];
#pragma unroll
  for (int j = 0; j < 8; ++j) w[j] = cvtpk(lds[(kc + 2 * j) * 65 + n], lds[(kc + 2 * j + 1) * 65 + n]);
  uint4* d = (uint4*)(dst + (size_t)(n0 + n) * 1024 + k0 + kc);
  d[0] = make_uint4(w[0], w[1], w[2], w[3]); d[1] = make_uint4(w[4], w[5], w[6], w[7]);
  __syncthreads();
}
DI void phase0(const Params& p, char* smem) {
  {
    bf16_t* BL = (bf16_t*)(p.ws + WS_BTL);
    for (int i = blockIdx.x * NT + TIDX; i < 2048 * 256; i += gridDim.x * NT) {
      const int n = i >> 8, k = i & 255;
      float v = 0.f;
      if (n < 1024) { if (k < 64) v = p.in[10][(size_t)k * 1024 + n]; }
      else if (k >= 64 && k < 128) v = p.in[12][(size_t)(k - 64) * 1024 + (n - 1024)];
      BL[i] = f2bf(v);
    }
  }
  constexpr int N_ROWS = MT / 8, N_TIN = 16 * 162 / 2, N_TSQ = 256 / 2;
  constexpr int N_ITEMS = N_ROWS + N_TIN + 3 * N_TSQ;
  const int half = TIDX >> 8;
  float* scr = (float*)smem + half * (64 * 65);
  for (int it = blockIdx.x; it < N_ITEMS; it += gridDim.x) {
    if (it < N_ROWS) { p0_rmsnorm_rows(p, it); continue; }
    int j = it - N_ROWS;
    if (j < N_TIN) { const int t = 2 * j + half; p0_transpose_tile(p.in[7], (bf16_t*)(p.ws + WS_WINT), NIN, t / 162, t % 162, scr); continue; }
    j -= N_TIN;
    const int w = j / N_TSQ; const int t = 2 * (j % N_TSQ) + half;
    p0_transpose_tile(p.in[18 + w], (bf16_t*)(p.ws + WS_WT) + (size_t)w * 1024 * 1024, 1024, t >> 4, t & 15, scr);
  }
}

struct EpiP1 {
  static constexpr bool PERM = true, AFTER_DRAIN = false;
  Params p;
  DI void operator()(const pg8::f32x4 (&acc)[2][2][4][2], const pg8::Unit& u, int wr, int wc, int fr, int fq) const {
    const int colt = u.pn * 256;
    const int region = colt >> 10;
#pragma unroll
    for (int ai = 0; ai < 2; ++ai)
#pragma unroll
      for (int m = 0; m < 4; ++m) {
        const int row = u.pm * 256 + ai * 128 + wr * 64 + m * 16 + fr;
        const bool prompt = row < MP;
        const int rs = row - MP;
#pragma unroll
        for (int bj = 0; bj < 2; ++bj) {
          const int col = colt + bj * 128 + wc * 32 + 8 * fq;
          const f32x4 v0 = acc[ai][bj][m][0], v1 = acc[ai][bj][m][1];
          if (region >= 6) {
            const int pc = col - 6144;
            if (pc < CSH) {
              *(uint4*)((bf16_t*)(p.ws + WS_PB) + (size_t)row * CSH + pc) = pack8(v0, v1);
              float* so = nullptr;
              if (prompt) { if ((row & 4095) == 4095) so = p.out + OUT_SHP + (size_t)(row >> 12) * CSH + pc; }
              else if ((rs & 15) == 15) so = p.out + OUT_SHS + (size_t)(rs >> 4) * CSH + pc;
              if (so) { *(f32x4*)so = v0; *(f32x4*)(so + 4) = v1; }
            }
          } else if (region == 0) {
            *(uint4*)((bf16_t*)(p.ws + WS_QB) + (size_t)row * 1024 + col) = pack8(v0 * QSCALE, v1 * QSCALE);
          } else if (region == 1) {
            const int c = col - 1024, hh = c >> 6, d = c & 63;
            float* o = prompt ? p.out + OUT_KP + (((size_t)(row >> 12) * 16 + hh) * 4096 + (row & 4095)) * 64 + d
                              : p.out + OUT_KS + (((size_t)(rs >> 4) * 16 + hh) * 16 + (rs & 15)) * 64 + d;
            __builtin_nontemporal_store(v0, (f32x4*)o); __builtin_nontemporal_store(v1, (f32x4*)(o + 4));
          } else if (region == 2) {
            const int c = col - 2048, hh = c >> 6, d = c & 63;
            float* o = prompt ? p.out + OUT_VP + (((size_t)(row >> 12) * 16 + hh) * 4096 + (row & 4095)) * 64 + d
                              : p.out + OUT_VS + (((size_t)(rs >> 4) * 16 + hh) * 16 + (rs & 15)) * 64 + d;
            __builtin_nontemporal_store(v0, (f32x4*)o); __builtin_nontemporal_store(v1, (f32x4*)(o + 4));
          } else if (region == 3) {
            f32x4 a, b;
#pragma unroll
            for (int j = 0; j < 4; ++j) { a[j] = v0[j] * sigmoidf_(v0[j]); b[j] = v1[j] * sigmoidf_(v1[j]); }
            *(uint4*)((bf16_t*)(p.ws + WS_SZA) + (size_t)row * 1024 + (col - 3072)) = pack8(a, b);
          } else {
            f32x4 a, b;
#pragma unroll
            for (int j = 0; j < 4; ++j) { a[j] = sigmoidf_(v0[j]); b[j] = sigmoidf_(v1[j]); }
            *(uint4*)((bf16_t*)p.out + (size_t)row * 2048 + (col - 4096)) = pack8(a, b);
          }
        }
      }
  }
};
struct EpiGate {
  static constexpr bool PERM = true, AFTER_DRAIN = false;
  Params p; int goff; bool first;
  DI void operator()(const pg8::f32x4 (&acc)[2][2][4][2], const pg8::Unit& u, int wr, int wc, int fr, int fq) const {
    const bf16_t* G = (const bf16_t*)p.out; bf16_t* MG = (bf16_t*)(p.ws + WS_MG);
#pragma unroll
    for (int ai = 0; ai < 2; ++ai)
#pragma unroll
      for (int m = 0; m < 4; ++m) {
        const size_t row = u.pm * 256 + ai * 128 + wr * 64 + m * 16 + fr;
#pragma unroll
        for (int bj = 0; bj < 2; ++bj) {
          const int col = u.pn * 256 + bj * 128 + wc * 32 + 8 * fq;
          const uint4 g = *(const uint4*)(G + row * 2048 + goff + col);
          f32x4 a = acc[ai][bj][m][0], b = acc[ai][bj][m][1];
          a[0] *= bflo(g.x); a[1] *= bfhi(g.x); a[2] *= bflo(g.y); a[3] *= bfhi(g.y);
          b[0] *= bflo(g.z); b[1] *= bfhi(g.z); b[2] *= bflo(g.w); b[3] *= bfhi(g.w);
          if (!first) {
            const uint4 o = *(const uint4*)(MG + row * 1024 + col);
            a[0] += bflo(o.x); a[1] += bfhi(o.x); a[2] += bflo(o.y); a[3] += bfhi(o.y);
            b[0] += bflo(o.z); b[1] += bfhi(o.z); b[2] += bflo(o.w); b[3] += bfhi(o.w);
          }
          *(uint4*)(MG + row * 1024 + col) = pack8(a, b);
        }
      }
  }
};
struct EpiOut {
  static constexpr bool PERM = true, AFTER_DRAIN = false;
  Params p;
  DI void operator()(const pg8::f32x4 (&acc)[2][2][4][2], const pg8::Unit& u, int wr, int wc, int fr, int fq) const {
#pragma unroll
    for (int ai = 0; ai < 2; ++ai)
#pragma unroll
      for (int m = 0; m < 4; ++m) {
        const int row = u.pm * 256 + ai * 128 + wr * 64 + m * 16 + fr;
        const float* xr = row < MP ? p.in[0] + (size_t)row * 1024 : p.in[1] + (size_t)(row - MP) * 1024;
        float* orow = p.out + OUT_YP + (size_t)row * 1024;
#pragma unroll
        for (int bj = 0; bj < 2; ++bj) {
          const int col = u.pn * 256 + bj * 128 + wc * 32 + 8 * fq;
          const f32x4 x0 = *(const f32x4*)(xr + col), x1 = *(const f32x4*)(xr + col + 4);
          *(f32x4*)(orow + col) = x0 + acc[ai][bj][m][0]; *(f32x4*)(orow + col + 4) = x1 + acc[ai][bj][m][1];
        }
      }
  }
};
template <class Epi>
DI void run_gemm(char* smem, const bf16_t* A, const bf16_t* Bt, int M, int N, const Epi& E, int K = 1024) {
  pg8::Gemm g; g.A = A; g.Bt = Bt; g.M = M; g.N = N; g.K = K;
  pg8::StaticOrder S; S.init(M, N, (int)gridDim.x, (int)blockIdx.x);
  pg8::gemm_phase<Epi, pg8::StaticOrder, true, true>((LAS unsigned char*)smem, g, S, E);
  __syncthreads();
}

template <int MODE>
DI void small_gemm(const Params& p, const bf16_t* A, const bf16_t* Bt) {
  const int lane = TIDX & 63, wid = TIDX >> 6, r = lane & 31, h = lane >> 5;
  for (int tile = wid * gridDim.x + blockIdx.x; tile < 512; tile += 8 * gridDim.x) {
    const int row0 = MP + (tile >> 5) * 32, col0 = (tile & 31) * 32;
    const bf16_t* pa = A + (size_t)(row0 + r) * 1024 + 8 * h;
    const bf16_t* pb = Bt + (size_t)(col0 + r) * 1024 + 8 * h;
    f32x16 acc;
#pragma unroll
    for (int i = 0; i < 16; ++i) acc[i] = 0.f;
#pragma unroll 8
    for (int s = 0; s < 64; ++s) acc = MFMA32(*(const bf16x8*)(pa + 16 * s), *(const bf16x8*)(pb + 16 * s), acc);
    const int col = col0 + r;
#pragma unroll
    for (int i = 0; i < 16; ++i) {
      const size_t row = row0 + crow(i, h);
      if (MODE == 2) p.out[OUT_YP + row * 1024 + col] = p.in[1][(row - MP) * 1024 + col] + acc[i];
      else {
        bf16_t* mg = (bf16_t*)(p.ws + WS_MG) + row * 1024 + col;
        const float g = bf2f(((const bf16_t*)p.out)[row * 2048 + (MODE == 1 ? 1024 : 0) + col]);
        *mg = f2bf((MODE == 1 ? bf2f(*mg) : 0.f) + acc[i] * g);
      }
    }
  }
}

DI float tanh_fast(float x) { return 1.f - 2.f / (1.f + __expf(2.f * x)); }
DI void phase_x(const Params& p) {
  const bf16_t* PB = (const bf16_t*)(p.ws + WS_PB);
  bf16_t* X = (bf16_t*)(p.ws + WS_X);
  const float* mu = p.in[8];
  for (int i = blockIdx.x * NT + TIDX; i < MT * 32; i += gridDim.x * NT) {
    const int row = i >> 5, g = i & 31;
    uint4 o = make_uint4(0u, 0u, 0u, 0u);
    if (g < 16) {
      const int col = 3072 + g * 8;
      const bool prompt = row < MP;
      const int t = prompt ? (row & 4095) : ((row - MP) & 15);
      const uint4 a = *(const uint4*)(PB + (size_t)row * CSH + col);
      float c[8] = {bflo(a.x), bfhi(a.x), bflo(a.y), bfhi(a.y), bflo(a.z), bfhi(a.z), bflo(a.w), bfhi(a.w)}, q[8];
      if (t != 0) { const uint4 b = *(const uint4*)(PB + (size_t)(row - 1) * CSH + col); q[0] = bflo(b.x); q[1] = bfhi(b.x); q[2] = bflo(b.y); q[3] = bfhi(b.y); q[4] = bflo(b.z); q[5] = bfhi(b.z); q[6] = bflo(b.w); q[7] = bfhi(b.w); }
      else if (prompt) {
#pragma unroll
        for (int j = 0; j < 8; ++j) q[j] = 0.f;
      } else { const float* s = p.in[4] + (size_t)((row - MP) >> 4) * CSH + col; const float4 b0 = *(const float4*)s, b1 = *(const float4*)(s + 4); q[0] = b0.x; q[1] = b0.y; q[2] = b0.z; q[3] = b0.w; q[4] = b1.x; q[5] = b1.y; q[6] = b1.z; q[7] = b1.w; }
      const float4 u0 = *(const float4*)(mu + col), u1 = *(const float4*)(mu + col + 4);
      const float u[8] = {u0.x, u0.y, u0.z, u0.w, u1.x, u1.y, u1.z, u1.w};
      float m[8];
#pragma unroll
      for (int j = 0; j < 8; ++j) { m[j] = c[j] + u[j] * (q[j] - c[j]); if (g < 8) m[j] = tanh_fast(m[j]); }
      o = make_uint4(cvtpk(m[0], m[1]), cvtpk(m[2], m[3]), cvtpk(m[4], m[5]), cvtpk(m[6], m[7]));
    }
    *(uint4*)(X + (size_t)row * 256 + g * 8) = o;
  }
}
struct EpiLora {
  static constexpr bool PERM = true, AFTER_DRAIN = false;
  Params p;
  DI void operator()(const pg8::f32x4 (&acc)[2][2][4][2], const pg8::Unit& u, int wr, int wc, int fr, int fq) const {
    const bool isw = u.pn < 4;
#pragma unroll
    for (int ai = 0; ai < 2; ++ai)
#pragma unroll
      for (int m = 0; m < 4; ++m) {
        const int row = u.pm * 256 + ai * 128 + wr * 64 + m * 16 + fr;
        const size_t hb = hm_base(row), hs = hm_hstride(row);
#pragma unroll
        for (int bj = 0; bj < 2; ++bj) {
          const int c = (u.pn & 3) * 256 + bj * 128 + wc * 32 + 8 * fq;
          const size_t idx = hb + (c >> 6) * hs + (c & 63);
          const f32x4 v0 = acc[ai][bj][m][0], v1 = acc[ai][bj][m][1];
          if (isw) {
            const f32x4 b0 = *(const f32x4*)(p.in[9] + c), b1 = *(const f32x4*)(p.in[9] + c + 4);
            f32x4 d0, d1;
#pragma unroll
            for (int j = 0; j < 4; ++j) {
              const float x0 = -(b0[j] + v0[j]), x1 = -(b1[j] + v1[j]);
              const float s0 = fmaxf(x0, 0.f) + __logf(1.f + __expf(-fabsf(x0))), s1 = fmaxf(x1, 0.f) + __logf(1.f + __expf(-fabsf(x1)));
              d0[j] = __expf(-__expf(-s0 - 0.5f)); d1[j] = __expf(-__expf(-s1 - 0.5f));
            }
            float* o = (float*)(p.ws + WS_SW) + idx; *(f32x4*)o = d0; *(f32x4*)(o + 4) = d1;
          } else {
            const f32x4 b0 = *(const f32x4*)(p.in[11] + c), b1 = *(const f32x4*)(p.in[11] + c + 4);
            f32x4 d0, d1;
#pragma unroll
            for (int j = 0; j < 4; ++j) { d0[j] = sigmoidf_(b0[j] + v0[j]); d1[j] = sigmoidf_(b1[j] + v1[j]); }
            *(uint4*)((bf16_t*)(p.ws + WS_SB) + idx) = pack8(d0, d1);
          }
        }
      }
  }
};
DI void phase1c(const Params& p) {
  const int tid = TIDX & 255, half = TIDX >> 8, c = tid * 4, hh = c >> 6;
  const bf16_t* PB = (const bf16_t*)(p.ws + WS_PB);
  const float* mu = p.in[8];
  const float4 kkw = *(const float4*)(p.in[13] + c), kaw = *(const float4*)(p.in[14] + c), rkw = *(const float4*)(p.in[15] + c);
  const float4 mur = *(const float4*)(mu + c), muk = *(const float4*)(mu + 1024 + c), muv = *(const float4*)(mu + 2048 + c), muz = *(const float4*)(mu + 3200 + c);
  const float kka[4] = {kkw.x, kkw.y, kkw.z, kkw.w}, kaa[4] = {kaw.x, kaw.y, kaw.z, kaw.w}, rka[4] = {rkw.x, rkw.y, rkw.z, rkw.w};
  const float mura[4] = {mur.x, mur.y, mur.z, mur.w}, muka[4] = {muk.x, muk.y, muk.z, muk.w}, muva[4] = {muv.x, muv.y, muv.z, muv.w}, muza[4] = {muz.x, muz.y, muz.z, muz.w};
  bf16_t* SR = (bf16_t*)(p.ws + WS_SR); bf16_t* SK = (bf16_t*)(p.ws + WS_SK); bf16_t* SV = (bf16_t*)(p.ws + WS_SV);
  bf16_t* SKK = (bf16_t*)(p.ws + WS_SKK); bf16_t* SB = (bf16_t*)(p.ws + WS_SB); bf16_t* SZB = (bf16_t*)(p.ws + WS_SZB);
  float* BONUS = (float*)(p.ws + WS_BONUS);
  for (int r4 = blockIdx.x * 2 + half; r4 < MT / 4; r4 += gridDim.x * 2) {
    const int row0 = r4 * 4;
    const bool prompt = row0 < MP;
    const int t0 = prompt ? (row0 & 4095) : ((row0 - MP) & 15);
    uint2 gr[5], gk[5], gv[5], gz[5], ga[4];
#pragma unroll
    for (int t = 0; t < 5; ++t) {
      const int rr_ = (t == 0 && t0 == 0) ? row0 : row0 + t - 1;
      const bf16_t* pc = PB + (size_t)rr_ * CSH;
      gr[t] = *(const uint2*)(pc + c); gk[t] = *(const uint2*)(pc + 1024 + c); gv[t] = *(const uint2*)(pc + 2048 + c); gz[t] = *(const uint2*)(pc + 3200 + c);
    }
    size_t idx[4];
#pragma unroll
    for (int t = 0; t < 4; ++t) { idx[t] = hm_base(row0 + t) + hh * hm_hstride(row0 + t) + (c & 63); ga[t] = *(const uint2*)(SB + idx[t]); }
    float pr[4], pk[4], pv[4], pz[4];
    if (t0 == 0) {
      if (prompt) {
#pragma unroll
        for (int x = 0; x < 4; ++x) { pr[x] = 0.f; pk[x] = 0.f; pv[x] = 0.f; pz[x] = 0.f; }
      } else {
        const float* s = p.in[4] + (size_t)((row0 - MP) >> 4) * CSH;
        const float4 a = *(const float4*)(s + c), b = *(const float4*)(s + 1024 + c), d = *(const float4*)(s + 2048 + c), e = *(const float4*)(s + 3200 + c);
        pr[0] = a.x; pr[1] = a.y; pr[2] = a.z; pr[3] = a.w; pk[0] = b.x; pk[1] = b.y; pk[2] = b.z; pk[3] = b.w;
        pv[0] = d.x; pv[1] = d.y; pv[2] = d.z; pv[3] = d.w; pz[0] = e.x; pz[1] = e.y; pz[2] = e.z; pz[3] = e.w;
      }
    } else {
      pr[0] = bflo(gr[0].x); pr[1] = bfhi(gr[0].x); pr[2] = bflo(gr[0].y); pr[3] = bfhi(gr[0].y);
      pk[0] = bflo(gk[0].x); pk[1] = bfhi(gk[0].x); pk[2] = bflo(gk[0].y); pk[3] = bfhi(gk[0].y);
      pv[0] = bflo(gv[0].x); pv[1] = bfhi(gv[0].x); pv[2] = bflo(gv[0].y); pv[3] = bfhi(gv[0].y);
      pz[0] = bflo(gz[0].x); pz[1] = bfhi(gz[0].x); pz[2] = bflo(gz[0].y); pz[3] = bfhi(gz[0].y);
    }
#pragma unroll
    for (int t = 0; t < 4; ++t) {
      const int row = row0 + t;
      const float curr[4] = {bflo(gr[t + 1].x), bfhi(gr[t + 1].x), bflo(gr[t + 1].y), bfhi(gr[t + 1].y)}, curk[4] = {bflo(gk[t + 1].x), bfhi(gk[t + 1].x), bflo(gk[t + 1].y), bfhi(gk[t + 1].y)};
      const float curv[4] = {bflo(gv[t + 1].x), bfhi(gv[t + 1].x), bflo(gv[t + 1].y), bfhi(gv[t + 1].y)}, curz[4] = {bflo(gz[t + 1].x), bfhi(gz[t + 1].x), bflo(gz[t + 1].y), bfhi(gz[t + 1].y)};
      const float av[4] = {bflo(ga[t].x), bfhi(ga[t].x), bflo(ga[t].y), bfhi(ga[t].y)};
      float rm[4], km[4], vm[4], kkv[4], bb[4], kmod[4], szb[4];
      float ssq = 0.f, bon = 0.f;
#pragma unroll
      for (int x = 0; x < 4; ++x) {
        rm[x] = curr[x] + mura[x] * (pr[x] - curr[x]);
        km[x] = curk[x] + muka[x] * (pk[x] - curk[x]);
        vm[x] = curv[x] + muva[x] * (pv[x] - curv[x]);
        const float zm = curz[x] + muza[x] * (pz[x] - curz[x]);
        szb[x] = zm * sigmoidf_(zm);
        kkv[x] = km[x] * kka[x];
        ssq += kkv[x] * kkv[x];
        kmod[x] = km[x] * (1.f + (av[x] - 1.f) * kaa[x]);
        bon += rm[x] * kmod[x] * rka[x];
        pr[x] = curr[x]; pk[x] = curk[x]; pv[x] = curv[x]; pz[x] = curz[x];
      }
      ssq = sum16(ssq); bon = sum16(bon);
      const float inv = 1.f / fmaxf(sqrtf(ssq), 1e-12f);
#pragma unroll
      for (int x = 0; x < 4; ++x) { kkv[x] *= inv; bb[x] = kkv[x] * av[x]; }
      *(uint2*)(SR + idx[t]) = make_uint2(cvtpk(rm[0], rm[1]), cvtpk(rm[2], rm[3]));
      *(uint2*)(SK + idx[t]) = make_uint2(cvtpk(kmod[0], kmod[1]), cvtpk(kmod[2], kmod[3]));
      *(uint2*)(SV + idx[t]) = make_uint2(cvtpk(vm[0], vm[1]), cvtpk(vm[2], vm[3]));
      *(uint2*)(SKK + idx[t]) = make_uint2(cvtpk(-kkv[0], -kkv[1]), cvtpk(-kkv[2], -kkv[3]));
      *(uint2*)(SB + idx[t]) = make_uint2(cvtpk(bb[0], bb[1]), cvtpk(bb[2], bb[3]));
      *(uint2*)(SZB + (size_t)row * 1024 + c) = make_uint2(cvtpk(szb[0], szb[1]), cvtpk(szb[2], szb[3]));
      if ((tid & 15) == 0) BONUS[(size_t)row * 16 + hh] = bon;
    }
  }
}

template <bool SAMPLE>
DI void attn_wave(const Params& p, int sh, int qt) {
  const int lane = TIDX & 63, r = lane & 31, h = lane >> 5;
  const int hh = sh & 15, b = sh >> 4;
  bf16_t* QB = (bf16_t*)(p.ws + WS_QB);
  const int row0 = SAMPLE ? MP + b * 16 : b * 4096 + qt * 32;
  bf16_t* Qp = QB + (size_t)row0 * 1024 + hh * 64;
  const int qrow = SAMPLE ? (r < 15 ? r : 15) : r;
  bf16x8 qf[4];
#pragma unroll
  for (int s = 0; s < 4; ++s) qf[s] = *(const bf16x8*)(Qp + (size_t)qrow * 1024 + 16 * s + 8 * h);
  f32x16 z0, z1;
#pragma unroll
  for (int i = 0; i < 16; ++i) { z0[i] = 0.f; z1[i] = 0.f; }
  float carry = 1.f;
  const int ntiles = SAMPLE ? 33 : qt + 1;
  for (int it = 0; it < ntiles; ++it) {
    const bool diag = (it == 0);
    const int kt = SAMPLE ? 32 - it : qt - it;
    bf16x8 kf[4];
    {
      const float* Kp;
      if (!SAMPLE) Kp = p.out + OUT_KP + ((size_t)sh * 4096 + kt * 32 + r) * 64;
      else Kp = diag ? p.out + OUT_KS + ((size_t)sh * 16 + (r < 15 ? r : 15)) * 64 : p.in[2] + ((size_t)sh * 1024 + kt * 32 + r) * 64;
#pragma unroll
      for (int s = 0; s < 4; ++s) {
        const float4 a = *(const float4*)(Kp + 16 * s + 8 * h), bq = *(const float4*)(Kp + 16 * s + 8 * h + 4);
        u32x4 w; w[0] = cvtpk(a.x, a.y); w[1] = cvtpk(a.z, a.w); w[2] = cvtpk(bq.x, bq.y); w[3] = cvtpk(bq.z, bq.w);
        kf[s] = __builtin_bit_cast(bf16x8, w);
      }
    }
    f32x16 st;
#pragma unroll
    for (int i = 0; i < 16; ++i) st[i] = 0.f;
#pragma unroll
    for (int s = 0; s < 4; ++s) st = MFMA32(kf[s], qf[s], st);
    float keep[16], wgt[16];
#pragma unroll
    for (int i = 0; i < 16; ++i) {
      const float e = __builtin_amdgcn_exp2f(st[i]);
      const float kp = __builtin_amdgcn_rcpf(1.f + e);
      bool valid = true;
      if (diag) { const int kr = crow(i, h); valid = SAMPLE ? (kr < r && kr < 16) : (kr < r); }
      keep[i] = valid ? kp : 1.f;
      wgt[i] = valid ? 1.f - kp : 0.f;
    }
    float pp[4], hif[4];
#pragma unroll
    for (int g = 0; g < 4; ++g) {
      const float p4 = (keep[4 * g] * keep[4 * g + 1]) * (keep[4 * g + 2] * keep[4 * g + 3]);
      const auto sw = __builtin_amdgcn_permlane32_swap(__float_as_uint(p4), __float_as_uint(p4), false, false);
      const float lo = __uint_as_float(sw[0]), hi = __uint_as_float(sw[1]);
      pp[g] = lo * hi;
      hif[g] = h ? 1.f : hi;
    }
    float T[4];
    T[3] = carry; T[2] = T[3] * pp[3]; T[1] = T[2] * pp[2]; T[0] = T[1] * pp[1];
    carry = T[0] * pp[0];
#pragma unroll
    for (int g = 0; g < 4; ++g) {
      const float w3 = T[g] * hif[g], w2 = w3 * keep[4 * g + 3], w1 = w2 * keep[4 * g + 2], w0 = w1 * keep[4 * g + 1];
      wgt[4 * g + 3] *= w3; wgt[4 * g + 2] *= w2; wgt[4 * g + 1] *= w1; wgt[4 * g] *= w0;
    }
#pragma unroll
    for (int s = 0; s < 2; ++s) {
      u32x4 pw;
#pragma unroll
      for (int j = 0; j < 4; ++j) pw[j] = cvtpk(wgt[8 * s + 2 * j], wgt[8 * s + 2 * j + 1]);
      const bf16x8 pf = __builtin_bit_cast(bf16x8, pw);
#pragma unroll
      for (int db = 0; db < 2; ++db) {
        bf16x8 vf;
        {
          float vv[8];
#pragma unroll
          for (int j = 0; j < 8; ++j) {
            const int kr = 16 * s + 8 * (j >> 2) + 4 * h + (j & 3);
            const float* vp;
            if (!SAMPLE) vp = p.out + OUT_VP + ((size_t)sh * 4096 + kt * 32 + kr) * 64;
            else vp = diag ? p.out + OUT_VS + ((size_t)sh * 16 + (kr < 15 ? kr : 15)) * 64 : p.in[3] + ((size_t)sh * 1024 + kt * 32 + kr) * 64;
            vv[j] = vp[db * 32 + r];
          }
          u32x4 w; w[0] = cvtpk(vv[0], vv[1]); w[1] = cvtpk(vv[2], vv[3]); w[2] = cvtpk(vv[4], vv[5]); w[3] = cvtpk(vv[6], vv[7]);
          vf = __builtin_bit_cast(bf16x8, w);
        }
        if (db == 0) z0 = MFMA32(pf, vf, z0); else z1 = MFMA32(pf, vf, z1);
      }
    }
    if (__ballot(carry != 0.f) == 0ull) break;
  }
  const bf16_t* SZA = (const bf16_t*)(p.ws + WS_SZA);
#pragma unroll
  for (int i = 0; i < 16; ++i) {
    const int q = crow(i, h);
    if (SAMPLE && q >= 16) continue;
    const size_t o = (size_t)(row0 + q) * 1024 + hh * 64 + r;
    QB[o] = f2bf(z0[i] * bf2f(SZA[o]));
    QB[o + 32] = f2bf(z1[i] * bf2f(SZA[o + 32]));
  }
}

DI float row16_sum(float x) {
  x += dppf<0xB1>(x); x += dppf<0x4E>(x); x += dppf<0x124>(x); x += dppf<0x128>(x);
  return x;
}
DI void scan_wave(const Params& p, int shg, int slice, float* L) {
  const int lane = TIDX & 63, cc = lane & 15;
  const bool prompt = shg < 64;
  const int T = prompt ? 4096 : 16;
  const size_t base = prompt ? (size_t)shg * 4096 * 64 : (size_t)MP * 1024 + (size_t)(shg - 64) * 16 * 64;
  const int v = slice * 4 + (lane >> 4);
  const float* SW = (const float*)(p.ws + WS_SW) + base;
  const bf16_t* SARR = (const bf16_t*)(p.ws + WS_SR) + base;
  float* ORAW = (float*)(p.ws + WS_ORAW) + base;
  float4 S;
  float* wout;
  if (prompt) { S = make_float4(0.f, 0.f, 0.f, 0.f); wout = p.out + OUT_WP + ((size_t)shg * 64 + v) * 64 + 4 * cc; }
  else { S = *(const float4*)(p.in[5] + ((size_t)(shg - 64) * 64 + v) * 64 + 4 * cc); wout = p.out + OUT_WS + ((size_t)(shg - 64) * 64 + v) * 64 + 4 * cc; }
  const int nch = T / 8;
  const int dw0 = ((lane >> 4) * 6 + 2) * 64 + (lane & 15) * 4, dw1 = dw0 + 4 * 384;
  const int db = (lane >> 3) * 384 + (lane & 7) * 8;
  uint4 gw0, gw1, gr, gk, gv, gn, gb;
#define SCAN_GLOAD(ch) do { const float* w_ = SW + (size_t)(ch) * 512; gw0 = *(const uint4*)(w_ + lane * 4); gw1 = *(const uint4*)(w_ + 256 + lane * 4); \
    const bf16_t* a_ = SARR + (size_t)(ch) * 512 + lane * 8; gr = *(const uint4*)a_; gk = *(const uint4*)(a_ + SZ_ACT / 2); gv = *(const uint4*)(a_ + 2 * (SZ_ACT / 2)); \
    gn = *(const uint4*)(a_ + 3 * (SZ_ACT / 2)); gb = *(const uint4*)(a_ + 4 * (SZ_ACT / 2)); } while (0)
#define SCAN_PUT(slot, g) do { float* d_ = L + db + (slot) * 64; *(float4*)d_ = make_float4(bflo(g.x), bfhi(g.x), bflo(g.y), bfhi(g.y)); *(float4*)(d_ + 4) = make_float4(bflo(g.z), bfhi(g.z), bflo(g.w), bfhi(g.w)); } while (0)
#define SCAN_LSTORE() do { *(uint4*)(L + dw0) = gw0; *(uint4*)(L + dw1) = gw1; SCAN_PUT(4, gr); SCAN_PUT(3, gk); SCAN_PUT(5, gv); SCAN_PUT(0, gn); SCAN_PUT(1, gb); \
    asm volatile("s_waitcnt lgkmcnt(0)" ::: "memory"); } while (0)
  SCAN_GLOAD(0);
  asm volatile("s_waitcnt lgkmcnt(0)" ::: "memory");
  SCAN_LSTORE();
  for (int ch = 0; ch < nch; ++ch) {
    if (ch + 1 < nch) SCAN_GLOAD(ch + 1);
    float okeep = 0.f;
    const float* Lc = L + 4 * cc;
    float4 nk = *(const float4*)(Lc), bb = *(const float4*)(Lc + 64), ww = *(const float4*)(Lc + 128), kv = *(const float4*)(Lc + 192), rr = *(const float4*)(Lc + 256);
    float vt = L[320 + v];
#pragma unroll 4
    for (int st = 0; st < 8; ++st) {
      const int sn = ((st + 1) & 7) * 384;
      const float4 nk2 = *(const float4*)(Lc + sn), bb2 = *(const float4*)(Lc + sn + 64), ww2 = *(const float4*)(Lc + sn + 128);
      const float4 kv2 = *(const float4*)(Lc + sn + 192), rr2 = *(const float4*)(Lc + sn + 256);
      const float vt2 = L[sn + 320 + v];
      float d = (S.x * nk.x + S.y * nk.y) + (S.z * nk.z + S.w * nk.w);
      const float sa = row16_sum(d);
      S.x = S.x * ww.x + (sa * bb.x + vt * kv.x);
      S.y = S.y * ww.y + (sa * bb.y + vt * kv.y);
      S.z = S.z * ww.z + (sa * bb.z + vt * kv.z);
      S.w = S.w * ww.w + (sa * bb.w + vt * kv.w);
      float o = (S.x * rr.x + S.y * rr.y) + (S.z * rr.z + S.w * rr.w);
      o = row16_sum(o);
      okeep = (cc == st) ? o : okeep;
      nk = nk2; bb = bb2; ww = ww2; kv = kv2; rr = rr2; vt = vt2;
    }
    if (cc < 8) ORAW[(size_t)(ch * 8 + cc) * 64 + v] = okeep;
    asm volatile("s_waitcnt lgkmcnt(0)" ::: "memory");
    if (ch + 1 < nch) SCAN_LSTORE();
  }
  *(float4*)wout = S;
#undef SCAN_GLOAD
#undef SCAN_PUT
#undef SCAN_LSTORE
}

DI void sgroup_barrier(volatile LAS unsigned* cnt, unsigned target) {
  asm volatile("s_waitcnt lgkmcnt(0)" ::: "memory");
  if ((TIDX & 63) == 0) __hip_atomic_fetch_add((LAS unsigned*)cnt, 1u, __ATOMIC_RELAXED, __HIP_MEMORY_SCOPE_WORKGROUP);
  while (*cnt < target) __builtin_amdgcn_s_sleep(1);
  asm volatile("" ::: "memory");
}
DI void scan_group(const Params& p, int sh, int quarter, float* lds, volatile LAS unsigned* cnt, unsigned& nbar) {
  const int tid = TIDX & 255, lane = tid & 63, wid = tid >> 6, cc = lane & 15;
  const size_t base = (size_t)sh * 4096 * 64;
  const int v = quarter * 16 + wid * 4 + (lane >> 4);
  const float* SW = (const float*)(p.ws + WS_SW) + base;
  const bf16_t* SARR = (const bf16_t*)(p.ws + WS_SR) + base;
  float* ORAW = (float*)(p.ws + WS_ORAW) + base;
  f32x2 S01 = {0.f, 0.f}, S23 = {0.f, 0.f};
  const bool b0 = (lane & 1) != 0, b1 = (lane & 2) != 0;
  float4 gw; uint4 gb0, gb1, gb2;
  const int dstw = ((tid >> 4) * 6 + 2) * 64 + (tid & 15) * 4;
  const bf16_t* sb0; const bf16_t* sb1; const bf16_t* sb2; int db0, db1, db2;
  { const int idx = tid, arr = idx >> 7, c = idx & 127, slot = arr == 0 ? 4 : 3; sb0 = SARR + (size_t)arr * (SZ_ACT / 2) + c * 8; db0 = ((c >> 3) * 6 + slot) * 64 + (c & 7) * 8; }
  { const int idx = tid + 256, arr = idx >> 7, c = idx & 127, slot = arr == 2 ? 5 : 0; sb1 = SARR + (size_t)arr * (SZ_ACT / 2) + c * 8; db1 = ((c >> 3) * 6 + slot) * 64 + (c & 7) * 8; }
  { const int idx = (tid & 127) + 512, arr = 4, c = idx & 127; sb2 = SARR + (size_t)arr * (SZ_ACT / 2) + c * 8; db2 = ((c >> 3) * 6 + 1) * 64 + (c & 7) * 8; }
#define SG_GLOAD(ch) do { gw = *(const float4*)(SW + (size_t)(ch) * 1024 + tid * 4); gb0 = *(const uint4*)(sb0 + (size_t)(ch) * 1024); gb1 = *(const uint4*)(sb1 + (size_t)(ch) * 1024); \
    if (tid < 128) gb2 = *(const uint4*)(sb2 + (size_t)(ch) * 1024); } while (0)
#define SG_PUT(d_, g) do { *(float4*)(d_) = make_float4(bflo(g.x), bfhi(g.x), bflo(g.y), bfhi(g.y)); *(float4*)((d_) + 4) = make_float4(bflo(g.z), bfhi(g.z), bflo(g.w), bfhi(g.w)); } while (0)
#define SG_LSTORE(buf) do { float* L_ = lds + (buf) * (16 * 384); *(float4*)(L_ + dstw) = gw; SG_PUT(L_ + db0, gb0); SG_PUT(L_ + db1, gb1); if (tid < 128) SG_PUT(L_ + db2, gb2); } while (0)
  SG_GLOAD(0); SG_LSTORE(0); sgroup_barrier(cnt, 4u * (++nbar));
  for (int ch = 0; ch < 256; ++ch) {
    if (ch + 1 < 256) SG_GLOAD(ch + 1);
    const float* L = lds + (ch & 1) * (16 * 384);
    float okeep = 0.f;
    const float* Lc = L + 4 * cc;
    f32x4 nk = *(const f32x4*)(Lc), bb = *(const f32x4*)(Lc + 64), ww = *(const f32x4*)(Lc + 128), kv = *(const f32x4*)(Lc + 192), rr = *(const f32x4*)(Lc + 256);
    float vt = L[320 + v];
    f32x4 rrp = rr;
    float po[4];
#pragma unroll
    for (int st = 0; st <= 16; ++st) {
      if (st > 0) { const f32x2 o2 = S01 * rrp.xy + S23 * rrp.zw; po[(st - 1) & 3] = o2.x + o2.y; }
      if (st > 0 && (st & 3) == 0) {
        const float u0 = (b0 ? po[1] : po[0]) + dppf<0xB1>(b0 ? po[0] : po[1]);
        const float u1 = (b0 ? po[3] : po[2]) + dppf<0xB1>(b0 ? po[2] : po[3]);
        float w = (b1 ? u1 : u0) + dppf<0x4E>(b1 ? u0 : u1);
        w += dppf<0x124>(w); w += dppf<0x128>(w);
        okeep = ((cc >> 2) == (st >> 2) - 1) ? w : okeep;
      }
      if (st < 16) {
        const int sn = ((st + 1) & 15) * 384;
        const f32x2 d2 = S01 * nk.xy + S23 * nk.zw;
        float x = d2.x + d2.y;
        const f32x2 vt_2 = {vt, vt};
        const f32x2 t01 = vt_2 * kv.xy, t23 = vt_2 * kv.zw;
        __builtin_amdgcn_sched_barrier(0);
        x += dppf<0xB1>(x);
        const f32x4 nk2 = *(const f32x4*)(Lc + sn), bb2 = *(const f32x4*)(Lc + sn + 64);
        __builtin_amdgcn_sched_barrier(0);
        x += dppf<0x4E>(x);
        const f32x4 ww2 = *(const f32x4*)(Lc + sn + 128), kv2 = *(const f32x4*)(Lc + sn + 192);
        __builtin_amdgcn_sched_barrier(0);
        x += dppf<0x124>(x);
        const f32x4 rr2 = *(const f32x4*)(Lc + sn + 256);
        const float vt2 = L[sn + 320 + v];
        __builtin_amdgcn_sched_barrier(0);
        x += dppf<0x128>(x);
        __builtin_amdgcn_sched_barrier(0);
        const f32x2 sa2 = {x, x};
        S01 = S01 * ww.xy + (sa2 * bb.xy + t01);
        S23 = S23 * ww.zw + (sa2 * bb.zw + t23);
        rrp = rr;
        nk = nk2; bb = bb2; ww = ww2; kv = kv2; rr = rr2; vt = vt2;
      }
    }
    ORAW[(size_t)(ch * 16 + cc) * 64 + v] = okeep;
    if (ch + 1 < 256) SG_LSTORE((ch + 1) & 1);
    sgroup_barrier(cnt, 4u * (++nbar));
  }
  *(float4*)(p.out + OUT_WP + ((size_t)sh * 64 + v) * 64 + 4 * cc) = make_float4(S01.x, S01.y, S23.x, S23.y);
#undef SG_GLOAD
#undef SG_PUT
#undef SG_LSTORE
}

constexpr int NQ_ATT_P = 8192, NQ_ATT_S = 512, NQ_SCAN_S = 8192, NQ_DYN = NQ_ATT_P + NQ_ATT_S + NQ_SCAN_S;
DI int wave_grab(unsigned* ctr) { int v = 0; if ((TIDX & 63) == 0) v = (int)atomicAdd(ctr, 1u); return __builtin_amdgcn_readfirstlane(v); }
DI void phase2(const Params& p, char* smem) {
  __shared__ unsigned s_cnt;
  unsigned* ctl = (unsigned*)(p.ws + WS_CTL);
  const int wid = TIDX >> 6;
  if (TIDX == 0) s_cnt = 0u;
  __syncthreads();
  float* L = (float*)smem + wid * (8 * 384);
  if (wid < 4) {
    unsigned nbar = 0;
    __builtin_amdgcn_s_setprio(3);
    for (int bu = blockIdx.x; bu < 256; bu += gridDim.x) scan_group(p, bu >> 2, bu & 3, (float*)smem + 8 * 8 * 384, (volatile LAS unsigned*)&s_cnt, nbar);
    __builtin_amdgcn_s_setprio(0);
  }
  for (;;) {
    int u = wave_grab(&ctl[0]);
    if (u >= NQ_DYN) break;
    if (u < NQ_ATT_P) { attn_wave<false>(p, u >> 7, u & 127); continue; }
    u -= NQ_ATT_P;
    if (u < NQ_ATT_S) { attn_wave<true>(p, u, 0); continue; }
    u -= NQ_ATT_S;
    scan_wave(p, 64 + (u >> 4), u & 15, L);
  }
}

DI void p2c_row(const Params& p, int row, int c, int hh, const float4& lg, const float4& lb, const float4& o, const uint2& vv, const uint2& zz, float bon) {
  const float mean = sum16((o.x + o.y) + (o.z + o.w)) * (1.f / 64.f);
  const float dx = o.x - mean, dy = o.y - mean, dz = o.z - mean, dw = o.w - mean;
  const float var = sum16((dx * dx + dy * dy) + (dz * dz + dw * dw)) * (1.f / 64.f);
  const float inv = rsqrtf(var + LNX_EPS);
  const float r0 = (dx * inv * lg.x + lb.x + bon * bflo(vv.x)) * bflo(zz.x);
  const float r1 = (dy * inv * lg.y + lb.y + bon * bfhi(vv.x)) * bfhi(zz.x);
  const float r2 = (dz * inv * lg.z + lb.z + bon * bflo(vv.y)) * bflo(zz.y);
  const float r3 = (dw * inv * lg.w + lb.w + bon * bfhi(vv.y)) * bfhi(zz.y);
  *(uint2*)((bf16_t*)(p.ws + WS_OB) + (size_t)row * 1024 + c) = make_uint2(cvtpk(r0, r1), cvtpk(r2, r3));
}
DI void phase2c(const Params& p) {
  const int tid = TIDX & 255, half = TIDX >> 8, c = tid * 4, hh = c >> 6;
  const float4 lg = *(const float4*)(p.in[16] + c), lb = *(const float4*)(p.in[17] + c);
  const float* ORAW = (const float*)(p.ws + WS_ORAW); const bf16_t* SV = (const bf16_t*)(p.ws + WS_SV);
  const bf16_t* SZB = (const bf16_t*)(p.ws + WS_SZB); const float* BONUS = (const float*)(p.ws + WS_BONUS);
  const int stride = gridDim.x * 2;
  for (int row = blockIdx.x * 2 + half; row < MT; row += 2 * stride) {
    const bool two = row + stride < MT;
    const int rowb = two ? row + stride : row;
    const size_t ia = hm_base(row) + hh * hm_hstride(row) + (c & 63), ib = hm_base(rowb) + hh * hm_hstride(rowb) + (c & 63);
    const float4 oa = *(const float4*)(ORAW + ia), ob = *(const float4*)(ORAW + ib);
    const uint2 va = *(const uint2*)(SV + ia), vb = *(const uint2*)(SV + ib);
    const uint2 za = *(const uint2*)(SZB + (size_t)row * 1024 + c), zb = *(const uint2*)(SZB + (size_t)rowb * 1024 + c);
    const float ba = BONUS[(size_t)row * 16 + hh], bb = BONUS[(size_t)rowb * 16 + hh];
    p2c_row(p, row, c, hh, lg, lb, oa, va, za, ba);
    if (two) p2c_row(p, rowb, c, hh, lg, lb, ob, vb, zb, bb);
  }
}

DI void phase4(const Params& p) {
  const int lane = TIDX & 63, wid = TIDX >> 6;
  const float* g = p.in[21];
  float4 gg[4];
#pragma unroll
  for (int i = 0; i < 4; ++i) gg[i] = *(const float4*)(g + i * 256 + lane * 4);
  const int stride = gridDim.x * 8;
  for (int row = blockIdx.x * 8 + wid; row < MT; row += 2 * stride) {
    const bool two = row + stride < MT;
    float* x0 = p.out + OUT_YP + (size_t)row * 1024;
    float* x1 = p.out + OUT_YP + (size_t)(two ? row + stride : row) * 1024;
    float4 v0[4], v1[4]; float s0 = 0.f, s1 = 0.f;
#pragma unroll
    for (int i = 0; i < 4; ++i) { v0[i] = *(const float4*)(x0 + i * 256 + lane * 4); v1[i] = *(const float4*)(x1 + i * 256 + lane * 4); }
#pragma unroll
    for (int i = 0; i < 4; ++i) {
      s0 += v0[i].x * v0[i].x + v0[i].y * v0[i].y + v0[i].z * v0[i].z + v0[i].w * v0[i].w;
      s1 += v1[i].x * v1[i].x + v1[i].y * v1[i].y + v1[i].z * v1[i].z + v1[i].w * v1[i].w;
    }
    s0 = wave_sum(s0); s1 = wave_sum(s1);
    const float i0 = rsqrtf(s0 * (1.f / DM) + EPS), i1 = rsqrtf(s1 * (1.f / DM) + EPS);
#pragma unroll
    for (int i = 0; i < 4; ++i) *(float4*)(x0 + i * 256 + lane * 4) = make_float4(v0[i].x * i0 * gg[i].x, v0[i].y * i0 * gg[i].y, v0[i].z * i0 * gg[i].z, v0[i].w * i0 * gg[i].w);
    if (two) {
#pragma unroll
      for (int i = 0; i < 4; ++i) *(float4*)(x1 + i * 256 + lane * 4) = make_float4(v1[i].x * i1 * gg[i].x, v1[i].y * i1 * gg[i].y, v1[i].z * i1 * gg[i].z, v1[i].w * i1 * gg[i].w);
    }
  }
}

#define XB_TMO      128
#define XB_XCNT(j)  (256  + 64 * (j))
#define XB_XSUB(j)  (1280 + 64 * (j))
#define XB_XGEN(j)  (2304 + 64 * (j))
#define XB_TOP      3328
#define XB_TOPGEN   3392
#define XCD_BAR_WORDS 3456
#define XB_SPIN_CAP (1u << 18)

__device__ __forceinline__ unsigned xb_ld(unsigned* p)              { return __hip_atomic_load(p, __ATOMIC_RELAXED, __HIP_MEMORY_SCOPE_AGENT); }
__device__ __forceinline__ unsigned xb_add(unsigned* p, unsigned v) { return __hip_atomic_fetch_add(p, v, __ATOMIC_RELAXED, __HIP_MEMORY_SCOPE_AGENT); }
__device__ __forceinline__ unsigned xb_xcc_id() { return (unsigned)__builtin_amdgcn_s_getreg((3 << 11) | 20) & 0xFu; }
#define XB_SPIN(cond, bar) do { unsigned _sp = 0; while (cond) { __builtin_amdgcn_s_sleep(1); \
    if ((++_sp & 255u) == 0u) { if (xb_ld(&(bar)[XB_TMO])) break; if (_sp > XB_SPIN_CAP) { atomicAdd(&(bar)[XB_TMO], 1u); break; } } } } while (0)

struct XcdBarrier {
    unsigned* bar; unsigned x;
    volatile LAS unsigned* st;
};

__device__ __forceinline__ XcdBarrier xcd_barrier_post(unsigned* bar, volatile LAS unsigned* st) {
    XcdBarrier b; b.bar = bar; b.x = xb_xcc_id(); b.st = st;
    if (TIDX == 0) (void)xb_add(&bar[XB_XCNT(b.x)], 1u);
    return b;
}
__device__ __forceinline__ void xcd_barrier_complete(unsigned* bar, unsigned x, unsigned& nloc, unsigned& nx) {
    const unsigned G = gridDim.x * gridDim.y * gridDim.z;
    unsigned sum, cnt, mine, sp = 0u;
    for (;;) {
        sum = 0u; cnt = 0u; mine = 0u;
#pragma unroll
        for (unsigned j = 0; j < 16; ++j) { const unsigned c = xb_ld(&bar[XB_XCNT(j)]); sum += c; cnt += (c > 0u) ? 1u : 0u; mine = (j == x) ? c : mine; }
        if (sum == G) break;
        __builtin_amdgcn_s_sleep(1);
        if ((++sp & 255u) == 0u) { if (xb_ld(&bar[XB_TMO])) break; if (sp > XB_SPIN_CAP) { atomicAdd(&bar[XB_TMO], 1u); break; } }
    }
    nloc = mine > 0u ? mine : 1u; nx = cnt > 0u ? cnt : 1u;
}

__device__ __forceinline__ void xcd_barrier(const XcdBarrier& b) {
    asm volatile("s_waitcnt vmcnt(0)" ::: "memory");
    __syncthreads();
    if (TIDX == 0) {
        unsigned* bar = b.bar;
        __builtin_amdgcn_s_waitcnt(0);
        unsigned nloc = b.st[0], nx = b.st[1];
        if (nloc == 0u) { xcd_barrier_complete(bar, b.x, nloc, nx); b.st[0] = nloc; b.st[1] = nx; }
        const unsigned old = xb_add(&bar[XB_XSUB(b.x)], 1u);
        const unsigned gen = old / nloc;
        if (old + 1u == (gen + 1u) * nloc) {
            __builtin_amdgcn_fence(__ATOMIC_RELEASE, "agent");
            asm volatile("s_waitcnt vmcnt(0)" ::: "memory");
            const unsigned og = xb_add(&bar[XB_TOP], 1u);
            const unsigned tg = og / nx;
            if (og + 1u == (tg + 1u) * nx) xb_add(&bar[XB_TOPGEN], 1u);
            else XB_SPIN(xb_ld(&bar[XB_TOPGEN]) == tg, bar);
            __builtin_amdgcn_fence(__ATOMIC_ACQUIRE, "agent");
            xb_add(&bar[XB_XGEN(b.x)], 1u);
            asm volatile("s_waitcnt vmcnt(0)" ::: "memory");
        } else {
            XB_SPIN(xb_ld(&bar[XB_XGEN(b.x)]) == gen, bar);
            __builtin_amdgcn_fence(__ATOMIC_ACQUIRE, "agent");
            asm volatile("s_waitcnt vmcnt(0)" ::: "memory");
        }
    }
    __syncthreads();
}

__global__ void __launch_bounds__(NT, 2) mega(Params p) {
  extern __shared__ __attribute__((aligned(16))) char smem[];
  cg::grid_group grid = cg::this_grid();
  if (blockIdx.x == 0) { unsigned* ctl = (unsigned*)(p.ws + WS_CTL); for (int i = TIDX; i < 16384; i += NT) ctl[i] = 0u; }
  grid.sync();
  __shared__ unsigned xb_st[2];
  if (TIDX == 0) { xb_st[0] = 0u; xb_st[1] = 0u; }
  __syncthreads();
  (void)xcd_barrier_post((unsigned*)(p.ws + WS_CTL) + 8192, (volatile LAS unsigned*)xb_st);
#define XBAR() do { XcdBarrier xb_; xb_.bar = (unsigned*)(p.ws + WS_CTL) + 8192; xb_.x = xb_xcc_id(); xb_.st = (volatile LAS unsigned*)xb_st; xcd_barrier(xb_); } while (0)
  phase0(p, smem);
  XBAR();
  { EpiP1 E; E.p = p; run_gemm(smem, (const bf16_t*)(p.ws + WS_H), (const bf16_t*)(p.ws + WS_WINT), MT, NINP, E); }
  XBAR();
  phase_x(p);
  XBAR();
  { EpiLora E; E.p = p; run_gemm(smem, (const bf16_t*)(p.ws + WS_X), (const bf16_t*)(p.ws + WS_BTL), MT, 2048, E, 256); }
  XBAR();
  phase1c(p);
  XBAR();
  phase2(p, smem);
  XBAR();
  phase2c(p);
  XBAR();
  { EpiGate E; E.p = p; E.goff = 0; E.first = true; run_gemm(smem, (const bf16_t*)(p.ws + WS_QB), (const bf16_t*)(p.ws + WS_WT), MP, 1024, E); }
  small_gemm<0>(p, (const bf16_t*)(p.ws + WS_QB), (const bf16_t*)(p.ws + WS_WT));
  { EpiGate E; E.p = p; E.goff = 1024; E.first = false; run_gemm(smem, (const bf16_t*)(p.ws + WS_OB), (const bf16_t*)(p.ws + WS_WT) + (size_t)1024 * 1024, MP, 1024, E); }
  small_gemm<1>(p, (const bf16_t*)(p.ws + WS_OB), (const bf16_t*)(p.ws + WS_WT) + (size_t)1024 * 1024);
  XBAR();
  { EpiOut E; E.p = p; run_gemm(smem, (const bf16_t*)(p.ws + WS_MG), (const bf16_t*)(p.ws + WS_WT) + (size_t)2 * 1024 * 1024, MP, 1024, E); }
  small_gemm<2>(p, (const bf16_t*)(p.ws + WS_MG), (const bf16_t*)(p.ws + WS_WT) + (size_t)2 * 1024 * 1024);
  XBAR();
  phase4(p);
}

extern "C" void kernel_launch(void* const* d_in, const int* in_sizes, int n_in, void* d_out, int out_size, void* d_ws, size_t ws_size, hipStream_t stream) {
  static int grid_blocks = 0;
  if (grid_blocks == 0) {
    if (n_in != 22 || ws_size < WS_END) { fprintf(stderr, "kernel_launch: unexpected n_in %d / ws_size %zu (need %zu)\n", n_in, ws_size, (size_t)WS_END); grid_blocks = -1; return; }
    int dev = 0, cus = 0, per_cu = 0;
    (void)hipGetDevice(&dev);
    (void)hipDeviceGetAttribute(&cus, hipDeviceAttributeMultiprocessorCount, dev);
    (void)hipFuncSetAttribute((const void*)mega, hipFuncAttributeMaxDynamicSharedMemorySize, SMEM_BYTES);
    (void)hipOccupancyMaxActiveBlocksPerMultiprocessor(&per_cu, (const void*)mega, NT, SMEM_BYTES);
    (void)hipGetLastError();
    grid_blocks = cus;
  }
  if (grid_blocks < 0) return;
  Params p{};
  for (int i = 0; i < 22; ++i) p.in[i] = (const float*)d_in[i];
  p.out = (float*)d_out; p.ws = (unsigned char*)d_ws;
  void* args[] = {&p};
  hipError_t e = hipLaunchCooperativeKernel((const void*)mega, dim3(grid_blocks), dim3(NT), args, SMEM_BYTES, stream);
  if (e != hipSuccess) fprintf(stderr, "cooperative launch failed: %s (grid %d)\n", hipGetErrorString(e), grid_blocks);
}
```

```cpp
#include <hip/hip_runtime.h>
#include <hip/hip_cooperative_groups.h>
#include <cstdio>
#include <cstdint>
namespace cg = cooperative_groups;
__device__ __forceinline__ int lane_id_() { return (int)__builtin_amdgcn_mbcnt_hi(~0u, __builtin_amdgcn_mbcnt_lo(~0u, 0u)); }
#define TIDX (__builtin_amdgcn_readfirstlane((int)(threadIdx.x >> 6)) * 64 + lane_id_())

namespace pg8 {
#define PG8_LAS __attribute__((address_space(3)))
typedef unsigned short bf16_t;
typedef short bf16x8 __attribute__((ext_vector_type(8)));
typedef float f32x4 __attribute__((ext_vector_type(4)));
typedef unsigned u32x4 __attribute__((ext_vector_type(4)));
constexpr int BM = 256, BK = 64, HALF = 128, HTB = HALF * BK * 2  , STAGE_BYTES = 8 * HTB, NXCD = 8, WGM = 8;

__host__ __device__ __forceinline__ int lds_byte(int r, int c) { const int st = (r >> 4) * 2 + (c >> 5), rr = r & 15, cc = c & 31, ob = rr * 64 + cc * 2; return st * 1024 + (ob ^ (((ob >> 9) & 1) << 5)); }
__host__ __device__ __forceinline__ void stage_rc(int b, int& R, int& C) { const int st = b / 1024, sb = b % 1024, swz = sb ^ (((sb >> 9) & 1) << 5); R = (st >> 1) * 16 + swz / 64; C = (st & 1) * 32 + (swz % 64) / 2; }
__host__ __device__ __forceinline__ int perm32(int rho) { const int n = rho >> 4, i = rho & 15; return 8 * (i >> 2) + 4 * n + (i & 3); }

struct Unit { int pm, pn; };
struct Gemm { const bf16_t* A; const bf16_t* Bt; int M, N, K; };

struct StaticOrder {
    int nM, nN, nwg, G, c;
    __host__ __device__ void init(int M, int N, int G_, int c_) { nM = M / BM; nN = N / BM; nwg = nM * nN; G = G_; c = c_; }
    __host__ __device__ bool next(int i, Unit& u) const {
        const long L = (long)i * G + c; if (L >= nwg) return false;
        int wgid = (int)L; { const int q = nwg / NXCD, r = nwg % NXCD, xcd = wgid % NXCD, off = wgid / NXCD; wgid = (xcd < r ? xcd * (q + 1) : r * (q + 1) + (xcd - r) * q) + off; }
        const int nig = WGM * nN, gid = wgid / nig, fm = gid * WGM, gsz = (nM - fm) < WGM ? (nM - fm) : WGM;
        u.pm = fm + ((wgid % nig) % gsz); u.pn = (wgid % nig) / gsz; return true;
    }
    __device__ __forceinline__ void a_ready(const Unit&) const {}
    __device__ __forceinline__ void done(const Unit&) const {}
};


template <class Epi, class Sched, bool ALIGN_EPI = false, bool SP2 = false>
__device__ __forceinline__ void gemm_phase(PG8_LAS unsigned char* lds, const Gemm g, const Sched& S, const Epi& E) {
    int tid_ = TIDX; asm volatile("" : "+v"(tid_));
    const int tid = tid_, wid = __builtin_amdgcn_readfirstlane(tid >> 6), lane = tid & 63, wr = wid >> 2, wc = wid & 3, fr = lane & 15, fq = lane >> 4;
    const int K = g.K, nt = K / BK;
    unsigned voffA[2], voffB[2];
#pragma unroll
    for (int i = 0; i < 2; ++i) { int R, C; stage_rc(tid * 16 + i * 8192, R, C); const int Rb = Epi::PERM ? ((R & ~31) + perm32(R & 31)) : R;
        voffA[i] = (unsigned)(R * K + C) * 2u; voffB[i] = (unsigned)(Rb * K + C) * 2u; }
    const size_t kstep = (size_t)(BK * 2);
    const size_t hstep = (size_t)HALF * K * 2;
    const size_t tstep = 2 * hstep;
    const unsigned ldsw = (unsigned)wid * 1024u;
    const int aoff = lds_byte(wr * 64 + fr, fq * 8), boff = lds_byte(wc * 32 + fr, fq * 8);
#define PG8_SA(b, h) (((b) * 2 + (h)) * HTB)
#define PG8_SB(b, h) ((4 + (b) * 2 + (h)) * HTB)
#define PG8_STAGE(bufoff, gbase, voff) do { _Pragma("unroll") for (int _i = 0; _i < 2; ++_i) \
        __builtin_amdgcn_global_load_lds((const unsigned*)((const char*)(gbase) + (voff)[_i]), (PG8_LAS unsigned*)(lds + (bufoff) + ldsw + _i * 8192), 16, 0, 0); } while (0)
#define PG8_LDA(dst, b, h) do { _Pragma("unroll") for (int m = 0; m < 4; ++m) _Pragma("unroll") for (int k = 0; k < 2; ++k) dst[m][k] = *(const PG8_LAS bf16x8*)(lds + PG8_SA(b, h) + aoff + m * 2048 + k * 1024); } while (0)
#define PG8_LDB(dst, b, h) do { _Pragma("unroll") for (int n = 0; n < 2; ++n) _Pragma("unroll") for (int k = 0; k < 2; ++k) dst[n][k] = *(const PG8_LAS bf16x8*)(lds + PG8_SB(b, h) + boff + n * 2048 + k * 1024); } while (0)
#define PG8_MMA(ai, bj, At, Bt) do { __builtin_amdgcn_s_setprio(1); _Pragma("unroll") for (int m = 0; m < 4; ++m) _Pragma("unroll") for (int n = 0; n < 2; ++n) _Pragma("unroll") for (int k = 0; k < 2; ++k) \
        acc[ai][bj][m][n] = __builtin_amdgcn_mfma_f32_16x16x32_bf16(Bt[n][k], At[m][k], acc[ai][bj][m][n], 0, 0, 0); __builtin_amdgcn_s_setprio(0); } while (0)
#define PG8_WAIT_V(n) asm volatile("s_waitcnt vmcnt(" #n ")" ::: "memory")
#define PG8_WAIT_L(n) asm volatile("s_waitcnt lgkmcnt(" #n ")" ::: "memory")
#define PG8_BAR __builtin_amdgcn_s_barrier()
#define PG8_SCHED __builtin_amdgcn_sched_barrier(0)
    Unit cur, nxt; int ui = 0;
    if (!S.next(0, cur)) return;
    f32x4 acc[2][2][4][2];
#pragma unroll
    for (int a = 0; a < 2; ++a)
#pragma unroll
        for (int b = 0; b < 2; ++b)
#pragma unroll
            for (int m = 0; m < 4; ++m)
#pragma unroll
                for (int n = 0; n < 2; ++n) acc[a][b][m][n] = (f32x4){0.f, 0.f, 0.f, 0.f};
    bf16x8 At[4][2], B0[2][2], B1[2][2];
    const char* cA = (const char*)g.A + (size_t)cur.pm * tstep; const char* cB = (const char*)g.Bt + (size_t)cur.pn * tstep;
    S.a_ready(cur);
    if constexpr (SP2) {
        PG8_STAGE(PG8_SB(0, 0), cB, voffB); PG8_STAGE(PG8_SB(0, 1), cB + hstep, voffB); PG8_STAGE(PG8_SA(0, 0), cA, voffA); PG8_STAGE(PG8_SA(0, 1), cA + hstep, voffA);
        if (wr == 1) PG8_BAR;
        PG8_WAIT_V(2); PG8_BAR;
        PG8_STAGE(PG8_SB(1, 0), cB + kstep, voffB); PG8_STAGE(PG8_SA(1, 0), cA + kstep, voffA); PG8_STAGE(PG8_SB(1, 1), cB + hstep + kstep, voffB);
        PG8_WAIT_V(6); PG8_BAR;
    } else {
        PG8_STAGE(PG8_SB(0, 0), cB, voffB); PG8_STAGE(PG8_SA(0, 0), cA, voffA); PG8_STAGE(PG8_SB(0, 1), cB + hstep, voffB); PG8_STAGE(PG8_SA(0, 1), cA + hstep, voffA);
        if (wr == 1) PG8_BAR;
        PG8_WAIT_V(4); PG8_BAR;
        PG8_STAGE(PG8_SB(1, 0), cB + kstep, voffB); PG8_STAGE(PG8_SA(1, 0), cA + kstep, voffA); PG8_STAGE(PG8_SB(1, 1), cB + hstep + kstep, voffB);
        PG8_WAIT_V(6); PG8_BAR;
    }
    for (;;) {
        const bool has_next = S.next(ui + 1, nxt);
        const char* nA = has_next ? (const char*)g.A + (size_t)nxt.pm * tstep : cA; const char* nB = has_next ? (const char*)g.Bt + (size_t)nxt.pn * tstep : cB;
        for (int t = 0; t < nt; t += 2) {
            const bool last = (t == nt - 2);
            const char* a1 = cA + (size_t)(t + 1) * kstep;
            const char* a2 = last ? nA : cA + (size_t)(t + 2) * kstep; const char* b2 = last ? nB : cB + (size_t)(t + 2) * kstep;
            const char* a3 = a2 + kstep; const char* b3 = b2 + kstep;
            if (last && has_next) S.a_ready(nxt);
            if constexpr (SP2) {
            PG8_LDB(B0, 0, 0); PG8_LDB(B1, 0, 1); PG8_SCHED; PG8_LDA(At, 0, 0); PG8_STAGE(PG8_SA(1, 1), a1 + hstep, voffA);
            PG8_WAIT_V(8); PG8_WAIT_L(0); PG8_BAR; PG8_MMA(0, 0, At, B0); PG8_MMA(0, 1, At, B1); PG8_BAR; PG8_SCHED;
            PG8_LDA(At, 0, 1); PG8_STAGE(PG8_SB(0, 0), b2, voffB); PG8_STAGE(PG8_SB(0, 1), b2 + hstep, voffB); PG8_STAGE(PG8_SA(0, 0), a2, voffA);
            PG8_WAIT_V(8); PG8_WAIT_L(0); PG8_BAR; PG8_MMA(1, 0, At, B0); PG8_MMA(1, 1, At, B1); PG8_BAR; PG8_SCHED;
            PG8_LDB(B0, 1, 0); PG8_LDB(B1, 1, 1); PG8_SCHED; PG8_LDA(At, 1, 0); PG8_STAGE(PG8_SA(0, 1), a2 + hstep, voffA);
            PG8_WAIT_V(8); PG8_WAIT_L(0); PG8_BAR; PG8_MMA(0, 0, At, B0); PG8_MMA(0, 1, At, B1); PG8_BAR; PG8_SCHED;
            PG8_LDA(At, 1, 1); PG8_STAGE(PG8_SB(1, 0), b3, voffB); PG8_STAGE(PG8_SB(1, 1), b3 + hstep, voffB); PG8_STAGE(PG8_SA(1, 0), a3, voffA);
            PG8_WAIT_V(8); PG8_WAIT_L(0); PG8_BAR; PG8_MMA(1, 0, At, B0); PG8_MMA(1, 1, At, B1); PG8_BAR; PG8_SCHED;
            } else {
            PG8_LDB(B0, 0, 0); PG8_SCHED; PG8_LDA(At, 0, 0); PG8_STAGE(PG8_SA(1, 1), a1 + hstep, voffA);
            PG8_WAIT_L(8); PG8_BAR; PG8_WAIT_L(0); PG8_MMA(0, 0, At, B0); PG8_BAR; PG8_SCHED;
            PG8_LDB(B1, 0, 1); PG8_STAGE(PG8_SB(0, 0), b2, voffB);
            PG8_BAR; PG8_WAIT_L(0); PG8_MMA(0, 1, At, B1); PG8_BAR;
            PG8_LDA(At, 0, 1); PG8_STAGE(PG8_SA(0, 0), a2, voffA);
            PG8_BAR; PG8_WAIT_L(0); PG8_MMA(1, 0, At, B0); PG8_BAR; PG8_SCHED;
            PG8_STAGE(PG8_SB(0, 1), b2 + hstep, voffB);
            PG8_WAIT_V(6); PG8_BAR; PG8_MMA(1, 1, At, B1); PG8_BAR;
            PG8_LDB(B0, 1, 0); PG8_SCHED; PG8_LDA(At, 1, 0); PG8_STAGE(PG8_SA(0, 1), a2 + hstep, voffA);
            PG8_WAIT_L(8); PG8_BAR; PG8_WAIT_L(0); PG8_MMA(0, 0, At, B0); PG8_BAR; PG8_SCHED;
            PG8_LDB(B1, 1, 1); PG8_STAGE(PG8_SB(1, 0), b3, voffB);
            PG8_BAR; PG8_WAIT_L(0); PG8_MMA(0, 1, At, B1); PG8_BAR;
            PG8_LDA(At, 1, 1); PG8_STAGE(PG8_SA(1, 0), a3, voffA);
            PG8_BAR; PG8_WAIT_L(0); PG8_MMA(1, 0, At, B0); PG8_BAR; PG8_SCHED;
            PG8_STAGE(PG8_SB(1, 1), b3 + hstep, voffB);
            PG8_WAIT_V(6); PG8_BAR; PG8_MMA(1, 1, At, B1); PG8_BAR;
            }
        }
        if constexpr (ALIGN_EPI) { if (wr == 0) PG8_BAR; }
        if constexpr (!Epi::AFTER_DRAIN) { E(acc, cur, wr, wc, fr, fq); S.done(cur); }
        if (!has_next) break;
#pragma unroll
        for (int a = 0; a < 2; ++a)
#pragma unroll
            for (int b = 0; b < 2; ++b)
#pragma unroll
                for (int m = 0; m < 4; ++m)
#pragma unroll
                    for (int n = 0; n < 2; ++n) acc[a][b][m][n] = (f32x4){0.f, 0.f, 0.f, 0.f};
        cur = nxt; cA = nA; cB = nB; ++ui;
        if constexpr (ALIGN_EPI) { if (wr == 1) PG8_BAR; }
    }
    PG8_WAIT_V(0);
    if constexpr (!ALIGN_EPI) { if (wr == 0) PG8_BAR; }
    PG8_BAR;
    if constexpr (Epi::AFTER_DRAIN) { E.fused(acc, cur, wr, wc, fr, fq, lds, wid, lane); S.done(cur); }
#undef PG8_SA
#undef PG8_SB
#undef PG8_STAGE
#undef PG8_LDA
#undef PG8_LDB
#undef PG8_MMA
#undef PG8_WAIT_V
#undef PG8_WAIT_L
#undef PG8_BAR
#undef PG8_SCHED
}
}


#define DI __device__ __forceinline__
typedef unsigned short bf16_t;
typedef short bf16x8 __attribute__((ext_vector_type(8)));
typedef float f32x4 __attribute__((ext_vector_type(4)));
typedef float f32x2 __attribute__((ext_vector_type(2)));
typedef float f32x16 __attribute__((ext_vector_type(16)));
typedef unsigned u32x4 __attribute__((ext_vector_type(4)));
#define MFMA32(a, b, c) __builtin_amdgcn_mfma_f32_32x32x16_bf16((a), (b), (c), 0, 0, 0)
#define LAS __attribute__((address_space(3)))

constexpr int NT = 512;
constexpr int DM = 1024, MP = 16384, MT = 16896;
constexpr int NIN = 10368, NINP = 10496, CSH = 4224;
constexpr float EPS = 1e-6f, LNX_EPS = 64e-5f;
constexpr float QSCALE = 0.18033688011112042f;

constexpr size_t OUT_YP = 0, OUT_KP = 17301504, OUT_VP = 34078720, OUT_SHP = 50855936, OUT_WP = 50872832,
                 OUT_KS = 51134976, OUT_VS = 51659264, OUT_SHS = 52183552, OUT_WS = 52318720;

constexpr size_t SZ_ACT = (size_t)MT * 1024 * 2;
constexpr size_t WS_R1 = 0;
constexpr size_t WS_H = WS_R1, WS_WINT = WS_R1 + SZ_ACT, WS_SW = WS_R1;
constexpr size_t WS_R2 = (size_t)MT * 1024 * 4;
constexpr size_t WS_PB = WS_R2, WS_ORAW = WS_R2, WS_OB = WS_ORAW + (size_t)MT * 1024 * 4, WS_MG = WS_OB + SZ_ACT;
constexpr size_t WS_R3 = WS_R2 + (size_t)MT * CSH * 2;
constexpr size_t WS_QB = WS_R3, WS_X = WS_QB + SZ_ACT  , WS_BTL = WS_X + (size_t)MT * 256 * 2  , WS_SZA = WS_X + (size_t)MP * 1024 * 2;
static_assert(WS_BTL + (size_t)2048 * 256 * 2 <= WS_SZA, "LoRA buffers");
constexpr size_t WS_SR = WS_SZA + SZ_ACT, WS_SK = WS_SR + SZ_ACT, WS_SV = WS_SK + SZ_ACT, WS_SKK = WS_SV + SZ_ACT, WS_SB = WS_SKK + SZ_ACT;
constexpr size_t WS_SZB = WS_SB + SZ_ACT;
constexpr size_t WS_BONUS = WS_SZB + SZ_ACT;
constexpr size_t WS_WT = WS_BONUS + (size_t)MT * 16 * 4;
constexpr size_t WS_CTL = WS_WT + 3 * (size_t)1024 * 1024 * 2;
constexpr size_t WS_END = WS_CTL + 65536;
static_assert(WS_MG + SZ_ACT <= WS_R3, "R2 overflow");
static_assert(WS_WINT + (size_t)NINP * 1024 * 2 <= WS_R2, "R1 overflow");
static_assert(WS_END <= (size_t)512 * 1024 * 1024, "workspace");

constexpr int SMEM_BYTES = 147456;

struct Params { const float* in[22]; float* out; unsigned char* ws; };

DI float bf2f(bf16_t u) { return __uint_as_float((unsigned)u << 16); }
DI unsigned cvtpk(float lo, float hi) { unsigned r; asm volatile("v_cvt_pk_bf16_f32 %0, %1, %2" : "=v"(r) : "v"(lo), "v"(hi)); return r; }
DI bf16_t f2bf(float x) { return (bf16_t)(cvtpk(x, 0.f) & 0xffffu); }
DI float bflo(unsigned u) { return __uint_as_float(u << 16); }
DI float bfhi(unsigned u) { return __uint_as_float(u & 0xffff0000u); }
DI int crow(int i, int h) { return (i & 3) + 8 * (i >> 2) + 4 * h; }
DI float sigmoidf_(float x) { return fminf(__builtin_amdgcn_rcpf(1.f + __expf(-x)), 1.f); }
DI uint4 pack8(f32x4 a, f32x4 b) { return make_uint4(cvtpk(a[0], a[1]), cvtpk(a[2], a[3]), cvtpk(b[0], b[1]), cvtpk(b[2], b[3])); }
DI float wave_sum(float x) {
#pragma unroll
  for (int o = 32; o > 0; o >>= 1) x += __shfl_xor(x, o);
  return x;
}
DI float sum16(float x) { x += __shfl_xor(x, 1); x += __shfl_xor(x, 2); x += __shfl_xor(x, 4); x += __shfl_xor(x, 8); return x; }
template <int CTRL> DI float dppf(float x) { return __builtin_bit_cast(float, __builtin_amdgcn_mov_dpp(__builtin_bit_cast(int, x), CTRL, 0xf, 0xf, true)); }
DI float row32_sum(float x) {
  x += dppf<0xB1>(x);
  x += dppf<0x4E>(x);
  x += dppf<0x124>(x);
  x += dppf<0x128>(x);
  const auto s = __builtin_amdgcn_permlane16_swap(__float_as_uint(x), __float_as_uint(x), false, false);
  return __uint_as_float(s[0]) + __uint_as_float(s[1]);
}
DI size_t hm_base(int row) {
  if (row < MP) { const int b = row >> 12, t = row & 4095; return ((size_t)(b * 16) * 4096 + t) * 64; }
  const int rs = row - MP, b = rs >> 4, t = rs & 15; return (size_t)MP * 1024 + ((size_t)(b * 16) * 16 + t) * 64;
}
DI size_t hm_hstride(int row) { return row < MP ? (size_t)4096 * 64 : (size_t)16 * 64; }

DI void p0_rmsnorm_rows(const Params& p, int item) {
  const int lane = TIDX & 63, wid = TIDX >> 6;
  const int row = item * 8 + wid;
  const float* x = row < MP ? p.in[0] + (size_t)row * DM : p.in[1] + (size_t)(row - MP) * DM;
  const float* g = p.in[6];
  float4 v[4]; float ss = 0.f;
#pragma unroll
  for (int i = 0; i < 4; ++i) { v[i] = *(const float4*)(x + i * 256 + lane * 4); ss += v[i].x * v[i].x + v[i].y * v[i].y + v[i].z * v[i].z + v[i].w * v[i].w; }
  ss = wave_sum(ss);
  const float inv = rsqrtf(ss * (1.f / DM) + EPS);
  bf16_t* H = (bf16_t*)(p.ws + WS_H) + (size_t)row * DM;
#pragma unroll
  for (int i = 0; i < 4; ++i) {
    const float4 gg = *(const float4*)(g + i * 256 + lane * 4);
    uint2 o; o.x = cvtpk(v[i].x * inv * gg.x, v[i].y * inv * gg.y); o.y = cvtpk(v[i].z * inv * gg.z, v[i].w * inv * gg.w);
    *(uint2*)(H + i * 256 + lane * 4) = o;
  }
}
DI void p0_transpose_tile(const float* src, bf16_t* dst, int N, int kt, int nt, float* lds) {
  const int tid = TIDX & 255;
  const int k0 = kt * 64, n0 = nt * 64;
#pragma unroll
  for (int i = 0; i < 4; ++i) {
    const int row = (tid >> 4) + 16 * i, c4 = (tid & 15) * 4;
    const float4 v = *(const float4*)(src + (size_t)(k0 + row) * N + n0 + c4);
    lds[row * 65 + c4 + 0] = v.x; lds[row * 65 + c4 + 1] = v.y; lds[row * 65 + c4 + 2] = v.z; lds[row * 65 + c4 + 3] = v.w;
  }
  __syncthreads();
  const int n = tid >> 2, kc = (tid & 3) * 16;
  unsigned w[8];
#pragma unroll
  for (int j = 0; j < 8; ++j) w[j] = cvtpk(lds[(kc + 2 * j) * 65 + n], lds[(kc + 2 * j + 1) * 65 + n]);
  uint4* d = (uint4*)(dst + (size_t)(n0 + n) * 1024 + k0 + kc);
  d[0] = make_uint4(w[0], w[1], w[2], w[3]); d[1] = make_uint4(w[4], w[5], w[6], w[7]);
  __syncthreads();
}
DI void phase0(const Params& p, char* smem) {
  {
    bf16_t* BL = (bf16_t*)(p.ws + WS_BTL);
    for (int i = blockIdx.x * NT + TIDX; i < 2048 * 256; i += gridDim.x * NT) {
      const int n = i >> 8, k = i & 255;
      float v = 0.f;
      if (n < 1024) { if (k < 64) v = p.in[10][(size_t)k * 1024 + n]; }
      else if (k >= 64 && k < 128) v = p.in[12][(size_t)(k - 64) * 1024 + (n - 1024)];
      BL[i] = f2bf(v);
    }
  }
  constexpr int N_ROWS = MT / 8, N_TIN = 16 * 162 / 2, N_TSQ = 256 / 2;
  constexpr int N_ITEMS = N_ROWS + N_TIN + 3 * N_TSQ;
  const int half = TIDX >> 8;
  float* scr = (float*)smem + half * (64 * 65);
  for (int it = blockIdx.x; it < N_ITEMS; it += gridDim.x) {
    if (it < N_ROWS) { p0_rmsnorm_rows(p, it); continue; }
    int j = it - N_ROWS;
    if (j < N_TIN) { const int t = 2 * j + half; p0_transpose_tile(p.in[7], (bf16_t*)(p.ws + WS_WINT), NIN, t / 162, t % 162, scr); continue; }
    j -= N_TIN;
    const int w = j / N_TSQ; const int t = 2 * (j % N_TSQ) + half;
    p0_transpose_tile(p.in[18 + w], (bf16_t*)(p.ws + WS_WT) + (size_t)w * 1024 * 1024, 1024, t >> 4, t & 15, scr);
  }
}

struct EpiP1 {
  static constexpr bool PERM = true, AFTER_DRAIN = false;
  Params p;
  DI void operator()(const pg8::f32x4 (&acc)[2][2][4][2], const pg8::Unit& u, int wr, int wc, int fr, int fq) const {
    const int colt = u.pn * 256;
    const int region = colt >> 10;
#pragma unroll
    for (int ai = 0; ai < 2; ++ai)
#pragma unroll
      for (int m = 0; m < 4; ++m) {
        const int row = u.pm * 256 + ai * 128 + wr * 64 + m * 16 + fr;
        const bool prompt = row < MP;
        const int rs = row - MP;
#pragma unroll
        for (int bj = 0; bj < 2; ++bj) {
          const int col = colt + bj * 128 + wc * 32 + 8 * fq;
          const f32x4 v0 = acc[ai][bj][m][0], v1 = acc[ai][bj][m][1];
          if (region >= 6) {
            const int pc = col - 6144;
            if (pc < CSH) {
              *(uint4*)((bf16_t*)(p.ws + WS_PB) + (size_t)row * CSH + pc) = pack8(v0, v1);
              float* so = nullptr;
              if (prompt) { if ((row & 4095) == 4095) so = p.out + OUT_SHP + (size_t)(row >> 12) * CSH + pc; }
              else if ((rs & 15) == 15) so = p.out + OUT_SHS + (size_t)(rs >> 4) * CSH + pc;
              if (so) { *(f32x4*)so = v0; *(f32x4*)(so + 4) = v1; }
            }
          } else if (region == 0) {
            *(uint4*)((bf16_t*)(p.ws + WS_QB) + (size_t)row * 1024 + col) = pack8(v0 * QSCALE, v1 * QSCALE);
          } else if (region == 1) {
            const int c = col - 1024, hh = c >> 6, d = c & 63;
            float* o = prompt ? p.out + OUT_KP + (((size_t)(row >> 12) * 16 + hh) * 4096 + (row & 4095)) * 64 + d
                              : p.out + OUT_KS + (((size_t)(rs >> 4) * 16 + hh) * 16 + (rs & 15)) * 64 + d;
            __builtin_nontemporal_store(v0, (f32x4*)o); __builtin_nontemporal_store(v1, (f32x4*)(o + 4));
          } else if (region == 2) {
            const int c = col - 2048, hh = c >> 6, d = c & 63;
            float* o = prompt ? p.out + OUT_VP + (((size_t)(row >> 12) * 16 + hh) * 4096 + (row & 4095)) * 64 + d
                              : p.out + OUT_VS + (((size_t)(rs >> 4) * 16 + hh) * 16 + (rs & 15)) * 64 + d;
            __builtin_nontemporal_store(v0, (f32x4*)o); __builtin_nontemporal_store(v1, (f32x4*)(o + 4));
          } else if (region == 3) {
            f32x4 a, b;
#pragma unroll
            for (int j = 0; j < 4; ++j) { a[j] = v0[j] * sigmoidf_(v0[j]); b[j] = v1[j] * sigmoidf_(v1[j]); }
            *(uint4*)((bf16_t*)(p.ws + WS_SZA) + (size_t)row * 1024 + (col - 3072)) = pack8(a, b);
          } else {
            f32x4 a, b;
#pragma unroll
            for (int j = 0; j < 4; ++j) { a[j] = sigmoidf_(v0[j]); b[j] = sigmoidf_(v1[j]); }
            *(uint4*)((bf16_t*)p.out + (size_t)row * 2048 + (col - 4096)) = pack8(a, b);
          }
        }
      }
  }
};
struct EpiGate {
  static constexpr bool PERM = true, AFTER_DRAIN = false;
  Params p; int goff; bool first;
  DI void operator()(const pg8::f32x4 (&acc)[2][2][4][2], const pg8::Unit& u, int wr, int wc, int fr, int fq) const {
    const bf16_t* G = (const bf16_t*)p.out; bf16_t* MG = (bf16_t*)(p.ws + WS_MG);
#pragma unroll
    for (int ai = 0; ai < 2; ++ai)
#pragma unroll
      for (int m = 0; m < 4; ++m) {
        const size_t row = u.pm * 256 + ai * 128 + wr * 64 + m * 16 + fr;
#pragma unroll
        for (int bj = 0; bj < 2; ++bj) {
          const int col = u.pn * 256 + bj * 128 + wc * 32 + 8 * fq;
          const uint4 g = *(const uint4*)(G + row * 2048 + goff + col);
          f32x4 a = acc[ai][bj][m][0], b = acc[ai][bj][m][1];
          a[0] *= bflo(g.x); a[1] *= bfhi(g.x); a[2] *= bflo(g.y); a[3] *= bfhi(g.y);
          b[0] *= bflo(g.z); b[1] *= bfhi(g.z); b[2] *= bflo(g.w); b[3] *= bfhi(g.w);
          if (!first) {
            const uint4 o = *(const uint4*)(MG + row * 1024 + col);
            a[0] += bflo(o.x); a[1] += bfhi(o.x); a[2] += bflo(o.y); a[3] += bfhi(o.y);
            b[0] += bflo(o.z); b[1] += bfhi(o.z); b[2] += bflo(o.w); b[3] += bfhi(o.w);
          }
          *(uint4*)(MG + row * 1024 + col) = pack8(a, b);
        }
      }
  }
};
struct EpiOut {
  static constexpr bool PERM = true, AFTER_DRAIN = false;
  Params p;
  DI void operator()(const pg8::f32x4 (&acc)[2][2][4][2], const pg8::Unit& u, int wr, int wc, int fr, int fq) const {
#pragma unroll
    for (int ai = 0; ai < 2; ++ai)
#pragma unroll
      for (int m = 0; m < 4; ++m) {
        const int row = u.pm * 256 + ai * 128 + wr * 64 + m * 16 + fr;
        const float* xr = row < MP ? p.in[0] + (size_t)row * 1024 : p.in[1] + (size_t)(row - MP) * 1024;
        float* orow = p.out + OUT_YP + (size_t)row * 1024;
#pragma unroll
        for (int bj = 0; bj < 2; ++bj) {
          const int col = u.pn * 256 + bj * 128 + wc * 32 + 8 * fq;
          const f32x4 x0 = *(const f32x4*)(xr + col), x1 = *(const f32x4*)(xr + col + 4);
          *(f32x4*)(orow + col) = x0 + acc[ai][bj][m][0]; *(f32x4*)(orow + col + 4) = x1 + acc[ai][bj][m][1];
        }
      }
  }
};
template <class Epi>
DI void run_gemm(char* smem, const bf16_t* A, const bf16_t* Bt, int M, int N, const Epi& E, int K = 1024) {
  pg8::Gemm g; g.A = A; g.Bt = Bt; g.M = M; g.N = N; g.K = K;
  pg8::StaticOrder S; S.init(M, N, (int)gridDim.x, (int)blockIdx.x);
  pg8::gemm_phase<Epi, pg8::StaticOrder, true, true>((LAS unsigned char*)smem, g, S, E);
  __syncthreads();
}

template <int MODE>
DI void small_gemm(const Params& p, const bf16_t* A, const bf16_t* Bt) {
  const int lane = TIDX & 63, wid = TIDX >> 6, r = lane & 31, h = lane >> 5;
  for (int tile = wid * gridDim.x + blockIdx.x; tile < 512; tile += 8 * gridDim.x) {
    const int row0 = MP + (tile >> 5) * 32, col0 = (tile & 31) * 32;
    const bf16_t* pa = A + (size_t)(row0 + r) * 1024 + 8 * h;
    const bf16_t* pb = Bt + (size_t)(col0 + r) * 1024 + 8 * h;
    f32x16 acc;
#pragma unroll
    for (int i = 0; i < 16; ++i) acc[i] = 0.f;
#pragma unroll 8
    for (int s = 0; s < 64; ++s) acc = MFMA32(*(const bf16x8*)(pa + 16 * s), *(const bf16x8*)(pb + 16 * s), acc);
    const int col = col0 + r;
#pragma unroll
    for (int i = 0; i < 16; ++i) {
      const size_t row = row0 + crow(i, h);
      if (MODE == 2) p.out[OUT_YP + row * 1024 + col] = p.in[1][(row - MP) * 1024 + col] + acc[i];
      else {
        bf16_t* mg = (bf16_t*)(p.ws + WS_MG) + row * 1024 + col;
        const float g = bf2f(((const bf16_t*)p.out)[row * 2048 + (MODE == 1 ? 1024 : 0) + col]);
        *mg = f2bf((MODE == 1 ? bf2f(*mg) : 0.f) + acc[i] * g);
      }
    }
  }
}

DI float tanh_fast(float x) { return 1.f - 2.f * __builtin_amdgcn_rcpf(1.f + __expf(2.f * x)); }
DI void phase_x(const Params& p) {
  const bf16_t* PB = (const bf16_t*)(p.ws + WS_PB);
  bf16_t* X = (bf16_t*)(p.ws + WS_X);
  const float* mu = p.in[8];
  for (int i = blockIdx.x * NT + TIDX; i < MT * 32; i += gridDim.x * NT) {
    const int row = i >> 5, g = i & 31;
    uint4 o = make_uint4(0u, 0u, 0u, 0u);
    if (g < 16) {
      const int col = 3072 + g * 8;
      const bool prompt = row < MP;
      const int t = prompt ? (row & 4095) : ((row - MP) & 15);
      const uint4 a = *(const uint4*)(PB + (size_t)row * CSH + col);
      float c[8] = {bflo(a.x), bfhi(a.x), bflo(a.y), bfhi(a.y), bflo(a.z), bfhi(a.z), bflo(a.w), bfhi(a.w)}, q[8];
      if (t != 0) { const uint4 b = *(const uint4*)(PB + (size_t)(row - 1) * CSH + col); q[0] = bflo(b.x); q[1] = bfhi(b.x); q[2] = bflo(b.y); q[3] = bfhi(b.y); q[4] = bflo(b.z); q[5] = bfhi(b.z); q[6] = bflo(b.w); q[7] = bfhi(b.w); }
      else if (prompt) {
#pragma unroll
        for (int j = 0; j < 8; ++j) q[j] = 0.f;
      } else { const float* s = p.in[4] + (size_t)((row - MP) >> 4) * CSH + col; const float4 b0 = *(const float4*)s, b1 = *(const float4*)(s + 4); q[0] = b0.x; q[1] = b0.y; q[2] = b0.z; q[3] = b0.w; q[4] = b1.x; q[5] = b1.y; q[6] = b1.z; q[7] = b1.w; }
      const float4 u0 = *(const float4*)(mu + col), u1 = *(const float4*)(mu + col + 4);
      const float u[8] = {u0.x, u0.y, u0.z, u0.w, u1.x, u1.y, u1.z, u1.w};
      float m[8];
#pragma unroll
      for (int j = 0; j < 8; ++j) { m[j] = c[j] + u[j] * (q[j] - c[j]); if (g < 8) m[j] = tanh_fast(m[j]); }
      o = make_uint4(cvtpk(m[0], m[1]), cvtpk(m[2], m[3]), cvtpk(m[4], m[5]), cvtpk(m[6], m[7]));
    }
    *(uint4*)(X + (size_t)row * 256 + g * 8) = o;
  }
}
struct EpiLora {
  static constexpr bool PERM = true, AFTER_DRAIN = false;
  Params p;
  DI void operator()(const pg8::f32x4 (&acc)[2][2][4][2], const pg8::Unit& u, int wr, int wc, int fr, int fq) const {
    const bool isw = u.pn < 4;
#pragma unroll
    for (int ai = 0; ai < 2; ++ai)
#pragma unroll
      for (int m = 0; m < 4; ++m) {
        const int row = u.pm * 256 + ai * 128 + wr * 64 + m * 16 + fr;
        const size_t hb = hm_base(row), hs = hm_hstride(row);
#pragma unroll
        for (int bj = 0; bj < 2; ++bj) {
          const int c = (u.pn & 3) * 256 + bj * 128 + wc * 32 + 8 * fq;
          const size_t idx = hb + (c >> 6) * hs + (c & 63);
          const f32x4 v0 = acc[ai][bj][m][0], v1 = acc[ai][bj][m][1];
          if (isw) {
            const f32x4 b0 = *(const f32x4*)(p.in[9] + c), b1 = *(const f32x4*)(p.in[9] + c + 4);
            f32x4 d0, d1;
#pragma unroll
            for (int j = 0; j < 4; ++j) {
              const float x0 = -(b0[j] + v0[j]), x1 = -(b1[j] + v1[j]);
              const float s0 = fmaxf(x0, 0.f) + __logf(1.f + __expf(-fabsf(x0))), s1 = fmaxf(x1, 0.f) + __logf(1.f + __expf(-fabsf(x1)));
              d0[j] = __expf(-__expf(-s0 - 0.5f)); d1[j] = __expf(-__expf(-s1 - 0.5f));
            }
            float* o = (float*)(p.ws + WS_SW) + idx; *(f32x4*)o = d0; *(f32x4*)(o + 4) = d1;
          } else {
            const f32x4 b0 = *(const f32x4*)(p.in[11] + c), b1 = *(const f32x4*)(p.in[11] + c + 4);
            f32x4 d0, d1;
#pragma unroll
            for (int j = 0; j < 4; ++j) { d0[j] = sigmoidf_(b0[j] + v0[j]); d1[j] = sigmoidf_(b1[j] + v1[j]); }
            *(uint4*)((bf16_t*)(p.ws + WS_SB) + idx) = pack8(d0, d1);
          }
        }
      }
  }
};
DI void phase1c(const Params& p) {
  const int tid = TIDX & 255, half = TIDX >> 8, c = tid * 4, hh = c >> 6;
  const bf16_t* PB = (const bf16_t*)(p.ws + WS_PB);
  const float* mu = p.in[8];
  const float4 kkw = *(const float4*)(p.in[13] + c), kaw = *(const float4*)(p.in[14] + c), rkw = *(const float4*)(p.in[15] + c);
  const float4 mur = *(const float4*)(mu + c), muk = *(const float4*)(mu + 1024 + c), muv = *(const float4*)(mu + 2048 + c), muz = *(const float4*)(mu + 3200 + c);
  const float kka[4] = {kkw.x, kkw.y, kkw.z, kkw.w}, kaa[4] = {kaw.x, kaw.y, kaw.z, kaw.w}, rka[4] = {rkw.x, rkw.y, rkw.z, rkw.w};
  const float mura[4] = {mur.x, mur.y, mur.z, mur.w}, muka[4] = {muk.x, muk.y, muk.z, muk.w}, muva[4] = {muv.x, muv.y, muv.z, muv.w}, muza[4] = {muz.x, muz.y, muz.z, muz.w};
  bf16_t* SR = (bf16_t*)(p.ws + WS_SR); bf16_t* SK = (bf16_t*)(p.ws + WS_SK); bf16_t* SV = (bf16_t*)(p.ws + WS_SV);
  bf16_t* SKK = (bf16_t*)(p.ws + WS_SKK); bf16_t* SB = (bf16_t*)(p.ws + WS_SB); bf16_t* SZB = (bf16_t*)(p.ws + WS_SZB);
  float* BONUS = (float*)(p.ws + WS_BONUS);
  for (int r4 = blockIdx.x * 2 + half; r4 < MT / 4; r4 += gridDim.x * 2) {
    const int row0 = r4 * 4;
    const bool prompt = row0 < MP;
    const int t0 = prompt ? (row0 & 4095) : ((row0 - MP) & 15);
    uint2 gr[5], gk[5], gv[5], gz[5], ga[4];
#pragma unroll
    for (int t = 0; t < 5; ++t) {
      const int rr_ = (t == 0 && t0 == 0) ? row0 : row0 + t - 1;
      const bf16_t* pc = PB + (size_t)rr_ * CSH;
      gr[t] = *(const uint2*)(pc + c); gk[t] = *(const uint2*)(pc + 1024 + c); gv[t] = *(const uint2*)(pc + 2048 + c); gz[t] = *(const uint2*)(pc + 3200 + c);
    }
    size_t idx[4];
#pragma unroll
    for (int t = 0; t < 4; ++t) { idx[t] = hm_base(row0 + t) + hh * hm_hstride(row0 + t) + (c & 63); ga[t] = *(const uint2*)(SB + idx[t]); }
    float pr[4], pk[4], pv[4], pz[4];
    if (t0 == 0) {
      if (prompt) {
#pragma unroll
        for (int x = 0; x < 4; ++x) { pr[x] = 0.f; pk[x] = 0.f; pv[x] = 0.f; pz[x] = 0.f; }
      } else {
        const float* s = p.in[4] + (size_t)((row0 - MP) >> 4) * CSH;
        const float4 a = *(const float4*)(s + c), b = *(const float4*)(s + 1024 + c), d = *(const float4*)(s + 2048 + c), e = *(const float4*)(s + 3200 + c);
        pr[0] = a.x; pr[1] = a.y; pr[2] = a.z; pr[3] = a.w; pk[0] = b.x; pk[1] = b.y; pk[2] = b.z; pk[3] = b.w;
        pv[0] = d.x; pv[1] = d.y; pv[2] = d.z; pv[3] = d.w; pz[0] = e.x; pz[1] = e.y; pz[2] = e.z; pz[3] = e.w;
      }
    } else {
      pr[0] = bflo(gr[0].x); pr[1] = bfhi(gr[0].x); pr[2] = bflo(gr[0].y); pr[3] = bfhi(gr[0].y);
      pk[0] = bflo(gk[0].x); pk[1] = bfhi(gk[0].x); pk[2] = bflo(gk[0].y); pk[3] = bfhi(gk[0].y);
      pv[0] = bflo(gv[0].x); pv[1] = bfhi(gv[0].x); pv[2] = bflo(gv[0].y); pv[3] = bfhi(gv[0].y);
      pz[0] = bflo(gz[0].x); pz[1] = bfhi(gz[0].x); pz[2] = bflo(gz[0].y); pz[3] = bfhi(gz[0].y);
    }
#pragma unroll
    for (int t = 0; t < 4; ++t) {
      const int row = row0 + t;
      const float curr[4] = {bflo(gr[t + 1].x), bfhi(gr[t + 1].x), bflo(gr[t + 1].y), bfhi(gr[t + 1].y)}, curk[4] = {bflo(gk[t + 1].x), bfhi(gk[t + 1].x), bflo(gk[t + 1].y), bfhi(gk[t + 1].y)};
      const float curv[4] = {bflo(gv[t + 1].x), bfhi(gv[t + 1].x), bflo(gv[t + 1].y), bfhi(gv[t + 1].y)}, curz[4] = {bflo(gz[t + 1].x), bfhi(gz[t + 1].x), bflo(gz[t + 1].y), bfhi(gz[t + 1].y)};
      const float av[4] = {bflo(ga[t].x), bfhi(ga[t].x), bflo(ga[t].y), bfhi(ga[t].y)};
      float rm[4], km[4], vm[4], kkv[4], bb[4], kmod[4], szb[4];
      float ssq = 0.f, bon = 0.f;
#pragma unroll
      for (int x = 0; x < 4; ++x) {
        rm[x] = curr[x] + mura[x] * (pr[x] - curr[x]);
        km[x] = curk[x] + muka[x] * (pk[x] - curk[x]);
        vm[x] = curv[x] + muva[x] * (pv[x] - curv[x]);
        const float zm = curz[x] + muza[x] * (pz[x] - curz[x]);
        szb[x] = zm * sigmoidf_(zm);
        kkv[x] = km[x] * kka[x];
        ssq += kkv[x] * kkv[x];
        kmod[x] = km[x] * (1.f + (av[x] - 1.f) * kaa[x]);
        bon += rm[x] * kmod[x] * rka[x];
        pr[x] = curr[x]; pk[x] = curk[x]; pv[x] = curv[x]; pz[x] = curz[x];
      }
      ssq = sum16(ssq); bon = sum16(bon);
      const float inv = 1.f / fmaxf(sqrtf(ssq), 1e-12f);
#pragma unroll
      for (int x = 0; x < 4; ++x) { kkv[x] *= inv; bb[x] = kkv[x] * av[x]; }
      *(uint2*)(SR + idx[t]) = make_uint2(cvtpk(rm[0], rm[1]), cvtpk(rm[2], rm[3]));
      *(uint2*)(SK + idx[t]) = make_uint2(cvtpk(kmod[0], kmod[1]), cvtpk(kmod[2], kmod[3]));
      *(uint2*)(SV + idx[t]) = make_uint2(cvtpk(vm[0], vm[1]), cvtpk(vm[2], vm[3]));
      *(uint2*)(SKK + idx[t]) = make_uint2(cvtpk(-kkv[0], -kkv[1]), cvtpk(-kkv[2], -kkv[3]));
      *(uint2*)(SB + idx[t]) = make_uint2(cvtpk(bb[0], bb[1]), cvtpk(bb[2], bb[3]));
      *(uint2*)(SZB + (size_t)row * 1024 + c) = make_uint2(cvtpk(szb[0], szb[1]), cvtpk(szb[2], szb[3]));
      if ((tid & 15) == 0) BONUS[(size_t)row * 16 + hh] = bon;
    }
  }
}

template <bool SAMPLE>
DI void attn_wave(const Params& p, int sh, int qt) {
  const int lane = TIDX & 63, r = lane & 31, h = lane >> 5;
  const int hh = sh & 15, b = sh >> 4;
  bf16_t* QB = (bf16_t*)(p.ws + WS_QB);
  const int row0 = SAMPLE ? MP + b * 16 : b * 4096 + qt * 32;
  bf16_t* Qp = QB + (size_t)row0 * 1024 + hh * 64;
  const int qrow = SAMPLE ? (r < 15 ? r : 15) : r;
  bf16x8 qf[4];
#pragma unroll
  for (int s = 0; s < 4; ++s) qf[s] = *(const bf16x8*)(Qp + (size_t)qrow * 1024 + 16 * s + 8 * h);
  f32x16 z0, z1;
#pragma unroll
  for (int i = 0; i < 16; ++i) { z0[i] = 0.f; z1[i] = 0.f; }
  float carry = 1.f;
  const int ntiles = SAMPLE ? 33 : qt + 1;
  for (int it = 0; it < ntiles; ++it) {
    const bool diag = (it == 0);
    const int kt = SAMPLE ? 32 - it : qt - it;
    bf16x8 kf[4];
    {
      const float* Kp;
      if (!SAMPLE) Kp = p.out + OUT_KP + ((size_t)sh * 4096 + kt * 32 + r) * 64;
      else Kp = diag ? p.out + OUT_KS + ((size_t)sh * 16 + (r < 15 ? r : 15)) * 64 : p.in[2] + ((size_t)sh * 1024 + kt * 32 + r) * 64;
#pragma unroll
      for (int s = 0; s < 4; ++s) {
        const float4 a = *(const float4*)(Kp + 16 * s + 8 * h), bq = *(const float4*)(Kp + 16 * s + 8 * h + 4);
        u32x4 w; w[0] = cvtpk(a.x, a.y); w[1] = cvtpk(a.z, a.w); w[2] = cvtpk(bq.x, bq.y); w[3] = cvtpk(bq.z, bq.w);
        kf[s] = __builtin_bit_cast(bf16x8, w);
      }
    }
    f32x16 st;
#pragma unroll
    for (int i = 0; i < 16; ++i) st[i] = 0.f;
#pragma unroll
    for (int s = 0; s < 4; ++s) st = MFMA32(kf[s], qf[s], st);
    float keep[16], wgt[16];
#pragma unroll
    for (int i = 0; i < 16; ++i) {
      const float e = __builtin_amdgcn_exp2f(st[i]);
      const float kp = __builtin_amdgcn_rcpf(1.f + e);
      bool valid = true;
      if (diag) { const int kr = crow(i, h); valid = SAMPLE ? (kr < r && kr < 16) : (kr < r); }
      keep[i] = valid ? kp : 1.f;
      wgt[i] = valid ? 1.f - kp : 0.f;
    }
    float pp[4], hif[4];
#pragma unroll
    for (int g = 0; g < 4; ++g) {
      const float p4 = (keep[4 * g] * keep[4 * g + 1]) * (keep[4 * g + 2] * keep[4 * g + 3]);
      const auto sw = __builtin_amdgcn_permlane32_swap(__float_as_uint(p4), __float_as_uint(p4), false, false);
      const float lo = __uint_as_float(sw[0]), hi = __uint_as_float(sw[1]);
      pp[g] = lo * hi;
      hif[g] = h ? 1.f : hi;
    }
    float T[4];
    T[3] = carry; T[2] = T[3] * pp[3]; T[1] = T[2] * pp[2]; T[0] = T[1] * pp[1];
    carry = T[0] * pp[0];
#pragma unroll
    for (int g = 0; g < 4; ++g) {
      const float w3 = T[g] * hif[g], w2 = w3 * keep[4 * g + 3], w1 = w2 * keep[4 * g + 2], w0 = w1 * keep[4 * g + 1];
      wgt[4 * g + 3] *= w3; wgt[4 * g + 2] *= w2; wgt[4 * g + 1] *= w1; wgt[4 * g] *= w0;
    }
#pragma unroll
    for (int s = 0; s < 2; ++s) {
      u32x4 pw;
#pragma unroll
      for (int j = 0; j < 4; ++j) pw[j] = cvtpk(wgt[8 * s + 2 * j], wgt[8 * s + 2 * j + 1]);
      const bf16x8 pf = __builtin_bit_cast(bf16x8, pw);
#pragma unroll
      for (int db = 0; db < 2; ++db) {
        bf16x8 vf;
        {
          float vv[8];
#pragma unroll
          for (int j = 0; j < 8; ++j) {
            const int kr = 16 * s + 8 * (j >> 2) + 4 * h + (j & 3);
            const float* vp;
            if (!SAMPLE) vp = p.out + OUT_VP + ((size_t)sh * 4096 + kt * 32 + kr) * 64;
            else vp = diag ? p.out + OUT_VS + ((size_t)sh * 16 + (kr < 15 ? kr : 15)) * 64 : p.in[3] + ((size_t)sh * 1024 + kt * 32 + kr) * 64;
            vv[j] = vp[db * 32 + r];
          }
          u32x4 w; w[0] = cvtpk(vv[0], vv[1]); w[1] = cvtpk(vv[2], vv[3]); w[2] = cvtpk(vv[4], vv[5]); w[3] = cvtpk(vv[6], vv[7]);
          vf = __builtin_bit_cast(bf16x8, w);
        }
        if (db == 0) z0 = MFMA32(pf, vf, z0); else z1 = MFMA32(pf, vf, z1);
      }
    }
    if (__ballot(carry != 0.f) == 0ull) break;
  }
  const bf16_t* SZA = (const bf16_t*)(p.ws + WS_SZA);
#pragma unroll
  for (int i = 0; i < 16; ++i) {
    const int q = crow(i, h);
    if (SAMPLE && q >= 16) continue;
    const size_t o = (size_t)(row0 + q) * 1024 + hh * 64 + r;
    QB[o] = f2bf(z0[i] * bf2f(SZA[o]));
    QB[o + 32] = f2bf(z1[i] * bf2f(SZA[o + 32]));
  }
}

DI float row16_sum(float x) {
  x += dppf<0xB1>(x); x += dppf<0x4E>(x); x += dppf<0x124>(x); x += dppf<0x128>(x);
  return x;
}
DI void scan_wave(const Params& p, int shg, int slice, float* L) {
  const int lane = TIDX & 63, cc = lane & 15;
  const bool prompt = shg < 64;
  const int T = prompt ? 4096 : 16;
  const size_t base = prompt ? (size_t)shg * 4096 * 64 : (size_t)MP * 1024 + (size_t)(shg - 64) * 16 * 64;
  const int v = slice * 4 + (lane >> 4);
  const float* SW = (const float*)(p.ws + WS_SW) + base;
  const bf16_t* SARR = (const bf16_t*)(p.ws + WS_SR) + base;
  float* ORAW = (float*)(p.ws + WS_ORAW) + base;
  float4 S;
  float* wout;
  if (prompt) { S = make_float4(0.f, 0.f, 0.f, 0.f); wout = p.out + OUT_WP + ((size_t)shg * 64 + v) * 64 + 4 * cc; }
  else { S = *(const float4*)(p.in[5] + ((size_t)(shg - 64) * 64 + v) * 64 + 4 * cc); wout = p.out + OUT_WS + ((size_t)(shg - 64) * 64 + v) * 64 + 4 * cc; }
  const int nch = T / 8;
  const int dw0 = ((lane >> 4) * 6 + 2) * 64 + (lane & 15) * 4, dw1 = dw0 + 4 * 384;
  const int db = (lane >> 3) * 384 + (lane & 7) * 8;
  uint4 gw0, gw1, gr, gk, gv, gn, gb;
#define SCAN_GLOAD(ch) do { const float* w_ = SW + (size_t)(ch) * 512; gw0 = *(const uint4*)(w_ + lane * 4); gw1 = *(const uint4*)(w_ + 256 + lane * 4); \
    const bf16_t* a_ = SARR + (size_t)(ch) * 512 + lane * 8; gr = *(const uint4*)a_; gk = *(const uint4*)(a_ + SZ_ACT / 2); gv = *(const uint4*)(a_ + 2 * (SZ_ACT / 2)); \
    gn = *(const uint4*)(a_ + 3 * (SZ_ACT / 2)); gb = *(const uint4*)(a_ + 4 * (SZ_ACT / 2)); } while (0)
#define SCAN_PUT(slot, g) do { float* d_ = L + db + (slot) * 64; *(float4*)d_ = make_float4(bflo(g.x), bfhi(g.x), bflo(g.y), bfhi(g.y)); *(float4*)(d_ + 4) = make_float4(bflo(g.z), bfhi(g.z), bflo(g.w), bfhi(g.w)); } while (0)
#define SCAN_LSTORE() do { *(uint4*)(L + dw0) = gw0; *(uint4*)(L + dw1) = gw1; SCAN_PUT(4, gr); SCAN_PUT(3, gk); SCAN_PUT(5, gv); SCAN_PUT(0, gn); SCAN_PUT(1, gb); \
    asm volatile("s_waitcnt lgkmcnt(0)" ::: "memory"); } while (0)
  SCAN_GLOAD(0);
  asm volatile("s_waitcnt lgkmcnt(0)" ::: "memory");
  SCAN_LSTORE();
  for (int ch = 0; ch < nch; ++ch) {
    if (ch + 1 < nch) SCAN_GLOAD(ch + 1);
    float okeep = 0.f;
    const float* Lc = L + 4 * cc;
    float4 nk = *(const float4*)(Lc), bb = *(const float4*)(Lc + 64), ww = *(const float4*)(Lc + 128), kv = *(const float4*)(Lc + 192), rr = *(const float4*)(Lc + 256);
    float vt = L[320 + v];
#pragma unroll 4
    for (int st = 0; st < 8; ++st) {
      const int sn = ((st + 1) & 7) * 384;
      const float4 nk2 = *(const float4*)(Lc + sn), bb2 = *(const float4*)(Lc + sn + 64), ww2 = *(const float4*)(Lc + sn + 128);
      const float4 kv2 = *(const float4*)(Lc + sn + 192), rr2 = *(const float4*)(Lc + sn + 256);
      const float vt2 = L[sn + 320 + v];
      float d = (S.x * nk.x + S.y * nk.y) + (S.z * nk.z + S.w * nk.w);
      const float sa = row16_sum(d);
      S.x = S.x * ww.x + (sa * bb.x + vt * kv.x);
      S.y = S.y * ww.y + (sa * bb.y + vt * kv.y);
      S.z = S.z * ww.z + (sa * bb.z + vt * kv.z);
      S.w = S.w * ww.w + (sa * bb.w + vt * kv.w);
      float o = (S.x * rr.x + S.y * rr.y) + (S.z * rr.z + S.w * rr.w);
      o = row16_sum(o);
      okeep = (cc == st) ? o : okeep;
      nk = nk2; bb = bb2; ww = ww2; kv = kv2; rr = rr2; vt = vt2;
    }
    if (cc < 8) ORAW[(size_t)(ch * 8 + cc) * 64 + v] = okeep;
    asm volatile("s_waitcnt lgkmcnt(0)" ::: "memory");
    if (ch + 1 < nch) SCAN_LSTORE();
  }
  *(float4*)wout = S;
#undef SCAN_GLOAD
#undef SCAN_PUT
#undef SCAN_LSTORE
}

DI void sgroup_barrier(volatile LAS unsigned* cnt, unsigned target) {
  asm volatile("s_waitcnt lgkmcnt(0)" ::: "memory");
  if ((TIDX & 63) == 0) __hip_atomic_fetch_add((LAS unsigned*)cnt, 1u, __ATOMIC_RELAXED, __HIP_MEMORY_SCOPE_WORKGROUP);
  while (*cnt < target) __builtin_amdgcn_s_sleep(1);
  asm volatile("" ::: "memory");
}
DI void scan_group(const Params& p, int sh, int quarter, float* lds, volatile LAS unsigned* cnt, unsigned& nbar) {
  const int tid = TIDX & 255, lane = tid & 63, wid = tid >> 6, cc = lane & 15;
  const size_t base = (size_t)sh * 4096 * 64;
  const int v = quarter * 16 + wid * 4 + (lane >> 4);
  const float* SW = (const float*)(p.ws + WS_SW) + base;
  const bf16_t* SARR = (const bf16_t*)(p.ws + WS_SR) + base;
  float* ORAW = (float*)(p.ws + WS_ORAW) + base;
  f32x2 S01 = {0.f, 0.f}, S23 = {0.f, 0.f};
  const bool b0 = (lane & 1) != 0, b1 = (lane & 2) != 0;
  float4 gw; uint4 gb0, gb1, gb2;
  const int dstw = ((tid >> 4) * 6 + 2) * 64 + (tid & 15) * 4;
  const bf16_t* sb0; const bf16_t* sb1; const bf16_t* sb2; int db0, db1, db2;
  { const int idx = tid, arr = idx >> 7, c = idx & 127, slot = arr == 0 ? 4 : 3; sb0 = SARR + (size_t)arr * (SZ_ACT / 2) + c * 8; db0 = ((c >> 3) * 6 + slot) * 64 + (c & 7) * 8; }
  { const int idx = tid + 256, arr = idx >> 7, c = idx & 127, slot = arr == 2 ? 5 : 0; sb1 = SARR + (size_t)arr * (SZ_ACT / 2) + c * 8; db1 = ((c >> 3) * 6 + slot) * 64 + (c & 7) * 8; }
  { const int idx = (tid & 127) + 512, arr = 4, c = idx & 127; sb2 = SARR + (size_t)arr * (SZ_ACT / 2) + c * 8; db2 = ((c >> 3) * 6 + 1) * 64 + (c & 7) * 8; }
#define SG_GLOAD(ch) do { gw = *(const float4*)(SW + (size_t)(ch) * 1024 + tid * 4); gb0 = *(const uint4*)(sb0 + (size_t)(ch) * 1024); gb1 = *(const uint4*)(sb1 + (size_t)(ch) * 1024); \
    if (tid < 128) gb2 = *(const uint4*)(sb2 + (size_t)(ch) * 1024); } while (0)
#define SG_PUT(d_, g) do { *(float4*)(d_) = make_float4(bflo(g.x), bfhi(g.x), bflo(g.y), bfhi(g.y)); *(float4*)((d_) + 4) = make_float4(bflo(g.z), bfhi(g.z), bflo(g.w), bfhi(g.w)); } while (0)
#define SG_LSTORE(buf) do { float* L_ = lds + (buf) * (16 * 384); *(float4*)(L_ + dstw) = gw; SG_PUT(L_ + db0, gb0); SG_PUT(L_ + db1, gb1); if (tid < 128) SG_PUT(L_ + db2, gb2); } while (0)
  SG_GLOAD(0); SG_LSTORE(0); sgroup_barrier(cnt, 4u * (++nbar));
  for (int ch = 0; ch < 256; ++ch) {
    if (ch + 1 < 256) SG_GLOAD(ch + 1);
    const float* L = lds + (ch & 1) * (16 * 384);
    float okeep = 0.f;
    const float* Lc = L + 4 * cc;
    f32x4 nk = *(const f32x4*)(Lc), bb = *(const f32x4*)(Lc + 64), ww = *(const f32x4*)(Lc + 128), kv = *(const f32x4*)(Lc + 192), rr = *(const f32x4*)(Lc + 256);
    float vt = L[320 + v];
    f32x4 rrp = rr;
    float po[4];
#pragma unroll
    for (int st = 0; st <= 16; ++st) {
      if (st > 0) { const f32x2 o2 = S01 * rrp.xy + S23 * rrp.zw; po[(st - 1) & 3] = o2.x + o2.y; }
      if (st > 0 && (st & 3) == 0) {
        const float u0 = (b0 ? po[1] : po[0]) + dppf<0xB1>(b0 ? po[0] : po[1]);
        const float u1 = (b0 ? po[3] : po[2]) + dppf<0xB1>(b0 ? po[2] : po[3]);
        float w = (b1 ? u1 : u0) + dppf<0x4E>(b1 ? u0 : u1);
        w += dppf<0x124>(w); w += dppf<0x128>(w);
        okeep = ((cc >> 2) == (st >> 2) - 1) ? w : okeep;
      }
      if (st < 16) {
        const int sn = ((st + 1) & 15) * 384;
        const f32x2 d2 = S01 * nk.xy + S23 * nk.zw;
        float x = d2.x + d2.y;
        const f32x2 vt_2 = {vt, vt};
        const f32x2 t01 = vt_2 * kv.xy, t23 = vt_2 * kv.zw;
        __builtin_amdgcn_sched_barrier(0);
        x += dppf<0xB1>(x);
        const f32x4 nk2 = *(const f32x4*)(Lc + sn), bb2 = *(const f32x4*)(Lc + sn + 64);
        __builtin_amdgcn_sched_barrier(0);
        x += dppf<0x4E>(x);
        const f32x4 ww2 = *(const f32x4*)(Lc + sn + 128), kv2 = *(const f32x4*)(Lc + sn + 192);
        __builtin_amdgcn_sched_barrier(0);
        x += dppf<0x124>(x);
        const f32x4 rr2 = *(const f32x4*)(Lc + sn + 256);
        const float vt2 = L[sn + 320 + v];
        __builtin_amdgcn_sched_barrier(0);
        x += dppf<0x128>(x);
        __builtin_amdgcn_sched_barrier(0);
        const f32x2 sa2 = {x, x};
        S01 = S01 * ww.xy + (sa2 * bb.xy + t01);
        S23 = S23 * ww.zw + (sa2 * bb.zw + t23);
        rrp = rr;
        nk = nk2; bb = bb2; ww = ww2; kv = kv2; rr = rr2; vt = vt2;
      }
    }
    ORAW[(size_t)(ch * 16 + cc) * 64 + v] = okeep;
    if (ch + 1 < 256) SG_LSTORE((ch + 1) & 1);
    sgroup_barrier(cnt, 4u * (++nbar));
  }
  *(float4*)(p.out + OUT_WP + ((size_t)sh * 64 + v) * 64 + 4 * cc) = make_float4(S01.x, S01.y, S23.x, S23.y);
#undef SG_GLOAD
#undef SG_PUT
#undef SG_LSTORE
}

constexpr int NQ_ATT_P = 8192, NQ_ATT_S = 512, NQ_SCAN_S = 8192, NQ_DYN = NQ_ATT_P + NQ_ATT_S + NQ_SCAN_S;
DI int wave_grab(unsigned* ctr) { int v = 0; if ((TIDX & 63) == 0) v = (int)atomicAdd(ctr, 1u); return __builtin_amdgcn_readfirstlane(v); }
DI void phase2(const Params& p, char* smem) {
  __shared__ unsigned s_cnt;
  unsigned* ctl = (unsigned*)(p.ws + WS_CTL);
  const int wid = TIDX >> 6;
  if (TIDX == 0) s_cnt = 0u;
  __syncthreads();
  float* L = (float*)smem + wid * (8 * 384);
  if (wid < 4) {
    unsigned nbar = 0;
    __builtin_amdgcn_s_setprio(3);
    for (int bu = blockIdx.x; bu < 256; bu += gridDim.x) scan_group(p, bu >> 2, bu & 3, (float*)smem + 8 * 8 * 384, (volatile LAS unsigned*)&s_cnt, nbar);
    __builtin_amdgcn_s_setprio(0);
  }
  for (;;) {
    int u = wave_grab(&ctl[0]);
    if (u >= NQ_DYN) break;
    if (u < NQ_ATT_P) { attn_wave<false>(p, u >> 7, u & 127); continue; }
    u -= NQ_ATT_P;
    if (u < NQ_ATT_S) { attn_wave<true>(p, u, 0); continue; }
    u -= NQ_ATT_S;
    scan_wave(p, 64 + (u >> 4), u & 15, L);
  }
}

DI void p2c_row(const Params& p, int row, int c, int hh, const float4& lg, const float4& lb, const float4& o, const uint2& vv, const uint2& zz, float bon) {
  const float mean = sum16((o.x + o.y) + (o.z + o.w)) * (1.f / 64.f);
  const float dx = o.x - mean, dy = o.y - mean, dz = o.z - mean, dw = o.w - mean;
  const float var = sum16((dx * dx + dy * dy) + (dz * dz + dw * dw)) * (1.f / 64.f);
  const float inv = rsqrtf(var + LNX_EPS);
  const float r0 = (dx * inv * lg.x + lb.x + bon * bflo(vv.x)) * bflo(zz.x);
  const float r1 = (dy * inv * lg.y + lb.y + bon * bfhi(vv.x)) * bfhi(zz.x);
  const float r2 = (dz * inv * lg.z + lb.z + bon * bflo(vv.y)) * bflo(zz.y);
  const float r3 = (dw * inv * lg.w + lb.w + bon * bfhi(vv.y)) * bfhi(zz.y);
  *(uint2*)((bf16_t*)(p.ws + WS_OB) + (size_t)row * 1024 + c) = make_uint2(cvtpk(r0, r1), cvtpk(r2, r3));
}
DI void phase2c(const Params& p) {
  const int tid = TIDX & 255, half = TIDX >> 8, c = tid * 4, hh = c >> 6;
  const float4 lg = *(const float4*)(p.in[16] + c), lb = *(const float4*)(p.in[17] + c);
  const float* ORAW = (const float*)(p.ws + WS_ORAW); const bf16_t* SV = (const bf16_t*)(p.ws + WS_SV);
  const bf16_t* SZB = (const bf16_t*)(p.ws + WS_SZB); const float* BONUS = (const float*)(p.ws + WS_BONUS);
  const int stride = gridDim.x * 2;
  for (int row = blockIdx.x * 2 + half; row < MT; row += 2 * stride) {
    const bool two = row + stride < MT;
    const int rowb = two ? row + stride : row;
    const size_t ia = hm_base(row) + hh * hm_hstride(row) + (c & 63), ib = hm_base(rowb) + hh * hm_hstride(rowb) + (c & 63);
    const float4 oa = *(const float4*)(ORAW + ia), ob = *(const float4*)(ORAW + ib);
    const uint2 va = *(const uint2*)(SV + ia), vb = *(const uint2*)(SV + ib);
    const uint2 za = *(const uint2*)(SZB + (size_t)row * 1024 + c), zb = *(const uint2*)(SZB + (size_t)rowb * 1024 + c);
    const float ba = BONUS[(size_t)row * 16 + hh], bb = BONUS[(size_t)rowb * 16 + hh];
    p2c_row(p, row, c, hh, lg, lb, oa, va, za, ba);
    if (two) p2c_row(p, rowb, c, hh, lg, lb, ob, vb, zb, bb);
  }
}

DI void phase4(const Params& p) {
  const int lane = TIDX & 63, wid = TIDX >> 6;
  const float* g = p.in[21];
  float4 gg[4];
#pragma unroll
  for (int i = 0; i < 4; ++i) gg[i] = *(const float4*)(g + i * 256 + lane * 4);
  const int stride = gridDim.x * 8;
  for (int row = blockIdx.x * 8 + wid; row < MT; row += 2 * stride) {
    const bool two = row + stride < MT;
    float* x0 = p.out + OUT_YP + (size_t)row * 1024;
    float* x1 = p.out + OUT_YP + (size_t)(two ? row + stride : row) * 1024;
    float4 v0[4], v1[4]; float s0 = 0.f, s1 = 0.f;
#pragma unroll
    for (int i = 0; i < 4; ++i) { v0[i] = *(const float4*)(x0 + i * 256 + lane * 4); v1[i] = *(const float4*)(x1 + i * 256 + lane * 4); }
#pragma unroll
    for (int i = 0; i < 4; ++i) {
      s0 += v0[i].x * v0[i].x + v0[i].y * v0[i].y + v0[i].z * v0[i].z + v0[i].w * v0[i].w;
      s1 += v1[i].x * v1[i].x + v1[i].y * v1[i].y + v1[i].z * v1[i].z + v1[i].w * v1[i].w;
    }
    s0 = wave_sum(s0); s1 = wave_sum(s1);
    const float i0 = rsqrtf(s0 * (1.f / DM) + EPS), i1 = rsqrtf(s1 * (1.f / DM) + EPS);
#pragma unroll
    for (int i = 0; i < 4; ++i) *(float4*)(x0 + i * 256 + lane * 4) = make_float4(v0[i].x * i0 * gg[i].x, v0[i].y * i0 * gg[i].y, v0[i].z * i0 * gg[i].z, v0[i].w * i0 * gg[i].w);
    if (two) {
#pragma unroll
      for (int i = 0; i < 4; ++i) *(float4*)(x1 + i * 256 + lane * 4) = make_float4(v1[i].x * i1 * gg[i].x, v1[i].y * i1 * gg[i].y, v1[i].z * i1 * gg[i].z, v1[i].w * i1 * gg[i].w);
    }
  }
}

#define XB_TMO      128
#define XB_XCNT(j)  (256  + 64 * (j))
#define XB_XSUB(j)  (1280 + 64 * (j))
#define XB_XGEN(j)  (2304 + 64 * (j))
#define XB_TOP      3328
#define XB_TOPGEN   3392
#define XCD_BAR_WORDS 3456
#define XB_SPIN_CAP (1u << 18)

__device__ __forceinline__ unsigned xb_ld(unsigned* p)              { return __hip_atomic_load(p, __ATOMIC_RELAXED, __HIP_MEMORY_SCOPE_AGENT); }
__device__ __forceinline__ unsigned xb_add(unsigned* p, unsigned v) { return __hip_atomic_fetch_add(p, v, __ATOMIC_RELAXED, __HIP_MEMORY_SCOPE_AGENT); }
__device__ __forceinline__ unsigned xb_xcc_id() { return (unsigned)__builtin_amdgcn_s_getreg((3 << 11) | 20) & 0xFu; }
#define XB_SPIN(cond, bar) do { unsigned _sp = 0; while (cond) { __builtin_amdgcn_s_sleep(1); \
    if ((++_sp & 255u) == 0u) { if (xb_ld(&(bar)[XB_TMO])) break; if (_sp > XB_SPIN_CAP) { atomicAdd(&(bar)[XB_TMO], 1u); break; } } } } while (0)

struct XcdBarrier {
    unsigned* bar; unsigned x;
    volatile LAS unsigned* st;
};

__device__ __forceinline__ XcdBarrier xcd_barrier_post(unsigned* bar, volatile LAS unsigned* st) {
    XcdBarrier b; b.bar = bar; b.x = xb_xcc_id(); b.st = st;
    if (TIDX == 0) (void)xb_add(&bar[XB_XCNT(b.x)], 1u);
    return b;
}
__device__ __forceinline__ void xcd_barrier_complete(unsigned* bar, unsigned x, unsigned& nloc, unsigned& nx) {
    const unsigned G = gridDim.x * gridDim.y * gridDim.z;
    unsigned sum, cnt, mine, sp = 0u;
    for (;;) {
        sum = 0u; cnt = 0u; mine = 0u;
#pragma unroll
        for (unsigned j = 0; j < 16; ++j) { const unsigned c = xb_ld(&bar[XB_XCNT(j)]); sum += c; cnt += (c > 0u) ? 1u : 0u; mine = (j == x) ? c : mine; }
        if (sum == G) break;
        __builtin_amdgcn_s_sleep(1);
        if ((++sp & 255u) == 0u) { if (xb_ld(&bar[XB_TMO])) break; if (sp > XB_SPIN_CAP) { atomicAdd(&bar[XB_TMO], 1u); break; } }
    }
    nloc = mine > 0u ? mine : 1u; nx = cnt > 0u ? cnt : 1u;
}

__device__ __forceinline__ void xcd_barrier(const XcdBarrier& b) {
    asm volatile("s_waitcnt vmcnt(0)" ::: "memory");
    __syncthreads();
    if (TIDX == 0) {
        unsigned* bar = b.bar;
        __builtin_amdgcn_s_waitcnt(0);
        unsigned nloc = b.st[0], nx = b.st[1];
        if (nloc == 0u) { xcd_barrier_complete(bar, b.x, nloc, nx); b.st[0] = nloc; b.st[1] = nx; }
        const unsigned old = xb_add(&bar[XB_XSUB(b.x)], 1u);
        const unsigned gen = old / nloc;
        if (old + 1u == (gen + 1u) * nloc) {
            __builtin_amdgcn_fence(__ATOMIC_RELEASE, "agent");
            asm volatile("s_waitcnt vmcnt(0)" ::: "memory");
            const unsigned og = xb_add(&bar[XB_TOP], 1u);
            const unsigned tg = og / nx;
            if (og + 1u == (tg + 1u) * nx) xb_add(&bar[XB_TOPGEN], 1u);
            else XB_SPIN(xb_ld(&bar[XB_TOPGEN]) == tg, bar);
            __builtin_amdgcn_fence(__ATOMIC_ACQUIRE, "agent");
            xb_add(&bar[XB_XGEN(b.x)], 1u);
            asm volatile("s_waitcnt vmcnt(0)" ::: "memory");
        } else {
            XB_SPIN(xb_ld(&bar[XB_XGEN(b.x)]) == gen, bar);
            __builtin_amdgcn_fence(__ATOMIC_ACQUIRE, "agent");
            asm volatile("s_waitcnt vmcnt(0)" ::: "memory");
        }
    }
    __syncthreads();
}

__global__ void __launch_bounds__(NT, 2) mega(Params p) {
  extern __shared__ __attribute__((aligned(16))) char smem[];
  cg::grid_group grid = cg::this_grid();
  if (blockIdx.x == 0) { unsigned* ctl = (unsigned*)(p.ws + WS_CTL); for (int i = TIDX; i < 16384; i += NT) ctl[i] = 0u; }
  grid.sync();
  __shared__ unsigned xb_st[2];
  if (TIDX == 0) { xb_st[0] = 0u; xb_st[1] = 0u; }
  __syncthreads();
  (void)xcd_barrier_post((unsigned*)(p.ws + WS_CTL) + 8192, (volatile LAS unsigned*)xb_st);
#define XBAR() do { XcdBarrier xb_; xb_.bar = (unsigned*)(p.ws + WS_CTL) + 8192; xb_.x = xb_xcc_id(); xb_.st = (volatile LAS unsigned*)xb_st; xcd_barrier(xb_); } while (0)
  phase0(p, smem);
  XBAR();
  { EpiP1 E; E.p = p; run_gemm(smem, (const bf16_t*)(p.ws + WS_H), (const bf16_t*)(p.ws + WS_WINT), MT, NINP, E); }
  XBAR();
  phase_x(p);
  XBAR();
  { EpiLora E; E.p = p; run_gemm(smem, (const bf16_t*)(p.ws + WS_X), (const bf16_t*)(p.ws + WS_BTL), MT, 2048, E, 256); }
  XBAR();
  phase1c(p);
  XBAR();
  phase2(p, smem);
  XBAR();
  phase2c(p);
  XBAR();
  { EpiGate E; E.p = p; E.goff = 0; E.first = true; run_gemm(smem, (const bf16_t*)(p.ws + WS_QB), (const bf16_t*)(p.ws + WS_WT), MP, 1024, E); }
  small_gemm<0>(p, (const bf16_t*)(p.ws + WS_QB), (const bf16_t*)(p.ws + WS_WT));
  { EpiGate E; E.p = p; E.goff = 1024; E.first = false; run_gemm(smem, (const bf16_t*)(p.ws + WS_OB), (const bf16_t*)(p.ws + WS_WT) + (size_t)1024 * 1024, MP, 1024, E); }
  small_gemm<1>(p, (const bf16_t*)(p.ws + WS_OB), (const bf16_t*)(p.ws + WS_WT) + (size_t)1024 * 1024);
  XBAR();
  { EpiOut E; E.p = p; run_gemm(smem, (const bf16_t*)(p.ws + WS_MG), (const bf16_t*)(p.ws + WS_WT) + (size_t)2 * 1024 * 1024, MP, 1024, E); }
  small_gemm<2>(p, (const bf16_t*)(p.ws + WS_MG), (const bf16_t*)(p.ws + WS_WT) + (size_t)2 * 1024 * 1024);
  XBAR();
  phase4(p);
}

extern "C" void kernel_launch(void* const* d_in, const int* in_sizes, int n_in, void* d_out, int out_size, void* d_ws, size_t ws_size, hipStream_t stream) {
  static int grid_blocks = 0;
  if (grid_blocks == 0) {
    if (n_in != 22 || ws_size < WS_END) { fprintf(stderr, "kernel_launch: unexpected n_in %d / ws_size %zu (need %zu)\n", n_in, ws_size, (size_t)WS_END); grid_blocks = -1; return; }
    int dev = 0, cus = 0, per_cu = 0;
    (void)hipGetDevice(&dev);
    (void)hipDeviceGetAttribute(&cus, hipDeviceAttributeMultiprocessorCount, dev);
    (void)hipFuncSetAttribute((const void*)mega, hipFuncAttributeMaxDynamicSharedMemorySize, SMEM_BYTES);
    (void)hipOccupancyMaxActiveBlocksPerMultiprocessor(&per_cu, (const void*)mega, NT, SMEM_BYTES);
    (void)hipGetLastError();
    grid_blocks = cus;
  }
  if (grid_blocks < 0) return;
  Params p{};
  for (int i = 0; i < 22; ++i) p.in[i] = (const float*)d_in[i];
  p.out = (float*)d_out; p.ws = (unsigned char*)d_ws;
  void* args[] = {&p};
  hipError_t e = hipLaunchCooperativeKernel((const void*)mega, dim3(grid_blocks), dim3(NT), args, SMEM_BYTES, stream);
  if (e != hipSuccess) fprintf(stderr, "cooperative launch failed: %s (grid %d)\n", hipGetErrorString(e), grid_blocks);
}
```

```cpp
#include <hip/hip_runtime.h>
#include <hip/hip_cooperative_groups.h>
#include <cstdio>
#include <cstdint>
namespace cg = cooperative_groups;
__device__ __forceinline__ int lane_id_() { return (int)__builtin_amdgcn_mbcnt_hi(~0u, __builtin_amdgcn_mbcnt_lo(~0u, 0u)); }
#define TIDX (__builtin_amdgcn_readfirstlane((int)(threadIdx.x >> 6)) * 64 + lane_id_())

namespace pg8 {
#define PG8_LAS __attribute__((address_space(3)))
typedef unsigned short bf16_t;
typedef short bf16x8 __attribute__((ext_vector_type(8)));
typedef float f32x4 __attribute__((ext_vector_type(4)));
typedef unsigned u32x4 __attribute__((ext_vector_type(4)));
constexpr int BM = 256, BK = 64, HALF = 128, HTB = HALF * BK * 2  , STAGE_BYTES = 8 * HTB, NXCD = 8, WGM = 8;

__host__ __device__ __forceinline__ int lds_byte(int r, int c) { const int st = (r >> 4) * 2 + (c >> 5), rr = r & 15, cc = c & 31, ob = rr * 64 + cc * 2; return st * 1024 + (ob ^ (((ob >> 9) & 1) << 5)); }
__host__ __device__ __forceinline__ void stage_rc(int b, int& R, int& C) { const int st = b / 1024, sb = b % 1024, swz = sb ^ (((sb >> 9) & 1) << 5); R = (st >> 1) * 16 + swz / 64; C = (st & 1) * 32 + (swz % 64) / 2; }
__host__ __device__ __forceinline__ int perm32(int rho) { const int n = rho >> 4, i = rho & 15; return 8 * (i >> 2) + 4 * n + (i & 3); }

struct Unit { int pm, pn; };
struct Gemm { const bf16_t* A; const bf16_t* Bt; int M, N, K; };

struct StaticOrder {
    int nM, nN, nwg, G, c;
    __host__ __device__ void init(int M, int N, int G_, int c_) { nM = M / BM; nN = N / BM; nwg = nM * nN; G = G_; c = c_; }
    __host__ __device__ bool next(int i, Unit& u) const {
        const long L = (long)i * G + c; if (L >= nwg) return false;
        int wgid = (int)L; { const int q = nwg / NXCD, r = nwg % NXCD, xcd = wgid % NXCD, off = wgid / NXCD; wgid = (xcd < r ? xcd * (q + 1) : r * (q + 1) + (xcd - r) * q) + off; }
        const int nig = WGM * nN, gid = wgid / nig, fm = gid * WGM, gsz = (nM - fm) < WGM ? (nM - fm) : WGM;
        u.pm = fm + ((wgid % nig) % gsz); u.pn = (wgid % nig) / gsz; return true;
    }
    __device__ __forceinline__ void a_ready(const Unit&) const {}
    __device__ __forceinline__ void done(const Unit&) const {}
};


template <class Epi, class Sched, bool ALIGN_EPI = false, bool SP2 = false>
__device__ __forceinline__ void gemm_phase(PG8_LAS unsigned char* lds, const Gemm g, const Sched& S, const Epi& E) {
    int tid_ = TIDX; asm volatile("" : "+v"(tid_));
    const int tid = tid_, wid = __builtin_amdgcn_readfirstlane(tid >> 6), lane = tid & 63, wr = wid >> 2, wc = wid & 3, fr = lane & 15, fq = lane >> 4;
    const int K = g.K, nt = K / BK;
    unsigned voffA[2], voffB[2];
#pragma unroll
    for (int i = 0; i < 2; ++i) { int R, C; stage_rc(tid * 16 + i * 8192, R, C); const int Rb = Epi::PERM ? ((R & ~31) + perm32(R & 31)) : R;
        voffA[i] = (unsigned)(R * K + C) * 2u; voffB[i] = (unsigned)(Rb * K + C) * 2u; }
    const size_t kstep = (size_t)(BK * 2);
    const size_t hstep = (size_t)HALF * K * 2;
    const size_t tstep = 2 * hstep;
    const unsigned ldsw = (unsigned)wid * 1024u;
    const int aoff = lds_byte(wr * 64 + fr, fq * 8), boff = lds_byte(wc * 32 + fr, fq * 8);
#define PG8_SA(b, h) (((b) * 2 + (h)) * HTB)
#define PG8_SB(b, h) ((4 + (b) * 2 + (h)) * HTB)
#define PG8_STAGE(bufoff, gbase, voff) do { _Pragma("unroll") for (int _i = 0; _i < 2; ++_i) \
        __builtin_amdgcn_global_load_lds((const unsigned*)((const char*)(gbase) + (voff)[_i]), (PG8_LAS unsigned*)(lds + (bufoff) + ldsw + _i * 8192), 16, 0, 0); } while (0)
#define PG8_LDA(dst, b, h) do { _Pragma("unroll") for (int m = 0; m < 4; ++m) _Pragma("unroll") for (int k = 0; k < 2; ++k) dst[m][k] = *(const PG8_LAS bf16x8*)(lds + PG8_SA(b, h) + aoff + m * 2048 + k * 1024); } while (0)
#define PG8_LDB(dst, b, h) do { _Pragma("unroll") for (int n = 0; n < 2; ++n) _Pragma("unroll") for (int k = 0; k < 2; ++k) dst[n][k] = *(const PG8_LAS bf16x8*)(lds + PG8_SB(b, h) + boff + n * 2048 + k * 1024); } while (0)
#define PG8_MMA(ai, bj, At, Bt) do { __builtin_amdgcn_s_setprio(1); _Pragma("unroll") for (int m = 0; m < 4; ++m) _Pragma("unroll") for (int n = 0; n < 2; ++n) _Pragma("unroll") for (int k = 0; k < 2; ++k) \
        acc[ai][bj][m][n] = __builtin_amdgcn_mfma_f32_16x16x32_bf16(Bt[n][k], At[m][k], acc[ai][bj][m][n], 0, 0, 0); __builtin_amdgcn_s_setprio(0); } while (0)
#define PG8_WAIT_V(n) asm volatile("s_waitcnt vmcnt(" #n ")" ::: "memory")
#define PG8_WAIT_L(n) asm volatile("s_waitcnt lgkmcnt(" #n ")" ::: "memory")
#define PG8_BAR __builtin_amdgcn_s_barrier()
#define PG8_SCHED __builtin_amdgcn_sched_barrier(0)
    Unit cur, nxt; int ui = 0;
    if (!S.next(0, cur)) return;
    f32x4 acc[2][2][4][2];
#pragma unroll
    for (int a = 0; a < 2; ++a)
#pragma unroll
        for (int b = 0; b < 2; ++b)
#pragma unroll
            for (int m = 0; m < 4; ++m)
#pragma unroll
                for (int n = 0; n < 2; ++n) acc[a][b][m][n] = (f32x4){0.f, 0.f, 0.f, 0.f};
    bf16x8 At[4][2], B0[2][2], B1[2][2];
    const char* cA = (const char*)g.A + (size_t)cur.pm * tstep; const char* cB = (const char*)g.Bt + (size_t)cur.pn * tstep;
    S.a_ready(cur);
    if constexpr (SP2) {
        PG8_STAGE(PG8_SB(0, 0), cB, voffB); PG8_STAGE(PG8_SB(0, 1), cB + hstep, voffB); PG8_STAGE(PG8_SA(0, 0), cA, voffA); PG8_STAGE(PG8_SA(0, 1), cA + hstep, voffA);
        if (wr == 1) PG8_BAR;
        PG8_WAIT_V(2); PG8_BAR;
        PG8_STAGE(PG8_SB(1, 0), cB + kstep, voffB); PG8_STAGE(PG8_SA(1, 0), cA + kstep, voffA); PG8_STAGE(PG8_SB(1, 1), cB + hstep + kstep, voffB);
        PG8_WAIT_V(6); PG8_BAR;
    } else {
        PG8_STAGE(PG8_SB(0, 0), cB, voffB); PG8_STAGE(PG8_SA(0, 0), cA, voffA); PG8_STAGE(PG8_SB(0, 1), cB + hstep, voffB); PG8_STAGE(PG8_SA(0, 1), cA + hstep, voffA);
        if (wr == 1) PG8_BAR;
        PG8_WAIT_V(4); PG8_BAR;
        PG8_STAGE(PG8_SB(1, 0), cB + kstep, voffB); PG8_STAGE(PG8_SA(1, 0), cA + kstep, voffA); PG8_STAGE(PG8_SB(1, 1), cB + hstep + kstep, voffB);
        PG8_WAIT_V(6); PG8_BAR;
    }
    for (;;) {
        const bool has_next = S.next(ui + 1, nxt);
        const char* nA = has_next ? (const char*)g.A + (size_t)nxt.pm * tstep : cA; const char* nB = has_next ? (const char*)g.Bt + (size_t)nxt.pn * tstep : cB;
        for (int t = 0; t < nt; t += 2) {
            const bool last = (t == nt - 2);
            const char* a1 = cA + (size_t)(t + 1) * kstep;
            const char* a2 = last ? nA : cA + (size_t)(t + 2) * kstep; const char* b2 = last ? nB : cB + (size_t)(t + 2) * kstep;
            const char* a3 = a2 + kstep; const char* b3 = b2 + kstep;
            if (last && has_next) S.a_ready(nxt);
            if constexpr (SP2) {
            PG8_LDB(B0, 0, 0); PG8_LDB(B1, 0, 1); PG8_SCHED; PG8_LDA(At, 0, 0); PG8_STAGE(PG8_SA(1, 1), a1 + hstep, voffA);
            PG8_WAIT_V(8); PG8_WAIT_L(0); PG8_BAR; PG8_MMA(0, 0, At, B0); PG8_MMA(0, 1, At, B1); PG8_BAR; PG8_SCHED;
            PG8_LDA(At, 0, 1); PG8_STAGE(PG8_SB(0, 0), b2, voffB); PG8_STAGE(PG8_SB(0, 1), b2 + hstep, voffB); PG8_STAGE(PG8_SA(0, 0), a2, voffA);
            PG8_WAIT_V(8); PG8_WAIT_L(0); PG8_BAR; PG8_MMA(1, 0, At, B0); PG8_MMA(1, 1, At, B1); PG8_BAR; PG8_SCHED;
            PG8_LDB(B0, 1, 0); PG8_LDB(B1, 1, 1); PG8_SCHED; PG8_LDA(At, 1, 0); PG8_STAGE(PG8_SA(0, 1), a2 + hstep, voffA);
            PG8_WAIT_V(8); PG8_WAIT_L(0); PG8_BAR; PG8_MMA(0, 0, At, B0); PG8_MMA(0, 1, At, B1); PG8_BAR; PG8_SCHED;
            PG8_LDA(At, 1, 1); PG8_STAGE(PG8_SB(1, 0), b3, voffB); PG8_STAGE(PG8_SB(1, 1), b3 + hstep, voffB); PG8_STAGE(PG8_SA(1, 0), a3, voffA);
            PG8_WAIT_V(8); PG8_WAIT_L(0); PG8_BAR; PG8_MMA(1, 0, At, B0); PG8_MMA(1, 1, At, B1); PG8_BAR; PG8_SCHED;
            } else {
            PG8_LDB(B0, 0, 0); PG8_SCHED; PG8_LDA(At, 0, 0); PG8_STAGE(PG8_SA(1, 1), a1 + hstep, voffA);
            PG8_WAIT_L(8); PG8_BAR; PG8_WAIT_L(0); PG8_MMA(0, 0, At, B0); PG8_BAR; PG8_SCHED;
            PG8_LDB(B1, 0, 1); PG8_STAGE(PG8_SB(0, 0), b2, voffB);
            PG8_BAR; PG8_WAIT_L(0); PG8_MMA(0, 1, At, B1); PG8_BAR;
            PG8_LDA(At, 0, 1); PG8_STAGE(PG8_SA(0, 0), a2, voffA);
            PG8_BAR; PG8_WAIT_L(0); PG8_MMA(1, 0, At, B0); PG8_BAR; PG8_SCHED;
            PG8_STAGE(PG8_SB(0, 1), b2 + hstep, voffB);
            PG8_WAIT_V(6); PG8_BAR; PG8_MMA(1, 1, At, B1); PG8_BAR;
            PG8_LDB(B0, 1, 0); PG8_SCHED; PG8_LDA(At, 1, 0); PG8_STAGE(PG8_SA(0, 1), a2 + hstep, voffA);
            PG8_WAIT_L(8); PG8_BAR; PG8_WAIT_L(0); PG8_MMA(0, 0, At, B0); PG8_BAR; PG8_SCHED;
            PG8_LDB(B1, 1, 1); PG8_STAGE(PG8_SB(1, 0), b3, voffB);
            PG8_BAR; PG8_WAIT_L(0); PG8_MMA(0, 1, At, B1); PG8_BAR;
            PG8_LDA(At, 1, 1); PG8_STAGE(PG8_SA(1, 0), a3, voffA);
            PG8_BAR; PG8_WAIT_L(0); PG8_MMA(1, 0, At, B0); PG8_BAR; PG8_SCHED;
            PG8_STAGE(PG8_SB(1, 1), b3 + hstep, voffB);
            PG8_WAIT_V(6); PG8_BAR; PG8_MMA(1, 1, At, B1); PG8_BAR;
            }
        }
        if constexpr (ALIGN_EPI) { if (wr == 0) PG8_BAR; }
        if constexpr (!Epi::AFTER_DRAIN) { E(acc, cur, wr, wc, fr, fq); S.done(cur); }
        if (!has_next) break;
#pragma unroll
        for (int a = 0; a < 2; ++a)
#pragma unroll
            for (int b = 0; b < 2; ++b)
#pragma unroll
                for (int m = 0; m < 4; ++m)
#pragma unroll
                    for (int n = 0; n < 2; ++n) acc[a][b][m][n] = (f32x4){0.f, 0.f, 0.f, 0.f};
        cur = nxt; cA = nA; cB = nB; ++ui;
        if constexpr (ALIGN_EPI) { if (wr == 1) PG8_BAR; }
    }
    PG8_WAIT_V(0);
    if constexpr (!ALIGN_EPI) { if (wr == 0) PG8_BAR; }
    PG8_BAR;
    if constexpr (Epi::AFTER_DRAIN) { E.fused(acc, cur, wr, wc, fr, fq, lds, wid, lane); S.done(cur); }
#undef PG8_SA
#undef PG8_SB
#undef PG8_STAGE
#undef PG8_LDA
#undef PG8_LDB
#undef PG8_MMA
#undef PG8_WAIT_V
#undef PG8_WAIT_L
#undef PG8_BAR
#undef PG8_SCHED
}
}


#define DI __device__ __forceinline__
typedef unsigned short bf16_t;
typedef short bf16x8 __attribute__((ext_vector_type(8)));
typedef float f32x4 __attribute__((ext_vector_type(4)));
typedef float f32x2 __attribute__((ext_vector_type(2)));
typedef float f32x16 __attribute__((ext_vector_type(16)));
typedef unsigned u32x4 __attribute__((ext_vector_type(4)));
#define MFMA32(a, b, c) __builtin_amdgcn_mfma_f32_32x32x16_bf16((a), (b), (c), 0, 0, 0)
#define LAS __attribute__((address_space(3)))

constexpr int NT = 512;
constexpr int DM = 1024, MP = 16384, MT = 16896;
constexpr int NIN = 10368, NINP = 10496, CSH = 4224;
constexpr float EPS = 1e-6f, LNX_EPS = 64e-5f;
constexpr float QSCALE = 0.18033688011112042f;

constexpr size_t OUT_YP = 0, OUT_KP = 17301504, OUT_VP = 34078720, OUT_SHP = 50855936, OUT_WP = 50872832,
                 OUT_KS = 51134976, OUT_VS = 51659264, OUT_SHS = 52183552, OUT_WS = 52318720;

constexpr size_t SZ_ACT = (size_t)MT * 1024 * 2;
constexpr size_t WS_R1 = 0;
constexpr size_t WS_H = WS_R1, WS_WINT = WS_R1 + SZ_ACT, WS_SW = WS_R1;
constexpr size_t WS_R2 = (size_t)MT * 1024 * 4;
constexpr size_t WS_PB = WS_R2, WS_ORAW = WS_R2, WS_OB = WS_ORAW + (size_t)MT * 1024 * 4, WS_MG = WS_OB + SZ_ACT;
constexpr size_t WS_R3 = WS_R2 + (size_t)MT * CSH * 2;
constexpr size_t WS_QB = WS_R3, WS_X = WS_QB + SZ_ACT  , WS_BTL = WS_X + (size_t)MT * 256 * 2  , WS_SZA = WS_X + (size_t)MP * 1024 * 2;
static_assert(WS_BTL + (size_t)2048 * 256 * 2 <= WS_SZA, "LoRA buffers");
constexpr size_t WS_SR = WS_SZA + SZ_ACT, WS_SK = WS_SR + SZ_ACT, WS_SV = WS_SK + SZ_ACT, WS_SKK = WS_SV + SZ_ACT, WS_SB = WS_SKK + SZ_ACT;
constexpr size_t WS_SZB = WS_SB + SZ_ACT;
constexpr size_t WS_BONUS = WS_SZB + SZ_ACT;
constexpr size_t WS_WT = WS_BONUS + (size_t)MT * 16 * 4;
constexpr size_t WS_CTL = WS_WT + 3 * (size_t)1024 * 1024 * 2;
constexpr size_t WS_END = WS_CTL + 65536;
static_assert(WS_MG + SZ_ACT <= WS_R3, "R2 overflow");
static_assert(WS_WINT + (size_t)NINP * 1024 * 2 <= WS_R2, "R1 overflow");
static_assert(WS_END <= (size_t)512 * 1024 * 1024, "workspace");

constexpr int SMEM_BYTES = 147456;

struct Params { const float* in[22]; float* out; unsigned char* ws; };

DI float bf2f(bf16_t u) { return __uint_as_float((unsigned)u << 16); }
DI unsigned cvtpk(float lo, float hi) { unsigned r; asm volatile("v_cvt_pk_bf16_f32 %0, %1, %2" : "=v"(r) : "v"(lo), "v"(hi)); return r; }
DI bf16_t f2bf(float x) { return (bf16_t)(cvtpk(x, 0.f) & 0xffffu); }
DI float bflo(unsigned u) { return __uint_as_float(u << 16); }
DI float bfhi(unsigned u) { return __uint_as_float(u & 0xffff0000u); }
DI int crow(int i, int h) { return (i & 3) + 8 * (i >> 2) + 4 * h; }
DI float sigmoidf_(float x) { return fminf(__builtin_amdgcn_rcpf(1.f + __expf(-x)), 1.f); }
DI uint4 pack8(f32x4 a, f32x4 b) { return make_uint4(cvtpk(a[0], a[1]), cvtpk(a[2], a[3]), cvtpk(b[0], b[1]), cvtpk(b[2], b[3])); }
DI float wave_sum(float x) {
#pragma unroll
  for (int o = 32; o > 0; o >>= 1) x += __shfl_xor(x, o);
  return x;
}
DI float sum16(float x) { x += __shfl_xor(x, 1); x += __shfl_xor(x, 2); x += __shfl_xor(x, 4); x += __shfl_xor(x, 8); return x; }
template <int CTRL> DI float dppf(float x) { return __builtin_bit_cast(float, __builtin_amdgcn_mov_dpp(__builtin_bit_cast(int, x), CTRL, 0xf, 0xf, true)); }
DI float row32_sum(float x) {
  x += dppf<0xB1>(x);
  x += dppf<0x4E>(x);
  x += dppf<0x124>(x);
  x += dppf<0x128>(x);
  const auto s = __builtin_amdgcn_permlane16_swap(__float_as_uint(x), __float_as_uint(x), false, false);
  return __uint_as_float(s[0]) + __uint_as_float(s[1]);
}
DI size_t hm_base(int row) {
  if (row < MP) { const int b = row >> 12, t = row & 4095; return ((size_t)(b * 16) * 4096 + t) * 64; }
  const int rs = row - MP, b = rs >> 4, t = rs & 15; return (size_t)MP * 1024 + ((size_t)(b * 16) * 16 + t) * 64;
}
DI size_t hm_hstride(int row) { return row < MP ? (size_t)4096 * 64 : (size_t)16 * 64; }

DI void p0_rmsnorm_rows(const Params& p, int item) {
  const int lane = TIDX & 63, wid = TIDX >> 6;
  const int row = item * 8 + wid;
  const float* x = row < MP ? p.in[0] + (size_t)row * DM : p.in[1] + (size_t)(row - MP) * DM;
  const float* g = p.in[6];
  float4 v[4]; float ss = 0.f;
#pragma unroll
  for (int i = 0; i < 4; ++i) { v[i] = *(const float4*)(x + i * 256 + lane * 4); ss += v[i].x * v[i].x + v[i].y * v[i].y + v[i].z * v[i].z + v[i].w * v[i].w; }
  ss = wave_sum(ss);
  const float inv = rsqrtf(ss * (1.f / DM) + EPS);
  bf16_t* H = (bf16_t*)(p.ws + WS_H) + (size_t)row * DM;
#pragma unroll
  for (int i = 0; i < 4; ++i) {
    const float4 gg = *(const float4*)(g + i * 256 + lane * 4);
    uint2 o; o.x = cvtpk(v[i].x * inv * gg.x, v[i].y * inv * gg.y); o.y = cvtpk(v[i].z * inv * gg.z, v[i].w * inv * gg.w);
    *(uint2*)(H + i * 256 + lane * 4) = o;
  }
}
DI void p0_transpose_tile(const float* src, bf16_t* dst, int N, int kt, int nt, float* lds) {
  const int tid = TIDX & 255;
  const int k0 = kt * 64, n0 = nt * 64;
#pragma unroll
  for (int i = 0; i < 4; ++i) {
    const int row = (tid >> 4) + 16 * i, c4 = (tid & 15) * 4;
    const float4 v = *(const float4*)(src + (size_t)(k0 + row) * N + n0 + c4);
    lds[row * 65 + c4 + 0] = v.x; lds[row * 65 + c4 + 1] = v.y; lds[row * 65 + c4 + 2] = v.z; lds[row * 65 + c4 + 3] = v.w;
  }
  __syncthreads();
  const int n = tid >> 2, kc = (tid & 3) * 16;
  unsigned w[8];
#pragma unroll
  for (int j = 0; j < 8; ++j) w[j] = cvtpk(lds[(kc + 2 * j) * 65 + n], lds[(kc + 2 * j + 1) * 65 + n]);
  uint4* d = (uint4*)(dst + (size_t)(n0 + n) * 1024 + k0 + kc);
  d[0] = make_uint4(w[0], w[1], w[2], w[3]); d[1] = make_uint4(w[4], w[5], w[6], w[7]);
  __syncthreads();
}
DI void phase0(const Params& p, char* smem) {
  {
    bf16_t* BL = (bf16_t*)(p.ws + WS_BTL);
    for (int i = blockIdx.x * NT + TIDX; i < 2048 * 256; i += gridDim.x * NT) {
      const int n = i >> 8, k = i & 255;
      float v = 0.f;
      if (n < 1024) { if (k < 64) v = p.in[10][(size_t)k * 1024 + n]; }
      else if (k >= 64 && k < 128) v = p.in[12][(size_t)(k - 64) * 1024 + (n - 1024)];
      BL[i] = f2bf(v);
    }
  }
  constexpr int N_ROWS = MT / 8, N_TIN = 16 * 162 / 2, N_TSQ = 256 / 2;
  constexpr int N_ITEMS = N_ROWS + N_TIN + 3 * N_TSQ;
  const int half = TIDX >> 8;
  float* scr = (float*)smem + half * (64 * 65);
  for (int it = blockIdx.x; it < N_ITEMS; it += gridDim.x) {
    if (it < N_ROWS) { p0_rmsnorm_rows(p, it); continue; }
    int j = it - N_ROWS;
    if (j < N_TIN) { const int t = 2 * j + half; p0_transpose_tile(p.in[7], (bf16_t*)(p.ws + WS_WINT), NIN, t / 162, t % 162, scr); continue; }
    j -= N_TIN;
    const int w = j / N_TSQ; const int t = 2 * (j % N_TSQ) + half;
    p0_transpose_tile(p.in[18 + w], (bf16_t*)(p.ws + WS_WT) + (size_t)w * 1024 * 1024, 1024, t >> 4, t & 15, scr);
  }
}

struct EpiP1 {
  static constexpr bool PERM = true, AFTER_DRAIN = false;
  Params p;
  DI void operator()(const pg8::f32x4 (&acc)[2][2][4][2], const pg8::Unit& u, int wr, int wc, int fr, int fq) const {
    const int colt = u.pn * 256;
    const int region = colt >> 10;
#pragma unroll
    for (int ai = 0; ai < 2; ++ai)
#pragma unroll
      for (int m = 0; m < 4; ++m) {
        const int row = u.pm * 256 + ai * 128 + wr * 64 + m * 16 + fr;
        const bool prompt = row < MP;
        const int rs = row - MP;
#pragma unroll
        for (int bj = 0; bj < 2; ++bj) {
          const int col = colt + bj * 128 + wc * 32 + 8 * fq;
          const f32x4 v0 = acc[ai][bj][m][0], v1 = acc[ai][bj][m][1];
          if (region >= 6) {
            const int pc = col - 6144;
            if (pc < CSH) {
              *(uint4*)((bf16_t*)(p.ws + WS_PB) + (size_t)row * CSH + pc) = pack8(v0, v1);
              float* so = nullptr;
              if (prompt) { if ((row & 4095) == 4095) so = p.out + OUT_SHP + (size_t)(row >> 12) * CSH + pc; }
              else if ((rs & 15) == 15) so = p.out + OUT_SHS + (size_t)(rs >> 4) * CSH + pc;
              if (so) { *(f32x4*)so = v0; *(f32x4*)(so + 4) = v1; }
            }
          } else if (region == 0) {
            *(uint4*)((bf16_t*)(p.ws + WS_QB) + (size_t)row * 1024 + col) = pack8(v0 * QSCALE, v1 * QSCALE);
          } else if (region == 1) {
            const int c = col - 1024, hh = c >> 6, d = c & 63;
            float* o = prompt ? p.out + OUT_KP + (((size_t)(row >> 12) * 16 + hh) * 4096 + (row & 4095)) * 64 + d
                              : p.out + OUT_KS + (((size_t)(rs >> 4) * 16 + hh) * 16 + (rs & 15)) * 64 + d;
            __builtin_nontemporal_store(v0, (f32x4*)o); __builtin_nontemporal_store(v1, (f32x4*)(o + 4));
          } else if (region == 2) {
            const int c = col - 2048, hh = c >> 6, d = c & 63;
            float* o = prompt ? p.out + OUT_VP + (((size_t)(row >> 12) * 16 + hh) * 4096 + (row & 4095)) * 64 + d
                              : p.out + OUT_VS + (((size_t)(rs >> 4) * 16 + hh) * 16 + (rs & 15)) * 64 + d;
            __builtin_nontemporal_store(v0, (f32x4*)o); __builtin_nontemporal_store(v1, (f32x4*)(o + 4));
          } else if (region == 3) {
            f32x4 a, b;
#pragma unroll
            for (int j = 0; j < 4; ++j) { a[j] = v0[j] * sigmoidf_(v0[j]); b[j] = v1[j] * sigmoidf_(v1[j]); }
            *(uint4*)((bf16_t*)(p.ws + WS_SZA) + (size_t)row * 1024 + (col - 3072)) = pack8(a, b);
          } else {
            f32x4 a, b;
#pragma unroll
            for (int j = 0; j < 4; ++j) { a[j] = sigmoidf_(v0[j]); b[j] = sigmoidf_(v1[j]); }
            *(uint4*)((bf16_t*)p.out + (size_t)row * 2048 + (col - 4096)) = pack8(a, b);
          }
        }
      }
  }
};
struct EpiGate {
  static constexpr bool PERM = true, AFTER_DRAIN = false;
  Params p; int goff; bool first;
  DI void operator()(const pg8::f32x4 (&acc)[2][2][4][2], const pg8::Unit& u, int wr, int wc, int fr, int fq) const {
    const bf16_t* G = (const bf16_t*)p.out; bf16_t* MG = (bf16_t*)(p.ws + WS_MG);
#pragma unroll
    for (int ai = 0; ai < 2; ++ai)
#pragma unroll
      for (int m = 0; m < 4; ++m) {
        const size_t row = u.pm * 256 + ai * 128 + wr * 64 + m * 16 + fr;
#pragma unroll
        for (int bj = 0; bj < 2; ++bj) {
          const int col = u.pn * 256 + bj * 128 + wc * 32 + 8 * fq;
          const uint4 g = *(const uint4*)(G + row * 2048 + goff + col);
          f32x4 a = acc[ai][bj][m][0], b = acc[ai][bj][m][1];
          a[0] *= bflo(g.x); a[1] *= bfhi(g.x); a[2] *= bflo(g.y); a[3] *= bfhi(g.y);
          b[0] *= bflo(g.z); b[1] *= bfhi(g.z); b[2] *= bflo(g.w); b[3] *= bfhi(g.w);
          if (!first) {
            const uint4 o = *(const uint4*)(MG + row * 1024 + col);
            a[0] += bflo(o.x); a[1] += bfhi(o.x); a[2] += bflo(o.y); a[3] += bfhi(o.y);
            b[0] += bflo(o.z); b[1] += bfhi(o.z); b[2] += bflo(o.w); b[3] += bfhi(o.w);
          }
          *(uint4*)(MG + row * 1024 + col) = pack8(a, b);
        }
      }
  }
};
struct EpiOut {
  static constexpr bool PERM = true, AFTER_DRAIN = false;
  Params p;
  DI void operator()(const pg8::f32x4 (&acc)[2][2][4][2], const pg8::Unit& u, int wr, int wc, int fr, int fq) const {
#pragma unroll
    for (int ai = 0; ai < 2; ++ai)
#pragma unroll
      for (int m = 0; m < 4; ++m) {
        const int row = u.pm * 256 + ai * 128 + wr * 64 + m * 16 + fr;
        const float* xr = row < MP ? p.in[0] + (size_t)row * 1024 : p.in[1] + (size_t)(row - MP) * 1024;
        float* orow = p.out + OUT_YP + (size_t)row * 1024;
#pragma unroll
        for (int bj = 0; bj < 2; ++bj) {
          const int col = u.pn * 256 + bj * 128 + wc * 32 + 8 * fq;
          const f32x4 x0 = *(const f32x4*)(xr + col), x1 = *(const f32x4*)(xr + col + 4);
          *(f32x4*)(orow + col) = x0 + acc[ai][bj][m][0]; *(f32x4*)(orow + col + 4) = x1 + acc[ai][bj][m][1];
        }
      }
  }
};
template <class Epi>
DI void run_gemm(char* smem, const bf16_t* A, const bf16_t* Bt, int M, int N, const Epi& E, int K = 1024) {
  pg8::Gemm g; g.A = A; g.Bt = Bt; g.M = M; g.N = N; g.K = K;
  pg8::StaticOrder S; S.init(M, N, (int)gridDim.x, (int)blockIdx.x);
  pg8::gemm_phase<Epi, pg8::StaticOrder, true, true>((LAS unsigned char*)smem, g, S, E);
  __syncthreads();
}

template <int MODE>
DI void small_gemm(const Params& p, const bf16_t* A, const bf16_t* Bt) {
  const int lane = TIDX & 63, wid = TIDX >> 6, r = lane & 31, h = lane >> 5;
  for (int tile = wid * gridDim.x + blockIdx.x; tile < 512; tile += 8 * gridDim.x) {
    const int row0 = MP + (tile >> 5) * 32, col0 = (tile & 31) * 32;
    const bf16_t* pa = A + (size_t)(row0 + r) * 1024 + 8 * h;
    const bf16_t* pb = Bt + (size_t)(col0 + r) * 1024 + 8 * h;
    f32x16 acc;
#pragma unroll
    for (int i = 0; i < 16; ++i) acc[i] = 0.f;
#pragma unroll 8
    for (int s = 0; s < 64; ++s) acc = MFMA32(*(const bf16x8*)(pa + 16 * s), *(const bf16x8*)(pb + 16 * s), acc);
    const int col = col0 + r;
#pragma unroll
    for (int i = 0; i < 16; ++i) {
      const size_t row = row0 + crow(i, h);
      if (MODE == 2) p.out[OUT_YP + row * 1024 + col] = p.in[1][(row - MP) * 1024 + col] + acc[i];
      else {
        bf16_t* mg = (bf16_t*)(p.ws + WS_MG) + row * 1024 + col;
        const float g = bf2f(((const bf16_t*)p.out)[row * 2048 + (MODE == 1 ? 1024 : 0) + col]);
        *mg = f2bf((MODE == 1 ? bf2f(*mg) : 0.f) + acc[i] * g);
      }
    }
  }
}

DI float tanh_fast(float x) { return 1.f - 2.f * __builtin_amdgcn_rcpf(1.f + __expf(2.f * x)); }
DI void phase_x(const Params& p) {
  const bf16_t* PB = (const bf16_t*)(p.ws + WS_PB);
  bf16_t* X = (bf16_t*)(p.ws + WS_X);
  const float* mu = p.in[8];
  for (int i = blockIdx.x * NT + TIDX; i < MT * 32; i += gridDim.x * NT) {
    const int row = i >> 5, g = i & 31;
    uint4 o = make_uint4(0u, 0u, 0u, 0u);
    if (g < 16) {
      const int col = 3072 + g * 8;
      const bool prompt = row < MP;
      const int t = prompt ? (row & 4095) : ((row - MP) & 15);
      const uint4 a = *(const uint4*)(PB + (size_t)row * CSH + col);
      float c[8] = {bflo(a.x), bfhi(a.x), bflo(a.y), bfhi(a.y), bflo(a.z), bfhi(a.z), bflo(a.w), bfhi(a.w)}, q[8];
      if (t != 0) { const uint4 b = *(const uint4*)(PB + (size_t)(row - 1) * CSH + col); q[0] = bflo(b.x); q[1] = bfhi(b.x); q[2] = bflo(b.y); q[3] = bfhi(b.y); q[4] = bflo(b.z); q[5] = bfhi(b.z); q[6] = bflo(b.w); q[7] = bfhi(b.w); }
      else if (prompt) {
#pragma unroll
        for (int j = 0; j < 8; ++j) q[j] = 0.f;
      } else { const float* s = p.in[4] + (size_t)((row - MP) >> 4) * CSH + col; const float4 b0 = *(const float4*)s, b1 = *(const float4*)(s + 4); q[0] = b0.x; q[1] = b0.y; q[2] = b0.z; q[3] = b0.w; q[4] = b1.x; q[5] = b1.y; q[6] = b1.z; q[7] = b1.w; }
      const float4 u0 = *(const float4*)(mu + col), u1 = *(const float4*)(mu + col + 4);
      const float u[8] = {u0.x, u0.y, u0.z, u0.w, u1.x, u1.y, u1.z, u1.w};
      float m[8];
#pragma unroll
      for (int j = 0; j < 8; ++j) { m[j] = c[j] + u[j] * (q[j] - c[j]); if (g < 8) m[j] = tanh_fast(m[j]); }
      o = make_uint4(cvtpk(m[0], m[1]), cvtpk(m[2], m[3]), cvtpk(m[4], m[5]), cvtpk(m[6], m[7]));
    }
    *(uint4*)(X + (size_t)row * 256 + g * 8) = o;
  }
}
struct EpiLora {
  static constexpr bool PERM = true, AFTER_DRAIN = false;
  Params p;
  DI void operator()(const pg8::f32x4 (&acc)[2][2][4][2], const pg8::Unit& u, int wr, int wc, int fr, int fq) const {
    const bool isw = u.pn < 4;
#pragma unroll
    for (int ai = 0; ai < 2; ++ai)
#pragma unroll
      for (int m = 0; m < 4; ++m) {
        const int row = u.pm * 256 + ai * 128 + wr * 64 + m * 16 + fr;
        const size_t hb = hm_base(row), hs = hm_hstride(row);
#pragma unroll
        for (int bj = 0; bj < 2; ++bj) {
          const int c = (u.pn & 3) * 256 + bj * 128 + wc * 32 + 8 * fq;
          const size_t idx = hb + (c >> 6) * hs + (c & 63);
          const f32x4 v0 = acc[ai][bj][m][0], v1 = acc[ai][bj][m][1];
          if (isw) {
            const f32x4 b0 = *(const f32x4*)(p.in[9] + c), b1 = *(const f32x4*)(p.in[9] + c + 4);
            f32x4 d0, d1;
#pragma unroll
            for (int j = 0; j < 4; ++j) {
              const float x0 = -(b0[j] + v0[j]), x1 = -(b1[j] + v1[j]);
              const float s0 = fmaxf(x0, 0.f) + __logf(1.f + __expf(-fabsf(x0))), s1 = fmaxf(x1, 0.f) + __logf(1.f + __expf(-fabsf(x1)));
              d0[j] = __expf(-__expf(-s0 - 0.5f)); d1[j] = __expf(-__expf(-s1 - 0.5f));
            }
            float* o = (float*)(p.ws + WS_SW) + idx; *(f32x4*)o = d0; *(f32x4*)(o + 4) = d1;
          } else {
            const f32x4 b0 = *(const f32x4*)(p.in[11] + c), b1 = *(const f32x4*)(p.in[11] + c + 4);
            f32x4 d0, d1;
#pragma unroll
            for (int j = 0; j < 4; ++j) { d0[j] = sigmoidf_(b0[j] + v0[j]); d1[j] = sigmoidf_(b1[j] + v1[j]); }
            *(uint4*)((bf16_t*)(p.ws + WS_SB) + idx) = pack8(d0, d1);
          }
        }
      }
  }
};
DI void phase1c(const Params& p) {
  const int tid = TIDX & 255, half = TIDX >> 8, c = tid * 4, hh = c >> 6;
  const bf16_t* PB = (const bf16_t*)(p.ws + WS_PB);
  const float* mu = p.in[8];
  const float4 kkw = *(const float4*)(p.in[13] + c), kaw = *(const float4*)(p.in[14] + c), rkw = *(const float4*)(p.in[15] + c);
  const float4 mur = *(const float4*)(mu + c), muk = *(const float4*)(mu + 1024 + c), muv = *(const float4*)(mu + 2048 + c), muz = *(const float4*)(mu + 3200 + c);
  const float kka[4] = {kkw.x, kkw.y, kkw.z, kkw.w}, kaa[4] = {kaw.x, kaw.y, kaw.z, kaw.w}, rka[4] = {rkw.x, rkw.y, rkw.z, rkw.w};
  const float mura[4] = {mur.x, mur.y, mur.z, mur.w}, muka[4] = {muk.x, muk.y, muk.z, muk.w}, muva[4] = {muv.x, muv.y, muv.z, muv.w}, muza[4] = {muz.x, muz.y, muz.z, muz.w};
  bf16_t* SR = (bf16_t*)(p.ws + WS_SR); bf16_t* SK = (bf16_t*)(p.ws + WS_SK); bf16_t* SV = (bf16_t*)(p.ws + WS_SV);
  bf16_t* SKK = (bf16_t*)(p.ws + WS_SKK); bf16_t* SB = (bf16_t*)(p.ws + WS_SB); bf16_t* SZB = (bf16_t*)(p.ws + WS_SZB);
  float* BONUS = (float*)(p.ws + WS_BONUS);
  for (int r4 = blockIdx.x * 2 + half; r4 < MT / 4; r4 += gridDim.x * 2) {
    const int row0 = r4 * 4;
    const bool prompt = row0 < MP;
    const int t0 = prompt ? (row0 & 4095) : ((row0 - MP) & 15);
    uint2 gr[5], gk[5], gv[5], gz[5], ga[4];
#pragma unroll
    for (int t = 0; t < 5; ++t) {
      const int rr_ = (t == 0 && t0 == 0) ? row0 : row0 + t - 1;
      const bf16_t* pc = PB + (size_t)rr_ * CSH;
      gr[t] = *(const uint2*)(pc + c); gk[t] = *(const uint2*)(pc + 1024 + c); gv[t] = *(const uint2*)(pc + 2048 + c); gz[t] = *(const uint2*)(pc + 3200 + c);
    }
    size_t idx[4];
#pragma unroll
    for (int t = 0; t < 4; ++t) { idx[t] = hm_base(row0 + t) + hh * hm_hstride(row0 + t) + (c & 63); ga[t] = *(const uint2*)(SB + idx[t]); }
    float pr[4], pk[4], pv[4], pz[4];
    if (t0 == 0) {
      if (prompt) {
#pragma unroll
        for (int x = 0; x < 4; ++x) { pr[x] = 0.f; pk[x] = 0.f; pv[x] = 0.f; pz[x] = 0.f; }
      } else {
        const float* s = p.in[4] + (size_t)((row0 - MP) >> 4) * CSH;
        const float4 a = *(const float4*)(s + c), b = *(const float4*)(s + 1024 + c), d = *(const float4*)(s + 2048 + c), e = *(const float4*)(s + 3200 + c);
        pr[0] = a.x; pr[1] = a.y; pr[2] = a.z; pr[3] = a.w; pk[0] = b.x; pk[1] = b.y; pk[2] = b.z; pk[3] = b.w;
        pv[0] = d.x; pv[1] = d.y; pv[2] = d.z; pv[3] = d.w; pz[0] = e.x; pz[1] = e.y; pz[2] = e.z; pz[3] = e.w;
      }
    } else {
      pr[0] = bflo(gr[0].x); pr[1] = bfhi(gr[0].x); pr[2] = bflo(gr[0].y); pr[3] = bfhi(gr[0].y);
      pk[0] = bflo(gk[0].x); pk[1] = bfhi(gk[0].x); pk[2] = bflo(gk[0].y); pk[3] = bfhi(gk[0].y);
      pv[0] = bflo(gv[0].x); pv[1] = bfhi(gv[0].x); pv[2] = bflo(gv[0].y); pv[3] = bfhi(gv[0].y);
      pz[0] = bflo(gz[0].x); pz[1] = bfhi(gz[0].x); pz[2] = bflo(gz[0].y); pz[3] = bfhi(gz[0].y);
    }
#pragma unroll
    for (int t = 0; t < 4; ++t) {
      const int row = row0 + t;
      const float curr[4] = {bflo(gr[t + 1].x), bfhi(gr[t + 1].x), bflo(gr[t + 1].y), bfhi(gr[t + 1].y)}, curk[4] = {bflo(gk[t + 1].x), bfhi(gk[t + 1].x), bflo(gk[t + 1].y), bfhi(gk[t + 1].y)};
      const float curv[4] = {bflo(gv[t + 1].x), bfhi(gv[t + 1].x), bflo(gv[t + 1].y), bfhi(gv[t + 1].y)}, curz[4] = {bflo(gz[t + 1].x), bfhi(gz[t + 1].x), bflo(gz[t + 1].y), bfhi(gz[t + 1].y)};
      const float av[4] = {bflo(ga[t].x), bfhi(ga[t].x), bflo(ga[t].y), bfhi(ga[t].y)};
      float rm[4], km[4], vm[4], kkv[4], bb[4], kmod[4], szb[4];
      float ssq = 0.f, bon = 0.f;
#pragma unroll
      for (int x = 0; x < 4; ++x) {
        rm[x] = curr[x] + mura[x] * (pr[x] - curr[x]);
        km[x] = curk[x] + muka[x] * (pk[x] - curk[x]);
        vm[x] = curv[x] + muva[x] * (pv[x] - curv[x]);
        const float zm = curz[x] + muza[x] * (pz[x] - curz[x]);
        szb[x] = zm * sigmoidf_(zm);
        kkv[x] = km[x] * kka[x];
        ssq += kkv[x] * kkv[x];
        kmod[x] = km[x] * (1.f + (av[x] - 1.f) * kaa[x]);
        bon += rm[x] * kmod[x] * rka[x];
        pr[x] = curr[x]; pk[x] = curk[x]; pv[x] = curv[x]; pz[x] = curz[x];
      }
      ssq = sum16(ssq); bon = sum16(bon);
      const float inv = 1.f / fmaxf(sqrtf(ssq), 1e-12f);
#pragma unroll
      for (int x = 0; x < 4; ++x) { kkv[x] *= inv; bb[x] = kkv[x] * av[x]; }
      *(uint2*)(SR + idx[t]) = make_uint2(cvtpk(rm[0], rm[1]), cvtpk(rm[2], rm[3]));
      *(uint2*)(SK + idx[t]) = make_uint2(cvtpk(kmod[0], kmod[1]), cvtpk(kmod[2], kmod[3]));
      *(uint2*)(SV + idx[t]) = make_uint2(cvtpk(vm[0], vm[1]), cvtpk(vm[2], vm[3]));
      *(uint2*)(SKK + idx[t]) = make_uint2(cvtpk(-kkv[0], -kkv[1]), cvtpk(-kkv[2], -kkv[3]));
      *(uint2*)(SB + idx[t]) = make_uint2(cvtpk(bb[0], bb[1]), cvtpk(bb[2], bb[3]));
      *(uint2*)(SZB + (size_t)row * 1024 + c) = make_uint2(cvtpk(szb[0], szb[1]), cvtpk(szb[2], szb[3]));
      if ((tid & 15) == 0) BONUS[(size_t)row * 16 + hh] = bon;
    }
  }
}

template <bool SAMPLE>
DI void attn_wave(const Params& p, int sh, int qt) {
  const int lane = TIDX & 63, r = lane & 31, h = lane >> 5;
  const int hh = sh & 15, b = sh >> 4;
  bf16_t* QB = (bf16_t*)(p.ws + WS_QB);
  const int row0 = SAMPLE ? MP + b * 16 : b * 4096 + qt * 32;
  bf16_t* Qp = QB + (size_t)row0 * 1024 + hh * 64;
  const int qrow = SAMPLE ? (r < 15 ? r : 15) : r;
  bf16x8 qf[4];
#pragma unroll
  for (int s = 0; s < 4; ++s) qf[s] = *(const bf16x8*)(Qp + (size_t)qrow * 1024 + 16 * s + 8 * h);
  f32x16 z0, z1;
#pragma unroll
  for (int i = 0; i < 16; ++i) { z0[i] = 0.f; z1[i] = 0.f; }
  float carry = 1.f;
  const int ntiles = SAMPLE ? 33 : qt + 1;
  for (int it = 0; it < ntiles; ++it) {
    const bool diag = (it == 0);
    const int kt = SAMPLE ? 32 - it : qt - it;
    bf16x8 kf[4];
    {
      const float* Kp;
      if (!SAMPLE) Kp = p.out + OUT_KP + ((size_t)sh * 4096 + kt * 32 + r) * 64;
      else Kp = diag ? p.out + OUT_KS + ((size_t)sh * 16 + (r < 15 ? r : 15)) * 64 : p.in[2] + ((size_t)sh * 1024 + kt * 32 + r) * 64;
#pragma unroll
      for (int s = 0; s < 4; ++s) {
        const float4 a = *(const float4*)(Kp + 16 * s + 8 * h), bq = *(const float4*)(Kp + 16 * s + 8 * h + 4);
        u32x4 w; w[0] = cvtpk(a.x, a.y); w[1] = cvtpk(a.z, a.w); w[2] = cvtpk(bq.x, bq.y); w[3] = cvtpk(bq.z, bq.w);
        kf[s] = __builtin_bit_cast(bf16x8, w);
      }
    }
    f32x16 st;
#pragma unroll
    for (int i = 0; i < 16; ++i) st[i] = 0.f;
#pragma unroll
    for (int s = 0; s < 4; ++s) st = MFMA32(kf[s], qf[s], st);
    float keep[16], wgt[16];
#pragma unroll
    for (int i = 0; i < 16; ++i) {
      const float e = __builtin_amdgcn_exp2f(st[i]);
      const float kp = __builtin_amdgcn_rcpf(1.f + e);
      bool valid = true;
      if (diag) { const int kr = crow(i, h); valid = SAMPLE ? (kr < r && kr < 16) : (kr < r); }
      keep[i] = valid ? kp : 1.f;
      wgt[i] = valid ? 1.f - kp : 0.f;
    }
    float pp[4], hif[4];
#pragma unroll
    for (int g = 0; g < 4; ++g) {
      const float p4 = (keep[4 * g] * keep[4 * g + 1]) * (keep[4 * g + 2] * keep[4 * g + 3]);
      const auto sw = __builtin_amdgcn_permlane32_swap(__float_as_uint(p4), __float_as_uint(p4), false, false);
      const float lo = __uint_as_float(sw[0]), hi = __uint_as_float(sw[1]);
      pp[g] = lo * hi;
      hif[g] = h ? 1.f : hi;
    }
    float T[4];
    T[3] = carry; T[2] = T[3] * pp[3]; T[1] = T[2] * pp[2]; T[0] = T[1] * pp[1];
    carry = T[0] * pp[0];
#pragma unroll
    for (int g = 0; g < 4; ++g) {
      const float w3 = T[g] * hif[g], w2 = w3 * keep[4 * g + 3], w1 = w2 * keep[4 * g + 2], w0 = w1 * keep[4 * g + 1];
      wgt[4 * g + 3] *= w3; wgt[4 * g + 2] *= w2; wgt[4 * g + 1] *= w1; wgt[4 * g] *= w0;
    }
#pragma unroll
    for (int s = 0; s < 2; ++s) {
      u32x4 pw;
#pragma unroll
      for (int j = 0; j < 4; ++j) pw[j] = cvtpk(wgt[8 * s + 2 * j], wgt[8 * s + 2 * j + 1]);
      const bf16x8 pf = __builtin_bit_cast(bf16x8, pw);
#pragma unroll
      for (int db = 0; db < 2; ++db) {
        bf16x8 vf;
        {
          float vv[8];
#pragma unroll
          for (int j = 0; j < 8; ++j) {
            const int kr = 16 * s + 8 * (j >> 2) + 4 * h + (j & 3);
            const float* vp;
            if (!SAMPLE) vp = p.out + OUT_VP + ((size_t)sh * 4096 + kt * 32 + kr) * 64;
            else vp = diag ? p.out + OUT_VS + ((size_t)sh * 16 + (kr < 15 ? kr : 15)) * 64 : p.in[3] + ((size_t)sh * 1024 + kt * 32 + kr) * 64;
            vv[j] = vp[db * 32 + r];
          }
          u32x4 w; w[0] = cvtpk(vv[0], vv[1]); w[1] = cvtpk(vv[2], vv[3]); w[2] = cvtpk(vv[4], vv[5]); w[3] = cvtpk(vv[6], vv[7]);
          vf = __builtin_bit_cast(bf16x8, w);
        }
        if (db == 0) z0 = MFMA32(pf, vf, z0); else z1 = MFMA32(pf, vf, z1);
      }
    }
    if (__ballot(carry != 0.f) == 0ull) break;
  }
  const bf16_t* SZA = (const bf16_t*)(p.ws + WS_SZA);
#pragma unroll
  for (int i = 0; i < 16; ++i) {
    const int q = crow(i, h);
    if (SAMPLE && q >= 16) continue;
    const size_t o = (size_t)(row0 + q) * 1024 + hh * 64 + r;
    QB[o] = f2bf(z0[i] * bf2f(SZA[o]));
    QB[o + 32] = f2bf(z1[i] * bf2f(SZA[o + 32]));
  }
}

DI float row16_sum(float x) {
  x += dppf<0xB1>(x); x += dppf<0x4E>(x); x += dppf<0x124>(x); x += dppf<0x128>(x);
  return x;
}
DI void scan_wave(const Params& p, int shg, int slice, float* L) {
  const int lane = TIDX & 63, cc = lane & 15;
  const bool prompt = shg < 64;
  const int T = prompt ? 4096 : 16;
  const size_t base = prompt ? (size_t)shg * 4096 * 64 : (size_t)MP * 1024 + (size_t)(shg - 64) * 16 * 64;
  const int v = slice * 4 + (lane >> 4);
  const float* SW = (const float*)(p.ws + WS_SW) + base;
  const bf16_t* SARR = (const bf16_t*)(p.ws + WS_SR) + base;
  float* ORAW = (float*)(p.ws + WS_ORAW) + base;
  float4 S;
  float* wout;
  if (prompt) { S = make_float4(0.f, 0.f, 0.f, 0.f); wout = p.out + OUT_WP + ((size_t)shg * 64 + v) * 64 + 4 * cc; }
  else { S = *(const float4*)(p.in[5] + ((size_t)(shg - 64) * 64 + v) * 64 + 4 * cc); wout = p.out + OUT_WS + ((size_t)(shg - 64) * 64 + v) * 64 + 4 * cc; }
  const int nch = T / 8;
  const int dw0 = ((lane >> 4) * 6 + 2) * 64 + (lane & 15) * 4, dw1 = dw0 + 4 * 384;
  const int db = (lane >> 3) * 384 + (lane & 7) * 8;
  uint4 gw0, gw1, gr, gk, gv, gn, gb;
#define SCAN_GLOAD(ch) do { const float* w_ = SW + (size_t)(ch) * 512; gw0 = *(const uint4*)(w_ + lane * 4); gw1 = *(const uint4*)(w_ + 256 + lane * 4); \
    const bf16_t* a_ = SARR + (size_t)(ch) * 512 + lane * 8; gr = *(const uint4*)a_; gk = *(const uint4*)(a_ + SZ_ACT / 2); gv = *(const uint4*)(a_ + 2 * (SZ_ACT / 2)); \
    gn = *(const uint4*)(a_ + 3 * (SZ_ACT / 2)); gb = *(const uint4*)(a_ + 4 * (SZ_ACT / 2)); } while (0)
#define SCAN_PUT(slot, g) do { float* d_ = L + db + (slot) * 64; *(float4*)d_ = make_float4(bflo(g.x), bfhi(g.x), bflo(g.y), bfhi(g.y)); *(float4*)(d_ + 4) = make_float4(bflo(g.z), bfhi(g.z), bflo(g.w), bfhi(g.w)); } while (0)
#define SCAN_LSTORE() do { *(uint4*)(L + dw0) = gw0; *(uint4*)(L + dw1) = gw1; SCAN_PUT(4, gr); SCAN_PUT(3, gk); SCAN_PUT(5, gv); SCAN_PUT(0, gn); SCAN_PUT(1, gb); \
    asm volatile("s_waitcnt lgkmcnt(0)" ::: "memory"); } while (0)
  SCAN_GLOAD(0);
  asm volatile("s_waitcnt lgkmcnt(0)" ::: "memory");
  SCAN_LSTORE();
  for (int ch = 0; ch < nch; ++ch) {
    if (ch + 1 < nch) SCAN_GLOAD(ch + 1);
    float okeep = 0.f;
    const float* Lc = L + 4 * cc;
    float4 nk = *(const float4*)(Lc), bb = *(const float4*)(Lc + 64), ww = *(const float4*)(Lc + 128), kv = *(const float4*)(Lc + 192), rr = *(const float4*)(Lc + 256);
    float vt = L[320 + v];
#pragma unroll 4
    for (int st = 0; st < 8; ++st) {
      const int sn = ((st + 1) & 7) * 384;
      const float4 nk2 = *(const float4*)(Lc + sn), bb2 = *(const float4*)(Lc + sn + 64), ww2 = *(const float4*)(Lc + sn + 128);
      const float4 kv2 = *(const float4*)(Lc + sn + 192), rr2 = *(const float4*)(Lc + sn + 256);
      const float vt2 = L[sn + 320 + v];
      float d = (S.x * nk.x + S.y * nk.y) + (S.z * nk.z + S.w * nk.w);
      const float sa = row16_sum(d);
      S.x = S.x * ww.x + (sa * bb.x + vt * kv.x);
      S.y = S.y * ww.y + (sa * bb.y + vt * kv.y);
      S.z = S.z * ww.z + (sa * bb.z + vt * kv.z);
      S.w = S.w * ww.w + (sa * bb.w + vt * kv.w);
      float o = (S.x * rr.x + S.y * rr.y) + (S.z * rr.z + S.w * rr.w);
      o = row16_sum(o);
      okeep = (cc == st) ? o : okeep;
      nk = nk2; bb = bb2; ww = ww2; kv = kv2; rr = rr2; vt = vt2;
    }
    if (cc < 8) ORAW[(size_t)(ch * 8 + cc) * 64 + v] = okeep;
    asm volatile("s_waitcnt lgkmcnt(0)" ::: "memory");
    if (ch + 1 < nch) SCAN_LSTORE();
  }
  *(float4*)wout = S;
#undef SCAN_GLOAD
#undef SCAN_PUT
#undef SCAN_LSTORE
}

DI void sgroup_barrier(volatile LAS unsigned* cnt, unsigned target) {
  asm volatile("s_waitcnt lgkmcnt(0)" ::: "memory");
  if ((TIDX & 63) == 0) __hip_atomic_fetch_add((LAS unsigned*)cnt, 1u, __ATOMIC_RELAXED, __HIP_MEMORY_SCOPE_WORKGROUP);
  while (*cnt < target) __builtin_amdgcn_s_sleep(1);
  asm volatile("" ::: "memory");
}
DI void scan_group(const Params& p, int sh, int quarter, float* lds, volatile LAS unsigned* cnt, unsigned& nbar) {
  const int tid = TIDX & 255, lane = tid & 63, wid = tid >> 6, cc = lane & 15;
  const size_t base = (size_t)sh * 4096 * 64;
  const int v = quarter * 16 + wid * 4 + (lane >> 4);
  const float* SW = (const float*)(p.ws + WS_SW) + base;
  const bf16_t* SARR = (const bf16_t*)(p.ws + WS_SR) + base;
  float* ORAW = (float*)(p.ws + WS_ORAW) + base;
  f32x2 S01 = {0.f, 0.f}, S23 = {0.f, 0.f};
  const bool b0 = (lane & 1) != 0, b1 = (lane & 2) != 0;
  float4 gw0, gw1; uint4 gb0, gb1, gb2, gb3, gb4;
  const int dstw0 = ((tid >> 4) * 6 + 2) * 64 + (tid & 15) * 4, dstw1 = dstw0 + 16 * 384;
  const int dstb = (tid >> 3) * 384 + (tid & 7) * 8;
  const bf16_t* sbp = SARR + tid * 8;
#define SG_GLOAD(ch) do { const size_t o_ = (size_t)(ch) * 2048; gw0 = *(const float4*)(SW + o_ + tid * 4); gw1 = *(const float4*)(SW + o_ + 1024 + tid * 4); \
    gb0 = *(const uint4*)(sbp + o_); gb1 = *(const uint4*)(sbp + (SZ_ACT / 2) + o_); gb2 = *(const uint4*)(sbp + 2 * (SZ_ACT / 2) + o_); \
    gb3 = *(const uint4*)(sbp + 3 * (SZ_ACT / 2) + o_); gb4 = *(const uint4*)(sbp + 4 * (SZ_ACT / 2) + o_); } while (0)
#define SG_PUT(d_, g) do { *(float4*)(d_) = make_float4(bflo(g.x), bfhi(g.x), bflo(g.y), bfhi(g.y)); *(float4*)((d_) + 4) = make_float4(bflo(g.z), bfhi(g.z), bflo(g.w), bfhi(g.w)); } while (0)
#define SG_LSTORE(buf) do { float* L_ = lds + (buf) * (32 * 384); *(float4*)(L_ + dstw0) = gw0; *(float4*)(L_ + dstw1) = gw1; \
    SG_PUT(L_ + dstb + 4 * 64, gb0); SG_PUT(L_ + dstb + 3 * 64, gb1); SG_PUT(L_ + dstb + 5 * 64, gb2); SG_PUT(L_ + dstb + 0 * 64, gb3); SG_PUT(L_ + dstb + 1 * 64, gb4); } while (0)
  SG_GLOAD(0); SG_LSTORE(0); sgroup_barrier(cnt, 4u * (++nbar));
  for (int ch = 0; ch < 128; ++ch) {
    if (ch + 1 < 128) SG_GLOAD(ch + 1);
#pragma unroll 1
    for (int hlf = 0; hlf < 2; ++hlf) {
    const float* L = lds + (ch & 1) * (32 * 384) + hlf * (16 * 384);
    float okeep = 0.f;
    const float* Lc = L + 4 * cc;
    f32x4 nk = *(const f32x4*)(Lc), bb = *(const f32x4*)(Lc + 64), ww = *(const f32x4*)(Lc + 128), kv = *(const f32x4*)(Lc + 192), rr = *(const f32x4*)(Lc + 256);
    float vt = L[320 + v];
    f32x4 rrp = rr;
    float po[4];
#pragma unroll
    for (int st = 0; st <= 16; ++st) {
      if (st > 0) { const f32x2 o2 = S01 * rrp.xy + S23 * rrp.zw; po[(st - 1) & 3] = o2.x + o2.y; }
      if (st > 0 && (st & 3) == 0) {
        const float u0 = (b0 ? po[1] : po[0]) + dppf<0xB1>(b0 ? po[0] : po[1]);
        const float u1 = (b0 ? po[3] : po[2]) + dppf<0xB1>(b0 ? po[2] : po[3]);
        float w = (b1 ? u1 : u0) + dppf<0x4E>(b1 ? u0 : u1);
        w += dppf<0x124>(w); w += dppf<0x128>(w);
        okeep = ((cc >> 2) == (st >> 2) - 1) ? w : okeep;
      }
      if (st < 16) {
        const int sn = ((st + 1) & 15) * 384;
        const f32x2 d2 = S01 * nk.xy + S23 * nk.zw;
        float x = d2.x + d2.y;
        const f32x2 vt_2 = {vt, vt};
        const f32x2 t01 = vt_2 * kv.xy, t23 = vt_2 * kv.zw;
        __builtin_amdgcn_sched_barrier(0);
        x += dppf<0xB1>(x);
        const f32x4 nk2 = *(const f32x4*)(Lc + sn), bb2 = *(const f32x4*)(Lc + sn + 64);
        __builtin_amdgcn_sched_barrier(0);
        x += dppf<0x4E>(x);
        const f32x4 ww2 = *(const f32x4*)(Lc + sn + 128), kv2 = *(const f32x4*)(Lc + sn + 192);
        __builtin_amdgcn_sched_barrier(0);
        x += dppf<0x124>(x);
        const f32x4 rr2 = *(const f32x4*)(Lc + sn + 256);
        const float vt2 = L[sn + 320 + v];
        __builtin_amdgcn_sched_barrier(0);
        x += dppf<0x128>(x);
        __builtin_amdgcn_sched_barrier(0);
        const f32x2 sa2 = {x, x};
        S01 = S01 * ww.xy + (sa2 * bb.xy + t01);
        S23 = S23 * ww.zw + (sa2 * bb.zw + t23);
        rrp = rr;
        nk = nk2; bb = bb2; ww = ww2; kv = kv2; rr = rr2; vt = vt2;
      }
    }
    ORAW[(size_t)(ch * 32 + hlf * 16 + cc) * 64 + v] = okeep;
    }
    if (ch + 1 < 128) SG_LSTORE((ch + 1) & 1);
    sgroup_barrier(cnt, 4u * (++nbar));
  }
  *(float4*)(p.out + OUT_WP + ((size_t)sh * 64 + v) * 64 + 4 * cc) = make_float4(S01.x, S01.y, S23.x, S23.y);
#undef SG_GLOAD
#undef SG_PUT
#undef SG_LSTORE
}

constexpr int NQ_ATT_P = 8192, NQ_ATT_S = 512, NQ_SCAN_S = 8192, NQ_DYN = NQ_ATT_P + NQ_ATT_S + NQ_SCAN_S;
DI int wave_grab(unsigned* ctr) { int v = 0; if ((TIDX & 63) == 0) v = (int)atomicAdd(ctr, 1u); return __builtin_amdgcn_readfirstlane(v); }
DI void phase2(const Params& p, char* smem) {
  __shared__ unsigned s_cnt;
  unsigned* ctl = (unsigned*)(p.ws + WS_CTL);
  const int wid = TIDX >> 6;
  if (TIDX == 0) s_cnt = 0u;
  __syncthreads();
  float* Lsh = (float*)smem + 4 * (8 * 384);
  float* L = wid >= 4 ? (float*)smem + (wid - 4) * (8 * 384) : Lsh + wid * (8 * 384);
  if (wid < 4) {
    unsigned nbar = 0;
    __builtin_amdgcn_s_setprio(3);
    for (int bu = blockIdx.x; bu < 256; bu += gridDim.x) scan_group(p, bu >> 2, bu & 3, Lsh, (volatile LAS unsigned*)&s_cnt, nbar);
    __builtin_amdgcn_s_setprio(0);
  }
  for (;;) {
    int u = wave_grab(&ctl[0]);
    if (u >= NQ_DYN) break;
    if (u < NQ_ATT_P) { attn_wave<false>(p, u >> 7, u & 127); continue; }
    u -= NQ_ATT_P;
    if (u < NQ_ATT_S) { attn_wave<true>(p, u, 0); continue; }
    u -= NQ_ATT_S;
    scan_wave(p, 64 + (u >> 4), u & 15, L);
  }
}

DI void p2c_row(const Params& p, int row, int c, int hh, const float4& lg, const float4& lb, const float4& o, const uint2& vv, const uint2& zz, float bon) {
  const float mean = sum16((o.x + o.y) + (o.z + o.w)) * (1.f / 64.f);
  const float dx = o.x - mean, dy = o.y - mean, dz = o.z - mean, dw = o.w - mean;
  const float var = sum16((dx * dx + dy * dy) + (dz * dz + dw * dw)) * (1.f / 64.f);
  const float inv = rsqrtf(var + LNX_EPS);
  const float r0 = (dx * inv * lg.x + lb.x + bon * bflo(vv.x)) * bflo(zz.x);
  const float r1 = (dy * inv * lg.y + lb.y + bon * bfhi(vv.x)) * bfhi(zz.x);
  const float r2 = (dz * inv * lg.z + lb.z + bon * bflo(vv.y)) * bflo(zz.y);
  const float r3 = (dw * inv * lg.w + lb.w + bon * bfhi(vv.y)) * bfhi(zz.y);
  *(uint2*)((bf16_t*)(p.ws + WS_OB) + (size_t)row * 1024 + c) = make_uint2(cvtpk(r0, r1), cvtpk(r2, r3));
}
DI void phase2c(const Params& p) {
  const int tid = TIDX & 255, half = TIDX >> 8, c = tid * 4, hh = c >> 6;
  const float4 lg = *(const float4*)(p.in[16] + c), lb = *(const float4*)(p.in[17] + c);
  const float* ORAW = (const float*)(p.ws + WS_ORAW); const bf16_t* SV = (const bf16_t*)(p.ws + WS_SV);
  const bf16_t* SZB = (const bf16_t*)(p.ws + WS_SZB); const float* BONUS = (const float*)(p.ws + WS_BONUS);
  const int stride = gridDim.x * 2;
  for (int row = blockIdx.x * 2 + half; row < MT; row += 2 * stride) {
    const bool two = row + stride < MT;
    const int rowb = two ? row + stride : row;
    const size_t ia = hm_base(row) + hh * hm_hstride(row) + (c & 63), ib = hm_base(rowb) + hh * hm_hstride(rowb) + (c & 63);
    const float4 oa = *(const float4*)(ORAW + ia), ob = *(const float4*)(ORAW + ib);
    const uint2 va = *(const uint2*)(SV + ia), vb = *(const uint2*)(SV + ib);
    const uint2 za = *(const uint2*)(SZB + (size_t)row * 1024 + c), zb = *(const uint2*)(SZB + (size_t)rowb * 1024 + c);
    const float ba = BONUS[(size_t)row * 16 + hh], bb = BONUS[(size_t)rowb * 16 + hh];
    p2c_row(p, row, c, hh, lg, lb, oa, va, za, ba);
    if (two) p2c_row(p, rowb, c, hh, lg, lb, ob, vb, zb, bb);
  }
}

DI void phase4(const Params& p) {
  const int lane = TIDX & 63, wid = TIDX >> 6;
  const float* g = p.in[21];
  float4 gg[4];
#pragma unroll
  for (int i = 0; i < 4; ++i) gg[i] = *(const float4*)(g + i * 256 + lane * 4);
  const int stride = gridDim.x * 8;
  for (int row = blockIdx.x * 8 + wid; row < MT; row += 2 * stride) {
    const bool two = row + stride < MT;
    float* x0 = p.out + OUT_YP + (size_t)row * 1024;
    float* x1 = p.out + OUT_YP + (size_t)(two ? row + stride : row) * 1024;
    float4 v0[4], v1[4]; float s0 = 0.f, s1 = 0.f;
#pragma unroll
    for (int i = 0; i < 4; ++i) { v0[i] = *(const float4*)(x0 + i * 256 + lane * 4); v1[i] = *(const float4*)(x1 + i * 256 + lane * 4); }
#pragma unroll
    for (int i = 0; i < 4; ++i) {
      s0 += v0[i].x * v0[i].x + v0[i].y * v0[i].y + v0[i].z * v0[i].z + v0[i].w * v0[i].w;
      s1 += v1[i].x * v1[i].x + v1[i].y * v1[i].y + v1[i].z * v1[i].z + v1[i].w * v1[i].w;
    }
    s0 = wave_sum(s0); s1 = wave_sum(s1);
    const float i0 = rsqrtf(s0 * (1.f / DM) + EPS), i1 = rsqrtf(s1 * (1.f / DM) + EPS);
#pragma unroll
    for (int i = 0; i < 4; ++i) *(float4*)(x0 + i * 256 + lane * 4) = make_float4(v0[i].x * i0 * gg[i].x, v0[i].y * i0 * gg[i].y, v0[i].z * i0 * gg[i].z, v0[i].w * i0 * gg[i].w);
    if (two) {
#pragma unroll
      for (int i = 0; i < 4; ++i) *(float4*)(x1 + i * 256 + lane * 4) = make_float4(v1[i].x * i1 * gg[i].x, v1[i].y * i1 * gg[i].y, v1[i].z * i1 * gg[i].z, v1[i].w * i1 * gg[i].w);
    }
  }
}

#define XB_TMO      128
#define XB_XCNT(j)  (256  + 64 * (j))
#define XB_XSUB(j)  (1280 + 64 * (j))
#define XB_XGEN(j)  (2304 + 64 * (j))
#define XB_TOP      3328
#define XB_TOPGEN   3392
#define XCD_BAR_WORDS 3456
#define XB_SPIN_CAP (1u << 18)

__device__ __forceinline__ unsigned xb_ld(unsigned* p)              { return __hip_atomic_load(p, __ATOMIC_RELAXED, __HIP_MEMORY_SCOPE_AGENT); }
__device__ __forceinline__ unsigned xb_add(unsigned* p, unsigned v) { return __hip_atomic_fetch_add(p, v, __ATOMIC_RELAXED, __HIP_MEMORY_SCOPE_AGENT); }
__device__ __forceinline__ unsigned xb_xcc_id() { return (unsigned)__builtin_amdgcn_s_getreg((3 << 11) | 20) & 0xFu; }
#define XB_SPIN(cond, bar) do { unsigned _sp = 0; while (cond) { __builtin_amdgcn_s_sleep(1); \
    if ((++_sp & 255u) == 0u) { if (xb_ld(&(bar)[XB_TMO])) break; if (_sp > XB_SPIN_CAP) { atomicAdd(&(bar)[XB_TMO], 1u); break; } } } } while (0)

struct XcdBarrier {
    unsigned* bar; unsigned x;
    volatile LAS unsigned* st;
};

__device__ __forceinline__ XcdBarrier xcd_barrier_post(unsigned* bar, volatile LAS unsigned* st) {
    XcdBarrier b; b.bar = bar; b.x = xb_xcc_id(); b.st = st;
    if (TIDX == 0) (void)xb_add(&bar[XB_XCNT(b.x)], 1u);
    return b;
}
__device__ __forceinline__ void xcd_barrier_complete(unsigned* bar, unsigned x, unsigned& nloc, unsigned& nx) {
    const unsigned G = gridDim.x * gridDim.y * gridDim.z;
    unsigned sum, cnt, mine, sp = 0u;
    for (;;) {
        sum = 0u; cnt = 0u; mine = 0u;
#pragma unroll
        for (unsigned j = 0; j < 16; ++j) { const unsigned c = xb_ld(&bar[XB_XCNT(j)]); sum += c; cnt += (c > 0u) ? 1u : 0u; mine = (j == x) ? c : mine; }
        if (sum == G) break;
        __builtin_amdgcn_s_sleep(1);
        if ((++sp & 255u) == 0u) { if (xb_ld(&bar[XB_TMO])) break; if (sp > XB_SPIN_CAP) { atomicAdd(&bar[XB_TMO], 1u); break; } }
    }
    nloc = mine > 0u ? mine : 1u; nx = cnt > 0u ? cnt : 1u;
}

__device__ __forceinline__ void xcd_barrier(const XcdBarrier& b) {
    asm volatile("s_waitcnt vmcnt(0)" ::: "memory");
    __syncthreads();
    if (TIDX == 0) {
        unsigned* bar = b.bar;
        __builtin_amdgcn_s_waitcnt(0);
        unsigned nloc = b.st[0], nx = b.st[1];
        if (nloc == 0u) { xcd_barrier_complete(bar, b.x, nloc, nx); b.st[0] = nloc; b.st[1] = nx; }
        const unsigned old = xb_add(&bar[XB_XSUB(b.x)], 1u);
        const unsigned gen = old / nloc;
        if (old + 1u == (gen + 1u) * nloc) {
            __builtin_amdgcn_fence(__ATOMIC_RELEASE, "agent");
            asm volatile("s_waitcnt vmcnt(0)" ::: "memory");
            const unsigned og = xb_add(&bar[XB_TOP], 1u);
            const unsigned tg = og / nx;
            if (og + 1u == (tg + 1u) * nx) xb_add(&bar[XB_TOPGEN], 1u);
            else XB_SPIN(xb_ld(&bar[XB_TOPGEN]) == tg, bar);
            __builtin_amdgcn_fence(__ATOMIC_ACQUIRE, "agent");
            xb_add(&bar[XB_XGEN(b.x)], 1u);
            asm volatile("s_waitcnt vmcnt(0)" ::: "memory");
        } else {
            XB_SPIN(xb_ld(&bar[XB_XGEN(b.x)]) == gen, bar);
            __builtin_amdgcn_fence(__ATOMIC_ACQUIRE, "agent");
            asm volatile("s_waitcnt vmcnt(0)" ::: "memory");
        }
    }
    __syncthreads();
}

__global__ void __launch_bounds__(NT, 2) mega(Params p) {
  extern __shared__ __attribute__((aligned(16))) char smem[];
  cg::grid_group grid = cg::this_grid();
  if (blockIdx.x == 0) { unsigned* ctl = (unsigned*)(p.ws + WS_CTL); for (int i = TIDX; i < 16384; i += NT) ctl[i] = 0u; }
  grid.sync();
  __shared__ unsigned xb_st[2];
  if (TIDX == 0) { xb_st[0] = 0u; xb_st[1] = 0u; }
  __syncthreads();
  (void)xcd_barrier_post((unsigned*)(p.ws + WS_CTL) + 8192, (volatile LAS unsigned*)xb_st);
#define XBAR() do { XcdBarrier xb_; xb_.bar = (unsigned*)(p.ws + WS_CTL) + 8192; xb_.x = xb_xcc_id(); xb_.st = (volatile LAS unsigned*)xb_st; xcd_barrier(xb_); } while (0)
  phase0(p, smem);
  XBAR();
  { EpiP1 E; E.p = p; run_gemm(smem, (const bf16_t*)(p.ws + WS_H), (const bf16_t*)(p.ws + WS_WINT), MT, NINP, E); }
  XBAR();
  phase_x(p);
  XBAR();
  { EpiLora E; E.p = p; run_gemm(smem, (const bf16_t*)(p.ws + WS_X), (const bf16_t*)(p.ws + WS_BTL), MT, 2048, E, 256); }
  XBAR();
  phase1c(p);
  XBAR();
  phase2(p, smem);
  XBAR();
  phase2c(p);
  XBAR();
  { EpiGate E; E.p = p; E.goff = 0; E.first = true; run_gemm(smem, (const bf16_t*)(p.ws + WS_QB), (const bf16_t*)(p.ws + WS_WT), MP, 1024, E); }
  small_gemm<0>(p, (const bf16_t*)(p.ws + WS_QB), (const bf16_t*)(p.ws + WS_WT));
  { EpiGate E; E.p = p; E.goff = 1024; E.first = false; run_gemm(smem, (const bf16_t*)(p.ws + WS_OB), (const bf16_t*)(p.ws + WS_WT) + (size_t)1024 * 1024, MP, 1024, E); }
  small_gemm<1>(p, (const bf16_t*)(p.ws + WS_OB), (const bf16_t*)(p.ws + WS_WT) + (size_t)1024 * 1024);
  XBAR();
  { EpiOut E; E.p = p; run_gemm(smem, (const bf16_t*)(p.ws + WS_MG), (const bf16_t*)(p.ws + WS_WT) + (size_t)2 * 1024 * 1024, MP, 1024, E); }
  small_gemm<2>(p, (const bf16_t*)(p.ws + WS_MG), (const bf16_t*)(p.ws + WS_WT) + (size_t)2 * 1024 * 1024);
  XBAR();
  phase4(p);
}

extern "C" void kernel_launch(void* const* d_in, const int* in_sizes, int n_in, void* d_out, int out_size, void* d_ws, size_t ws_size, hipStream_t stream) {
  static int grid_blocks = 0;
  if (grid_blocks == 0) {
    if (n_in != 22 || ws_size < WS_END) { fprintf(stderr, "kernel_launch: unexpected n_in %d / ws_size %zu (need %zu)\n", n_in, ws_size, (size_t)WS_END); grid_blocks = -1; return; }
    int dev = 0, cus = 0, per_cu = 0;
    (void)hipGetDevice(&dev);
    (void)hipDeviceGetAttribute(&cus, hipDeviceAttributeMultiprocessorCount, dev);
    (void)hipFuncSetAttribute((const void*)mega, hipFuncAttributeMaxDynamicSharedMemorySize, SMEM_BYTES);
    (void)hipOccupancyMaxActiveBlocksPerMultiprocessor(&per_cu, (const void*)mega, NT, SMEM_BYTES);
    (void)hipGetLastError();
    grid_blocks = cus;
  }
  if (grid_blocks < 0) return;
  Params p{};
  for (int i = 0; i < 22; ++i) p.in[i] = (const float*)d_in[i];
  p.out = (float*)d_out; p.ws = (unsigned char*)d_ws;
  void* args[] = {&p};
  hipError_t e = hipLaunchCooperativeKernel((const void*)mega, dim3(grid_blocks), dim3(NT), args, SMEM_BYTES, stream);
  if (e != hipSuccess) fprintf(stderr, "cooperative launch failed: %s (grid %d)\n", hipGetErrorString(e), grid_blocks);
}
```

```cpp
#include <hip/hip_runtime.h>
#include <hip/hip_cooperative_groups.h>
#include <cstdio>
#include <cstdint>
namespace cg = cooperative_groups;
__device__ __forceinline__ int lane_id_() { return (int)__builtin_amdgcn_mbcnt_hi(~0u, __builtin_amdgcn_mbcnt_lo(~0u, 0u)); }
#define TIDX (__builtin_amdgcn_readfirstlane((int)(threadIdx.x >> 6)) * 64 + lane_id_())

namespace pg8 {
#define PG8_LAS __attribute__((address_space(3)))
typedef unsigned short bf16_t;
typedef short bf16x8 __attribute__((ext_vector_type(8)));
typedef float f32x4 __attribute__((ext_vector_type(4)));
typedef unsigned u32x4 __attribute__((ext_vector_type(4)));
constexpr int BM = 256, BK = 64, HALF = 128, HTB = HALF * BK * 2  , STAGE_BYTES = 8 * HTB, NXCD = 8, WGM = 8;

__host__ __device__ __forceinline__ int lds_byte(int r, int c) { const int st = (r >> 4) * 2 + (c >> 5), rr = r & 15, cc = c & 31, ob = rr * 64 + cc * 2; return st * 1024 + (ob ^ (((ob >> 9) & 1) << 5)); }
__host__ __device__ __forceinline__ void stage_rc(int b, int& R, int& C) { const int st = b / 1024, sb = b % 1024, swz = sb ^ (((sb >> 9) & 1) << 5); R = (st >> 1) * 16 + swz / 64; C = (st & 1) * 32 + (swz % 64) / 2; }
__host__ __device__ __forceinline__ int perm32(int rho) { const int n = rho >> 4, i = rho & 15; return 8 * (i >> 2) + 4 * n + (i & 3); }

struct Unit { int pm, pn; };
struct Gemm { const bf16_t* A; const bf16_t* Bt; int M, N, K; };

struct StaticOrder {
    int nM, nN, nwg, G, c;
    __host__ __device__ void init(int M, int N, int G_, int c_) { nM = M / BM; nN = N / BM; nwg = nM * nN; G = G_; c = c_; }
    __host__ __device__ bool next(int i, Unit& u) const {
        const long L = (long)i * G + c; if (L >= nwg) return false;
        int wgid = (int)L; { const int q = nwg / NXCD, r = nwg % NXCD, xcd = wgid % NXCD, off = wgid / NXCD; wgid = (xcd < r ? xcd * (q + 1) : r * (q + 1) + (xcd - r) * q) + off; }
        const int nig = WGM * nN, gid = wgid / nig, fm = gid * WGM, gsz = (nM - fm) < WGM ? (nM - fm) : WGM;
        u.pm = fm + ((wgid % nig) % gsz); u.pn = (wgid % nig) / gsz; return true;
    }
    __device__ __forceinline__ void a_ready(const Unit&) const {}
    __device__ __forceinline__ void done(const Unit&) const {}
};


template <class Epi, class Sched, bool ALIGN_EPI = false, bool SP2 = false>
__device__ __forceinline__ void gemm_phase(PG8_LAS unsigned char* lds, const Gemm g, const Sched& S, const Epi& E) {
    int tid_ = TIDX; asm volatile("" : "+v"(tid_));
    const int tid = tid_, wid = __builtin_amdgcn_readfirstlane(tid >> 6), lane = tid & 63, wr = wid >> 2, wc = wid & 3, fr = lane & 15, fq = lane >> 4;
    const int K = g.K, nt = K / BK;
    unsigned voffA[2], voffB[2];
#pragma unroll
    for (int i = 0; i < 2; ++i) { int R, C; stage_rc(tid * 16 + i * 8192, R, C); const int Rb = Epi::PERM ? ((R & ~31) + perm32(R & 31)) : R;
        voffA[i] = (unsigned)(R * K + C) * 2u; voffB[i] = (unsigned)(Rb * K + C) * 2u; }
    const size_t kstep = (size_t)(BK * 2);
    const size_t hstep = (size_t)HALF * K * 2;
    const size_t tstep = 2 * hstep;
    const unsigned ldsw = (unsigned)wid * 1024u;
    const int aoff = lds_byte(wr * 64 + fr, fq * 8), boff = lds_byte(wc * 32 + fr, fq * 8);
#define PG8_SA(b, h) (((b) * 2 + (h)) * HTB)
#define PG8_SB(b, h) ((4 + (b) * 2 + (h)) * HTB)
#define PG8_STAGE(bufoff, gbase, voff) do { _Pragma("unroll") for (int _i = 0; _i < 2; ++_i) \
        __builtin_amdgcn_global_load_lds((const unsigned*)((const char*)(gbase) + (voff)[_i]), (PG8_LAS unsigned*)(lds + (bufoff) + ldsw + _i * 8192), 16, 0, 0); } while (0)
#define PG8_LDA(dst, b, h) do { _Pragma("unroll") for (int m = 0; m < 4; ++m) _Pragma("unroll") for (int k = 0; k < 2; ++k) dst[m][k] = *(const PG8_LAS bf16x8*)(lds + PG8_SA(b, h) + aoff + m * 2048 + k * 1024); } while (0)
#define PG8_LDB(dst, b, h) do { _Pragma("unroll") for (int n = 0; n < 2; ++n) _Pragma("unroll") for (int k = 0; k < 2; ++k) dst[n][k] = *(const PG8_LAS bf16x8*)(lds + PG8_SB(b, h) + boff + n * 2048 + k * 1024); } while (0)
#define PG8_MMA(ai, bj, At, Bt) do { __builtin_amdgcn_s_setprio(1); _Pragma("unroll") for (int m = 0; m < 4; ++m) _Pragma("unroll") for (int n = 0; n < 2; ++n) _Pragma("unroll") for (int k = 0; k < 2; ++k) \
        acc[ai][bj][m][n] = __builtin_amdgcn_mfma_f32_16x16x32_bf16(Bt[n][k], At[m][k], acc[ai][bj][m][n], 0, 0, 0); __builtin_amdgcn_s_setprio(0); } while (0)
#define PG8_WAIT_V(n) asm volatile("s_waitcnt vmcnt(" #n ")" ::: "memory")
#define PG8_WAIT_L(n) asm volatile("s_waitcnt lgkmcnt(" #n ")" ::: "memory")
#define PG8_BAR __builtin_amdgcn_s_barrier()
#define PG8_SCHED __builtin_amdgcn_sched_barrier(0)
    Unit cur, nxt; int ui = 0;
    if (!S.next(0, cur)) return;
    f32x4 acc[2][2][4][2];
#pragma unroll
    for (int a = 0; a < 2; ++a)
#pragma unroll
        for (int b = 0; b < 2; ++b)
#pragma unroll
            for (int m = 0; m < 4; ++m)
#pragma unroll
                for (int n = 0; n < 2; ++n) acc[a][b][m][n] = (f32x4){0.f, 0.f, 0.f, 0.f};
    bf16x8 At[4][2], B0[2][2], B1[2][2];
    const char* cA = (const char*)g.A + (size_t)cur.pm * tstep; const char* cB = (const char*)g.Bt + (size_t)cur.pn * tstep;
    S.a_ready(cur);
    if constexpr (SP2) {
        PG8_STAGE(PG8_SB(0, 0), cB, voffB); PG8_STAGE(PG8_SB(0, 1), cB + hstep, voffB); PG8_STAGE(PG8_SA(0, 0), cA, voffA); PG8_STAGE(PG8_SA(0, 1), cA + hstep, voffA);
        if (wr == 1) PG8_BAR;
        PG8_WAIT_V(2); PG8_BAR;
        PG8_STAGE(PG8_SB(1, 0), cB + kstep, voffB); PG8_STAGE(PG8_SA(1, 0), cA + kstep, voffA); PG8_STAGE(PG8_SB(1, 1), cB + hstep + kstep, voffB);
        PG8_WAIT_V(6); PG8_BAR;
    } else {
        PG8_STAGE(PG8_SB(0, 0), cB, voffB); PG8_STAGE(PG8_SA(0, 0), cA, voffA); PG8_STAGE(PG8_SB(0, 1), cB + hstep, voffB); PG8_STAGE(PG8_SA(0, 1), cA + hstep, voffA);
        if (wr == 1) PG8_BAR;
        PG8_WAIT_V(4); PG8_BAR;
        PG8_STAGE(PG8_SB(1, 0), cB + kstep, voffB); PG8_STAGE(PG8_SA(1, 0), cA + kstep, voffA); PG8_STAGE(PG8_SB(1, 1), cB + hstep + kstep, voffB);
        PG8_WAIT_V(6); PG8_BAR;
    }
    for (;;) {
        const bool has_next = S.next(ui + 1, nxt);
        const char* nA = has_next ? (const char*)g.A + (size_t)nxt.pm * tstep : cA; const char* nB = has_next ? (const char*)g.Bt + (size_t)nxt.pn * tstep : cB;
        for (int t = 0; t < nt; t += 2) {
            const bool last = (t == nt - 2);
            const char* a1 = cA + (size_t)(t + 1) * kstep;
            const char* a2 = last ? nA : cA + (size_t)(t + 2) * kstep; const char* b2 = last ? nB : cB + (size_t)(t + 2) * kstep;
            const char* a3 = a2 + kstep; const char* b3 = b2 + kstep;
            if (last && has_next) S.a_ready(nxt);
            if constexpr (SP2) {
            PG8_LDB(B0, 0, 0); PG8_LDB(B1, 0, 1); PG8_SCHED; PG8_LDA(At, 0, 0); PG8_STAGE(PG8_SA(1, 1), a1 + hstep, voffA);
            PG8_WAIT_V(8); PG8_WAIT_L(0); PG8_BAR; PG8_MMA(0, 0, At, B0); PG8_MMA(0, 1, At, B1); PG8_BAR; PG8_SCHED;
            PG8_LDA(At, 0, 1); PG8_STAGE(PG8_SB(0, 0), b2, voffB); PG8_STAGE(PG8_SB(0, 1), b2 + hstep, voffB); PG8_STAGE(PG8_SA(0, 0), a2, voffA);
            PG8_WAIT_V(8); PG8_WAIT_L(0); PG8_BAR; PG8_MMA(1, 0, At, B0); PG8_MMA(1, 1, At, B1); PG8_BAR; PG8_SCHED;
            PG8_LDB(B0, 1, 0); PG8_LDB(B1, 1, 1); PG8_SCHED; PG8_LDA(At, 1, 0); PG8_STAGE(PG8_SA(0, 1), a2 + hstep, voffA);
            PG8_WAIT_V(8); PG8_WAIT_L(0); PG8_BAR; PG8_MMA(0, 0, At, B0); PG8_MMA(0, 1, At, B1); PG8_BAR; PG8_SCHED;
            PG8_LDA(At, 1, 1); PG8_STAGE(PG8_SB(1, 0), b3, voffB); PG8_STAGE(PG8_SB(1, 1), b3 + hstep, voffB); PG8_STAGE(PG8_SA(1, 0), a3, voffA);
            PG8_WAIT_V(8); PG8_WAIT_L(0); PG8_BAR; PG8_MMA(1, 0, At, B0); PG8_MMA(1, 1, At, B1); PG8_BAR; PG8_SCHED;
            } else {
            PG8_LDB(B0, 0, 0); PG8_SCHED; PG8_LDA(At, 0, 0); PG8_STAGE(PG8_SA(1, 1), a1 + hstep, voffA);
            PG8_WAIT_L(8); PG8_BAR; PG8_WAIT_L(0); PG8_MMA(0, 0, At, B0); PG8_BAR; PG8_SCHED;
            PG8_LDB(B1, 0, 1); PG8_STAGE(PG8_SB(0, 0), b2, voffB);
            PG8_BAR; PG8_WAIT_L(0); PG8_MMA(0, 1, At, B1); PG8_BAR;
            PG8_LDA(At, 0, 1); PG8_STAGE(PG8_SA(0, 0), a2, voffA);
            PG8_BAR; PG8_WAIT_L(0); PG8_MMA(1, 0, At, B0); PG8_BAR; PG8_SCHED;
            PG8_STAGE(PG8_SB(0, 1), b2 + hstep, voffB);
            PG8_WAIT_V(6); PG8_BAR; PG8_MMA(1, 1, At, B1); PG8_BAR;
            PG8_LDB(B0, 1, 0); PG8_SCHED; PG8_LDA(At, 1, 0); PG8_STAGE(PG8_SA(0, 1), a2 + hstep, voffA);
            PG8_WAIT_L(8); PG8_BAR; PG8_WAIT_L(0); PG8_MMA(0, 0, At, B0); PG8_BAR; PG8_SCHED;
            PG8_LDB(B1, 1, 1); PG8_STAGE(PG8_SB(1, 0), b3, voffB);
            PG8_BAR; PG8_WAIT_L(0); PG8_MMA(0, 1, At, B1); PG8_BAR;
            PG8_LDA(At, 1, 1); PG8_STAGE(PG8_SA(1, 0), a3, voffA);
            PG8_BAR; PG8_WAIT_L(0); PG8_MMA(1, 0, At, B0); PG8_BAR; PG8_SCHED;
            PG8_STAGE(PG8_SB(1, 1), b3 + hstep, voffB);
            PG8_WAIT_V(6); PG8_BAR; PG8_MMA(1, 1, At, B1); PG8_BAR;
            }
        }
        if constexpr (ALIGN_EPI) { if (wr == 0) PG8_BAR; }
        if constexpr (!Epi::AFTER_DRAIN) { E(acc, cur, wr, wc, fr, fq); S.done(cur); }
        if (!has_next) break;
#pragma unroll
        for (int a = 0; a < 2; ++a)
#pragma unroll
            for (int b = 0; b < 2; ++b)
#pragma unroll
                for (int m = 0; m < 4; ++m)
#pragma unroll
                    for (int n = 0; n < 2; ++n) acc[a][b][m][n] = (f32x4){0.f, 0.f, 0.f, 0.f};
        cur = nxt; cA = nA; cB = nB; ++ui;
        if constexpr (ALIGN_EPI) { if (wr == 1) PG8_BAR; }
    }
    PG8_WAIT_V(0);
    if constexpr (!ALIGN_EPI) { if (wr == 0) PG8_BAR; }
    PG8_BAR;
    if constexpr (Epi::AFTER_DRAIN) { E.fused(acc, cur, wr, wc, fr, fq, lds, wid, lane); S.done(cur); }
#undef PG8_SA
#undef PG8_SB
#undef PG8_STAGE
#undef PG8_LDA
#undef PG8_LDB
#undef PG8_MMA
#undef PG8_WAIT_V
#undef PG8_WAIT_L
#undef PG8_BAR
#undef PG8_SCHED
}
}


#define DI __device__ __forceinline__
typedef unsigned short bf16_t;
typedef short bf16x8 __attribute__((ext_vector_type(8)));
typedef float f32x4 __attribute__((ext_vector_type(4)));
typedef float f32x2 __attribute__((ext_vector_type(2)));
typedef float f32x16 __attribute__((ext_vector_type(16)));
typedef unsigned u32x4 __attribute__((ext_vector_type(4)));
#define MFMA32(a, b, c) __builtin_amdgcn_mfma_f32_32x32x16_bf16((a), (b), (c), 0, 0, 0)
#define LAS __attribute__((address_space(3)))

constexpr int NT = 512;
constexpr int DM = 1024, MP = 16384, MT = 16896;
constexpr int NIN = 10368, NINP = 10496, CSH = 4224;
constexpr float EPS = 1e-6f, LNX_EPS = 64e-5f;
constexpr float QSCALE = 0.18033688011112042f;

constexpr size_t OUT_YP = 0, OUT_KP = 17301504, OUT_VP = 34078720, OUT_SHP = 50855936, OUT_WP = 50872832,
                 OUT_KS = 51134976, OUT_VS = 51659264, OUT_SHS = 52183552, OUT_WS = 52318720;

constexpr size_t SZ_ACT = (size_t)MT * 1024 * 2;
constexpr size_t WS_R1 = 0;
constexpr size_t WS_H = WS_R1, WS_WINT = WS_R1 + SZ_ACT, WS_SW = WS_R1;
constexpr size_t WS_R2 = (size_t)MT * 1024 * 4;
constexpr size_t WS_PB = WS_R2, WS_ORAW = WS_R2, WS_OB = WS_ORAW + (size_t)MT * 1024 * 4, WS_MG = WS_OB + SZ_ACT;
constexpr size_t WS_R3 = WS_R2 + (size_t)MT * CSH * 2;
constexpr size_t WS_QB = WS_R3, WS_X = WS_QB + SZ_ACT  , WS_BTL = WS_X + (size_t)MT * 256 * 2  , WS_SZA = WS_X + (size_t)MP * 1024 * 2;
static_assert(WS_BTL + (size_t)2048 * 256 * 2 <= WS_SZA, "LoRA buffers");
constexpr size_t WS_SR = WS_SZA + SZ_ACT, WS_SK = WS_SR + SZ_ACT, WS_SV = WS_SK + SZ_ACT, WS_SKK = WS_SV + SZ_ACT, WS_SB = WS_SKK + SZ_ACT;
constexpr size_t WS_SZB = WS_SB + SZ_ACT;
constexpr size_t WS_BONUS = WS_SZB + SZ_ACT;
constexpr size_t WS_WT = WS_BONUS + (size_t)MT * 16 * 4;
constexpr size_t WS_CTL = WS_WT + 3 * (size_t)1024 * 1024 * 2;
constexpr size_t WS_END = WS_CTL + 65536;
static_assert(WS_MG + SZ_ACT <= WS_R3, "R2 overflow");
static_assert(WS_WINT + (size_t)NINP * 1024 * 2 <= WS_R2, "R1 overflow");
static_assert(WS_END <= (size_t)512 * 1024 * 1024, "workspace");

constexpr int SMEM_BYTES = 147456;

struct Params { const float* in[22]; float* out; unsigned char* ws; };

DI float bf2f(bf16_t u) { return __uint_as_float((unsigned)u << 16); }
DI unsigned cvtpk(float lo, float hi) { unsigned r; asm volatile("v_cvt_pk_bf16_f32 %0, %1, %2" : "=v"(r) : "v"(lo), "v"(hi)); return r; }
DI bf16_t f2bf(float x) { return (bf16_t)(cvtpk(x, 0.f) & 0xffffu); }
DI float bflo(unsigned u) { return __uint_as_float(u << 16); }
DI float bfhi(unsigned u) { return __uint_as_float(u & 0xffff0000u); }
DI int crow(int i, int h) { return (i & 3) + 8 * (i >> 2) + 4 * h; }
DI float sigmoidf_(float x) { return fminf(__builtin_amdgcn_rcpf(1.f + __expf(-x)), 1.f); }
DI uint4 pack8(f32x4 a, f32x4 b) { return make_uint4(cvtpk(a[0], a[1]), cvtpk(a[2], a[3]), cvtpk(b[0], b[1]), cvtpk(b[2], b[3])); }
DI float wave_sum(float x) {
#pragma unroll
  for (int o = 32; o > 0; o >>= 1) x += __shfl_xor(x, o);
  return x;
}
DI float sum16(float x) { x += __shfl_xor(x, 1); x += __shfl_xor(x, 2); x += __shfl_xor(x, 4); x += __shfl_xor(x, 8); return x; }
template <int CTRL> DI float dppf(float x) { return __builtin_bit_cast(float, __builtin_amdgcn_mov_dpp(__builtin_bit_cast(int, x), CTRL, 0xf, 0xf, true)); }
DI float row32_sum(float x) {
  x += dppf<0xB1>(x);
  x += dppf<0x4E>(x);
  x += dppf<0x124>(x);
  x += dppf<0x128>(x);
  const auto s = __builtin_amdgcn_permlane16_swap(__float_as_uint(x), __float_as_uint(x), false, false);
  return __uint_as_float(s[0]) + __uint_as_float(s[1]);
}
DI size_t hm_base(int row) {
  if (row < MP) { const int b = row >> 12, t = row & 4095; return ((size_t)(b * 16) * 4096 + t) * 64; }
  const int rs = row - MP, b = rs >> 4, t = rs & 15; return (size_t)MP * 1024 + ((size_t)(b * 16) * 16 + t) * 64;
}
DI size_t hm_hstride(int row) { return row < MP ? (size_t)4096 * 64 : (size_t)16 * 64; }

DI void p0_rmsnorm_rows(const Params& p, int item) {
  const int lane = TIDX & 63, wid = TIDX >> 6;
  const int row = item * 8 + wid;
  const float* x = row < MP ? p.in[0] + (size_t)row * DM : p.in[1] + (size_t)(row - MP) * DM;
  const float* g = p.in[6];
  float4 v[4]; float ss = 0.f;
#pragma unroll
  for (int i = 0; i < 4; ++i) { v[i] = *(const float4*)(x + i * 256 + lane * 4); ss += v[i].x * v[i].x + v[i].y * v[i].y + v[i].z * v[i].z + v[i].w * v[i].w; }
  ss = wave_sum(ss);
  const float inv = rsqrtf(ss * (1.f / DM) + EPS);
  bf16_t* H = (bf16_t*)(p.ws + WS_H) + (size_t)row * DM;
#pragma unroll
  for (int i = 0; i < 4; ++i) {
    const float4 gg = *(const float4*)(g + i * 256 + lane * 4);
    uint2 o; o.x = cvtpk(v[i].x * inv * gg.x, v[i].y * inv * gg.y); o.y = cvtpk(v[i].z * inv * gg.z, v[i].w * inv * gg.w);
    *(uint2*)(H + i * 256 + lane * 4) = o;
  }
}
DI void p0_transpose_tile(const float* src, bf16_t* dst, int N, int kt, int nt, float* lds) {
  const int tid = TIDX & 255;
  const int k0 = kt * 64, n0 = nt * 64;
#pragma unroll
  for (int i = 0; i < 4; ++i) {
    const int row = (tid >> 4) + 16 * i, c4 = (tid & 15) * 4;
    const float4 v = *(const float4*)(src + (size_t)(k0 + row) * N + n0 + c4);
    lds[row * 65 + c4 + 0] = v.x; lds[row * 65 + c4 + 1] = v.y; lds[row * 65 + c4 + 2] = v.z; lds[row * 65 + c4 + 3] = v.w;
  }
  __syncthreads();
  const int n = tid >> 2, kc = (tid & 3) * 16;
  unsigned w[8];
#pragma unroll
  for (int j = 0; j < 8; ++j) w[j] = cvtpk(lds[(kc + 2 * j) * 65 + n], lds[(kc + 2 * j + 1) * 65 + n]);
  uint4* d = (uint4*)(dst + (size_t)(n0 + n) * 1024 + k0 + kc);
  d[0] = make_uint4(w[0], w[1], w[2], w[3]); d[1] = make_uint4(w[4], w[5], w[6], w[7]);
  __syncthreads();
}
DI void phase0(const Params& p, char* smem) {
  {
    bf16_t* BL = (bf16_t*)(p.ws + WS_BTL);
    for (int i = blockIdx.x * NT + TIDX; i < 2048 * 256; i += gridDim.x * NT) {
      const int n = i >> 8, k = i & 255;
      float v = 0.f;
      if (n < 1024) { if (k < 64) v = p.in[10][(size_t)k * 1024 + n]; }
      else if (k >= 64 && k < 128) v = p.in[12][(size_t)(k - 64) * 1024 + (n - 1024)];
      BL[i] = f2bf(v);
    }
  }
  constexpr int N_ROWS = MT / 8, N_TIN = 16 * 162 / 2, N_TSQ = 256 / 2;
  constexpr int N_ITEMS = N_ROWS + N_TIN + 3 * N_TSQ;
  const int half = TIDX >> 8;
  float* scr = (float*)smem + half * (64 * 65);
  for (int it = blockIdx.x; it < N_ITEMS; it += gridDim.x) {
    if (it < N_ROWS) { p0_rmsnorm_rows(p, it); continue; }
    int j = it - N_ROWS;
    if (j < N_TIN) { const int t = 2 * j + half; p0_transpose_tile(p.in[7], (bf16_t*)(p.ws + WS_WINT), NIN, t / 162, t % 162, scr); continue; }
    j -= N_TIN;
    const int w = j / N_TSQ; const int t = 2 * (j % N_TSQ) + half;
    p0_transpose_tile(p.in[18 + w], (bf16_t*)(p.ws + WS_WT) + (size_t)w * 1024 * 1024, 1024, t >> 4, t & 15, scr);
  }
}

struct EpiP1 {
  static constexpr bool PERM = true, AFTER_DRAIN = false;
  Params p;
  DI void operator()(const pg8::f32x4 (&acc)[2][2][4][2], const pg8::Unit& u, int wr, int wc, int fr, int fq) const {
    const int colt = u.pn * 256;
    const int region = colt >> 10;
#pragma unroll
    for (int ai = 0; ai < 2; ++ai)
#pragma unroll
      for (int m = 0; m < 4; ++m) {
        const int row = u.pm * 256 + ai * 128 + wr * 64 + m * 16 + fr;
        const bool prompt = row < MP;
        const int rs = row - MP;
#pragma unroll
        for (int bj = 0; bj < 2; ++bj) {
          const int col = colt + bj * 128 + wc * 32 + 8 * fq;
          const f32x4 v0 = acc[ai][bj][m][0], v1 = acc[ai][bj][m][1];
          if (region >= 6) {
            const int pc = col - 6144;
            if (pc < CSH) {
              *(uint4*)((bf16_t*)(p.ws + WS_PB) + (size_t)row * CSH + pc) = pack8(v0, v1);
              float* so = nullptr;
              if (prompt) { if ((row & 4095) == 4095) so = p.out + OUT_SHP + (size_t)(row >> 12) * CSH + pc; }
              else if ((rs & 15) == 15) so = p.out + OUT_SHS + (size_t)(rs >> 4) * CSH + pc;
              if (so) { *(f32x4*)so = v0; *(f32x4*)(so + 4) = v1; }
            }
          } else if (region == 0) {
            *(uint4*)((bf16_t*)(p.ws + WS_QB) + (size_t)row * 1024 + col) = pack8(v0 * QSCALE, v1 * QSCALE);
          } else if (region == 1) {
            const int c = col - 1024, hh = c >> 6, d = c & 63;
            float* o = prompt ? p.out + OUT_KP + (((size_t)(row >> 12) * 16 + hh) * 4096 + (row & 4095)) * 64 + d
                              : p.out + OUT_KS + (((size_t)(rs >> 4) * 16 + hh) * 16 + (rs & 15)) * 64 + d;
            __builtin_nontemporal_store(v0, (f32x4*)o); __builtin_nontemporal_store(v1, (f32x4*)(o + 4));
          } else if (region == 2) {
            const int c = col - 2048, hh = c >> 6, d = c & 63;
            float* o = prompt ? p.out + OUT_VP + (((size_t)(row >> 12) * 16 + hh) * 4096 + (row & 4095)) * 64 + d
                              : p.out + OUT_VS + (((size_t)(rs >> 4) * 16 + hh) * 16 + (rs & 15)) * 64 + d;
            __builtin_nontemporal_store(v0, (f32x4*)o); __builtin_nontemporal_store(v1, (f32x4*)(o + 4));
          } else if (region == 3) {
            f32x4 a, b;
#pragma unroll
            for (int j = 0; j < 4; ++j) { a[j] = v0[j] * sigmoidf_(v0[j]); b[j] = v1[j] * sigmoidf_(v1[j]); }
            *(uint4*)((bf16_t*)(p.ws + WS_SZA) + (size_t)row * 1024 + (col - 3072)) = pack8(a, b);
          } else {
            f32x4 a, b;
#pragma unroll
            for (int j = 0; j < 4; ++j) { a[j] = sigmoidf_(v0[j]); b[j] = sigmoidf_(v1[j]); }
            *(uint4*)((bf16_t*)p.out + (size_t)row * 2048 + (col - 4096)) = pack8(a, b);
          }
        }
      }
  }
};
struct EpiGate {
  static constexpr bool PERM = true, AFTER_DRAIN = false;
  Params p; int goff; bool first;
  DI void operator()(const pg8::f32x4 (&acc)[2][2][4][2], const pg8::Unit& u, int wr, int wc, int fr, int fq) const {
    const bf16_t* G = (const bf16_t*)p.out; bf16_t* MG = (bf16_t*)(p.ws + WS_MG);
#pragma unroll
    for (int ai = 0; ai < 2; ++ai)
#pragma unroll
      for (int m = 0; m < 4; ++m) {
        const size_t row = u.pm * 256 + ai * 128 + wr * 64 + m * 16 + fr;
#pragma unroll
        for (int bj = 0; bj < 2; ++bj) {
          const int col = u.pn * 256 + bj * 128 + wc * 32 + 8 * fq;
          const uint4 g = *(const uint4*)(G + row * 2048 + goff + col);
          f32x4 a = acc[ai][bj][m][0], b = acc[ai][bj][m][1];
          a[0] *= bflo(g.x); a[1] *= bfhi(g.x); a[2] *= bflo(g.y); a[3] *= bfhi(g.y);
          b[0] *= bflo(g.z); b[1] *= bfhi(g.z); b[2] *= bflo(g.w); b[3] *= bfhi(g.w);
          if (!first) {
            const uint4 o = *(const uint4*)(MG + row * 1024 + col);
            a[0] += bflo(o.x); a[1] += bfhi(o.x); a[2] += bflo(o.y); a[3] += bfhi(o.y);
            b[0] += bflo(o.z); b[1] += bfhi(o.z); b[2] += bflo(o.w); b[3] += bfhi(o.w);
          }
          *(uint4*)(MG + row * 1024 + col) = pack8(a, b);
        }
      }
  }
};
struct EpiOut {
  static constexpr bool PERM = true, AFTER_DRAIN = false;
  Params p;
  DI void operator()(const pg8::f32x4 (&acc)[2][2][4][2], const pg8::Unit& u, int wr, int wc, int fr, int fq) const {
#pragma unroll
    for (int ai = 0; ai < 2; ++ai)
#pragma unroll
      for (int m = 0; m < 4; ++m) {
        const int row = u.pm * 256 + ai * 128 + wr * 64 + m * 16 + fr;
        const float* xr = row < MP ? p.in[0] + (size_t)row * 1024 : p.in[1] + (size_t)(row - MP) * 1024;
        float* orow = p.out + OUT_YP + (size_t)row * 1024;
#pragma unroll
        for (int bj = 0; bj < 2; ++bj) {
          const int col = u.pn * 256 + bj * 128 + wc * 32 + 8 * fq;
          const f32x4 x0 = *(const f32x4*)(xr + col), x1 = *(const f32x4*)(xr + col + 4);
          *(f32x4*)(orow + col) = x0 + acc[ai][bj][m][0]; *(f32x4*)(orow + col + 4) = x1 + acc[ai][bj][m][1];
        }
      }
  }
};
template <class Epi>
DI void run_gemm(char* smem, const bf16_t* A, const bf16_t* Bt, int M, int N, const Epi& E, int K = 1024) {
  pg8::Gemm g; g.A = A; g.Bt = Bt; g.M = M; g.N = N; g.K = K;
  pg8::StaticOrder S; S.init(M, N, (int)gridDim.x, (int)blockIdx.x);
  pg8::gemm_phase<Epi, pg8::StaticOrder, true, true>((LAS unsigned char*)smem, g, S, E);
  __syncthreads();
}

template <int MODE>
DI void small_gemm(const Params& p, const bf16_t* A, const bf16_t* Bt) {
  const int lane = TIDX & 63, wid = TIDX >> 6, r = lane & 31, h = lane >> 5;
  for (int tile = wid * gridDim.x + blockIdx.x; tile < 512; tile += 8 * gridDim.x) {
    const int row0 = MP + (tile >> 5) * 32, col0 = (tile & 31) * 32;
    const bf16_t* pa = A + (size_t)(row0 + r) * 1024 + 8 * h;
    const bf16_t* pb = Bt + (size_t)(col0 + r) * 1024 + 8 * h;
    f32x16 acc;
#pragma unroll
    for (int i = 0; i < 16; ++i) acc[i] = 0.f;
#pragma unroll 8
    for (int s = 0; s < 64; ++s) acc = MFMA32(*(const bf16x8*)(pa + 16 * s), *(const bf16x8*)(pb + 16 * s), acc);
    const int col = col0 + r;
#pragma unroll
    for (int i = 0; i < 16; ++i) {
      const size_t row = row0 + crow(i, h);
      if (MODE == 2) p.out[OUT_YP + row * 1024 + col] = p.in[1][(row - MP) * 1024 + col] + acc[i];
      else {
        bf16_t* mg = (bf16_t*)(p.ws + WS_MG) + row * 1024 + col;
        const float g = bf2f(((const bf16_t*)p.out)[row * 2048 + (MODE == 1 ? 1024 : 0) + col]);
        *mg = f2bf((MODE == 1 ? bf2f(*mg) : 0.f) + acc[i] * g);
      }
    }
  }
}

DI float tanh_fast(float x) { return 1.f - 2.f * __builtin_amdgcn_rcpf(1.f + __expf(2.f * x)); }
DI void phase_x(const Params& p) {
  const bf16_t* PB = (const bf16_t*)(p.ws + WS_PB);
  bf16_t* X = (bf16_t*)(p.ws + WS_X);
  const float* mu = p.in[8];
  for (int i = blockIdx.x * NT + TIDX; i < MT * 32; i += gridDim.x * NT) {
    const int row = i >> 5, g = i & 31;
    uint4 o = make_uint4(0u, 0u, 0u, 0u);
    if (g < 16) {
      const int col = 3072 + g * 8;
      const bool prompt = row < MP;
      const int t = prompt ? (row & 4095) : ((row - MP) & 15);
      const uint4 a = *(const uint4*)(PB + (size_t)row * CSH + col);
      float c[8] = {bflo(a.x), bfhi(a.x), bflo(a.y), bfhi(a.y), bflo(a.z), bfhi(a.z), bflo(a.w), bfhi(a.w)}, q[8];
      if (t != 0) { const uint4 b = *(const uint4*)(PB + (size_t)(row - 1) * CSH + col); q[0] = bflo(b.x); q[1] = bfhi(b.x); q[2] = bflo(b.y); q[3] = bfhi(b.y); q[4] = bflo(b.z); q[5] = bfhi(b.z); q[6] = bflo(b.w); q[7] = bfhi(b.w); }
      else if (prompt) {
#pragma unroll
        for (int j = 0; j < 8; ++j) q[j] = 0.f;
      } else { const float* s = p.in[4] + (size_t)((row - MP) >> 4) * CSH + col; const float4 b0 = *(const float4*)s, b1 = *(const float4*)(s + 4); q[0] = b0.x; q[1] = b0.y; q[2] = b0.z; q[3] = b0.w; q[4] = b1.x; q[5] = b1.y; q[6] = b1.z; q[7] = b1.w; }
      const float4 u0 = *(const float4*)(mu + col), u1 = *(const float4*)(mu + col + 4);
      const float u[8] = {u0.x, u0.y, u0.z, u0.w, u1.x, u1.y, u1.z, u1.w};
      float m[8];
#pragma unroll
      for (int j = 0; j < 8; ++j) { m[j] = c[j] + u[j] * (q[j] - c[j]); if (g < 8) m[j] = tanh_fast(m[j]); }
      o = make_uint4(cvtpk(m[0], m[1]), cvtpk(m[2], m[3]), cvtpk(m[4], m[5]), cvtpk(m[6], m[7]));
    }
    *(uint4*)(X + (size_t)row * 256 + g * 8) = o;
  }
}
struct EpiLora {
  static constexpr bool PERM = true, AFTER_DRAIN = false;
  Params p;
  DI void operator()(const pg8::f32x4 (&acc)[2][2][4][2], const pg8::Unit& u, int wr, int wc, int fr, int fq) const {
    const bool isw = u.pn < 4;
#pragma unroll
    for (int ai = 0; ai < 2; ++ai)
#pragma unroll
      for (int m = 0; m < 4; ++m) {
        const int row = u.pm * 256 + ai * 128 + wr * 64 + m * 16 + fr;
        const size_t hb = hm_base(row), hs = hm_hstride(row);
#pragma unroll
        for (int bj = 0; bj < 2; ++bj) {
          const int c = (u.pn & 3) * 256 + bj * 128 + wc * 32 + 8 * fq;
          const size_t idx = hb + (c >> 6) * hs + (c & 63);
          const f32x4 v0 = acc[ai][bj][m][0], v1 = acc[ai][bj][m][1];
          if (isw) {
            const f32x4 b0 = *(const f32x4*)(p.in[9] + c), b1 = *(const f32x4*)(p.in[9] + c + 4);
            f32x4 d0, d1;
#pragma unroll
            for (int j = 0; j < 4; ++j) {
              const float x0 = -(b0[j] + v0[j]), x1 = -(b1[j] + v1[j]);
              const float s0 = fmaxf(x0, 0.f) + __logf(1.f + __expf(-fabsf(x0))), s1 = fmaxf(x1, 0.f) + __logf(1.f + __expf(-fabsf(x1)));
              d0[j] = __expf(-__expf(-s0 - 0.5f)); d1[j] = __expf(-__expf(-s1 - 0.5f));
            }
            float* o = (float*)(p.ws + WS_SW) + idx; *(f32x4*)o = d0; *(f32x4*)(o + 4) = d1;
          } else {
            const f32x4 b0 = *(const f32x4*)(p.in[11] + c), b1 = *(const f32x4*)(p.in[11] + c + 4);
            f32x4 d0, d1;
#pragma unroll
            for (int j = 0; j < 4; ++j) { d0[j] = sigmoidf_(b0[j] + v0[j]); d1[j] = sigmoidf_(b1[j] + v1[j]); }
            *(uint4*)((bf16_t*)(p.ws + WS_SB) + idx) = pack8(d0, d1);
          }
        }
      }
  }
};
DI void small_lora(const Params& p) {
  const int lane = TIDX & 63, wid = TIDX >> 6, r = lane & 31, h = lane >> 5;
  const bf16_t* X = (const bf16_t*)(p.ws + WS_X); const bf16_t* BL = (const bf16_t*)(p.ws + WS_BTL);
  for (int tile = wid * gridDim.x + blockIdx.x; tile < 16 * 64; tile += 8 * gridDim.x) {
    const int row0 = MP + (tile >> 6) * 32, ct = tile & 63, col0 = ct * 32, k0 = ct < 32 ? 0 : 64;
    const bf16_t* pa = X + (size_t)(row0 + r) * 256 + k0 + 8 * h;
    const bf16_t* pb = BL + (size_t)(col0 + r) * 256 + k0 + 8 * h;
    f32x16 acc;
#pragma unroll
    for (int i = 0; i < 16; ++i) acc[i] = 0.f;
#pragma unroll
    for (int s = 0; s < 4; ++s) acc = MFMA32(*(const bf16x8*)(pa + 16 * s), *(const bf16x8*)(pb + 16 * s), acc);
    const int c = (col0 + r) & 1023;
    const float bias = ct < 32 ? p.in[9][c] : p.in[11][c];
#pragma unroll
    for (int i = 0; i < 16; ++i) {
      const int row = row0 + crow(i, h);
      const size_t idx = hm_base(row) + (c >> 6) * hm_hstride(row) + (c & 63);
      const float v = bias + acc[i];
      if (ct < 32) {
        const float x = -v, sp = fmaxf(x, 0.f) + __logf(1.f + __expf(-fabsf(x)));
        ((float*)(p.ws + WS_SW))[idx] = __expf(-__expf(-sp - 0.5f));
      } else ((bf16_t*)(p.ws + WS_SB))[idx] = f2bf(sigmoidf_(v));
    }
  }
}

DI void phase1c(const Params& p) {
  const int tid = TIDX & 255, half = TIDX >> 8, c = tid * 4, hh = c >> 6;
  const bf16_t* PB = (const bf16_t*)(p.ws + WS_PB);
  const float* mu = p.in[8];
  const float4 kkw = *(const float4*)(p.in[13] + c), kaw = *(const float4*)(p.in[14] + c), rkw = *(const float4*)(p.in[15] + c);
  const float4 mur = *(const float4*)(mu + c), muk = *(const float4*)(mu + 1024 + c), muv = *(const float4*)(mu + 2048 + c), muz = *(const float4*)(mu + 3200 + c);
  const float kka[4] = {kkw.x, kkw.y, kkw.z, kkw.w}, kaa[4] = {kaw.x, kaw.y, kaw.z, kaw.w}, rka[4] = {rkw.x, rkw.y, rkw.z, rkw.w};
  const float mura[4] = {mur.x, mur.y, mur.z, mur.w}, muka[4] = {muk.x, muk.y, muk.z, muk.w}, muva[4] = {muv.x, muv.y, muv.z, muv.w}, muza[4] = {muz.x, muz.y, muz.z, muz.w};
  bf16_t* SR = (bf16_t*)(p.ws + WS_SR); bf16_t* SK = (bf16_t*)(p.ws + WS_SK); bf16_t* SV = (bf16_t*)(p.ws + WS_SV);
  bf16_t* SKK = (bf16_t*)(p.ws + WS_SKK); bf16_t* SB = (bf16_t*)(p.ws + WS_SB); bf16_t* SZB = (bf16_t*)(p.ws + WS_SZB);
  float* BONUS = (float*)(p.ws + WS_BONUS);
  for (int r4 = blockIdx.x * 2 + half; r4 < MT / 4; r4 += gridDim.x * 2) {
    const int row0 = r4 * 4;
    const bool prompt = row0 < MP;
    const int t0 = prompt ? (row0 & 4095) : ((row0 - MP) & 15);
    uint2 gr[5], gk[5], gv[5], gz[5], ga[4];
#pragma unroll
    for (int t = 0; t < 5; ++t) {
      const int rr_ = (t == 0 && t0 == 0) ? row0 : row0 + t - 1;
      const bf16_t* pc = PB + (size_t)rr_ * CSH;
      gr[t] = *(const uint2*)(pc + c); gk[t] = *(const uint2*)(pc + 1024 + c); gv[t] = *(const uint2*)(pc + 2048 + c); gz[t] = *(const uint2*)(pc + 3200 + c);
    }
    size_t idx[4];
#pragma unroll
    for (int t = 0; t < 4; ++t) { idx[t] = hm_base(row0 + t) + hh * hm_hstride(row0 + t) + (c & 63); ga[t] = *(const uint2*)(SB + idx[t]); }
    float pr[4], pk[4], pv[4], pz[4];
    if (t0 == 0) {
      if (prompt) {
#pragma unroll
        for (int x = 0; x < 4; ++x) { pr[x] = 0.f; pk[x] = 0.f; pv[x] = 0.f; pz[x] = 0.f; }
      } else {
        const float* s = p.in[4] + (size_t)((row0 - MP) >> 4) * CSH;
        const float4 a = *(const float4*)(s + c), b = *(const float4*)(s + 1024 + c), d = *(const float4*)(s + 2048 + c), e = *(const float4*)(s + 3200 + c);
        pr[0] = a.x; pr[1] = a.y; pr[2] = a.z; pr[3] = a.w; pk[0] = b.x; pk[1] = b.y; pk[2] = b.z; pk[3] = b.w;
        pv[0] = d.x; pv[1] = d.y; pv[2] = d.z; pv[3] = d.w; pz[0] = e.x; pz[1] = e.y; pz[2] = e.z; pz[3] = e.w;
      }
    } else {
      pr[0] = bflo(gr[0].x); pr[1] = bfhi(gr[0].x); pr[2] = bflo(gr[0].y); pr[3] = bfhi(gr[0].y);
      pk[0] = bflo(gk[0].x); pk[1] = bfhi(gk[0].x); pk[2] = bflo(gk[0].y); pk[3] = bfhi(gk[0].y);
      pv[0] = bflo(gv[0].x); pv[1] = bfhi(gv[0].x); pv[2] = bflo(gv[0].y); pv[3] = bfhi(gv[0].y);
      pz[0] = bflo(gz[0].x); pz[1] = bfhi(gz[0].x); pz[2] = bflo(gz[0].y); pz[3] = bfhi(gz[0].y);
    }
#pragma unroll
    for (int t = 0; t < 4; ++t) {
      const int row = row0 + t;
      const float curr[4] = {bflo(gr[t + 1].x), bfhi(gr[t + 1].x), bflo(gr[t + 1].y), bfhi(gr[t + 1].y)}, curk[4] = {bflo(gk[t + 1].x), bfhi(gk[t + 1].x), bflo(gk[t + 1].y), bfhi(gk[t + 1].y)};
      const float curv[4] = {bflo(gv[t + 1].x), bfhi(gv[t + 1].x), bflo(gv[t + 1].y), bfhi(gv[t + 1].y)}, curz[4] = {bflo(gz[t + 1].x), bfhi(gz[t + 1].x), bflo(gz[t + 1].y), bfhi(gz[t + 1].y)};
      const float av[4] = {bflo(ga[t].x), bfhi(ga[t].x), bflo(ga[t].y), bfhi(ga[t].y)};
      float rm[4], km[4], vm[4], kkv[4], bb[4], kmod[4], szb[4];
      float ssq = 0.f, bon = 0.f;
#pragma unroll
      for (int x = 0; x < 4; ++x) {
        rm[x] = curr[x] + mura[x] * (pr[x] - curr[x]);
        km[x] = curk[x] + muka[x] * (pk[x] - curk[x]);
        vm[x] = curv[x] + muva[x] * (pv[x] - curv[x]);
        const float zm = curz[x] + muza[x] * (pz[x] - curz[x]);
        szb[x] = zm * sigmoidf_(zm);
        kkv[x] = km[x] * kka[x];
        ssq += kkv[x] * kkv[x];
        kmod[x] = km[x] * (1.f + (av[x] - 1.f) * kaa[x]);
        bon += rm[x] * kmod[x] * rka[x];
        pr[x] = curr[x]; pk[x] = curk[x]; pv[x] = curv[x]; pz[x] = curz[x];
      }
      ssq = sum16(ssq); bon = sum16(bon);
      const float inv = 1.f / fmaxf(sqrtf(ssq), 1e-12f);
#pragma unroll
      for (int x = 0; x < 4; ++x) { kkv[x] *= inv; bb[x] = kkv[x] * av[x]; }
      *(uint2*)(SR + idx[t]) = make_uint2(cvtpk(rm[0], rm[1]), cvtpk(rm[2], rm[3]));
      *(uint2*)(SK + idx[t]) = make_uint2(cvtpk(kmod[0], kmod[1]), cvtpk(kmod[2], kmod[3]));
      *(uint2*)(SV + idx[t]) = make_uint2(cvtpk(vm[0], vm[1]), cvtpk(vm[2], vm[3]));
      *(uint2*)(SKK + idx[t]) = make_uint2(cvtpk(-kkv[0], -kkv[1]), cvtpk(-kkv[2], -kkv[3]));
      *(uint2*)(SB + idx[t]) = make_uint2(cvtpk(bb[0], bb[1]), cvtpk(bb[2], bb[3]));
      *(uint2*)(SZB + (size_t)row * 1024 + c) = make_uint2(cvtpk(szb[0], szb[1]), cvtpk(szb[2], szb[3]));
      if ((tid & 15) == 0) BONUS[(size_t)row * 16 + hh] = bon;
    }
  }
}

template <bool SAMPLE>
DI void attn_wave(const Params& p, int sh, int qt) {
  const int lane = TIDX & 63, r = lane & 31, h = lane >> 5;
  const int hh = sh & 15, b = sh >> 4;
  bf16_t* QB = (bf16_t*)(p.ws + WS_QB);
  const int row0 = SAMPLE ? MP + b * 16 : b * 4096 + qt * 32;
  bf16_t* Qp = QB + (size_t)row0 * 1024 + hh * 64;
  const int qrow = SAMPLE ? (r < 15 ? r : 15) : r;
  bf16x8 qf[4];
#pragma unroll
  for (int s = 0; s < 4; ++s) qf[s] = *(const bf16x8*)(Qp + (size_t)qrow * 1024 + 16 * s + 8 * h);
  f32x16 z0, z1;
#pragma unroll
  for (int i = 0; i < 16; ++i) { z0[i] = 0.f; z1[i] = 0.f; }
  float carry = 1.f;
  const int ntiles = SAMPLE ? 33 : qt + 1;
  for (int it = 0; it < ntiles; ++it) {
    const bool diag = (it == 0);
    const int kt = SAMPLE ? 32 - it : qt - it;
    bf16x8 kf[4];
    {
      const float* Kp;
      if (!SAMPLE) Kp = p.out + OUT_KP + ((size_t)sh * 4096 + kt * 32 + r) * 64;
      else Kp = diag ? p.out + OUT_KS + ((size_t)sh * 16 + (r < 15 ? r : 15)) * 64 : p.in[2] + ((size_t)sh * 1024 + kt * 32 + r) * 64;
#pragma unroll
      for (int s = 0; s < 4; ++s) {
        const float4 a = *(const float4*)(Kp + 16 * s + 8 * h), bq = *(const float4*)(Kp + 16 * s + 8 * h + 4);
        u32x4 w; w[0] = cvtpk(a.x, a.y); w[1] = cvtpk(a.z, a.w); w[2] = cvtpk(bq.x, bq.y); w[3] = cvtpk(bq.z, bq.w);
        kf[s] = __builtin_bit_cast(bf16x8, w);
      }
    }
    f32x16 st;
#pragma unroll
    for (int i = 0; i < 16; ++i) st[i] = 0.f;
#pragma unroll
    for (int s = 0; s < 4; ++s) st = MFMA32(kf[s], qf[s], st);
    float keep[16], wgt[16];
#pragma unroll
    for (int i = 0; i < 16; ++i) {
      const float e = __builtin_amdgcn_exp2f(st[i]);
      const float kp = __builtin_amdgcn_rcpf(1.f + e);
      bool valid = true;
      if (diag) { const int kr = crow(i, h); valid = SAMPLE ? (kr < r && kr < 16) : (kr < r); }
      keep[i] = valid ? kp : 1.f;
      wgt[i] = valid ? 1.f - kp : 0.f;
    }
    float pp[4], hif[4];
#pragma unroll
    for (int g = 0; g < 4; ++g) {
      const float p4 = (keep[4 * g] * keep[4 * g + 1]) * (keep[4 * g + 2] * keep[4 * g + 3]);
      const auto sw = __builtin_amdgcn_permlane32_swap(__float_as_uint(p4), __float_as_uint(p4), false, false);
      const float lo = __uint_as_float(sw[0]), hi = __uint_as_float(sw[1]);
      pp[g] = lo * hi;
      hif[g] = h ? 1.f : hi;
    }
    float T[4];
    T[3] = carry; T[2] = T[3] * pp[3]; T[1] = T[2] * pp[2]; T[0] = T[1] * pp[1];
    carry = T[0] * pp[0];
#pragma unroll
    for (int g = 0; g < 4; ++g) {
      const float w3 = T[g] * hif[g], w2 = w3 * keep[4 * g + 3], w1 = w2 * keep[4 * g + 2], w0 = w1 * keep[4 * g + 1];
      wgt[4 * g + 3] *= w3; wgt[4 * g + 2] *= w2; wgt[4 * g + 1] *= w1; wgt[4 * g] *= w0;
    }
#pragma unroll
    for (int s = 0; s < 2; ++s) {
      u32x4 pw;
#pragma unroll
      for (int j = 0; j < 4; ++j) pw[j] = cvtpk(wgt[8 * s + 2 * j], wgt[8 * s + 2 * j + 1]);
      const bf16x8 pf = __builtin_bit_cast(bf16x8, pw);
#pragma unroll
      for (int db = 0; db < 2; ++db) {
        bf16x8 vf;
        {
          float vv[8];
#pragma unroll
          for (int j = 0; j < 8; ++j) {
            const int kr = 16 * s + 8 * (j >> 2) + 4 * h + (j & 3);
            const float* vp;
            if (!SAMPLE) vp = p.out + OUT_VP + ((size_t)sh * 4096 + kt * 32 + kr) * 64;
            else vp = diag ? p.out + OUT_VS + ((size_t)sh * 16 + (kr < 15 ? kr : 15)) * 64 : p.in[3] + ((size_t)sh * 1024 + kt * 32 + kr) * 64;
            vv[j] = vp[db * 32 + r];
          }
          u32x4 w; w[0] = cvtpk(vv[0], vv[1]); w[1] = cvtpk(vv[2], vv[3]); w[2] = cvtpk(vv[4], vv[5]); w[3] = cvtpk(vv[6], vv[7]);
          vf = __builtin_bit_cast(bf16x8, w);
        }
        if (db == 0) z0 = MFMA32(pf, vf, z0); else z1 = MFMA32(pf, vf, z1);
      }
    }
    if (__ballot(carry != 0.f) == 0ull) break;
  }
  const bf16_t* SZA = (const bf16_t*)(p.ws + WS_SZA);
#pragma unroll
  for (int i = 0; i < 16; ++i) {
    const int q = crow(i, h);
    if (SAMPLE && q >= 16) continue;
    const size_t o = (size_t)(row0 + q) * 1024 + hh * 64 + r;
    QB[o] = f2bf(z0[i] * bf2f(SZA[o]));
    QB[o + 32] = f2bf(z1[i] * bf2f(SZA[o + 32]));
  }
}

DI float row16_sum(float x) {
  x += dppf<0xB1>(x); x += dppf<0x4E>(x); x += dppf<0x124>(x); x += dppf<0x128>(x);
  return x;
}
DI void scan_wave(const Params& p, int shg, int slice, float* L) {
  const int lane = TIDX & 63, cc = lane & 15;
  const bool prompt = shg < 64;
  const int T = prompt ? 4096 : 16;
  const size_t base = prompt ? (size_t)shg * 4096 * 64 : (size_t)MP * 1024 + (size_t)(shg - 64) * 16 * 64;
  const int v = slice * 4 + (lane >> 4);
  const float* SW = (const float*)(p.ws + WS_SW) + base;
  const bf16_t* SARR = (const bf16_t*)(p.ws + WS_SR) + base;
  float* ORAW = (float*)(p.ws + WS_ORAW) + base;
  float4 S;
  float* wout;
  if (prompt) { S = make_float4(0.f, 0.f, 0.f, 0.f); wout = p.out + OUT_WP + ((size_t)shg * 64 + v) * 64 + 4 * cc; }
  else { S = *(const float4*)(p.in[5] + ((size_t)(shg - 64) * 64 + v) * 64 + 4 * cc); wout = p.out + OUT_WS + ((size_t)(shg - 64) * 64 + v) * 64 + 4 * cc; }
  const int nch = T / 8;
  const int dw0 = ((lane >> 4) * 6 + 2) * 64 + (lane & 15) * 4, dw1 = dw0 + 4 * 384;
  const int db = (lane >> 3) * 384 + (lane & 7) * 8;
  uint4 gw0, gw1, gr, gk, gv, gn, gb;
#define SCAN_GLOAD(ch) do { const float* w_ = SW + (size_t)(ch) * 512; gw0 = *(const uint4*)(w_ + lane * 4); gw1 = *(const uint4*)(w_ + 256 + lane * 4); \
    const bf16_t* a_ = SARR + (size_t)(ch) * 512 + lane * 8; gr = *(const uint4*)a_; gk = *(const uint4*)(a_ + SZ_ACT / 2); gv = *(const uint4*)(a_ + 2 * (SZ_ACT / 2)); \
    gn = *(const uint4*)(a_ + 3 * (SZ_ACT / 2)); gb = *(const uint4*)(a_ + 4 * (SZ_ACT / 2)); } while (0)
#define SCAN_PUT(slot, g) do { float* d_ = L + db + (slot) * 64; *(float4*)d_ = make_float4(bflo(g.x), bfhi(g.x), bflo(g.y), bfhi(g.y)); *(float4*)(d_ + 4) = make_float4(bflo(g.z), bfhi(g.z), bflo(g.w), bfhi(g.w)); } while (0)
#define SCAN_LSTORE() do { *(uint4*)(L + dw0) = gw0; *(uint4*)(L + dw1) = gw1; SCAN_PUT(4, gr); SCAN_PUT(3, gk); SCAN_PUT(5, gv); SCAN_PUT(0, gn); SCAN_PUT(1, gb); \
    asm volatile("s_waitcnt lgkmcnt(0)" ::: "memory"); } while (0)
  SCAN_GLOAD(0);
  asm volatile("s_waitcnt lgkmcnt(0)" ::: "memory");
  SCAN_LSTORE();
  for (int ch = 0; ch < nch; ++ch) {
    if (ch + 1 < nch) SCAN_GLOAD(ch + 1);
    float okeep = 0.f;
    const float* Lc = L + 4 * cc;
    float4 nk = *(const float4*)(Lc), bb = *(const float4*)(Lc + 64), ww = *(const float4*)(Lc + 128), kv = *(const float4*)(Lc + 192), rr = *(const float4*)(Lc + 256);
    float vt = L[320 + v];
#pragma unroll 4
    for (int st = 0; st < 8; ++st) {
      const int sn = ((st + 1) & 7) * 384;
      const float4 nk2 = *(const float4*)(Lc + sn), bb2 = *(const float4*)(Lc + sn + 64), ww2 = *(const float4*)(Lc + sn + 128);
      const float4 kv2 = *(const float4*)(Lc + sn + 192), rr2 = *(const float4*)(Lc + sn + 256);
      const float vt2 = L[sn + 320 + v];
      float d = (S.x * nk.x + S.y * nk.y) + (S.z * nk.z + S.w * nk.w);
      const float sa = row16_sum(d);
      S.x = S.x * ww.x + (sa * bb.x + vt * kv.x);
      S.y = S.y * ww.y + (sa * bb.y + vt * kv.y);
      S.z = S.z * ww.z + (sa * bb.z + vt * kv.z);
      S.w = S.w * ww.w + (sa * bb.w + vt * kv.w);
      float o = (S.x * rr.x + S.y * rr.y) + (S.z * rr.z + S.w * rr.w);
      o = row16_sum(o);
      okeep = (cc == st) ? o : okeep;
      nk = nk2; bb = bb2; ww = ww2; kv = kv2; rr = rr2; vt = vt2;
    }
    if (cc < 8) ORAW[(size_t)(ch * 8 + cc) * 64 + v] = okeep;
    asm volatile("s_waitcnt lgkmcnt(0)" ::: "memory");
    if (ch + 1 < nch) SCAN_LSTORE();
  }
  *(float4*)wout = S;
#undef SCAN_GLOAD
#undef SCAN_PUT
#undef SCAN_LSTORE
}

DI void sgroup_barrier(volatile LAS unsigned* cnt, unsigned target) {
  asm volatile("s_waitcnt lgkmcnt(0)" ::: "memory");
  if ((TIDX & 63) == 0) __hip_atomic_fetch_add((LAS unsigned*)cnt, 1u, __ATOMIC_RELAXED, __HIP_MEMORY_SCOPE_WORKGROUP);
  while (*cnt < target) __builtin_amdgcn_s_sleep(1);
  asm volatile("" ::: "memory");
}
DI void scan_group(const Params& p, int sh, int quarter, float* lds, volatile LAS unsigned* cnt, unsigned& nbar) {
  const int tid = TIDX & 255, lane = tid & 63, wid = tid >> 6, cc = lane & 15;
  const size_t base = (size_t)sh * 4096 * 64;
  const int v = quarter * 16 + wid * 4 + (lane >> 4);
  const float* SW = (const float*)(p.ws + WS_SW) + base;
  const bf16_t* SARR = (const bf16_t*)(p.ws + WS_SR) + base;
  float* ORAW = (float*)(p.ws + WS_ORAW) + base;
  f32x2 S01 = {0.f, 0.f}, S23 = {0.f, 0.f};
  const bool b0 = (lane & 1) != 0, b1 = (lane & 2) != 0;
  float4 gw0, gw1; uint4 gb0, gb1, gb2, gb3, gb4;
  const int dstw0 = ((tid >> 4) * 6 + 2) * 64 + (tid & 15) * 4, dstw1 = dstw0 + 16 * 384;
  const int dstb = (tid >> 3) * 384 + (tid & 7) * 8;
  const bf16_t* sbp = SARR + tid * 8;
#define SG_GLOAD(ch) do { const size_t o_ = (size_t)(ch) * 2048; gw0 = *(const float4*)(SW + o_ + tid * 4); gw1 = *(const float4*)(SW + o_ + 1024 + tid * 4); \
    gb0 = *(const uint4*)(sbp + o_); gb1 = *(const uint4*)(sbp + (SZ_ACT / 2) + o_); gb2 = *(const uint4*)(sbp + 2 * (SZ_ACT / 2) + o_); \
    gb3 = *(const uint4*)(sbp + 3 * (SZ_ACT / 2) + o_); gb4 = *(const uint4*)(sbp + 4 * (SZ_ACT / 2) + o_); } while (0)
#define SG_PUT(d_, g) do { *(float4*)(d_) = make_float4(bflo(g.x), bfhi(g.x), bflo(g.y), bfhi(g.y)); *(float4*)((d_) + 4) = make_float4(bflo(g.z), bfhi(g.z), bflo(g.w), bfhi(g.w)); } while (0)
#define SG_LSTORE(buf) do { float* L_ = lds + (buf) * (32 * 384); *(float4*)(L_ + dstw0) = gw0; *(float4*)(L_ + dstw1) = gw1; \
    SG_PUT(L_ + dstb + 4 * 64, gb0); SG_PUT(L_ + dstb + 3 * 64, gb1); SG_PUT(L_ + dstb + 5 * 64, gb2); SG_PUT(L_ + dstb + 0 * 64, gb3); SG_PUT(L_ + dstb + 1 * 64, gb4); } while (0)
  SG_GLOAD(0); SG_LSTORE(0); sgroup_barrier(cnt, 4u * (++nbar));
  for (int ch = 0; ch < 128; ++ch) {
    if (ch + 1 < 128) SG_GLOAD(ch + 1);
#pragma unroll 1
    for (int hlf = 0; hlf < 2; ++hlf) {
    const float* L = lds + (ch & 1) * (32 * 384) + hlf * (16 * 384);
    float okeep = 0.f;
    const float* Lc = L + 4 * cc;
    f32x4 nk = *(const f32x4*)(Lc), bb = *(const f32x4*)(Lc + 64), ww = *(const f32x4*)(Lc + 128), kv = *(const f32x4*)(Lc + 192), rr = *(const f32x4*)(Lc + 256);
    float vt = L[320 + v];
    f32x4 rrp = rr;
    float po[4];
#pragma unroll
    for (int st = 0; st <= 16; ++st) {
      if (st > 0) { const f32x2 o2 = S01 * rrp.xy + S23 * rrp.zw; po[(st - 1) & 3] = o2.x + o2.y; }
      if (st > 0 && (st & 3) == 0) {
        const float u0 = (b0 ? po[1] : po[0]) + dppf<0xB1>(b0 ? po[0] : po[1]);
        const float u1 = (b0 ? po[3] : po[2]) + dppf<0xB1>(b0 ? po[2] : po[3]);
        float w = (b1 ? u1 : u0) + dppf<0x4E>(b1 ? u0 : u1);
        w += dppf<0x124>(w); w += dppf<0x128>(w);
        okeep = ((cc >> 2) == (st >> 2) - 1) ? w : okeep;
      }
      if (st < 16) {
        const int sn = ((st + 1) & 15) * 384;
        const f32x2 d2 = S01 * nk.xy + S23 * nk.zw;
        float x = d2.x + d2.y;
        const f32x2 vt_2 = {vt, vt};
        const f32x2 t01 = vt_2 * kv.xy, t23 = vt_2 * kv.zw;
        __builtin_amdgcn_sched_barrier(0);
        x += dppf<0xB1>(x);
        const f32x4 nk2 = *(const f32x4*)(Lc + sn), bb2 = *(const f32x4*)(Lc + sn + 64);
        __builtin_amdgcn_sched_barrier(0);
        x += dppf<0x4E>(x);
        const f32x4 ww2 = *(const f32x4*)(Lc + sn + 128), kv2 = *(const f32x4*)(Lc + sn + 192);
        __builtin_amdgcn_sched_barrier(0);
        x += dppf<0x124>(x);
        const f32x4 rr2 = *(const f32x4*)(Lc + sn + 256);
        const float vt2 = L[sn + 320 + v];
        __builtin_amdgcn_sched_barrier(0);
        x += dppf<0x128>(x);
        __builtin_amdgcn_sched_barrier(0);
        const f32x2 sa2 = {x, x};
        S01 = S01 * ww.xy + (sa2 * bb.xy + t01);
        S23 = S23 * ww.zw + (sa2 * bb.zw + t23);
        rrp = rr;
        nk = nk2; bb = bb2; ww = ww2; kv = kv2; rr = rr2; vt = vt2;
      }
    }
    ORAW[(size_t)(ch * 32 + hlf * 16 + cc) * 64 + v] = okeep;
    }
    if (ch + 1 < 128) SG_LSTORE((ch + 1) & 1);
    sgroup_barrier(cnt, 4u * (++nbar));
  }
  *(float4*)(p.out + OUT_WP + ((size_t)sh * 64 + v) * 64 + 4 * cc) = make_float4(S01.x, S01.y, S23.x, S23.y);
#undef SG_GLOAD
#undef SG_PUT
#undef SG_LSTORE
}

constexpr int NQ_ATT_P = 8192, NQ_ATT_S = 512, NQ_SCAN_S = 8192, NQ_DYN = NQ_ATT_P + NQ_ATT_S + NQ_SCAN_S;
DI int wave_grab(unsigned* ctr) { int v = 0; if ((TIDX & 63) == 0) v = (int)atomicAdd(ctr, 1u); return __builtin_amdgcn_readfirstlane(v); }
DI void phase2(const Params& p, char* smem) {
  __shared__ unsigned s_cnt;
  unsigned* ctl = (unsigned*)(p.ws + WS_CTL);
  const int wid = TIDX >> 6;
  if (TIDX == 0) s_cnt = 0u;
  __syncthreads();
  float* Lsh = (float*)smem + 4 * (8 * 384);
  float* L = wid >= 4 ? (float*)smem + (wid - 4) * (8 * 384) : Lsh + wid * (8 * 384);
  if (wid < 4) {
    unsigned nbar = 0;
    __builtin_amdgcn_s_setprio(3);
    for (int bu = blockIdx.x; bu < 256; bu += gridDim.x) scan_group(p, bu >> 2, bu & 3, Lsh, (volatile LAS unsigned*)&s_cnt, nbar);
    __builtin_amdgcn_s_setprio(0);
  }
  for (;;) {
    int u = wave_grab(&ctl[0]);
    if (u >= NQ_DYN) break;
    if (u < NQ_ATT_P) { attn_wave<false>(p, u >> 7, u & 127); continue; }
    u -= NQ_ATT_P;
    if (u < NQ_ATT_S) { attn_wave<true>(p, u, 0); continue; }
    u -= NQ_ATT_S;
    scan_wave(p, 64 + (u >> 4), u & 15, L);
  }
}

DI void p2c_row(const Params& p, int row, int c, int hh, const float4& lg, const float4& lb, const float4& o, const uint2& vv, const uint2& zz, float bon) {
  const float mean = sum16((o.x + o.y) + (o.z + o.w)) * (1.f / 64.f);
  const float dx = o.x - mean, dy = o.y - mean, dz = o.z - mean, dw = o.w - mean;
  const float var = sum16((dx * dx + dy * dy) + (dz * dz + dw * dw)) * (1.f / 64.f);
  const float inv = rsqrtf(var + LNX_EPS);
  const float r0 = (dx * inv * lg.x + lb.x + bon * bflo(vv.x)) * bflo(zz.x);
  const float r1 = (dy * inv * lg.y + lb.y + bon * bfhi(vv.x)) * bfhi(zz.x);
  const float r2 = (dz * inv * lg.z + lb.z + bon * bflo(vv.y)) * bflo(zz.y);
  const float r3 = (dw * inv * lg.w + lb.w + bon * bfhi(vv.y)) * bfhi(zz.y);
  *(uint2*)((bf16_t*)(p.ws + WS_OB) + (size_t)row * 1024 + c) = make_uint2(cvtpk(r0, r1), cvtpk(r2, r3));
}
DI void phase2c(const Params& p) {
  const int tid = TIDX & 255, half = TIDX >> 8, c = tid * 4, hh = c >> 6;
  const float4 lg = *(const float4*)(p.in[16] + c), lb = *(const float4*)(p.in[17] + c);
  const float* ORAW = (const float*)(p.ws + WS_ORAW); const bf16_t* SV = (const bf16_t*)(p.ws + WS_SV);
  const bf16_t* SZB = (const bf16_t*)(p.ws + WS_SZB); const float* BONUS = (const float*)(p.ws + WS_BONUS);
  const int stride = gridDim.x * 2;
  for (int row = blockIdx.x * 2 + half; row < MT; row += 2 * stride) {
    const bool two = row + stride < MT;
    const int rowb = two ? row + stride : row;
    const size_t ia = hm_base(row) + hh * hm_hstride(row) + (c & 63), ib = hm_base(rowb) + hh * hm_hstride(rowb) + (c & 63);
    const float4 oa = *(const float4*)(ORAW + ia), ob = *(const float4*)(ORAW + ib);
    const uint2 va = *(const uint2*)(SV + ia), vb = *(const uint2*)(SV + ib);
    const uint2 za = *(const uint2*)(SZB + (size_t)row * 1024 + c), zb = *(const uint2*)(SZB + (size_t)rowb * 1024 + c);
    const float ba = BONUS[(size_t)row * 16 + hh], bb = BONUS[(size_t)rowb * 16 + hh];
    p2c_row(p, row, c, hh, lg, lb, oa, va, za, ba);
    if (two) p2c_row(p, rowb, c, hh, lg, lb, ob, vb, zb, bb);
  }
}

DI void phase4(const Params& p) {
  const int lane = TIDX & 63, wid = TIDX >> 6;
  const float* g = p.in[21];
  float4 gg[4];
#pragma unroll
  for (int i = 0; i < 4; ++i) gg[i] = *(const float4*)(g + i * 256 + lane * 4);
  const int stride = gridDim.x * 8;
  for (int row = blockIdx.x * 8 + wid; row < MT; row += 2 * stride) {
    const bool two = row + stride < MT;
    float* x0 = p.out + OUT_YP + (size_t)row * 1024;
    float* x1 = p.out + OUT_YP + (size_t)(two ? row + stride : row) * 1024;
    float4 v0[4], v1[4]; float s0 = 0.f, s1 = 0.f;
#pragma unroll
    for (int i = 0; i < 4; ++i) { v0[i] = *(const float4*)(x0 + i * 256 + lane * 4); v1[i] = *(const float4*)(x1 + i * 256 + lane * 4); }
#pragma unroll
    for (int i = 0; i < 4; ++i) {
      s0 += v0[i].x * v0[i].x + v0[i].y * v0[i].y + v0[i].z * v0[i].z + v0[i].w * v0[i].w;
      s1 += v1[i].x * v1[i].x + v1[i].y * v1[i].y + v1[i].z * v1[i].z + v1[i].w * v1[i].w;
    }
    s0 = wave_sum(s0); s1 = wave_sum(s1);
    const float i0 = rsqrtf(s0 * (1.f / DM) + EPS), i1 = rsqrtf(s1 * (1.f / DM) + EPS);
#pragma unroll
    for (int i = 0; i < 4; ++i) *(float4*)(x0 + i * 256 + lane * 4) = make_float4(v0[i].x * i0 * gg[i].x, v0[i].y * i0 * gg[i].y, v0[i].z * i0 * gg[i].z, v0[i].w * i0 * gg[i].w);
    if (two) {
#pragma unroll
      for (int i = 0; i < 4; ++i) *(float4*)(x1 + i * 256 + lane * 4) = make_float4(v1[i].x * i1 * gg[i].x, v1[i].y * i1 * gg[i].y, v1[i].z * i1 * gg[i].z, v1[i].w * i1 * gg[i].w);
    }
  }
}

#define XB_TMO      128
#define XB_XCNT(j)  (256  + 64 * (j))
#define XB_XSUB(j)  (1280 + 64 * (j))
#define XB_XGEN(j)  (2304 + 64 * (j))
#define XB_TOP      3328
#define XB_TOPGEN   3392
#define XCD_BAR_WORDS 3456
#define XB_SPIN_CAP (1u << 18)

__device__ __forceinline__ unsigned xb_ld(unsigned* p)              { return __hip_atomic_load(p, __ATOMIC_RELAXED, __HIP_MEMORY_SCOPE_AGENT); }
__device__ __forceinline__ unsigned xb_add(unsigned* p, unsigned v) { return __hip_atomic_fetch_add(p, v, __ATOMIC_RELAXED, __HIP_MEMORY_SCOPE_AGENT); }
__device__ __forceinline__ unsigned xb_xcc_id() { return (unsigned)__builtin_amdgcn_s_getreg((3 << 11) | 20) & 0xFu; }
#define XB_SPIN(cond, bar) do { unsigned _sp = 0; while (cond) { __builtin_amdgcn_s_sleep(1); \
    if ((++_sp & 255u) == 0u) { if (xb_ld(&(bar)[XB_TMO])) break; if (_sp > XB_SPIN_CAP) { atomicAdd(&(bar)[XB_TMO], 1u); break; } } } } while (0)

struct XcdBarrier {
    unsigned* bar; unsigned x;
    volatile LAS unsigned* st;
};

__device__ __forceinline__ XcdBarrier xcd_barrier_post(unsigned* bar, volatile LAS unsigned* st) {
    XcdBarrier b; b.bar = bar; b.x = xb_xcc_id(); b.st = st;
    if (TIDX == 0) (void)xb_add(&bar[XB_XCNT(b.x)], 1u);
    return b;
}
__device__ __forceinline__ void xcd_barrier_complete(unsigned* bar, unsigned x, unsigned& nloc, unsigned& nx) {
    const unsigned G = gridDim.x * gridDim.y * gridDim.z;
    unsigned sum, cnt, mine, sp = 0u;
    for (;;) {
        sum = 0u; cnt = 0u; mine = 0u;
#pragma unroll
        for (unsigned j = 0; j < 16; ++j) { const unsigned c = xb_ld(&bar[XB_XCNT(j)]); sum += c; cnt += (c > 0u) ? 1u : 0u; mine = (j == x) ? c : mine; }
        if (sum == G) break;
        __builtin_amdgcn_s_sleep(1);
        if ((++sp & 255u) == 0u) { if (xb_ld(&bar[XB_TMO])) break; if (sp > XB_SPIN_CAP) { atomicAdd(&bar[XB_TMO], 1u); break; } }
    }
    nloc = mine > 0u ? mine : 1u; nx = cnt > 0u ? cnt : 1u;
}

__device__ __forceinline__ void xcd_barrier(const XcdBarrier& b) {
    asm volatile("s_waitcnt vmcnt(0)" ::: "memory");
    __syncthreads();
    if (TIDX == 0) {
        unsigned* bar = b.bar;
        __builtin_amdgcn_s_waitcnt(0);
        unsigned nloc = b.st[0], nx = b.st[1];
        if (nloc == 0u) { xcd_barrier_complete(bar, b.x, nloc, nx); b.st[0] = nloc; b.st[1] = nx; }
        const unsigned old = xb_add(&bar[XB_XSUB(b.x)], 1u);
        const unsigned gen = old / nloc;
        if (old + 1u == (gen + 1u) * nloc) {
            __builtin_amdgcn_fence(__ATOMIC_RELEASE, "agent");
            asm volatile("s_waitcnt vmcnt(0)" ::: "memory");
            const unsigned og = xb_add(&bar[XB_TOP], 1u);
            const unsigned tg = og / nx;
            if (og + 1u == (tg + 1u) * nx) xb_add(&bar[XB_TOPGEN], 1u);
            else XB_SPIN(xb_ld(&bar[XB_TOPGEN]) == tg, bar);
            __builtin_amdgcn_fence(__ATOMIC_ACQUIRE, "agent");
            xb_add(&bar[XB_XGEN(b.x)], 1u);
            asm volatile("s_waitcnt vmcnt(0)" ::: "memory");
        } else {
            XB_SPIN(xb_ld(&bar[XB_XGEN(b.x)]) == gen, bar);
            __builtin_amdgcn_fence(__ATOMIC_ACQUIRE, "agent");
            asm volatile("s_waitcnt vmcnt(0)" ::: "memory");
        }
    }
    __syncthreads();
}

__global__ void __launch_bounds__(NT, 2) mega(Params p) {
  extern __shared__ __attribute__((aligned(16))) char smem[];
  cg::grid_group grid = cg::this_grid();
  if (blockIdx.x == 0) { unsigned* ctl = (unsigned*)(p.ws + WS_CTL); for (int i = TIDX; i < 16384; i += NT) ctl[i] = 0u; }
  grid.sync();
  __shared__ unsigned xb_st[2];
  if (TIDX == 0) { xb_st[0] = 0u; xb_st[1] = 0u; }
  __syncthreads();
  (void)xcd_barrier_post((unsigned*)(p.ws + WS_CTL) + 8192, (volatile LAS unsigned*)xb_st);
#define XBAR() do { XcdBarrier xb_; xb_.bar = (unsigned*)(p.ws + WS_CTL) + 8192; xb_.x = xb_xcc_id(); xb_.st = (volatile LAS unsigned*)xb_st; xcd_barrier(xb_); } while (0)
  phase0(p, smem);
  XBAR();
  { EpiP1 E; E.p = p; run_gemm(smem, (const bf16_t*)(p.ws + WS_H), (const bf16_t*)(p.ws + WS_WINT), MT, NINP, E); }
  XBAR();
  phase_x(p);
  XBAR();
  { EpiLora E; E.p = p; run_gemm(smem, (const bf16_t*)(p.ws + WS_X), (const bf16_t*)(p.ws + WS_BTL), MP, 2048, E, 256); }
  small_lora(p);
  XBAR();
  phase1c(p);
  XBAR();
  phase2(p, smem);
  XBAR();
  phase2c(p);
  XBAR();
  { EpiGate E; E.p = p; E.goff = 0; E.first = true; run_gemm(smem, (const bf16_t*)(p.ws + WS_QB), (const bf16_t*)(p.ws + WS_WT), MP, 1024, E); }
  small_gemm<0>(p, (const bf16_t*)(p.ws + WS_QB), (const bf16_t*)(p.ws + WS_WT));
  { EpiGate E; E.p = p; E.goff = 1024; E.first = false; run_gemm(smem, (const bf16_t*)(p.ws + WS_OB), (const bf16_t*)(p.ws + WS_WT) + (size_t)1024 * 1024, MP, 1024, E); }
  small_gemm<1>(p, (const bf16_t*)(p.ws + WS_OB), (const bf16_t*)(p.ws + WS_WT) + (size_t)1024 * 1024);
  XBAR();
  { EpiOut E; E.p = p; run_gemm(smem, (const bf16_t*)(p.ws + WS_MG), (const bf16_t*)(p.ws + WS_WT) + (size_t)2 * 1024 * 1024, MP, 1024, E); }
  small_gemm<2>(p, (const bf16_t*)(p.ws + WS_MG), (const bf16_t*)(p.ws + WS_WT) + (size_t)2 * 1024 * 1024);
  XBAR();
  phase4(p);
}

extern "C" void kernel_launch(void* const* d_in, const int* in_sizes, int n_in, void* d_out, int out_size, void* d_ws, size_t ws_size, hipStream_t stream) {
  static int grid_blocks = 0;
  if (grid_blocks == 0) {
    if (n_in != 22 || ws_size < WS_END) { fprintf(stderr, "kernel_launch: unexpected n_in %d / ws_size %zu (need %zu)\n", n_in, ws_size, (size_t)WS_END); grid_blocks = -1; return; }
    int dev = 0, cus = 0, per_cu = 0;
    (void)hipGetDevice(&dev);
    (void)hipDeviceGetAttribute(&cus, hipDeviceAttributeMultiprocessorCount, dev);
    (void)hipFuncSetAttribute((const void*)mega, hipFuncAttributeMaxDynamicSharedMemorySize, SMEM_BYTES);
    (void)hipOccupancyMaxActiveBlocksPerMultiprocessor(&per_cu, (const void*)mega, NT, SMEM_BYTES);
    (void)hipGetLastError();
    grid_blocks = cus;
  }
  if (grid_blocks < 0) return;
  Params p{};
  for (int i = 0; i < 22; ++i) p.in[i] = (const float*)d_in[i];
  p.out = (float*)d_out; p.ws = (unsigned char*)d_ws;
  void* args[] = {&p};
  hipError_t e = hipLaunchCooperativeKernel((const void*)mega, dim3(grid_blocks), dim3(NT), args, SMEM_BYTES, stream);
  if (e != hipSuccess) fprintf(stderr, "cooperative launch failed: %s (grid %d)\n", hipGetErrorString(e), grid_blocks);
}
```

```cpp
#include <hip/hip_runtime.h>
#include <hip/hip_cooperative_groups.h>
#include <cstdio>
#include <cstdint>
namespace cg = cooperative_groups;
__device__ __forceinline__ int lane_id_() { return (int)__builtin_amdgcn_mbcnt_hi(~0u, __builtin_amdgcn_mbcnt_lo(~0u, 0u)); }
#define TIDX (__builtin_amdgcn_readfirstlane((int)(threadIdx.x >> 6)) * 64 + lane_id_())

namespace pg8 {
#define PG8_LAS __attribute__((address_space(3)))
typedef unsigned short bf16_t;
typedef short bf16x8 __attribute__((ext_vector_type(8)));
typedef float f32x4 __attribute__((ext_vector_type(4)));
typedef unsigned u32x4 __attribute__((ext_vector_type(4)));
constexpr int BM = 256, BK = 64, HALF = 128, HTB = HALF * BK * 2  , STAGE_BYTES = 8 * HTB, NXCD = 8, WGM = 8;

__host__ __device__ __forceinline__ int lds_byte(int r, int c) { const int st = (r >> 4) * 2 + (c >> 5), rr = r & 15, cc = c & 31, ob = rr * 64 + cc * 2; return st * 1024 + (ob ^ (((ob >> 9) & 1) << 5)); }
__host__ __device__ __forceinline__ void stage_rc(int b, int& R, int& C) { const int st = b / 1024, sb = b % 1024, swz = sb ^ (((sb >> 9) & 1) << 5); R = (st >> 1) * 16 + swz / 64; C = (st & 1) * 32 + (swz % 64) / 2; }
__host__ __device__ __forceinline__ int perm32(int rho) { const int n = rho >> 4, i = rho & 15; return 8 * (i >> 2) + 4 * n + (i & 3); }

struct Unit { int pm, pn; };
struct Gemm { const bf16_t* A; const bf16_t* Bt; int M, N, K; };

struct StaticOrder {
    int nM, nN, nwg, G, c;
    __host__ __device__ void init(int M, int N, int G_, int c_) { nM = M / BM; nN = N / BM; nwg = nM * nN; G = G_; c = c_; }
    __host__ __device__ bool next(int i, Unit& u) const {
        const long L = (long)i * G + c; if (L >= nwg) return false;
        int wgid = (int)L; { const int q = nwg / NXCD, r = nwg % NXCD, xcd = wgid % NXCD, off = wgid / NXCD; wgid = (xcd < r ? xcd * (q + 1) : r * (q + 1) + (xcd - r) * q) + off; }
        const int nig = WGM * nN, gid = wgid / nig, fm = gid * WGM, gsz = (nM - fm) < WGM ? (nM - fm) : WGM;
        u.pm = fm + ((wgid % nig) % gsz); u.pn = (wgid % nig) / gsz; return true;
    }
    __device__ __forceinline__ void a_ready(const Unit&) const {}
    __device__ __forceinline__ void done(const Unit&) const {}
};


template <class Epi, class Sched, bool ALIGN_EPI = false, bool SP2 = false>
__device__ __forceinline__ void gemm_phase(PG8_LAS unsigned char* lds, const Gemm g, const Sched& S, const Epi& E) {
    int tid_ = TIDX; asm volatile("" : "+v"(tid_));
    const int tid = tid_, wid = __builtin_amdgcn_readfirstlane(tid >> 6), lane = tid & 63, wr = wid >> 2, wc = wid & 3, fr = lane & 15, fq = lane >> 4;
    const int K = g.K, nt = K / BK;
    unsigned voffA[2], voffB[2];
#pragma unroll
    for (int i = 0; i < 2; ++i) { int R, C; stage_rc(tid * 16 + i * 8192, R, C); const int Rb = Epi::PERM ? ((R & ~31) + perm32(R & 31)) : R;
        voffA[i] = (unsigned)(R * K + C) * 2u; voffB[i] = (unsigned)(Rb * K + C) * 2u; }
    const size_t kstep = (size_t)(BK * 2);
    const size_t hstep = (size_t)HALF * K * 2;
    const size_t tstep = 2 * hstep;
    const unsigned ldsw = (unsigned)wid * 1024u;
    const int aoff = lds_byte(wr * 64 + fr, fq * 8), boff = lds_byte(wc * 32 + fr, fq * 8);
#define PG8_SA(b, h) (((b) * 2 + (h)) * HTB)
#define PG8_SB(b, h) ((4 + (b) * 2 + (h)) * HTB)
#define PG8_STAGE(bufoff, gbase, voff) do { _Pragma("unroll") for (int _i = 0; _i < 2; ++_i) \
        __builtin_amdgcn_global_load_lds((const unsigned*)((const char*)(gbase) + (voff)[_i]), (PG8_LAS unsigned*)(lds + (bufoff) + ldsw + _i * 8192), 16, 0, 0); } while (0)
#define PG8_LDA(dst, b, h) do { _Pragma("unroll") for (int m = 0; m < 4; ++m) _Pragma("unroll") for (int k = 0; k < 2; ++k) dst[m][k] = *(const PG8_LAS bf16x8*)(lds + PG8_SA(b, h) + aoff + m * 2048 + k * 1024); } while (0)
#define PG8_LDB(dst, b, h) do { _Pragma("unroll") for (int n = 0; n < 2; ++n) _Pragma("unroll") for (int k = 0; k < 2; ++k) dst[n][k] = *(const PG8_LAS bf16x8*)(lds + PG8_SB(b, h) + boff + n * 2048 + k * 1024); } while (0)
#define PG8_MMA(ai, bj, At, Bt) do { __builtin_amdgcn_s_setprio(1); _Pragma("unroll") for (int m = 0; m < 4; ++m) _Pragma("unroll") for (int n = 0; n < 2; ++n) _Pragma("unroll") for (int k = 0; k < 2; ++k) \
        acc[ai][bj][m][n] = __builtin_amdgcn_mfma_f32_16x16x32_bf16(Bt[n][k], At[m][k], acc[ai][bj][m][n], 0, 0, 0); __builtin_amdgcn_s_setprio(0); } while (0)
#define PG8_WAIT_V(n) asm volatile("s_waitcnt vmcnt(" #n ")" ::: "memory")
#define PG8_WAIT_L(n) asm volatile("s_waitcnt lgkmcnt(" #n ")" ::: "memory")
#define PG8_BAR __builtin_amdgcn_s_barrier()
#define PG8_SCHED __builtin_amdgcn_sched_barrier(0)
    Unit cur, nxt; int ui = 0;
    if (!S.next(0, cur)) return;
    f32x4 acc[2][2][4][2];
#pragma unroll
    for (int a = 0; a < 2; ++a)
#pragma unroll
        for (int b = 0; b < 2; ++b)
#pragma unroll
            for (int m = 0; m < 4; ++m)
#pragma unroll
                for (int n = 0; n < 2; ++n) acc[a][b][m][n] = (f32x4){0.f, 0.f, 0.f, 0.f};
    bf16x8 At[4][2], B0[2][2], B1[2][2];
    const char* cA = (const char*)g.A + (size_t)cur.pm * tstep; const char* cB = (const char*)g.Bt + (size_t)cur.pn * tstep;
    S.a_ready(cur);
    if constexpr (SP2) {
        PG8_STAGE(PG8_SB(0, 0), cB, voffB); PG8_STAGE(PG8_SB(0, 1), cB + hstep, voffB); PG8_STAGE(PG8_SA(0, 0), cA, voffA); PG8_STAGE(PG8_SA(0, 1), cA + hstep, voffA);
        if (wr == 1) PG8_BAR;
        PG8_WAIT_V(2); PG8_BAR;
        PG8_STAGE(PG8_SB(1, 0), cB + kstep, voffB); PG8_STAGE(PG8_SA(1, 0), cA + kstep, voffA); PG8_STAGE(PG8_SB(1, 1), cB + hstep + kstep, voffB);
        PG8_WAIT_V(6); PG8_BAR;
    } else {
        PG8_STAGE(PG8_SB(0, 0), cB, voffB); PG8_STAGE(PG8_SA(0, 0), cA, voffA); PG8_STAGE(PG8_SB(0, 1), cB + hstep, voffB); PG8_STAGE(PG8_SA(0, 1), cA + hstep, voffA);
        if (wr == 1) PG8_BAR;
        PG8_WAIT_V(4); PG8_BAR;
        PG8_STAGE(PG8_SB(1, 0), cB + kstep, voffB); PG8_STAGE(PG8_SA(1, 0), cA + kstep, voffA); PG8_STAGE(PG8_SB(1, 1), cB + hstep + kstep, voffB);
        PG8_WAIT_V(6); PG8_BAR;
    }
    for (;;) {
        const bool has_next = S.next(ui + 1, nxt);
        const char* nA = has_next ? (const char*)g.A + (size_t)nxt.pm * tstep : cA; const char* nB = has_next ? (const char*)g.Bt + (size_t)nxt.pn * tstep : cB;
        for (int t = 0; t < nt; t += 2) {
            const bool last = (t == nt - 2);
            const char* a1 = cA + (size_t)(t + 1) * kstep;
            const char* a2 = last ? nA : cA + (size_t)(t + 2) * kstep; const char* b2 = last ? nB : cB + (size_t)(t + 2) * kstep;
            const char* a3 = a2 + kstep; const char* b3 = b2 + kstep;
            if (last && has_next) S.a_ready(nxt);
            if constexpr (SP2) {
            PG8_LDB(B0, 0, 0); PG8_LDB(B1, 0, 1); PG8_SCHED; PG8_LDA(At, 0, 0); PG8_STAGE(PG8_SA(1, 1), a1 + hstep, voffA);
            PG8_WAIT_V(8); PG8_WAIT_L(0); PG8_BAR; PG8_MMA(0, 0, At, B0); PG8_MMA(0, 1, At, B1); PG8_BAR; PG8_SCHED;
            PG8_LDA(At, 0, 1); PG8_STAGE(PG8_SB(0, 0), b2, voffB); PG8_STAGE(PG8_SB(0, 1), b2 + hstep, voffB); PG8_STAGE(PG8_SA(0, 0), a2, voffA);
            PG8_WAIT_V(8); PG8_WAIT_L(0); PG8_BAR; PG8_MMA(1, 0, At, B0); PG8_MMA(1, 1, At, B1); PG8_BAR; PG8_SCHED;
            PG8_LDB(B0, 1, 0); PG8_LDB(B1, 1, 1); PG8_SCHED; PG8_LDA(At, 1, 0); PG8_STAGE(PG8_SA(0, 1), a2 + hstep, voffA);
            PG8_WAIT_V(8); PG8_WAIT_L(0); PG8_BAR; PG8_MMA(0, 0, At, B0); PG8_MMA(0, 1, At, B1); PG8_BAR; PG8_SCHED;
            PG8_LDA(At, 1, 1); PG8_STAGE(PG8_SB(1, 0), b3, voffB); PG8_STAGE(PG8_SB(1, 1), b3 + hstep, voffB); PG8_STAGE(PG8_SA(1, 0), a3, voffA);
            PG8_WAIT_V(8); PG8_WAIT_L(0); PG8_BAR; PG8_MMA(1, 0, At, B0); PG8_MMA(1, 1, At, B1); PG8_BAR; PG8_SCHED;
            } else {
            PG8_LDB(B0, 0, 0); PG8_SCHED; PG8_LDA(At, 0, 0); PG8_STAGE(PG8_SA(1, 1), a1 + hstep, voffA);
            PG8_WAIT_L(8); PG8_BAR; PG8_WAIT_L(0); PG8_MMA(0, 0, At, B0); PG8_BAR; PG8_SCHED;
            PG8_LDB(B1, 0, 1); PG8_STAGE(PG8_SB(0, 0), b2, voffB);
            PG8_BAR; PG8_WAIT_L(0); PG8_MMA(0, 1, At, B1); PG8_BAR;
            PG8_LDA(At, 0, 1); PG8_STAGE(PG8_SA(0, 0), a2, voffA);
            PG8_BAR; PG8_WAIT_L(0); PG8_MMA(1, 0, At, B0); PG8_BAR; PG8_SCHED;
            PG8_STAGE(PG8_SB(0, 1), b2 + hstep, voffB);
            PG8_WAIT_V(6); PG8_BAR; PG8_MMA(1, 1, At, B1); PG8_BAR;
            PG8_LDB(B0, 1, 0); PG8_SCHED; PG8_LDA(At, 1, 0); PG8_STAGE(PG8_SA(0, 1), a2 + hstep, voffA);
            PG8_WAIT_L(8); PG8_BAR; PG8_WAIT_L(0); PG8_MMA(0, 0, At, B0); PG8_BAR; PG8_SCHED;
            PG8_LDB(B1, 1, 1); PG8_STAGE(PG8_SB(1, 0), b3, voffB);
            PG8_BAR; PG8_WAIT_L(0); PG8_MMA(0, 1, At, B1); PG8_BAR;
            PG8_LDA(At, 1, 1); PG8_STAGE(PG8_SA(1, 0), a3, voffA);
            PG8_BAR; PG8_WAIT_L(0); PG8_MMA(1, 0, At, B0); PG8_BAR; PG8_SCHED;
            PG8_STAGE(PG8_SB(1, 1), b3 + hstep, voffB);
            PG8_WAIT_V(6); PG8_BAR; PG8_MMA(1, 1, At, B1); PG8_BAR;
            }
        }
        if constexpr (ALIGN_EPI) { if (wr == 0) PG8_BAR; }
        if constexpr (!Epi::AFTER_DRAIN) { E(acc, cur, wr, wc, fr, fq); S.done(cur); }
        if (!has_next) break;
#pragma unroll
        for (int a = 0; a < 2; ++a)
#pragma unroll
            for (int b = 0; b < 2; ++b)
#pragma unroll
                for (int m = 0; m < 4; ++m)
#pragma unroll
                    for (int n = 0; n < 2; ++n) acc[a][b][m][n] = (f32x4){0.f, 0.f, 0.f, 0.f};
        cur = nxt; cA = nA; cB = nB; ++ui;
        if constexpr (ALIGN_EPI) { if (wr == 1) PG8_BAR; }
    }
    PG8_WAIT_V(0);
    if constexpr (!ALIGN_EPI) { if (wr == 0) PG8_BAR; }
    PG8_BAR;
    if constexpr (Epi::AFTER_DRAIN) { E.fused(acc, cur, wr, wc, fr, fq, lds, wid, lane); S.done(cur); }
#undef PG8_SA
#undef PG8_SB
#undef PG8_STAGE
#undef PG8_LDA
#undef PG8_LDB
#undef PG8_MMA
#undef PG8_WAIT_V
#undef PG8_WAIT_L
#undef PG8_BAR
#undef PG8_SCHED
}
}


#define DI __device__ __forceinline__
typedef unsigned short bf16_t;
typedef short bf16x8 __attribute__((ext_vector_type(8)));
typedef float f32x4 __attribute__((ext_vector_type(4)));
typedef float f32x2 __attribute__((ext_vector_type(2)));
typedef float f32x16 __attribute__((ext_vector_type(16)));
typedef unsigned u32x4 __attribute__((ext_vector_type(4)));
#define MFMA32(a, b, c) __builtin_amdgcn_mfma_f32_32x32x16_bf16((a), (b), (c), 0, 0, 0)
#define LAS __attribute__((address_space(3)))

constexpr int NT = 512;
constexpr int DM = 1024, MP = 16384, MT = 16896;
constexpr int NIN = 10368, NINP = 10496, CSH = 4224;
constexpr float EPS = 1e-6f, LNX_EPS = 64e-5f;
constexpr float QSCALE = 0.18033688011112042f;

constexpr size_t OUT_YP = 0, OUT_KP = 17301504, OUT_VP = 34078720, OUT_SHP = 50855936, OUT_WP = 50872832,
                 OUT_KS = 51134976, OUT_VS = 51659264, OUT_SHS = 52183552, OUT_WS = 52318720;

constexpr size_t SZ_ACT = (size_t)MT * 1024 * 2;
constexpr size_t WS_R1 = 0;
constexpr size_t WS_H = WS_R1, WS_WINT = WS_R1 + SZ_ACT, WS_SW = WS_R1;
constexpr size_t WS_R2 = (size_t)MT * 1024 * 4;
constexpr size_t WS_PB = WS_R2, WS_ORAW = WS_R2, WS_OB = WS_ORAW + (size_t)MT * 1024 * 4, WS_MG = WS_OB + SZ_ACT;
constexpr size_t WS_R3 = WS_R2 + (size_t)MT * CSH * 2;
constexpr size_t WS_QB = WS_R3, WS_X = WS_QB + SZ_ACT  , WS_BTL = WS_X + (size_t)MT * 256 * 2  , WS_SZA = WS_X + (size_t)MP * 1024 * 2;
static_assert(WS_BTL + (size_t)2048 * 256 * 2 <= WS_SZA, "LoRA buffers");
constexpr size_t WS_SR = WS_SZA + SZ_ACT, WS_SK = WS_SR + SZ_ACT, WS_SV = WS_SK + SZ_ACT, WS_SKK = WS_SV + SZ_ACT, WS_SB = WS_SKK + SZ_ACT;
constexpr size_t WS_SZB = WS_SB + SZ_ACT;
constexpr size_t WS_BONUS = WS_SZB + SZ_ACT;
constexpr size_t WS_WT = WS_BONUS + (size_t)MT * 16 * 4;
constexpr size_t WS_CTL = WS_WT + 3 * (size_t)1024 * 1024 * 2;
constexpr size_t WS_END = WS_CTL + 65536;
static_assert(WS_MG + SZ_ACT <= WS_R3, "R2 overflow");
static_assert(WS_WINT + (size_t)NINP * 1024 * 2 <= WS_R2, "R1 overflow");
static_assert(WS_END <= (size_t)512 * 1024 * 1024, "workspace");

constexpr int SMEM_BYTES = 147456;

struct Params { const float* in[22]; float* out; unsigned char* ws; };

DI float bf2f(bf16_t u) { return __uint_as_float((unsigned)u << 16); }
DI unsigned cvtpk(float lo, float hi) { unsigned r; asm volatile("v_cvt_pk_bf16_f32 %0, %1, %2" : "=v"(r) : "v"(lo), "v"(hi)); return r; }
DI bf16_t f2bf(float x) { return (bf16_t)(cvtpk(x, 0.f) & 0xffffu); }
DI float bflo(unsigned u) { return __uint_as_float(u << 16); }
DI float bfhi(unsigned u) { return __uint_as_float(u & 0xffff0000u); }
DI int crow(int i, int h) { return (i & 3) + 8 * (i >> 2) + 4 * h; }
DI float sigmoidf_(float x) { return fminf(__builtin_amdgcn_rcpf(1.f + __expf(-x)), 1.f); }
DI uint4 pack8(f32x4 a, f32x4 b) { return make_uint4(cvtpk(a[0], a[1]), cvtpk(a[2], a[3]), cvtpk(b[0], b[1]), cvtpk(b[2], b[3])); }
template <int CTRL> DI float dppf(float x) { return __builtin_bit_cast(float, __builtin_amdgcn_mov_dpp(__builtin_bit_cast(int, x), CTRL, 0xf, 0xf, true)); }
DI float sum16(float x) { x += dppf<0xB1>(x); x += dppf<0x4E>(x); x += dppf<0x124>(x); x += dppf<0x128>(x); return x; }
DI float wave_sum(float x) {
  x = sum16(x);
  const auto s = __builtin_amdgcn_permlane16_swap(__float_as_uint(x), __float_as_uint(x), false, false);
  x = __uint_as_float(s[0]) + __uint_as_float(s[1]);
  const auto t = __builtin_amdgcn_permlane32_swap(__float_as_uint(x), __float_as_uint(x), false, false);
  return __uint_as_float(t[0]) + __uint_as_float(t[1]);
}
DI float row32_sum(float x) {
  x += dppf<0xB1>(x);
  x += dppf<0x4E>(x);
  x += dppf<0x124>(x);
  x += dppf<0x128>(x);
  const auto s = __builtin_amdgcn_permlane16_swap(__float_as_uint(x), __float_as_uint(x), false, false);
  return __uint_as_float(s[0]) + __uint_as_float(s[1]);
}
DI size_t hm_base(int row) {
  if (row < MP) { const int b = row >> 12, t = row & 4095; return ((size_t)(b * 16) * 4096 + t) * 64; }
  const int rs = row - MP, b = rs >> 4, t = rs & 15; return (size_t)MP * 1024 + ((size_t)(b * 16) * 16 + t) * 64;
}
DI size_t hm_hstride(int row) { return row < MP ? (size_t)4096 * 64 : (size_t)16 * 64; }

DI void p0_rmsnorm_rows(const Params& p, int item) {
  const int lane = TIDX & 63, wid = TIDX >> 6;
  const int row = item * 8 + wid;
  const float* x = row < MP ? p.in[0] + (size_t)row * DM : p.in[1] + (size_t)(row - MP) * DM;
  const float* g = p.in[6];
  float4 v[4]; float ss = 0.f;
#pragma unroll
  for (int i = 0; i < 4; ++i) { v[i] = *(const float4*)(x + i * 256 + lane * 4); ss += v[i].x * v[i].x + v[i].y * v[i].y + v[i].z * v[i].z + v[i].w * v[i].w; }
  ss = wave_sum(ss);
  const float inv = rsqrtf(ss * (1.f / DM) + EPS);
  bf16_t* H = (bf16_t*)(p.ws + WS_H) + (size_t)row * DM;
#pragma unroll
  for (int i = 0; i < 4; ++i) {
    const float4 gg = *(const float4*)(g + i * 256 + lane * 4);
    uint2 o; o.x = cvtpk(v[i].x * inv * gg.x, v[i].y * inv * gg.y); o.y = cvtpk(v[i].z * inv * gg.z, v[i].w * inv * gg.w);
    *(uint2*)(H + i * 256 + lane * 4) = o;
  }
}
DI void p0_transpose_tile(const float* src, bf16_t* dst, int N, int kt, int nt, float* lds) {
  const int tid = TIDX & 255;
  const int k0 = kt * 64, n0 = nt * 64;
#pragma unroll
  for (int i = 0; i < 4; ++i) {
    const int row = (tid >> 4) + 16 * i, c4 = (tid & 15) * 4;
    const float4 v = *(const float4*)(src + (size_t)(k0 + row) * N + n0 + c4);
    lds[row * 65 + c4 + 0] = v.x; lds[row * 65 + c4 + 1] = v.y; lds[row * 65 + c4 + 2] = v.z; lds[row * 65 + c4 + 3] = v.w;
  }
  __syncthreads();
  const int n = tid >> 2, kc = (tid & 3) * 16;
  unsigned w[8];
#pragma unroll
  for (int j = 0; j < 8; ++j) w[j] = cvtpk(lds[(kc + 2 * j) * 65 + n], lds[(kc + 2 * j + 1) * 65 + n]);
  uint4* d = (uint4*)(dst + (size_t)(n0 + n) * 1024 + k0 + kc);
  d[0] = make_uint4(w[0], w[1], w[2], w[3]); d[1] = make_uint4(w[4], w[5], w[6], w[7]);
  __syncthreads();
}
DI void phase0(const Params& p, char* smem) {
  {
    bf16_t* BL = (bf16_t*)(p.ws + WS_BTL);
    for (int i = blockIdx.x * NT + TIDX; i < 2048 * 256; i += gridDim.x * NT) {
      const int n = i >> 8, k = i & 255;
      float v = 0.f;
      if (n < 1024) { if (k < 64) v = p.in[10][(size_t)k * 1024 + n]; }
      else if (k >= 64 && k < 128) v = p.in[12][(size_t)(k - 64) * 1024 + (n - 1024)];
      BL[i] = f2bf(v);
    }
  }
  constexpr int N_ROWS = MT / 8, N_TIN = 16 * 162 / 2, N_TSQ = 256 / 2;
  constexpr int N_ITEMS = N_ROWS + N_TIN + 3 * N_TSQ;
  const int half = TIDX >> 8;
  float* scr = (float*)smem + half * (64 * 65);
  for (int it = blockIdx.x; it < N_ITEMS; it += gridDim.x) {
    if (it < N_ROWS) { p0_rmsnorm_rows(p, it); continue; }
    int j = it - N_ROWS;
    if (j < N_TIN) { const int t = 2 * j + half; p0_transpose_tile(p.in[7], (bf16_t*)(p.ws + WS_WINT), NIN, t / 162, t % 162, scr); continue; }
    j -= N_TIN;
    const int w = j / N_TSQ; const int t = 2 * (j % N_TSQ) + half;
    p0_transpose_tile(p.in[18 + w], (bf16_t*)(p.ws + WS_WT) + (size_t)w * 1024 * 1024, 1024, t >> 4, t & 15, scr);
  }
}

struct EpiP1 {
  static constexpr bool PERM = true, AFTER_DRAIN = false;
  Params p;
  DI void operator()(const pg8::f32x4 (&acc)[2][2][4][2], const pg8::Unit& u, int wr, int wc, int fr, int fq) const {
    const int colt = u.pn * 256;
    const int region = colt >> 10;
#pragma unroll
    for (int ai = 0; ai < 2; ++ai)
#pragma unroll
      for (int m = 0; m < 4; ++m) {
        const int row = u.pm * 256 + ai * 128 + wr * 64 + m * 16 + fr;
        const bool prompt = row < MP;
        const int rs = row - MP;
#pragma unroll
        for (int bj = 0; bj < 2; ++bj) {
          const int col = colt + bj * 128 + wc * 32 + 8 * fq;
          const f32x4 v0 = acc[ai][bj][m][0], v1 = acc[ai][bj][m][1];
          if (region >= 6) {
            const int pc = col - 6144;
            if (pc < CSH) {
              *(uint4*)((bf16_t*)(p.ws + WS_PB) + (size_t)row * CSH + pc) = pack8(v0, v1);
              float* so = nullptr;
              if (prompt) { if ((row & 4095) == 4095) so = p.out + OUT_SHP + (size_t)(row >> 12) * CSH + pc; }
              else if ((rs & 15) == 15) so = p.out + OUT_SHS + (size_t)(rs >> 4) * CSH + pc;
              if (so) { *(f32x4*)so = v0; *(f32x4*)(so + 4) = v1; }
            }
          } else if (region == 0) {
            *(uint4*)((bf16_t*)(p.ws + WS_QB) + (size_t)row * 1024 + col) = pack8(v0 * QSCALE, v1 * QSCALE);
          } else if (region == 1) {
            const int c = col - 1024, hh = c >> 6, d = c & 63;
            float* o = prompt ? p.out + OUT_KP + (((size_t)(row >> 12) * 16 + hh) * 4096 + (row & 4095)) * 64 + d
                              : p.out + OUT_KS + (((size_t)(rs >> 4) * 16 + hh) * 16 + (rs & 15)) * 64 + d;
            __builtin_nontemporal_store(v0, (f32x4*)o); __builtin_nontemporal_store(v1, (f32x4*)(o + 4));
          } else if (region == 2) {
            const int c = col - 2048, hh = c >> 6, d = c & 63;
            float* o = prompt ? p.out + OUT_VP + (((size_t)(row >> 12) * 16 + hh) * 4096 + (row & 4095)) * 64 + d
                              : p.out + OUT_VS + (((size_t)(rs >> 4) * 16 + hh) * 16 + (rs & 15)) * 64 + d;
            __builtin_nontemporal_store(v0, (f32x4*)o); __builtin_nontemporal_store(v1, (f32x4*)(o + 4));
          } else if (region == 3) {
            f32x4 a, b;
#pragma unroll
            for (int j = 0; j < 4; ++j) { a[j] = v0[j] * sigmoidf_(v0[j]); b[j] = v1[j] * sigmoidf_(v1[j]); }
            *(uint4*)((bf16_t*)(p.ws + WS_SZA) + (size_t)row * 1024 + (col - 3072)) = pack8(a, b);
          } else {
            f32x4 a, b;
#pragma unroll
            for (int j = 0; j < 4; ++j) { a[j] = sigmoidf_(v0[j]); b[j] = sigmoidf_(v1[j]); }
            *(uint4*)((bf16_t*)p.out + (size_t)row * 2048 + (col - 4096)) = pack8(a, b);
          }
        }
      }
  }
};
struct EpiGate {
  static constexpr bool PERM = true, AFTER_DRAIN = false;
  Params p; int goff; bool first;
  DI void operator()(const pg8::f32x4 (&acc)[2][2][4][2], const pg8::Unit& u, int wr, int wc, int fr, int fq) const {
    const bf16_t* G = (const bf16_t*)p.out; bf16_t* MG = (bf16_t*)(p.ws + WS_MG);
#pragma unroll
    for (int ai = 0; ai < 2; ++ai)
#pragma unroll
      for (int m = 0; m < 4; ++m) {
        const size_t row = u.pm * 256 + ai * 128 + wr * 64 + m * 16 + fr;
#pragma unroll
        for (int bj = 0; bj < 2; ++bj) {
          const int col = u.pn * 256 + bj * 128 + wc * 32 + 8 * fq;
          const uint4 g = *(const uint4*)(G + row * 2048 + goff + col);
          f32x4 a = acc[ai][bj][m][0], b = acc[ai][bj][m][1];
          a[0] *= bflo(g.x); a[1] *= bfhi(g.x); a[2] *= bflo(g.y); a[3] *= bfhi(g.y);
          b[0] *= bflo(g.z); b[1] *= bfhi(g.z); b[2] *= bflo(g.w); b[3] *= bfhi(g.w);
          if (!first) {
            const uint4 o = *(const uint4*)(MG + row * 1024 + col);
            a[0] += bflo(o.x); a[1] += bfhi(o.x); a[2] += bflo(o.y); a[3] += bfhi(o.y);
            b[0] += bflo(o.z); b[1] += bfhi(o.z); b[2] += bflo(o.w); b[3] += bfhi(o.w);
          }
          *(uint4*)(MG + row * 1024 + col) = pack8(a, b);
        }
      }
  }
};
struct EpiOut {
  static constexpr bool PERM = true, AFTER_DRAIN = false;
  Params p;
  DI void operator()(const pg8::f32x4 (&acc)[2][2][4][2], const pg8::Unit& u, int wr, int wc, int fr, int fq) const {
#pragma unroll
    for (int ai = 0; ai < 2; ++ai)
#pragma unroll
      for (int m = 0; m < 4; ++m) {
        const int row = u.pm * 256 + ai * 128 + wr * 64 + m * 16 + fr;
        const float* xr = row < MP ? p.in[0] + (size_t)row * 1024 : p.in[1] + (size_t)(row - MP) * 1024;
        float* orow = p.out + OUT_YP + (size_t)row * 1024;
#pragma unroll
        for (int bj = 0; bj < 2; ++bj) {
          const int col = u.pn * 256 + bj * 128 + wc * 32 + 8 * fq;
          const f32x4 x0 = *(const f32x4*)(xr + col), x1 = *(const f32x4*)(xr + col + 4);
          *(f32x4*)(orow + col) = x0 + acc[ai][bj][m][0]; *(f32x4*)(orow + col + 4) = x1 + acc[ai][bj][m][1];
        }
      }
  }
};
template <class Epi>
DI void run_gemm(char* smem, const bf16_t* A, const bf16_t* Bt, int M, int N, const Epi& E, int K = 1024) {
  pg8::Gemm g; g.A = A; g.Bt = Bt; g.M = M; g.N = N; g.K = K;
  pg8::StaticOrder S; S.init(M, N, (int)gridDim.x, (int)blockIdx.x);
  pg8::gemm_phase<Epi, pg8::StaticOrder, true, true>((LAS unsigned char*)smem, g, S, E);
  __syncthreads();
}

template <int MODE>
DI void small_gemm(const Params& p, const bf16_t* A, const bf16_t* Bt) {
  int t_ = TIDX; asm volatile("" : "+v"(t_));
  const int lane = t_ & 63, wid = __builtin_amdgcn_readfirstlane(t_ >> 6), fr = lane & 15, fq = lane >> 4;
  for (int tile = wid * gridDim.x + blockIdx.x; tile < 2048; tile += 8 * gridDim.x) {
    const int row0 = MP + (tile >> 6) * 16, col0 = (tile & 63) * 16;
    const bf16_t* pa = A + (size_t)(row0 + fr) * 1024 + 8 * fq;
    const bf16_t* pb = Bt + (size_t)(col0 + fr) * 1024 + 8 * fq;
    f32x4 acc = {0.f, 0.f, 0.f, 0.f};
#pragma unroll 8
    for (int s = 0; s < 32; ++s) acc = __builtin_amdgcn_mfma_f32_16x16x32_bf16(*(const bf16x8*)(pa + 32 * s), *(const bf16x8*)(pb + 32 * s), acc, 0, 0, 0);
    const int col = col0 + fr;
#pragma unroll
    for (int j = 0; j < 4; ++j) {
      const size_t row = row0 + 4 * fq + j;
      if (MODE == 2) p.out[OUT_YP + row * 1024 + col] = p.in[1][(row - MP) * 1024 + col] + acc[j];
      else {
        bf16_t* mg = (bf16_t*)(p.ws + WS_MG) + row * 1024 + col;
        const float g = bf2f(((const bf16_t*)p.out)[row * 2048 + (MODE == 1 ? 1024 : 0) + col]);
        *mg = f2bf((MODE == 1 ? bf2f(*mg) : 0.f) + acc[j] * g);
      }
    }
  }
}

DI float tanh_fast(float x) { return 1.f - 2.f * __builtin_amdgcn_rcpf(1.f + __expf(2.f * x)); }
DI void phase_x(const Params& p) {
  const bf16_t* PB = (const bf16_t*)(p.ws + WS_PB);
  bf16_t* X = (bf16_t*)(p.ws + WS_X);
  const float* mu = p.in[8];
  for (int i = blockIdx.x * NT + TIDX; i < MT * 32; i += gridDim.x * NT) {
    const int row = i >> 5, g = i & 31;
    uint4 o = make_uint4(0u, 0u, 0u, 0u);
    if (g < 16) {
      const int col = 3072 + g * 8;
      const bool prompt = row < MP;
      const int t = prompt ? (row & 4095) : ((row - MP) & 15);
      const uint4 a = *(const uint4*)(PB + (size_t)row * CSH + col);
      float c[8] = {bflo(a.x), bfhi(a.x), bflo(a.y), bfhi(a.y), bflo(a.z), bfhi(a.z), bflo(a.w), bfhi(a.w)}, q[8];
      if (t != 0) { const uint4 b = *(const uint4*)(PB + (size_t)(row - 1) * CSH + col); q[0] = bflo(b.x); q[1] = bfhi(b.x); q[2] = bflo(b.y); q[3] = bfhi(b.y); q[4] = bflo(b.z); q[5] = bfhi(b.z); q[6] = bflo(b.w); q[7] = bfhi(b.w); }
      else if (prompt) {
#pragma unroll
        for (int j = 0; j < 8; ++j) q[j] = 0.f;
      } else { const float* s = p.in[4] + (size_t)((row - MP) >> 4) * CSH + col; const float4 b0 = *(const float4*)s, b1 = *(const float4*)(s + 4); q[0] = b0.x; q[1] = b0.y; q[2] = b0.z; q[3] = b0.w; q[4] = b1.x; q[5] = b1.y; q[6] = b1.z; q[7] = b1.w; }
      const float4 u0 = *(const float4*)(mu + col), u1 = *(const float4*)(mu + col + 4);
      const float u[8] = {u0.x, u0.y, u0.z, u0.w, u1.x, u1.y, u1.z, u1.w};
      float m[8];
#pragma unroll
      for (int j = 0; j < 8; ++j) { m[j] = c[j] + u[j] * (q[j] - c[j]); if (g < 8) m[j] = tanh_fast(m[j]); }
      o = make_uint4(cvtpk(m[0], m[1]), cvtpk(m[2], m[3]), cvtpk(m[4], m[5]), cvtpk(m[6], m[7]));
    }
    *(uint4*)(X + (size_t)row * 256 + g * 8) = o;
  }
}
struct EpiLora {
  static constexpr bool PERM = true, AFTER_DRAIN = false;
  Params p;
  DI void operator()(const pg8::f32x4 (&acc)[2][2][4][2], const pg8::Unit& u, int wr, int wc, int fr, int fq) const {
    const bool isw = u.pn < 4;
#pragma unroll
    for (int ai = 0; ai < 2; ++ai)
#pragma unroll
      for (int m = 0; m < 4; ++m) {
        const int row = u.pm * 256 + ai * 128 + wr * 64 + m * 16 + fr;
        const size_t hb = hm_base(row), hs = hm_hstride(row);
#pragma unroll
        for (int bj = 0; bj < 2; ++bj) {
          const int c = (u.pn & 3) * 256 + bj * 128 + wc * 32 + 8 * fq;
          const size_t idx = hb + (c >> 6) * hs + (c & 63);
          const f32x4 v0 = acc[ai][bj][m][0], v1 = acc[ai][bj][m][1];
          if (isw) {
            const f32x4 b0 = *(const f32x4*)(p.in[9] + c), b1 = *(const f32x4*)(p.in[9] + c + 4);
            f32x4 d0, d1;
#pragma unroll
            for (int j = 0; j < 4; ++j) {
              const float x0 = -(b0[j] + v0[j]), x1 = -(b1[j] + v1[j]);
              const float s0 = fmaxf(x0, 0.f) + __logf(1.f + __expf(-fabsf(x0))), s1 = fmaxf(x1, 0.f) + __logf(1.f + __expf(-fabsf(x1)));
              d0[j] = __expf(-__expf(-s0 - 0.5f)); d1[j] = __expf(-__expf(-s1 - 0.5f));
            }
            float* o = (float*)(p.ws + WS_SW) + idx; *(f32x4*)o = d0; *(f32x4*)(o + 4) = d1;
          } else {
            const f32x4 b0 = *(const f32x4*)(p.in[11] + c), b1 = *(const f32x4*)(p.in[11] + c + 4);
            f32x4 d0, d1;
#pragma unroll
            for (int j = 0; j < 4; ++j) { d0[j] = sigmoidf_(b0[j] + v0[j]); d1[j] = sigmoidf_(b1[j] + v1[j]); }
            *(uint4*)((bf16_t*)(p.ws + WS_SB) + idx) = pack8(d0, d1);
          }
        }
      }
  }
};
DI void small_lora(const Params& p) {
  const int lane = TIDX & 63, wid = TIDX >> 6, r = lane & 31, h = lane >> 5;
  const bf16_t* X = (const bf16_t*)(p.ws + WS_X); const bf16_t* BL = (const bf16_t*)(p.ws + WS_BTL);
  for (int tile = wid * gridDim.x + blockIdx.x; tile < 16 * 64; tile += 8 * gridDim.x) {
    const int row0 = MP + (tile >> 6) * 32, ct = tile & 63, col0 = ct * 32, k0 = ct < 32 ? 0 : 64;
    const bf16_t* pa = X + (size_t)(row0 + r) * 256 + k0 + 8 * h;
    const bf16_t* pb = BL + (size_t)(col0 + r) * 256 + k0 + 8 * h;
    f32x16 acc;
#pragma unroll
    for (int i = 0; i < 16; ++i) acc[i] = 0.f;
#pragma unroll
    for (int s = 0; s < 4; ++s) acc = MFMA32(*(const bf16x8*)(pa + 16 * s), *(const bf16x8*)(pb + 16 * s), acc);
    const int c = (col0 + r) & 1023;
    const float bias = ct < 32 ? p.in[9][c] : p.in[11][c];
#pragma unroll
    for (int i = 0; i < 16; ++i) {
      const int row = row0 + crow(i, h);
      const size_t idx = hm_base(row) + (c >> 6) * hm_hstride(row) + (c & 63);
      const float v = bias + acc[i];
      if (ct < 32) {
        const float x = -v, sp = fmaxf(x, 0.f) + __logf(1.f + __expf(-fabsf(x)));
        ((float*)(p.ws + WS_SW))[idx] = __expf(-__expf(-sp - 0.5f));
      } else ((bf16_t*)(p.ws + WS_SB))[idx] = f2bf(sigmoidf_(v));
    }
  }
}

DI void phase1c(const Params& p) {
  const int tid = TIDX & 255, half = TIDX >> 8, c = tid * 4, hh = c >> 6;
  const bf16_t* PB = (const bf16_t*)(p.ws + WS_PB);
  const float* mu = p.in[8];
  const float4 kkw = *(const float4*)(p.in[13] + c), kaw = *(const float4*)(p.in[14] + c), rkw = *(const float4*)(p.in[15] + c);
  const float4 mur = *(const float4*)(mu + c), muk = *(const float4*)(mu + 1024 + c), muv = *(const float4*)(mu + 2048 + c), muz = *(const float4*)(mu + 3200 + c);
  const float kka[4] = {kkw.x, kkw.y, kkw.z, kkw.w}, kaa[4] = {kaw.x, kaw.y, kaw.z, kaw.w}, rka[4] = {rkw.x, rkw.y, rkw.z, rkw.w};
  const float mura[4] = {mur.x, mur.y, mur.z, mur.w}, muka[4] = {muk.x, muk.y, muk.z, muk.w}, muva[4] = {muv.x, muv.y, muv.z, muv.w}, muza[4] = {muz.x, muz.y, muz.z, muz.w};
  bf16_t* SR = (bf16_t*)(p.ws + WS_SR); bf16_t* SK = (bf16_t*)(p.ws + WS_SK); bf16_t* SV = (bf16_t*)(p.ws + WS_SV);
  bf16_t* SKK = (bf16_t*)(p.ws + WS_SKK); bf16_t* SB = (bf16_t*)(p.ws + WS_SB); bf16_t* SZB = (bf16_t*)(p.ws + WS_SZB);
  float* BONUS = (float*)(p.ws + WS_BONUS);
  for (int r4 = blockIdx.x * 2 + half; r4 < MT / 4; r4 += gridDim.x * 2) {
    const int row0 = r4 * 4;
    const bool prompt = row0 < MP;
    const int t0 = prompt ? (row0 & 4095) : ((row0 - MP) & 15);
    uint2 gr[5], gk[5], gv[5], gz[5], ga[4];
#pragma unroll
    for (int t = 0; t < 5; ++t) {
      const int rr_ = (t == 0 && t0 == 0) ? row0 : row0 + t - 1;
      const bf16_t* pc = PB + (size_t)rr_ * CSH;
      gr[t] = *(const uint2*)(pc + c); gk[t] = *(const uint2*)(pc + 1024 + c); gv[t] = *(const uint2*)(pc + 2048 + c); gz[t] = *(const uint2*)(pc + 3200 + c);
    }
    size_t idx[4];
#pragma unroll
    for (int t = 0; t < 4; ++t) { idx[t] = hm_base(row0 + t) + hh * hm_hstride(row0 + t) + (c & 63); ga[t] = *(const uint2*)(SB + idx[t]); }
    float pr[4], pk[4], pv[4], pz[4];
    if (t0 == 0) {
      if (prompt) {
#pragma unroll
        for (int x = 0; x < 4; ++x) { pr[x] = 0.f; pk[x] = 0.f; pv[x] = 0.f; pz[x] = 0.f; }
      } else {
        const float* s = p.in[4] + (size_t)((row0 - MP) >> 4) * CSH;
        const float4 a = *(const float4*)(s + c), b = *(const float4*)(s + 1024 + c), d = *(const float4*)(s + 2048 + c), e = *(const float4*)(s + 3200 + c);
        pr[0] = a.x; pr[1] = a.y; pr[2] = a.z; pr[3] = a.w; pk[0] = b.x; pk[1] = b.y; pk[2] = b.z; pk[3] = b.w;
        pv[0] = d.x; pv[1] = d.y; pv[2] = d.z; pv[3] = d.w; pz[0] = e.x; pz[1] = e.y; pz[2] = e.z; pz[3] = e.w;
      }
    } else {
      pr[0] = bflo(gr[0].x); pr[1] = bfhi(gr[0].x); pr[2] = bflo(gr[0].y); pr[3] = bfhi(gr[0].y);
      pk[0] = bflo(gk[0].x); pk[1] = bfhi(gk[0].x); pk[2] = bflo(gk[0].y); pk[3] = bfhi(gk[0].y);
      pv[0] = bflo(gv[0].x); pv[1] = bfhi(gv[0].x); pv[2] = bflo(gv[0].y); pv[3] = bfhi(gv[0].y);
      pz[0] = bflo(gz[0].x); pz[1] = bfhi(gz[0].x); pz[2] = bflo(gz[0].y); pz[3] = bfhi(gz[0].y);
    }
#pragma unroll
    for (int t = 0; t < 4; ++t) {
      const int row = row0 + t;
      const float curr[4] = {bflo(gr[t + 1].x), bfhi(gr[t + 1].x), bflo(gr[t + 1].y), bfhi(gr[t + 1].y)}, curk[4] = {bflo(gk[t + 1].x), bfhi(gk[t + 1].x), bflo(gk[t + 1].y), bfhi(gk[t + 1].y)};
      const float curv[4] = {bflo(gv[t + 1].x), bfhi(gv[t + 1].x), bflo(gv[t + 1].y), bfhi(gv[t + 1].y)}, curz[4] = {bflo(gz[t + 1].x), bfhi(gz[t + 1].x), bflo(gz[t + 1].y), bfhi(gz[t + 1].y)};
      const float av[4] = {bflo(ga[t].x), bfhi(ga[t].x), bflo(ga[t].y), bfhi(ga[t].y)};
      float rm[4], km[4], vm[4], kkv[4], bb[4], kmod[4], szb[4];
      float ssq = 0.f, bon = 0.f;
#pragma unroll
      for (int x = 0; x < 4; ++x) {
        rm[x] = curr[x] + mura[x] * (pr[x] - curr[x]);
        km[x] = curk[x] + muka[x] * (pk[x] - curk[x]);
        vm[x] = curv[x] + muva[x] * (pv[x] - curv[x]);
        const float zm = curz[x] + muza[x] * (pz[x] - curz[x]);
        szb[x] = zm * sigmoidf_(zm);
        kkv[x] = km[x] * kka[x];
        ssq += kkv[x] * kkv[x];
        kmod[x] = km[x] * (1.f + (av[x] - 1.f) * kaa[x]);
        bon += rm[x] * kmod[x] * rka[x];
        pr[x] = curr[x]; pk[x] = curk[x]; pv[x] = curv[x]; pz[x] = curz[x];
      }
      ssq = sum16(ssq); bon = sum16(bon);
      const float inv = 1.f / fmaxf(sqrtf(ssq), 1e-12f);
#pragma unroll
      for (int x = 0; x < 4; ++x) { kkv[x] *= inv; bb[x] = kkv[x] * av[x]; }
      *(uint2*)(SR + idx[t]) = make_uint2(cvtpk(rm[0], rm[1]), cvtpk(rm[2], rm[3]));
      *(uint2*)(SK + idx[t]) = make_uint2(cvtpk(kmod[0], kmod[1]), cvtpk(kmod[2], kmod[3]));
      *(uint2*)(SV + idx[t]) = make_uint2(cvtpk(vm[0], vm[1]), cvtpk(vm[2], vm[3]));
      *(uint2*)(SKK + idx[t]) = make_uint2(cvtpk(-kkv[0], -kkv[1]), cvtpk(-kkv[2], -kkv[3]));
      *(uint2*)(SB + idx[t]) = make_uint2(cvtpk(bb[0], bb[1]), cvtpk(bb[2], bb[3]));
      *(uint2*)(SZB + (size_t)row * 1024 + c) = make_uint2(cvtpk(szb[0], szb[1]), cvtpk(szb[2], szb[3]));
      if ((tid & 15) == 0) BONUS[(size_t)row * 16 + hh] = bon;
    }
  }
}

template <bool SAMPLE>
DI void attn_wave(const Params& p, int sh, int qt) {
  const int lane = TIDX & 63, r = lane & 31, h = lane >> 5;
  const int hh = sh & 15, b = sh >> 4;
  bf16_t* QB = (bf16_t*)(p.ws + WS_QB);
  const int row0 = SAMPLE ? MP + b * 16 : b * 4096 + qt * 32;
  bf16_t* Qp = QB + (size_t)row0 * 1024 + hh * 64;
  const int qrow = SAMPLE ? (r < 15 ? r : 15) : r;
  bf16x8 qf[4];
#pragma unroll
  for (int s = 0; s < 4; ++s) qf[s] = *(const bf16x8*)(Qp + (size_t)qrow * 1024 + 16 * s + 8 * h);
  f32x16 z0, z1;
#pragma unroll
  for (int i = 0; i < 16; ++i) { z0[i] = 0.f; z1[i] = 0.f; }
  float carry = 1.f;
  const int ntiles = SAMPLE ? 33 : qt + 1;
  for (int it = 0; it < ntiles; ++it) {
    const bool diag = (it == 0);
    const int kt = SAMPLE ? 32 - it : qt - it;
    bf16x8 kf[4];
    {
      const float* Kp;
      if (!SAMPLE) Kp = p.out + OUT_KP + ((size_t)sh * 4096 + kt * 32 + r) * 64;
      else Kp = diag ? p.out + OUT_KS + ((size_t)sh * 16 + (r < 15 ? r : 15)) * 64 : p.in[2] + ((size_t)sh * 1024 + kt * 32 + r) * 64;
#pragma unroll
      for (int s = 0; s < 4; ++s) {
        const float4 a = *(const float4*)(Kp + 16 * s + 8 * h), bq = *(const float4*)(Kp + 16 * s + 8 * h + 4);
        u32x4 w; w[0] = cvtpk(a.x, a.y); w[1] = cvtpk(a.z, a.w); w[2] = cvtpk(bq.x, bq.y); w[3] = cvtpk(bq.z, bq.w);
        kf[s] = __builtin_bit_cast(bf16x8, w);
      }
    }
    f32x16 st;
#pragma unroll
    for (int i = 0; i < 16; ++i) st[i] = 0.f;
#pragma unroll
    for (int s = 0; s < 4; ++s) st = MFMA32(kf[s], qf[s], st);
    float keep[16], wgt[16];
#pragma unroll
    for (int i = 0; i < 16; ++i) {
      const float e = __builtin_amdgcn_exp2f(st[i]);
      const float kp = __builtin_amdgcn_rcpf(1.f + e);
      bool valid = true;
      if (diag) { const int kr = crow(i, h); valid = SAMPLE ? (kr < r && kr < 16) : (kr < r); }
      keep[i] = valid ? kp : 1.f;
      wgt[i] = valid ? 1.f - kp : 0.f;
    }
    float pp[4], hif[4];
#pragma unroll
    for (int g = 0; g < 4; ++g) {
      const float p4 = (keep[4 * g] * keep[4 * g + 1]) * (keep[4 * g + 2] * keep[4 * g + 3]);
      const auto sw = __builtin_amdgcn_permlane32_swap(__float_as_uint(p4), __float_as_uint(p4), false, false);
      const float lo = __uint_as_float(sw[0]), hi = __uint_as_float(sw[1]);
      pp[g] = lo * hi;
      hif[g] = h ? 1.f : hi;
    }
    float T[4];
    T[3] = carry; T[2] = T[3] * pp[3]; T[1] = T[2] * pp[2]; T[0] = T[1] * pp[1];
    carry = T[0] * pp[0];
#pragma unroll
    for (int g = 0; g < 4; ++g) {
      const float w3 = T[g] * hif[g], w2 = w3 * keep[4 * g + 3], w1 = w2 * keep[4 * g + 2], w0 = w1 * keep[4 * g + 1];
      wgt[4 * g + 3] *= w3; wgt[4 * g + 2] *= w2; wgt[4 * g + 1] *= w1; wgt[4 * g] *= w0;
    }
#pragma unroll
    for (int s = 0; s < 2; ++s) {
      u32x4 pw;
#pragma unroll
      for (int j = 0; j < 4; ++j) pw[j] = cvtpk(wgt[8 * s + 2 * j], wgt[8 * s + 2 * j + 1]);
      const bf16x8 pf = __builtin_bit_cast(bf16x8, pw);
#pragma unroll
      for (int db = 0; db < 2; ++db) {
        bf16x8 vf;
        {
          float vv[8];
#pragma unroll
          for (int j = 0; j < 8; ++j) {
            const int kr = 16 * s + 8 * (j >> 2) + 4 * h + (j & 3);
            const float* vp;
            if (!SAMPLE) vp = p.out + OUT_VP + ((size_t)sh * 4096 + kt * 32 + kr) * 64;
            else vp = diag ? p.out + OUT_VS + ((size_t)sh * 16 + (kr < 15 ? kr : 15)) * 64 : p.in[3] + ((size_t)sh * 1024 + kt * 32 + kr) * 64;
            vv[j] = vp[db * 32 + r];
          }
          u32x4 w; w[0] = cvtpk(vv[0], vv[1]); w[1] = cvtpk(vv[2], vv[3]); w[2] = cvtpk(vv[4], vv[5]); w[3] = cvtpk(vv[6], vv[7]);
          vf = __builtin_bit_cast(bf16x8, w);
        }
        if (db == 0) z0 = MFMA32(pf, vf, z0); else z1 = MFMA32(pf, vf, z1);
      }
    }
    if (__ballot(carry != 0.f) == 0ull) break;
  }
  const bf16_t* SZA = (const bf16_t*)(p.ws + WS_SZA);
#pragma unroll
  for (int i = 0; i < 16; ++i) {
    const int q = crow(i, h);
    if (SAMPLE && q >= 16) continue;
    const size_t o = (size_t)(row0 + q) * 1024 + hh * 64 + r;
    QB[o] = f2bf(z0[i] * bf2f(SZA[o]));
    QB[o + 32] = f2bf(z1[i] * bf2f(SZA[o + 32]));
  }
}

DI float row16_sum(float x) {
  x += dppf<0xB1>(x); x += dppf<0x4E>(x); x += dppf<0x124>(x); x += dppf<0x128>(x);
  return x;
}
DI void scan_wave(const Params& p, int shg, int slice, float* L) {
  const int lane = TIDX & 63, cc = lane & 15;
  const bool prompt = shg < 64;
  const int T = prompt ? 4096 : 16;
  const size_t base = prompt ? (size_t)shg * 4096 * 64 : (size_t)MP * 1024 + (size_t)(shg - 64) * 16 * 64;
  const int v = slice * 4 + (lane >> 4);
  const float* SW = (const float*)(p.ws + WS_SW) + base;
  const bf16_t* SARR = (const bf16_t*)(p.ws + WS_SR) + base;
  float* ORAW = (float*)(p.ws + WS_ORAW) + base;
  float4 S;
  float* wout;
  if (prompt) { S = make_float4(0.f, 0.f, 0.f, 0.f); wout = p.out + OUT_WP + ((size_t)shg * 64 + v) * 64 + 4 * cc; }
  else { S = *(const float4*)(p.in[5] + ((size_t)(shg - 64) * 64 + v) * 64 + 4 * cc); wout = p.out + OUT_WS + ((size_t)(shg - 64) * 64 + v) * 64 + 4 * cc; }
  const int nch = T / 8;
  const int dw0 = ((lane >> 4) * 6 + 2) * 64 + (lane & 15) * 4, dw1 = dw0 + 4 * 384;
  const int db = (lane >> 3) * 384 + (lane & 7) * 8;
  uint4 gw0, gw1, gr, gk, gv, gn, gb;
#define SCAN_GLOAD(ch) do { const float* w_ = SW + (size_t)(ch) * 512; gw0 = *(const uint4*)(w_ + lane * 4); gw1 = *(const uint4*)(w_ + 256 + lane * 4); \
    const bf16_t* a_ = SARR + (size_t)(ch) * 512 + lane * 8; gr = *(const uint4*)a_; gk = *(const uint4*)(a_ + SZ_ACT / 2); gv = *(const uint4*)(a_ + 2 * (SZ_ACT / 2)); \
    gn = *(const uint4*)(a_ + 3 * (SZ_ACT / 2)); gb = *(const uint4*)(a_ + 4 * (SZ_ACT / 2)); } while (0)
#define SCAN_PUT(slot, g) do { float* d_ = L + db + (slot) * 64; *(float4*)d_ = make_float4(bflo(g.x), bfhi(g.x), bflo(g.y), bfhi(g.y)); *(float4*)(d_ + 4) = make_float4(bflo(g.z), bfhi(g.z), bflo(g.w), bfhi(g.w)); } while (0)
#define SCAN_LSTORE() do { *(uint4*)(L + dw0) = gw0; *(uint4*)(L + dw1) = gw1; SCAN_PUT(4, gr); SCAN_PUT(3, gk); SCAN_PUT(5, gv); SCAN_PUT(0, gn); SCAN_PUT(1, gb); \
    asm volatile("s_waitcnt lgkmcnt(0)" ::: "memory"); } while (0)
  SCAN_GLOAD(0);
  asm volatile("s_waitcnt lgkmcnt(0)" ::: "memory");
  SCAN_LSTORE();
  for (int ch = 0; ch < nch; ++ch) {
    if (ch + 1 < nch) SCAN_GLOAD(ch + 1);
    float okeep = 0.f;
    const float* Lc = L + 4 * cc;
    float4 nk = *(const float4*)(Lc), bb = *(const float4*)(Lc + 64), ww = *(const float4*)(Lc + 128), kv = *(const float4*)(Lc + 192), rr = *(const float4*)(Lc + 256);
    float vt = L[320 + v];
#pragma unroll 4
    for (int st = 0; st < 8; ++st) {
      const int sn = ((st + 1) & 7) * 384;
      const float4 nk2 = *(const float4*)(Lc + sn), bb2 = *(const float4*)(Lc + sn + 64), ww2 = *(const float4*)(Lc + sn + 128);
      const float4 kv2 = *(const float4*)(Lc + sn + 192), rr2 = *(const float4*)(Lc + sn + 256);
      const float vt2 = L[sn + 320 + v];
      float d = (S.x * nk.x + S.y * nk.y) + (S.z * nk.z + S.w * nk.w);
      const float sa = row16_sum(d);
      S.x = S.x * ww.x + (sa * bb.x + vt * kv.x);
      S.y = S.y * ww.y + (sa * bb.y + vt * kv.y);
      S.z = S.z * ww.z + (sa * bb.z + vt * kv.z);
      S.w = S.w * ww.w + (sa * bb.w + vt * kv.w);
      float o = (S.x * rr.x + S.y * rr.y) + (S.z * rr.z + S.w * rr.w);
      o = row16_sum(o);
      okeep = (cc == st) ? o : okeep;
      nk = nk2; bb = bb2; ww = ww2; kv = kv2; rr = rr2; vt = vt2;
    }
    if (cc < 8) ORAW[(size_t)(ch * 8 + cc) * 64 + v] = okeep;
    asm volatile("s_waitcnt lgkmcnt(0)" ::: "memory");
    if (ch + 1 < nch) SCAN_LSTORE();
  }
  *(float4*)wout = S;
#undef SCAN_GLOAD
#undef SCAN_PUT
#undef SCAN_LSTORE
}

DI void sgroup_barrier(volatile LAS unsigned* cnt, unsigned target) {
  asm volatile("s_waitcnt lgkmcnt(0)" ::: "memory");
  if ((TIDX & 63) == 0) __hip_atomic_fetch_add((LAS unsigned*)cnt, 1u, __ATOMIC_RELAXED, __HIP_MEMORY_SCOPE_WORKGROUP);
  while (*cnt < target) __builtin_amdgcn_s_sleep(1);
  asm volatile("" ::: "memory");
}
DI void scan_group(const Params& p, int sh, int quarter, float* lds, volatile LAS unsigned* cnt, unsigned& nbar) {
  const int tid = TIDX & 255, lane = tid & 63, wid = tid >> 6, cc = lane & 15;
  const size_t base = (size_t)sh * 4096 * 64;
  const int v = quarter * 16 + wid * 4 + (lane >> 4);
  const float* SW = (const float*)(p.ws + WS_SW) + base;
  const bf16_t* SARR = (const bf16_t*)(p.ws + WS_SR) + base;
  float* ORAW = (float*)(p.ws + WS_ORAW) + base;
  f32x2 S01 = {0.f, 0.f}, S23 = {0.f, 0.f};
  const bool b0 = (lane & 1) != 0, b1 = (lane & 2) != 0;
  float4 gw0, gw1; uint4 gb0, gb1, gb2, gb3, gb4;
  const int dstw0 = ((tid >> 4) * 6 + 2) * 64 + (tid & 15) * 4, dstw1 = dstw0 + 16 * 384;
  const int dstb = (tid >> 3) * 384 + (tid & 7) * 8;
  const bf16_t* sbp = SARR + tid * 8;
#define SG_GLOAD(ch) do { const size_t o_ = (size_t)(ch) * 2048; gw0 = *(const float4*)(SW + o_ + tid * 4); gw1 = *(const float4*)(SW + o_ + 1024 + tid * 4); \
    gb0 = *(const uint4*)(sbp + o_); gb1 = *(const uint4*)(sbp + (SZ_ACT / 2) + o_); gb2 = *(const uint4*)(sbp + 2 * (SZ_ACT / 2) + o_); \
    gb3 = *(const uint4*)(sbp + 3 * (SZ_ACT / 2) + o_); gb4 = *(const uint4*)(sbp + 4 * (SZ_ACT / 2) + o_); } while (0)
#define SG_PUT(d_, g) do { *(float4*)(d_) = make_float4(bflo(g.x), bfhi(g.x), bflo(g.y), bfhi(g.y)); *(float4*)((d_) + 4) = make_float4(bflo(g.z), bfhi(g.z), bflo(g.w), bfhi(g.w)); } while (0)
#define SG_LSTORE(buf) do { float* L_ = lds + (buf) * (32 * 384); *(float4*)(L_ + dstw0) = gw0; *(float4*)(L_ + dstw1) = gw1; \
    SG_PUT(L_ + dstb + 4 * 64, gb0); SG_PUT(L_ + dstb + 3 * 64, gb1); SG_PUT(L_ + dstb + 5 * 64, gb2); SG_PUT(L_ + dstb + 0 * 64, gb3); SG_PUT(L_ + dstb + 1 * 64, gb4); } while (0)
  SG_GLOAD(0); SG_LSTORE(0); sgroup_barrier(cnt, 4u * (++nbar));
  for (int ch = 0; ch < 128; ++ch) {
    if (ch + 1 < 128) SG_GLOAD(ch + 1);
#pragma unroll 1
    for (int hlf = 0; hlf < 2; ++hlf) {
    const float* L = lds + (ch & 1) * (32 * 384) + hlf * (16 * 384);
    float okeep = 0.f;
    const float* Lc = L + 4 * cc;
    f32x4 nk = *(const f32x4*)(Lc), bb = *(const f32x4*)(Lc + 64), ww = *(const f32x4*)(Lc + 128), kv = *(const f32x4*)(Lc + 192), rr = *(const f32x4*)(Lc + 256);
    float vt = L[320 + v];
    f32x4 rrp = rr;
    float po[4];
#pragma unroll
    for (int st = 0; st <= 16; ++st) {
      if (st > 0) { const f32x2 o2 = S01 * rrp.xy + S23 * rrp.zw; po[(st - 1) & 3] = o2.x + o2.y; }
      if (st > 0 && (st & 3) == 0) {
        const float u0 = (b0 ? po[1] : po[0]) + dppf<0xB1>(b0 ? po[0] : po[1]);
        const float u1 = (b0 ? po[3] : po[2]) + dppf<0xB1>(b0 ? po[2] : po[3]);
        float w = (b1 ? u1 : u0) + dppf<0x4E>(b1 ? u0 : u1);
        w += dppf<0x124>(w); w += dppf<0x128>(w);
        okeep = ((cc >> 2) == (st >> 2) - 1) ? w : okeep;
      }
      if (st < 16) {
        const int sn = ((st + 1) & 15) * 384;
        const f32x2 d2 = S01 * nk.xy + S23 * nk.zw;
        float x = d2.x + d2.y;
        const f32x2 vt_2 = {vt, vt};
        const f32x2 t01 = vt_2 * kv.xy, t23 = vt_2 * kv.zw;
        __builtin_amdgcn_sched_barrier(0);
        x += dppf<0xB1>(x);
        const f32x4 nk2 = *(const f32x4*)(Lc + sn), bb2 = *(const f32x4*)(Lc + sn + 64);
        __builtin_amdgcn_sched_barrier(0);
        x += dppf<0x4E>(x);
        const f32x4 ww2 = *(const f32x4*)(Lc + sn + 128), kv2 = *(const f32x4*)(Lc + sn + 192);
        __builtin_amdgcn_sched_barrier(0);
        x += dppf<0x124>(x);
        const f32x4 rr2 = *(const f32x4*)(Lc + sn + 256);
        const float vt2 = L[sn + 320 + v];
        __builtin_amdgcn_sched_barrier(0);
        x += dppf<0x128>(x);
        __builtin_amdgcn_sched_barrier(0);
        const f32x2 sa2 = {x, x};
        S01 = S01 * ww.xy + (sa2 * bb.xy + t01);
        S23 = S23 * ww.zw + (sa2 * bb.zw + t23);
        rrp = rr;
        nk = nk2; bb = bb2; ww = ww2; kv = kv2; rr = rr2; vt = vt2;
      }
    }
    ORAW[(size_t)(ch * 32 + hlf * 16 + cc) * 64 + v] = okeep;
    }
    if (ch + 1 < 128) SG_LSTORE((ch + 1) & 1);
    sgroup_barrier(cnt, 4u * (++nbar));
  }
  *(float4*)(p.out + OUT_WP + ((size_t)sh * 64 + v) * 64 + 4 * cc) = make_float4(S01.x, S01.y, S23.x, S23.y);
#undef SG_GLOAD
#undef SG_PUT
#undef SG_LSTORE
}

constexpr int NQ_ATT_P = 8192, NQ_ATT_S = 512, NQ_SCAN_S = 8192, NQ_DYN = NQ_ATT_P + NQ_ATT_S + NQ_SCAN_S;
DI int wave_grab(unsigned* ctr) { int v = 0; if ((TIDX & 63) == 0) v = (int)atomicAdd(ctr, 1u); return __builtin_amdgcn_readfirstlane(v); }
DI void phase2(const Params& p, char* smem) {
  __shared__ unsigned s_cnt;
  unsigned* ctl = (unsigned*)(p.ws + WS_CTL);
  const int wid = TIDX >> 6;
  if (TIDX == 0) s_cnt = 0u;
  __syncthreads();
  float* Lsh = (float*)smem + 4 * (8 * 384);
  float* L = wid >= 4 ? (float*)smem + (wid - 4) * (8 * 384) : Lsh + wid * (8 * 384);
  if (wid < 4) {
    unsigned nbar = 0;
    __builtin_amdgcn_s_setprio(3);
    for (int bu = blockIdx.x; bu < 256; bu += gridDim.x) scan_group(p, bu >> 2, bu & 3, Lsh, (volatile LAS unsigned*)&s_cnt, nbar);
    __builtin_amdgcn_s_setprio(0);
  }
  for (;;) {
    int u = wave_grab(&ctl[0]);
    if (u >= NQ_DYN) break;
    if (u < NQ_ATT_P) { attn_wave<false>(p, u >> 7, u & 127); continue; }
    u -= NQ_ATT_P;
    if (u < NQ_ATT_S) { attn_wave<true>(p, u, 0); continue; }
    u -= NQ_ATT_S;
    scan_wave(p, 64 + (u >> 4), u & 15, L);
  }
}

DI void p2c_row(const Params& p, int row, int c, int hh, const float4& lg, const float4& lb, const float4& o, const uint2& vv, const uint2& zz, float bon) {
  const float mean = sum16((o.x + o.y) + (o.z + o.w)) * (1.f / 64.f);
  const float dx = o.x - mean, dy = o.y - mean, dz = o.z - mean, dw = o.w - mean;
  const float var = sum16((dx * dx + dy * dy) + (dz * dz + dw * dw)) * (1.f / 64.f);
  const float inv = rsqrtf(var + LNX_EPS);
  const float r0 = (dx * inv * lg.x + lb.x + bon * bflo(vv.x)) * bflo(zz.x);
  const float r1 = (dy * inv * lg.y + lb.y + bon * bfhi(vv.x)) * bfhi(zz.x);
  const float r2 = (dz * inv * lg.z + lb.z + bon * bflo(vv.y)) * bflo(zz.y);
  const float r3 = (dw * inv * lg.w + lb.w + bon * bfhi(vv.y)) * bfhi(zz.y);
  *(uint2*)((bf16_t*)(p.ws + WS_OB) + (size_t)row * 1024 + c) = make_uint2(cvtpk(r0, r1), cvtpk(r2, r3));
}
DI void phase2c(const Params& p) {
  const int tid = TIDX & 255, half = TIDX >> 8, c = tid * 4, hh = c >> 6;
  const float4 lg = *(const float4*)(p.in[16] + c), lb = *(const float4*)(p.in[17] + c);
  const float* ORAW = (const float*)(p.ws + WS_ORAW); const bf16_t* SV = (const bf16_t*)(p.ws + WS_SV);
  const bf16_t* SZB = (const bf16_t*)(p.ws + WS_SZB); const float* BONUS = (const float*)(p.ws + WS_BONUS);
  const int stride = gridDim.x * 2;
  for (int row = blockIdx.x * 2 + half; row < MT; row += 2 * stride) {
    const bool two = row + stride < MT;
    const int rowb = two ? row + stride : row;
    const size_t ia = hm_base(row) + hh * hm_hstride(row) + (c & 63), ib = hm_base(rowb) + hh * hm_hstride(rowb) + (c & 63);
    const float4 oa = *(const float4*)(ORAW + ia), ob = *(const float4*)(ORAW + ib);
    const uint2 va = *(const uint2*)(SV + ia), vb = *(const uint2*)(SV + ib);
    const uint2 za = *(const uint2*)(SZB + (size_t)row * 1024 + c), zb = *(const uint2*)(SZB + (size_t)rowb * 1024 + c);
    const float ba = BONUS[(size_t)row * 16 + hh], bb = BONUS[(size_t)rowb * 16 + hh];
    p2c_row(p, row, c, hh, lg, lb, oa, va, za, ba);
    if (two) p2c_row(p, rowb, c, hh, lg, lb, ob, vb, zb, bb);
  }
}

DI void phase4(const Params& p) {
  const int lane = TIDX & 63, wid = TIDX >> 6;
  const float* g = p.in[21];
  float4 gg[4];
#pragma unroll
  for (int i = 0; i < 4; ++i) gg[i] = *(const float4*)(g + i * 256 + lane * 4);
  const int stride = gridDim.x * 8;
  for (int row = blockIdx.x * 8 + wid; row < MT; row += 2 * stride) {
    const bool two = row + stride < MT;
    float* x0 = p.out + OUT_YP + (size_t)row * 1024;
    float* x1 = p.out + OUT_YP + (size_t)(two ? row + stride : row) * 1024;
    float4 v0[4], v1[4]; float s0 = 0.f, s1 = 0.f;
#pragma unroll
    for (int i = 0; i < 4; ++i) { v0[i] = *(const float4*)(x0 + i * 256 + lane * 4); v1[i] = *(const float4*)(x1 + i * 256 + lane * 4); }
#pragma unroll
    for (int i = 0; i < 4; ++i) {
      s0 += v0[i].x * v0[i].x + v0[i].y * v0[i].y + v0[i].z * v0[i].z + v0[i].w * v0[i].w;
      s1 += v1[i].x * v1[i].x + v1[i].y * v1[i].y + v1[i].z * v1[i].z + v1[i].w * v1[i].w;
    }
    s0 = wave_sum(s0); s1 = wave_sum(s1);
    const float i0 = rsqrtf(s0 * (1.f / DM) + EPS), i1 = rsqrtf(s1 * (1.f / DM) + EPS);
#pragma unroll
    for (int i = 0; i < 4; ++i) *(float4*)(x0 + i * 256 + lane * 4) = make_float4(v0[i].x * i0 * gg[i].x, v0[i].y * i0 * gg[i].y, v0[i].z * i0 * gg[i].z, v0[i].w * i0 * gg[i].w);
    if (two) {
#pragma unroll
      for (int i = 0; i < 4; ++i) *(float4*)(x1 + i * 256 + lane * 4) = make_float4(v1[i].x * i1 * gg[i].x, v1[i].y * i1 * gg[i].y, v1[i].z * i1 * gg[i].z, v1[i].w * i1 * gg[i].w);
    }
  }
}

#define XB_TMO      128
#define XB_XCNT(j)  (256  + 64 * (j))
#define XB_XSUB(j)  (1280 + 64 * (j))
#define XB_XGEN(j)  (2304 + 64 * (j))
#define XB_TOP      3328
#define XB_TOPGEN   3392
#define XCD_BAR_WORDS 3456
#define XB_SPIN_CAP (1u << 18)

__device__ __forceinline__ unsigned xb_ld(unsigned* p)              { return __hip_atomic_load(p, __ATOMIC_RELAXED, __HIP_MEMORY_SCOPE_AGENT); }
__device__ __forceinline__ unsigned xb_add(unsigned* p, unsigned v) { return __hip_atomic_fetch_add(p, v, __ATOMIC_RELAXED, __HIP_MEMORY_SCOPE_AGENT); }
__device__ __forceinline__ unsigned xb_xcc_id() { return (unsigned)__builtin_amdgcn_s_getreg((3 << 11) | 20) & 0xFu; }
#define XB_SPIN(cond, bar) do { unsigned _sp = 0; while (cond) { __builtin_amdgcn_s_sleep(1); \
    if ((++_sp & 255u) == 0u) { if (xb_ld(&(bar)[XB_TMO])) break; if (_sp > XB_SPIN_CAP) { atomicAdd(&(bar)[XB_TMO], 1u); break; } } } } while (0)

struct XcdBarrier {
    unsigned* bar; unsigned x;
    volatile LAS unsigned* st;
};

__device__ __forceinline__ XcdBarrier xcd_barrier_post(unsigned* bar, volatile LAS unsigned* st) {
    XcdBarrier b; b.bar = bar; b.x = xb_xcc_id(); b.st = st;
    if (TIDX == 0) (void)xb_add(&bar[XB_XCNT(b.x)], 1u);
    return b;
}
__device__ __forceinline__ void xcd_barrier_complete(unsigned* bar, unsigned x, unsigned& nloc, unsigned& nx) {
    const unsigned G = gridDim.x * gridDim.y * gridDim.z;
    unsigned sum, cnt, mine, sp = 0u;
    for (;;) {
        sum = 0u; cnt = 0u; mine = 0u;
#pragma unroll
        for (unsigned j = 0; j < 16; ++j) { const unsigned c = xb_ld(&bar[XB_XCNT(j)]); sum += c; cnt += (c > 0u) ? 1u : 0u; mine = (j == x) ? c : mine; }
        if (sum == G) break;
        __builtin_amdgcn_s_sleep(1);
        if ((++sp & 255u) == 0u) { if (xb_ld(&bar[XB_TMO])) break; if (sp > XB_SPIN_CAP) { atomicAdd(&bar[XB_TMO], 1u); break; } }
    }
    nloc = mine > 0u ? mine : 1u; nx = cnt > 0u ? cnt : 1u;
}

__device__ __forceinline__ void xcd_barrier(const XcdBarrier& b) {
    asm volatile("s_waitcnt vmcnt(0)" ::: "memory");
    __syncthreads();
    if (TIDX == 0) {
        unsigned* bar = b.bar;
        __builtin_amdgcn_s_waitcnt(0);
        unsigned nloc = b.st[0], nx = b.st[1];
        if (nloc == 0u) { xcd_barrier_complete(bar, b.x, nloc, nx); b.st[0] = nloc; b.st[1] = nx; }
        const unsigned old = xb_add(&bar[XB_XSUB(b.x)], 1u);
        const unsigned gen = old / nloc;
        if (old + 1u == (gen + 1u) * nloc) {
            __builtin_amdgcn_fence(__ATOMIC_RELEASE, "agent");
            asm volatile("s_waitcnt vmcnt(0)" ::: "memory");
            const unsigned og = xb_add(&bar[XB_TOP], 1u);
            const unsigned tg = og / nx;
            if (og + 1u == (tg + 1u) * nx) xb_add(&bar[XB_TOPGEN], 1u);
            else XB_SPIN(xb_ld(&bar[XB_TOPGEN]) == tg, bar);
            __builtin_amdgcn_fence(__ATOMIC_ACQUIRE, "agent");
            xb_add(&bar[XB_XGEN(b.x)], 1u);
            asm volatile("s_waitcnt vmcnt(0)" ::: "memory");
        } else {
            XB_SPIN(xb_ld(&bar[XB_XGEN(b.x)]) == gen, bar);
            __builtin_amdgcn_fence(__ATOMIC_ACQUIRE, "agent");
            asm volatile("s_waitcnt vmcnt(0)" ::: "memory");
        }
    }
    __syncthreads();
}

__global__ void __launch_bounds__(NT, 2) mega(Params p) {
  extern __shared__ __attribute__((aligned(16))) char smem[];
  cg::grid_group grid = cg::this_grid();
  if (blockIdx.x == 0) { unsigned* ctl = (unsigned*)(p.ws + WS_CTL); for (int i = TIDX; i < 16384; i += NT) ctl[i] = 0u; }
  grid.sync();
  __shared__ unsigned xb_st[2];
  if (TIDX == 0) { xb_st[0] = 0u; xb_st[1] = 0u; }
  __syncthreads();
  (void)xcd_barrier_post((unsigned*)(p.ws + WS_CTL) + 8192, (volatile LAS unsigned*)xb_st);
#define XBAR() do { XcdBarrier xb_; xb_.bar = (unsigned*)(p.ws + WS_CTL) + 8192; xb_.x = xb_xcc_id(); xb_.st = (volatile LAS unsigned*)xb_st; xcd_barrier(xb_); } while (0)
  phase0(p, smem);
  XBAR();
  { EpiP1 E; E.p = p; run_gemm(smem, (const bf16_t*)(p.ws + WS_H), (const bf16_t*)(p.ws + WS_WINT), MT, NINP, E); }
  XBAR();
  phase_x(p);
  XBAR();
  { EpiLora E; E.p = p; run_gemm(smem, (const bf16_t*)(p.ws + WS_X), (const bf16_t*)(p.ws + WS_BTL), MP, 2048, E, 256); }
  small_lora(p);
  XBAR();
  phase1c(p);
  XBAR();
  phase2(p, smem);
  XBAR();
  phase2c(p);
  XBAR();
  { EpiGate E; E.p = p; E.goff = 0; E.first = true; run_gemm(smem, (const bf16_t*)(p.ws + WS_QB), (const bf16_t*)(p.ws + WS_WT), MP, 1024, E); }
  small_gemm<0>(p, (const bf16_t*)(p.ws + WS_QB), (const bf16_t*)(p.ws + WS_WT));
  { EpiGate E; E.p = p; E.goff = 1024; E.first = false; run_gemm(smem, (const bf16_t*)(p.ws + WS_OB), (const bf16_t*)(p.ws + WS_WT) + (size_t)1024 * 1024, MP, 1024, E); }
  small_gemm<1>(p, (const bf16_t*)(p.ws + WS_OB), (const bf16_t*)(p.ws + WS_WT) + (size_t)1024 * 1024);
  XBAR();
  { EpiOut E; E.p = p; run_gemm(smem, (const bf16_t*)(p.ws + WS_MG), (const bf16_t*)(p.ws + WS_WT) + (size_t)2 * 1024 * 1024, MP, 1024, E); }
  small_gemm<2>(p, (const bf16_t*)(p.ws + WS_MG), (const bf16_t*)(p.ws + WS_WT) + (size_t)2 * 1024 * 1024);
  XBAR();
  phase4(p);
}

extern "C" void kernel_launch(void* const* d_in, const int* in_sizes, int n_in, void* d_out, int out_size, void* d_ws, size_t ws_size, hipStream_t stream) {
  static int grid_blocks = 0;
  if (grid_blocks == 0) {
    if (n_in != 22 || ws_size < WS_END) { fprintf(stderr, "kernel_launch: unexpected n_in %d / ws_size %zu (need %zu)\n", n_in, ws_size, (size_t)WS_END); grid_blocks = -1; return; }
    int dev = 0, cus = 0, per_cu = 0;
    (void)hipGetDevice(&dev);
    (void)hipDeviceGetAttribute(&cus, hipDeviceAttributeMultiprocessorCount, dev);
    (void)hipFuncSetAttribute((const void*)mega, hipFuncAttributeMaxDynamicSharedMemorySize, SMEM_BYTES);
    (void)hipOccupancyMaxActiveBlocksPerMultiprocessor(&per_cu, (const void*)mega, NT, SMEM_BYTES);
    (void)hipGetLastError();
    grid_blocks = cus;
  }
  if (grid_blocks < 0) return;
  Params p{};
  for (int i = 0; i < 22; ++i) p.in[i] = (const float*)d_in[i];
  p.out = (float*)d_out; p.ws = (unsigned char*)d_ws;
  void* args[] = {&p};
  hipError_t e = hipLaunchCooperativeKernel((const void*)mega, dim3(grid_blocks), dim3(NT), args, SMEM_BYTES, stream);
  if (e != hipSuccess) fprintf(stderr, "cooperative launch failed: %s (grid %d)\n", hipGetErrorString(e), grid_blocks);
}
```

```cpp
#include <hip/hip_runtime.h>
#include <hip/hip_cooperative_groups.h>
#include <cstdio>
#include <cstdint>
namespace cg = cooperative_groups;
__device__ __forceinline__ int lane_id_() { return (int)__builtin_amdgcn_mbcnt_hi(~0u, __builtin_amdgcn_mbcnt_lo(~0u, 0u)); }
#define TIDX (__builtin_amdgcn_readfirstlane((int)(threadIdx.x >> 6)) * 64 + lane_id_())

namespace pg8 {
#define PG8_LAS __attribute__((address_space(3)))
typedef unsigned short bf16_t;
typedef short bf16x8 __attribute__((ext_vector_type(8)));
typedef float f32x4 __attribute__((ext_vector_type(4)));
typedef unsigned u32x4 __attribute__((ext_vector_type(4)));
constexpr int BM = 256, BK = 64, HALF = 128, HTB = HALF * BK * 2  , STAGE_BYTES = 8 * HTB, NXCD = 8, WGM = 8;

__host__ __device__ __forceinline__ int lds_byte(int r, int c) { const int st = (r >> 4) * 2 + (c >> 5), rr = r & 15, cc = c & 31, ob = rr * 64 + cc * 2; return st * 1024 + (ob ^ (((ob >> 9) & 1) << 5)); }
__host__ __device__ __forceinline__ void stage_rc(int b, int& R, int& C) { const int st = b / 1024, sb = b % 1024, swz = sb ^ (((sb >> 9) & 1) << 5); R = (st >> 1) * 16 + swz / 64; C = (st & 1) * 32 + (swz % 64) / 2; }
__host__ __device__ __forceinline__ int perm32(int rho) { const int n = rho >> 4, i = rho & 15; return 8 * (i >> 2) + 4 * n + (i & 3); }

struct Unit { int pm, pn; };
struct Gemm { const bf16_t* A; const bf16_t* Bt; int M, N, K; };

struct StaticOrder {
    int nM, nN, nwg, G, c;
    __host__ __device__ void init(int M, int N, int G_, int c_) { nM = M / BM; nN = N / BM; nwg = nM * nN; G = G_; c = c_; }
    __host__ __device__ bool next(int i, Unit& u) const {
        const long L = (long)i * G + c; if (L >= nwg) return false;
        int wgid = (int)L; { const int q = nwg / NXCD, r = nwg % NXCD, xcd = wgid % NXCD, off = wgid / NXCD; wgid = (xcd < r ? xcd * (q + 1) : r * (q + 1) + (xcd - r) * q) + off; }
        const int nig = WGM * nN, gid = wgid / nig, fm = gid * WGM, gsz = (nM - fm) < WGM ? (nM - fm) : WGM;
        u.pm = fm + ((wgid % nig) % gsz); u.pn = (wgid % nig) / gsz; return true;
    }
    __device__ __forceinline__ void a_ready(const Unit&) const {}
    __device__ __forceinline__ void done(const Unit&) const {}
};


template <class Epi, class Sched, bool ALIGN_EPI = false, bool SP2 = false>
__device__ __forceinline__ void gemm_phase(PG8_LAS unsigned char* lds, const Gemm g, const Sched& S, const Epi& E) {
    int tid_ = TIDX; asm volatile("" : "+v"(tid_));
    const int tid = tid_, wid = __builtin_amdgcn_readfirstlane(tid >> 6), lane = tid & 63, wr = wid >> 2, wc = wid & 3, fr = lane & 15, fq = lane >> 4;
    const int K = g.K, nt = K / BK;
    unsigned voffA[2], voffB[2];
#pragma unroll
    for (int i = 0; i < 2; ++i) { int R, C; stage_rc(tid * 16 + i * 8192, R, C); const int Rb = Epi::PERM ? ((R & ~31) + perm32(R & 31)) : R;
        voffA[i] = (unsigned)(R * K + C) * 2u; voffB[i] = (unsigned)(Rb * K + C) * 2u; }
    const size_t kstep = (size_t)(BK * 2);
    const size_t hstep = (size_t)HALF * K * 2;
    const size_t tstep = 2 * hstep;
    const unsigned ldsw = (unsigned)wid * 1024u;
    const int aoff = lds_byte(wr * 64 + fr, fq * 8), boff = lds_byte(wc * 32 + fr, fq * 8);
#define PG8_SA(b, h) (((b) * 2 + (h)) * HTB)
#define PG8_SB(b, h) ((4 + (b) * 2 + (h)) * HTB)
#define PG8_STAGE(bufoff, gbase, voff) do { _Pragma("unroll") for (int _i = 0; _i < 2; ++_i) \
        __builtin_amdgcn_global_load_lds((const unsigned*)((const char*)(gbase) + (voff)[_i]), (PG8_LAS unsigned*)(lds + (bufoff) + ldsw + _i * 8192), 16, 0, 0); } while (0)
#define PG8_LDA(dst, b, h) do { _Pragma("unroll") for (int m = 0; m < 4; ++m) _Pragma("unroll") for (int k = 0; k < 2; ++k) dst[m][k] = *(const PG8_LAS bf16x8*)(lds + PG8_SA(b, h) + aoff + m * 2048 + k * 1024); } while (0)
#define PG8_LDB(dst, b, h) do { _Pragma("unroll") for (int n = 0; n < 2; ++n) _Pragma("unroll") for (int k = 0; k < 2; ++k) dst[n][k] = *(const PG8_LAS bf16x8*)(lds + PG8_SB(b, h) + boff + n * 2048 + k * 1024); } while (0)
#define PG8_MMA(ai, bj, At, Bt) do { __builtin_amdgcn_s_setprio(1); _Pragma("unroll") for (int m = 0; m < 4; ++m) _Pragma("unroll") for (int n = 0; n < 2; ++n) _Pragma("unroll") for (int k = 0; k < 2; ++k) \
        acc[ai][bj][m][n] = __builtin_amdgcn_mfma_f32_16x16x32_bf16(Bt[n][k], At[m][k], acc[ai][bj][m][n], 0, 0, 0); __builtin_amdgcn_s_setprio(0); } while (0)
#define PG8_WAIT_V(n) asm volatile("s_waitcnt vmcnt(" #n ")" ::: "memory")
#define PG8_WAIT_L(n) asm volatile("s_waitcnt lgkmcnt(" #n ")" ::: "memory")
#define PG8_BAR __builtin_amdgcn_s_barrier()
#define PG8_SCHED __builtin_amdgcn_sched_barrier(0)
    Unit cur, nxt; int ui = 0;
    if (!S.next(0, cur)) return;
    f32x4 acc[2][2][4][2];
#pragma unroll
    for (int a = 0; a < 2; ++a)
#pragma unroll
        for (int b = 0; b < 2; ++b)
#pragma unroll
            for (int m = 0; m < 4; ++m)
#pragma unroll
                for (int n = 0; n < 2; ++n) acc[a][b][m][n] = (f32x4){0.f, 0.f, 0.f, 0.f};
    bf16x8 At[4][2], B0[2][2], B1[2][2];
    const char* cA = (const char*)g.A + (size_t)cur.pm * tstep; const char* cB = (const char*)g.Bt + (size_t)cur.pn * tstep;
    S.a_ready(cur);
    if constexpr (SP2) {
        PG8_STAGE(PG8_SB(0, 0), cB, voffB); PG8_STAGE(PG8_SB(0, 1), cB + hstep, voffB); PG8_STAGE(PG8_SA(0, 0), cA, voffA); PG8_STAGE(PG8_SA(0, 1), cA + hstep, voffA);
        if (wr == 1) PG8_BAR;
        PG8_WAIT_V(2); PG8_BAR;
        PG8_STAGE(PG8_SB(1, 0), cB + kstep, voffB); PG8_STAGE(PG8_SA(1, 0), cA + kstep, voffA); PG8_STAGE(PG8_SB(1, 1), cB + hstep + kstep, voffB);
        PG8_WAIT_V(6); PG8_BAR;
    } else {
        PG8_STAGE(PG8_SB(0, 0), cB, voffB); PG8_STAGE(PG8_SA(0, 0), cA, voffA); PG8_STAGE(PG8_SB(0, 1), cB + hstep, voffB); PG8_STAGE(PG8_SA(0, 1), cA + hstep, voffA);
        if (wr == 1) PG8_BAR;
        PG8_WAIT_V(4); PG8_BAR;
        PG8_STAGE(PG8_SB(1, 0), cB + kstep, voffB); PG8_STAGE(PG8_SA(1, 0), cA + kstep, voffA); PG8_STAGE(PG8_SB(1, 1), cB + hstep + kstep, voffB);
        PG8_WAIT_V(6); PG8_BAR;
    }
    for (;;) {
        const bool has_next = S.next(ui + 1, nxt);
        const char* nA = has_next ? (const char*)g.A + (size_t)nxt.pm * tstep : cA; const char* nB = has_next ? (const char*)g.Bt + (size_t)nxt.pn * tstep : cB;
        for (int t = 0; t < nt; t += 2) {
            const bool last = (t == nt - 2);
            const char* a1 = cA + (size_t)(t + 1) * kstep;
            const char* a2 = last ? nA : cA + (size_t)(t + 2) * kstep; const char* b2 = last ? nB : cB + (size_t)(t + 2) * kstep;
            const char* a3 = a2 + kstep; const char* b3 = b2 + kstep;
            if (last && has_next) S.a_ready(nxt);
            if constexpr (SP2) {
            PG8_LDB(B0, 0, 0); PG8_LDB(B1, 0, 1); PG8_SCHED; PG8_LDA(At, 0, 0); PG8_STAGE(PG8_SA(1, 1), a1 + hstep, voffA);
            PG8_WAIT_V(8); PG8_WAIT_L(0); PG8_BAR; PG8_MMA(0, 0, At, B0); PG8_MMA(0, 1, At, B1); PG8_BAR; PG8_SCHED;
            PG8_LDA(At, 0, 1); PG8_STAGE(PG8_SB(0, 0), b2, voffB); PG8_STAGE(PG8_SB(0, 1), b2 + hstep, voffB); PG8_STAGE(PG8_SA(0, 0), a2, voffA);
            PG8_WAIT_V(8); PG8_WAIT_L(0); PG8_BAR; PG8_MMA(1, 0, At, B0); PG8_MMA(1, 1, At, B1); PG8_BAR; PG8_SCHED;
            PG8_LDB(B0, 1, 0); PG8_LDB(B1, 1, 1); PG8_SCHED; PG8_LDA(At, 1, 0); PG8_STAGE(PG8_SA(0, 1), a2 + hstep, voffA);
            PG8_WAIT_V(8); PG8_WAIT_L(0); PG8_BAR; PG8_MMA(0, 0, At, B0); PG8_MMA(0, 1, At, B1); PG8_BAR; PG8_SCHED;
            PG8_LDA(At, 1, 1); PG8_STAGE(PG8_SB(1, 0), b3, voffB); PG8_STAGE(PG8_SB(1, 1), b3 + hstep, voffB); PG8_STAGE(PG8_SA(1, 0), a3, voffA);
            PG8_WAIT_V(8); PG8_WAIT_L(0); PG8_BAR; PG8_MMA(1, 0, At, B0); PG8_MMA(1, 1, At, B1); PG8_BAR; PG8_SCHED;
            } else {
            PG8_LDB(B0, 0, 0); PG8_SCHED; PG8_LDA(At, 0, 0); PG8_STAGE(PG8_SA(1, 1), a1 + hstep, voffA);
            PG8_WAIT_L(8); PG8_BAR; PG8_WAIT_L(0); PG8_MMA(0, 0, At, B0); PG8_BAR; PG8_SCHED;
            PG8_LDB(B1, 0, 1); PG8_STAGE(PG8_SB(0, 0), b2, voffB);
            PG8_BAR; PG8_WAIT_L(0); PG8_MMA(0, 1, At, B1); PG8_BAR;
            PG8_LDA(At, 0, 1); PG8_STAGE(PG8_SA(0, 0), a2, voffA);
            PG8_BAR; PG8_WAIT_L(0); PG8_MMA(1, 0, At, B0); PG8_BAR; PG8_SCHED;
            PG8_STAGE(PG8_SB(0, 1), b2 + hstep, voffB);
            PG8_WAIT_V(6); PG8_BAR; PG8_MMA(1, 1, At, B1); PG8_BAR;
            PG8_LDB(B0, 1, 0); PG8_SCHED; PG8_LDA(At, 1, 0); PG8_STAGE(PG8_SA(0, 1), a2 + hstep, voffA);
            PG8_WAIT_L(8); PG8_BAR; PG8_WAIT_L(0); PG8_MMA(0, 0, At, B0); PG8_BAR; PG8_SCHED;
            PG8_LDB(B1, 1, 1); PG8_STAGE(PG8_SB(1, 0), b3, voffB);
            PG8_BAR; PG8_WAIT_L(0); PG8_MMA(0, 1, At, B1); PG8_BAR;
            PG8_LDA(At, 1, 1); PG8_STAGE(PG8_SA(1, 0), a3, voffA);
            PG8_BAR; PG8_WAIT_L(0); PG8_MMA(1, 0, At, B0); PG8_BAR; PG8_SCHED;
            PG8_STAGE(PG8_SB(1, 1), b3 + hstep, voffB);
            PG8_WAIT_V(6); PG8_BAR; PG8_MMA(1, 1, At, B1); PG8_BAR;
            }
        }
        if constexpr (ALIGN_EPI) { if (wr == 0) PG8_BAR; }
        if constexpr (!Epi::AFTER_DRAIN) { E(acc, cur, wr, wc, fr, fq); S.done(cur); }
        if (!has_next) break;
#pragma unroll
        for (int a = 0; a < 2; ++a)
#pragma unroll
            for (int b = 0; b < 2; ++b)
#pragma unroll
                for (int m = 0; m < 4; ++m)
#pragma unroll
                    for (int n = 0; n < 2; ++n) acc[a][b][m][n] = (f32x4){0.f, 0.f, 0.f, 0.f};
        cur = nxt; cA = nA; cB = nB; ++ui;
        if constexpr (ALIGN_EPI) { if (wr == 1) PG8_BAR; }
    }
    PG8_WAIT_V(0);
    if constexpr (!ALIGN_EPI) { if (wr == 0) PG8_BAR; }
    PG8_BAR;
    if constexpr (Epi::AFTER_DRAIN) { E.fused(acc, cur, wr, wc, fr, fq, lds, wid, lane); S.done(cur); }
#undef PG8_SA
#undef PG8_SB
#undef PG8_STAGE
#undef PG8_LDA
#undef PG8_LDB
#undef PG8_MMA
#undef PG8_WAIT_V
#undef PG8_WAIT_L
#undef PG8_BAR
#undef PG8_SCHED
}
}


#define DI __device__ __forceinline__
typedef unsigned short bf16_t;
typedef short bf16x8 __attribute__((ext_vector_type(8)));
typedef float f32x4 __attribute__((ext_vector_type(4)));
typedef float f32x2 __attribute__((ext_vector_type(2)));
typedef float f32x16 __attribute__((ext_vector_type(16)));
typedef unsigned u32x4 __attribute__((ext_vector_type(4)));
#define MFMA32(a, b, c) __builtin_amdgcn_mfma_f32_32x32x16_bf16((a), (b), (c), 0, 0, 0)
#define LAS __attribute__((address_space(3)))

constexpr int NT = 512;
constexpr int DM = 1024, MP = 16384, MT = 16896;
constexpr int NIN = 10368, NINP = 10496, CSH = 4224;
constexpr float EPS = 1e-6f, LNX_EPS = 64e-5f;
constexpr float QSCALE = 0.18033688011112042f;

constexpr size_t OUT_YP = 0, OUT_KP = 17301504, OUT_VP = 34078720, OUT_SHP = 50855936, OUT_WP = 50872832,
                 OUT_KS = 51134976, OUT_VS = 51659264, OUT_SHS = 52183552, OUT_WS = 52318720;

constexpr size_t SZ_ACT = (size_t)MT * 1024 * 2;
constexpr size_t WS_R1 = 0;
constexpr size_t WS_H = WS_R1, WS_WINT = WS_R1 + SZ_ACT, WS_SW = WS_R1;
constexpr size_t WS_R2 = (size_t)MT * 1024 * 4;
constexpr size_t WS_PB = WS_R2, WS_ORAW = WS_R2, WS_OB = WS_ORAW + (size_t)MT * 1024 * 4, WS_MG = WS_OB + SZ_ACT;
constexpr size_t WS_R3 = WS_R2 + (size_t)MT * CSH * 2;
constexpr size_t WS_QB = WS_R3, WS_X = WS_QB + SZ_ACT  , WS_BTL = WS_X + (size_t)MT * 256 * 2  , WS_SZA = WS_X + (size_t)MP * 1024 * 2;
static_assert(WS_BTL + (size_t)2048 * 256 * 2 <= WS_SZA, "LoRA buffers");
constexpr size_t WS_SR = WS_SZA + SZ_ACT, WS_SK = WS_SR + SZ_ACT, WS_SV = WS_SK + SZ_ACT, WS_SKK = WS_SV + SZ_ACT, WS_SB = WS_SKK + SZ_ACT;
constexpr size_t WS_SZB = WS_SB + SZ_ACT;
constexpr size_t WS_BONUS = WS_SZB + SZ_ACT;
constexpr size_t WS_WT = WS_BONUS + (size_t)MT * 16 * 4;
constexpr size_t WS_CTL = WS_WT + 3 * (size_t)1024 * 1024 * 2;
constexpr size_t WS_END = WS_CTL + 65536;
static_assert(WS_MG + SZ_ACT <= WS_R3, "R2 overflow");
static_assert(WS_WINT + (size_t)NINP * 1024 * 2 <= WS_R2, "R1 overflow");
static_assert(WS_END <= (size_t)512 * 1024 * 1024, "workspace");

constexpr int SMEM_BYTES = 147456;

struct Params { const float* in[22]; float* out; unsigned char* ws; };

DI float bf2f(bf16_t u) { return __uint_as_float((unsigned)u << 16); }
DI unsigned cvtpk(float lo, float hi) { unsigned r; asm volatile("v_cvt_pk_bf16_f32 %0, %1, %2" : "=v"(r) : "v"(lo), "v"(hi)); return r; }
DI bf16_t f2bf(float x) { return (bf16_t)(cvtpk(x, 0.f) & 0xffffu); }
DI float bflo(unsigned u) { return __uint_as_float(u << 16); }
DI float bfhi(unsigned u) { return __uint_as_float(u & 0xffff0000u); }
DI int crow(int i, int h) { return (i & 3) + 8 * (i >> 2) + 4 * h; }
DI float sigmoidf_(float x) { return fminf(__builtin_amdgcn_rcpf(1.f + __expf(-x)), 1.f); }
DI uint4 pack8(f32x4 a, f32x4 b) { return make_uint4(cvtpk(a[0], a[1]), cvtpk(a[2], a[3]), cvtpk(b[0], b[1]), cvtpk(b[2], b[3])); }
template <int CTRL> DI float dppf(float x) { return __builtin_bit_cast(float, __builtin_amdgcn_mov_dpp(__builtin_bit_cast(int, x), CTRL, 0xf, 0xf, true)); }
DI float sum16(float x) { x += dppf<0xB1>(x); x += dppf<0x4E>(x); x += dppf<0x124>(x); x += dppf<0x128>(x); return x; }
DI float wave_sum(float x) {
  x = sum16(x);
  const auto s = __builtin_amdgcn_permlane16_swap(__float_as_uint(x), __float_as_uint(x), false, false);
  x = __uint_as_float(s[0]) + __uint_as_float(s[1]);
  const auto t = __builtin_amdgcn_permlane32_swap(__float_as_uint(x), __float_as_uint(x), false, false);
  return __uint_as_float(t[0]) + __uint_as_float(t[1]);
}
DI float row32_sum(float x) {
  x += dppf<0xB1>(x);
  x += dppf<0x4E>(x);
  x += dppf<0x124>(x);
  x += dppf<0x128>(x);
  const auto s = __builtin_amdgcn_permlane16_swap(__float_as_uint(x), __float_as_uint(x), false, false);
  return __uint_as_float(s[0]) + __uint_as_float(s[1]);
}
DI size_t hm_base(int row) {
  if (row < MP) { const int b = row >> 12, t = row & 4095; return ((size_t)(b * 16) * 4096 + t) * 64; }
  const int rs = row - MP, b = rs >> 4, t = rs & 15; return (size_t)MP * 1024 + ((size_t)(b * 16) * 16 + t) * 64;
}
DI size_t hm_hstride(int row) { return row < MP ? (size_t)4096 * 64 : (size_t)16 * 64; }

DI void p0_rmsnorm_rows(const Params& p, int item) {
  const int lane = TIDX & 63, wid = TIDX >> 6;
  const int row = item * 8 + wid;
  const float* x = row < MP ? p.in[0] + (size_t)row * DM : p.in[1] + (size_t)(row - MP) * DM;
  const float* g = p.in[6];
  float4 v[4]; float ss = 0.f;
#pragma unroll
  for (int i = 0; i < 4; ++i) { v[i] = *(const float4*)(x + i * 256 + lane * 4); ss += v[i].x * v[i].x + v[i].y * v[i].y + v[i].z * v[i].z + v[i].w * v[i].w; }
  ss = wave_sum(ss);
  const float inv = rsqrtf(ss * (1.f / DM) + EPS);
  bf16_t* H = (bf16_t*)(p.ws + WS_H) + (size_t)row * DM;
#pragma unroll
  for (int i = 0; i < 4; ++i) {
    const float4 gg = *(const float4*)(g + i * 256 + lane * 4);
    uint2 o; o.x = cvtpk(v[i].x * inv * gg.x, v[i].y * inv * gg.y); o.y = cvtpk(v[i].z * inv * gg.z, v[i].w * inv * gg.w);
    *(uint2*)(H + i * 256 + lane * 4) = o;
  }
}
DI void p0_transpose_tile(const float* src, bf16_t* dst, int N, int kt, int nt, float* lds) {
  const int tid = TIDX & 255;
  const int k0 = kt * 64, n0 = nt * 64;
#pragma unroll
  for (int i = 0; i < 4; ++i) {
    const int row = (tid >> 4) + 16 * i, c4 = (tid & 15) * 4;
    const float4 v = *(const float4*)(src + (size_t)(k0 + row) * N + n0 + c4);
    lds[row * 65 + c4 + 0] = v.x; lds[row * 65 + c4 + 1] = v.y; lds[row * 65 + c4 + 2] = v.z; lds[row * 65 + c4 + 3] = v.w;
  }
  __syncthreads();
  const int n = tid >> 2, kc = (tid & 3) * 16;
  unsigned w[8];
#pragma unroll
  for (int j = 0; j < 8; ++j) w[j] = cvtpk(lds[(kc + 2 * j) * 65 + n], lds[(kc + 2 * j + 1) * 65 + n]);
  uint4* d = (uint4*)(dst + (size_t)(n0 + n) * 1024 + k0 + kc);
  d[0] = make_uint4(w[0], w[1], w[2], w[3]); d[1] = make_uint4(w[4], w[5], w[6], w[7]);
  __syncthreads();
}
DI void phase0(const Params& p, char* smem) {
  {
    bf16_t* BL = (bf16_t*)(p.ws + WS_BTL);
    for (int i = blockIdx.x * NT + TIDX; i < 2048 * 256; i += gridDim.x * NT) {
      const int n = i >> 8, k = i & 255;
      float v = 0.f;
      if (n < 1024) { if (k < 64) v = p.in[10][(size_t)k * 1024 + n]; }
      else if (k >= 64 && k < 128) v = p.in[12][(size_t)(k - 64) * 1024 + (n - 1024)];
      BL[i] = f2bf(v);
    }
  }
  constexpr int N_ROWS = MT / 8, N_TIN = 16 * 162 / 2, N_TSQ = 256 / 2;
  constexpr int N_ITEMS = N_ROWS + N_TIN + 3 * N_TSQ;
  const int half = TIDX >> 8;
  float* scr = (float*)smem + half * (64 * 65);
  for (int it = blockIdx.x; it < N_ITEMS; it += gridDim.x) {
    if (it < N_ROWS) { p0_rmsnorm_rows(p, it); continue; }
    int j = it - N_ROWS;
    if (j < N_TIN) { const int t = 2 * j + half; p0_transpose_tile(p.in[7], (bf16_t*)(p.ws + WS_WINT), NIN, t / 162, t % 162, scr); continue; }
    j -= N_TIN;
    const int w = j / N_TSQ; const int t = 2 * (j % N_TSQ) + half;
    p0_transpose_tile(p.in[18 + w], (bf16_t*)(p.ws + WS_WT) + (size_t)w * 1024 * 1024, 1024, t >> 4, t & 15, scr);
  }
}

struct EpiP1 {
  static constexpr bool PERM = true, AFTER_DRAIN = false;
  Params p;
  DI void operator()(const pg8::f32x4 (&acc)[2][2][4][2], const pg8::Unit& u, int wr, int wc, int fr, int fq) const {
    const int colt = u.pn * 256;
    const int region = colt >> 10;
#pragma unroll
    for (int ai = 0; ai < 2; ++ai)
#pragma unroll
      for (int m = 0; m < 4; ++m) {
        const int row = u.pm * 256 + ai * 128 + wr * 64 + m * 16 + fr;
        const bool prompt = row < MP;
        const int rs = row - MP;
#pragma unroll
        for (int bj = 0; bj < 2; ++bj) {
          const int col = colt + bj * 128 + wc * 32 + 8 * fq;
          const f32x4 v0 = acc[ai][bj][m][0], v1 = acc[ai][bj][m][1];
          if (region >= 6) {
            const int pc = col - 6144;
            if (pc < CSH) {
              *(uint4*)((bf16_t*)(p.ws + WS_PB) + (size_t)row * CSH + pc) = pack8(v0, v1);
              float* so = nullptr;
              if (prompt) { if ((row & 4095) == 4095) so = p.out + OUT_SHP + (size_t)(row >> 12) * CSH + pc; }
              else if ((rs & 15) == 15) so = p.out + OUT_SHS + (size_t)(rs >> 4) * CSH + pc;
              if (so) { *(f32x4*)so = v0; *(f32x4*)(so + 4) = v1; }
            }
          } else if (region == 0) {
            *(uint4*)((bf16_t*)(p.ws + WS_QB) + (size_t)row * 1024 + col) = pack8(v0 * QSCALE, v1 * QSCALE);
          } else if (region == 1) {
            const int c = col - 1024, hh = c >> 6, d = c & 63;
            float* o = prompt ? p.out + OUT_KP + (((size_t)(row >> 12) * 16 + hh) * 4096 + (row & 4095)) * 64 + d
                              : p.out + OUT_KS + (((size_t)(rs >> 4) * 16 + hh) * 16 + (rs & 15)) * 64 + d;
            __builtin_nontemporal_store(v0, (f32x4*)o); __builtin_nontemporal_store(v1, (f32x4*)(o + 4));
          } else if (region == 2) {
            const int c = col - 2048, hh = c >> 6, d = c & 63;
            float* o = prompt ? p.out + OUT_VP + (((size_t)(row >> 12) * 16 + hh) * 4096 + (row & 4095)) * 64 + d
                              : p.out + OUT_VS + (((size_t)(rs >> 4) * 16 + hh) * 16 + (rs & 15)) * 64 + d;
            __builtin_nontemporal_store(v0, (f32x4*)o); __builtin_nontemporal_store(v1, (f32x4*)(o + 4));
          } else if (region == 3) {
            f32x4 a, b;
#pragma unroll
            for (int j = 0; j < 4; ++j) { a[j] = v0[j] * sigmoidf_(v0[j]); b[j] = v1[j] * sigmoidf_(v1[j]); }
            *(uint4*)((bf16_t*)(p.ws + WS_SZA) + (size_t)row * 1024 + (col - 3072)) = pack8(a, b);
          } else {
            f32x4 a, b;
#pragma unroll
            for (int j = 0; j < 4; ++j) { a[j] = sigmoidf_(v0[j]); b[j] = sigmoidf_(v1[j]); }
            *(uint4*)((bf16_t*)p.out + (size_t)row * 2048 + (col - 4096)) = pack8(a, b);
          }
        }
      }
  }
};
struct EpiGate {
  static constexpr bool PERM = true, AFTER_DRAIN = false;
  Params p; int goff; bool first;
  DI void operator()(const pg8::f32x4 (&acc)[2][2][4][2], const pg8::Unit& u, int wr, int wc, int fr, int fq) const {
    const bf16_t* G = (const bf16_t*)p.out; bf16_t* MG = (bf16_t*)(p.ws + WS_MG);
#pragma unroll
    for (int ai = 0; ai < 2; ++ai)
#pragma unroll
      for (int m = 0; m < 4; ++m) {
        const size_t row = u.pm * 256 + ai * 128 + wr * 64 + m * 16 + fr;
#pragma unroll
        for (int bj = 0; bj < 2; ++bj) {
          const int col = u.pn * 256 + bj * 128 + wc * 32 + 8 * fq;
          const uint4 g = *(const uint4*)(G + row * 2048 + goff + col);
          f32x4 a = acc[ai][bj][m][0], b = acc[ai][bj][m][1];
          a[0] *= bflo(g.x); a[1] *= bfhi(g.x); a[2] *= bflo(g.y); a[3] *= bfhi(g.y);
          b[0] *= bflo(g.z); b[1] *= bfhi(g.z); b[2] *= bflo(g.w); b[3] *= bfhi(g.w);
          if (!first) {
            const uint4 o = *(const uint4*)(MG + row * 1024 + col);
            a[0] += bflo(o.x); a[1] += bfhi(o.x); a[2] += bflo(o.y); a[3] += bfhi(o.y);
            b[0] += bflo(o.z); b[1] += bfhi(o.z); b[2] += bflo(o.w); b[3] += bfhi(o.w);
          }
          *(uint4*)(MG + row * 1024 + col) = pack8(a, b);
        }
      }
  }
};
struct EpiOut {
  static constexpr bool PERM = true, AFTER_DRAIN = false;
  Params p;
  DI void operator()(const pg8::f32x4 (&acc)[2][2][4][2], const pg8::Unit& u, int wr, int wc, int fr, int fq) const {
#pragma unroll
    for (int ai = 0; ai < 2; ++ai)
#pragma unroll
      for (int m = 0; m < 4; ++m) {
        const int row = u.pm * 256 + ai * 128 + wr * 64 + m * 16 + fr;
        const float* xr = row < MP ? p.in[0] + (size_t)row * 1024 : p.in[1] + (size_t)(row - MP) * 1024;
        float* orow = p.out + OUT_YP + (size_t)row * 1024;
#pragma unroll
        for (int bj = 0; bj < 2; ++bj) {
          const int col = u.pn * 256 + bj * 128 + wc * 32 + 8 * fq;
          const f32x4 x0 = *(const f32x4*)(xr + col), x1 = *(const f32x4*)(xr + col + 4);
          *(f32x4*)(orow + col) = x0 + acc[ai][bj][m][0]; *(f32x4*)(orow + col + 4) = x1 + acc[ai][bj][m][1];
        }
      }
  }
};
template <class Epi>
DI void run_gemm(char* smem, const bf16_t* A, const bf16_t* Bt, int M, int N, const Epi& E, int K = 1024) {
  pg8::Gemm g; g.A = A; g.Bt = Bt; g.M = M; g.N = N; g.K = K;
  pg8::StaticOrder S; S.init(M, N, (int)gridDim.x, (int)blockIdx.x);
  pg8::gemm_phase<Epi, pg8::StaticOrder, true, true>((LAS unsigned char*)smem, g, S, E);
  __syncthreads();
}

template <int MODE>
DI void small_gemm(const Params& p, const bf16_t* A, const bf16_t* Bt) {
  int t_ = TIDX; asm volatile("" : "+v"(t_));
  const int lane = t_ & 63, wid = __builtin_amdgcn_readfirstlane(t_ >> 6), fr = lane & 15, fq = lane >> 4;
  for (int tile = wid * gridDim.x + blockIdx.x; tile < 2048; tile += 8 * gridDim.x) {
    const int row0 = MP + (tile >> 6) * 16, col0 = (tile & 63) * 16;
    const bf16_t* pa = A + (size_t)(row0 + fr) * 1024 + 8 * fq;
    const bf16_t* pb = Bt + (size_t)(col0 + fr) * 1024 + 8 * fq;
    f32x4 acc = {0.f, 0.f, 0.f, 0.f};
#pragma unroll 8
    for (int s = 0; s < 32; ++s) acc = __builtin_amdgcn_mfma_f32_16x16x32_bf16(*(const bf16x8*)(pa + 32 * s), *(const bf16x8*)(pb + 32 * s), acc, 0, 0, 0);
    const int col = col0 + fr;
#pragma unroll
    for (int j = 0; j < 4; ++j) {
      const size_t row = row0 + 4 * fq + j;
      if (MODE == 2) p.out[OUT_YP + row * 1024 + col] = p.in[1][(row - MP) * 1024 + col] + acc[j];
      else {
        bf16_t* mg = (bf16_t*)(p.ws + WS_MG) + row * 1024 + col;
        const float g = bf2f(((const bf16_t*)p.out)[row * 2048 + (MODE == 1 ? 1024 : 0) + col]);
        *mg = f2bf((MODE == 1 ? bf2f(*mg) : 0.f) + acc[j] * g);
      }
    }
  }
}

DI float tanh_fast(float x) { return 1.f - 2.f * __builtin_amdgcn_rcpf(1.f + __expf(2.f * x)); }
DI void phase_x(const Params& p) {
  const bf16_t* PB = (const bf16_t*)(p.ws + WS_PB);
  bf16_t* X = (bf16_t*)(p.ws + WS_X);
  const float* mu = p.in[8];
  for (int i = blockIdx.x * NT + TIDX; i < MT * 32; i += gridDim.x * NT) {
    const int row = i >> 5, g = i & 31;
    uint4 o = make_uint4(0u, 0u, 0u, 0u);
    if (g < 16) {
      const int col = 3072 + g * 8;
      const bool prompt = row < MP;
      const int t = prompt ? (row & 4095) : ((row - MP) & 15);
      const uint4 a = *(const uint4*)(PB + (size_t)row * CSH + col);
      float c[8] = {bflo(a.x), bfhi(a.x), bflo(a.y), bfhi(a.y), bflo(a.z), bfhi(a.z), bflo(a.w), bfhi(a.w)}, q[8];
      if (t != 0) { const uint4 b = *(const uint4*)(PB + (size_t)(row - 1) * CSH + col); q[0] = bflo(b.x); q[1] = bfhi(b.x); q[2] = bflo(b.y); q[3] = bfhi(b.y); q[4] = bflo(b.z); q[5] = bfhi(b.z); q[6] = bflo(b.w); q[7] = bfhi(b.w); }
      else if (prompt) {
#pragma unroll
        for (int j = 0; j < 8; ++j) q[j] = 0.f;
      } else { const float* s = p.in[4] + (size_t)((row - MP) >> 4) * CSH + col; const float4 b0 = *(const float4*)s, b1 = *(const float4*)(s + 4); q[0] = b0.x; q[1] = b0.y; q[2] = b0.z; q[3] = b0.w; q[4] = b1.x; q[5] = b1.y; q[6] = b1.z; q[7] = b1.w; }
      const float4 u0 = *(const float4*)(mu + col), u1 = *(const float4*)(mu + col + 4);
      const float u[8] = {u0.x, u0.y, u0.z, u0.w, u1.x, u1.y, u1.z, u1.w};
      float m[8];
#pragma unroll
      for (int j = 0; j < 8; ++j) { m[j] = c[j] + u[j] * (q[j] - c[j]); if (g < 8) m[j] = tanh_fast(m[j]); }
      o = make_uint4(cvtpk(m[0], m[1]), cvtpk(m[2], m[3]), cvtpk(m[4], m[5]), cvtpk(m[6], m[7]));
    }
    *(uint4*)(X + (size_t)row * 256 + g * 8) = o;
  }
}
struct EpiLora {
  static constexpr bool PERM = true, AFTER_DRAIN = false;
  Params p;
  DI void operator()(const pg8::f32x4 (&acc)[2][2][4][2], const pg8::Unit& u, int wr, int wc, int fr, int fq) const {
    const bool isw = u.pn < 4;
#pragma unroll
    for (int ai = 0; ai < 2; ++ai)
#pragma unroll
      for (int m = 0; m < 4; ++m) {
        const int row = u.pm * 256 + ai * 128 + wr * 64 + m * 16 + fr;
        const size_t hb = hm_base(row), hs = hm_hstride(row);
#pragma unroll
        for (int bj = 0; bj < 2; ++bj) {
          const int c = (u.pn & 3) * 256 + bj * 128 + wc * 32 + 8 * fq;
          const size_t idx = hb + (c >> 6) * hs + (c & 63);
          const f32x4 v0 = acc[ai][bj][m][0], v1 = acc[ai][bj][m][1];
          if (isw) {
            const f32x4 b0 = *(const f32x4*)(p.in[9] + c), b1 = *(const f32x4*)(p.in[9] + c + 4);
            f32x4 d0, d1;
#pragma unroll
            for (int j = 0; j < 4; ++j) {
              const float x0 = -(b0[j] + v0[j]), x1 = -(b1[j] + v1[j]);
              const float s0 = fmaxf(x0, 0.f) + __logf(1.f + __expf(-fabsf(x0))), s1 = fmaxf(x1, 0.f) + __logf(1.f + __expf(-fabsf(x1)));
              d0[j] = __expf(-__expf(-s0 - 0.5f)); d1[j] = __expf(-__expf(-s1 - 0.5f));
            }
            float* o = (float*)(p.ws + WS_SW) + idx; *(f32x4*)o = d0; *(f32x4*)(o + 4) = d1;
          } else {
            const f32x4 b0 = *(const f32x4*)(p.in[11] + c), b1 = *(const f32x4*)(p.in[11] + c + 4);
            f32x4 d0, d1;
#pragma unroll
            for (int j = 0; j < 4; ++j) { d0[j] = sigmoidf_(b0[j] + v0[j]); d1[j] = sigmoidf_(b1[j] + v1[j]); }
            *(uint4*)((bf16_t*)(p.ws + WS_SB) + idx) = pack8(d0, d1);
          }
        }
      }
  }
};
DI void small_lora(const Params& p) {
  const int lane = TIDX & 63, wid = TIDX >> 6, r = lane & 31, h = lane >> 5;
  const bf16_t* X = (const bf16_t*)(p.ws + WS_X); const bf16_t* BL = (const bf16_t*)(p.ws + WS_BTL);
  for (int tile = wid * gridDim.x + blockIdx.x; tile < 16 * 64; tile += 8 * gridDim.x) {
    const int row0 = MP + (tile >> 6) * 32, ct = tile & 63, col0 = ct * 32, k0 = ct < 32 ? 0 : 64;
    const bf16_t* pa = X + (size_t)(row0 + r) * 256 + k0 + 8 * h;
    const bf16_t* pb = BL + (size_t)(col0 + r) * 256 + k0 + 8 * h;
    f32x16 acc;
#pragma unroll
    for (int i = 0; i < 16; ++i) acc[i] = 0.f;
#pragma unroll
    for (int s = 0; s < 4; ++s) acc = MFMA32(*(const bf16x8*)(pa + 16 * s), *(const bf16x8*)(pb + 16 * s), acc);
    const int c = (col0 + r) & 1023;
    const float bias = ct < 32 ? p.in[9][c] : p.in[11][c];
#pragma unroll
    for (int i = 0; i < 16; ++i) {
      const int row = row0 + crow(i, h);
      const size_t idx = hm_base(row) + (c >> 6) * hm_hstride(row) + (c & 63);
      const float v = bias + acc[i];
      if (ct < 32) {
        const float x = -v, sp = fmaxf(x, 0.f) + __logf(1.f + __expf(-fabsf(x)));
        ((float*)(p.ws + WS_SW))[idx] = __expf(-__expf(-sp - 0.5f));
      } else ((bf16_t*)(p.ws + WS_SB))[idx] = f2bf(sigmoidf_(v));
    }
  }
}

DI void phase1c(const Params& p) {
  const int tid = TIDX & 255, half = TIDX >> 8, c = tid * 4, hh = c >> 6;
  const bf16_t* PB = (const bf16_t*)(p.ws + WS_PB);
  const float* mu = p.in[8];
  const float4 kkw = *(const float4*)(p.in[13] + c), kaw = *(const float4*)(p.in[14] + c), rkw = *(const float4*)(p.in[15] + c);
  const float4 mur = *(const float4*)(mu + c), muk = *(const float4*)(mu + 1024 + c), muv = *(const float4*)(mu + 2048 + c), muz = *(const float4*)(mu + 3200 + c);
  const float kka[4] = {kkw.x, kkw.y, kkw.z, kkw.w}, kaa[4] = {kaw.x, kaw.y, kaw.z, kaw.w}, rka[4] = {rkw.x, rkw.y, rkw.z, rkw.w};
  const float mura[4] = {mur.x, mur.y, mur.z, mur.w}, muka[4] = {muk.x, muk.y, muk.z, muk.w}, muva[4] = {muv.x, muv.y, muv.z, muv.w}, muza[4] = {muz.x, muz.y, muz.z, muz.w};
  bf16_t* SR = (bf16_t*)(p.ws + WS_SR); bf16_t* SK = (bf16_t*)(p.ws + WS_SK); bf16_t* SV = (bf16_t*)(p.ws + WS_SV);
  bf16_t* SKK = (bf16_t*)(p.ws + WS_SKK); bf16_t* SB = (bf16_t*)(p.ws + WS_SB); bf16_t* SZB = (bf16_t*)(p.ws + WS_SZB);
  float* BONUS = (float*)(p.ws + WS_BONUS);
  for (int r4 = blockIdx.x * 2 + half; r4 < MT / 4; r4 += gridDim.x * 2) {
    const int row0 = r4 * 4;
    const bool prompt = row0 < MP;
    const int t0 = prompt ? (row0 & 4095) : ((row0 - MP) & 15);
    uint2 gr[5], gk[5], gv[5], gz[5], ga[4];
#pragma unroll
    for (int t = 0; t < 5; ++t) {
      const int rr_ = (t == 0 && t0 == 0) ? row0 : row0 + t - 1;
      const bf16_t* pc = PB + (size_t)rr_ * CSH;
      gr[t] = *(const uint2*)(pc + c); gk[t] = *(const uint2*)(pc + 1024 + c); gv[t] = *(const uint2*)(pc + 2048 + c); gz[t] = *(const uint2*)(pc + 3200 + c);
    }
    size_t idx[4];
#pragma unroll
    for (int t = 0; t < 4; ++t) { idx[t] = hm_base(row0 + t) + hh * hm_hstride(row0 + t) + (c & 63); ga[t] = *(const uint2*)(SB + idx[t]); }
    float pr[4], pk[4], pv[4], pz[4];
    if (t0 == 0) {
      if (prompt) {
#pragma unroll
        for (int x = 0; x < 4; ++x) { pr[x] = 0.f; pk[x] = 0.f; pv[x] = 0.f; pz[x] = 0.f; }
      } else {
        const float* s = p.in[4] + (size_t)((row0 - MP) >> 4) * CSH;
        const float4 a = *(const float4*)(s + c), b = *(const float4*)(s + 1024 + c), d = *(const float4*)(s + 2048 + c), e = *(const float4*)(s + 3200 + c);
        pr[0] = a.x; pr[1] = a.y; pr[2] = a.z; pr[3] = a.w; pk[0] = b.x; pk[1] = b.y; pk[2] = b.z; pk[3] = b.w;
        pv[0] = d.x; pv[1] = d.y; pv[2] = d.z; pv[3] = d.w; pz[0] = e.x; pz[1] = e.y; pz[2] = e.z; pz[3] = e.w;
      }
    } else {
      pr[0] = bflo(gr[0].x); pr[1] = bfhi(gr[0].x); pr[2] = bflo(gr[0].y); pr[3] = bfhi(gr[0].y);
      pk[0] = bflo(gk[0].x); pk[1] = bfhi(gk[0].x); pk[2] = bflo(gk[0].y); pk[3] = bfhi(gk[0].y);
      pv[0] = bflo(gv[0].x); pv[1] = bfhi(gv[0].x); pv[2] = bflo(gv[0].y); pv[3] = bfhi(gv[0].y);
      pz[0] = bflo(gz[0].x); pz[1] = bfhi(gz[0].x); pz[2] = bflo(gz[0].y); pz[3] = bfhi(gz[0].y);
    }
#pragma unroll
    for (int t = 0; t < 4; ++t) {
      const int row = row0 + t;
      const float curr[4] = {bflo(gr[t + 1].x), bfhi(gr[t + 1].x), bflo(gr[t + 1].y), bfhi(gr[t + 1].y)}, curk[4] = {bflo(gk[t + 1].x), bfhi(gk[t + 1].x), bflo(gk[t + 1].y), bfhi(gk[t + 1].y)};
      const float curv[4] = {bflo(gv[t + 1].x), bfhi(gv[t + 1].x), bflo(gv[t + 1].y), bfhi(gv[t + 1].y)}, curz[4] = {bflo(gz[t + 1].x), bfhi(gz[t + 1].x), bflo(gz[t + 1].y), bfhi(gz[t + 1].y)};
      const float av[4] = {bflo(ga[t].x), bfhi(ga[t].x), bflo(ga[t].y), bfhi(ga[t].y)};
      float rm[4], km[4], vm[4], kkv[4], bb[4], kmod[4], szb[4];
      float ssq = 0.f, bon = 0.f;
#pragma unroll
      for (int x = 0; x < 4; ++x) {
        rm[x] = curr[x] + mura[x] * (pr[x] - curr[x]);
        km[x] = curk[x] + muka[x] * (pk[x] - curk[x]);
        vm[x] = curv[x] + muva[x] * (pv[x] - curv[x]);
        const float zm = curz[x] + muza[x] * (pz[x] - curz[x]);
        szb[x] = zm * sigmoidf_(zm);
        kkv[x] = km[x] * kka[x];
        ssq += kkv[x] * kkv[x];
        kmod[x] = km[x] * (1.f + (av[x] - 1.f) * kaa[x]);
        bon += rm[x] * kmod[x] * rka[x];
        pr[x] = curr[x]; pk[x] = curk[x]; pv[x] = curv[x]; pz[x] = curz[x];
      }
      ssq = sum16(ssq); bon = sum16(bon);
      const float inv = 1.f / fmaxf(sqrtf(ssq), 1e-12f);
#pragma unroll
      for (int x = 0; x < 4; ++x) { kkv[x] *= inv; bb[x] = kkv[x] * av[x]; }
      *(uint2*)(SR + idx[t]) = make_uint2(cvtpk(rm[0], rm[1]), cvtpk(rm[2], rm[3]));
      *(uint2*)(SK + idx[t]) = make_uint2(cvtpk(kmod[0], kmod[1]), cvtpk(kmod[2], kmod[3]));
      *(uint2*)(SV + idx[t]) = make_uint2(cvtpk(vm[0], vm[1]), cvtpk(vm[2], vm[3]));
      *(uint2*)(SKK + idx[t]) = make_uint2(cvtpk(-kkv[0], -kkv[1]), cvtpk(-kkv[2], -kkv[3]));
      *(uint2*)(SB + idx[t]) = make_uint2(cvtpk(bb[0], bb[1]), cvtpk(bb[2], bb[3]));
      *(uint2*)(SZB + (size_t)row * 1024 + c) = make_uint2(cvtpk(szb[0], szb[1]), cvtpk(szb[2], szb[3]));
      if ((tid & 15) == 0) BONUS[(size_t)row * 16 + hh] = bon;
    }
  }
}

template <bool SAMPLE>
DI void attn_wave(const Params& p, int sh, int qt) {
  const int lane = TIDX & 63, r = lane & 31, h = lane >> 5;
  const int hh = sh & 15, b = sh >> 4;
  bf16_t* QB = (bf16_t*)(p.ws + WS_QB);
  const int row0 = SAMPLE ? MP + b * 16 : b * 4096 + qt * 32;
  bf16_t* Qp = QB + (size_t)row0 * 1024 + hh * 64;
  const int qrow = SAMPLE ? (r < 15 ? r : 15) : r;
  bf16x8 qf[4];
#pragma unroll
  for (int s = 0; s < 4; ++s) qf[s] = *(const bf16x8*)(Qp + (size_t)qrow * 1024 + 16 * s + 8 * h);
  f32x16 z0, z1;
#pragma unroll
  for (int i = 0; i < 16; ++i) { z0[i] = 0.f; z1[i] = 0.f; }
  float carry = 1.f;
  const int ntiles = SAMPLE ? 33 : qt + 1;
  for (int it = 0; it < ntiles; ++it) {
    const bool diag = (it == 0);
    const int kt = SAMPLE ? 32 - it : qt - it;
    bf16x8 kf[4];
    {
      const float* Kp;
      if (!SAMPLE) Kp = p.out + OUT_KP + ((size_t)sh * 4096 + kt * 32 + r) * 64;
      else Kp = diag ? p.out + OUT_KS + ((size_t)sh * 16 + (r < 15 ? r : 15)) * 64 : p.in[2] + ((size_t)sh * 1024 + kt * 32 + r) * 64;
#pragma unroll
      for (int s = 0; s < 4; ++s) {
        const float4 a = *(const float4*)(Kp + 16 * s + 8 * h), bq = *(const float4*)(Kp + 16 * s + 8 * h + 4);
        u32x4 w; w[0] = cvtpk(a.x, a.y); w[1] = cvtpk(a.z, a.w); w[2] = cvtpk(bq.x, bq.y); w[3] = cvtpk(bq.z, bq.w);
        kf[s] = __builtin_bit_cast(bf16x8, w);
      }
    }
    f32x16 st;
#pragma unroll
    for (int i = 0; i < 16; ++i) st[i] = 0.f;
#pragma unroll
    for (int s = 0; s < 4; ++s) st = MFMA32(kf[s], qf[s], st);
    float keep[16], wgt[16];
#pragma unroll
    for (int i = 0; i < 16; ++i) {
      const float e = __builtin_amdgcn_exp2f(st[i]);
      const float kp = __builtin_amdgcn_rcpf(1.f + e);
      bool valid = true;
      if (diag) { const int kr = crow(i, h); valid = SAMPLE ? (kr < r && kr < 16) : (kr < r); }
      keep[i] = valid ? kp : 1.f;
      wgt[i] = valid ? 1.f - kp : 0.f;
    }
    float pp[4], hif[4];
#pragma unroll
    for (int g = 0; g < 4; ++g) {
      const float p4 = (keep[4 * g] * keep[4 * g + 1]) * (keep[4 * g + 2] * keep[4 * g + 3]);
      const auto sw = __builtin_amdgcn_permlane32_swap(__float_as_uint(p4), __float_as_uint(p4), false, false);
      const float lo = __uint_as_float(sw[0]), hi = __uint_as_float(sw[1]);
      pp[g] = lo * hi;
      hif[g] = h ? 1.f : hi;
    }
    float T[4];
    T[3] = carry; T[2] = T[3] * pp[3]; T[1] = T[2] * pp[2]; T[0] = T[1] * pp[1];
    carry = T[0] * pp[0];
#pragma unroll
    for (int g = 0; g < 4; ++g) {
      const float w3 = T[g] * hif[g], w2 = w3 * keep[4 * g + 3], w1 = w2 * keep[4 * g + 2], w0 = w1 * keep[4 * g + 1];
      wgt[4 * g + 3] *= w3; wgt[4 * g + 2] *= w2; wgt[4 * g + 1] *= w1; wgt[4 * g] *= w0;
    }
#pragma unroll
    for (int s = 0; s < 2; ++s) {
      u32x4 pw;
#pragma unroll
      for (int j = 0; j < 4; ++j) pw[j] = cvtpk(wgt[8 * s + 2 * j], wgt[8 * s + 2 * j + 1]);
      const bf16x8 pf = __builtin_bit_cast(bf16x8, pw);
#pragma unroll
      for (int db = 0; db < 2; ++db) {
        bf16x8 vf;
        {
          float vv[8];
#pragma unroll
          for (int j = 0; j < 8; ++j) {
            const int kr = 16 * s + 8 * (j >> 2) + 4 * h + (j & 3);
            const float* vp;
            if (!SAMPLE) vp = p.out + OUT_VP + ((size_t)sh * 4096 + kt * 32 + kr) * 64;
            else vp = diag ? p.out + OUT_VS + ((size_t)sh * 16 + (kr < 15 ? kr : 15)) * 64 : p.in[3] + ((size_t)sh * 1024 + kt * 32 + kr) * 64;
            vv[j] = vp[db * 32 + r];
          }
          u32x4 w; w[0] = cvtpk(vv[0], vv[1]); w[1] = cvtpk(vv[2], vv[3]); w[2] = cvtpk(vv[4], vv[5]); w[3] = cvtpk(vv[6], vv[7]);
          vf = __builtin_bit_cast(bf16x8, w);
        }
        if (db == 0) z0 = MFMA32(pf, vf, z0); else z1 = MFMA32(pf, vf, z1);
      }
    }
    if (__ballot(carry != 0.f) == 0ull) break;
  }
  const bf16_t* SZA = (const bf16_t*)(p.ws + WS_SZA);
#pragma unroll
  for (int i = 0; i < 16; ++i) {
    const int q = crow(i, h);
    if (SAMPLE && q >= 16) continue;
    const size_t o = (size_t)(row0 + q) * 1024 + hh * 64 + r;
    QB[o] = f2bf(z0[i] * bf2f(SZA[o]));
    QB[o + 32] = f2bf(z1[i] * bf2f(SZA[o + 32]));
  }
}

DI float row16_sum(float x) {
  x += dppf<0xB1>(x); x += dppf<0x4E>(x); x += dppf<0x124>(x); x += dppf<0x128>(x);
  return x;
}
DI void scan_wave(const Params& p, int shg, int slice, float* L) {
  const int lane = TIDX & 63, cc = lane & 15;
  const bool prompt = shg < 64;
  const int T = prompt ? 4096 : 16;
  const size_t base = prompt ? (size_t)shg * 4096 * 64 : (size_t)MP * 1024 + (size_t)(shg - 64) * 16 * 64;
  const int v = slice * 4 + (lane >> 4);
  const float* SW = (const float*)(p.ws + WS_SW) + base;
  const bf16_t* SARR = (const bf16_t*)(p.ws + WS_SR) + base;
  float* ORAW = (float*)(p.ws + WS_ORAW) + base;
  float4 S;
  float* wout;
  if (prompt) { S = make_float4(0.f, 0.f, 0.f, 0.f); wout = p.out + OUT_WP + ((size_t)shg * 64 + v) * 64 + 4 * cc; }
  else { S = *(const float4*)(p.in[5] + ((size_t)(shg - 64) * 64 + v) * 64 + 4 * cc); wout = p.out + OUT_WS + ((size_t)(shg - 64) * 64 + v) * 64 + 4 * cc; }
  const int nch = T / 8;
  const int dw0 = ((lane >> 4) * 6 + 2) * 64 + (lane & 15) * 4, dw1 = dw0 + 4 * 384;
  const int db = (lane >> 3) * 384 + (lane & 7) * 8;
  uint4 gw0, gw1, gr, gk, gv, gn, gb;
#define SCAN_GLOAD(ch) do { const float* w_ = SW + (size_t)(ch) * 512; gw0 = *(const uint4*)(w_ + lane * 4); gw1 = *(const uint4*)(w_ + 256 + lane * 4); \
    const bf16_t* a_ = SARR + (size_t)(ch) * 512 + lane * 8; gr = *(const uint4*)a_; gk = *(const uint4*)(a_ + SZ_ACT / 2); gv = *(const uint4*)(a_ + 2 * (SZ_ACT / 2)); \
    gn = *(const uint4*)(a_ + 3 * (SZ_ACT / 2)); gb = *(const uint4*)(a_ + 4 * (SZ_ACT / 2)); } while (0)
#define SCAN_PUT(slot, g) do { float* d_ = L + db + (slot) * 64; *(float4*)d_ = make_float4(bflo(g.x), bfhi(g.x), bflo(g.y), bfhi(g.y)); *(float4*)(d_ + 4) = make_float4(bflo(g.z), bfhi(g.z), bflo(g.w), bfhi(g.w)); } while (0)
#define SCAN_LSTORE() do { *(uint4*)(L + dw0) = gw0; *(uint4*)(L + dw1) = gw1; SCAN_PUT(4, gr); SCAN_PUT(3, gk); SCAN_PUT(5, gv); SCAN_PUT(0, gn); SCAN_PUT(1, gb); \
    asm volatile("s_waitcnt lgkmcnt(0)" ::: "memory"); } while (0)
  SCAN_GLOAD(0);
  asm volatile("s_waitcnt lgkmcnt(0)" ::: "memory");
  SCAN_LSTORE();
  for (int ch = 0; ch < nch; ++ch) {
    if (ch + 1 < nch) SCAN_GLOAD(ch + 1);
    float okeep = 0.f;
    const float* Lc = L + 4 * cc;
    float4 nk = *(const float4*)(Lc), bb = *(const float4*)(Lc + 64), ww = *(const float4*)(Lc + 128), kv = *(const float4*)(Lc + 192), rr = *(const float4*)(Lc + 256);
    float vt = L[320 + v];
#pragma unroll 4
    for (int st = 0; st < 8; ++st) {
      const int sn = ((st + 1) & 7) * 384;
      const float4 nk2 = *(const float4*)(Lc + sn), bb2 = *(const float4*)(Lc + sn + 64), ww2 = *(const float4*)(Lc + sn + 128);
      const float4 kv2 = *(const float4*)(Lc + sn + 192), rr2 = *(const float4*)(Lc + sn + 256);
      const float vt2 = L[sn + 320 + v];
      float d = (S.x * nk.x + S.y * nk.y) + (S.z * nk.z + S.w * nk.w);
      const float sa = row16_sum(d);
      S.x = S.x * ww.x + (sa * bb.x + vt * kv.x);
      S.y = S.y * ww.y + (sa * bb.y + vt * kv.y);
      S.z = S.z * ww.z + (sa * bb.z + vt * kv.z);
      S.w = S.w * ww.w + (sa * bb.w + vt * kv.w);
      float o = (S.x * rr.x + S.y * rr.y) + (S.z * rr.z + S.w * rr.w);
      o = row16_sum(o);
      okeep = (cc == st) ? o : okeep;
      nk = nk2; bb = bb2; ww = ww2; kv = kv2; rr = rr2; vt = vt2;
    }
    if (cc < 8) ORAW[(size_t)(ch * 8 + cc) * 64 + v] = okeep;
    asm volatile("s_waitcnt lgkmcnt(0)" ::: "memory");
    if (ch + 1 < nch) SCAN_LSTORE();
  }
  *(float4*)wout = S;
#undef SCAN_GLOAD
#undef SCAN_PUT
#undef SCAN_LSTORE
}

DI void sgroup_barrier(volatile LAS unsigned* cnt, unsigned target) {
  asm volatile("s_waitcnt lgkmcnt(0)" ::: "memory");
  if ((TIDX & 63) == 0) __hip_atomic_fetch_add((LAS unsigned*)cnt, 1u, __ATOMIC_RELAXED, __HIP_MEMORY_SCOPE_WORKGROUP);
  while (*cnt < target) __builtin_amdgcn_s_sleep(1);
  asm volatile("" ::: "memory");
}
DI void scan_group(const Params& p, int sh, int quarter, float* lds, volatile LAS unsigned* cnt, unsigned& nbar) {
  const int tid = TIDX & 255, lane = tid & 63, wid = tid >> 6, cc = lane & 15;
  const size_t base = (size_t)sh * 4096 * 64;
  const int v = quarter * 16 + wid * 4 + (lane >> 4);
  const float* SW = (const float*)(p.ws + WS_SW) + base;
  const bf16_t* SARR = (const bf16_t*)(p.ws + WS_SR) + base;
  float* ORAW = (float*)(p.ws + WS_ORAW) + base;
  f32x2 S01 = {0.f, 0.f}, S23 = {0.f, 0.f};
  const bool b0 = (lane & 1) != 0, b1 = (lane & 2) != 0;
  float4 gw0, gw1; uint4 gb0, gb1, gb2, gb3, gb4;
  const int dstw0 = ((tid >> 4) * 6 + 2) * 64 + (tid & 15) * 4, dstw1 = dstw0 + 16 * 384;
  const int dstb = (tid >> 3) * 384 + (tid & 7) * 8;
  const bf16_t* sbp = SARR + tid * 8;
#define SG_GLOAD(ch) do { const size_t o_ = (size_t)(ch) * 2048; gw0 = *(const float4*)(SW + o_ + tid * 4); gw1 = *(const float4*)(SW + o_ + 1024 + tid * 4); \
    gb0 = *(const uint4*)(sbp + o_); gb1 = *(const uint4*)(sbp + (SZ_ACT / 2) + o_); gb2 = *(const uint4*)(sbp + 2 * (SZ_ACT / 2) + o_); \
    gb3 = *(const uint4*)(sbp + 3 * (SZ_ACT / 2) + o_); gb4 = *(const uint4*)(sbp + 4 * (SZ_ACT / 2) + o_); } while (0)
#define SG_PUT(d_, g) do { *(float4*)(d_) = make_float4(bflo(g.x), bfhi(g.x), bflo(g.y), bfhi(g.y)); *(float4*)((d_) + 4) = make_float4(bflo(g.z), bfhi(g.z), bflo(g.w), bfhi(g.w)); } while (0)
#define SG_LSTORE(buf) do { float* L_ = lds + (buf) * (32 * 384); *(float4*)(L_ + dstw0) = gw0; *(float4*)(L_ + dstw1) = gw1; \
    SG_PUT(L_ + dstb + 4 * 64, gb0); SG_PUT(L_ + dstb + 3 * 64, gb1); SG_PUT(L_ + dstb + 5 * 64, gb2); SG_PUT(L_ + dstb + 0 * 64, gb3); SG_PUT(L_ + dstb + 1 * 64, gb4); } while (0)
  SG_GLOAD(0); SG_LSTORE(0); sgroup_barrier(cnt, 4u * (++nbar));
  for (int ch = 0; ch < 128; ++ch) {
    if (ch + 1 < 128) SG_GLOAD(ch + 1);
#pragma unroll 1
    for (int hlf = 0; hlf < 2; ++hlf) {
    const float* L = lds + (ch & 1) * (32 * 384) + hlf * (16 * 384);
    float okeep = 0.f;
    const float* Lc = L + 4 * cc;
    f32x4 nk = *(const f32x4*)(Lc), bb = *(const f32x4*)(Lc + 64), ww = *(const f32x4*)(Lc + 128), kv = *(const f32x4*)(Lc + 192), rr = *(const f32x4*)(Lc + 256);
    float vt = L[320 + v];
    f32x4 rrp = rr;
    float po[4];
#pragma unroll
    for (int st = 0; st <= 16; ++st) {
      if (st > 0) { const f32x2 o2 = S01 * rrp.xy + S23 * rrp.zw; po[(st - 1) & 3] = o2.x + o2.y; }
      if (st > 0 && (st & 3) == 0) {
        const float u0 = (b0 ? po[1] : po[0]) + dppf<0xB1>(b0 ? po[0] : po[1]);
        const float u1 = (b0 ? po[3] : po[2]) + dppf<0xB1>(b0 ? po[2] : po[3]);
        float w = (b1 ? u1 : u0) + dppf<0x4E>(b1 ? u0 : u1);
        w += dppf<0x124>(w); w += dppf<0x128>(w);
        okeep = ((cc >> 2) == (st >> 2) - 1) ? w : okeep;
      }
      if (st < 16) {
        const int sn = ((st + 1) & 15) * 384;
        const f32x2 d2 = S01 * nk.xy + S23 * nk.zw;
        float x = d2.x + d2.y;
        const f32x2 vt_2 = {vt, vt};
        const f32x2 t01 = vt_2 * kv.xy, t23 = vt_2 * kv.zw;
        __builtin_amdgcn_sched_barrier(0);
        x += dppf<0xB1>(x);
        const f32x4 nk2 = *(const f32x4*)(Lc + sn), bb2 = *(const f32x4*)(Lc + sn + 64);
        __builtin_amdgcn_sched_barrier(0);
        x += dppf<0x4E>(x);
        const f32x4 ww2 = *(const f32x4*)(Lc + sn + 128), kv2 = *(const f32x4*)(Lc + sn + 192);
        __builtin_amdgcn_sched_barrier(0);
        x += dppf<0x124>(x);
        const f32x4 rr2 = *(const f32x4*)(Lc + sn + 256);
        const float vt2 = L[sn + 320 + v];
        __builtin_amdgcn_sched_barrier(0);
        x += dppf<0x128>(x);
        __builtin_amdgcn_sched_barrier(0);
        const f32x2 sa2 = {x, x};
        S01 = S01 * ww.xy + (sa2 * bb.xy + t01);
        S23 = S23 * ww.zw + (sa2 * bb.zw + t23);
        rrp = rr;
        nk = nk2; bb = bb2; ww = ww2; kv = kv2; rr = rr2; vt = vt2;
      }
    }
    ORAW[(size_t)(ch * 32 + hlf * 16 + cc) * 64 + v] = okeep;
    }
    if (ch + 1 < 128) SG_LSTORE((ch + 1) & 1);
    sgroup_barrier(cnt, 4u * (++nbar));
  }
  *(float4*)(p.out + OUT_WP + ((size_t)sh * 64 + v) * 64 + 4 * cc) = make_float4(S01.x, S01.y, S23.x, S23.y);
#undef SG_GLOAD
#undef SG_PUT
#undef SG_LSTORE
}

constexpr int NQ_ATT_P = 8192, NQ_ATT_S = 512, NQ_SCAN_S = 8192, NQ_DYN = NQ_ATT_P + NQ_ATT_S + NQ_SCAN_S;
DI int wave_grab(unsigned* ctr) { int v = 0; if ((TIDX & 63) == 0) v = (int)atomicAdd(ctr, 1u); return __builtin_amdgcn_readfirstlane(v); }
DI void phase2(const Params& p, char* smem) {
  __shared__ unsigned s_cnt;
  unsigned* ctl = (unsigned*)(p.ws + WS_CTL);
  const int wid = TIDX >> 6;
  if (TIDX == 0) s_cnt = 0u;
  __syncthreads();
  float* Lsh = (float*)smem + 4 * (8 * 384);
  float* L = wid >= 4 ? (float*)smem + (wid - 4) * (8 * 384) : Lsh + wid * (8 * 384);
  if (wid < 4) {
    unsigned nbar = 0;
    __builtin_amdgcn_s_setprio(3);
    for (int bu = blockIdx.x; bu < 256; bu += gridDim.x) {
      const int xs = bu & 7, slot = bu >> 3, head = xs * 8 + (slot >> 2), quarter = slot & 3;
      scan_group(p, head, quarter, Lsh, (volatile LAS unsigned*)&s_cnt, nbar);
    }
    __builtin_amdgcn_s_setprio(0);
  }
  for (;;) {
    int u = wave_grab(&ctl[0]);
    if (u >= NQ_DYN) break;
    if (u < NQ_ATT_P) { attn_wave<false>(p, u >> 7, u & 127); continue; }
    u -= NQ_ATT_P;
    if (u < NQ_ATT_S) { attn_wave<true>(p, u, 0); continue; }
    u -= NQ_ATT_S;
    scan_wave(p, 64 + (u >> 4), u & 15, L);
  }
}

DI void p2c_row(const Params& p, int row, int c, int hh, const float4& lg, const float4& lb, const float4& o, const uint2& vv, const uint2& zz, float bon) {
  const float mean = sum16((o.x + o.y) + (o.z + o.w)) * (1.f / 64.f);
  const float dx = o.x - mean, dy = o.y - mean, dz = o.z - mean, dw = o.w - mean;
  const float var = sum16((dx * dx + dy * dy) + (dz * dz + dw * dw)) * (1.f / 64.f);
  const float inv = rsqrtf(var + LNX_EPS);
  const float r0 = (dx * inv * lg.x + lb.x + bon * bflo(vv.x)) * bflo(zz.x);
  const float r1 = (dy * inv * lg.y + lb.y + bon * bfhi(vv.x)) * bfhi(zz.x);
  const float r2 = (dz * inv * lg.z + lb.z + bon * bflo(vv.y)) * bflo(zz.y);
  const float r3 = (dw * inv * lg.w + lb.w + bon * bfhi(vv.y)) * bfhi(zz.y);
  *(uint2*)((bf16_t*)(p.ws + WS_OB) + (size_t)row * 1024 + c) = make_uint2(cvtpk(r0, r1), cvtpk(r2, r3));
}
DI void phase2c(const Params& p) {
  const int tid = TIDX & 255, half = TIDX >> 8, c = tid * 4, hh = c >> 6;
  const float4 lg = *(const float4*)(p.in[16] + c), lb = *(const float4*)(p.in[17] + c);
  const float* ORAW = (const float*)(p.ws + WS_ORAW); const bf16_t* SV = (const bf16_t*)(p.ws + WS_SV);
  const bf16_t* SZB = (const bf16_t*)(p.ws + WS_SZB); const float* BONUS = (const float*)(p.ws + WS_BONUS);
  const int stride = gridDim.x * 2;
  for (int row = blockIdx.x * 2 + half; row < MT; row += 2 * stride) {
    const bool two = row + stride < MT;
    const int rowb = two ? row + stride : row;
    const size_t ia = hm_base(row) + hh * hm_hstride(row) + (c & 63), ib = hm_base(rowb) + hh * hm_hstride(rowb) + (c & 63);
    const float4 oa = *(const float4*)(ORAW + ia), ob = *(const float4*)(ORAW + ib);
    const uint2 va = *(const uint2*)(SV + ia), vb = *(const uint2*)(SV + ib);
    const uint2 za = *(const uint2*)(SZB + (size_t)row * 1024 + c), zb = *(const uint2*)(SZB + (size_t)rowb * 1024 + c);
    const float ba = BONUS[(size_t)row * 16 + hh], bb = BONUS[(size_t)rowb * 16 + hh];
    p2c_row(p, row, c, hh, lg, lb, oa, va, za, ba);
    if (two) p2c_row(p, rowb, c, hh, lg, lb, ob, vb, zb, bb);
  }
}

DI void phase4(const Params& p) {
  const int lane = TIDX & 63, wid = TIDX >> 6;
  const float* g = p.in[21];
  float4 gg[4];
#pragma unroll
  for (int i = 0; i < 4; ++i) gg[i] = *(const float4*)(g + i * 256 + lane * 4);
  const int stride = gridDim.x * 8;
  for (int row = blockIdx.x * 8 + wid; row < MT; row += 2 * stride) {
    const bool two = row + stride < MT;
    float* x0 = p.out + OUT_YP + (size_t)row * 1024;
    float* x1 = p.out + OUT_YP + (size_t)(two ? row + stride : row) * 1024;
    float4 v0[4], v1[4]; float s0 = 0.f, s1 = 0.f;
#pragma unroll
    for (int i = 0; i < 4; ++i) { v0[i] = *(const float4*)(x0 + i * 256 + lane * 4); v1[i] = *(const float4*)(x1 + i * 256 + lane * 4); }
#pragma unroll
    for (int i = 0; i < 4; ++i) {
      s0 += v0[i].x * v0[i].x + v0[i].y * v0[i].y + v0[i].z * v0[i].z + v0[i].w * v0[i].w;
      s1 += v1[i].x * v1[i].x + v1[i].y * v1[i].y + v1[i].z * v1[i].z + v1[i].w * v1[i].w;
    }
    s0 = wave_sum(s0); s1 = wave_sum(s1);
    const float i0 = rsqrtf(s0 * (1.f / DM) + EPS), i1 = rsqrtf(s1 * (1.f / DM) + EPS);
#pragma unroll
    for (int i = 0; i < 4; ++i) *(float4*)(x0 + i * 256 + lane * 4) = make_float4(v0[i].x * i0 * gg[i].x, v0[i].y * i0 * gg[i].y, v0[i].z * i0 * gg[i].z, v0[i].w * i0 * gg[i].w);
    if (two) {
#pragma unroll
      for (int i = 0; i < 4; ++i) *(float4*)(x1 + i * 256 + lane * 4) = make_float4(v1[i].x * i1 * gg[i].x, v1[i].y * i1 * gg[i].y, v1[i].z * i1 * gg[i].z, v1[i].w * i1 * gg[i].w);
    }
  }
}

#define XB_TMO      128
#define XB_XCNT(j)  (256  + 64 * (j))
#define XB_XSUB(j)  (1280 + 64 * (j))
#define XB_XGEN(j)  (2304 + 64 * (j))
#define XB_TOP      3328
#define XB_TOPGEN   3392
#define XCD_BAR_WORDS 3456
#define XB_SPIN_CAP (1u << 18)

__device__ __forceinline__ unsigned xb_ld(unsigned* p)              { return __hip_atomic_load(p, __ATOMIC_RELAXED, __HIP_MEMORY_SCOPE_AGENT); }
__device__ __forceinline__ unsigned xb_add(unsigned* p, unsigned v) { return __hip_atomic_fetch_add(p, v, __ATOMIC_RELAXED, __HIP_MEMORY_SCOPE_AGENT); }
__device__ __forceinline__ unsigned xb_xcc_id() { return (unsigned)__builtin_amdgcn_s_getreg((3 << 11) | 20) & 0xFu; }
#define XB_SPIN(cond, bar) do { unsigned _sp = 0; while (cond) { __builtin_amdgcn_s_sleep(1); \
    if ((++_sp & 255u) == 0u) { if (xb_ld(&(bar)[XB_TMO])) break; if (_sp > XB_SPIN_CAP) { atomicAdd(&(bar)[XB_TMO], 1u); break; } } } } while (0)

struct XcdBarrier {
    unsigned* bar; unsigned x;
    volatile LAS unsigned* st;
};

__device__ __forceinline__ XcdBarrier xcd_barrier_post(unsigned* bar, volatile LAS unsigned* st) {
    XcdBarrier b; b.bar = bar; b.x = xb_xcc_id(); b.st = st;
    if (TIDX == 0) (void)xb_add(&bar[XB_XCNT(b.x)], 1u);
    return b;
}
__device__ __forceinline__ void xcd_barrier_complete(unsigned* bar, unsigned x, unsigned& nloc, unsigned& nx) {
    const unsigned G = gridDim.x * gridDim.y * gridDim.z;
    unsigned sum, cnt, mine, sp = 0u;
    for (;;) {
        sum = 0u; cnt = 0u; mine = 0u;
#pragma unroll
        for (unsigned j = 0; j < 16; ++j) { const unsigned c = xb_ld(&bar[XB_XCNT(j)]); sum += c; cnt += (c > 0u) ? 1u : 0u; mine = (j == x) ? c : mine; }
        if (sum == G) break;
        __builtin_amdgcn_s_sleep(1);
        if ((++sp & 255u) == 0u) { if (xb_ld(&bar[XB_TMO])) break; if (sp > XB_SPIN_CAP) { atomicAdd(&bar[XB_TMO], 1u); break; } }
    }
    nloc = mine > 0u ? mine : 1u; nx = cnt > 0u ? cnt : 1u;
}

__device__ __forceinline__ void xcd_barrier(const XcdBarrier& b) {
    asm volatile("s_waitcnt vmcnt(0)" ::: "memory");
    __syncthreads();
    if (TIDX == 0) {
        unsigned* bar = b.bar;
        __builtin_amdgcn_s_waitcnt(0);
        unsigned nloc = b.st[0], nx = b.st[1];
        if (nloc == 0u) { xcd_barrier_complete(bar, b.x, nloc, nx); b.st[0] = nloc; b.st[1] = nx; }
        const unsigned old = xb_add(&bar[XB_XSUB(b.x)], 1u);
        const unsigned gen = old / nloc;
        if (old + 1u == (gen + 1u) * nloc) {
            __builtin_amdgcn_fence(__ATOMIC_RELEASE, "agent");
            asm volatile("s_waitcnt vmcnt(0)" ::: "memory");
            const unsigned og = xb_add(&bar[XB_TOP], 1u);
            const unsigned tg = og / nx;
            if (og + 1u == (tg + 1u) * nx) xb_add(&bar[XB_TOPGEN], 1u);
            else XB_SPIN(xb_ld(&bar[XB_TOPGEN]) == tg, bar);
            __builtin_amdgcn_fence(__ATOMIC_ACQUIRE, "agent");
            xb_add(&bar[XB_XGEN(b.x)], 1u);
            asm volatile("s_waitcnt vmcnt(0)" ::: "memory");
        } else {
            XB_SPIN(xb_ld(&bar[XB_XGEN(b.x)]) == gen, bar);
            __builtin_amdgcn_fence(__ATOMIC_ACQUIRE, "agent");
            asm volatile("s_waitcnt vmcnt(0)" ::: "memory");
        }
    }
    __syncthreads();
}

__global__ void __launch_bounds__(NT, 2) mega(Params p) {
  extern __shared__ __attribute__((aligned(16))) char smem[];
  cg::grid_group grid = cg::this_grid();
  if (blockIdx.x == 0) { unsigned* ctl = (unsigned*)(p.ws + WS_CTL); for (int i = TIDX; i < 16384; i += NT) ctl[i] = 0u; }
  grid.sync();
  __shared__ unsigned xb_st[2];
  if (TIDX == 0) { xb_st[0] = 0u; xb_st[1] = 0u; }
  __syncthreads();
  (void)xcd_barrier_post((unsigned*)(p.ws + WS_CTL) + 8192, (volatile LAS unsigned*)xb_st);
#define XBAR() do { XcdBarrier xb_; xb_.bar = (unsigned*)(p.ws + WS_CTL) + 8192; xb_.x = xb_xcc_id(); xb_.st = (volatile LAS unsigned*)xb_st; xcd_barrier(xb_); } while (0)
  phase0(p, smem);
  XBAR();
  { EpiP1 E; E.p = p; run_gemm(smem, (const bf16_t*)(p.ws + WS_H), (const bf16_t*)(p.ws + WS_WINT), MT, NINP, E); }
  XBAR();
  phase_x(p);
  XBAR();
  { EpiLora E; E.p = p; run_gemm(smem, (const bf16_t*)(p.ws + WS_X), (const bf16_t*)(p.ws + WS_BTL), MP, 2048, E, 256); }
  small_lora(p);
  XBAR();
  phase1c(p);
  XBAR();
  phase2(p, smem);
  XBAR();
  phase2c(p);
  XBAR();
  { EpiGate E; E.p = p; E.goff = 0; E.first = true; run_gemm(smem, (const bf16_t*)(p.ws + WS_QB), (const bf16_t*)(p.ws + WS_WT), MP, 1024, E); }
  small_gemm<0>(p, (const bf16_t*)(p.ws + WS_QB), (const bf16_t*)(p.ws + WS_WT));
  { EpiGate E; E.p = p; E.goff = 1024; E.first = false; run_gemm(smem, (const bf16_t*)(p.ws + WS_OB), (const bf16_t*)(p.ws + WS_WT) + (size_t)1024 * 1024, MP, 1024, E); }
  small_gemm<1>(p, (const bf16_t*)(p.ws + WS_OB), (const bf16_t*)(p.ws + WS_WT) + (size_t)1024 * 1024);
  XBAR();
  { EpiOut E; E.p = p; run_gemm(smem, (const bf16_t*)(p.ws + WS_MG), (const bf16_t*)(p.ws + WS_WT) + (size_t)2 * 1024 * 1024, MP, 1024, E); }
  small_gemm<2>(p, (const bf16_t*)(p.ws + WS_MG), (const bf16_t*)(p.ws + WS_WT) + (size_t)2 * 1024 * 1024);
  XBAR();
  phase4(p);
}

extern "C" void kernel_launch(void* const* d_in, const int* in_sizes, int n_in, void* d_out, int out_size, void* d_ws, size_t ws_size, hipStream_t stream) {
  static int grid_blocks = 0;
  if (grid_blocks == 0) {
    if (n_in != 22 || ws_size < WS_END) { fprintf(stderr, "kernel_launch: unexpected n_in %d / ws_size %zu (need %zu)\n", n_in, ws_size, (size_t)WS_END); grid_blocks = -1; return; }
    int dev = 0, cus = 0, per_cu = 0;
    (void)hipGetDevice(&dev);
    (void)hipDeviceGetAttribute(&cus, hipDeviceAttributeMultiprocessorCount, dev);
    (void)hipFuncSetAttribute((const void*)mega, hipFuncAttributeMaxDynamicSharedMemorySize, SMEM_BYTES);
    (void)hipOccupancyMaxActiveBlocksPerMultiprocessor(&per_cu, (const void*)mega, NT, SMEM_BYTES);
    (void)hipGetLastError();
    grid_blocks = cus;
  }
  if (grid_blocks < 0) return;
  Params p{};
  for (int i = 0; i < 22; ++i) p.in[i] = (const float*)d_in[i];
  p.out = (float*)d_out; p.ws = (unsigned char*)d_ws;
  void* args[] = {&p};
  hipError_t e = hipLaunchCooperativeKernel((const void*)mega, dim3(grid_blocks), dim3(NT), args, SMEM_BYTES, stream);
  if (e != hipSuccess) fprintf(stderr, "cooperative launch failed: %s (grid %d)\n", hipGetErrorString(e), grid_blocks);
}
```

```cpp
#include <hip/hip_runtime.h>
#include <hip/hip_cooperative_groups.h>
#include <cstdio>
#include <cstdint>
namespace cg = cooperative_groups;
__device__ __forceinline__ int lane_id_() { return (int)__builtin_amdgcn_mbcnt_hi(~0u, __builtin_amdgcn_mbcnt_lo(~0u, 0u)); }
#define TIDX (__builtin_amdgcn_readfirstlane((int)(threadIdx.x >> 6)) * 64 + lane_id_())

namespace pg8 {
#define PG8_LAS __attribute__((address_space(3)))
typedef unsigned short bf16_t;
typedef short bf16x8 __attribute__((ext_vector_type(8)));
typedef float f32x4 __attribute__((ext_vector_type(4)));
typedef unsigned u32x4 __attribute__((ext_vector_type(4)));
constexpr int BM = 256, BK = 64, HALF = 128, HTB = HALF * BK * 2  , STAGE_BYTES = 8 * HTB, NXCD = 8, WGM = 8;

__host__ __device__ __forceinline__ int lds_byte(int r, int c) { const int st = (r >> 4) * 2 + (c >> 5), rr = r & 15, cc = c & 31, ob = rr * 64 + cc * 2; return st * 1024 + (ob ^ (((ob >> 9) & 1) << 5)); }
__host__ __device__ __forceinline__ void stage_rc(int b, int& R, int& C) { const int st = b / 1024, sb = b % 1024, swz = sb ^ (((sb >> 9) & 1) << 5); R = (st >> 1) * 16 + swz / 64; C = (st & 1) * 32 + (swz % 64) / 2; }
__host__ __device__ __forceinline__ int perm32(int rho) { const int n = rho >> 4, i = rho & 15; return 8 * (i >> 2) + 4 * n + (i & 3); }

struct Unit { int pm, pn; };
struct Gemm { const bf16_t* A; const bf16_t* Bt; int M, N, K; };

struct StaticOrder {
    int nM, nN, nwg, G, c;
    __host__ __device__ void init(int M, int N, int G_, int c_) { nM = M / BM; nN = N / BM; nwg = nM * nN; G = G_; c = c_; }
    __host__ __device__ bool next(int i, Unit& u) const {
        const long L = (long)i * G + c; if (L >= nwg) return false;
        int wgid = (int)L; { const int q = nwg / NXCD, r = nwg % NXCD, xcd = wgid % NXCD, off = wgid / NXCD; wgid = (xcd < r ? xcd * (q + 1) : r * (q + 1) + (xcd - r) * q) + off; }
        const int nig = WGM * nN, gid = wgid / nig, fm = gid * WGM, gsz = (nM - fm) < WGM ? (nM - fm) : WGM;
        u.pm = fm + ((wgid % nig) % gsz); u.pn = (wgid % nig) / gsz; return true;
    }
    __device__ __forceinline__ void a_ready(const Unit&) const {}
    __device__ __forceinline__ void done(const Unit&) const {}
};


template <class Epi, class Sched, bool ALIGN_EPI = false, bool SP2 = false>
__device__ __forceinline__ void gemm_phase(PG8_LAS unsigned char* lds, const Gemm g, const Sched& S, const Epi& E) {
    int tid_ = TIDX; asm volatile("" : "+v"(tid_));
    const int tid = tid_, wid = __builtin_amdgcn_readfirstlane(tid >> 6), lane = tid & 63, wr = wid >> 2, wc = wid & 3, fr = lane & 15, fq = lane >> 4;
    const int K = g.K, nt = K / BK;
    unsigned voffA[2], voffB[2];
#pragma unroll
    for (int i = 0; i < 2; ++i) { int R, C; stage_rc(tid * 16 + i * 8192, R, C); const int Rb = Epi::PERM ? ((R & ~31) + perm32(R & 31)) : R;
        voffA[i] = (unsigned)(R * K + C) * 2u; voffB[i] = (unsigned)(Rb * K + C) * 2u; }
    const size_t kstep = (size_t)(BK * 2);
    const size_t hstep = (size_t)HALF * K * 2;
    const size_t tstep = 2 * hstep;
    const unsigned ldsw = (unsigned)wid * 1024u;
    const int aoff = lds_byte(wr * 64 + fr, fq * 8), boff = lds_byte(wc * 32 + fr, fq * 8);
#define PG8_SA(b, h) (((b) * 2 + (h)) * HTB)
#define PG8_SB(b, h) ((4 + (b) * 2 + (h)) * HTB)
#define PG8_STAGE(bufoff, gbase, voff) do { _Pragma("unroll") for (int _i = 0; _i < 2; ++_i) \
        __builtin_amdgcn_global_load_lds((const unsigned*)((const char*)(gbase) + (voff)[_i]), (PG8_LAS unsigned*)(lds + (bufoff) + ldsw + _i * 8192), 16, 0, 0); } while (0)
#define PG8_LDA(dst, b, h) do { _Pragma("unroll") for (int m = 0; m < 4; ++m) _Pragma("unroll") for (int k = 0; k < 2; ++k) dst[m][k] = *(const PG8_LAS bf16x8*)(lds + PG8_SA(b, h) + aoff + m * 2048 + k * 1024); } while (0)
#define PG8_LDB(dst, b, h) do { _Pragma("unroll") for (int n = 0; n < 2; ++n) _Pragma("unroll") for (int k = 0; k < 2; ++k) dst[n][k] = *(const PG8_LAS bf16x8*)(lds + PG8_SB(b, h) + boff + n * 2048 + k * 1024); } while (0)
#define PG8_MMA(ai, bj, At, Bt) do { __builtin_amdgcn_s_setprio(1); _Pragma("unroll") for (int m = 0; m < 4; ++m) _Pragma("unroll") for (int n = 0; n < 2; ++n) _Pragma("unroll") for (int k = 0; k < 2; ++k) \
        acc[ai][bj][m][n] = __builtin_amdgcn_mfma_f32_16x16x32_bf16(Bt[n][k], At[m][k], acc[ai][bj][m][n], 0, 0, 0); __builtin_amdgcn_s_setprio(0); } while (0)
#define PG8_WAIT_V(n) asm volatile("s_waitcnt vmcnt(" #n ")" ::: "memory")
#define PG8_WAIT_L(n) asm volatile("s_waitcnt lgkmcnt(" #n ")" ::: "memory")
#define PG8_BAR __builtin_amdgcn_s_barrier()
#define PG8_SCHED __builtin_amdgcn_sched_barrier(0)
    Unit cur, nxt; int ui = 0;
    if (!S.next(0, cur)) return;
    f32x4 acc[2][2][4][2];
#pragma unroll
    for (int a = 0; a < 2; ++a)
#pragma unroll
        for (int b = 0; b < 2; ++b)
#pragma unroll
            for (int m = 0; m < 4; ++m)
#pragma unroll
                for (int n = 0; n < 2; ++n) acc[a][b][m][n] = (f32x4){0.f, 0.f, 0.f, 0.f};
    bf16x8 At[4][2], B0[2][2], B1[2][2];
    const char* cA = (const char*)g.A + (size_t)cur.pm * tstep; const char* cB = (const char*)g.Bt + (size_t)cur.pn * tstep;
    S.a_ready(cur);
    if constexpr (SP2) {
        PG8_STAGE(PG8_SB(0, 0), cB, voffB); PG8_STAGE(PG8_SB(0, 1), cB + hstep, voffB); PG8_STAGE(PG8_SA(0, 0), cA, voffA); PG8_STAGE(PG8_SA(0, 1), cA + hstep, voffA);
        if (wr == 1) PG8_BAR;
        PG8_WAIT_V(2); PG8_BAR;
        PG8_STAGE(PG8_SB(1, 0), cB + kstep, voffB); PG8_STAGE(PG8_SA(1, 0), cA + kstep, voffA); PG8_STAGE(PG8_SB(1, 1), cB + hstep + kstep, voffB);
        PG8_WAIT_V(6); PG8_BAR;
    } else {
        PG8_STAGE(PG8_SB(0, 0), cB, voffB); PG8_STAGE(PG8_SA(0, 0), cA, voffA); PG8_STAGE(PG8_SB(0, 1), cB + hstep, voffB); PG8_STAGE(PG8_SA(0, 1), cA + hstep, voffA);
        if (wr == 1) PG8_BAR;
        PG8_WAIT_V(4); PG8_BAR;
        PG8_STAGE(PG8_SB(1, 0), cB + kstep, voffB); PG8_STAGE(PG8_SA(1, 0), cA + kstep, voffA); PG8_STAGE(PG8_SB(1, 1), cB + hstep + kstep, voffB);
        PG8_WAIT_V(6); PG8_BAR;
    }
    for (;;) {
        const bool has_next = S.next(ui + 1, nxt);
        const char* nA = has_next ? (const char*)g.A + (size_t)nxt.pm * tstep : cA; const char* nB = has_next ? (const char*)g.Bt + (size_t)nxt.pn * tstep : cB;
        for (int t = 0; t < nt; t += 2) {
            const bool last = (t == nt - 2);
            const char* a1 = cA + (size_t)(t + 1) * kstep;
            const char* a2 = last ? nA : cA + (size_t)(t + 2) * kstep; const char* b2 = last ? nB : cB + (size_t)(t + 2) * kstep;
            const char* a3 = a2 + kstep; const char* b3 = b2 + kstep;
            if (last && has_next) S.a_ready(nxt);
            if constexpr (SP2) {
            PG8_LDB(B0, 0, 0); PG8_LDB(B1, 0, 1); PG8_SCHED; PG8_LDA(At, 0, 0); PG8_STAGE(PG8_SA(1, 1), a1 + hstep, voffA);
            PG8_WAIT_V(8); PG8_WAIT_L(0); PG8_BAR; PG8_MMA(0, 0, At, B0); PG8_MMA(0, 1, At, B1); PG8_BAR; PG8_SCHED;
            PG8_LDA(At, 0, 1); PG8_STAGE(PG8_SB(0, 0), b2, voffB); PG8_STAGE(PG8_SB(0, 1), b2 + hstep, voffB); PG8_STAGE(PG8_SA(0, 0), a2, voffA);
            PG8_WAIT_V(8); PG8_WAIT_L(0); PG8_BAR; PG8_MMA(1, 0, At, B0); PG8_MMA(1, 1, At, B1); PG8_BAR; PG8_SCHED;
            PG8_LDB(B0, 1, 0); PG8_LDB(B1, 1, 1); PG8_SCHED; PG8_LDA(At, 1, 0); PG8_STAGE(PG8_SA(0, 1), a2 + hstep, voffA);
            PG8_WAIT_V(8); PG8_WAIT_L(0); PG8_BAR; PG8_MMA(0, 0, At, B0); PG8_MMA(0, 1, At, B1); PG8_BAR; PG8_SCHED;
            PG8_LDA(At, 1, 1); PG8_STAGE(PG8_SB(1, 0), b3, voffB); PG8_STAGE(PG8_SB(1, 1), b3 + hstep, voffB); PG8_STAGE(PG8_SA(1, 0), a3, voffA);
            PG8_WAIT_V(8); PG8_WAIT_L(0); PG8_BAR; PG8_MMA(1, 0, At, B0); PG8_MMA(1, 1, At, B1); PG8_BAR; PG8_SCHED;
            } else {
            PG8_LDB(B0, 0, 0); PG8_SCHED; PG8_LDA(At, 0, 0); PG8_STAGE(PG8_SA(1, 1), a1 + hstep, voffA);
            PG8_WAIT_L(8); PG8_BAR; PG8_WAIT_L(0); PG8_MMA(0, 0, At, B0); PG8_BAR; PG8_SCHED;
            PG8_LDB(B1, 0, 1); PG8_STAGE(PG8_SB(0, 0), b2, voffB);
            PG8_BAR; PG8_WAIT_L(0); PG8_MMA(0, 1, At, B1); PG8_BAR;
            PG8_LDA(At, 0, 1); PG8_STAGE(PG8_SA(0, 0), a2, voffA);
            PG8_BAR; PG8_WAIT_L(0); PG8_MMA(1, 0, At, B0); PG8_BAR; PG8_SCHED;
            PG8_STAGE(PG8_SB(0, 1), b2 + hstep, voffB);
            PG8_WAIT_V(6); PG8_BAR; PG8_MMA(1, 1, At, B1); PG8_BAR;
            PG8_LDB(B0, 1, 0); PG8_SCHED; PG8_LDA(At, 1, 0); PG8_STAGE(PG8_SA(0, 1), a2 + hstep, voffA);
            PG8_WAIT_L(8); PG8_BAR; PG8_WAIT_L(0); PG8_MMA(0, 0, At, B0); PG8_BAR; PG8_SCHED;
            PG8_LDB(B1, 1, 1); PG8_STAGE(PG8_SB(1, 0), b3, voffB);
            PG8_BAR; PG8_WAIT_L(0); PG8_MMA(0, 1, At, B1); PG8_BAR;
            PG8_LDA(At, 1, 1); PG8_STAGE(PG8_SA(1, 0), a3, voffA);
            PG8_BAR; PG8_WAIT_L(0); PG8_MMA(1, 0, At, B0); PG8_BAR; PG8_SCHED;
            PG8_STAGE(PG8_SB(1, 1), b3 + hstep, voffB);
            PG8_WAIT_V(6); PG8_BAR; PG8_MMA(1, 1, At, B1); PG8_BAR;
            }
        }
        if constexpr (ALIGN_EPI) { if (wr == 0) PG8_BAR; }
        if constexpr (!Epi::AFTER_DRAIN) { E(acc, cur, wr, wc, fr, fq); S.done(cur); }
        if (!has_next) break;
#pragma unroll
        for (int a = 0; a < 2; ++a)
#pragma unroll
            for (int b = 0; b < 2; ++b)
#pragma unroll
                for (int m = 0; m < 4; ++m)
#pragma unroll
                    for (int n = 0; n < 2; ++n) acc[a][b][m][n] = (f32x4){0.f, 0.f, 0.f, 0.f};
        cur = nxt; cA = nA; cB = nB; ++ui;
        if constexpr (ALIGN_EPI) { if (wr == 1) PG8_BAR; }
    }
    PG8_WAIT_V(0);
    if constexpr (!ALIGN_EPI) { if (wr == 0) PG8_BAR; }
    PG8_BAR;
    if constexpr (Epi::AFTER_DRAIN) { E.fused(acc, cur, wr, wc, fr, fq, lds, wid, lane); S.done(cur); }
#undef PG8_SA
#undef PG8_SB
#undef PG8_STAGE
#undef PG8_LDA
#undef PG8_LDB
#undef PG8_MMA
#undef PG8_WAIT_V
#undef PG8_WAIT_L
#undef PG8_BAR
#undef PG8_SCHED
}
}


#define DI __device__ __forceinline__
typedef unsigned short bf16_t;
typedef short bf16x8 __attribute__((ext_vector_type(8)));
typedef float f32x4 __attribute__((ext_vector_type(4)));
typedef float f32x2 __attribute__((ext_vector_type(2)));
typedef float f32x16 __attribute__((ext_vector_type(16)));
typedef unsigned u32x4 __attribute__((ext_vector_type(4)));
#define MFMA32(a, b, c) __builtin_amdgcn_mfma_f32_32x32x16_bf16((a), (b), (c), 0, 0, 0)
#define LAS __attribute__((address_space(3)))

constexpr int NT = 512;
constexpr int DM = 1024, MP = 16384, MT = 16896;
constexpr int NIN = 10368, NINP = 10496, CSH = 4224;
constexpr float EPS = 1e-6f, LNX_EPS = 64e-5f;
constexpr float QSCALE = 0.18033688011112042f;

constexpr size_t OUT_YP = 0, OUT_KP = 17301504, OUT_VP = 34078720, OUT_SHP = 50855936, OUT_WP = 50872832,
                 OUT_KS = 51134976, OUT_VS = 51659264, OUT_SHS = 52183552, OUT_WS = 52318720;

constexpr size_t SZ_ACT = (size_t)MT * 1024 * 2;
constexpr size_t WS_R1 = 0;
constexpr size_t WS_H = WS_R1, WS_WINT = WS_R1 + SZ_ACT, WS_SW = WS_R1;
constexpr size_t WS_R2 = (size_t)MT * 1024 * 4;
constexpr size_t WS_PB = WS_R2, WS_ORAW = WS_R2, WS_OB = WS_ORAW + (size_t)MT * 1024 * 4, WS_MG = WS_OB + SZ_ACT;
constexpr size_t WS_R3 = WS_R2 + (size_t)MT * CSH * 2;
constexpr size_t WS_QB = WS_R3, WS_X = WS_QB + SZ_ACT  , WS_BTL = WS_X + (size_t)MT * 256 * 2  , WS_SZA = WS_X + (size_t)MP * 1024 * 2;
static_assert(WS_BTL + (size_t)2048 * 256 * 2 <= WS_SZA, "LoRA buffers");
constexpr size_t WS_SR = WS_SZA + SZ_ACT, WS_SK = WS_SR + SZ_ACT, WS_SV = WS_SK + SZ_ACT, WS_SKK = WS_SV + SZ_ACT, WS_SB = WS_SKK + SZ_ACT;
constexpr size_t WS_SZB = WS_SB + SZ_ACT;
constexpr size_t WS_BONUS = WS_SZB + SZ_ACT;
constexpr size_t WS_WT = WS_BONUS + (size_t)MT * 16 * 4;
constexpr size_t WS_CTL = WS_WT + 3 * (size_t)1024 * 1024 * 2;
constexpr size_t WS_END = WS_CTL + 65536;
static_assert(WS_MG + SZ_ACT <= WS_R3, "R2 overflow");
static_assert(WS_WINT + (size_t)NINP * 1024 * 2 <= WS_R2, "R1 overflow");
static_assert(WS_END <= (size_t)512 * 1024 * 1024, "workspace");

constexpr int SMEM_BYTES = 147456;

struct Params { const float* in[22]; float* out; unsigned char* ws; };

DI float bf2f(bf16_t u) { return __uint_as_float((unsigned)u << 16); }
DI unsigned cvtpk(float lo, float hi) { unsigned r; asm volatile("v_cvt_pk_bf16_f32 %0, %1, %2" : "=v"(r) : "v"(lo), "v"(hi)); return r; }
DI bf16_t f2bf(float x) { return (bf16_t)(cvtpk(x, 0.f) & 0xffffu); }
DI float bflo(unsigned u) { return __uint_as_float(u << 16); }
DI float bfhi(unsigned u) { return __uint_as_float(u & 0xffff0000u); }
DI int crow(int i, int h) { return (i & 3) + 8 * (i >> 2) + 4 * h; }
DI float sigmoidf_(float x) { return fminf(__builtin_amdgcn_rcpf(1.f + __expf(-x)), 1.f); }
typedef unsigned u32x2 __attribute__((ext_vector_type(2)));
DI uint2 ntload2(const void* q) { const u32x2 v = __builtin_nontemporal_load((const u32x2*)q); return make_uint2(v.x, v.y); }
DI void ntstore2(void* q, uint2 v) { const u32x2 t = {v.x, v.y}; __builtin_nontemporal_store(t, (u32x2*)q); }
DI uint4 pack8(f32x4 a, f32x4 b) { return make_uint4(cvtpk(a[0], a[1]), cvtpk(a[2], a[3]), cvtpk(b[0], b[1]), cvtpk(b[2], b[3])); }
template <int CTRL> DI float dppf(float x) { return __builtin_bit_cast(float, __builtin_amdgcn_mov_dpp(__builtin_bit_cast(int, x), CTRL, 0xf, 0xf, true)); }
DI float sum16(float x) { x += dppf<0xB1>(x); x += dppf<0x4E>(x); x += dppf<0x124>(x); x += dppf<0x128>(x); return x; }
DI float wave_sum(float x) {
  x = sum16(x);
  const auto s = __builtin_amdgcn_permlane16_swap(__float_as_uint(x), __float_as_uint(x), false, false);
  x = __uint_as_float(s[0]) + __uint_as_float(s[1]);
  const auto t = __builtin_amdgcn_permlane32_swap(__float_as_uint(x), __float_as_uint(x), false, false);
  return __uint_as_float(t[0]) + __uint_as_float(t[1]);
}
DI float row32_sum(float x) {
  x += dppf<0xB1>(x);
  x += dppf<0x4E>(x);
  x += dppf<0x124>(x);
  x += dppf<0x128>(x);
  const auto s = __builtin_amdgcn_permlane16_swap(__float_as_uint(x), __float_as_uint(x), false, false);
  return __uint_as_float(s[0]) + __uint_as_float(s[1]);
}
DI size_t hm_base(int row) {
  if (row < MP) { const int b = row >> 12, t = row & 4095; return ((size_t)(b * 16) * 4096 + t) * 64; }
  const int rs = row - MP, b = rs >> 4, t = rs & 15; return (size_t)MP * 1024 + ((size_t)(b * 16) * 16 + t) * 64;
}
DI size_t hm_hstride(int row) { return row < MP ? (size_t)4096 * 64 : (size_t)16 * 64; }

DI void p0_rmsnorm_rows(const Params& p, int item) {
  const int lane = TIDX & 63, wid = TIDX >> 6;
  const int row = item * 8 + wid;
  const float* x = row < MP ? p.in[0] + (size_t)row * DM : p.in[1] + (size_t)(row - MP) * DM;
  const float* g = p.in[6];
  float4 v[4]; float ss = 0.f;
#pragma unroll
  for (int i = 0; i < 4; ++i) { v[i] = *(const float4*)(x + i * 256 + lane * 4); ss += v[i].x * v[i].x + v[i].y * v[i].y + v[i].z * v[i].z + v[i].w * v[i].w; }
  ss = wave_sum(ss);
  const float inv = rsqrtf(ss * (1.f / DM) + EPS);
  bf16_t* H = (bf16_t*)(p.ws + WS_H) + (size_t)row * DM;
#pragma unroll
  for (int i = 0; i < 4; ++i) {
    const float4 gg = *(const float4*)(g + i * 256 + lane * 4);
    uint2 o; o.x = cvtpk(v[i].x * inv * gg.x, v[i].y * inv * gg.y); o.y = cvtpk(v[i].z * inv * gg.z, v[i].w * inv * gg.w);
    *(uint2*)(H + i * 256 + lane * 4) = o;
  }
}
DI void p0_transpose_tile(const float* src, bf16_t* dst, int N, int kt, int nt, float* lds) {
  const int tid = TIDX & 255;
  const int k0 = kt * 64, n0 = nt * 64;
#pragma unroll
  for (int i = 0; i < 4; ++i) {
    const int row = (tid >> 4) + 16 * i, c4 = (tid & 15) * 4;
    const float4 v = *(const float4*)(src + (size_t)(k0 + row) * N + n0 + c4);
    lds[row * 65 + c4 + 0] = v.x; lds[row * 65 + c4 + 1] = v.y; lds[row * 65 + c4 + 2] = v.z; lds[row * 65 + c4 + 3] = v.w;
  }
  __syncthreads();
  const int n = tid >> 2, kc = (tid & 3) * 16;
  unsigned w[8];
#pragma unroll
  for (int j = 0; j < 8; ++j) w[j] = cvtpk(lds[(kc + 2 * j) * 65 + n], lds[(kc + 2 * j + 1) * 65 + n]);
  uint4* d = (uint4*)(dst + (size_t)(n0 + n) * 1024 + k0 + kc);
  d[0] = make_uint4(w[0], w[1], w[2], w[3]); d[1] = make_uint4(w[4], w[5], w[6], w[7]);
  __syncthreads();
}
DI void phase0(const Params& p, char* smem) {
  {
    bf16_t* BL = (bf16_t*)(p.ws + WS_BTL);
    for (int i = blockIdx.x * NT + TIDX; i < 2048 * 256; i += gridDim.x * NT) {
      const int n = i >> 8, k = i & 255;
      float v = 0.f;
      if (n < 1024) { if (k < 64) v = p.in[10][(size_t)k * 1024 + n]; }
      else if (k >= 64 && k < 128) v = p.in[12][(size_t)(k - 64) * 1024 + (n - 1024)];
      BL[i] = f2bf(v);
    }
  }
  constexpr int N_ROWS = MT / 8, N_TIN = 16 * 162 / 2, N_TSQ = 256 / 2;
  constexpr int N_ITEMS = N_ROWS + N_TIN + 3 * N_TSQ;
  const int half = TIDX >> 8;
  float* scr = (float*)smem + half * (64 * 65);
  for (int it = blockIdx.x; it < N_ITEMS; it += gridDim.x) {
    if (it < N_ROWS) { p0_rmsnorm_rows(p, it); continue; }
    int j = it - N_ROWS;
    if (j < N_TIN) { const int t = 2 * j + half; p0_transpose_tile(p.in[7], (bf16_t*)(p.ws + WS_WINT), NIN, t / 162, t % 162, scr); continue; }
    j -= N_TIN;
    const int w = j / N_TSQ; const int t = 2 * (j % N_TSQ) + half;
    p0_transpose_tile(p.in[18 + w], (bf16_t*)(p.ws + WS_WT) + (size_t)w * 1024 * 1024, 1024, t >> 4, t & 15, scr);
  }
}

struct EpiP1 {
  static constexpr bool PERM = true, AFTER_DRAIN = false;
  Params p;
  DI void operator()(const pg8::f32x4 (&acc)[2][2][4][2], const pg8::Unit& u, int wr, int wc, int fr, int fq) const {
    const int colt = u.pn * 256;
    const int region = colt >> 10;
#pragma unroll
    for (int ai = 0; ai < 2; ++ai)
#pragma unroll
      for (int m = 0; m < 4; ++m) {
        const int row = u.pm * 256 + ai * 128 + wr * 64 + m * 16 + fr;
        const bool prompt = row < MP;
        const int rs = row - MP;
#pragma unroll
        for (int bj = 0; bj < 2; ++bj) {
          const int col = colt + bj * 128 + wc * 32 + 8 * fq;
          const f32x4 v0 = acc[ai][bj][m][0], v1 = acc[ai][bj][m][1];
          if (region >= 6) {
            const int pc = col - 6144;
            if (pc < CSH) {
              *(uint4*)((bf16_t*)(p.ws + WS_PB) + (size_t)row * CSH + pc) = pack8(v0, v1);
              float* so = nullptr;
              if (prompt) { if ((row & 4095) == 4095) so = p.out + OUT_SHP + (size_t)(row >> 12) * CSH + pc; }
              else if ((rs & 15) == 15) so = p.out + OUT_SHS + (size_t)(rs >> 4) * CSH + pc;
              if (so) { *(f32x4*)so = v0; *(f32x4*)(so + 4) = v1; }
            }
          } else if (region == 0) {
            *(uint4*)((bf16_t*)(p.ws + WS_QB) + (size_t)row * 1024 + col) = pack8(v0 * QSCALE, v1 * QSCALE);
          } else if (region == 1) {
            const int c = col - 1024, hh = c >> 6, d = c & 63;
            float* o = prompt ? p.out + OUT_KP + (((size_t)(row >> 12) * 16 + hh) * 4096 + (row & 4095)) * 64 + d
                              : p.out + OUT_KS + (((size_t)(rs >> 4) * 16 + hh) * 16 + (rs & 15)) * 64 + d;
            __builtin_nontemporal_store(v0, (f32x4*)o); __builtin_nontemporal_store(v1, (f32x4*)(o + 4));
          } else if (region == 2) {
            const int c = col - 2048, hh = c >> 6, d = c & 63;
            float* o = prompt ? p.out + OUT_VP + (((size_t)(row >> 12) * 16 + hh) * 4096 + (row & 4095)) * 64 + d
                              : p.out + OUT_VS + (((size_t)(rs >> 4) * 16 + hh) * 16 + (rs & 15)) * 64 + d;
            __builtin_nontemporal_store(v0, (f32x4*)o); __builtin_nontemporal_store(v1, (f32x4*)(o + 4));
          } else if (region == 3) {
            f32x4 a, b;
#pragma unroll
            for (int j = 0; j < 4; ++j) { a[j] = v0[j] * sigmoidf_(v0[j]); b[j] = v1[j] * sigmoidf_(v1[j]); }
            *(uint4*)((bf16_t*)(p.ws + WS_SZA) + (size_t)row * 1024 + (col - 3072)) = pack8(a, b);
          } else {
            f32x4 a, b;
#pragma unroll
            for (int j = 0; j < 4; ++j) { a[j] = sigmoidf_(v0[j]); b[j] = sigmoidf_(v1[j]); }
            *(uint4*)((bf16_t*)p.out + (size_t)row * 2048 + (col - 4096)) = pack8(a, b);
          }
        }
      }
  }
};
struct EpiGate {
  static constexpr bool PERM = true, AFTER_DRAIN = false;
  Params p; int goff; bool first;
  DI void operator()(const pg8::f32x4 (&acc)[2][2][4][2], const pg8::Unit& u, int wr, int wc, int fr, int fq) const {
    const bf16_t* G = (const bf16_t*)p.out; bf16_t* MG = (bf16_t*)(p.ws + WS_MG);
#pragma unroll
    for (int ai = 0; ai < 2; ++ai)
#pragma unroll
      for (int m = 0; m < 4; ++m) {
        const size_t row = u.pm * 256 + ai * 128 + wr * 64 + m * 16 + fr;
#pragma unroll
        for (int bj = 0; bj < 2; ++bj) {
          const int col = u.pn * 256 + bj * 128 + wc * 32 + 8 * fq;
          const uint4 g = *(const uint4*)(G + row * 2048 + goff + col);
          f32x4 a = acc[ai][bj][m][0], b = acc[ai][bj][m][1];
          a[0] *= bflo(g.x); a[1] *= bfhi(g.x); a[2] *= bflo(g.y); a[3] *= bfhi(g.y);
          b[0] *= bflo(g.z); b[1] *= bfhi(g.z); b[2] *= bflo(g.w); b[3] *= bfhi(g.w);
          if (!first) {
            const uint4 o = *(const uint4*)(MG + row * 1024 + col);
            a[0] += bflo(o.x); a[1] += bfhi(o.x); a[2] += bflo(o.y); a[3] += bfhi(o.y);
            b[0] += bflo(o.z); b[1] += bfhi(o.z); b[2] += bflo(o.w); b[3] += bfhi(o.w);
          }
          *(uint4*)(MG + row * 1024 + col) = pack8(a, b);
        }
      }
  }
};
struct EpiOut {
  static constexpr bool PERM = true, AFTER_DRAIN = false;
  Params p;
  DI void operator()(const pg8::f32x4 (&acc)[2][2][4][2], const pg8::Unit& u, int wr, int wc, int fr, int fq) const {
#pragma unroll
    for (int ai = 0; ai < 2; ++ai)
#pragma unroll
      for (int m = 0; m < 4; ++m) {
        const int row = u.pm * 256 + ai * 128 + wr * 64 + m * 16 + fr;
        const float* xr = row < MP ? p.in[0] + (size_t)row * 1024 : p.in[1] + (size_t)(row - MP) * 1024;
        float* orow = p.out + OUT_YP + (size_t)row * 1024;
#pragma unroll
        for (int bj = 0; bj < 2; ++bj) {
          const int col = u.pn * 256 + bj * 128 + wc * 32 + 8 * fq;
          const f32x4 x0 = *(const f32x4*)(xr + col), x1 = *(const f32x4*)(xr + col + 4);
          *(f32x4*)(orow + col) = x0 + acc[ai][bj][m][0]; *(f32x4*)(orow + col + 4) = x1 + acc[ai][bj][m][1];
        }
      }
  }
};
template <class Epi>
DI void run_gemm(char* smem, const bf16_t* A, const bf16_t* Bt, int M, int N, const Epi& E, int K = 1024) {
  pg8::Gemm g; g.A = A; g.Bt = Bt; g.M = M; g.N = N; g.K = K;
  pg8::StaticOrder S; S.init(M, N, (int)gridDim.x, (int)blockIdx.x);
  pg8::gemm_phase<Epi, pg8::StaticOrder, true, true>((LAS unsigned char*)smem, g, S, E);
  __syncthreads();
}

template <int MODE>
DI void small_gemm(const Params& p, const bf16_t* A, const bf16_t* Bt) {
  int t_ = TIDX; asm volatile("" : "+v"(t_));
  const int lane = t_ & 63, wid = __builtin_amdgcn_readfirstlane(t_ >> 6), fr = lane & 15, fq = lane >> 4;
  for (int tile = wid * gridDim.x + blockIdx.x; tile < 2048; tile += 8 * gridDim.x) {
    const int row0 = MP + (tile >> 6) * 16, col0 = (tile & 63) * 16;
    const bf16_t* pa = A + (size_t)(row0 + fr) * 1024 + 8 * fq;
    const bf16_t* pb = Bt + (size_t)(col0 + fr) * 1024 + 8 * fq;
    f32x4 acc = {0.f, 0.f, 0.f, 0.f};
#pragma unroll 8
    for (int s = 0; s < 32; ++s) acc = __builtin_amdgcn_mfma_f32_16x16x32_bf16(*(const bf16x8*)(pa + 32 * s), *(const bf16x8*)(pb + 32 * s), acc, 0, 0, 0);
    const int col = col0 + fr;
#pragma unroll
    for (int j = 0; j < 4; ++j) {
      const size_t row = row0 + 4 * fq + j;
      if (MODE == 2) p.out[OUT_YP + row * 1024 + col] = p.in[1][(row - MP) * 1024 + col] + acc[j];
      else {
        bf16_t* mg = (bf16_t*)(p.ws + WS_MG) + row * 1024 + col;
        const float g = bf2f(((const bf16_t*)p.out)[row * 2048 + (MODE == 1 ? 1024 : 0) + col]);
        *mg = f2bf((MODE == 1 ? bf2f(*mg) : 0.f) + acc[j] * g);
      }
    }
  }
}

DI float tanh_fast(float x) { return 1.f - 2.f * __builtin_amdgcn_rcpf(1.f + __expf(2.f * x)); }
DI void phase_x(const Params& p) {
  const bf16_t* PB = (const bf16_t*)(p.ws + WS_PB);
  bf16_t* X = (bf16_t*)(p.ws + WS_X);
  const float* mu = p.in[8];
  for (int i = blockIdx.x * NT + TIDX; i < MT * 32; i += gridDim.x * NT) {
    const int row = i >> 5, g = i & 31;
    uint4 o = make_uint4(0u, 0u, 0u, 0u);
    if (g < 16) {
      const int col = 3072 + g * 8;
      const bool prompt = row < MP;
      const int t = prompt ? (row & 4095) : ((row - MP) & 15);
      const uint4 a = *(const uint4*)(PB + (size_t)row * CSH + col);
      float c[8] = {bflo(a.x), bfhi(a.x), bflo(a.y), bfhi(a.y), bflo(a.z), bfhi(a.z), bflo(a.w), bfhi(a.w)}, q[8];
      if (t != 0) { const uint4 b = *(const uint4*)(PB + (size_t)(row - 1) * CSH + col); q[0] = bflo(b.x); q[1] = bfhi(b.x); q[2] = bflo(b.y); q[3] = bfhi(b.y); q[4] = bflo(b.z); q[5] = bfhi(b.z); q[6] = bflo(b.w); q[7] = bfhi(b.w); }
      else if (prompt) {
#pragma unroll
        for (int j = 0; j < 8; ++j) q[j] = 0.f;
      } else { const float* s = p.in[4] + (size_t)((row - MP) >> 4) * CSH + col; const float4 b0 = *(const float4*)s, b1 = *(const float4*)(s + 4); q[0] = b0.x; q[1] = b0.y; q[2] = b0.z; q[3] = b0.w; q[4] = b1.x; q[5] = b1.y; q[6] = b1.z; q[7] = b1.w; }
      const float4 u0 = *(const float4*)(mu + col), u1 = *(const float4*)(mu + col + 4);
      const float u[8] = {u0.x, u0.y, u0.z, u0.w, u1.x, u1.y, u1.z, u1.w};
      float m[8];
#pragma unroll
      for (int j = 0; j < 8; ++j) { m[j] = c[j] + u[j] * (q[j] - c[j]); if (g < 8) m[j] = tanh_fast(m[j]); }
      o = make_uint4(cvtpk(m[0], m[1]), cvtpk(m[2], m[3]), cvtpk(m[4], m[5]), cvtpk(m[6], m[7]));
    }
    *(uint4*)(X + (size_t)row * 256 + g * 8) = o;
  }
}
struct EpiLora {
  static constexpr bool PERM = true, AFTER_DRAIN = false;
  Params p;
  DI void operator()(const pg8::f32x4 (&acc)[2][2][4][2], const pg8::Unit& u, int wr, int wc, int fr, int fq) const {
    const bool isw = u.pn < 4;
#pragma unroll
    for (int ai = 0; ai < 2; ++ai)
#pragma unroll
      for (int m = 0; m < 4; ++m) {
        const int row = u.pm * 256 + ai * 128 + wr * 64 + m * 16 + fr;
        const size_t hb = hm_base(row), hs = hm_hstride(row);
#pragma unroll
        for (int bj = 0; bj < 2; ++bj) {
          const int c = (u.pn & 3) * 256 + bj * 128 + wc * 32 + 8 * fq;
          const size_t idx = hb + (c >> 6) * hs + (c & 63);
          const f32x4 v0 = acc[ai][bj][m][0], v1 = acc[ai][bj][m][1];
          if (isw) {
            const f32x4 b0 = *(const f32x4*)(p.in[9] + c), b1 = *(const f32x4*)(p.in[9] + c + 4);
            f32x4 d0, d1;
#pragma unroll
            for (int j = 0; j < 4; ++j) {
              const float x0 = -(b0[j] + v0[j]), x1 = -(b1[j] + v1[j]);
              const float s0 = fmaxf(x0, 0.f) + __logf(1.f + __expf(-fabsf(x0))), s1 = fmaxf(x1, 0.f) + __logf(1.f + __expf(-fabsf(x1)));
              d0[j] = __expf(-__expf(-s0 - 0.5f)); d1[j] = __expf(-__expf(-s1 - 0.5f));
            }
            float* o = (float*)(p.ws + WS_SW) + idx; *(f32x4*)o = d0; *(f32x4*)(o + 4) = d1;
          } else {
            const f32x4 b0 = *(const f32x4*)(p.in[11] + c), b1 = *(const f32x4*)(p.in[11] + c + 4);
            f32x4 d0, d1;
#pragma unroll
            for (int j = 0; j < 4; ++j) { d0[j] = sigmoidf_(b0[j] + v0[j]); d1[j] = sigmoidf_(b1[j] + v1[j]); }
            *(uint4*)((bf16_t*)(p.ws + WS_SB) + idx) = pack8(d0, d1);
          }
        }
      }
  }
};
DI void small_lora(const Params& p) {
  const int lane = TIDX & 63, wid = TIDX >> 6, r = lane & 31, h = lane >> 5;
  const bf16_t* X = (const bf16_t*)(p.ws + WS_X); const bf16_t* BL = (const bf16_t*)(p.ws + WS_BTL);
  for (int tile = wid * gridDim.x + blockIdx.x; tile < 16 * 64; tile += 8 * gridDim.x) {
    const int row0 = MP + (tile >> 6) * 32, ct = tile & 63, col0 = ct * 32, k0 = ct < 32 ? 0 : 64;
    const bf16_t* pa = X + (size_t)(row0 + r) * 256 + k0 + 8 * h;
    const bf16_t* pb = BL + (size_t)(col0 + r) * 256 + k0 + 8 * h;
    f32x16 acc;
#pragma unroll
    for (int i = 0; i < 16; ++i) acc[i] = 0.f;
#pragma unroll
    for (int s = 0; s < 4; ++s) acc = MFMA32(*(const bf16x8*)(pa + 16 * s), *(const bf16x8*)(pb + 16 * s), acc);
    const int c = (col0 + r) & 1023;
    const float bias = ct < 32 ? p.in[9][c] : p.in[11][c];
#pragma unroll
    for (int i = 0; i < 16; ++i) {
      const int row = row0 + crow(i, h);
      const size_t idx = hm_base(row) + (c >> 6) * hm_hstride(row) + (c & 63);
      const float v = bias + acc[i];
      if (ct < 32) {
        const float x = -v, sp = fmaxf(x, 0.f) + __logf(1.f + __expf(-fabsf(x)));
        ((float*)(p.ws + WS_SW))[idx] = __expf(-__expf(-sp - 0.5f));
      } else ((bf16_t*)(p.ws + WS_SB))[idx] = f2bf(sigmoidf_(v));
    }
  }
}

DI void phase1c(const Params& p) {
  const int tid = TIDX & 255, half = TIDX >> 8, c = tid * 4, hh = c >> 6;
  const bf16_t* PB = (const bf16_t*)(p.ws + WS_PB);
  const float* mu = p.in[8];
  const float4 kkw = *(const float4*)(p.in[13] + c), kaw = *(const float4*)(p.in[14] + c), rkw = *(const float4*)(p.in[15] + c);
  const float4 mur = *(const float4*)(mu + c), muk = *(const float4*)(mu + 1024 + c), muv = *(const float4*)(mu + 2048 + c), muz = *(const float4*)(mu + 3200 + c);
  const float kka[4] = {kkw.x, kkw.y, kkw.z, kkw.w}, kaa[4] = {kaw.x, kaw.y, kaw.z, kaw.w}, rka[4] = {rkw.x, rkw.y, rkw.z, rkw.w};
  const float mura[4] = {mur.x, mur.y, mur.z, mur.w}, muka[4] = {muk.x, muk.y, muk.z, muk.w}, muva[4] = {muv.x, muv.y, muv.z, muv.w}, muza[4] = {muz.x, muz.y, muz.z, muz.w};
  bf16_t* SR = (bf16_t*)(p.ws + WS_SR); bf16_t* SK = (bf16_t*)(p.ws + WS_SK); bf16_t* SV = (bf16_t*)(p.ws + WS_SV);
  bf16_t* SKK = (bf16_t*)(p.ws + WS_SKK); bf16_t* SB = (bf16_t*)(p.ws + WS_SB); bf16_t* SZB = (bf16_t*)(p.ws + WS_SZB);
  float* BONUS = (float*)(p.ws + WS_BONUS);
  for (int r4 = blockIdx.x * 2 + half; r4 < MT / 4; r4 += gridDim.x * 2) {
    const int row0 = r4 * 4;
    const bool prompt = row0 < MP;
    const int t0 = prompt ? (row0 & 4095) : ((row0 - MP) & 15);
    uint2 gr[5], gk[5], gv[5], gz[5], ga[4];
#pragma unroll
    for (int t = 0; t < 5; ++t) {
      const int rr_ = (t == 0 && t0 == 0) ? row0 : row0 + t - 1;
      const bf16_t* pc = PB + (size_t)rr_ * CSH;
      gr[t] = ntload2(pc + c); gk[t] = ntload2(pc + 1024 + c); gv[t] = ntload2(pc + 2048 + c); gz[t] = ntload2(pc + 3200 + c);
    }
    size_t idx[4];
#pragma unroll
    for (int t = 0; t < 4; ++t) { idx[t] = hm_base(row0 + t) + hh * hm_hstride(row0 + t) + (c & 63); ga[t] = *(const uint2*)(SB + idx[t]); }
    float pr[4], pk[4], pv[4], pz[4];
    if (t0 == 0) {
      if (prompt) {
#pragma unroll
        for (int x = 0; x < 4; ++x) { pr[x] = 0.f; pk[x] = 0.f; pv[x] = 0.f; pz[x] = 0.f; }
      } else {
        const float* s = p.in[4] + (size_t)((row0 - MP) >> 4) * CSH;
        const float4 a = *(const float4*)(s + c), b = *(const float4*)(s + 1024 + c), d = *(const float4*)(s + 2048 + c), e = *(const float4*)(s + 3200 + c);
        pr[0] = a.x; pr[1] = a.y; pr[2] = a.z; pr[3] = a.w; pk[0] = b.x; pk[1] = b.y; pk[2] = b.z; pk[3] = b.w;
        pv[0] = d.x; pv[1] = d.y; pv[2] = d.z; pv[3] = d.w; pz[0] = e.x; pz[1] = e.y; pz[2] = e.z; pz[3] = e.w;
      }
    } else {
      pr[0] = bflo(gr[0].x); pr[1] = bfhi(gr[0].x); pr[2] = bflo(gr[0].y); pr[3] = bfhi(gr[0].y);
      pk[0] = bflo(gk[0].x); pk[1] = bfhi(gk[0].x); pk[2] = bflo(gk[0].y); pk[3] = bfhi(gk[0].y);
      pv[0] = bflo(gv[0].x); pv[1] = bfhi(gv[0].x); pv[2] = bflo(gv[0].y); pv[3] = bfhi(gv[0].y);
      pz[0] = bflo(gz[0].x); pz[1] = bfhi(gz[0].x); pz[2] = bflo(gz[0].y); pz[3] = bfhi(gz[0].y);
    }
#pragma unroll
    for (int t = 0; t < 4; ++t) {
      const int row = row0 + t;
      const float curr[4] = {bflo(gr[t + 1].x), bfhi(gr[t + 1].x), bflo(gr[t + 1].y), bfhi(gr[t + 1].y)}, curk[4] = {bflo(gk[t + 1].x), bfhi(gk[t + 1].x), bflo(gk[t + 1].y), bfhi(gk[t + 1].y)};
      const float curv[4] = {bflo(gv[t + 1].x), bfhi(gv[t + 1].x), bflo(gv[t + 1].y), bfhi(gv[t + 1].y)}, curz[4] = {bflo(gz[t + 1].x), bfhi(gz[t + 1].x), bflo(gz[t + 1].y), bfhi(gz[t + 1].y)};
      const float av[4] = {bflo(ga[t].x), bfhi(ga[t].x), bflo(ga[t].y), bfhi(ga[t].y)};
      float rm[4], km[4], vm[4], kkv[4], bb[4], kmod[4], szb[4];
      float ssq = 0.f, bon = 0.f;
#pragma unroll
      for (int x = 0; x < 4; ++x) {
        rm[x] = curr[x] + mura[x] * (pr[x] - curr[x]);
        km[x] = curk[x] + muka[x] * (pk[x] - curk[x]);
        vm[x] = curv[x] + muva[x] * (pv[x] - curv[x]);
        const float zm = curz[x] + muza[x] * (pz[x] - curz[x]);
        szb[x] = zm * sigmoidf_(zm);
        kkv[x] = km[x] * kka[x];
        ssq += kkv[x] * kkv[x];
        kmod[x] = km[x] * (1.f + (av[x] - 1.f) * kaa[x]);
        bon += rm[x] * kmod[x] * rka[x];
        pr[x] = curr[x]; pk[x] = curk[x]; pv[x] = curv[x]; pz[x] = curz[x];
      }
      ssq = sum16(ssq); bon = sum16(bon);
      const float inv = 1.f / fmaxf(sqrtf(ssq), 1e-12f);
#pragma unroll
      for (int x = 0; x < 4; ++x) { kkv[x] *= inv; bb[x] = kkv[x] * av[x]; }
      ntstore2(SR + idx[t], make_uint2(cvtpk(rm[0], rm[1]), cvtpk(rm[2], rm[3])));
      ntstore2(SK + idx[t], make_uint2(cvtpk(kmod[0], kmod[1]), cvtpk(kmod[2], kmod[3])));
      ntstore2(SV + idx[t], make_uint2(cvtpk(vm[0], vm[1]), cvtpk(vm[2], vm[3])));
      ntstore2(SKK + idx[t], make_uint2(cvtpk(-kkv[0], -kkv[1]), cvtpk(-kkv[2], -kkv[3])));
      ntstore2(SB + idx[t], make_uint2(cvtpk(bb[0], bb[1]), cvtpk(bb[2], bb[3])));
      ntstore2(SZB + (size_t)row * 1024 + c, make_uint2(cvtpk(szb[0], szb[1]), cvtpk(szb[2], szb[3])));
      if ((tid & 15) == 0) BONUS[(size_t)row * 16 + hh] = bon;
    }
  }
}

template <bool SAMPLE>
DI void attn_wave(const Params& p, int sh, int qt) {
  const int lane = TIDX & 63, r = lane & 31, h = lane >> 5;
  const int hh = sh & 15, b = sh >> 4;
  bf16_t* QB = (bf16_t*)(p.ws + WS_QB);
  const int row0 = SAMPLE ? MP + b * 16 : b * 4096 + qt * 32;
  bf16_t* Qp = QB + (size_t)row0 * 1024 + hh * 64;
  const int qrow = SAMPLE ? (r < 15 ? r : 15) : r;
  bf16x8 qf[4];
#pragma unroll
  for (int s = 0; s < 4; ++s) qf[s] = *(const bf16x8*)(Qp + (size_t)qrow * 1024 + 16 * s + 8 * h);
  f32x16 z0, z1;
#pragma unroll
  for (int i = 0; i < 16; ++i) { z0[i] = 0.f; z1[i] = 0.f; }
  float carry = 1.f;
  const int ntiles = SAMPLE ? 33 : qt + 1;
  for (int it = 0; it < ntiles; ++it) {
    const bool diag = (it == 0);
    const int kt = SAMPLE ? 32 - it : qt - it;
    bf16x8 kf[4];
    {
      const float* Kp;
      if (!SAMPLE) Kp = p.out + OUT_KP + ((size_t)sh * 4096 + kt * 32 + r) * 64;
      else Kp = diag ? p.out + OUT_KS + ((size_t)sh * 16 + (r < 15 ? r : 15)) * 64 : p.in[2] + ((size_t)sh * 1024 + kt * 32 + r) * 64;
#pragma unroll
      for (int s = 0; s < 4; ++s) {
        const float4 a = *(const float4*)(Kp + 16 * s + 8 * h), bq = *(const float4*)(Kp + 16 * s + 8 * h + 4);
        u32x4 w; w[0] = cvtpk(a.x, a.y); w[1] = cvtpk(a.z, a.w); w[2] = cvtpk(bq.x, bq.y); w[3] = cvtpk(bq.z, bq.w);
        kf[s] = __builtin_bit_cast(bf16x8, w);
      }
    }
    f32x16 st;
#pragma unroll
    for (int i = 0; i < 16; ++i) st[i] = 0.f;
#pragma unroll
    for (int s = 0; s < 4; ++s) st = MFMA32(kf[s], qf[s], st);
    float keep[16], wgt[16];
#pragma unroll
    for (int i = 0; i < 16; ++i) {
      const float e = __builtin_amdgcn_exp2f(st[i]);
      const float kp = __builtin_amdgcn_rcpf(1.f + e);
      bool valid = true;
      if (diag) { const int kr = crow(i, h); valid = SAMPLE ? (kr < r && kr < 16) : (kr < r); }
      keep[i] = valid ? kp : 1.f;
      wgt[i] = valid ? 1.f - kp : 0.f;
    }
    float pp[4], hif[4];
#pragma unroll
    for (int g = 0; g < 4; ++g) {
      const float p4 = (keep[4 * g] * keep[4 * g + 1]) * (keep[4 * g + 2] * keep[4 * g + 3]);
      const auto sw = __builtin_amdgcn_permlane32_swap(__float_as_uint(p4), __float_as_uint(p4), false, false);
      const float lo = __uint_as_float(sw[0]), hi = __uint_as_float(sw[1]);
      pp[g] = lo * hi;
      hif[g] = h ? 1.f : hi;
    }
    float T[4];
    T[3] = carry; T[2] = T[3] * pp[3]; T[1] = T[2] * pp[2]; T[0] = T[1] * pp[1];
    carry = T[0] * pp[0];
#pragma unroll
    for (int g = 0; g < 4; ++g) {
      const float w3 = T[g] * hif[g], w2 = w3 * keep[4 * g + 3], w1 = w2 * keep[4 * g + 2], w0 = w1 * keep[4 * g + 1];
      wgt[4 * g + 3] *= w3; wgt[4 * g + 2] *= w2; wgt[4 * g + 1] *= w1; wgt[4 * g] *= w0;
    }
#pragma unroll
    for (int s = 0; s < 2; ++s) {
      u32x4 pw;
#pragma unroll
      for (int j = 0; j < 4; ++j) pw[j] = cvtpk(wgt[8 * s + 2 * j], wgt[8 * s + 2 * j + 1]);
      const bf16x8 pf = __builtin_bit_cast(bf16x8, pw);
#pragma unroll
      for (int db = 0; db < 2; ++db) {
        bf16x8 vf;
        {
          float vv[8];
#pragma unroll
          for (int j = 0; j < 8; ++j) {
            const int kr = 16 * s + 8 * (j >> 2) + 4 * h + (j & 3);
            const float* vp;
            if (!SAMPLE) vp = p.out + OUT_VP + ((size_t)sh * 4096 + kt * 32 + kr) * 64;
            else vp = diag ? p.out + OUT_VS + ((size_t)sh * 16 + (kr < 15 ? kr : 15)) * 64 : p.in[3] + ((size_t)sh * 1024 + kt * 32 + kr) * 64;
            vv[j] = vp[db * 32 + r];
          }
          u32x4 w; w[0] = cvtpk(vv[0], vv[1]); w[1] = cvtpk(vv[2], vv[3]); w[2] = cvtpk(vv[4], vv[5]); w[3] = cvtpk(vv[6], vv[7]);
          vf = __builtin_bit_cast(bf16x8, w);
        }
        if (db == 0) z0 = MFMA32(pf, vf, z0); else z1 = MFMA32(pf, vf, z1);
      }
    }
    if (__ballot(carry != 0.f) == 0ull) break;
  }
  const bf16_t* SZA = (const bf16_t*)(p.ws + WS_SZA);
#pragma unroll
  for (int i = 0; i < 16; ++i) {
    const int q = crow(i, h);
    if (SAMPLE && q >= 16) continue;
    const size_t o = (size_t)(row0 + q) * 1024 + hh * 64 + r;
    QB[o] = f2bf(z0[i] * bf2f(SZA[o]));
    QB[o + 32] = f2bf(z1[i] * bf2f(SZA[o + 32]));
  }
}

DI float row16_sum(float x) {
  x += dppf<0xB1>(x); x += dppf<0x4E>(x); x += dppf<0x124>(x); x += dppf<0x128>(x);
  return x;
}
DI void scan_wave(const Params& p, int shg, int slice, float* L) {
  const int lane = TIDX & 63, cc = lane & 15;
  const bool prompt = shg < 64;
  const int T = prompt ? 4096 : 16;
  const size_t base = prompt ? (size_t)shg * 4096 * 64 : (size_t)MP * 1024 + (size_t)(shg - 64) * 16 * 64;
  const int v = slice * 4 + (lane >> 4);
  const float* SW = (const float*)(p.ws + WS_SW) + base;
  const bf16_t* SARR = (const bf16_t*)(p.ws + WS_SR) + base;
  float* ORAW = (float*)(p.ws + WS_ORAW) + base;
  float4 S;
  float* wout;
  if (prompt) { S = make_float4(0.f, 0.f, 0.f, 0.f); wout = p.out + OUT_WP + ((size_t)shg * 64 + v) * 64 + 4 * cc; }
  else { S = *(const float4*)(p.in[5] + ((size_t)(shg - 64) * 64 + v) * 64 + 4 * cc); wout = p.out + OUT_WS + ((size_t)(shg - 64) * 64 + v) * 64 + 4 * cc; }
  const int nch = T / 8;
  const int dw0 = ((lane >> 4) * 6 + 2) * 64 + (lane & 15) * 4, dw1 = dw0 + 4 * 384;
  const int db = (lane >> 3) * 384 + (lane & 7) * 8;
  uint4 gw0, gw1, gr, gk, gv, gn, gb;
#define SCAN_GLOAD(ch) do { const float* w_ = SW + (size_t)(ch) * 512; gw0 = *(const uint4*)(w_ + lane * 4); gw1 = *(const uint4*)(w_ + 256 + lane * 4); \
    const bf16_t* a_ = SARR + (size_t)(ch) * 512 + lane * 8; gr = *(const uint4*)a_; gk = *(const uint4*)(a_ + SZ_ACT / 2); gv = *(const uint4*)(a_ + 2 * (SZ_ACT / 2)); \
    gn = *(const uint4*)(a_ + 3 * (SZ_ACT / 2)); gb = *(const uint4*)(a_ + 4 * (SZ_ACT / 2)); } while (0)
#define SCAN_PUT(slot, g) do { float* d_ = L + db + (slot) * 64; *(float4*)d_ = make_float4(bflo(g.x), bfhi(g.x), bflo(g.y), bfhi(g.y)); *(float4*)(d_ + 4) = make_float4(bflo(g.z), bfhi(g.z), bflo(g.w), bfhi(g.w)); } while (0)
#define SCAN_LSTORE() do { *(uint4*)(L + dw0) = gw0; *(uint4*)(L + dw1) = gw1; SCAN_PUT(4, gr); SCAN_PUT(3, gk); SCAN_PUT(5, gv); SCAN_PUT(0, gn); SCAN_PUT(1, gb); \
    asm volatile("s_waitcnt lgkmcnt(0)" ::: "memory"); } while (0)
  SCAN_GLOAD(0);
  asm volatile("s_waitcnt lgkmcnt(0)" ::: "memory");
  SCAN_LSTORE();
  for (int ch = 0; ch < nch; ++ch) {
    if (ch + 1 < nch) SCAN_GLOAD(ch + 1);
    float okeep = 0.f;
    const float* Lc = L + 4 * cc;
    float4 nk = *(const float4*)(Lc), bb = *(const float4*)(Lc + 64), ww = *(const float4*)(Lc + 128), kv = *(const float4*)(Lc + 192), rr = *(const float4*)(Lc + 256);
    float vt = L[320 + v];
#pragma unroll 4
    for (int st = 0; st < 8; ++st) {
      const int sn = ((st + 1) & 7) * 384;
      const float4 nk2 = *(const float4*)(Lc + sn), bb2 = *(const float4*)(Lc + sn + 64), ww2 = *(const float4*)(Lc + sn + 128);
      const float4 kv2 = *(const float4*)(Lc + sn + 192), rr2 = *(const float4*)(Lc + sn + 256);
      const float vt2 = L[sn + 320 + v];
      float d = (S.x * nk.x + S.y * nk.y) + (S.z * nk.z + S.w * nk.w);
      const float sa = row16_sum(d);
      S.x = S.x * ww.x + (sa * bb.x + vt * kv.x);
      S.y = S.y * ww.y + (sa * bb.y + vt * kv.y);
      S.z = S.z * ww.z + (sa * bb.z + vt * kv.z);
      S.w = S.w * ww.w + (sa * bb.w + vt * kv.w);
      float o = (S.x * rr.x + S.y * rr.y) + (S.z * rr.z + S.w * rr.w);
      o = row16_sum(o);
      okeep = (cc == st) ? o : okeep;
      nk = nk2; bb = bb2; ww = ww2; kv = kv2; rr = rr2; vt = vt2;
    }
    if (cc < 8) ORAW[(size_t)(ch * 8 + cc) * 64 + v] = okeep;
    asm volatile("s_waitcnt lgkmcnt(0)" ::: "memory");
    if (ch + 1 < nch) SCAN_LSTORE();
  }
  *(float4*)wout = S;
#undef SCAN_GLOAD
#undef SCAN_PUT
#undef SCAN_LSTORE
}

DI void sgroup_barrier(volatile LAS unsigned* cnt, unsigned target) {
  asm volatile("s_waitcnt lgkmcnt(0)" ::: "memory");
  if ((TIDX & 63) == 0) __hip_atomic_fetch_add((LAS unsigned*)cnt, 1u, __ATOMIC_RELAXED, __HIP_MEMORY_SCOPE_WORKGROUP);
  while (*cnt < target) __builtin_amdgcn_s_sleep(1);
  asm volatile("" ::: "memory");
}
DI void scan_group(const Params& p, int sh, int quarter, float* lds, volatile LAS unsigned* cnt, unsigned& nbar) {
  const int tid = TIDX & 255, lane = tid & 63, wid = tid >> 6, cc = lane & 15;
  const size_t base = (size_t)sh * 4096 * 64;
  const int v = quarter * 16 + wid * 4 + (lane >> 4);
  const float* SW = (const float*)(p.ws + WS_SW) + base;
  const bf16_t* SARR = (const bf16_t*)(p.ws + WS_SR) + base;
  float* ORAW = (float*)(p.ws + WS_ORAW) + base;
  f32x2 S01 = {0.f, 0.f}, S23 = {0.f, 0.f};
  const bool b0 = (lane & 1) != 0, b1 = (lane & 2) != 0;
  float4 gw0, gw1; uint4 gb0, gb1, gb2, gb3, gb4;
  const int dstw0 = ((tid >> 4) * 6 + 2) * 64 + (tid & 15) * 4, dstw1 = dstw0 + 16 * 384;
  const int dstb = (tid >> 3) * 384 + (tid & 7) * 8;
  const bf16_t* sbp = SARR + tid * 8;
#define SG_GLOAD(ch) do { const size_t o_ = (size_t)(ch) * 2048; gw0 = *(const float4*)(SW + o_ + tid * 4); gw1 = *(const float4*)(SW + o_ + 1024 + tid * 4); \
    gb0 = *(const uint4*)(sbp + o_); gb1 = *(const uint4*)(sbp + (SZ_ACT / 2) + o_); gb2 = *(const uint4*)(sbp + 2 * (SZ_ACT / 2) + o_); \
    gb3 = *(const uint4*)(sbp + 3 * (SZ_ACT / 2) + o_); gb4 = *(const uint4*)(sbp + 4 * (SZ_ACT / 2) + o_); } while (0)
#define SG_PUT(d_, g) do { *(float4*)(d_) = make_float4(bflo(g.x), bfhi(g.x), bflo(g.y), bfhi(g.y)); *(float4*)((d_) + 4) = make_float4(bflo(g.z), bfhi(g.z), bflo(g.w), bfhi(g.w)); } while (0)
#define SG_LSTORE(buf) do { float* L_ = lds + (buf) * (32 * 384); *(float4*)(L_ + dstw0) = gw0; *(float4*)(L_ + dstw1) = gw1; \
    SG_PUT(L_ + dstb + 4 * 64, gb0); SG_PUT(L_ + dstb + 3 * 64, gb1); SG_PUT(L_ + dstb + 5 * 64, gb2); SG_PUT(L_ + dstb + 0 * 64, gb3); SG_PUT(L_ + dstb + 1 * 64, gb4); } while (0)
  SG_GLOAD(0); SG_LSTORE(0); sgroup_barrier(cnt, 4u * (++nbar));
  for (int ch = 0; ch < 128; ++ch) {
    if (ch + 1 < 128) SG_GLOAD(ch + 1);
#pragma unroll 1
    for (int hlf = 0; hlf < 2; ++hlf) {
    const float* L = lds + (ch & 1) * (32 * 384) + hlf * (16 * 384);
    float okeep = 0.f;
    const float* Lc = L + 4 * cc;
    f32x4 nk = *(const f32x4*)(Lc), bb = *(const f32x4*)(Lc + 64), ww = *(const f32x4*)(Lc + 128), kv = *(const f32x4*)(Lc + 192), rr = *(const f32x4*)(Lc + 256);
    float vt = L[320 + v];
    f32x4 rrp = rr;
    float po[4];
#pragma unroll
    for (int st = 0; st <= 16; ++st) {
      if (st > 0) { const f32x2 o2 = S01 * rrp.xy + S23 * rrp.zw; po[(st - 1) & 3] = o2.x + o2.y; }
      if (st > 0 && (st & 3) == 0) {
        const float u0 = (b0 ? po[1] : po[0]) + dppf<0xB1>(b0 ? po[0] : po[1]);
        const float u1 = (b0 ? po[3] : po[2]) + dppf<0xB1>(b0 ? po[2] : po[3]);
        float w = (b1 ? u1 : u0) + dppf<0x4E>(b1 ? u0 : u1);
        w += dppf<0x124>(w); w += dppf<0x128>(w);
        okeep = ((cc >> 2) == (st >> 2) - 1) ? w : okeep;
      }
      if (st < 16) {
        const int sn = ((st + 1) & 15) * 384;
        const f32x2 d2 = S01 * nk.xy + S23 * nk.zw;
        float x = d2.x + d2.y;
        const f32x2 vt_2 = {vt, vt};
        const f32x2 t01 = vt_2 * kv.xy, t23 = vt_2 * kv.zw;
        __builtin_amdgcn_sched_barrier(0);
        x += dppf<0xB1>(x);
        const f32x4 nk2 = *(const f32x4*)(Lc + sn), bb2 = *(const f32x4*)(Lc + sn + 64);
        __builtin_amdgcn_sched_barrier(0);
        x += dppf<0x4E>(x);
        const f32x4 ww2 = *(const f32x4*)(Lc + sn + 128), kv2 = *(const f32x4*)(Lc + sn + 192);
        __builtin_amdgcn_sched_barrier(0);
        x += dppf<0x124>(x);
        const f32x4 rr2 = *(const f32x4*)(Lc + sn + 256);
        const float vt2 = L[sn + 320 + v];
        __builtin_amdgcn_sched_barrier(0);
        x += dppf<0x128>(x);
        __builtin_amdgcn_sched_barrier(0);
        const f32x2 sa2 = {x, x};
        S01 = S01 * ww.xy + (sa2 * bb.xy + t01);
        S23 = S23 * ww.zw + (sa2 * bb.zw + t23);
        rrp = rr;
        nk = nk2; bb = bb2; ww = ww2; kv = kv2; rr = rr2; vt = vt2;
      }
    }
    ORAW[(size_t)(ch * 32 + hlf * 16 + cc) * 64 + v] = okeep;
    }
    if (ch + 1 < 128) SG_LSTORE((ch + 1) & 1);
    sgroup_barrier(cnt, 4u * (++nbar));
  }
  *(float4*)(p.out + OUT_WP + ((size_t)sh * 64 + v) * 64 + 4 * cc) = make_float4(S01.x, S01.y, S23.x, S23.y);
#undef SG_GLOAD
#undef SG_PUT
#undef SG_LSTORE
}

constexpr int NQ_ATT_P = 8192, NQ_ATT_S = 512, NQ_SCAN_S = 8192, NQ_DYN = NQ_ATT_P + NQ_ATT_S + NQ_SCAN_S;
DI int wave_grab(unsigned* ctr) { int v = 0; if ((TIDX & 63) == 0) v = (int)atomicAdd(ctr, 1u); return __builtin_amdgcn_readfirstlane(v); }
DI void phase2(const Params& p, char* smem) {
  __shared__ unsigned s_cnt;
  unsigned* ctl = (unsigned*)(p.ws + WS_CTL);
  const int wid = TIDX >> 6;
  if (TIDX == 0) s_cnt = 0u;
  __syncthreads();
  float* Lsh = (float*)smem + 4 * (8 * 384);
  float* L = wid >= 4 ? (float*)smem + (wid - 4) * (8 * 384) : Lsh + wid * (8 * 384);
  if (wid < 4) {
    unsigned nbar = 0;
    __builtin_amdgcn_s_setprio(3);
    for (int bu = blockIdx.x; bu < 256; bu += gridDim.x) {
      const int xs = bu & 7, slot = bu >> 3, head = xs * 8 + (slot >> 2), quarter = slot & 3;
      scan_group(p, head, quarter, Lsh, (volatile LAS unsigned*)&s_cnt, nbar);
    }
    __builtin_amdgcn_s_setprio(0);
  }
  for (;;) {
    int u = wave_grab(&ctl[0]);
    if (u >= NQ_DYN) break;
    if (u < NQ_ATT_P) { attn_wave<false>(p, u >> 7, u & 127); continue; }
    u -= NQ_ATT_P;
    if (u < NQ_ATT_S) { attn_wave<true>(p, u, 0); continue; }
    u -= NQ_ATT_S;
    scan_wave(p, 64 + (u >> 4), u & 15, L);
  }
}

DI void p2c_row(const Params& p, int row, int c, int hh, const float4& lg, const float4& lb, const float4& o, const uint2& vv, const uint2& zz, float bon) {
  const float mean = sum16((o.x + o.y) + (o.z + o.w)) * (1.f / 64.f);
  const float dx = o.x - mean, dy = o.y - mean, dz = o.z - mean, dw = o.w - mean;
  const float var = sum16((dx * dx + dy * dy) + (dz * dz + dw * dw)) * (1.f / 64.f);
  const float inv = rsqrtf(var + LNX_EPS);
  const float r0 = (dx * inv * lg.x + lb.x + bon * bflo(vv.x)) * bflo(zz.x);
  const float r1 = (dy * inv * lg.y + lb.y + bon * bfhi(vv.x)) * bfhi(zz.x);
  const float r2 = (dz * inv * lg.z + lb.z + bon * bflo(vv.y)) * bflo(zz.y);
  const float r3 = (dw * inv * lg.w + lb.w + bon * bfhi(vv.y)) * bfhi(zz.y);
  *(uint2*)((bf16_t*)(p.ws + WS_OB) + (size_t)row * 1024 + c) = make_uint2(cvtpk(r0, r1), cvtpk(r2, r3));
}
DI void phase2c(const Params& p) {
  const int tid = TIDX & 255, half = TIDX >> 8, c = tid * 4, hh = c >> 6;
  const float4 lg = *(const float4*)(p.in[16] + c), lb = *(const float4*)(p.in[17] + c);
  const float* ORAW = (const float*)(p.ws + WS_ORAW); const bf16_t* SV = (const bf16_t*)(p.ws + WS_SV);
  const bf16_t* SZB = (const bf16_t*)(p.ws + WS_SZB); const float* BONUS = (const float*)(p.ws + WS_BONUS);
  const int stride = gridDim.x * 2;
  for (int row = blockIdx.x * 2 + half; row < MT; row += 2 * stride) {
    const bool two = row + stride < MT;
    const int rowb = two ? row + stride : row;
    const size_t ia = hm_base(row) + hh * hm_hstride(row) + (c & 63), ib = hm_base(rowb) + hh * hm_hstride(rowb) + (c & 63);
    const float4 oa = *(const float4*)(ORAW + ia), ob = *(const float4*)(ORAW + ib);
    const uint2 va = *(const uint2*)(SV + ia), vb = *(const uint2*)(SV + ib);
    const uint2 za = *(const uint2*)(SZB + (size_t)row * 1024 + c), zb = *(const uint2*)(SZB + (size_t)rowb * 1024 + c);
    const float ba = BONUS[(size_t)row * 16 + hh], bb = BONUS[(size_t)rowb * 16 + hh];
    p2c_row(p, row, c, hh, lg, lb, oa, va, za, ba);
    if (two) p2c_row(p, rowb, c, hh, lg, lb, ob, vb, zb, bb);
  }
}

DI void phase4(const Params& p) {
  const int lane = TIDX & 63, wid = TIDX >> 6;
  const float* g = p.in[21];
  float4 gg[4];
#pragma unroll
  for (int i = 0; i < 4; ++i) gg[i] = *(const float4*)(g + i * 256 + lane * 4);
  const int stride = gridDim.x * 8;
  for (int row = blockIdx.x * 8 + wid; row < MT; row += 2 * stride) {
    const bool two = row + stride < MT;
    float* x0 = p.out + OUT_YP + (size_t)row * 1024;
    float* x1 = p.out + OUT_YP + (size_t)(two ? row + stride : row) * 1024;
    float4 v0[4], v1[4]; float s0 = 0.f, s1 = 0.f;
#pragma unroll
    for (int i = 0; i < 4; ++i) { v0[i] = *(const float4*)(x0 + i * 256 + lane * 4); v1[i] = *(const float4*)(x1 + i * 256 + lane * 4); }
#pragma unroll
    for (int i = 0; i < 4; ++i) {
      s0 += v0[i].x * v0[i].x + v0[i].y * v0[i].y + v0[i].z * v0[i].z + v0[i].w * v0[i].w;
      s1 += v1[i].x * v1[i].x + v1[i].y * v1[i].y + v1[i].z * v1[i].z + v1[i].w * v1[i].w;
    }
    s0 = wave_sum(s0); s1 = wave_sum(s1);
    const float i0 = rsqrtf(s0 * (1.f / DM) + EPS), i1 = rsqrtf(s1 * (1.f / DM) + EPS);
#pragma unroll
    for (int i = 0; i < 4; ++i) *(float4*)(x0 + i * 256 + lane * 4) = make_float4(v0[i].x * i0 * gg[i].x, v0[i].y * i0 * gg[i].y, v0[i].z * i0 * gg[i].z, v0[i].w * i0 * gg[i].w);
    if (two) {
#pragma unroll
      for (int i = 0; i < 4; ++i) *(float4*)(x1 + i * 256 + lane * 4) = make_float4(v1[i].x * i1 * gg[i].x, v1[i].y * i1 * gg[i].y, v1[i].z * i1 * gg[i].z, v1[i].w * i1 * gg[i].w);
    }
  }
}

#define XB_TMO      128
#define XB_XCNT(j)  (256  + 64 * (j))
#define XB_XSUB(j)  (1280 + 64 * (j))
#define XB_XGEN(j)  (2304 + 64 * (j))
#define XB_TOP      3328
#define XB_TOPGEN   3392
#define XCD_BAR_WORDS 3456
#define XB_SPIN_CAP (1u << 18)

__device__ __forceinline__ unsigned xb_ld(unsigned* p)              { return __hip_atomic_load(p, __ATOMIC_RELAXED, __HIP_MEMORY_SCOPE_AGENT); }
__device__ __forceinline__ unsigned xb_add(unsigned* p, unsigned v) { return __hip_atomic_fetch_add(p, v, __ATOMIC_RELAXED, __HIP_MEMORY_SCOPE_AGENT); }
__device__ __forceinline__ unsigned xb_xcc_id() { return (unsigned)__builtin_amdgcn_s_getreg((3 << 11) | 20) & 0xFu; }
#define XB_SPIN(cond, bar) do { unsigned _sp = 0; while (cond) { __builtin_amdgcn_s_sleep(1); \
    if ((++_sp & 255u) == 0u) { if (xb_ld(&(bar)[XB_TMO])) break; if (_sp > XB_SPIN_CAP) { atomicAdd(&(bar)[XB_TMO], 1u); break; } } } } while (0)

struct XcdBarrier {
    unsigned* bar; unsigned x;
    volatile LAS unsigned* st;
};

__device__ __forceinline__ XcdBarrier xcd_barrier_post(unsigned* bar, volatile LAS unsigned* st) {
    XcdBarrier b; b.bar = bar; b.x = xb_xcc_id(); b.st = st;
    if (TIDX == 0) (void)xb_add(&bar[XB_XCNT(b.x)], 1u);
    return b;
}
__device__ __forceinline__ void xcd_barrier_complete(unsigned* bar, unsigned x, unsigned& nloc, unsigned& nx) {
    const unsigned G = gridDim.x * gridDim.y * gridDim.z;
    unsigned sum, cnt, mine, sp = 0u;
    for (;;) {
        sum = 0u; cnt = 0u; mine = 0u;
#pragma unroll
        for (unsigned j = 0; j < 16; ++j) { const unsigned c = xb_ld(&bar[XB_XCNT(j)]); sum += c; cnt += (c > 0u) ? 1u : 0u; mine = (j == x) ? c : mine; }
        if (sum == G) break;
        __builtin_amdgcn_s_sleep(1);
        if ((++sp & 255u) == 0u) { if (xb_ld(&bar[XB_TMO])) break; if (sp > XB_SPIN_CAP) { atomicAdd(&bar[XB_TMO], 1u); break; } }
    }
    nloc = mine > 0u ? mine : 1u; nx = cnt > 0u ? cnt : 1u;
}

__device__ __forceinline__ void xcd_barrier(const XcdBarrier& b) {
    asm volatile("s_waitcnt vmcnt(0)" ::: "memory");
    __syncthreads();
    if (TIDX == 0) {
        unsigned* bar = b.bar;
        __builtin_amdgcn_s_waitcnt(0);
        unsigned nloc = b.st[0], nx = b.st[1];
        if (nloc == 0u) { xcd_barrier_complete(bar, b.x, nloc, nx); b.st[0] = nloc; b.st[1] = nx; }
        const unsigned old = xb_add(&bar[XB_XSUB(b.x)], 1u);
        const unsigned gen = old / nloc;
        if (old + 1u == (gen + 1u) * nloc) {
            __builtin_amdgcn_fence(__ATOMIC_RELEASE, "agent");
            asm volatile("s_waitcnt vmcnt(0)" ::: "memory");
            const unsigned og = xb_add(&bar[XB_TOP], 1u);
            const unsigned tg = og / nx;
            if (og + 1u == (tg + 1u) * nx) xb_add(&bar[XB_TOPGEN], 1u);
            else XB_SPIN(xb_ld(&bar[XB_TOPGEN]) == tg, bar);
            __builtin_amdgcn_fence(__ATOMIC_ACQUIRE, "agent");
            xb_add(&bar[XB_XGEN(b.x)], 1u);
            asm volatile("s_waitcnt vmcnt(0)" ::: "memory");
        } else {
            XB_SPIN(xb_ld(&bar[XB_XGEN(b.x)]) == gen, bar);
            __builtin_amdgcn_fence(__ATOMIC_ACQUIRE, "agent");
            asm volatile("s_waitcnt vmcnt(0)" ::: "memory");
        }
    }
    __syncthreads();
}

__global__ void __launch_bounds__(NT, 2) mega(Params p) {
  extern __shared__ __attribute__((aligned(16))) char smem[];
  cg::grid_group grid = cg::this_grid();
  if (blockIdx.x == 0) { unsigned* ctl = (unsigned*)(p.ws + WS_CTL); for (int i = TIDX; i < 16384; i += NT) ctl[i] = 0u; }
  grid.sync();
  __shared__ unsigned xb_st[2];
  if (TIDX == 0) { xb_st[0] = 0u; xb_st[1] = 0u; }
  __syncthreads();
  (void)xcd_barrier_post((unsigned*)(p.ws + WS_CTL) + 8192, (volatile LAS unsigned*)xb_st);
#define XBAR() do { XcdBarrier xb_; xb_.bar = (unsigned*)(p.ws + WS_CTL) + 8192; xb_.x = xb_xcc_id(); xb_.st = (volatile LAS unsigned*)xb_st; xcd_barrier(xb_); } while (0)
  phase0(p, smem);
  XBAR();
  { EpiP1 E; E.p = p; run_gemm(smem, (const bf16_t*)(p.ws + WS_H), (const bf16_t*)(p.ws + WS_WINT), MT, NINP, E); }
  XBAR();
  phase_x(p);
  XBAR();
  { EpiLora E; E.p = p; run_gemm(smem, (const bf16_t*)(p.ws + WS_X), (const bf16_t*)(p.ws + WS_BTL), MP, 2048, E, 256); }
  small_lora(p);
  XBAR();
  phase1c(p);
  XBAR();
  phase2(p, smem);
  XBAR();
  phase2c(p);
  XBAR();
  { EpiGate E; E.p = p; E.goff = 0; E.first = true; run_gemm(smem, (const bf16_t*)(p.ws + WS_QB), (const bf16_t*)(p.ws + WS_WT), MP, 1024, E); }
  small_gemm<0>(p, (const bf16_t*)(p.ws + WS_QB), (const bf16_t*)(p.ws + WS_WT));
  { EpiGate E; E.p = p; E.goff = 1024; E.first = false; run_gemm(smem, (const bf16_t*)(p.ws + WS_OB), (const bf16_t*)(p.ws + WS_WT) + (size_t)1024 * 1024, MP, 1024, E); }
  small_gemm<1>(p, (const bf16_t*)(p.ws + WS_OB), (const bf16_t*)(p.ws + WS_WT) + (size_t)1024 * 1024);
  XBAR();
  { EpiOut E; E.p = p; run_gemm(smem, (const bf16_t*)(p.ws + WS_MG), (const bf16_t*)(p.ws + WS_WT) + (size_t)2 * 1024 * 1024, MP, 1024, E); }
  small_gemm<2>(p, (const bf16_t*)(p.ws + WS_MG), (const bf16_t*)(p.ws + WS_WT) + (size_t)2 * 1024 * 1024);
  XBAR();
  phase4(p);
}

extern "C" void kernel_launch(void* const* d_in, const int* in_sizes, int n_in, void* d_out, int out_size, void* d_ws, size_t ws_size, hipStream_t stream) {
  static int grid_blocks = 0;
  if (grid_blocks == 0) {
    if (n_in != 22 || ws_size < WS_END) { fprintf(stderr, "kernel_launch: unexpected n_in %d / ws_size %zu (need %zu)\n", n_in, ws_size, (size_t)WS_END); grid_blocks = -1; return; }
    int dev = 0, cus = 0, per_cu = 0;
    (void)hipGetDevice(&dev);
    (void)hipDeviceGetAttribute(&cus, hipDeviceAttributeMultiprocessorCount, dev);
    (void)hipFuncSetAttribute((const void*)mega, hipFuncAttributeMaxDynamicSharedMemorySize, SMEM_BYTES);
    (void)hipOccupancyMaxActiveBlocksPerMultiprocessor(&per_cu, (const void*)mega, NT, SMEM_BYTES);
    (void)hipGetLastError();
    grid_blocks = cus;
  }
  if (grid_blocks < 0) return;
  Params p{};
  for (int i = 0; i < 22; ++i) p.in[i] = (const float*)d_in[i];
  p.out = (float*)d_out; p.ws = (unsigned char*)d_ws;
  void* args[] = {&p};
  hipError_t e = hipLaunchCooperativeKernel((const void*)mega, dim3(grid_blocks), dim3(NT), args, SMEM_BYTES, stream);
  if (e != hipSuccess) fprintf(stderr, "cooperative launch failed: %s (grid %d)\n", hipGetErrorString(e), grid_blocks);
}
```

```cpp
#include <hip/hip_runtime.h>
#include <hip/hip_cooperative_groups.h>
#include <cstdio>
#include <cstdint>
namespace cg = cooperative_groups;
__device__ __forceinline__ int lane_id_() { return (int)__builtin_amdgcn_mbcnt_hi(~0u, __builtin_amdgcn_mbcnt_lo(~0u, 0u)); }
#define TIDX (__builtin_amdgcn_readfirstlane((int)(threadIdx.x >> 6)) * 64 + lane_id_())

namespace pg8 {
#define PG8_LAS __attribute__((address_space(3)))
typedef unsigned short bf16_t;
typedef short bf16x8 __attribute__((ext_vector_type(8)));
typedef float f32x4 __attribute__((ext_vector_type(4)));
typedef unsigned u32x4 __attribute__((ext_vector_type(4)));
constexpr int BM = 256, BK = 64, HALF = 128, HTB = HALF * BK * 2  , STAGE_BYTES = 8 * HTB, NXCD = 8, WGM = 8;

__host__ __device__ __forceinline__ int lds_byte(int r, int c) { const int st = (r >> 4) * 2 + (c >> 5), rr = r & 15, cc = c & 31, ob = rr * 64 + cc * 2; return st * 1024 + (ob ^ (((ob >> 9) & 1) << 5)); }
__host__ __device__ __forceinline__ void stage_rc(int b, int& R, int& C) { const int st = b / 1024, sb = b % 1024, swz = sb ^ (((sb >> 9) & 1) << 5); R = (st >> 1) * 16 + swz / 64; C = (st & 1) * 32 + (swz % 64) / 2; }
__host__ __device__ __forceinline__ int perm32(int rho) { const int n = rho >> 4, i = rho & 15; return 8 * (i >> 2) + 4 * n + (i & 3); }

struct Unit { int pm, pn; };
struct Gemm { const bf16_t* A; const bf16_t* Bt; int M, N, K; };

struct StaticOrder {
    int nM, nN, nwg, G, c;
    __host__ __device__ void init(int M, int N, int G_, int c_) { nM = M / BM; nN = N / BM; nwg = nM * nN; G = G_; c = c_; }
    __host__ __device__ bool next(int i, Unit& u) const {
        const long L = (long)i * G + c; if (L >= nwg) return false;
        int wgid = (int)L; { const int q = nwg / NXCD, r = nwg % NXCD, xcd = wgid % NXCD, off = wgid / NXCD; wgid = (xcd < r ? xcd * (q + 1) : r * (q + 1) + (xcd - r) * q) + off; }
        const int nig = WGM * nN, gid = wgid / nig, fm = gid * WGM, gsz = (nM - fm) < WGM ? (nM - fm) : WGM;
        u.pm = fm + ((wgid % nig) % gsz); u.pn = (wgid % nig) / gsz; return true;
    }
    __device__ __forceinline__ void a_ready(const Unit&) const {}
    __device__ __forceinline__ void done(const Unit&) const {}
};


template <class Epi, class Sched, bool ALIGN_EPI = false, bool SP2 = false>
__device__ __forceinline__ void gemm_phase(PG8_LAS unsigned char* lds, const Gemm g, const Sched& S, const Epi& E) {
    int tid_ = TIDX; asm volatile("" : "+v"(tid_));
    const int tid = tid_, wid = __builtin_amdgcn_readfirstlane(tid >> 6), lane = tid & 63, wr = wid >> 2, wc = wid & 3, fr = lane & 15, fq = lane >> 4;
    const int K = g.K, nt = K / BK;
    unsigned voffA[2], voffB[2];
#pragma unroll
    for (int i = 0; i < 2; ++i) { int R, C; stage_rc(tid * 16 + i * 8192, R, C); const int Rb = Epi::PERM ? ((R & ~31) + perm32(R & 31)) : R;
        voffA[i] = (unsigned)(R * K + C) * 2u; voffB[i] = (unsigned)(Rb * K + C) * 2u; }
    const size_t kstep = (size_t)(BK * 2);
    const size_t hstep = (size_t)HALF * K * 2;
    const size_t tstep = 2 * hstep;
    const unsigned ldsw = (unsigned)wid * 1024u;
    const int aoff = lds_byte(wr * 64 + fr, fq * 8), boff = lds_byte(wc * 32 + fr, fq * 8);
#define PG8_SA(b, h) (((b) * 2 + (h)) * HTB)
#define PG8_SB(b, h) ((4 + (b) * 2 + (h)) * HTB)
#define PG8_STAGE(bufoff, gbase, voff) do { _Pragma("unroll") for (int _i = 0; _i < 2; ++_i) \
        __builtin_amdgcn_global_load_lds((const unsigned*)((const char*)(gbase) + (voff)[_i]), (PG8_LAS unsigned*)(lds + (bufoff) + ldsw + _i * 8192), 16, 0, 0); } while (0)
#define PG8_LDA(dst, b, h) do { _Pragma("unroll") for (int m = 0; m < 4; ++m) _Pragma("unroll") for (int k = 0; k < 2; ++k) dst[m][k] = *(const PG8_LAS bf16x8*)(lds + PG8_SA(b, h) + aoff + m * 2048 + k * 1024); } while (0)
#define PG8_LDB(dst, b, h) do { _Pragma("unroll") for (int n = 0; n < 2; ++n) _Pragma("unroll") for (int k = 0; k < 2; ++k) dst[n][k] = *(const PG8_LAS bf16x8*)(lds + PG8_SB(b, h) + boff + n * 2048 + k * 1024); } while (0)
#define PG8_MMA(ai, bj, At, Bt) do { __builtin_amdgcn_s_setprio(1); _Pragma("unroll") for (int m = 0; m < 4; ++m) _Pragma("unroll") for (int n = 0; n < 2; ++n) _Pragma("unroll") for (int k = 0; k < 2; ++k) \
        acc[ai][bj][m][n] = __builtin_amdgcn_mfma_f32_16x16x32_bf16(Bt[n][k], At[m][k], acc[ai][bj][m][n], 0, 0, 0); __builtin_amdgcn_s_setprio(0); } while (0)
#define PG8_WAIT_V(n) asm volatile("s_waitcnt vmcnt(" #n ")" ::: "memory")
#define PG8_WAIT_L(n) asm volatile("s_waitcnt lgkmcnt(" #n ")" ::: "memory")
#define PG8_BAR __builtin_amdgcn_s_barrier()
#define PG8_SCHED __builtin_amdgcn_sched_barrier(0)
    Unit cur, nxt; int ui = 0;
    if (!S.next(0, cur)) return;
    f32x4 acc[2][2][4][2];
#pragma unroll
    for (int a = 0; a < 2; ++a)
#pragma unroll
        for (int b = 0; b < 2; ++b)
#pragma unroll
            for (int m = 0; m < 4; ++m)
#pragma unroll
                for (int n = 0; n < 2; ++n) acc[a][b][m][n] = (f32x4){0.f, 0.f, 0.f, 0.f};
    bf16x8 At[4][2], B0[2][2], B1[2][2];
    const char* cA = (const char*)g.A + (size_t)cur.pm * tstep; const char* cB = (const char*)g.Bt + (size_t)cur.pn * tstep;
    S.a_ready(cur);
    if constexpr (SP2) {
        PG8_STAGE(PG8_SB(0, 0), cB, voffB); PG8_STAGE(PG8_SB(0, 1), cB + hstep, voffB); PG8_STAGE(PG8_SA(0, 0), cA, voffA); PG8_STAGE(PG8_SA(0, 1), cA + hstep, voffA);
        if (wr == 1) PG8_BAR;
        PG8_WAIT_V(2); PG8_BAR;
        PG8_STAGE(PG8_SB(1, 0), cB + kstep, voffB); PG8_STAGE(PG8_SA(1, 0), cA + kstep, voffA); PG8_STAGE(PG8_SB(1, 1), cB + hstep + kstep, voffB);
        PG8_WAIT_V(6); PG8_BAR;
    } else {
        PG8_STAGE(PG8_SB(0, 0), cB, voffB); PG8_STAGE(PG8_SA(0, 0), cA, voffA); PG8_STAGE(PG8_SB(0, 1), cB + hstep, voffB); PG8_STAGE(PG8_SA(0, 1), cA + hstep, voffA);
        if (wr == 1) PG8_BAR;
        PG8_WAIT_V(4); PG8_BAR;
        PG8_STAGE(PG8_SB(1, 0), cB + kstep, voffB); PG8_STAGE(PG8_SA(1, 0), cA + kstep, voffA); PG8_STAGE(PG8_SB(1, 1), cB + hstep + kstep, voffB);
        PG8_WAIT_V(6); PG8_BAR;
    }
    for (;;) {
        const bool has_next = S.next(ui + 1, nxt);
        const char* nA = has_next ? (const char*)g.A + (size_t)nxt.pm * tstep : cA; const char* nB = has_next ? (const char*)g.Bt + (size_t)nxt.pn * tstep : cB;
        for (int t = 0; t < nt; t += 2) {
            const bool last = (t == nt - 2);
            const char* a1 = cA + (size_t)(t + 1) * kstep;
            const char* a2 = last ? nA : cA + (size_t)(t + 2) * kstep; const char* b2 = last ? nB : cB + (size_t)(t + 2) * kstep;
            const char* a3 = a2 + kstep; const char* b3 = b2 + kstep;
            if (last && has_next) S.a_ready(nxt);
            if constexpr (SP2) {
            PG8_LDB(B0, 0, 0); PG8_LDB(B1, 0, 1); PG8_SCHED; PG8_LDA(At, 0, 0); PG8_STAGE(PG8_SA(1, 1), a1 + hstep, voffA);
            PG8_WAIT_V(8); PG8_WAIT_L(0); PG8_BAR; PG8_MMA(0, 0, At, B0); PG8_MMA(0, 1, At, B1); PG8_BAR; PG8_SCHED;
            PG8_LDA(At, 0, 1); PG8_STAGE(PG8_SB(0, 0), b2, voffB); PG8_STAGE(PG8_SB(0, 1), b2 + hstep, voffB); PG8_STAGE(PG8_SA(0, 0), a2, voffA);
            PG8_WAIT_V(8); PG8_WAIT_L(0); PG8_BAR; PG8_MMA(1, 0, At, B0); PG8_MMA(1, 1, At, B1); PG8_BAR; PG8_SCHED;
            PG8_LDB(B0, 1, 0); PG8_LDB(B1, 1, 1); PG8_SCHED; PG8_LDA(At, 1, 0); PG8_STAGE(PG8_SA(0, 1), a2 + hstep, voffA);
            PG8_WAIT_V(8); PG8_WAIT_L(0); PG8_BAR; PG8_MMA(0, 0, At, B0); PG8_MMA(0, 1, At, B1); PG8_BAR; PG8_SCHED;
            PG8_LDA(At, 1, 1); PG8_STAGE(PG8_SB(1, 0), b3, voffB); PG8_STAGE(PG8_SB(1, 1), b3 + hstep, voffB); PG8_STAGE(PG8_SA(1, 0), a3, voffA);
            PG8_WAIT_V(8); PG8_WAIT_L(0); PG8_BAR; PG8_MMA(1, 0, At, B0); PG8_MMA(1, 1, At, B1); PG8_BAR; PG8_SCHED;
            } else {
            PG8_LDB(B0, 0, 0); PG8_SCHED; PG8_LDA(At, 0, 0); PG8_STAGE(PG8_SA(1, 1), a1 + hstep, voffA);
            PG8_WAIT_L(8); PG8_BAR; PG8_WAIT_L(0); PG8_MMA(0, 0, At, B0); PG8_BAR; PG8_SCHED;
            PG8_LDB(B1, 0, 1); PG8_STAGE(PG8_SB(0, 0), b2, voffB);
            PG8_BAR; PG8_WAIT_L(0); PG8_MMA(0, 1, At, B1); PG8_BAR;
            PG8_LDA(At, 0, 1); PG8_STAGE(PG8_SA(0, 0), a2, voffA);
            PG8_BAR; PG8_WAIT_L(0); PG8_MMA(1, 0, At, B0); PG8_BAR; PG8_SCHED;
            PG8_STAGE(PG8_SB(0, 1), b2 + hstep, voffB);
            PG8_WAIT_V(6); PG8_BAR; PG8_MMA(1, 1, At, B1); PG8_BAR;
            PG8_LDB(B0, 1, 0); PG8_SCHED; PG8_LDA(At, 1, 0); PG8_STAGE(PG8_SA(0, 1), a2 + hstep, voffA);
            PG8_WAIT_L(8); PG8_BAR; PG8_WAIT_L(0); PG8_MMA(0, 0, At, B0); PG8_BAR; PG8_SCHED;
            PG8_LDB(B1, 1, 1); PG8_STAGE(PG8_SB(1, 0), b3, voffB);
            PG8_BAR; PG8_WAIT_L(0); PG8_MMA(0, 1, At, B1); PG8_BAR;
            PG8_LDA(At, 1, 1); PG8_STAGE(PG8_SA(1, 0), a3, voffA);
            PG8_BAR; PG8_WAIT_L(0); PG8_MMA(1, 0, At, B0); PG8_BAR; PG8_SCHED;
            PG8_STAGE(PG8_SB(1, 1), b3 + hstep, voffB);
            PG8_WAIT_V(6); PG8_BAR; PG8_MMA(1, 1, At, B1); PG8_BAR;
            }
        }
        if constexpr (ALIGN_EPI) { if (wr == 0) PG8_BAR; }
        if constexpr (!Epi::AFTER_DRAIN) { E(acc, cur, wr, wc, fr, fq); S.done(cur); }
        if (!has_next) break;
#pragma unroll
        for (int a = 0; a < 2; ++a)
#pragma unroll
            for (int b = 0; b < 2; ++b)
#pragma unroll
                for (int m = 0; m < 4; ++m)
#pragma unroll
                    for (int n = 0; n < 2; ++n) acc[a][b][m][n] = (f32x4){0.f, 0.f, 0.f, 0.f};
        cur = nxt; cA = nA; cB = nB; ++ui;
        if constexpr (ALIGN_EPI) { if (wr == 1) PG8_BAR; }
    }
    PG8_WAIT_V(0);
    if constexpr (!ALIGN_EPI) { if (wr == 0) PG8_BAR; }
    PG8_BAR;
    if constexpr (Epi::AFTER_DRAIN) { E.fused(acc, cur, wr, wc, fr, fq, lds, wid, lane); S.done(cur); }
#undef PG8_SA
#undef PG8_SB
#undef PG8_STAGE
#undef PG8_LDA
#undef PG8_LDB
#undef PG8_MMA
#undef PG8_WAIT_V
#undef PG8_WAIT_L
#undef PG8_BAR
#undef PG8_SCHED
}
}


#define DI __device__ __forceinline__
typedef unsigned short bf16_t;
typedef short bf16x8 __attribute__((ext_vector_type(8)));
typedef float f32x4 __attribute__((ext_vector_type(4)));
typedef float f32x2 __attribute__((ext_vector_type(2)));
typedef float f32x16 __attribute__((ext_vector_type(16)));
typedef unsigned u32x4 __attribute__((ext_vector_type(4)));
#define MFMA32(a, b, c) __builtin_amdgcn_mfma_f32_32x32x16_bf16((a), (b), (c), 0, 0, 0)
#define LAS __attribute__((address_space(3)))

constexpr int NT = 512;
constexpr int DM = 1024, MP = 16384, MT = 16896;
constexpr int NIN = 10368, NINP = 10496, CSH = 4224;
constexpr float EPS = 1e-6f, LNX_EPS = 64e-5f;
constexpr float QSCALE = 0.18033688011112042f;

constexpr size_t OUT_YP = 0, OUT_KP = 17301504, OUT_VP = 34078720, OUT_SHP = 50855936, OUT_WP = 50872832,
                 OUT_KS = 51134976, OUT_VS = 51659264, OUT_SHS = 52183552, OUT_WS = 52318720;

constexpr size_t SZ_ACT = (size_t)MT * 1024 * 2;
constexpr size_t WS_R1 = 0;
constexpr size_t WS_H = WS_R1, WS_WINT = WS_R1 + SZ_ACT, WS_SW = WS_R1;
constexpr size_t WS_R2 = (size_t)MT * 1024 * 4;
constexpr size_t WS_PB = WS_R2, WS_ORAW = WS_R2, WS_OB = WS_ORAW + (size_t)MT * 1024 * 4, WS_MG = WS_OB + SZ_ACT;
constexpr size_t WS_R3 = WS_R2 + (size_t)MT * CSH * 2;
constexpr size_t WS_QB = WS_R3, WS_X = WS_QB + SZ_ACT  , WS_BTL = WS_X + (size_t)MT * 256 * 2  , WS_SZA = WS_X + (size_t)MP * 1024 * 2;
static_assert(WS_BTL + (size_t)2048 * 256 * 2 <= WS_SZA, "LoRA buffers");
constexpr size_t WS_SR = WS_SZA + SZ_ACT, WS_SK = WS_SR + SZ_ACT, WS_SV = WS_SK + SZ_ACT, WS_SKK = WS_SV + SZ_ACT, WS_SB = WS_SKK + SZ_ACT;
constexpr size_t WS_SZB = WS_SB + SZ_ACT;
constexpr size_t WS_BONUS = WS_SZB + SZ_ACT;
constexpr size_t WS_WT = WS_BONUS + (size_t)MT * 16 * 4;
constexpr size_t WS_CTL = WS_WT + 3 * (size_t)1024 * 1024 * 2;
constexpr size_t WS_END = WS_CTL + 65536;
static_assert(WS_MG + SZ_ACT <= WS_R3, "R2 overflow");
static_assert(WS_WINT + (size_t)NINP * 1024 * 2 <= WS_R2, "R1 overflow");
static_assert(WS_END <= (size_t)512 * 1024 * 1024, "workspace");

constexpr int SMEM_BYTES = 147456;

struct Params { const float* in[22]; float* out; unsigned char* ws; };

DI float bf2f(bf16_t u) { return __uint_as_float((unsigned)u << 16); }
DI unsigned cvtpk(float lo, float hi) { unsigned r; asm volatile("v_cvt_pk_bf16_f32 %0, %1, %2" : "=v"(r) : "v"(lo), "v"(hi)); return r; }
DI bf16_t f2bf(float x) { return (bf16_t)(cvtpk(x, 0.f) & 0xffffu); }
DI float bflo(unsigned u) { return __uint_as_float(u << 16); }
DI float bfhi(unsigned u) { return __uint_as_float(u & 0xffff0000u); }
DI int crow(int i, int h) { return (i & 3) + 8 * (i >> 2) + 4 * h; }
DI float sigmoidf_(float x) { return fminf(__builtin_amdgcn_rcpf(1.f + __expf(-x)), 1.f); }
typedef unsigned u32x2 __attribute__((ext_vector_type(2)));
DI uint2 ntload2(const void* q) { const u32x2 v = __builtin_nontemporal_load((const u32x2*)q); return make_uint2(v.x, v.y); }
DI void ntstore2(void* q, uint2 v) { const u32x2 t = {v.x, v.y}; __builtin_nontemporal_store(t, (u32x2*)q); }
DI uint4 pack8(f32x4 a, f32x4 b) { return make_uint4(cvtpk(a[0], a[1]), cvtpk(a[2], a[3]), cvtpk(b[0], b[1]), cvtpk(b[2], b[3])); }
template <int CTRL> DI float dppf(float x) { return __builtin_bit_cast(float, __builtin_amdgcn_mov_dpp(__builtin_bit_cast(int, x), CTRL, 0xf, 0xf, true)); }
DI float sum16(float x) { x += dppf<0xB1>(x); x += dppf<0x4E>(x); x += dppf<0x124>(x); x += dppf<0x128>(x); return x; }
DI float wave_sum(float x) {
  x = sum16(x);
  const auto s = __builtin_amdgcn_permlane16_swap(__float_as_uint(x), __float_as_uint(x), false, false);
  x = __uint_as_float(s[0]) + __uint_as_float(s[1]);
  const auto t = __builtin_amdgcn_permlane32_swap(__float_as_uint(x), __float_as_uint(x), false, false);
  return __uint_as_float(t[0]) + __uint_as_float(t[1]);
}
DI float row32_sum(float x) {
  x += dppf<0xB1>(x);
  x += dppf<0x4E>(x);
  x += dppf<0x124>(x);
  x += dppf<0x128>(x);
  const auto s = __builtin_amdgcn_permlane16_swap(__float_as_uint(x), __float_as_uint(x), false, false);
  return __uint_as_float(s[0]) + __uint_as_float(s[1]);
}
DI size_t hm_base(int row) {
  if (row < MP) { const int b = row >> 12, t = row & 4095; return ((size_t)(b * 16) * 4096 + t) * 64; }
  const int rs = row - MP, b = rs >> 4, t = rs & 15; return (size_t)MP * 1024 + ((size_t)(b * 16) * 16 + t) * 64;
}
DI size_t hm_hstride(int row) { return row < MP ? (size_t)4096 * 64 : (size_t)16 * 64; }

DI void p0_rmsnorm_rows(const Params& p, int item) {
  const int lane = TIDX & 63, wid = TIDX >> 6;
  const int row = item * 8 + wid;
  const float* x = row < MP ? p.in[0] + (size_t)row * DM : p.in[1] + (size_t)(row - MP) * DM;
  const float* g = p.in[6];
  float4 v[4]; float ss = 0.f;
#pragma unroll
  for (int i = 0; i < 4; ++i) { v[i] = *(const float4*)(x + i * 256 + lane * 4); ss += v[i].x * v[i].x + v[i].y * v[i].y + v[i].z * v[i].z + v[i].w * v[i].w; }
  ss = wave_sum(ss);
  const float inv = rsqrtf(ss * (1.f / DM) + EPS);
  bf16_t* H = (bf16_t*)(p.ws + WS_H) + (size_t)row * DM;
#pragma unroll
  for (int i = 0; i < 4; ++i) {
    const float4 gg = *(const float4*)(g + i * 256 + lane * 4);
    uint2 o; o.x = cvtpk(v[i].x * inv * gg.x, v[i].y * inv * gg.y); o.y = cvtpk(v[i].z * inv * gg.z, v[i].w * inv * gg.w);
    *(uint2*)(H + i * 256 + lane * 4) = o;
  }
}
DI void p0_transpose_tile(const float* src, bf16_t* dst, int N, int kt, int nt, float* lds) {
  const int tid = TIDX & 255;
  const int k0 = kt * 64, n0 = nt * 64;
#pragma unroll
  for (int i = 0; i < 4; ++i) {
    const int row = (tid >> 4) + 16 * i, c4 = (tid & 15) * 4;
    const float4 v = *(const float4*)(src + (size_t)(k0 + row) * N + n0 + c4);
    lds[row * 65 + c4 + 0] = v.x; lds[row * 65 + c4 + 1] = v.y; lds[row * 65 + c4 + 2] = v.z; lds[row * 65 + c4 + 3] = v.w;
  }
  __syncthreads();
  const int n = tid >> 2, kc = (tid & 3) * 16;
  unsigned w[8];
#pragma unroll
  for (int j = 0; j < 8; ++j) w[j] = cvtpk(lds[(kc + 2 * j) * 65 + n], lds[(kc + 2 * j + 1) * 65 + n]);
  uint4* d = (uint4*)(dst + (size_t)(n0 + n) * 1024 + k0 + kc);
  d[0] = make_uint4(w[0], w[1], w[2], w[3]); d[1] = make_uint4(w[4], w[5], w[6], w[7]);
  __syncthreads();
}
DI void phase0(const Params& p, char* smem) {
  {
    bf16_t* BL = (bf16_t*)(p.ws + WS_BTL);
    for (int i = blockIdx.x * NT + TIDX; i < 2048 * 256; i += gridDim.x * NT) {
      const int n = i >> 8, k = i & 255;
      float v = 0.f;
      if (n < 1024) { if (k < 64) v = p.in[10][(size_t)k * 1024 + n]; }
      else if (k >= 64 && k < 128) v = p.in[12][(size_t)(k - 64) * 1024 + (n - 1024)];
      BL[i] = f2bf(v);
    }
  }
  constexpr int N_ROWS = MT / 8, N_TIN = 16 * 162 / 2, N_TSQ = 256 / 2;
  constexpr int N_ITEMS = N_ROWS + N_TIN + 3 * N_TSQ;
  const int half = TIDX >> 8;
  float* scr = (float*)smem + half * (64 * 65);
  for (int it = blockIdx.x; it < N_ITEMS; it += gridDim.x) {
    if (it < N_ROWS) { p0_rmsnorm_rows(p, it); continue; }
    int j = it - N_ROWS;
    if (j < N_TIN) { const int t = 2 * j + half; p0_transpose_tile(p.in[7], (bf16_t*)(p.ws + WS_WINT), NIN, t / 162, t % 162, scr); continue; }
    j -= N_TIN;
    const int w = j / N_TSQ; const int t = 2 * (j % N_TSQ) + half;
    p0_transpose_tile(p.in[18 + w], (bf16_t*)(p.ws + WS_WT) + (size_t)w * 1024 * 1024, 1024, t >> 4, t & 15, scr);
  }
}

struct EpiP1 {
  static constexpr bool PERM = true, AFTER_DRAIN = false;
  Params p;
  DI void operator()(const pg8::f32x4 (&acc)[2][2][4][2], const pg8::Unit& u, int wr, int wc, int fr, int fq) const {
    const int colt = u.pn * 256;
    const int region = colt >> 10;
#pragma unroll
    for (int ai = 0; ai < 2; ++ai)
#pragma unroll
      for (int m = 0; m < 4; ++m) {
        const int row = u.pm * 256 + ai * 128 + wr * 64 + m * 16 + fr;
        const bool prompt = row < MP;
        const int rs = row - MP;
#pragma unroll
        for (int bj = 0; bj < 2; ++bj) {
          const int col = colt + bj * 128 + wc * 32 + 8 * fq;
          const f32x4 v0 = acc[ai][bj][m][0], v1 = acc[ai][bj][m][1];
          if (region >= 6) {
            const int pc = col - 6144;
            if (pc < CSH) {
              *(uint4*)((bf16_t*)(p.ws + WS_PB) + (size_t)row * CSH + pc) = pack8(v0, v1);
              float* so = nullptr;
              if (prompt) { if ((row & 4095) == 4095) so = p.out + OUT_SHP + (size_t)(row >> 12) * CSH + pc; }
              else if ((rs & 15) == 15) so = p.out + OUT_SHS + (size_t)(rs >> 4) * CSH + pc;
              if (so) { *(f32x4*)so = v0; *(f32x4*)(so + 4) = v1; }
            }
          } else if (region == 0) {
            *(uint4*)((bf16_t*)(p.ws + WS_QB) + (size_t)row * 1024 + col) = pack8(v0 * QSCALE, v1 * QSCALE);
          } else if (region == 1) {
            const int c = col - 1024, hh = c >> 6, d = c & 63;
            float* o = prompt ? p.out + OUT_KP + (((size_t)(row >> 12) * 16 + hh) * 4096 + (row & 4095)) * 64 + d
                              : p.out + OUT_KS + (((size_t)(rs >> 4) * 16 + hh) * 16 + (rs & 15)) * 64 + d;
            __builtin_nontemporal_store(v0, (f32x4*)o); __builtin_nontemporal_store(v1, (f32x4*)(o + 4));
          } else if (region == 2) {
            const int c = col - 2048, hh = c >> 6, d = c & 63;
            float* o = prompt ? p.out + OUT_VP + (((size_t)(row >> 12) * 16 + hh) * 4096 + (row & 4095)) * 64 + d
                              : p.out + OUT_VS + (((size_t)(rs >> 4) * 16 + hh) * 16 + (rs & 15)) * 64 + d;
            __builtin_nontemporal_store(v0, (f32x4*)o); __builtin_nontemporal_store(v1, (f32x4*)(o + 4));
          } else if (region == 3) {
            f32x4 a, b;
#pragma unroll
            for (int j = 0; j < 4; ++j) { a[j] = v0[j] * sigmoidf_(v0[j]); b[j] = v1[j] * sigmoidf_(v1[j]); }
            *(uint4*)((bf16_t*)(p.ws + WS_SZA) + (size_t)row * 1024 + (col - 3072)) = pack8(a, b);
          } else {
            f32x4 a, b;
#pragma unroll
            for (int j = 0; j < 4; ++j) { a[j] = sigmoidf_(v0[j]); b[j] = sigmoidf_(v1[j]); }
            *(uint4*)((bf16_t*)p.out + (size_t)row * 2048 + (col - 4096)) = pack8(a, b);
          }
        }
      }
  }
};
struct EpiGate {
  static constexpr bool PERM = true, AFTER_DRAIN = false;
  Params p; int goff; bool first;
  DI void operator()(const pg8::f32x4 (&acc)[2][2][4][2], const pg8::Unit& u, int wr, int wc, int fr, int fq) const {
    const bf16_t* G = (const bf16_t*)p.out; bf16_t* MG = (bf16_t*)(p.ws + WS_MG);
#pragma unroll
    for (int ai = 0; ai < 2; ++ai)
#pragma unroll
      for (int m = 0; m < 4; ++m) {
        const size_t row = u.pm * 256 + ai * 128 + wr * 64 + m * 16 + fr;
#pragma unroll
        for (int bj = 0; bj < 2; ++bj) {
          const int col = u.pn * 256 + bj * 128 + wc * 32 + 8 * fq;
          const uint4 g = *(const uint4*)(G + row * 2048 + goff + col);
          f32x4 a = acc[ai][bj][m][0], b = acc[ai][bj][m][1];
          a[0] *= bflo(g.x); a[1] *= bfhi(g.x); a[2] *= bflo(g.y); a[3] *= bfhi(g.y);
          b[0] *= bflo(g.z); b[1] *= bfhi(g.z); b[2] *= bflo(g.w); b[3] *= bfhi(g.w);
          if (!first) {
            const uint4 o = *(const uint4*)(MG + row * 1024 + col);
            a[0] += bflo(o.x); a[1] += bfhi(o.x); a[2] += bflo(o.y); a[3] += bfhi(o.y);
            b[0] += bflo(o.z); b[1] += bfhi(o.z); b[2] += bflo(o.w); b[3] += bfhi(o.w);
          }
          *(uint4*)(MG + row * 1024 + col) = pack8(a, b);
        }
      }
  }
};
struct EpiOut {
  static constexpr bool PERM = true, AFTER_DRAIN = false;
  Params p;
  DI void operator()(const pg8::f32x4 (&acc)[2][2][4][2], const pg8::Unit& u, int wr, int wc, int fr, int fq) const {
#pragma unroll
    for (int ai = 0; ai < 2; ++ai)
#pragma unroll
      for (int m = 0; m < 4; ++m) {
        const int row = u.pm * 256 + ai * 128 + wr * 64 + m * 16 + fr;
        const float* xr = row < MP ? p.in[0] + (size_t)row * 1024 : p.in[1] + (size_t)(row - MP) * 1024;
        float* orow = p.out + OUT_YP + (size_t)row * 1024;
#pragma unroll
        for (int bj = 0; bj < 2; ++bj) {
          const int col = u.pn * 256 + bj * 128 + wc * 32 + 8 * fq;
          const f32x4 x0 = *(const f32x4*)(xr + col), x1 = *(const f32x4*)(xr + col + 4);
          *(f32x4*)(orow + col) = x0 + acc[ai][bj][m][0]; *(f32x4*)(orow + col + 4) = x1 + acc[ai][bj][m][1];
        }
      }
  }
};
template <class Epi>
DI void run_gemm(char* smem, const bf16_t* A, const bf16_t* Bt, int M, int N, const Epi& E, int K = 1024) {
  pg8::Gemm g; g.A = A; g.Bt = Bt; g.M = M; g.N = N; g.K = K;
  pg8::StaticOrder S; S.init(M, N, (int)gridDim.x, (int)blockIdx.x);
  pg8::gemm_phase<Epi, pg8::StaticOrder, true, true>((LAS unsigned char*)smem, g, S, E);
  __syncthreads();
}

template <int MODE>
DI void small_gemm(const Params& p, const bf16_t* A, const bf16_t* Bt) {
  int t_ = TIDX; asm volatile("" : "+v"(t_));
  const int lane = t_ & 63, wid = __builtin_amdgcn_readfirstlane(t_ >> 6), fr = lane & 15, fq = lane >> 4;
  for (int tile = wid * gridDim.x + blockIdx.x; tile < 2048; tile += 8 * gridDim.x) {
    const int row0 = MP + (tile >> 6) * 16, col0 = (tile & 63) * 16;
    const bf16_t* pa = A + (size_t)(row0 + fr) * 1024 + 8 * fq;
    const bf16_t* pb = Bt + (size_t)(col0 + fr) * 1024 + 8 * fq;
    f32x4 acc = {0.f, 0.f, 0.f, 0.f};
#pragma unroll 8
    for (int s = 0; s < 32; ++s) acc = __builtin_amdgcn_mfma_f32_16x16x32_bf16(*(const bf16x8*)(pa + 32 * s), *(const bf16x8*)(pb + 32 * s), acc, 0, 0, 0);
    const int col = col0 + fr;
#pragma unroll
    for (int j = 0; j < 4; ++j) {
      const size_t row = row0 + 4 * fq + j;
      if (MODE == 2) p.out[OUT_YP + row * 1024 + col] = p.in[1][(row - MP) * 1024 + col] + acc[j];
      else {
        bf16_t* mg = (bf16_t*)(p.ws + WS_MG) + row * 1024 + col;
        const float g = bf2f(((const bf16_t*)p.out)[row * 2048 + (MODE == 1 ? 1024 : 0) + col]);
        *mg = f2bf((MODE == 1 ? bf2f(*mg) : 0.f) + acc[j] * g);
      }
    }
  }
}

DI float tanh_fast(float x) { return 1.f - 2.f * __builtin_amdgcn_rcpf(1.f + __expf(2.f * x)); }
DI void phase_x(const Params& p) {
  const bf16_t* PB = (const bf16_t*)(p.ws + WS_PB);
  bf16_t* X = (bf16_t*)(p.ws + WS_X);
  const float* mu = p.in[8];
  for (int i = blockIdx.x * NT + TIDX; i < MT * 32; i += gridDim.x * NT) {
    const int row = i >> 5, g = i & 31;
    uint4 o = make_uint4(0u, 0u, 0u, 0u);
    if (g < 16) {
      const int col = 3072 + g * 8;
      const bool prompt = row < MP;
      const int t = prompt ? (row & 4095) : ((row - MP) & 15);
      const uint4 a = *(const uint4*)(PB + (size_t)row * CSH + col);
      float c[8] = {bflo(a.x), bfhi(a.x), bflo(a.y), bfhi(a.y), bflo(a.z), bfhi(a.z), bflo(a.w), bfhi(a.w)}, q[8];
      if (t != 0) { const uint4 b = *(const uint4*)(PB + (size_t)(row - 1) * CSH + col); q[0] = bflo(b.x); q[1] = bfhi(b.x); q[2] = bflo(b.y); q[3] = bfhi(b.y); q[4] = bflo(b.z); q[5] = bfhi(b.z); q[6] = bflo(b.w); q[7] = bfhi(b.w); }
      else if (prompt) {
#pragma unroll
        for (int j = 0; j < 8; ++j) q[j] = 0.f;
      } else { const float* s = p.in[4] + (size_t)((row - MP) >> 4) * CSH + col; const float4 b0 = *(const float4*)s, b1 = *(const float4*)(s + 4); q[0] = b0.x; q[1] = b0.y; q[2] = b0.z; q[3] = b0.w; q[4] = b1.x; q[5] = b1.y; q[6] = b1.z; q[7] = b1.w; }
      const float4 u0 = *(const float4*)(mu + col), u1 = *(const float4*)(mu + col + 4);
      const float u[8] = {u0.x, u0.y, u0.z, u0.w, u1.x, u1.y, u1.z, u1.w};
      float m[8];
#pragma unroll
      for (int j = 0; j < 8; ++j) { m[j] = c[j] + u[j] * (q[j] - c[j]); if (g < 8) m[j] = tanh_fast(m[j]); }
      o = make_uint4(cvtpk(m[0], m[1]), cvtpk(m[2], m[3]), cvtpk(m[4], m[5]), cvtpk(m[6], m[7]));
    }
    *(uint4*)(X + (size_t)row * 256 + g * 8) = o;
  }
}
struct EpiLora {
  static constexpr bool PERM = true, AFTER_DRAIN = false;
  Params p;
  DI void operator()(const pg8::f32x4 (&acc)[2][2][4][2], const pg8::Unit& u, int wr, int wc, int fr, int fq) const {
    const bool isw = u.pn < 4;
#pragma unroll
    for (int ai = 0; ai < 2; ++ai)
#pragma unroll
      for (int m = 0; m < 4; ++m) {
        const int row = u.pm * 256 + ai * 128 + wr * 64 + m * 16 + fr;
        const size_t hb = hm_base(row), hs = hm_hstride(row);
#pragma unroll
        for (int bj = 0; bj < 2; ++bj) {
          const int c = (u.pn & 3) * 256 + bj * 128 + wc * 32 + 8 * fq;
          const size_t idx = hb + (c >> 6) * hs + (c & 63);
          const f32x4 v0 = acc[ai][bj][m][0], v1 = acc[ai][bj][m][1];
          if (isw) {
            const f32x4 b0 = *(const f32x4*)(p.in[9] + c), b1 = *(const f32x4*)(p.in[9] + c + 4);
            f32x4 d0, d1;
#pragma unroll
            for (int j = 0; j < 4; ++j) {
              const float x0 = -(b0[j] + v0[j]), x1 = -(b1[j] + v1[j]);
              const float s0 = fmaxf(x0, 0.f) + __logf(1.f + __expf(-fabsf(x0))), s1 = fmaxf(x1, 0.f) + __logf(1.f + __expf(-fabsf(x1)));
              d0[j] = __expf(-__expf(-s0 - 0.5f)); d1[j] = __expf(-__expf(-s1 - 0.5f));
            }
            float* o = (float*)(p.ws + WS_SW) + idx; *(f32x4*)o = d0; *(f32x4*)(o + 4) = d1;
          } else {
            const f32x4 b0 = *(const f32x4*)(p.in[11] + c), b1 = *(const f32x4*)(p.in[11] + c + 4);
            f32x4 d0, d1;
#pragma unroll
            for (int j = 0; j < 4; ++j) { d0[j] = sigmoidf_(b0[j] + v0[j]); d1[j] = sigmoidf_(b1[j] + v1[j]); }
            *(uint4*)((bf16_t*)(p.ws + WS_SB) + idx) = pack8(d0, d1);
          }
        }
      }
  }
};
DI void small_lora(const Params& p) {
  const int lane = TIDX & 63, wid = TIDX >> 6, r = lane & 31, h = lane >> 5;
  const bf16_t* X = (const bf16_t*)(p.ws + WS_X); const bf16_t* BL = (const bf16_t*)(p.ws + WS_BTL);
  for (int tile = wid * gridDim.x + blockIdx.x; tile < 16 * 64; tile += 8 * gridDim.x) {
    const int row0 = MP + (tile >> 6) * 32, ct = tile & 63, col0 = ct * 32, k0 = ct < 32 ? 0 : 64;
    const bf16_t* pa = X + (size_t)(row0 + r) * 256 + k0 + 8 * h;
    const bf16_t* pb = BL + (size_t)(col0 + r) * 256 + k0 + 8 * h;
    f32x16 acc;
#pragma unroll
    for (int i = 0; i < 16; ++i) acc[i] = 0.f;
#pragma unroll
    for (int s = 0; s < 4; ++s) acc = MFMA32(*(const bf16x8*)(pa + 16 * s), *(const bf16x8*)(pb + 16 * s), acc);
    const int c = (col0 + r) & 1023;
    const float bias = ct < 32 ? p.in[9][c] : p.in[11][c];
#pragma unroll
    for (int i = 0; i < 16; ++i) {
      const int row = row0 + crow(i, h);
      const size_t idx = hm_base(row) + (c >> 6) * hm_hstride(row) + (c & 63);
      const float v = bias + acc[i];
      if (ct < 32) {
        const float x = -v, sp = fmaxf(x, 0.f) + __logf(1.f + __expf(-fabsf(x)));
        ((float*)(p.ws + WS_SW))[idx] = __expf(-__expf(-sp - 0.5f));
      } else ((bf16_t*)(p.ws + WS_SB))[idx] = f2bf(sigmoidf_(v));
    }
  }
}

DI void phase1c(const Params& p) {
  const int tid = TIDX & 255, half = TIDX >> 8, c = tid * 4, hh = c >> 6;
  const bf16_t* PB = (const bf16_t*)(p.ws + WS_PB);
  const float* mu = p.in[8];
  const float4 kkw = *(const float4*)(p.in[13] + c), kaw = *(const float4*)(p.in[14] + c), rkw = *(const float4*)(p.in[15] + c);
  const float4 mur = *(const float4*)(mu + c), muk = *(const float4*)(mu + 1024 + c), muv = *(const float4*)(mu + 2048 + c), muz = *(const float4*)(mu + 3200 + c);
  const float kka[4] = {kkw.x, kkw.y, kkw.z, kkw.w}, kaa[4] = {kaw.x, kaw.y, kaw.z, kaw.w}, rka[4] = {rkw.x, rkw.y, rkw.z, rkw.w};
  const float mura[4] = {mur.x, mur.y, mur.z, mur.w}, muka[4] = {muk.x, muk.y, muk.z, muk.w}, muva[4] = {muv.x, muv.y, muv.z, muv.w}, muza[4] = {muz.x, muz.y, muz.z, muz.w};
  bf16_t* SR = (bf16_t*)(p.ws + WS_SR); bf16_t* SK = (bf16_t*)(p.ws + WS_SK); bf16_t* SV = (bf16_t*)(p.ws + WS_SV);
  bf16_t* SKK = (bf16_t*)(p.ws + WS_SKK); bf16_t* SB = (bf16_t*)(p.ws + WS_SB); bf16_t* SZB = (bf16_t*)(p.ws + WS_SZB);
  float* BONUS = (float*)(p.ws + WS_BONUS);
  for (int r4 = blockIdx.x * 2 + half; r4 < MT / 4; r4 += gridDim.x * 2) {
    const int row0 = r4 * 4;
    const bool prompt = row0 < MP;
    const int t0 = prompt ? (row0 & 4095) : ((row0 - MP) & 15);
    uint2 gr[5], gk[5], gv[5], gz[5], ga[4];
#pragma unroll
    for (int t = 0; t < 5; ++t) {
      const int rr_ = (t == 0 && t0 == 0) ? row0 : row0 + t - 1;
      const bf16_t* pc = PB + (size_t)rr_ * CSH;
      gr[t] = ntload2(pc + c); gk[t] = ntload2(pc + 1024 + c); gv[t] = ntload2(pc + 2048 + c); gz[t] = ntload2(pc + 3200 + c);
    }
    size_t idx[4];
#pragma unroll
    for (int t = 0; t < 4; ++t) { idx[t] = hm_base(row0 + t) + hh * hm_hstride(row0 + t) + (c & 63); ga[t] = *(const uint2*)(SB + idx[t]); }
    float pr[4], pk[4], pv[4], pz[4];
    if (t0 == 0) {
      if (prompt) {
#pragma unroll
        for (int x = 0; x < 4; ++x) { pr[x] = 0.f; pk[x] = 0.f; pv[x] = 0.f; pz[x] = 0.f; }
      } else {
        const float* s = p.in[4] + (size_t)((row0 - MP) >> 4) * CSH;
        const float4 a = *(const float4*)(s + c), b = *(const float4*)(s + 1024 + c), d = *(const float4*)(s + 2048 + c), e = *(const float4*)(s + 3200 + c);
        pr[0] = a.x; pr[1] = a.y; pr[2] = a.z; pr[3] = a.w; pk[0] = b.x; pk[1] = b.y; pk[2] = b.z; pk[3] = b.w;
        pv[0] = d.x; pv[1] = d.y; pv[2] = d.z; pv[3] = d.w; pz[0] = e.x; pz[1] = e.y; pz[2] = e.z; pz[3] = e.w;
      }
    } else {
      pr[0] = bflo(gr[0].x); pr[1] = bfhi(gr[0].x); pr[2] = bflo(gr[0].y); pr[3] = bfhi(gr[0].y);
      pk[0] = bflo(gk[0].x); pk[1] = bfhi(gk[0].x); pk[2] = bflo(gk[0].y); pk[3] = bfhi(gk[0].y);
      pv[0] = bflo(gv[0].x); pv[1] = bfhi(gv[0].x); pv[2] = bflo(gv[0].y); pv[3] = bfhi(gv[0].y);
      pz[0] = bflo(gz[0].x); pz[1] = bfhi(gz[0].x); pz[2] = bflo(gz[0].y); pz[3] = bfhi(gz[0].y);
    }
#pragma unroll
    for (int t = 0; t < 4; ++t) {
      const int row = row0 + t;
      const float curr[4] = {bflo(gr[t + 1].x), bfhi(gr[t + 1].x), bflo(gr[t + 1].y), bfhi(gr[t + 1].y)}, curk[4] = {bflo(gk[t + 1].x), bfhi(gk[t + 1].x), bflo(gk[t + 1].y), bfhi(gk[t + 1].y)};
      const float curv[4] = {bflo(gv[t + 1].x), bfhi(gv[t + 1].x), bflo(gv[t + 1].y), bfhi(gv[t + 1].y)}, curz[4] = {bflo(gz[t + 1].x), bfhi(gz[t + 1].x), bflo(gz[t + 1].y), bfhi(gz[t + 1].y)};
      const float av[4] = {bflo(ga[t].x), bfhi(ga[t].x), bflo(ga[t].y), bfhi(ga[t].y)};
      float rm[4], km[4], vm[4], kkv[4], bb[4], kmod[4], szb[4];
      float ssq = 0.f, bon = 0.f;
#pragma unroll
      for (int x = 0; x < 4; ++x) {
        rm[x] = curr[x] + mura[x] * (pr[x] - curr[x]);
        km[x] = curk[x] + muka[x] * (pk[x] - curk[x]);
        vm[x] = curv[x] + muva[x] * (pv[x] - curv[x]);
        const float zm = curz[x] + muza[x] * (pz[x] - curz[x]);
        szb[x] = zm * sigmoidf_(zm);
        kkv[x] = km[x] * kka[x];
        ssq += kkv[x] * kkv[x];
        kmod[x] = km[x] * (1.f + (av[x] - 1.f) * kaa[x]);
        bon += rm[x] * kmod[x] * rka[x];
        pr[x] = curr[x]; pk[x] = curk[x]; pv[x] = curv[x]; pz[x] = curz[x];
      }
      ssq = sum16(ssq); bon = sum16(bon);
      const float inv = 1.f / fmaxf(sqrtf(ssq), 1e-12f);
#pragma unroll
      for (int x = 0; x < 4; ++x) { kkv[x] *= inv; bb[x] = kkv[x] * av[x]; }
      ntstore2(SR + idx[t], make_uint2(cvtpk(rm[0], rm[1]), cvtpk(rm[2], rm[3])));
      ntstore2(SK + idx[t], make_uint2(cvtpk(kmod[0], kmod[1]), cvtpk(kmod[2], kmod[3])));
      ntstore2(SV + idx[t], make_uint2(cvtpk(vm[0], vm[1]), cvtpk(vm[2], vm[3])));
      ntstore2(SKK + idx[t], make_uint2(cvtpk(-kkv[0], -kkv[1]), cvtpk(-kkv[2], -kkv[3])));
      ntstore2(SB + idx[t], make_uint2(cvtpk(bb[0], bb[1]), cvtpk(bb[2], bb[3])));
      ntstore2(SZB + (size_t)row * 1024 + c, make_uint2(cvtpk(szb[0], szb[1]), cvtpk(szb[2], szb[3])));
      if ((tid & 15) == 0) BONUS[(size_t)row * 16 + hh] = bon;
    }
  }
}

template <bool SAMPLE>
DI void attn_wave(const Params& p, int sh, int qt) {
  const int lane = TIDX & 63, r = lane & 31, h = lane >> 5;
  const int hh = sh & 15, b = sh >> 4;
  bf16_t* QB = (bf16_t*)(p.ws + WS_QB);
  const int row0 = SAMPLE ? MP + b * 16 : b * 4096 + qt * 32;
  bf16_t* Qp = QB + (size_t)row0 * 1024 + hh * 64;
  const int qrow = SAMPLE ? (r < 15 ? r : 15) : r;
  bf16x8 qf[4];
#pragma unroll
  for (int s = 0; s < 4; ++s) qf[s] = *(const bf16x8*)(Qp + (size_t)qrow * 1024 + 16 * s + 8 * h);
  f32x16 z0, z1;
#pragma unroll
  for (int i = 0; i < 16; ++i) { z0[i] = 0.f; z1[i] = 0.f; }
  float carry = 1.f;
  const int ntiles = SAMPLE ? 33 : qt + 1;
  for (int it = 0; it < ntiles; ++it) {
    const bool diag = (it == 0);
    const int kt = SAMPLE ? 32 - it : qt - it;
    bf16x8 kf[4];
    {
      const float* Kp;
      if (!SAMPLE) Kp = p.out + OUT_KP + ((size_t)sh * 4096 + kt * 32 + r) * 64;
      else Kp = diag ? p.out + OUT_KS + ((size_t)sh * 16 + (r < 15 ? r : 15)) * 64 : p.in[2] + ((size_t)sh * 1024 + kt * 32 + r) * 64;
#pragma unroll
      for (int s = 0; s < 4; ++s) {
        const float4 a = *(const float4*)(Kp + 16 * s + 8 * h), bq = *(const float4*)(Kp + 16 * s + 8 * h + 4);
        u32x4 w; w[0] = cvtpk(a.x, a.y); w[1] = cvtpk(a.z, a.w); w[2] = cvtpk(bq.x, bq.y); w[3] = cvtpk(bq.z, bq.w);
        kf[s] = __builtin_bit_cast(bf16x8, w);
      }
    }
    f32x16 st;
#pragma unroll
    for (int i = 0; i < 16; ++i) st[i] = 0.f;
#pragma unroll
    for (int s = 0; s < 4; ++s) st = MFMA32(kf[s], qf[s], st);
    float keep[16], wgt[16];
#pragma unroll
    for (int i = 0; i < 16; ++i) {
      const float e = __builtin_amdgcn_exp2f(st[i]);
      const float kp = __builtin_amdgcn_rcpf(1.f + e);
      bool valid = true;
      if (diag) { const int kr = crow(i, h); valid = SAMPLE ? (kr < r && kr < 16) : (kr < r); }
      keep[i] = valid ? kp : 1.f;
      wgt[i] = valid ? 1.f - kp : 0.f;
    }
    float pp[4], hif[4];
#pragma unroll
    for (int g = 0; g < 4; ++g) {
      const float p4 = (keep[4 * g] * keep[4 * g + 1]) * (keep[4 * g + 2] * keep[4 * g + 3]);
      const auto sw = __builtin_amdgcn_permlane32_swap(__float_as_uint(p4), __float_as_uint(p4), false, false);
      const float lo = __uint_as_float(sw[0]), hi = __uint_as_float(sw[1]);
      pp[g] = lo * hi;
      hif[g] = h ? 1.f : hi;
    }
    float T[4];
    T[3] = carry; T[2] = T[3] * pp[3]; T[1] = T[2] * pp[2]; T[0] = T[1] * pp[1];
    carry = T[0] * pp[0];
#pragma unroll
    for (int g = 0; g < 4; ++g) {
      const float w3 = T[g] * hif[g], w2 = w3 * keep[4 * g + 3], w1 = w2 * keep[4 * g + 2], w0 = w1 * keep[4 * g + 1];
      wgt[4 * g + 3] *= w3; wgt[4 * g + 2] *= w2; wgt[4 * g + 1] *= w1; wgt[4 * g] *= w0;
    }
#pragma unroll
    for (int s = 0; s < 2; ++s) {
      u32x4 pw;
#pragma unroll
      for (int j = 0; j < 4; ++j) pw[j] = cvtpk(wgt[8 * s + 2 * j], wgt[8 * s + 2 * j + 1]);
      const bf16x8 pf = __builtin_bit_cast(bf16x8, pw);
#pragma unroll
      for (int db = 0; db < 2; ++db) {
        bf16x8 vf;
        {
          float vv[8];
#pragma unroll
          for (int j = 0; j < 8; ++j) {
            const int kr = 16 * s + 8 * (j >> 2) + 4 * h + (j & 3);
            const float* vp;
            if (!SAMPLE) vp = p.out + OUT_VP + ((size_t)sh * 4096 + kt * 32 + kr) * 64;
            else vp = diag ? p.out + OUT_VS + ((size_t)sh * 16 + (kr < 15 ? kr : 15)) * 64 : p.in[3] + ((size_t)sh * 1024 + kt * 32 + kr) * 64;
            vv[j] = vp[db * 32 + r];
          }
          u32x4 w; w[0] = cvtpk(vv[0], vv[1]); w[1] = cvtpk(vv[2], vv[3]); w[2] = cvtpk(vv[4], vv[5]); w[3] = cvtpk(vv[6], vv[7]);
          vf = __builtin_bit_cast(bf16x8, w);
        }
        if (db == 0) z0 = MFMA32(pf, vf, z0); else z1 = MFMA32(pf, vf, z1);
      }
    }
    if (__ballot(carry != 0.f) == 0ull) break;
  }
  const bf16_t* SZA = (const bf16_t*)(p.ws + WS_SZA);
#pragma unroll
  for (int i = 0; i < 16; ++i) {
    const int q = crow(i, h);
    if (SAMPLE && q >= 16) continue;
    const size_t o = (size_t)(row0 + q) * 1024 + hh * 64 + r;
    QB[o] = f2bf(z0[i] * bf2f(SZA[o]));
    QB[o + 32] = f2bf(z1[i] * bf2f(SZA[o + 32]));
  }
}

DI float row16_sum(float x) {
  x += dppf<0xB1>(x); x += dppf<0x4E>(x); x += dppf<0x124>(x); x += dppf<0x128>(x);
  return x;
}
DI void scan_wave(const Params& p, int shg, int slice, float* L) {
  const int lane = TIDX & 63, cc = lane & 15;
  const bool prompt = shg < 64;
  const int T = prompt ? 4096 : 16;
  const size_t base = prompt ? (size_t)shg * 4096 * 64 : (size_t)MP * 1024 + (size_t)(shg - 64) * 16 * 64;
  const int v = slice * 4 + (lane >> 4);
  const float* SW = (const float*)(p.ws + WS_SW) + base;
  const bf16_t* SARR = (const bf16_t*)(p.ws + WS_SR) + base;
  float* ORAW = (float*)(p.ws + WS_ORAW) + base;
  float4 S;
  float* wout;
  if (prompt) { S = make_float4(0.f, 0.f, 0.f, 0.f); wout = p.out + OUT_WP + ((size_t)shg * 64 + v) * 64 + 4 * cc; }
  else { S = *(const float4*)(p.in[5] + ((size_t)(shg - 64) * 64 + v) * 64 + 4 * cc); wout = p.out + OUT_WS + ((size_t)(shg - 64) * 64 + v) * 64 + 4 * cc; }
  const int nch = T / 8;
  const int dw0 = ((lane >> 4) * 6 + 2) * 64 + (lane & 15) * 4, dw1 = dw0 + 4 * 384;
  const int db = (lane >> 3) * 384 + (lane & 7) * 8;
  uint4 gw0, gw1, gr, gk, gv, gn, gb;
#define SCAN_GLOAD(ch) do { const float* w_ = SW + (size_t)(ch) * 512; gw0 = *(const uint4*)(w_ + lane * 4); gw1 = *(const uint4*)(w_ + 256 + lane * 4); \
    const bf16_t* a_ = SARR + (size_t)(ch) * 512 + lane * 8; gr = *(const uint4*)a_; gk = *(const uint4*)(a_ + SZ_ACT / 2); gv = *(const uint4*)(a_ + 2 * (SZ_ACT / 2)); \
    gn = *(const uint4*)(a_ + 3 * (SZ_ACT / 2)); gb = *(const uint4*)(a_ + 4 * (SZ_ACT / 2)); } while (0)
#define SCAN_PUT(slot, g) do { float* d_ = L + db + (slot) * 64; *(float4*)d_ = make_float4(bflo(g.x), bfhi(g.x), bflo(g.y), bfhi(g.y)); *(float4*)(d_ + 4) = make_float4(bflo(g.z), bfhi(g.z), bflo(g.w), bfhi(g.w)); } while (0)
#define SCAN_LSTORE() do { *(uint4*)(L + dw0) = gw0; *(uint4*)(L + dw1) = gw1; SCAN_PUT(4, gr); SCAN_PUT(3, gk); SCAN_PUT(5, gv); SCAN_PUT(0, gn); SCAN_PUT(1, gb); \
    asm volatile("s_waitcnt lgkmcnt(0)" ::: "memory"); } while (0)
  SCAN_GLOAD(0);
  asm volatile("s_waitcnt lgkmcnt(0)" ::: "memory");
  SCAN_LSTORE();
  for (int ch = 0; ch < nch; ++ch) {
    if (ch + 1 < nch) SCAN_GLOAD(ch + 1);
    float okeep = 0.f;
    const float* Lc = L + 4 * cc;
    float4 nk = *(const float4*)(Lc), bb = *(const float4*)(Lc + 64), ww = *(const float4*)(Lc + 128), kv = *(const float4*)(Lc + 192), rr = *(const float4*)(Lc + 256);
    float vt = L[320 + v];
#pragma unroll 4
    for (int st = 0; st < 8; ++st) {
      const int sn = ((st + 1) & 7) * 384;
      const float4 nk2 = *(const float4*)(Lc + sn), bb2 = *(const float4*)(Lc + sn + 64), ww2 = *(const float4*)(Lc + sn + 128);
      const float4 kv2 = *(const float4*)(Lc + sn + 192), rr2 = *(const float4*)(Lc + sn + 256);
      const float vt2 = L[sn + 320 + v];
      float d = (S.x * nk.x + S.y * nk.y) + (S.z * nk.z + S.w * nk.w);
      const float sa = row16_sum(d);
      S.x = S.x * ww.x + (sa * bb.x + vt * kv.x);
      S.y = S.y * ww.y + (sa * bb.y + vt * kv.y);
      S.z = S.z * ww.z + (sa * bb.z + vt * kv.z);
      S.w = S.w * ww.w + (sa * bb.w + vt * kv.w);
      float o = (S.x * rr.x + S.y * rr.y) + (S.z * rr.z + S.w * rr.w);
      o = row16_sum(o);
      okeep = (cc == st) ? o : okeep;
      nk = nk2; bb = bb2; ww = ww2; kv = kv2; rr = rr2; vt = vt2;
    }
    if (cc < 8) ORAW[(size_t)(ch * 8 + cc) * 64 + v] = okeep;
    asm volatile("s_waitcnt lgkmcnt(0)" ::: "memory");
    if (ch + 1 < nch) SCAN_LSTORE();
  }
  *(float4*)wout = S;
#undef SCAN_GLOAD
#undef SCAN_PUT
#undef SCAN_LSTORE
}

DI void sgroup_barrier(volatile LAS unsigned* cnt, unsigned target) {
  asm volatile("s_waitcnt lgkmcnt(0)" ::: "memory");
  if ((TIDX & 63) == 0) __hip_atomic_fetch_add((LAS unsigned*)cnt, 1u, __ATOMIC_RELAXED, __HIP_MEMORY_SCOPE_WORKGROUP);
  while (*cnt < target) __builtin_amdgcn_s_sleep(1);
  asm volatile("" ::: "memory");
}
DI void scan_group(const Params& p, int sh, int quarter, float* lds, volatile LAS unsigned* cnt, unsigned& nbar) {
  const int tid = TIDX & 255, lane = tid & 63, wid = tid >> 6, cc = lane & 15;
  const size_t base = (size_t)sh * 4096 * 64;
  const int v = quarter * 16 + wid * 4 + (lane >> 4);
  const float* SW = (const float*)(p.ws + WS_SW) + base;
  const bf16_t* SARR = (const bf16_t*)(p.ws + WS_SR) + base;
  float* ORAW = (float*)(p.ws + WS_ORAW) + base;
  f32x2 S01 = {0.f, 0.f}, S23 = {0.f, 0.f};
  const bool b0 = (lane & 1) != 0, b1 = (lane & 2) != 0;
  float4 gw0, gw1; uint4 gb0, gb1, gb2, gb3, gb4;
  const int dstw0 = ((tid >> 4) * 6 + 2) * 64 + (tid & 15) * 4, dstw1 = dstw0 + 16 * 384;
  const int dstb = (tid >> 3) * 384 + (tid & 7) * 8;
  const bf16_t* sbp = SARR + tid * 8;
#define SG_GLOAD(ch) do { const size_t o_ = (size_t)(ch) * 2048; gw0 = *(const float4*)(SW + o_ + tid * 4); gw1 = *(const float4*)(SW + o_ + 1024 + tid * 4); \
    gb0 = *(const uint4*)(sbp + o_); gb1 = *(const uint4*)(sbp + (SZ_ACT / 2) + o_); gb2 = *(const uint4*)(sbp + 2 * (SZ_ACT / 2) + o_); \
    gb3 = *(const uint4*)(sbp + 3 * (SZ_ACT / 2) + o_); gb4 = *(const uint4*)(sbp + 4 * (SZ_ACT / 2) + o_); } while (0)
#define SG_PUT(d_, g) do { *(float4*)(d_) = make_float4(bflo(g.x), bfhi(g.x), bflo(g.y), bfhi(g.y)); *(float4*)((d_) + 4) = make_float4(bflo(g.z), bfhi(g.z), bflo(g.w), bfhi(g.w)); } while (0)
#define SG_LSTORE(buf) do { float* L_ = lds + (buf) * (32 * 384); *(float4*)(L_ + dstw0) = gw0; *(float4*)(L_ + dstw1) = gw1; \
    SG_PUT(L_ + dstb + 4 * 64, gb0); SG_PUT(L_ + dstb + 3 * 64, gb1); SG_PUT(L_ + dstb + 5 * 64, gb2); SG_PUT(L_ + dstb + 0 * 64, gb3); SG_PUT(L_ + dstb + 1 * 64, gb4); } while (0)
  SG_GLOAD(0); SG_LSTORE(0); sgroup_barrier(cnt, 4u * (++nbar));
  for (int ch = 0; ch < 128; ++ch) {
    if (ch + 1 < 128) SG_GLOAD(ch + 1);
    {
    const float* L = lds + (ch & 1) * (32 * 384);
    float okeep = 0.f;
    const float* Lc = L + 4 * cc;
    f32x4 nk = *(const f32x4*)(Lc), bb = *(const f32x4*)(Lc + 64), ww = *(const f32x4*)(Lc + 128), kv = *(const f32x4*)(Lc + 192), rr = *(const f32x4*)(Lc + 256);
    float vt = L[320 + v];
    f32x4 rrp = rr;
    float po[4];
#pragma unroll
    for (int st = 0; st <= 32; ++st) {
      if (st > 0) { const f32x2 o2 = S01 * rrp.xy + S23 * rrp.zw; po[(st - 1) & 3] = o2.x + o2.y; }
      if (st > 0 && (st & 3) == 0) {
        const float u0 = (b0 ? po[1] : po[0]) + dppf<0xB1>(b0 ? po[0] : po[1]);
        const float u1 = (b0 ? po[3] : po[2]) + dppf<0xB1>(b0 ? po[2] : po[3]);
        float w = (b1 ? u1 : u0) + dppf<0x4E>(b1 ? u0 : u1);
        w += dppf<0x124>(w); w += dppf<0x128>(w);
        okeep = ((cc >> 2) == (((st >> 2) - 1) & 3)) ? w : okeep;
      }
      if (st == 16 || st == 32) ORAW[(size_t)(ch * 32 + (st - 16) + cc) * 64 + v] = okeep;
      if (st < 32) {
        const int sn = ((st + 1) & 31) * 384;
        const f32x2 d2 = S01 * nk.xy + S23 * nk.zw;
        float x = d2.x + d2.y;
        const f32x2 vt_2 = {vt, vt};
        const f32x2 t01 = vt_2 * kv.xy, t23 = vt_2 * kv.zw;
        __builtin_amdgcn_sched_barrier(0);
        x += dppf<0xB1>(x);
        const f32x4 nk2 = *(const f32x4*)(Lc + sn), bb2 = *(const f32x4*)(Lc + sn + 64);
        __builtin_amdgcn_sched_barrier(0);
        x += dppf<0x4E>(x);
        const f32x4 ww2 = *(const f32x4*)(Lc + sn + 128), kv2 = *(const f32x4*)(Lc + sn + 192);
        __builtin_amdgcn_sched_barrier(0);
        x += dppf<0x124>(x);
        const f32x4 rr2 = *(const f32x4*)(Lc + sn + 256);
        const float vt2 = L[sn + 320 + v];
        __builtin_amdgcn_sched_barrier(0);
        x += dppf<0x128>(x);
        __builtin_amdgcn_sched_barrier(0);
        const f32x2 sa2 = {x, x};
        S01 = S01 * ww.xy + (sa2 * bb.xy + t01);
        S23 = S23 * ww.zw + (sa2 * bb.zw + t23);
        rrp = rr;
        nk = nk2; bb = bb2; ww = ww2; kv = kv2; rr = rr2; vt = vt2;
      }
    }
    }
    if (ch + 1 < 128) SG_LSTORE((ch + 1) & 1);
    sgroup_barrier(cnt, 4u * (++nbar));
  }
  *(float4*)(p.out + OUT_WP + ((size_t)sh * 64 + v) * 64 + 4 * cc) = make_float4(S01.x, S01.y, S23.x, S23.y);
#undef SG_GLOAD
#undef SG_PUT
#undef SG_LSTORE
}

constexpr int NQ_ATT_P = 8192, NQ_ATT_S = 512, NQ_SCAN_S = 8192, NQ_DYN = NQ_ATT_P + NQ_ATT_S + NQ_SCAN_S;
DI int wave_grab(unsigned* ctr) { int v = 0; if ((TIDX & 63) == 0) v = (int)atomicAdd(ctr, 1u); return __builtin_amdgcn_readfirstlane(v); }
DI void phase2(const Params& p, char* smem) {
  __shared__ unsigned s_cnt;
  unsigned* ctl = (unsigned*)(p.ws + WS_CTL);
  const int wid = TIDX >> 6;
  if (TIDX == 0) s_cnt = 0u;
  __syncthreads();
  float* Lsh = (float*)smem + 4 * (8 * 384);
  float* L = wid >= 4 ? (float*)smem + (wid - 4) * (8 * 384) : Lsh + wid * (8 * 384);
  if (wid < 4) {
    unsigned nbar = 0;
    __builtin_amdgcn_s_setprio(3);
    for (int bu = blockIdx.x; bu < 256; bu += gridDim.x) {
      const int xs = bu & 7, slot = bu >> 3, head = xs * 8 + (slot >> 2), quarter = slot & 3;
      scan_group(p, head, quarter, Lsh, (volatile LAS unsigned*)&s_cnt, nbar);
    }
    __builtin_amdgcn_s_setprio(0);
  }
  for (;;) {
    int u = wave_grab(&ctl[0]);
    if (u >= NQ_DYN) break;
    if (u < NQ_ATT_P) { attn_wave<false>(p, u >> 7, u & 127); continue; }
    u -= NQ_ATT_P;
    if (u < NQ_ATT_S) { attn_wave<true>(p, u, 0); continue; }
    u -= NQ_ATT_S;
    scan_wave(p, 64 + (u >> 4), u & 15, L);
  }
}

DI void p2c_row(const Params& p, int row, int c, int hh, const float4& lg, const float4& lb, const float4& o, const uint2& vv, const uint2& zz, float bon) {
  const float mean = sum16((o.x + o.y) + (o.z + o.w)) * (1.f / 64.f);
  const float dx = o.x - mean, dy = o.y - mean, dz = o.z - mean, dw = o.w - mean;
  const float var = sum16((dx * dx + dy * dy) + (dz * dz + dw * dw)) * (1.f / 64.f);
  const float inv = rsqrtf(var + LNX_EPS);
  const float r0 = (dx * inv * lg.x + lb.x + bon * bflo(vv.x)) * bflo(zz.x);
  const float r1 = (dy * inv * lg.y + lb.y + bon * bfhi(vv.x)) * bfhi(zz.x);
  const float r2 = (dz * inv * lg.z + lb.z + bon * bflo(vv.y)) * bflo(zz.y);
  const float r3 = (dw * inv * lg.w + lb.w + bon * bfhi(vv.y)) * bfhi(zz.y);
  *(uint2*)((bf16_t*)(p.ws + WS_OB) + (size_t)row * 1024 + c) = make_uint2(cvtpk(r0, r1), cvtpk(r2, r3));
}
DI void phase2c(const Params& p) {
  const int tid = TIDX & 255, half = TIDX >> 8, c = tid * 4, hh = c >> 6;
  const float4 lg = *(const float4*)(p.in[16] + c), lb = *(const float4*)(p.in[17] + c);
  const float* ORAW = (const float*)(p.ws + WS_ORAW); const bf16_t* SV = (const bf16_t*)(p.ws + WS_SV);
  const bf16_t* SZB = (const bf16_t*)(p.ws + WS_SZB); const float* BONUS = (const float*)(p.ws + WS_BONUS);
  const int stride = gridDim.x * 2;
  for (int row = blockIdx.x * 2 + half; row < MT; row += 2 * stride) {
    const bool two = row + stride < MT;
    const int rowb = two ? row + stride : row;
    const size_t ia = hm_base(row) + hh * hm_hstride(row) + (c & 63), ib = hm_base(rowb) + hh * hm_hstride(rowb) + (c & 63);
    const float4 oa = *(const float4*)(ORAW + ia), ob = *(const float4*)(ORAW + ib);
    const uint2 va = *(const uint2*)(SV + ia), vb = *(const uint2*)(SV + ib);
    const uint2 za = *(const uint2*)(SZB + (size_t)row * 1024 + c), zb = *(const uint2*)(SZB + (size_t)rowb * 1024 + c);
    const float ba = BONUS[(size_t)row * 16 + hh], bb = BONUS[(size_t)rowb * 16 + hh];
    p2c_row(p, row, c, hh, lg, lb, oa, va, za, ba);
    if (two) p2c_row(p, rowb, c, hh, lg, lb, ob, vb, zb, bb);
  }
}

DI void phase4(const Params& p) {
  const int lane = TIDX & 63, wid = TIDX >> 6;
  const float* g = p.in[21];
  float4 gg[4];
#pragma unroll
  for (int i = 0; i < 4; ++i) gg[i] = *(const float4*)(g + i * 256 + lane * 4);
  const int stride = gridDim.x * 8;
  for (int row = blockIdx.x * 8 + wid; row < MT; row += 2 * stride) {
    const bool two = row + stride < MT;
    float* x0 = p.out + OUT_YP + (size_t)row * 1024;
    float* x1 = p.out + OUT_YP + (size_t)(two ? row + stride : row) * 1024;
    float4 v0[4], v1[4]; float s0 = 0.f, s1 = 0.f;
#pragma unroll
    for (int i = 0; i < 4; ++i) { v0[i] = *(const float4*)(x0 + i * 256 + lane * 4); v1[i] = *(const float4*)(x1 + i * 256 + lane * 4); }
#pragma unroll
    for (int i = 0; i < 4; ++i) {
      s0 += v0[i].x * v0[i].x + v0[i].y * v0[i].y + v0[i].z * v0[i].z + v0[i].w * v0[i].w;
      s1 += v1[i].x * v1[i].x + v1[i].y * v1[i].y + v1[i].z * v1[i].z + v1[i].w * v1[i].w;
    }
    s0 = wave_sum(s0); s1 = wave_sum(s1);
    const float i0 = rsqrtf(s0 * (1.f / DM) + EPS), i1 = rsqrtf(s1 * (1.f / DM) + EPS);
#pragma unroll
    for (int i = 0; i < 4; ++i) *(float4*)(x0 + i * 256 + lane * 4) = make_float4(v0[i].x * i0 * gg[i].x, v0[i].y * i0 * gg[i].y, v0[i].z * i0 * gg[i].z, v0[i].w * i0 * gg[i].w);
    if (two) {
#pragma unroll
      for (int i = 0; i < 4; ++i) *(float4*)(x1 + i * 256 + lane * 4) = make_float4(v1[i].x * i1 * gg[i].x, v1[i].y * i1 * gg[i].y, v1[i].z * i1 * gg[i].z, v1[i].w * i1 * gg[i].w);
    }
  }
}

#define XB_TMO      128
#define XB_XCNT(j)  (256  + 64 * (j))
#define XB_XSUB(j)  (1280 + 64 * (j))
#define XB_XGEN(j)  (2304 + 64 * (j))
#define XB_TOP      3328
#define XB_TOPGEN   3392
#define XCD_BAR_WORDS 3456
#define XB_SPIN_CAP (1u << 18)

__device__ __forceinline__ unsigned xb_ld(unsigned* p)              { return __hip_atomic_load(p, __ATOMIC_RELAXED, __HIP_MEMORY_SCOPE_AGENT); }
__device__ __forceinline__ unsigned xb_add(unsigned* p, unsigned v) { return __hip_atomic_fetch_add(p, v, __ATOMIC_RELAXED, __HIP_MEMORY_SCOPE_AGENT); }
__device__ __forceinline__ unsigned xb_xcc_id() { return (unsigned)__builtin_amdgcn_s_getreg((3 << 11) | 20) & 0xFu; }
#define XB_SPIN(cond, bar) do { unsigned _sp = 0; while (cond) { __builtin_amdgcn_s_sleep(1); \
    if ((++_sp & 255u) == 0u) { if (xb_ld(&(bar)[XB_TMO])) break; if (_sp > XB_SPIN_CAP) { atomicAdd(&(bar)[XB_TMO], 1u); break; } } } } while (0)

struct XcdBarrier {
    unsigned* bar; unsigned x;
    volatile LAS unsigned* st;
};

__device__ __forceinline__ XcdBarrier xcd_barrier_post(unsigned* bar, volatile LAS unsigned* st) {
    XcdBarrier b; b.bar = bar; b.x = xb_xcc_id(); b.st = st;
    if (TIDX == 0) (void)xb_add(&bar[XB_XCNT(b.x)], 1u);
    return b;
}
__device__ __forceinline__ void xcd_barrier_complete(unsigned* bar, unsigned x, unsigned& nloc, unsigned& nx) {
    const unsigned G = gridDim.x * gridDim.y * gridDim.z;
    unsigned sum, cnt, mine, sp = 0u;
    for (;;) {
        sum = 0u; cnt = 0u; mine = 0u;
#pragma unroll
        for (unsigned j = 0; j < 16; ++j) { const unsigned c = xb_ld(&bar[XB_XCNT(j)]); sum += c; cnt += (c > 0u) ? 1u : 0u; mine = (j == x) ? c : mine; }
        if (sum == G) break;
        __builtin_amdgcn_s_sleep(1);
        if ((++sp & 255u) == 0u) { if (xb_ld(&bar[XB_TMO])) break; if (sp > XB_SPIN_CAP) { atomicAdd(&bar[XB_TMO], 1u); break; } }
    }
    nloc = mine > 0u ? mine : 1u; nx = cnt > 0u ? cnt : 1u;
}

__device__ __forceinline__ void xcd_barrier(const XcdBarrier& b) {
    asm volatile("s_waitcnt vmcnt(0)" ::: "memory");
    __syncthreads();
    if (TIDX == 0) {
        unsigned* bar = b.bar;
        __builtin_amdgcn_s_waitcnt(0);
        unsigned nloc = b.st[0], nx = b.st[1];
        if (nloc == 0u) { xcd_barrier_complete(bar, b.x, nloc, nx); b.st[0] = nloc; b.st[1] = nx; }
        const unsigned old = xb_add(&bar[XB_XSUB(b.x)], 1u);
        const unsigned gen = old / nloc;
        if (old + 1u == (gen + 1u) * nloc) {
            __builtin_amdgcn_fence(__ATOMIC_RELEASE, "agent");
            asm volatile("s_waitcnt vmcnt(0)" ::: "memory");
            const unsigned og = xb_add(&bar[XB_TOP], 1u);
            const unsigned tg = og / nx;
            if (og + 1u == (tg + 1u) * nx) xb_add(&bar[XB_TOPGEN], 1u);
            else XB_SPIN(xb_ld(&bar[XB_TOPGEN]) == tg, bar);
            __builtin_amdgcn_fence(__ATOMIC_ACQUIRE, "agent");
            xb_add(&bar[XB_XGEN(b.x)], 1u);
            asm volatile("s_waitcnt vmcnt(0)" ::: "memory");
        } else {
            XB_SPIN(xb_ld(&bar[XB_XGEN(b.x)]) == gen, bar);
            __builtin_amdgcn_fence(__ATOMIC_ACQUIRE, "agent");
            asm volatile("s_waitcnt vmcnt(0)" ::: "memory");
        }
    }
    __syncthreads();
}

__global__ void __launch_bounds__(NT, 2) mega(Params p) {
  extern __shared__ __attribute__((aligned(16))) char smem[];
  cg::grid_group grid = cg::this_grid();
  if (blockIdx.x == 0) { unsigned* ctl = (unsigned*)(p.ws + WS_CTL); for (int i = TIDX; i < 16384; i += NT) ctl[i] = 0u; }
  grid.sync();
  __shared__ unsigned xb_st[2];
  if (TIDX == 0) { xb_st[0] = 0u; xb_st[1] = 0u; }
  __syncthreads();
  (void)xcd_barrier_post((unsigned*)(p.ws + WS_CTL) + 8192, (volatile LAS unsigned*)xb_st);
#define XBAR() do { XcdBarrier xb_; xb_.bar = (unsigned*)(p.ws + WS_CTL) + 8192; xb_.x = xb_xcc_id(); xb_.st = (volatile LAS unsigned*)xb_st; xcd_barrier(xb_); } while (0)
  phase0(p, smem);
  XBAR();
  { EpiP1 E; E.p = p; run_gemm(smem, (const bf16_t*)(p.ws + WS_H), (const bf16_t*)(p.ws + WS_WINT), MT, NINP, E); }
  XBAR();
  phase_x(p);
  XBAR();
  { EpiLora E; E.p = p; run_gemm(smem, (const bf16_t*)(p.ws + WS_X), (const bf16_t*)(p.ws + WS_BTL), MP, 2048, E, 256); }
  small_lora(p);
  XBAR();
  phase1c(p);
  XBAR();
  phase2(p, smem);
  XBAR();
  phase2c(p);
  XBAR();
  { EpiGate E; E.p = p; E.goff = 0; E.first = true; run_gemm(smem, (const bf16_t*)(p.ws + WS_QB), (const bf16_t*)(p.ws + WS_WT), MP, 1024, E); }
  small_gemm<0>(p, (const bf16_t*)(p.ws + WS_QB), (const bf16_t*)(p.ws + WS_WT));
  { EpiGate E; E.p = p; E.goff = 1024; E.first = false; run_gemm(smem, (const bf16_t*)(p.ws + WS_OB), (const bf16_t*)(p.ws + WS_WT) + (size_t)1024 * 1024, MP, 1024, E); }
  small_gemm<1>(p, (const bf16_t*)(p.ws + WS_OB), (const bf16_t*)(p.ws + WS_WT) + (size_t)1024 * 1024);
  XBAR();
  { EpiOut E; E.p = p; run_gemm(smem, (const bf16_t*)(p.ws + WS_MG), (const bf16_t*)(p.ws + WS_WT) + (size_t)2 * 1024 * 1024, MP, 1024, E); }
  small_gemm<2>(p, (const bf16_t*)(p.ws + WS_MG), (const bf16_t*)(p.ws + WS_WT) + (size_t)2 * 1024 * 1024);
  XBAR();
  phase4(p);
}

extern "C" void kernel_launch(void* const* d_in, const int* in_sizes, int n_in, void* d_out, int out_size, void* d_ws, size_t ws_size, hipStream_t stream) {
  static int grid_blocks = 0;
  if (grid_blocks == 0) {
    if (n_in != 22 || ws_size < WS_END) { fprintf(stderr, "kernel_launch: unexpected n_in %d / ws_size %zu (need %zu)\n", n_in, ws_size, (size_t)WS_END); grid_blocks = -1; return; }
    int dev = 0, cus = 0, per_cu = 0;
    (void)hipGetDevice(&dev);
    (void)hipDeviceGetAttribute(&cus, hipDeviceAttributeMultiprocessorCount, dev);
    (void)hipFuncSetAttribute((const void*)mega, hipFuncAttributeMaxDynamicSharedMemorySize, SMEM_BYTES);
    (void)hipOccupancyMaxActiveBlocksPerMultiprocessor(&per_cu, (const void*)mega, NT, SMEM_BYTES);
    (void)hipGetLastError();
    grid_blocks = cus;
  }
  if (grid_blocks < 0) return;
  Params p{};
  for (int i = 0; i < 22; ++i) p.in[i] = (const float*)d_in[i];
  p.out = (float*)d_out; p.ws = (unsigned char*)d_ws;
  void* args[] = {&p};
  hipError_t e = hipLaunchCooperativeKernel((const void*)mega, dim3(grid_blocks), dim3(NT), args, SMEM_BYTES, stream);
  if (e != hipSuccess) fprintf(stderr, "cooperative launch failed: %s (grid %d)\n", hipGetErrorString(e), grid_blocks);
}
```

```cpp
#include <hip/hip_runtime.h>
#include <hip/hip_cooperative_groups.h>
#include <cstdio>
#include <cstdint>
namespace cg = cooperative_groups;
__device__ __forceinline__ int lane_id_() { return (int)__builtin_amdgcn_mbcnt_hi(~0u, __builtin_amdgcn_mbcnt_lo(~0u, 0u)); }
#define TIDX (__builtin_amdgcn_readfirstlane((int)(threadIdx.x >> 6)) * 64 + lane_id_())

namespace pg8 {
#define PG8_LAS __attribute__((address_space(3)))
typedef unsigned short bf16_t;
typedef short bf16x8 __attribute__((ext_vector_type(8)));
typedef float f32x4 __attribute__((ext_vector_type(4)));
typedef unsigned u32x4 __attribute__((ext_vector_type(4)));
constexpr int BM = 256, BK = 64, HALF = 128, HTB = HALF * BK * 2  , STAGE_BYTES = 8 * HTB, NXCD = 8, WGM = 8;

__host__ __device__ __forceinline__ int lds_byte(int r, int c) { const int st = (r >> 4) * 2 + (c >> 5), rr = r & 15, cc = c & 31, ob = rr * 64 + cc * 2; return st * 1024 + (ob ^ (((ob >> 9) & 1) << 5)); }
__host__ __device__ __forceinline__ void stage_rc(int b, int& R, int& C) { const int st = b / 1024, sb = b % 1024, swz = sb ^ (((sb >> 9) & 1) << 5); R = (st >> 1) * 16 + swz / 64; C = (st & 1) * 32 + (swz % 64) / 2; }
__host__ __device__ __forceinline__ int perm32(int rho) { const int n = rho >> 4, i = rho & 15; return 8 * (i >> 2) + 4 * n + (i & 3); }

struct Unit { int pm, pn; };
struct Gemm { const bf16_t* A; const bf16_t* Bt; int M, N, K; };

struct StaticOrder {
    int nM, nN, nwg, G, c;
    __host__ __device__ void init(int M, int N, int G_, int c_) { nM = M / BM; nN = N / BM; nwg = nM * nN; G = G_; c = c_; }
    __host__ __device__ bool next(int i, Unit& u) const {
        const long L = (long)i * G + c; if (L >= nwg) return false;
        int wgid = (int)L; { const int q = nwg / NXCD, r = nwg % NXCD, xcd = wgid % NXCD, off = wgid / NXCD; wgid = (xcd < r ? xcd * (q + 1) : r * (q + 1) + (xcd - r) * q) + off; }
        const int nig = WGM * nN, gid = wgid / nig, fm = gid * WGM, gsz = (nM - fm) < WGM ? (nM - fm) : WGM;
        u.pm = fm + ((wgid % nig) % gsz); u.pn = (wgid % nig) / gsz; return true;
    }
    __device__ __forceinline__ void a_ready(const Unit&) const {}
    __device__ __forceinline__ void done(const Unit&) const {}
};


template <class Epi, class Sched, bool ALIGN_EPI = false, bool SP2 = false>
__device__ __forceinline__ void gemm_phase(PG8_LAS unsigned char* lds, const Gemm g, const Sched& S, const Epi& E) {
    int tid_ = TIDX; asm volatile("" : "+v"(tid_));
    const int tid = tid_, wid = __builtin_amdgcn_readfirstlane(tid >> 6), lane = tid & 63, wr = wid >> 2, wc = wid & 3, fr = lane & 15, fq = lane >> 4;
    const int K = g.K, nt = K / BK;
    unsigned voffA[2], voffB[2];
#pragma unroll
    for (int i = 0; i < 2; ++i) { int R, C; stage_rc(tid * 16 + i * 8192, R, C); const int Rb = Epi::PERM ? ((R & ~31) + perm32(R & 31)) : R;
        voffA[i] = (unsigned)(R * K + C) * 2u; voffB[i] = (unsigned)(Rb * K + C) * 2u; }
    const size_t kstep = (size_t)(BK * 2);
    const size_t hstep = (size_t)HALF * K * 2;
    const size_t tstep = 2 * hstep;
    const unsigned ldsw = (unsigned)wid * 1024u;
    const int aoff = lds_byte(wr * 64 + fr, fq * 8), boff = lds_byte(wc * 32 + fr, fq * 8);
#define PG8_SA(b, h) (((b) * 2 + (h)) * HTB)
#define PG8_SB(b, h) ((4 + (b) * 2 + (h)) * HTB)
#define PG8_STAGE(bufoff, gbase, voff) do { _Pragma("unroll") for (int _i = 0; _i < 2; ++_i) \
        __builtin_amdgcn_global_load_lds((const unsigned*)((const char*)(gbase) + (voff)[_i]), (PG8_LAS unsigned*)(lds + (bufoff) + ldsw + _i * 8192), 16, 0, 0); } while (0)
#define PG8_LDA(dst, b, h) do { _Pragma("unroll") for (int m = 0; m < 4; ++m) _Pragma("unroll") for (int k = 0; k < 2; ++k) dst[m][k] = *(const PG8_LAS bf16x8*)(lds + PG8_SA(b, h) + aoff + m * 2048 + k * 1024); } while (0)
#define PG8_LDB(dst, b, h) do { _Pragma("unroll") for (int n = 0; n < 2; ++n) _Pragma("unroll") for (int k = 0; k < 2; ++k) dst[n][k] = *(const PG8_LAS bf16x8*)(lds + PG8_SB(b, h) + boff + n * 2048 + k * 1024); } while (0)
#define PG8_MMA(ai, bj, At, Bt) do { __builtin_amdgcn_s_setprio(1); _Pragma("unroll") for (int m = 0; m < 4; ++m) _Pragma("unroll") for (int n = 0; n < 2; ++n) _Pragma("unroll") for (int k = 0; k < 2; ++k) \
        acc[ai][bj][m][n] = __builtin_amdgcn_mfma_f32_16x16x32_bf16(Bt[n][k], At[m][k], acc[ai][bj][m][n], 0, 0, 0); __builtin_amdgcn_s_setprio(0); } while (0)
#define PG8_WAIT_V(n) asm volatile("s_waitcnt vmcnt(" #n ")" ::: "memory")
#define PG8_WAIT_L(n) asm volatile("s_waitcnt lgkmcnt(" #n ")" ::: "memory")
#define PG8_BAR __builtin_amdgcn_s_barrier()
#define PG8_SCHED __builtin_amdgcn_sched_barrier(0)
    Unit cur, nxt; int ui = 0;
    if (!S.next(0, cur)) return;
    f32x4 acc[2][2][4][2];
#pragma unroll
    for (int a = 0; a < 2; ++a)
#pragma unroll
        for (int b = 0; b < 2; ++b)
#pragma unroll
            for (int m = 0; m < 4; ++m)
#pragma unroll
                for (int n = 0; n < 2; ++n) acc[a][b][m][n] = (f32x4){0.f, 0.f, 0.f, 0.f};
    bf16x8 At[4][2], B0[2][2], B1[2][2];
    const char* cA = (const char*)g.A + (size_t)cur.pm * tstep; const char* cB = (const char*)g.Bt + (size_t)cur.pn * tstep;
    S.a_ready(cur);
    if constexpr (SP2) {
        PG8_STAGE(PG8_SB(0, 0), cB, voffB); PG8_STAGE(PG8_SB(0, 1), cB + hstep, voffB); PG8_STAGE(PG8_SA(0, 0), cA, voffA); PG8_STAGE(PG8_SA(0, 1), cA + hstep, voffA);
        if (wr == 1) PG8_BAR;
        PG8_WAIT_V(2); PG8_BAR;
        PG8_STAGE(PG8_SB(1, 0), cB + kstep, voffB); PG8_STAGE(PG8_SA(1, 0), cA + kstep, voffA); PG8_STAGE(PG8_SB(1, 1), cB + hstep + kstep, voffB);
        PG8_WAIT_V(6); PG8_BAR;
    } else {
        PG8_STAGE(PG8_SB(0, 0), cB, voffB); PG8_STAGE(PG8_SA(0, 0), cA, voffA); PG8_STAGE(PG8_SB(0, 1), cB + hstep, voffB); PG8_STAGE(PG8_SA(0, 1), cA + hstep, voffA);
        if (wr == 1) PG8_BAR;
        PG8_WAIT_V(4); PG8_BAR;
        PG8_STAGE(PG8_SB(1, 0), cB + kstep, voffB); PG8_STAGE(PG8_SA(1, 0), cA + kstep, voffA); PG8_STAGE(PG8_SB(1, 1), cB + hstep + kstep, voffB);
        PG8_WAIT_V(6); PG8_BAR;
    }
    for (;;) {
        const bool has_next = S.next(ui + 1, nxt);
        const char* nA = has_next ? (const char*)g.A + (size_t)nxt.pm * tstep : cA; const char* nB = has_next ? (const char*)g.Bt + (size_t)nxt.pn * tstep : cB;
        for (int t = 0; t < nt; t += 2) {
            const bool last = (t == nt - 2);
            const char* a1 = cA + (size_t)(t + 1) * kstep;
            const char* a2 = last ? nA : cA + (size_t)(t + 2) * kstep; const char* b2 = last ? nB : cB + (size_t)(t + 2) * kstep;
            const char* a3 = a2 + kstep; const char* b3 = b2 + kstep;
            if (last && has_next) S.a_ready(nxt);
            if constexpr (SP2) {
            PG8_LDB(B0, 0, 0); PG8_LDB(B1, 0, 1); PG8_SCHED; PG8_LDA(At, 0, 0); PG8_STAGE(PG8_SA(1, 1), a1 + hstep, voffA);
            PG8_WAIT_V(8); PG8_WAIT_L(0); PG8_BAR; PG8_MMA(0, 0, At, B0); PG8_MMA(0, 1, At, B1); PG8_BAR; PG8_SCHED;
            PG8_LDA(At, 0, 1); PG8_STAGE(PG8_SB(0, 0), b2, voffB); PG8_STAGE(PG8_SB(0, 1), b2 + hstep, voffB); PG8_STAGE(PG8_SA(0, 0), a2, voffA);
            PG8_WAIT_V(8); PG8_WAIT_L(0); PG8_BAR; PG8_MMA(1, 0, At, B0); PG8_MMA(1, 1, At, B1); PG8_BAR; PG8_SCHED;
            PG8_LDB(B0, 1, 0); PG8_LDB(B1, 1, 1); PG8_SCHED; PG8_LDA(At, 1, 0); PG8_STAGE(PG8_SA(0, 1), a2 + hstep, voffA);
            PG8_WAIT_V(8); PG8_WAIT_L(0); PG8_BAR; PG8_MMA(0, 0, At, B0); PG8_MMA(0, 1, At, B1); PG8_BAR; PG8_SCHED;
            PG8_LDA(At, 1, 1); PG8_STAGE(PG8_SB(1, 0), b3, voffB); PG8_STAGE(PG8_SB(1, 1), b3 + hstep, voffB); PG8_STAGE(PG8_SA(1, 0), a3, voffA);
            PG8_WAIT_V(8); PG8_WAIT_L(0); PG8_BAR; PG8_MMA(1, 0, At, B0); PG8_MMA(1, 1, At, B1); PG8_BAR; PG8_SCHED;
            } else {
            PG8_LDB(B0, 0, 0); PG8_SCHED; PG8_LDA(At, 0, 0); PG8_STAGE(PG8_SA(1, 1), a1 + hstep, voffA);
            PG8_WAIT_L(8); PG8_BAR; PG8_WAIT_L(0); PG8_MMA(0, 0, At, B0); PG8_BAR; PG8_SCHED;
            PG8_LDB(B1, 0, 1); PG8_STAGE(PG8_SB(0, 0), b2, voffB);
            PG8_BAR; PG8_WAIT_L(0); PG8_MMA(0, 1, At, B1); PG8_BAR;
            PG8_LDA(At, 0, 1); PG8_STAGE(PG8_SA(0, 0), a2, voffA);
            PG8_BAR; PG8_WAIT_L(0); PG8_MMA(1, 0, At, B0); PG8_BAR; PG8_SCHED;
            PG8_STAGE(PG8_SB(0, 1), b2 + hstep, voffB);
            PG8_WAIT_V(6); PG8_BAR; PG8_MMA(1, 1, At, B1); PG8_BAR;
            PG8_LDB(B0, 1, 0); PG8_SCHED; PG8_LDA(At, 1, 0); PG8_STAGE(PG8_SA(0, 1), a2 + hstep, voffA);
            PG8_WAIT_L(8); PG8_BAR; PG8_WAIT_L(0); PG8_MMA(0, 0, At, B0); PG8_BAR; PG8_SCHED;
            PG8_LDB(B1, 1, 1); PG8_STAGE(PG8_SB(1, 0), b3, voffB);
            PG8_BAR; PG8_WAIT_L(0); PG8_MMA(0, 1, At, B1); PG8_BAR;
            PG8_LDA(At, 1, 1); PG8_STAGE(PG8_SA(1, 0), a3, voffA);
            PG8_BAR; PG8_WAIT_L(0); PG8_MMA(1, 0, At, B0); PG8_BAR; PG8_SCHED;
            PG8_STAGE(PG8_SB(1, 1), b3 + hstep, voffB);
            PG8_WAIT_V(6); PG8_BAR; PG8_MMA(1, 1, At, B1); PG8_BAR;
            }
        }
        if constexpr (ALIGN_EPI) { if (wr == 0) PG8_BAR; }
        if constexpr (!Epi::AFTER_DRAIN) { E(acc, cur, wr, wc, fr, fq); S.done(cur); }
        if (!has_next) break;
#pragma unroll
        for (int a = 0; a < 2; ++a)
#pragma unroll
            for (int b = 0; b < 2; ++b)
#pragma unroll
                for (int m = 0; m < 4; ++m)
#pragma unroll
                    for (int n = 0; n < 2; ++n) acc[a][b][m][n] = (f32x4){0.f, 0.f, 0.f, 0.f};
        cur = nxt; cA = nA; cB = nB; ++ui;
        if constexpr (ALIGN_EPI) { if (wr == 1) PG8_BAR; }
    }
    PG8_WAIT_V(0);
    if constexpr (!ALIGN_EPI) { if (wr == 0) PG8_BAR; }
    PG8_BAR;
    if constexpr (Epi::AFTER_DRAIN) { E.fused(acc, cur, wr, wc, fr, fq, lds, wid, lane); S.done(cur); }
#undef PG8_SA
#undef PG8_SB
#undef PG8_STAGE
#undef PG8_LDA
#undef PG8_LDB
#undef PG8_MMA
#undef PG8_WAIT_V
#undef PG8_WAIT_L
#undef PG8_BAR
#undef PG8_SCHED
}
}


#define DI __device__ __forceinline__
typedef unsigned short bf16_t;
typedef short bf16x8 __attribute__((ext_vector_type(8)));
typedef float f32x4 __attribute__((ext_vector_type(4)));
typedef float f32x2 __attribute__((ext_vector_type(2)));
typedef float f32x16 __attribute__((ext_vector_type(16)));
typedef unsigned u32x4 __attribute__((ext_vector_type(4)));
#define MFMA32(a, b, c) __builtin_amdgcn_mfma_f32_32x32x16_bf16((a), (b), (c), 0, 0, 0)
#define LAS __attribute__((address_space(3)))

constexpr int NT = 512;
constexpr int DM = 1024, MP = 16384, MT = 16896;
constexpr int NIN = 10368, NINP = 10496, CSH = 4224;
constexpr float EPS = 1e-6f, LNX_EPS = 64e-5f;
constexpr float QSCALE = 0.18033688011112042f;

constexpr size_t OUT_YP = 0, OUT_KP = 17301504, OUT_VP = 34078720, OUT_SHP = 50855936, OUT_WP = 50872832,
                 OUT_KS = 51134976, OUT_VS = 51659264, OUT_SHS = 52183552, OUT_WS = 52318720;

constexpr size_t SZ_ACT = (size_t)MT * 1024 * 2;
constexpr size_t WS_R1 = 0;
constexpr size_t WS_H = WS_R1, WS_WINT = WS_R1 + SZ_ACT, WS_SW = WS_R1;
constexpr size_t WS_R2 = (size_t)MT * 1024 * 4;
constexpr size_t WS_PB = WS_R2, WS_ORAW = WS_R2, WS_OB = WS_ORAW + (size_t)MT * 1024 * 4, WS_MG = WS_OB + SZ_ACT;
constexpr size_t WS_R3 = WS_R2 + (size_t)MT * CSH * 2;
constexpr size_t WS_QB = WS_R3, WS_X = WS_QB + SZ_ACT  , WS_BTL = WS_X + (size_t)MT * 256 * 2  , WS_SZA = WS_X + (size_t)MP * 1024 * 2;
static_assert(WS_BTL + (size_t)2048 * 256 * 2 <= WS_SZA, "LoRA buffers");
constexpr size_t WS_SR = WS_SZA + SZ_ACT, WS_SK = WS_SR + SZ_ACT, WS_SV = WS_SK + SZ_ACT, WS_SKK = WS_SV + SZ_ACT, WS_SB = WS_SKK + SZ_ACT;
constexpr size_t WS_SZB = WS_SB + SZ_ACT;
constexpr size_t WS_BONUS = WS_SZB + SZ_ACT;
constexpr size_t WS_WT = WS_BONUS + (size_t)MT * 16 * 4;
constexpr size_t WS_CTL = WS_WT + 3 * (size_t)1024 * 1024 * 2;
constexpr size_t WS_END = WS_CTL + 65536;
static_assert(WS_MG + SZ_ACT <= WS_R3, "R2 overflow");
static_assert(WS_WINT + (size_t)NINP * 1024 * 2 <= WS_R2, "R1 overflow");
static_assert(WS_END <= (size_t)512 * 1024 * 1024, "workspace");

constexpr int SMEM_BYTES = 147456;

struct Params { const float* in[22]; float* out; unsigned char* ws; };

DI float bf2f(bf16_t u) { return __uint_as_float((unsigned)u << 16); }
DI unsigned cvtpk(float lo, float hi) { unsigned r; asm volatile("v_cvt_pk_bf16_f32 %0, %1, %2" : "=v"(r) : "v"(lo), "v"(hi)); return r; }
DI bf16_t f2bf(float x) { return (bf16_t)(cvtpk(x, 0.f) & 0xffffu); }
DI float bflo(unsigned u) { return __uint_as_float(u << 16); }
DI float bfhi(unsigned u) { return __uint_as_float(u & 0xffff0000u); }
DI int crow(int i, int h) { return (i & 3) + 8 * (i >> 2) + 4 * h; }
DI float sigmoidf_(float x) { return fminf(__builtin_amdgcn_rcpf(1.f + __expf(-x)), 1.f); }
typedef unsigned u32x2 __attribute__((ext_vector_type(2)));
DI uint2 ntload2(const void* q) { const u32x2 v = __builtin_nontemporal_load((const u32x2*)q); return make_uint2(v.x, v.y); }
DI void ntstore2(void* q, uint2 v) { const u32x2 t = {v.x, v.y}; __builtin_nontemporal_store(t, (u32x2*)q); }
DI uint4 pack8(f32x4 a, f32x4 b) { return make_uint4(cvtpk(a[0], a[1]), cvtpk(a[2], a[3]), cvtpk(b[0], b[1]), cvtpk(b[2], b[3])); }
template <int CTRL> DI float dppf(float x) { return __builtin_bit_cast(float, __builtin_amdgcn_mov_dpp(__builtin_bit_cast(int, x), CTRL, 0xf, 0xf, true)); }
DI float sum16(float x) { x += dppf<0xB1>(x); x += dppf<0x4E>(x); x += dppf<0x124>(x); x += dppf<0x128>(x); return x; }
DI float wave_sum(float x) {
  x = sum16(x);
  const auto s = __builtin_amdgcn_permlane16_swap(__float_as_uint(x), __float_as_uint(x), false, false);
  x = __uint_as_float(s[0]) + __uint_as_float(s[1]);
  const auto t = __builtin_amdgcn_permlane32_swap(__float_as_uint(x), __float_as_uint(x), false, false);
  return __uint_as_float(t[0]) + __uint_as_float(t[1]);
}
DI float row32_sum(float x) {
  x += dppf<0xB1>(x);
  x += dppf<0x4E>(x);
  x += dppf<0x124>(x);
  x += dppf<0x128>(x);
  const auto s = __builtin_amdgcn_permlane16_swap(__float_as_uint(x), __float_as_uint(x), false, false);
  return __uint_as_float(s[0]) + __uint_as_float(s[1]);
}
DI size_t hm_base(int row) {
  if (row < MP) { const int b = row >> 12, t = row & 4095; return ((size_t)(b * 16) * 4096 + t) * 64; }
  const int rs = row - MP, b = rs >> 4, t = rs & 15; return (size_t)MP * 1024 + ((size_t)(b * 16) * 16 + t) * 64;
}
DI size_t hm_hstride(int row) { return row < MP ? (size_t)4096 * 64 : (size_t)16 * 64; }

DI void p0_rmsnorm_rows(const Params& p, int item) {
  const int lane = TIDX & 63, wid = TIDX >> 6;
  const int row = item * 8 + wid;
  const float* x = row < MP ? p.in[0] + (size_t)row * DM : p.in[1] + (size_t)(row - MP) * DM;
  const float* g = p.in[6];
  float4 v[4]; float ss = 0.f;
#pragma unroll
  for (int i = 0; i < 4; ++i) { v[i] = *(const float4*)(x + i * 256 + lane * 4); ss += v[i].x * v[i].x + v[i].y * v[i].y + v[i].z * v[i].z + v[i].w * v[i].w; }
  ss = wave_sum(ss);
  const float inv = rsqrtf(ss * (1.f / DM) + EPS);
  bf16_t* H = (bf16_t*)(p.ws + WS_H) + (size_t)row * DM;
#pragma unroll
  for (int i = 0; i < 4; ++i) {
    const float4 gg = *(const float4*)(g + i * 256 + lane * 4);
    uint2 o; o.x = cvtpk(v[i].x * inv * gg.x, v[i].y * inv * gg.y); o.y = cvtpk(v[i].z * inv * gg.z, v[i].w * inv * gg.w);
    *(uint2*)(H + i * 256 + lane * 4) = o;
  }
}
DI void p0_transpose_tile(const float* src, bf16_t* dst, int N, int kt, int nt, float* lds) {
  const int tid = TIDX & 255;
  const int k0 = kt * 64, n0 = nt * 64;
#pragma unroll
  for (int i = 0; i < 4; ++i) {
    const int row = (tid >> 4) + 16 * i, c4 = (tid & 15) * 4;
    const float4 v = *(const float4*)(src + (size_t)(k0 + row) * N + n0 + c4);
    lds[row * 65 + c4 + 0] = v.x; lds[row * 65 + c4 + 1] = v.y; lds[row * 65 + c4 + 2] = v.z; lds[row * 65 + c4 + 3] = v.w;
  }
  __syncthreads();
  const int n = tid >> 2, kc = (tid & 3) * 16;
  unsigned w[8];
#pragma unroll
  for (int j = 0; j < 8; ++j) w[j] = cvtpk(lds[(kc + 2 * j) * 65 + n], lds[(kc + 2 * j + 1) * 65 + n]);
  uint4* d = (uint4*)(dst + (size_t)(n0 + n) * 1024 + k0 + kc);
  d[0] = make_uint4(w[0], w[1], w[2], w[3]); d[1] = make_uint4(w[4], w[5], w[6], w[7]);
  __syncthreads();
}
DI void phase0(const Params& p, char* smem) {
  {
    bf16_t* BL = (bf16_t*)(p.ws + WS_BTL);
    for (int i = blockIdx.x * NT + TIDX; i < 2048 * 256; i += gridDim.x * NT) {
      const int n = i >> 8, k = i & 255;
      float v = 0.f;
      if (n < 1024) { if (k < 64) v = p.in[10][(size_t)k * 1024 + n]; }
      else if (k >= 64 && k < 128) v = p.in[12][(size_t)(k - 64) * 1024 + (n - 1024)];
      BL[i] = f2bf(v);
    }
  }
  constexpr int N_ROWS = MT / 8, N_TIN = 16 * 162 / 2, N_TSQ = 256 / 2;
  constexpr int N_ITEMS = N_ROWS + N_TIN + 3 * N_TSQ;
  const int half = TIDX >> 8;
  float* scr = (float*)smem + half * (64 * 65);
  for (int it = blockIdx.x; it < N_ITEMS; it += gridDim.x) {
    if (it < N_ROWS) { p0_rmsnorm_rows(p, it); continue; }
    int j = it - N_ROWS;
    if (j < N_TIN) { const int t = 2 * j + half; p0_transpose_tile(p.in[7], (bf16_t*)(p.ws + WS_WINT), NIN, t / 162, t % 162, scr); continue; }
    j -= N_TIN;
    const int w = j / N_TSQ; const int t = 2 * (j % N_TSQ) + half;
    p0_transpose_tile(p.in[18 + w], (bf16_t*)(p.ws + WS_WT) + (size_t)w * 1024 * 1024, 1024, t >> 4, t & 15, scr);
  }
}

struct EpiP1 {
  static constexpr bool PERM = true, AFTER_DRAIN = false;
  Params p;
  DI void operator()(const pg8::f32x4 (&acc)[2][2][4][2], const pg8::Unit& u, int wr, int wc, int fr, int fq) const {
    const int colt = u.pn * 256;
    const int region = colt >> 10;
#pragma unroll
    for (int ai = 0; ai < 2; ++ai)
#pragma unroll
      for (int m = 0; m < 4; ++m) {
        const int row = u.pm * 256 + ai * 128 + wr * 64 + m * 16 + fr;
        const bool prompt = row < MP;
        const int rs = row - MP;
#pragma unroll
        for (int bj = 0; bj < 2; ++bj) {
          const int col = colt + bj * 128 + wc * 32 + 8 * fq;
          const f32x4 v0 = acc[ai][bj][m][0], v1 = acc[ai][bj][m][1];
          if (region >= 6) {
            const int pc = col - 6144;
            if (pc < CSH) {
              *(uint4*)((bf16_t*)(p.ws + WS_PB) + (size_t)row * CSH + pc) = pack8(v0, v1);
              float* so = nullptr;
              if (prompt) { if ((row & 4095) == 4095) so = p.out + OUT_SHP + (size_t)(row >> 12) * CSH + pc; }
              else if ((rs & 15) == 15) so = p.out + OUT_SHS + (size_t)(rs >> 4) * CSH + pc;
              if (so) { *(f32x4*)so = v0; *(f32x4*)(so + 4) = v1; }
            }
          } else if (region == 0) {
            *(uint4*)((bf16_t*)(p.ws + WS_QB) + (size_t)row * 1024 + col) = pack8(v0 * QSCALE, v1 * QSCALE);
          } else if (region == 1) {
            const int c = col - 1024, hh = c >> 6, d = c & 63;
            float* o = prompt ? p.out + OUT_KP + (((size_t)(row >> 12) * 16 + hh) * 4096 + (row & 4095)) * 64 + d
                              : p.out + OUT_KS + (((size_t)(rs >> 4) * 16 + hh) * 16 + (rs & 15)) * 64 + d;
            __builtin_nontemporal_store(v0, (f32x4*)o); __builtin_nontemporal_store(v1, (f32x4*)(o + 4));
          } else if (region == 2) {
            const int c = col - 2048, hh = c >> 6, d = c & 63;
            float* o = prompt ? p.out + OUT_VP + (((size_t)(row >> 12) * 16 + hh) * 4096 + (row & 4095)) * 64 + d
                              : p.out + OUT_VS + (((size_t)(rs >> 4) * 16 + hh) * 16 + (rs & 15)) * 64 + d;
            __builtin_nontemporal_store(v0, (f32x4*)o); __builtin_nontemporal_store(v1, (f32x4*)(o + 4));
          } else if (region == 3) {
            f32x4 a, b;
#pragma unroll
            for (int j = 0; j < 4; ++j) { a[j] = v0[j] * sigmoidf_(v0[j]); b[j] = v1[j] * sigmoidf_(v1[j]); }
            *(uint4*)((bf16_t*)(p.ws + WS_SZA) + (size_t)row * 1024 + (col - 3072)) = pack8(a, b);
          } else {
            f32x4 a, b;
#pragma unroll
            for (int j = 0; j < 4; ++j) { a[j] = sigmoidf_(v0[j]); b[j] = sigmoidf_(v1[j]); }
            *(uint4*)((bf16_t*)p.out + (size_t)row * 2048 + (col - 4096)) = pack8(a, b);
          }
        }
      }
  }
};
struct EpiGate {
  static constexpr bool PERM = true, AFTER_DRAIN = false;
  Params p; int goff; bool first;
  DI void operator()(const pg8::f32x4 (&acc)[2][2][4][2], const pg8::Unit& u, int wr, int wc, int fr, int fq) const {
    const bf16_t* G = (const bf16_t*)p.out; bf16_t* MG = (bf16_t*)(p.ws + WS_MG);
#pragma unroll
    for (int ai = 0; ai < 2; ++ai)
#pragma unroll
      for (int m = 0; m < 4; ++m) {
        const size_t row = u.pm * 256 + ai * 128 + wr * 64 + m * 16 + fr;
#pragma unroll
        for (int bj = 0; bj < 2; ++bj) {
          const int col = u.pn * 256 + bj * 128 + wc * 32 + 8 * fq;
          const uint4 g = *(const uint4*)(G + row * 2048 + goff + col);
          f32x4 a = acc[ai][bj][m][0], b = acc[ai][bj][m][1];
          a[0] *= bflo(g.x); a[1] *= bfhi(g.x); a[2] *= bflo(g.y); a[3] *= bfhi(g.y);
          b[0] *= bflo(g.z); b[1] *= bfhi(g.z); b[2] *= bflo(g.w); b[3] *= bfhi(g.w);
          if (!first) {
            const uint4 o = *(const uint4*)(MG + row * 1024 + col);
            a[0] += bflo(o.x); a[1] += bfhi(o.x); a[2] += bflo(o.y); a[3] += bfhi(o.y);
            b[0] += bflo(o.z); b[1] += bfhi(o.z); b[2] += bflo(o.w); b[3] += bfhi(o.w);
          }
          *(uint4*)(MG + row * 1024 + col) = pack8(a, b);
        }
      }
  }
};
struct EpiOut {
  static constexpr bool PERM = true, AFTER_DRAIN = false;
  Params p;
  DI void operator()(const pg8::f32x4 (&acc)[2][2][4][2], const pg8::Unit& u, int wr, int wc, int fr, int fq) const {
#pragma unroll
    for (int ai = 0; ai < 2; ++ai)
#pragma unroll
      for (int m = 0; m < 4; ++m) {
        const int row = u.pm * 256 + ai * 128 + wr * 64 + m * 16 + fr;
        const float* xr = row < MP ? p.in[0] + (size_t)row * 1024 : p.in[1] + (size_t)(row - MP) * 1024;
        float* orow = p.out + OUT_YP + (size_t)row * 1024;
#pragma unroll
        for (int bj = 0; bj < 2; ++bj) {
          const int col = u.pn * 256 + bj * 128 + wc * 32 + 8 * fq;
          const f32x4 x0 = *(const f32x4*)(xr + col), x1 = *(const f32x4*)(xr + col + 4);
          *(f32x4*)(orow + col) = x0 + acc[ai][bj][m][0]; *(f32x4*)(orow + col + 4) = x1 + acc[ai][bj][m][1];
        }
      }
  }
};
template <class Epi>
DI void run_gemm(char* smem, const bf16_t* A, const bf16_t* Bt, int M, int N, const Epi& E, int K = 1024) {
  pg8::Gemm g; g.A = A; g.Bt = Bt; g.M = M; g.N = N; g.K = K;
  pg8::StaticOrder S; S.init(M, N, (int)gridDim.x, (int)blockIdx.x);
  pg8::gemm_phase<Epi, pg8::StaticOrder, true, true>((LAS unsigned char*)smem, g, S, E);
  __syncthreads();
}

template <int MODE>
DI void small_gemm(const Params& p, const bf16_t* A, const bf16_t* Bt) {
  int t_ = TIDX; asm volatile("" : "+v"(t_));
  const int lane = t_ & 63, wid = __builtin_amdgcn_readfirstlane(t_ >> 6), fr = lane & 15, fq = lane >> 4;
  for (int tile = wid * gridDim.x + blockIdx.x; tile < 2048; tile += 8 * gridDim.x) {
    const int row0 = MP + (tile >> 6) * 16, col0 = (tile & 63) * 16;
    const bf16_t* pa = A + (size_t)(row0 + fr) * 1024 + 8 * fq;
    const bf16_t* pb = Bt + (size_t)(col0 + fr) * 1024 + 8 * fq;
    f32x4 acc = {0.f, 0.f, 0.f, 0.f};
#pragma unroll 8
    for (int s = 0; s < 32; ++s) acc = __builtin_amdgcn_mfma_f32_16x16x32_bf16(*(const bf16x8*)(pa + 32 * s), *(const bf16x8*)(pb + 32 * s), acc, 0, 0, 0);
    const int col = col0 + fr;
#pragma unroll
    for (int j = 0; j < 4; ++j) {
      const size_t row = row0 + 4 * fq + j;
      if (MODE == 2) p.out[OUT_YP + row * 1024 + col] = p.in[1][(row - MP) * 1024 + col] + acc[j];
      else {
        bf16_t* mg = (bf16_t*)(p.ws + WS_MG) + row * 1024 + col;
        const float g = bf2f(((const bf16_t*)p.out)[row * 2048 + (MODE == 1 ? 1024 : 0) + col]);
        *mg = f2bf((MODE == 1 ? bf2f(*mg) : 0.f) + acc[j] * g);
      }
    }
  }
}

DI float tanh_fast(float x) { return 1.f - 2.f * __builtin_amdgcn_rcpf(1.f + __expf(2.f * x)); }
DI void phase_x(const Params& p) {
  const bf16_t* PB = (const bf16_t*)(p.ws + WS_PB);
  bf16_t* X = (bf16_t*)(p.ws + WS_X);
  const float* mu = p.in[8];
  for (int i = blockIdx.x * NT + TIDX; i < MT * 32; i += gridDim.x * NT) {
    const int row = i >> 5, g = i & 31;
    uint4 o = make_uint4(0u, 0u, 0u, 0u);
    if (g < 16) {
      const int col = 3072 + g * 8;
      const bool prompt = row < MP;
      const int t = prompt ? (row & 4095) : ((row - MP) & 15);
      const uint4 a = *(const uint4*)(PB + (size_t)row * CSH + col);
      float c[8] = {bflo(a.x), bfhi(a.x), bflo(a.y), bfhi(a.y), bflo(a.z), bfhi(a.z), bflo(a.w), bfhi(a.w)}, q[8];
      if (t != 0) { const uint4 b = *(const uint4*)(PB + (size_t)(row - 1) * CSH + col); q[0] = bflo(b.x); q[1] = bfhi(b.x); q[2] = bflo(b.y); q[3] = bfhi(b.y); q[4] = bflo(b.z); q[5] = bfhi(b.z); q[6] = bflo(b.w); q[7] = bfhi(b.w); }
      else if (prompt) {
#pragma unroll
        for (int j = 0; j < 8; ++j) q[j] = 0.f;
      } else { const float* s = p.in[4] + (size_t)((row - MP) >> 4) * CSH + col; const float4 b0 = *(const float4*)s, b1 = *(const float4*)(s + 4); q[0] = b0.x; q[1] = b0.y; q[2] = b0.z; q[3] = b0.w; q[4] = b1.x; q[5] = b1.y; q[6] = b1.z; q[7] = b1.w; }
      const float4 u0 = *(const float4*)(mu + col), u1 = *(const float4*)(mu + col + 4);
      const float u[8] = {u0.x, u0.y, u0.z, u0.w, u1.x, u1.y, u1.z, u1.w};
      float m[8];
#pragma unroll
      for (int j = 0; j < 8; ++j) { m[j] = c[j] + u[j] * (q[j] - c[j]); if (g < 8) m[j] = tanh_fast(m[j]); }
      o = make_uint4(cvtpk(m[0], m[1]), cvtpk(m[2], m[3]), cvtpk(m[4], m[5]), cvtpk(m[6], m[7]));
    }
    *(uint4*)(X + (size_t)row * 256 + g * 8) = o;
  }
}
struct EpiLora {
  static constexpr bool PERM = true, AFTER_DRAIN = false;
  Params p;
  DI void operator()(const pg8::f32x4 (&acc)[2][2][4][2], const pg8::Unit& u, int wr, int wc, int fr, int fq) const {
    const bool isw = u.pn < 4;
#pragma unroll
    for (int ai = 0; ai < 2; ++ai)
#pragma unroll
      for (int m = 0; m < 4; ++m) {
        const int row = u.pm * 256 + ai * 128 + wr * 64 + m * 16 + fr;
        const size_t hb = hm_base(row), hs = hm_hstride(row);
#pragma unroll
        for (int bj = 0; bj < 2; ++bj) {
          const int c = (u.pn & 3) * 256 + bj * 128 + wc * 32 + 8 * fq;
          const size_t idx = hb + (c >> 6) * hs + (c & 63);
          const f32x4 v0 = acc[ai][bj][m][0], v1 = acc[ai][bj][m][1];
          if (isw) {
            const f32x4 b0 = *(const f32x4*)(p.in[9] + c), b1 = *(const f32x4*)(p.in[9] + c + 4);
            f32x4 d0, d1;
#pragma unroll
            for (int j = 0; j < 4; ++j) {
              const float x0 = -(b0[j] + v0[j]), x1 = -(b1[j] + v1[j]);
              const float s0 = fmaxf(x0, 0.f) + __logf(1.f + __expf(-fabsf(x0))), s1 = fmaxf(x1, 0.f) + __logf(1.f + __expf(-fabsf(x1)));
              d0[j] = __expf(-__expf(-s0 - 0.5f)); d1[j] = __expf(-__expf(-s1 - 0.5f));
            }
            float* o = (float*)(p.ws + WS_SW) + idx; *(f32x4*)o = d0; *(f32x4*)(o + 4) = d1;
          } else {
            const f32x4 b0 = *(const f32x4*)(p.in[11] + c), b1 = *(const f32x4*)(p.in[11] + c + 4);
            f32x4 d0, d1;
#pragma unroll
            for (int j = 0; j < 4; ++j) { d0[j] = sigmoidf_(b0[j] + v0[j]); d1[j] = sigmoidf_(b1[j] + v1[j]); }
            *(uint4*)((bf16_t*)(p.ws + WS_SB) + idx) = pack8(d0, d1);
          }
        }
      }
  }
};
DI void small_lora(const Params& p) {
  const int lane = TIDX & 63, wid = TIDX >> 6, r = lane & 31, h = lane >> 5;
  const bf16_t* X = (const bf16_t*)(p.ws + WS_X); const bf16_t* BL = (const bf16_t*)(p.ws + WS_BTL);
  for (int tile = wid * gridDim.x + blockIdx.x; tile < 16 * 64; tile += 8 * gridDim.x) {
    const int row0 = MP + (tile >> 6) * 32, ct = tile & 63, col0 = ct * 32, k0 = ct < 32 ? 0 : 64;
    const bf16_t* pa = X + (size_t)(row0 + r) * 256 + k0 + 8 * h;
    const bf16_t* pb = BL + (size_t)(col0 + r) * 256 + k0 + 8 * h;
    f32x16 acc;
#pragma unroll
    for (int i = 0; i < 16; ++i) acc[i] = 0.f;
#pragma unroll
    for (int s = 0; s < 4; ++s) acc = MFMA32(*(const bf16x8*)(pa + 16 * s), *(const bf16x8*)(pb + 16 * s), acc);
    const int c = (col0 + r) & 1023;
    const float bias = ct < 32 ? p.in[9][c] : p.in[11][c];
#pragma unroll
    for (int i = 0; i < 16; ++i) {
      const int row = row0 + crow(i, h);
      const size_t idx = hm_base(row) + (c >> 6) * hm_hstride(row) + (c & 63);
      const float v = bias + acc[i];
      if (ct < 32) {
        const float x = -v, sp = fmaxf(x, 0.f) + __logf(1.f + __expf(-fabsf(x)));
        ((float*)(p.ws + WS_SW))[idx] = __expf(-__expf(-sp - 0.5f));
      } else ((bf16_t*)(p.ws + WS_SB))[idx] = f2bf(sigmoidf_(v));
    }
  }
}

DI void phase1c(const Params& p) {
  const int tid = TIDX & 255, half = TIDX >> 8, c = tid * 4, hh = c >> 6;
  const bf16_t* PB = (const bf16_t*)(p.ws + WS_PB);
  const float* mu = p.in[8];
  const float4 kkw = *(const float4*)(p.in[13] + c), kaw = *(const float4*)(p.in[14] + c), rkw = *(const float4*)(p.in[15] + c);
  const float4 mur = *(const float4*)(mu + c), muk = *(const float4*)(mu + 1024 + c), muv = *(const float4*)(mu + 2048 + c), muz = *(const float4*)(mu + 3200 + c);
  const float kka[4] = {kkw.x, kkw.y, kkw.z, kkw.w}, kaa[4] = {kaw.x, kaw.y, kaw.z, kaw.w}, rka[4] = {rkw.x, rkw.y, rkw.z, rkw.w};
  const float mura[4] = {mur.x, mur.y, mur.z, mur.w}, muka[4] = {muk.x, muk.y, muk.z, muk.w}, muva[4] = {muv.x, muv.y, muv.z, muv.w}, muza[4] = {muz.x, muz.y, muz.z, muz.w};
  bf16_t* SR = (bf16_t*)(p.ws + WS_SR); bf16_t* SK = (bf16_t*)(p.ws + WS_SK); bf16_t* SV = (bf16_t*)(p.ws + WS_SV);
  bf16_t* SKK = (bf16_t*)(p.ws + WS_SKK); bf16_t* SB = (bf16_t*)(p.ws + WS_SB); bf16_t* SZB = (bf16_t*)(p.ws + WS_SZB);
  float* BONUS = (float*)(p.ws + WS_BONUS);
  for (int r4 = blockIdx.x * 2 + half; r4 < MT / 4; r4 += gridDim.x * 2) {
    const int row0 = r4 * 4;
    const bool prompt = row0 < MP;
    const int t0 = prompt ? (row0 & 4095) : ((row0 - MP) & 15);
    uint2 gr[5], gk[5], gv[5], gz[5], ga[4];
#pragma unroll
    for (int t = 0; t < 5; ++t) {
      const int rr_ = (t == 0 && t0 == 0) ? row0 : row0 + t - 1;
      const bf16_t* pc = PB + (size_t)rr_ * CSH;
      gr[t] = ntload2(pc + c); gk[t] = ntload2(pc + 1024 + c); gv[t] = ntload2(pc + 2048 + c); gz[t] = ntload2(pc + 3200 + c);
    }
    size_t idx[4];
#pragma unroll
    for (int t = 0; t < 4; ++t) { idx[t] = hm_base(row0 + t) + hh * hm_hstride(row0 + t) + (c & 63); ga[t] = *(const uint2*)(SB + idx[t]); }
    float pr[4], pk[4], pv[4], pz[4];
    if (t0 == 0) {
      if (prompt) {
#pragma unroll
        for (int x = 0; x < 4; ++x) { pr[x] = 0.f; pk[x] = 0.f; pv[x] = 0.f; pz[x] = 0.f; }
      } else {
        const float* s = p.in[4] + (size_t)((row0 - MP) >> 4) * CSH;
        const float4 a = *(const float4*)(s + c), b = *(const float4*)(s + 1024 + c), d = *(const float4*)(s + 2048 + c), e = *(const float4*)(s + 3200 + c);
        pr[0] = a.x; pr[1] = a.y; pr[2] = a.z; pr[3] = a.w; pk[0] = b.x; pk[1] = b.y; pk[2] = b.z; pk[3] = b.w;
        pv[0] = d.x; pv[1] = d.y; pv[2] = d.z; pv[3] = d.w; pz[0] = e.x; pz[1] = e.y; pz[2] = e.z; pz[3] = e.w;
      }
    } else {
      pr[0] = bflo(gr[0].x); pr[1] = bfhi(gr[0].x); pr[2] = bflo(gr[0].y); pr[3] = bfhi(gr[0].y);
      pk[0] = bflo(gk[0].x); pk[1] = bfhi(gk[0].x); pk[2] = bflo(gk[0].y); pk[3] = bfhi(gk[0].y);
      pv[0] = bflo(gv[0].x); pv[1] = bfhi(gv[0].x); pv[2] = bflo(gv[0].y); pv[3] = bfhi(gv[0].y);
      pz[0] = bflo(gz[0].x); pz[1] = bfhi(gz[0].x); pz[2] = bflo(gz[0].y); pz[3] = bfhi(gz[0].y);
    }
#pragma unroll
    for (int t = 0; t < 4; ++t) {
      const int row = row0 + t;
      const float curr[4] = {bflo(gr[t + 1].x), bfhi(gr[t + 1].x), bflo(gr[t + 1].y), bfhi(gr[t + 1].y)}, curk[4] = {bflo(gk[t + 1].x), bfhi(gk[t + 1].x), bflo(gk[t + 1].y), bfhi(gk[t + 1].y)};
      const float curv[4] = {bflo(gv[t + 1].x), bfhi(gv[t + 1].x), bflo(gv[t + 1].y), bfhi(gv[t + 1].y)}, curz[4] = {bflo(gz[t + 1].x), bfhi(gz[t + 1].x), bflo(gz[t + 1].y), bfhi(gz[t + 1].y)};
      const float av[4] = {bflo(ga[t].x), bfhi(ga[t].x), bflo(ga[t].y), bfhi(ga[t].y)};
      float rm[4], km[4], vm[4], kkv[4], bb[4], kmod[4], szb[4];
      float ssq = 0.f, bon = 0.f;
#pragma unroll
      for (int x = 0; x < 4; ++x) {
        rm[x] = curr[x] + mura[x] * (pr[x] - curr[x]);
        km[x] = curk[x] + muka[x] * (pk[x] - curk[x]);
        vm[x] = curv[x] + muva[x] * (pv[x] - curv[x]);
        const float zm = curz[x] + muza[x] * (pz[x] - curz[x]);
        szb[x] = zm * sigmoidf_(zm);
        kkv[x] = km[x] * kka[x];
        ssq += kkv[x] * kkv[x];
        kmod[x] = km[x] * (1.f + (av[x] - 1.f) * kaa[x]);
        bon += rm[x] * kmod[x] * rka[x];
        pr[x] = curr[x]; pk[x] = curk[x]; pv[x] = curv[x]; pz[x] = curz[x];
      }
      ssq = sum16(ssq); bon = sum16(bon);
      const float inv = 1.f / fmaxf(sqrtf(ssq), 1e-12f);
#pragma unroll
      for (int x = 0; x < 4; ++x) { kkv[x] *= inv; bb[x] = kkv[x] * av[x]; }
      ntstore2(SR + idx[t], make_uint2(cvtpk(rm[0], rm[1]), cvtpk(rm[2], rm[3])));
      ntstore2(SK + idx[t], make_uint2(cvtpk(kmod[0], kmod[1]), cvtpk(kmod[2], kmod[3])));
      ntstore2(SV + idx[t], make_uint2(cvtpk(vm[0], vm[1]), cvtpk(vm[2], vm[3])));
      ntstore2(SKK + idx[t], make_uint2(cvtpk(-kkv[0], -kkv[1]), cvtpk(-kkv[2], -kkv[3])));
      ntstore2(SB + idx[t], make_uint2(cvtpk(bb[0], bb[1]), cvtpk(bb[2], bb[3])));
      ntstore2(SZB + (size_t)row * 1024 + c, make_uint2(cvtpk(szb[0], szb[1]), cvtpk(szb[2], szb[3])));
      if ((tid & 15) == 0) BONUS[(size_t)row * 16 + hh] = bon;
    }
  }
}

template <bool SAMPLE>
DI void attn_wave(const Params& p, int sh, int qt) {
  const int lane = TIDX & 63, r = lane & 31, h = lane >> 5;
  const int hh = sh & 15, b = sh >> 4;
  bf16_t* QB = (bf16_t*)(p.ws + WS_QB);
  const int row0 = SAMPLE ? MP + b * 16 : b * 4096 + qt * 32;
  bf16_t* Qp = QB + (size_t)row0 * 1024 + hh * 64;
  const int qrow = SAMPLE ? (r < 15 ? r : 15) : r;
  bf16x8 qf[4];
#pragma unroll
  for (int s = 0; s < 4; ++s) qf[s] = *(const bf16x8*)(Qp + (size_t)qrow * 1024 + 16 * s + 8 * h);
  f32x16 z0, z1;
#pragma unroll
  for (int i = 0; i < 16; ++i) { z0[i] = 0.f; z1[i] = 0.f; }
  float carry = 1.f;
  const int ntiles = SAMPLE ? 33 : qt + 1;
  for (int it = 0; it < ntiles; ++it) {
    const bool diag = (it == 0);
    const int kt = SAMPLE ? 32 - it : qt - it;
    bf16x8 kf[4];
    {
      const float* Kp;
      if (!SAMPLE) Kp = p.out + OUT_KP + ((size_t)sh * 4096 + kt * 32 + r) * 64;
      else Kp = diag ? p.out + OUT_KS + ((size_t)sh * 16 + (r < 15 ? r : 15)) * 64 : p.in[2] + ((size_t)sh * 1024 + kt * 32 + r) * 64;
#pragma unroll
      for (int s = 0; s < 4; ++s) {
        const float4 a = *(const float4*)(Kp + 16 * s + 8 * h), bq = *(const float4*)(Kp + 16 * s + 8 * h + 4);
        u32x4 w; w[0] = cvtpk(a.x, a.y); w[1] = cvtpk(a.z, a.w); w[2] = cvtpk(bq.x, bq.y); w[3] = cvtpk(bq.z, bq.w);
        kf[s] = __builtin_bit_cast(bf16x8, w);
      }
    }
    f32x16 st;
#pragma unroll
    for (int i = 0; i < 16; ++i) st[i] = 0.f;
#pragma unroll
    for (int s = 0; s < 4; ++s) st = MFMA32(kf[s], qf[s], st);
    float keep[16], wgt[16];
#pragma unroll
    for (int i = 0; i < 16; ++i) {
      const float e = __builtin_amdgcn_exp2f(st[i]);
      const float kp = __builtin_amdgcn_rcpf(1.f + e);
      bool valid = true;
      if (diag) { const int kr = crow(i, h); valid = SAMPLE ? (kr < r && kr < 16) : (kr < r); }
      keep[i] = valid ? kp : 1.f;
      wgt[i] = valid ? 1.f - kp : 0.f;
    }
    float pp[4], hif[4];
#pragma unroll
    for (int g = 0; g < 4; ++g) {
      const float p4 = (keep[4 * g] * keep[4 * g + 1]) * (keep[4 * g + 2] * keep[4 * g + 3]);
      const auto sw = __builtin_amdgcn_permlane32_swap(__float_as_uint(p4), __float_as_uint(p4), false, false);
      const float lo = __uint_as_float(sw[0]), hi = __uint_as_float(sw[1]);
      pp[g] = lo * hi;
      hif[g] = h ? 1.f : hi;
    }
    float T[4];
    T[3] = carry; T[2] = T[3] * pp[3]; T[1] = T[2] * pp[2]; T[0] = T[1] * pp[1];
    carry = T[0] * pp[0];
#pragma unroll
    for (int g = 0; g < 4; ++g) {
      const float w3 = T[g] * hif[g], w2 = w3 * keep[4 * g + 3], w1 = w2 * keep[4 * g + 2], w0 = w1 * keep[4 * g + 1];
      wgt[4 * g + 3] *= w3; wgt[4 * g + 2] *= w2; wgt[4 * g + 1] *= w1; wgt[4 * g] *= w0;
    }
#pragma unroll
    for (int s = 0; s < 2; ++s) {
      u32x4 pw;
#pragma unroll
      for (int j = 0; j < 4; ++j) pw[j] = cvtpk(wgt[8 * s + 2 * j], wgt[8 * s + 2 * j + 1]);
      const bf16x8 pf = __builtin_bit_cast(bf16x8, pw);
#pragma unroll
      for (int db = 0; db < 2; ++db) {
        bf16x8 vf;
        {
          float vv[8];
#pragma unroll
          for (int j = 0; j < 8; ++j) {
            const int kr = 16 * s + 8 * (j >> 2) + 4 * h + (j & 3);
            const float* vp;
            if (!SAMPLE) vp = p.out + OUT_VP + ((size_t)sh * 4096 + kt * 32 + kr) * 64;
            else vp = diag ? p.out + OUT_VS + ((size_t)sh * 16 + (kr < 15 ? kr : 15)) * 64 : p.in[3] + ((size_t)sh * 1024 + kt * 32 + kr) * 64;
            vv[j] = vp[db * 32 + r];
          }
          u32x4 w; w[0] = cvtpk(vv[0], vv[1]); w[1] = cvtpk(vv[2], vv[3]); w[2] = cvtpk(vv[4], vv[5]); w[3] = cvtpk(vv[6], vv[7]);
          vf = __builtin_bit_cast(bf16x8, w);
        }
        if (db == 0) z0 = MFMA32(pf, vf, z0); else z1 = MFMA32(pf, vf, z1);
      }
    }
    if (__ballot(carry != 0.f) == 0ull) break;
  }
  const bf16_t* SZA = (const bf16_t*)(p.ws + WS_SZA);
#pragma unroll
  for (int i = 0; i < 16; ++i) {
    const int q = crow(i, h);
    if (SAMPLE && q >= 16) continue;
    const size_t o = (size_t)(row0 + q) * 1024 + hh * 64 + r;
    QB[o] = f2bf(z0[i] * bf2f(SZA[o]));
    QB[o + 32] = f2bf(z1[i] * bf2f(SZA[o + 32]));
  }
}

DI float row16_sum(float x) {
  x += dppf<0xB1>(x); x += dppf<0x4E>(x); x += dppf<0x124>(x); x += dppf<0x128>(x);
  return x;
}
DI void scan_wave(const Params& p, int shg, int slice, float* L) {
  const int lane = TIDX & 63, cc = lane & 15;
  const bool prompt = shg < 64;
  const int T = prompt ? 4096 : 16;
  const size_t base = prompt ? (size_t)shg * 4096 * 64 : (size_t)MP * 1024 + (size_t)(shg - 64) * 16 * 64;
  const int v = slice * 4 + (lane >> 4);
  const float* SW = (const float*)(p.ws + WS_SW) + base;
  const bf16_t* SARR = (const bf16_t*)(p.ws + WS_SR) + base;
  float* ORAW = (float*)(p.ws + WS_ORAW) + base;
  float4 S;
  float* wout;
  if (prompt) { S = make_float4(0.f, 0.f, 0.f, 0.f); wout = p.out + OUT_WP + ((size_t)shg * 64 + v) * 64 + 4 * cc; }
  else { S = *(const float4*)(p.in[5] + ((size_t)(shg - 64) * 64 + v) * 64 + 4 * cc); wout = p.out + OUT_WS + ((size_t)(shg - 64) * 64 + v) * 64 + 4 * cc; }
  const int nch = T / 8;
  const int dw0 = ((lane >> 4) * 6 + 2) * 64 + (lane & 15) * 4, dw1 = dw0 + 4 * 384;
  const int db = (lane >> 3) * 384 + (lane & 7) * 8;
  uint4 gw0, gw1, gr, gk, gv, gn, gb;
#define SCAN_GLOAD(ch) do { const float* w_ = SW + (size_t)(ch) * 512; gw0 = *(const uint4*)(w_ + lane * 4); gw1 = *(const uint4*)(w_ + 256 + lane * 4); \
    const bf16_t* a_ = SARR + (size_t)(ch) * 512 + lane * 8; gr = *(const uint4*)a_; gk = *(const uint4*)(a_ + SZ_ACT / 2); gv = *(const uint4*)(a_ + 2 * (SZ_ACT / 2)); \
    gn = *(const uint4*)(a_ + 3 * (SZ_ACT / 2)); gb = *(const uint4*)(a_ + 4 * (SZ_ACT / 2)); } while (0)
#define SCAN_PUT(slot, g) do { float* d_ = L + db + (slot) * 64; *(float4*)d_ = make_float4(bflo(g.x), bfhi(g.x), bflo(g.y), bfhi(g.y)); *(float4*)(d_ + 4) = make_float4(bflo(g.z), bfhi(g.z), bflo(g.w), bfhi(g.w)); } while (0)
#define SCAN_LSTORE() do { *(uint4*)(L + dw0) = gw0; *(uint4*)(L + dw1) = gw1; SCAN_PUT(4, gr); SCAN_PUT(3, gk); SCAN_PUT(5, gv); SCAN_PUT(0, gn); SCAN_PUT(1, gb); \
    asm volatile("s_waitcnt lgkmcnt(0)" ::: "memory"); } while (0)
  SCAN_GLOAD(0);
  asm volatile("s_waitcnt lgkmcnt(0)" ::: "memory");
  SCAN_LSTORE();
  for (int ch = 0; ch < nch; ++ch) {
    if (ch + 1 < nch) SCAN_GLOAD(ch + 1);
    float okeep = 0.f;
    const float* Lc = L + 4 * cc;
    float4 nk = *(const float4*)(Lc), bb = *(const float4*)(Lc + 64), ww = *(const float4*)(Lc + 128), kv = *(const float4*)(Lc + 192), rr = *(const float4*)(Lc + 256);
    float vt = L[320 + v];
#pragma unroll 4
    for (int st = 0; st < 8; ++st) {
      const int sn = ((st + 1) & 7) * 384;
      const float4 nk2 = *(const float4*)(Lc + sn), bb2 = *(const float4*)(Lc + sn + 64), ww2 = *(const float4*)(Lc + sn + 128);
      const float4 kv2 = *(const float4*)(Lc + sn + 192), rr2 = *(const float4*)(Lc + sn + 256);
      const float vt2 = L[sn + 320 + v];
      float d = (S.x * nk.x + S.y * nk.y) + (S.z * nk.z + S.w * nk.w);
      const float sa = row16_sum(d);
      S.x = S.x * ww.x + (sa * bb.x + vt * kv.x);
      S.y = S.y * ww.y + (sa * bb.y + vt * kv.y);
      S.z = S.z * ww.z + (sa * bb.z + vt * kv.z);
      S.w = S.w * ww.w + (sa * bb.w + vt * kv.w);
      float o = (S.x * rr.x + S.y * rr.y) + (S.z * rr.z + S.w * rr.w);
      o = row16_sum(o);
      okeep = (cc == st) ? o : okeep;
      nk = nk2; bb = bb2; ww = ww2; kv = kv2; rr = rr2; vt = vt2;
    }
    if (cc < 8) ORAW[(size_t)(ch * 8 + cc) * 64 + v] = okeep;
    asm volatile("s_waitcnt lgkmcnt(0)" ::: "memory");
    if (ch + 1 < nch) SCAN_LSTORE();
  }
  *(float4*)wout = S;
#undef SCAN_GLOAD
#undef SCAN_PUT
#undef SCAN_LSTORE
}

DI void sgroup_barrier(volatile LAS unsigned* cnt, unsigned target) {
  asm volatile("s_waitcnt lgkmcnt(0)" ::: "memory");
  if ((TIDX & 63) == 0) __hip_atomic_fetch_add((LAS unsigned*)cnt, 1u, __ATOMIC_RELAXED, __HIP_MEMORY_SCOPE_WORKGROUP);
  while (*cnt < target) { }
  asm volatile("" ::: "memory");
}
DI void scan_group(const Params& p, int sh, int quarter, float* lds, volatile LAS unsigned* cnt, unsigned& nbar) {
  const int tid = TIDX & 255, lane = tid & 63, wid = tid >> 6, cc = lane & 15;
  const size_t base = (size_t)sh * 4096 * 64;
  const int v = quarter * 16 + wid * 4 + (lane >> 4);
  const float* SW = (const float*)(p.ws + WS_SW) + base;
  const bf16_t* SARR = (const bf16_t*)(p.ws + WS_SR) + base;
  float* ORAW = (float*)(p.ws + WS_ORAW) + base;
  f32x2 S01 = {0.f, 0.f}, S23 = {0.f, 0.f};
  const bool b0 = (lane & 1) != 0, b1 = (lane & 2) != 0;
  float4 gw0, gw1; uint4 gb0, gb1, gb2, gb3, gb4;
  const int dstw0 = ((tid >> 4) * 6 + 2) * 64 + (tid & 15) * 4, dstw1 = dstw0 + 16 * 384;
  const int dstb = (tid >> 3) * 384 + (tid & 7) * 8;
  const bf16_t* sbp = SARR + tid * 8;
#define SG_GLOAD(ch) do { const size_t o_ = (size_t)(ch) * 2048; gw0 = *(const float4*)(SW + o_ + tid * 4); gw1 = *(const float4*)(SW + o_ + 1024 + tid * 4); \
    gb0 = *(const uint4*)(sbp + o_); gb1 = *(const uint4*)(sbp + (SZ_ACT / 2) + o_); gb2 = *(const uint4*)(sbp + 2 * (SZ_ACT / 2) + o_); \
    gb3 = *(const uint4*)(sbp + 3 * (SZ_ACT / 2) + o_); gb4 = *(const uint4*)(sbp + 4 * (SZ_ACT / 2) + o_); } while (0)
#define SG_PUT(d_, g) do { *(float4*)(d_) = make_float4(bflo(g.x), bfhi(g.x), bflo(g.y), bfhi(g.y)); *(float4*)((d_) + 4) = make_float4(bflo(g.z), bfhi(g.z), bflo(g.w), bfhi(g.w)); } while (0)
#define SG_LSTORE(buf) do { float* L_ = lds + (buf) * (32 * 384); *(float4*)(L_ + dstw0) = gw0; *(float4*)(L_ + dstw1) = gw1; \
    SG_PUT(L_ + dstb + 4 * 64, gb0); SG_PUT(L_ + dstb + 3 * 64, gb1); SG_PUT(L_ + dstb + 5 * 64, gb2); SG_PUT(L_ + dstb + 0 * 64, gb3); SG_PUT(L_ + dstb + 1 * 64, gb4); } while (0)
  SG_GLOAD(0); SG_LSTORE(0); sgroup_barrier(cnt, 4u * (++nbar));
  for (int ch = 0; ch < 128; ++ch) {
    {
    const float* L = lds + (ch & 1) * (32 * 384);
    float okeep = 0.f;
    const float* Lc = L + 4 * cc;
    f32x4 nk = *(const f32x4*)(Lc), bb = *(const f32x4*)(Lc + 64), ww = *(const f32x4*)(Lc + 128), kv = *(const f32x4*)(Lc + 192), rr = *(const f32x4*)(Lc + 256);
    float vt = L[320 + v];
    if (ch + 1 < 128) SG_GLOAD(ch + 1);
    f32x4 rrp = rr;
    float po[4];
#pragma unroll
    for (int st = 0; st <= 32; ++st) {
      if (st > 0) { const f32x2 o2 = S01 * rrp.xy + S23 * rrp.zw; po[(st - 1) & 3] = o2.x + o2.y; }
      if (st > 0 && (st & 3) == 0) {
        const float u0 = (b0 ? po[1] : po[0]) + dppf<0xB1>(b0 ? po[0] : po[1]);
        const float u1 = (b0 ? po[3] : po[2]) + dppf<0xB1>(b0 ? po[2] : po[3]);
        float w = (b1 ? u1 : u0) + dppf<0x4E>(b1 ? u0 : u1);
        w += dppf<0x124>(w); w += dppf<0x128>(w);
        okeep = ((cc >> 2) == (((st >> 2) - 1) & 3)) ? w : okeep;
      }
      if (st == 16 || st == 32) ORAW[(size_t)(ch * 32 + (st - 16) + cc) * 64 + v] = okeep;
      if (st < 32) {
        const int sn = ((st + 1) & 31) * 384;
        const f32x2 d2 = S01 * nk.xy + S23 * nk.zw;
        float x = d2.x + d2.y;
        const f32x2 vt_2 = {vt, vt};
        const f32x2 t01 = vt_2 * kv.xy, t23 = vt_2 * kv.zw;
        __builtin_amdgcn_sched_barrier(0);
        x += dppf<0xB1>(x);
        const f32x4 nk2 = *(const f32x4*)(Lc + sn), bb2 = *(const f32x4*)(Lc + sn + 64);
        __builtin_amdgcn_sched_barrier(0);
        x += dppf<0x4E>(x);
        const f32x4 ww2 = *(const f32x4*)(Lc + sn + 128), kv2 = *(const f32x4*)(Lc + sn + 192);
        __builtin_amdgcn_sched_barrier(0);
        x += dppf<0x124>(x);
        const f32x4 rr2 = *(const f32x4*)(Lc + sn + 256);
        const float vt2 = L[sn + 320 + v];
        __builtin_amdgcn_sched_barrier(0);
        x += dppf<0x128>(x);
        __builtin_amdgcn_sched_barrier(0);
        const f32x2 sa2 = {x, x};
        S01 = S01 * ww.xy + (sa2 * bb.xy + t01);
        S23 = S23 * ww.zw + (sa2 * bb.zw + t23);
        rrp = rr;
        nk = nk2; bb = bb2; ww = ww2; kv = kv2; rr = rr2; vt = vt2;
      }
    }
    }
    if (ch + 1 < 128) SG_LSTORE((ch + 1) & 1);
    sgroup_barrier(cnt, 4u * (++nbar));
  }
  *(float4*)(p.out + OUT_WP + ((size_t)sh * 64 + v) * 64 + 4 * cc) = make_float4(S01.x, S01.y, S23.x, S23.y);
#undef SG_GLOAD
#undef SG_PUT
#undef SG_LSTORE
}

constexpr int NQ_ATT_P = 8192, NQ_ATT_S = 512, NQ_SCAN_S = 8192, NQ_DYN = NQ_ATT_P + NQ_ATT_S + NQ_SCAN_S;
DI int wave_grab(unsigned* ctr) { int v = 0; if ((TIDX & 63) == 0) v = (int)atomicAdd(ctr, 1u); return __builtin_amdgcn_readfirstlane(v); }
DI void phase2(const Params& p, char* smem) {
  __shared__ unsigned s_cnt;
  unsigned* ctl = (unsigned*)(p.ws + WS_CTL);
  const int wid = TIDX >> 6;
  if (TIDX == 0) s_cnt = 0u;
  __syncthreads();
  float* Lsh = (float*)smem + 4 * (8 * 384);
  float* L = wid >= 4 ? (float*)smem + (wid - 4) * (8 * 384) : Lsh + wid * (8 * 384);
  if (wid < 4) {
    unsigned nbar = 0;
    __builtin_amdgcn_s_setprio(3);
    for (int bu = blockIdx.x; bu < 256; bu += gridDim.x) {
      const int xs = bu & 7, slot = bu >> 3, head = xs * 8 + (slot >> 2), quarter = slot & 3;
      scan_group(p, head, quarter, Lsh, (volatile LAS unsigned*)&s_cnt, nbar);
    }
    __builtin_amdgcn_s_setprio(0);
  }
  for (;;) {
    int u = wave_grab(&ctl[0]);
    if (u >= NQ_DYN) break;
    if (u < NQ_ATT_P) { attn_wave<false>(p, u >> 7, u & 127); continue; }
    u -= NQ_ATT_P;
    if (u < NQ_ATT_S) { attn_wave<true>(p, u, 0); continue; }
    u -= NQ_ATT_S;
    scan_wave(p, 64 + (u >> 4), u & 15, L);
  }
}

DI void p2c_row(const Params& p, int row, int c, int hh, const float4& lg, const float4& lb, const float4& o, const uint2& vv, const uint2& zz, float bon) {
  const float mean = sum16((o.x + o.y) + (o.z + o.w)) * (1.f / 64.f);
  const float dx = o.x - mean, dy = o.y - mean, dz = o.z - mean, dw = o.w - mean;
  const float var = sum16((dx * dx + dy * dy) + (dz * dz + dw * dw)) * (1.f / 64.f);
  const float inv = rsqrtf(var + LNX_EPS);
  const float r0 = (dx * inv * lg.x + lb.x + bon * bflo(vv.x)) * bflo(zz.x);
  const float r1 = (dy * inv * lg.y + lb.y + bon * bfhi(vv.x)) * bfhi(zz.x);
  const float r2 = (dz * inv * lg.z + lb.z + bon * bflo(vv.y)) * bflo(zz.y);
  const float r3 = (dw * inv * lg.w + lb.w + bon * bfhi(vv.y)) * bfhi(zz.y);
  *(uint2*)((bf16_t*)(p.ws + WS_OB) + (size_t)row * 1024 + c) = make_uint2(cvtpk(r0, r1), cvtpk(r2, r3));
}
DI void phase2c(const Params& p) {
  const int tid = TIDX & 255, half = TIDX >> 8, c = tid * 4, hh = c >> 6;
  const float4 lg = *(const float4*)(p.in[16] + c), lb = *(const float4*)(p.in[17] + c);
  const float* ORAW = (const float*)(p.ws + WS_ORAW); const bf16_t* SV = (const bf16_t*)(p.ws + WS_SV);
  const bf16_t* SZB = (const bf16_t*)(p.ws + WS_SZB); const float* BONUS = (const float*)(p.ws + WS_BONUS);
  const int stride = gridDim.x * 2;
  for (int row = blockIdx.x * 2 + half; row < MT; row += 2 * stride) {
    const bool two = row + stride < MT;
    const int rowb = two ? row + stride : row;
    const size_t ia = hm_base(row) + hh * hm_hstride(row) + (c & 63), ib = hm_base(rowb) + hh * hm_hstride(rowb) + (c & 63);
    const float4 oa = *(const float4*)(ORAW + ia), ob = *(const float4*)(ORAW + ib);
    const uint2 va = *(const uint2*)(SV + ia), vb = *(const uint2*)(SV + ib);
    const uint2 za = *(const uint2*)(SZB + (size_t)row * 1024 + c), zb = *(const uint2*)(SZB + (size_t)rowb * 1024 + c);
    const float ba = BONUS[(size_t)row * 16 + hh], bb = BONUS[(size_t)rowb * 16 + hh];
    p2c_row(p, row, c, hh, lg, lb, oa, va, za, ba);
    if (two) p2c_row(p, rowb, c, hh, lg, lb, ob, vb, zb, bb);
  }
}

DI void phase4(const Params& p) {
  const int lane = TIDX & 63, wid = TIDX >> 6;
  const float* g = p.in[21];
  float4 gg[4];
#pragma unroll
  for (int i = 0; i < 4; ++i) gg[i] = *(const float4*)(g + i * 256 + lane * 4);
  const int stride = gridDim.x * 8;
  for (int row = blockIdx.x * 8 + wid; row < MT; row += 2 * stride) {
    const bool two = row + stride < MT;
    float* x0 = p.out + OUT_YP + (size_t)row * 1024;
    float* x1 = p.out + OUT_YP + (size_t)(two ? row + stride : row) * 1024;
    float4 v0[4], v1[4]; float s0 = 0.f, s1 = 0.f;
#pragma unroll
    for (int i = 0; i < 4; ++i) { v0[i] = *(const float4*)(x0 + i * 256 + lane * 4); v1[i] = *(const float4*)(x1 + i * 256 + lane * 4); }
#pragma unroll
    for (int i = 0; i < 4; ++i) {
      s0 += v0[i].x * v0[i].x + v0[i].y * v0[i].y + v0[i].z * v0[i].z + v0[i].w * v0[i].w;
      s1 += v1[i].x * v1[i].x + v1[i].y * v1[i].y + v1[i].z * v1[i].z + v1[i].w * v1[i].w;
    }
    s0 = wave_sum(s0); s1 = wave_sum(s1);
    const float i0 = rsqrtf(s0 * (1.f / DM) + EPS), i1 = rsqrtf(s1 * (1.f / DM) + EPS);
#pragma unroll
    for (int i = 0; i < 4; ++i) *(float4*)(x0 + i * 256 + lane * 4) = make_float4(v0[i].x * i0 * gg[i].x, v0[i].y * i0 * gg[i].y, v0[i].z * i0 * gg[i].z, v0[i].w * i0 * gg[i].w);
    if (two) {
#pragma unroll
      for (int i = 0; i < 4; ++i) *(float4*)(x1 + i * 256 + lane * 4) = make_float4(v1[i].x * i1 * gg[i].x, v1[i].y * i1 * gg[i].y, v1[i].z * i1 * gg[i].z, v1[i].w * i1 * gg[i].w);
    }
  }
}

#define XB_TMO      128
#define XB_XCNT(j)  (256  + 64 * (j))
#define XB_XSUB(j)  (1280 + 64 * (j))
#define XB_XGEN(j)  (2304 + 64 * (j))
#define XB_TOP      3328
#define XB_TOPGEN   3392
#define XCD_BAR_WORDS 3456
#define XB_SPIN_CAP (1u << 18)

__device__ __forceinline__ unsigned xb_ld(unsigned* p)              { return __hip_atomic_load(p, __ATOMIC_RELAXED, __HIP_MEMORY_SCOPE_AGENT); }
__device__ __forceinline__ unsigned xb_add(unsigned* p, unsigned v) { return __hip_atomic_fetch_add(p, v, __ATOMIC_RELAXED, __HIP_MEMORY_SCOPE_AGENT); }
__device__ __forceinline__ unsigned xb_xcc_id() { return (unsigned)__builtin_amdgcn_s_getreg((3 << 11) | 20) & 0xFu; }
#define XB_SPIN(cond, bar) do { unsigned _sp = 0; while (cond) { __builtin_amdgcn_s_sleep(1); \
    if ((++_sp & 255u) == 0u) { if (xb_ld(&(bar)[XB_TMO])) break; if (_sp > XB_SPIN_CAP) { atomicAdd(&(bar)[XB_TMO], 1u); break; } } } } while (0)

struct XcdBarrier {
    unsigned* bar; unsigned x;
    volatile LAS unsigned* st;
};

__device__ __forceinline__ XcdBarrier xcd_barrier_post(unsigned* bar, volatile LAS unsigned* st) {
    XcdBarrier b; b.bar = bar; b.x = xb_xcc_id(); b.st = st;
    if (TIDX == 0) (void)xb_add(&bar[XB_XCNT(b.x)], 1u);
    return b;
}
__device__ __forceinline__ void xcd_barrier_complete(unsigned* bar, unsigned x, unsigned& nloc, unsigned& nx) {
    const unsigned G = gridDim.x * gridDim.y * gridDim.z;
    unsigned sum, cnt, mine, sp = 0u;
    for (;;) {
        sum = 0u; cnt = 0u; mine = 0u;
#pragma unroll
        for (unsigned j = 0; j < 16; ++j) { const unsigned c = xb_ld(&bar[XB_XCNT(j)]); sum += c; cnt += (c > 0u) ? 1u : 0u; mine = (j == x) ? c : mine; }
        if (sum == G) break;
        __builtin_amdgcn_s_sleep(1);
        if ((++sp & 255u) == 0u) { if (xb_ld(&bar[XB_TMO])) break; if (sp > XB_SPIN_CAP) { atomicAdd(&bar[XB_TMO], 1u); break; } }
    }
    nloc = mine > 0u ? mine : 1u; nx = cnt > 0u ? cnt : 1u;
}

__device__ __forceinline__ void xcd_barrier(const XcdBarrier& b) {
    asm volatile("s_waitcnt vmcnt(0)" ::: "memory");
    __syncthreads();
    if (TIDX == 0) {
        unsigned* bar = b.bar;
        __builtin_amdgcn_s_waitcnt(0);
        unsigned nloc = b.st[0], nx = b.st[1];
        if (nloc == 0u) { xcd_barrier_complete(bar, b.x, nloc, nx); b.st[0] = nloc; b.st[1] = nx; }
        const unsigned old = xb_add(&bar[XB_XSUB(b.x)], 1u);
        const unsigned gen = old / nloc;
        if (old + 1u == (gen + 1u) * nloc) {
            __builtin_amdgcn_fence(__ATOMIC_RELEASE, "agent");
            asm volatile("s_waitcnt vmcnt(0)" ::: "memory");
            const unsigned og = xb_add(&bar[XB_TOP], 1u);
            const unsigned tg = og / nx;
            if (og + 1u == (tg + 1u) * nx) xb_add(&bar[XB_TOPGEN], 1u);
            else XB_SPIN(xb_ld(&bar[XB_TOPGEN]) == tg, bar);
            __builtin_amdgcn_fence(__ATOMIC_ACQUIRE, "agent");
            xb_add(&bar[XB_XGEN(b.x)], 1u);
            asm volatile("s_waitcnt vmcnt(0)" ::: "memory");
        } else {
            XB_SPIN(xb_ld(&bar[XB_XGEN(b.x)]) == gen, bar);
            __builtin_amdgcn_fence(__ATOMIC_ACQUIRE, "agent");
            asm volatile("s_waitcnt vmcnt(0)" ::: "memory");
        }
    }
    __syncthreads();
}

__global__ void __launch_bounds__(NT, 2) mega(Params p) {
  extern __shared__ __attribute__((aligned(16))) char smem[];
  cg::grid_group grid = cg::this_grid();
  if (blockIdx.x == 0) { unsigned* ctl = (unsigned*)(p.ws + WS_CTL); for (int i = TIDX; i < 16384; i += NT) ctl[i] = 0u; }
  grid.sync();
  __shared__ unsigned xb_st[2];
  if (TIDX == 0) { xb_st[0] = 0u; xb_st[1] = 0u; }
  __syncthreads();
  (void)xcd_barrier_post((unsigned*)(p.ws + WS_CTL) + 8192, (volatile LAS unsigned*)xb_st);
#define XBAR() do { XcdBarrier xb_; xb_.bar = (unsigned*)(p.ws + WS_CTL) + 8192; xb_.x = xb_xcc_id(); xb_.st = (volatile LAS unsigned*)xb_st; xcd_barrier(xb_); } while (0)
  phase0(p, smem);
  XBAR();
  { EpiP1 E; E.p = p; run_gemm(smem, (const bf16_t*)(p.ws + WS_H), (const bf16_t*)(p.ws + WS_WINT), MT, NINP, E); }
  XBAR();
  phase_x(p);
  XBAR();
  { EpiLora E; E.p = p; run_gemm(smem, (const bf16_t*)(p.ws + WS_X), (const bf16_t*)(p.ws + WS_BTL), MP, 2048, E, 256); }
  small_lora(p);
  XBAR();
  phase1c(p);
  XBAR();
  phase2(p, smem);
  XBAR();
  phase2c(p);
  XBAR();
  { EpiGate E; E.p = p; E.goff = 0; E.first = true; run_gemm(smem, (const bf16_t*)(p.ws + WS_QB), (const bf16_t*)(p.ws + WS_WT), MP, 1024, E); }
  small_gemm<0>(p, (const bf16_t*)(p.ws + WS_QB), (const bf16_t*)(p.ws + WS_WT));
  { EpiGate E; E.p = p; E.goff = 1024; E.first = false; run_gemm(smem, (const bf16_t*)(p.ws + WS_OB), (const bf16_t*)(p.ws + WS_WT) + (size_t)1024 * 1024, MP, 1024, E); }
  small_gemm<1>(p, (const bf16_t*)(p.ws + WS_OB), (const bf16_t*)(p.ws + WS_WT) + (size_t)1024 * 1024);
  XBAR();
  { EpiOut E; E.p = p; run_gemm(smem, (const bf16_t*)(p.ws + WS_MG), (const bf16_t*)(p.ws + WS_WT) + (size_t)2 * 1024 * 1024, MP, 1024, E); }
  small_gemm<2>(p, (const bf16_t*)(p.ws + WS_MG), (const bf16_t*)(p.ws + WS_WT) + (size_t)2 * 1024 * 1024);
  XBAR();
  phase4(p);
}

extern "C" void kernel_launch(void* const* d_in, const int* in_sizes, int n_in, void* d_out, int out_size, void* d_ws, size_t ws_size, hipStream_t stream) {
  static int grid_blocks = 0;
  if (grid_blocks == 0) {
    if (n_in != 22 || ws_size < WS_END) { fprintf(stderr, "kernel_launch: unexpected n_in %d / ws_size %zu (need %zu)\n", n_in, ws_size, (size_t)WS_END); grid_blocks = -1; return; }
    int dev = 0, cus = 0, per_cu = 0;
    (void)hipGetDevice(&dev);
    (void)hipDeviceGetAttribute(&cus, hipDeviceAttributeMultiprocessorCount, dev);
    (void)hipFuncSetAttribute((const void*)mega, hipFuncAttributeMaxDynamicSharedMemorySize, SMEM_BYTES);
    (void)hipOccupancyMaxActiveBlocksPerMultiprocessor(&per_cu, (const void*)mega, NT, SMEM_BYTES);
    (void)hipGetLastError();
    grid_blocks = cus;
  }
  if (grid_blocks < 0) return;
  Params p{};
  for (int i = 0; i < 22; ++i) p.in[i] = (const float*)d_in[i];
  p.out = (float*)d_out; p.ws = (unsigned char*)d_ws;
  void* args[] = {&p};
  hipError_t e = hipLaunchCooperativeKernel((const void*)mega, dim3(grid_blocks), dim3(NT), args, SMEM_BYTES, stream);
  if (e != hipSuccess) fprintf(stderr, "cooperative launch failed: %s (grid %d)\n", hipGetErrorString(e), grid_blocks);
}
```

```cpp
#include <hip/hip_runtime.h>
#include <hip/hip_cooperative_groups.h>
#include <cstdio>
#include <cstdint>
namespace cg = cooperative_groups;
__device__ __forceinline__ int lane_id_() { return (int)__builtin_amdgcn_mbcnt_hi(~0u, __builtin_amdgcn_mbcnt_lo(~0u, 0u)); }
#define TIDX (__builtin_amdgcn_readfirstlane((int)(threadIdx.x >> 6)) * 64 + lane_id_())

namespace pg8 {
#define PG8_LAS __attribute__((address_space(3)))
typedef unsigned short bf16_t;
typedef short bf16x8 __attribute__((ext_vector_type(8)));
typedef float f32x4 __attribute__((ext_vector_type(4)));
typedef unsigned u32x4 __attribute__((ext_vector_type(4)));
constexpr int BM = 256, BK = 64, HALF = 128, HTB = HALF * BK * 2  , STAGE_BYTES = 8 * HTB, NXCD = 8, WGM = 8;

__host__ __device__ __forceinline__ int lds_byte(int r, int c) { const int st = (r >> 4) * 2 + (c >> 5), rr = r & 15, cc = c & 31, ob = rr * 64 + cc * 2; return st * 1024 + (ob ^ (((ob >> 9) & 1) << 5)); }
__host__ __device__ __forceinline__ void stage_rc(int b, int& R, int& C) { const int st = b / 1024, sb = b % 1024, swz = sb ^ (((sb >> 9) & 1) << 5); R = (st >> 1) * 16 + swz / 64; C = (st & 1) * 32 + (swz % 64) / 2; }
__host__ __device__ __forceinline__ int perm32(int rho) { const int n = rho >> 4, i = rho & 15; return 8 * (i >> 2) + 4 * n + (i & 3); }

struct Unit { int pm, pn; };
struct Gemm { const bf16_t* A; const bf16_t* Bt; int M, N, K; };

struct StaticOrder {
    int nM, nN, nwg, G, c;
    __host__ __device__ void init(int M, int N, int G_, int c_) { nM = M / BM; nN = N / BM; nwg = nM * nN; G = G_; c = c_; }
    __host__ __device__ bool next(int i, Unit& u) const {
        const long L = (long)i * G + c; if (L >= nwg) return false;
        int wgid = (int)L; { const int q = nwg / NXCD, r = nwg % NXCD, xcd = wgid % NXCD, off = wgid / NXCD; wgid = (xcd < r ? xcd * (q + 1) : r * (q + 1) + (xcd - r) * q) + off; }
        const int nig = WGM * nN, gid = wgid / nig, fm = gid * WGM, gsz = (nM - fm) < WGM ? (nM - fm) : WGM;
        u.pm = fm + ((wgid % nig) % gsz); u.pn = (wgid % nig) / gsz; return true;
    }
    __device__ __forceinline__ void a_ready(const Unit&) const {}
    __device__ __forceinline__ void done(const Unit&) const {}
};


template <class Epi, class Sched, bool ALIGN_EPI = false, bool SP2 = false>
__device__ __forceinline__ void gemm_phase(PG8_LAS unsigned char* lds, const Gemm g, const Sched& S, const Epi& E) {
    int tid_ = TIDX; asm volatile("" : "+v"(tid_));
    const int tid = tid_, wid = __builtin_amdgcn_readfirstlane(tid >> 6), lane = tid & 63, wr = wid >> 2, wc = wid & 3, fr = lane & 15, fq = lane >> 4;
    const int K = g.K, nt = K / BK;
    unsigned voffA[2], voffB[2];
#pragma unroll
    for (int i = 0; i < 2; ++i) { int R, C; stage_rc(tid * 16 + i * 8192, R, C); const int Rb = Epi::PERM ? ((R & ~31) + perm32(R & 31)) : R;
        voffA[i] = (unsigned)(R * K + C) * 2u; voffB[i] = (unsigned)(Rb * K + C) * 2u; }
    const size_t kstep = (size_t)(BK * 2);
    const size_t hstep = (size_t)HALF * K * 2;
    const size_t tstep = 2 * hstep;
    const unsigned ldsw = (unsigned)wid * 1024u;
    const int aoff = lds_byte(wr * 64 + fr, fq * 8), boff = lds_byte(wc * 32 + fr, fq * 8);
#define PG8_SA(b, h) (((b) * 2 + (h)) * HTB)
#define PG8_SB(b, h) ((4 + (b) * 2 + (h)) * HTB)
#define PG8_STAGE(bufoff, gbase, voff) do { _Pragma("unroll") for (int _i = 0; _i < 2; ++_i) \
        __builtin_amdgcn_global_load_lds((const unsigned*)((const char*)(gbase) + (voff)[_i]), (PG8_LAS unsigned*)(lds + (bufoff) + ldsw + _i * 8192), 16, 0, 0); } while (0)
#define PG8_LDA(dst, b, h) do { _Pragma("unroll") for (int m = 0; m < 4; ++m) _Pragma("unroll") for (int k = 0; k < 2; ++k) dst[m][k] = *(const PG8_LAS bf16x8*)(lds + PG8_SA(b, h) + aoff + m * 2048 + k * 1024); } while (0)
#define PG8_LDB(dst, b, h) do { _Pragma("unroll") for (int n = 0; n < 2; ++n) _Pragma("unroll") for (int k = 0; k < 2; ++k) dst[n][k] = *(const PG8_LAS bf16x8*)(lds + PG8_SB(b, h) + boff + n * 2048 + k * 1024); } while (0)
#define PG8_MMA(ai, bj, At, Bt) do { __builtin_amdgcn_s_setprio(1); _Pragma("unroll") for (int m = 0; m < 4; ++m) _Pragma("unroll") for (int n = 0; n < 2; ++n) _Pragma("unroll") for (int k = 0; k < 2; ++k) \
        acc[ai][bj][m][n] = __builtin_amdgcn_mfma_f32_16x16x32_bf16(Bt[n][k], At[m][k], acc[ai][bj][m][n], 0, 0, 0); __builtin_amdgcn_s_setprio(0); } while (0)
#define PG8_WAIT_V(n) asm volatile("s_waitcnt vmcnt(" #n ")" ::: "memory")
#define PG8_WAIT_L(n) asm volatile("s_waitcnt lgkmcnt(" #n ")" ::: "memory")
#define PG8_BAR __builtin_amdgcn_s_barrier()
#define PG8_SCHED __builtin_amdgcn_sched_barrier(0)
    Unit cur, nxt; int ui = 0;
    if (!S.next(0, cur)) return;
    f32x4 acc[2][2][4][2];
#pragma unroll
    for (int a = 0; a < 2; ++a)
#pragma unroll
        for (int b = 0; b < 2; ++b)
#pragma unroll
            for (int m = 0; m < 4; ++m)
#pragma unroll
                for (int n = 0; n < 2; ++n) acc[a][b][m][n] = (f32x4){0.f, 0.f, 0.f, 0.f};
    bf16x8 At[4][2], B0[2][2], B1[2][2];
    const char* cA = (const char*)g.A + (size_t)cur.pm * tstep; const char* cB = (const char*)g.Bt + (size_t)cur.pn * tstep;
    S.a_ready(cur);
    if constexpr (SP2) {
        PG8_STAGE(PG8_SB(0, 0), cB, voffB); PG8_STAGE(PG8_SB(0, 1), cB + hstep, voffB); PG8_STAGE(PG8_SA(0, 0), cA, voffA); PG8_STAGE(PG8_SA(0, 1), cA + hstep, voffA);
        if (wr == 1) PG8_BAR;
        PG8_WAIT_V(2); PG8_BAR;
        PG8_STAGE(PG8_SB(1, 0), cB + kstep, voffB); PG8_STAGE(PG8_SA(1, 0), cA + kstep, voffA); PG8_STAGE(PG8_SB(1, 1), cB + hstep + kstep, voffB);
        PG8_WAIT_V(6); PG8_BAR;
    } else {
        PG8_STAGE(PG8_SB(0, 0), cB, voffB); PG8_STAGE(PG8_SA(0, 0), cA, voffA); PG8_STAGE(PG8_SB(0, 1), cB + hstep, voffB); PG8_STAGE(PG8_SA(0, 1), cA + hstep, voffA);
        if (wr == 1) PG8_BAR;
        PG8_WAIT_V(4); PG8_BAR;
        PG8_STAGE(PG8_SB(1, 0), cB + kstep, voffB); PG8_STAGE(PG8_SA(1, 0), cA + kstep, voffA); PG8_STAGE(PG8_SB(1, 1), cB + hstep + kstep, voffB);
        PG8_WAIT_V(6); PG8_BAR;
    }
    for (;;) {
        const bool has_next = S.next(ui + 1, nxt);
        const char* nA = has_next ? (const char*)g.A + (size_t)nxt.pm * tstep : cA; const char* nB = has_next ? (const char*)g.Bt + (size_t)nxt.pn * tstep : cB;
        for (int t = 0; t < nt; t += 2) {
            const bool last = (t == nt - 2);
            const char* a1 = cA + (size_t)(t + 1) * kstep;
            const char* a2 = last ? nA : cA + (size_t)(t + 2) * kstep; const char* b2 = last ? nB : cB + (size_t)(t + 2) * kstep;
            const char* a3 = a2 + kstep; const char* b3 = b2 + kstep;
            if (last && has_next) S.a_ready(nxt);
            if constexpr (SP2) {
            PG8_LDB(B0, 0, 0); PG8_LDB(B1, 0, 1); PG8_SCHED; PG8_LDA(At, 0, 0); PG8_STAGE(PG8_SA(1, 1), a1 + hstep, voffA);
            PG8_WAIT_V(8); PG8_WAIT_L(0); PG8_BAR; PG8_MMA(0, 0, At, B0); PG8_MMA(0, 1, At, B1); PG8_BAR; PG8_SCHED;
            PG8_LDA(At, 0, 1); PG8_STAGE(PG8_SB(0, 0), b2, voffB); PG8_STAGE(PG8_SB(0, 1), b2 + hstep, voffB); PG8_STAGE(PG8_SA(0, 0), a2, voffA);
            PG8_WAIT_V(8); PG8_WAIT_L(0); PG8_BAR; PG8_MMA(1, 0, At, B0); PG8_MMA(1, 1, At, B1); PG8_BAR; PG8_SCHED;
            PG8_LDB(B0, 1, 0); PG8_LDB(B1, 1, 1); PG8_SCHED; PG8_LDA(At, 1, 0); PG8_STAGE(PG8_SA(0, 1), a2 + hstep, voffA);
            PG8_WAIT_V(8); PG8_WAIT_L(0); PG8_BAR; PG8_MMA(0, 0, At, B0); PG8_MMA(0, 1, At, B1); PG8_BAR; PG8_SCHED;
            PG8_LDA(At, 1, 1); PG8_STAGE(PG8_SB(1, 0), b3, voffB); PG8_STAGE(PG8_SB(1, 1), b3 + hstep, voffB); PG8_STAGE(PG8_SA(1, 0), a3, voffA);
            PG8_WAIT_V(8); PG8_WAIT_L(0); PG8_BAR; PG8_MMA(1, 0, At, B0); PG8_MMA(1, 1, At, B1); PG8_BAR; PG8_SCHED;
            } else {
            PG8_LDB(B0, 0, 0); PG8_SCHED; PG8_LDA(At, 0, 0); PG8_STAGE(PG8_SA(1, 1), a1 + hstep, voffA);
            PG8_WAIT_L(8); PG8_BAR; PG8_WAIT_L(0); PG8_MMA(0, 0, At, B0); PG8_BAR; PG8_SCHED;
            PG8_LDB(B1, 0, 1); PG8_STAGE(PG8_SB(0, 0), b2, voffB);
            PG8_BAR; PG8_WAIT_L(0); PG8_MMA(0, 1, At, B1); PG8_BAR;
            PG8_LDA(At, 0, 1); PG8_STAGE(PG8_SA(0, 0), a2, voffA);
            PG8_BAR; PG8_WAIT_L(0); PG8_MMA(1, 0, At, B0); PG8_BAR; PG8_SCHED;
            PG8_STAGE(PG8_SB(0, 1), b2 + hstep, voffB);
            PG8_WAIT_V(6); PG8_BAR; PG8_MMA(1, 1, At, B1); PG8_BAR;
            PG8_LDB(B0, 1, 0); PG8_SCHED; PG8_LDA(At, 1, 0); PG8_STAGE(PG8_SA(0, 1), a2 + hstep, voffA);
            PG8_WAIT_L(8); PG8_BAR; PG8_WAIT_L(0); PG8_MMA(0, 0, At, B0); PG8_BAR; PG8_SCHED;
            PG8_LDB(B1, 1, 1); PG8_STAGE(PG8_SB(1, 0), b3, voffB);
            PG8_BAR; PG8_WAIT_L(0); PG8_MMA(0, 1, At, B1); PG8_BAR;
            PG8_LDA(At, 1, 1); PG8_STAGE(PG8_SA(1, 0), a3, voffA);
            PG8_BAR; PG8_WAIT_L(0); PG8_MMA(1, 0, At, B0); PG8_BAR; PG8_SCHED;
            PG8_STAGE(PG8_SB(1, 1), b3 + hstep, voffB);
            PG8_WAIT_V(6); PG8_BAR; PG8_MMA(1, 1, At, B1); PG8_BAR;
            }
        }
        if constexpr (ALIGN_EPI) { if (wr == 0) PG8_BAR; }
        if constexpr (!Epi::AFTER_DRAIN) { E(acc, cur, wr, wc, fr, fq); S.done(cur); }
        if (!has_next) break;
#pragma unroll
        for (int a = 0; a < 2; ++a)
#pragma unroll
            for (int b = 0; b < 2; ++b)
#pragma unroll
                for (int m = 0; m < 4; ++m)
#pragma unroll
                    for (int n = 0; n < 2; ++n) acc[a][b][m][n] = (f32x4){0.f, 0.f, 0.f, 0.f};
        cur = nxt; cA = nA; cB = nB; ++ui;
        if constexpr (ALIGN_EPI) { if (wr == 1) PG8_BAR; }
    }
    PG8_WAIT_V(0);
    if constexpr (!ALIGN_EPI) { if (wr == 0) PG8_BAR; }
    PG8_BAR;
    if constexpr (Epi::AFTER_DRAIN) { E.fused(acc, cur, wr, wc, fr, fq, lds, wid, lane); S.done(cur); }
#undef PG8_SA
#undef PG8_SB
#undef PG8_STAGE
#undef PG8_LDA
#undef PG8_LDB
#undef PG8_MMA
#undef PG8_WAIT_V
#undef PG8_WAIT_L
#undef PG8_BAR
#undef PG8_SCHED
}
}


#define DI __device__ __forceinline__
typedef unsigned short bf16_t;
typedef short bf16x8 __attribute__((ext_vector_type(8)));
typedef float f32x4 __attribute__((ext_vector_type(4)));
typedef float f32x2 __attribute__((ext_vector_type(2)));
typedef float f32x16 __attribute__((ext_vector_type(16)));
typedef unsigned u32x4 __attribute__((ext_vector_type(4)));
#define MFMA32(a, b, c) __builtin_amdgcn_mfma_f32_32x32x16_bf16((a), (b), (c), 0, 0, 0)
#define LAS __attribute__((address_space(3)))

constexpr int NT = 512;
constexpr int DM = 1024, MP = 16384, MT = 16896;
constexpr int NIN = 10368, NINP = 10496, CSH = 4224;
constexpr float EPS = 1e-6f, LNX_EPS = 64e-5f;
constexpr float QSCALE = 0.18033688011112042f;

constexpr size_t OUT_YP = 0, OUT_KP = 17301504, OUT_VP = 34078720, OUT_SHP = 50855936, OUT_WP = 50872832,
                 OUT_KS = 51134976, OUT_VS = 51659264, OUT_SHS = 52183552, OUT_WS = 52318720;

constexpr size_t SZ_ACT = (size_t)MT * 1024 * 2;
constexpr size_t WS_R1 = 0;
constexpr size_t WS_H = WS_R1, WS_WINT = WS_R1 + SZ_ACT, WS_SW = WS_R1;
constexpr size_t WS_R2 = (size_t)MT * 1024 * 4;
constexpr size_t WS_PB = WS_R2, WS_ORAW = WS_R2, WS_OB = WS_ORAW + (size_t)MT * 1024 * 4, WS_MG = WS_OB + SZ_ACT;
constexpr size_t WS_R3 = WS_R2 + (size_t)MT * CSH * 2;
constexpr size_t WS_QB = WS_R3, WS_X = WS_QB + SZ_ACT  , WS_BTL = WS_X + (size_t)MT * 256 * 2  , WS_SZA = WS_X + (size_t)MP * 1024 * 2;
static_assert(WS_BTL + (size_t)2048 * 256 * 2 <= WS_SZA, "LoRA buffers");
constexpr size_t WS_SR = WS_SZA + SZ_ACT, WS_SK = WS_SR + SZ_ACT, WS_SV = WS_SK + SZ_ACT, WS_SKK = WS_SV + SZ_ACT, WS_SB = WS_SKK + SZ_ACT;
constexpr size_t WS_SZB = WS_SB + SZ_ACT;
constexpr size_t WS_BONUS = WS_SZB + SZ_ACT;
constexpr size_t WS_WT = WS_BONUS + (size_t)MT * 16 * 4;
constexpr size_t WS_CTL = WS_WT + 3 * (size_t)1024 * 1024 * 2;
constexpr size_t WS_END = WS_CTL + 65536;
static_assert(WS_MG + SZ_ACT <= WS_R3, "R2 overflow");
static_assert(WS_WINT + (size_t)NINP * 1024 * 2 <= WS_R2, "R1 overflow");
static_assert(WS_END <= (size_t)512 * 1024 * 1024, "workspace");

constexpr int SMEM_BYTES = 147456;

struct Params { const float* in[22]; float* out; unsigned char* ws; };

DI float bf2f(bf16_t u) { return __uint_as_float((unsigned)u << 16); }
DI unsigned cvtpk(float lo, float hi) { unsigned r; asm volatile("v_cvt_pk_bf16_f32 %0, %1, %2" : "=v"(r) : "v"(lo), "v"(hi)); return r; }
DI bf16_t f2bf(float x) { return (bf16_t)(cvtpk(x, 0.f) & 0xffffu); }
DI float bflo(unsigned u) { return __uint_as_float(u << 16); }
DI float bfhi(unsigned u) { return __uint_as_float(u & 0xffff0000u); }
DI int crow(int i, int h) { return (i & 3) + 8 * (i >> 2) + 4 * h; }
DI float sigmoidf_(float x) { return fminf(__builtin_amdgcn_rcpf(1.f + __expf(-x)), 1.f); }
typedef unsigned u32x2 __attribute__((ext_vector_type(2)));
DI uint2 ntload2(const void* q) { const u32x2 v = __builtin_nontemporal_load((const u32x2*)q); return make_uint2(v.x, v.y); }
DI void ntstore2(void* q, uint2 v) { const u32x2 t = {v.x, v.y}; __builtin_nontemporal_store(t, (u32x2*)q); }
DI uint4 pack8(f32x4 a, f32x4 b) { return make_uint4(cvtpk(a[0], a[1]), cvtpk(a[2], a[3]), cvtpk(b[0], b[1]), cvtpk(b[2], b[3])); }
template <int CTRL> DI float dppf(float x) { return __builtin_bit_cast(float, __builtin_amdgcn_mov_dpp(__builtin_bit_cast(int, x), CTRL, 0xf, 0xf, true)); }
DI float sum16(float x) { x += dppf<0xB1>(x); x += dppf<0x4E>(x); x += dppf<0x124>(x); x += dppf<0x128>(x); return x; }
DI float wave_sum(float x) {
  x = sum16(x);
  const auto s = __builtin_amdgcn_permlane16_swap(__float_as_uint(x), __float_as_uint(x), false, false);
  x = __uint_as_float(s[0]) + __uint_as_float(s[1]);
  const auto t = __builtin_amdgcn_permlane32_swap(__float_as_uint(x), __float_as_uint(x), false, false);
  return __uint_as_float(t[0]) + __uint_as_float(t[1]);
}
DI float row32_sum(float x) {
  x += dppf<0xB1>(x);
  x += dppf<0x4E>(x);
  x += dppf<0x124>(x);
  x += dppf<0x128>(x);
  const auto s = __builtin_amdgcn_permlane16_swap(__float_as_uint(x), __float_as_uint(x), false, false);
  return __uint_as_float(s[0]) + __uint_as_float(s[1]);
}
DI size_t hm_base(int row) {
  if (row < MP) { const int b = row >> 12, t = row & 4095; return ((size_t)(b * 16) * 4096 + t) * 64; }
  const int rs = row - MP, b = rs >> 4, t = rs & 15; return (size_t)MP * 1024 + ((size_t)(b * 16) * 16 + t) * 64;
}
DI size_t hm_hstride(int row) { return row < MP ? (size_t)4096 * 64 : (size_t)16 * 64; }

DI void p0_rmsnorm_rows(const Params& p, int item) {
  const int lane = TIDX & 63, wid = TIDX >> 6;
  const int row = item * 8 + wid;
  const float* x = row < MP ? p.in[0] + (size_t)row * DM : p.in[1] + (size_t)(row - MP) * DM;
  const float* g = p.in[6];
  float4 v[4]; float ss = 0.f;
#pragma unroll
  for (int i = 0; i < 4; ++i) { v[i] = *(const float4*)(x + i * 256 + lane * 4); ss += v[i].x * v[i].x + v[i].y * v[i].y + v[i].z * v[i].z + v[i].w * v[i].w; }
  ss = wave_sum(ss);
  const float inv = rsqrtf(ss * (1.f / DM) + EPS);
  bf16_t* H = (bf16_t*)(p.ws + WS_H) + (size_t)row * DM;
#pragma unroll
  for (int i = 0; i < 4; ++i) {
    const float4 gg = *(const float4*)(g + i * 256 + lane * 4);
    uint2 o; o.x = cvtpk(v[i].x * inv * gg.x, v[i].y * inv * gg.y); o.y = cvtpk(v[i].z * inv * gg.z, v[i].w * inv * gg.w);
    *(uint2*)(H + i * 256 + lane * 4) = o;
  }
}
DI void p0_transpose_tile(const float* src, bf16_t* dst, int N, int kt, int nt, float* lds) {
  const int tid = TIDX & 255;
  const int k0 = kt * 64, n0 = nt * 64;
#pragma unroll
  for (int i = 0; i < 4; ++i) {
    const int row = (tid >> 4) + 16 * i, c4 = (tid & 15) * 4;
    const float4 v = *(const float4*)(src + (size_t)(k0 + row) * N + n0 + c4);
    lds[row * 65 + c4 + 0] = v.x; lds[row * 65 + c4 + 1] = v.y; lds[row * 65 + c4 + 2] = v.z; lds[row * 65 + c4 + 3] = v.w;
  }
  __syncthreads();
  const int n = tid >> 2, kc = (tid & 3) * 16;
  unsigned w[8];
#pragma unroll
  for (int j = 0; j < 8; ++j) w[j] = cvtpk(lds[(kc + 2 * j) * 65 + n], lds[(kc + 2 * j + 1) * 65 + n]);
  uint4* d = (uint4*)(dst + (size_t)(n0 + n) * 1024 + k0 + kc);
  d[0] = make_uint4(w[0], w[1], w[2], w[3]); d[1] = make_uint4(w[4], w[5], w[6], w[7]);
  __syncthreads();
}
DI void phase0(const Params& p, char* smem) {
  {
    bf16_t* BL = (bf16_t*)(p.ws + WS_BTL);
    for (int i = blockIdx.x * NT + TIDX; i < 2048 * 256; i += gridDim.x * NT) {
      const int n = i >> 8, k = i & 255;
      float v = 0.f;
      if (n < 1024) { if (k < 64) v = p.in[10][(size_t)k * 1024 + n]; }
      else if (k >= 64 && k < 128) v = p.in[12][(size_t)(k - 64) * 1024 + (n - 1024)];
      BL[i] = f2bf(v);
    }
  }
  constexpr int N_ROWS = MT / 8, N_TIN = 16 * 162 / 2, N_TSQ = 256 / 2;
  constexpr int N_ITEMS = N_ROWS + N_TIN + 3 * N_TSQ;
  const int half = TIDX >> 8;
  float* scr = (float*)smem + half * (64 * 65);
  for (int it = blockIdx.x; it < N_ITEMS; it += gridDim.x) {
    if (it < N_ROWS) { p0_rmsnorm_rows(p, it); continue; }
    int j = it - N_ROWS;
    if (j < N_TIN) { const int t = 2 * j + half; p0_transpose_tile(p.in[7], (bf16_t*)(p.ws + WS_WINT), NIN, t / 162, t % 162, scr); continue; }
    j -= N_TIN;
    const int w = j / N_TSQ; const int t = 2 * (j % N_TSQ) + half;
    p0_transpose_tile(p.in[18 + w], (bf16_t*)(p.ws + WS_WT) + (size_t)w * 1024 * 1024, 1024, t >> 4, t & 15, scr);
  }
}

struct EpiP1 {
  static constexpr bool PERM = true, AFTER_DRAIN = false;
  Params p;
  DI void operator()(const pg8::f32x4 (&acc)[2][2][4][2], const pg8::Unit& u, int wr, int wc, int fr, int fq) const {
    const int colt = u.pn * 256;
    const int region = colt >> 10;
#pragma unroll
    for (int ai = 0; ai < 2; ++ai)
#pragma unroll
      for (int m = 0; m < 4; ++m) {
        const int row = u.pm * 256 + ai * 128 + wr * 64 + m * 16 + fr;
        const bool prompt = row < MP;
        const int rs = row - MP;
#pragma unroll
        for (int bj = 0; bj < 2; ++bj) {
          const int col = colt + bj * 128 + wc * 32 + 8 * fq;
          const f32x4 v0 = acc[ai][bj][m][0], v1 = acc[ai][bj][m][1];
          if (region >= 6) {
            const int pc = col - 6144;
            if (pc < CSH) {
              *(uint4*)((bf16_t*)(p.ws + WS_PB) + (size_t)row * CSH + pc) = pack8(v0, v1);
              float* so = nullptr;
              if (prompt) { if ((row & 4095) == 4095) so = p.out + OUT_SHP + (size_t)(row >> 12) * CSH + pc; }
              else if ((rs & 15) == 15) so = p.out + OUT_SHS + (size_t)(rs >> 4) * CSH + pc;
              if (so) { *(f32x4*)so = v0; *(f32x4*)(so + 4) = v1; }
            }
          } else if (region == 0) {
            *(uint4*)((bf16_t*)(p.ws + WS_QB) + (size_t)row * 1024 + col) = pack8(v0 * QSCALE, v1 * QSCALE);
          } else if (region == 1) {
            const int c = col - 1024, hh = c >> 6, d = c & 63;
            float* o = prompt ? p.out + OUT_KP + (((size_t)(row >> 12) * 16 + hh) * 4096 + (row & 4095)) * 64 + d
                              : p.out + OUT_KS + (((size_t)(rs >> 4) * 16 + hh) * 16 + (rs & 15)) * 64 + d;
            __builtin_nontemporal_store(v0, (f32x4*)o); __builtin_nontemporal_store(v1, (f32x4*)(o + 4));
          } else if (region == 2) {
            const int c = col - 2048, hh = c >> 6, d = c & 63;
            float* o = prompt ? p.out + OUT_VP + (((size_t)(row >> 12) * 16 + hh) * 4096 + (row & 4095)) * 64 + d
                              : p.out + OUT_VS + (((size_t)(rs >> 4) * 16 + hh) * 16 + (rs & 15)) * 64 + d;
            __builtin_nontemporal_store(v0, (f32x4*)o); __builtin_nontemporal_store(v1, (f32x4*)(o + 4));
          } else if (region == 3) {
            f32x4 a, b;
#pragma unroll
            for (int j = 0; j < 4; ++j) { a[j] = v0[j] * sigmoidf_(v0[j]); b[j] = v1[j] * sigmoidf_(v1[j]); }
            *(uint4*)((bf16_t*)(p.ws + WS_SZA) + (size_t)row * 1024 + (col - 3072)) = pack8(a, b);
          } else {
            f32x4 a, b;
#pragma unroll
            for (int j = 0; j < 4; ++j) { a[j] = sigmoidf_(v0[j]); b[j] = sigmoidf_(v1[j]); }
            *(uint4*)((bf16_t*)p.out + (size_t)row * 2048 + (col - 4096)) = pack8(a, b);
          }
        }
      }
  }
};
struct EpiGate {
  static constexpr bool PERM = true, AFTER_DRAIN = false;
  Params p; int goff; bool first;
  DI void operator()(const pg8::f32x4 (&acc)[2][2][4][2], const pg8::Unit& u, int wr, int wc, int fr, int fq) const {
    const bf16_t* G = (const bf16_t*)p.out; bf16_t* MG = (bf16_t*)(p.ws + WS_MG);
#pragma unroll
    for (int ai = 0; ai < 2; ++ai)
#pragma unroll
      for (int m = 0; m < 4; ++m) {
        const size_t row = u.pm * 256 + ai * 128 + wr * 64 + m * 16 + fr;
#pragma unroll
        for (int bj = 0; bj < 2; ++bj) {
          const int col = u.pn * 256 + bj * 128 + wc * 32 + 8 * fq;
          const uint4 g = *(const uint4*)(G + row * 2048 + goff + col);
          f32x4 a = acc[ai][bj][m][0], b = acc[ai][bj][m][1];
          a[0] *= bflo(g.x); a[1] *= bfhi(g.x); a[2] *= bflo(g.y); a[3] *= bfhi(g.y);
          b[0] *= bflo(g.z); b[1] *= bfhi(g.z); b[2] *= bflo(g.w); b[3] *= bfhi(g.w);
          if (!first) {
            const uint4 o = *(const uint4*)(MG + row * 1024 + col);
            a[0] += bflo(o.x); a[1] += bfhi(o.x); a[2] += bflo(o.y); a[3] += bfhi(o.y);
            b[0] += bflo(o.z); b[1] += bfhi(o.z); b[2] += bflo(o.w); b[3] += bfhi(o.w);
          }
          *(uint4*)(MG + row * 1024 + col) = pack8(a, b);
        }
      }
  }
};
struct EpiOut {
  static constexpr bool PERM = true, AFTER_DRAIN = false;
  Params p;
  DI void operator()(const pg8::f32x4 (&acc)[2][2][4][2], const pg8::Unit& u, int wr, int wc, int fr, int fq) const {
#pragma unroll
    for (int ai = 0; ai < 2; ++ai)
#pragma unroll
      for (int m = 0; m < 4; ++m) {
        const int row = u.pm * 256 + ai * 128 + wr * 64 + m * 16 + fr;
        const float* xr = row < MP ? p.in[0] + (size_t)row * 1024 : p.in[1] + (size_t)(row - MP) * 1024;
        float* orow = p.out + OUT_YP + (size_t)row * 1024;
#pragma unroll
        for (int bj = 0; bj < 2; ++bj) {
          const int col = u.pn * 256 + bj * 128 + wc * 32 + 8 * fq;
          const f32x4 x0 = *(const f32x4*)(xr + col), x1 = *(const f32x4*)(xr + col + 4);
          *(f32x4*)(orow + col) = x0 + acc[ai][bj][m][0]; *(f32x4*)(orow + col + 4) = x1 + acc[ai][bj][m][1];
        }
      }
  }
};
template <class Epi>
DI void run_gemm(char* smem, const bf16_t* A, const bf16_t* Bt, int M, int N, const Epi& E, int K = 1024) {
  pg8::Gemm g; g.A = A; g.Bt = Bt; g.M = M; g.N = N; g.K = K;
  pg8::StaticOrder S; S.init(M, N, (int)gridDim.x, (int)blockIdx.x);
  pg8::gemm_phase<Epi, pg8::StaticOrder, true, true>((LAS unsigned char*)smem, g, S, E);
  __syncthreads();
}

template <int MODE>
DI void small_gemm(const Params& p, const bf16_t* A, const bf16_t* Bt) {
  int t_ = TIDX; asm volatile("" : "+v"(t_));
  const int lane = t_ & 63, wid = __builtin_amdgcn_readfirstlane(t_ >> 6), fr = lane & 15, fq = lane >> 4;
  for (int tile = wid * gridDim.x + blockIdx.x; tile < 2048; tile += 8 * gridDim.x) {
    const int row0 = MP + (tile >> 6) * 16, col0 = (tile & 63) * 16;
    const bf16_t* pa = A + (size_t)(row0 + fr) * 1024 + 8 * fq;
    const bf16_t* pb = Bt + (size_t)(col0 + fr) * 1024 + 8 * fq;
    f32x4 acc = {0.f, 0.f, 0.f, 0.f};
#pragma unroll 8
    for (int s = 0; s < 32; ++s) acc = __builtin_amdgcn_mfma_f32_16x16x32_bf16(*(const bf16x8*)(pa + 32 * s), *(const bf16x8*)(pb + 32 * s), acc, 0, 0, 0);
    const int col = col0 + fr;
#pragma unroll
    for (int j = 0; j < 4; ++j) {
      const size_t row = row0 + 4 * fq + j;
      if (MODE == 2) p.out[OUT_YP + row * 1024 + col] = p.in[1][(row - MP) * 1024 + col] + acc[j];
      else {
        bf16_t* mg = (bf16_t*)(p.ws + WS_MG) + row * 1024 + col;
        const float g = bf2f(((const bf16_t*)p.out)[row * 2048 + (MODE == 1 ? 1024 : 0) + col]);
        *mg = f2bf((MODE == 1 ? bf2f(*mg) : 0.f) + acc[j] * g);
      }
    }
  }
}

DI float tanh_fast(float x) { return 1.f - 2.f * __builtin_amdgcn_rcpf(1.f + __expf(2.f * x)); }
DI void phase_x(const Params& p) {
  const bf16_t* PB = (const bf16_t*)(p.ws + WS_PB);
  bf16_t* X = (bf16_t*)(p.ws + WS_X);
  const float* mu = p.in[8];
  for (int i = blockIdx.x * NT + TIDX; i < MT * 32; i += gridDim.x * NT) {
    const int row = i >> 5, g = i & 31;
    uint4 o = make_uint4(0u, 0u, 0u, 0u);
    if (g < 16) {
      const int col = 3072 + g * 8;
      const bool prompt = row < MP;
      const int t = prompt ? (row & 4095) : ((row - MP) & 15);
      const uint4 a = *(const uint4*)(PB + (size_t)row * CSH + col);
      float c[8] = {bflo(a.x), bfhi(a.x), bflo(a.y), bfhi(a.y), bflo(a.z), bfhi(a.z), bflo(a.w), bfhi(a.w)}, q[8];
      if (t != 0) { const uint4 b = *(const uint4*)(PB + (size_t)(row - 1) * CSH + col); q[0] = bflo(b.x); q[1] = bfhi(b.x); q[2] = bflo(b.y); q[3] = bfhi(b.y); q[4] = bflo(b.z); q[5] = bfhi(b.z); q[6] = bflo(b.w); q[7] = bfhi(b.w); }
      else if (prompt) {
#pragma unroll
        for (int j = 0; j < 8; ++j) q[j] = 0.f;
      } else { const float* s = p.in[4] + (size_t)((row - MP) >> 4) * CSH + col; const float4 b0 = *(const float4*)s, b1 = *(const float4*)(s + 4); q[0] = b0.x; q[1] = b0.y; q[2] = b0.z; q[3] = b0.w; q[4] = b1.x; q[5] = b1.y; q[6] = b1.z; q[7] = b1.w; }
      const float4 u0 = *(const float4*)(mu + col), u1 = *(const float4*)(mu + col + 4);
      const float u[8] = {u0.x, u0.y, u0.z, u0.w, u1.x, u1.y, u1.z, u1.w};
      float m[8];
#pragma unroll
      for (int j = 0; j < 8; ++j) { m[j] = c[j] + u[j] * (q[j] - c[j]); if (g < 8) m[j] = tanh_fast(m[j]); }
      o = make_uint4(cvtpk(m[0], m[1]), cvtpk(m[2], m[3]), cvtpk(m[4], m[5]), cvtpk(m[6], m[7]));
    }
    *(uint4*)(X + (size_t)row * 256 + g * 8) = o;
  }
}
struct EpiLora {
  static constexpr bool PERM = true, AFTER_DRAIN = false;
  Params p;
  DI void operator()(const pg8::f32x4 (&acc)[2][2][4][2], const pg8::Unit& u, int wr, int wc, int fr, int fq) const {
    const bool isw = u.pn < 4;
#pragma unroll
    for (int ai = 0; ai < 2; ++ai)
#pragma unroll
      for (int m = 0; m < 4; ++m) {
        const int row = u.pm * 256 + ai * 128 + wr * 64 + m * 16 + fr;
        const size_t hb = hm_base(row), hs = hm_hstride(row);
#pragma unroll
        for (int bj = 0; bj < 2; ++bj) {
          const int c = (u.pn & 3) * 256 + bj * 128 + wc * 32 + 8 * fq;
          const size_t idx = hb + (c >> 6) * hs + (c & 63);
          const f32x4 v0 = acc[ai][bj][m][0], v1 = acc[ai][bj][m][1];
          if (isw) {
            const f32x4 b0 = *(const f32x4*)(p.in[9] + c), b1 = *(const f32x4*)(p.in[9] + c + 4);
            f32x4 d0, d1;
#pragma unroll
            for (int j = 0; j < 4; ++j) {
              const float x0 = -(b0[j] + v0[j]), x1 = -(b1[j] + v1[j]);
              const float s0 = fmaxf(x0, 0.f) + __logf(1.f + __expf(-fabsf(x0))), s1 = fmaxf(x1, 0.f) + __logf(1.f + __expf(-fabsf(x1)));
              d0[j] = __expf(-__expf(-s0 - 0.5f)); d1[j] = __expf(-__expf(-s1 - 0.5f));
            }
            float* o = (float*)(p.ws + WS_SW) + idx; *(f32x4*)o = d0; *(f32x4*)(o + 4) = d1;
          } else {
            const f32x4 b0 = *(const f32x4*)(p.in[11] + c), b1 = *(const f32x4*)(p.in[11] + c + 4);
            f32x4 d0, d1;
#pragma unroll
            for (int j = 0; j < 4; ++j) { d0[j] = sigmoidf_(b0[j] + v0[j]); d1[j] = sigmoidf_(b1[j] + v1[j]); }
            *(uint4*)((bf16_t*)(p.ws + WS_SB) + idx) = pack8(d0, d1);
          }
        }
      }
  }
};
DI void small_lora(const Params& p) {
  const int lane = TIDX & 63, wid = TIDX >> 6, r = lane & 31, h = lane >> 5;
  const bf16_t* X = (const bf16_t*)(p.ws + WS_X); const bf16_t* BL = (const bf16_t*)(p.ws + WS_BTL);
  for (int tile = wid * gridDim.x + blockIdx.x; tile < 16 * 64; tile += 8 * gridDim.x) {
    const int row0 = MP + (tile >> 6) * 32, ct = tile & 63, col0 = ct * 32, k0 = ct < 32 ? 0 : 64;
    const bf16_t* pa = X + (size_t)(row0 + r) * 256 + k0 + 8 * h;
    const bf16_t* pb = BL + (size_t)(col0 + r) * 256 + k0 + 8 * h;
    f32x16 acc;
#pragma unroll
    for (int i = 0; i < 16; ++i) acc[i] = 0.f;
#pragma unroll
    for (int s = 0; s < 4; ++s) acc = MFMA32(*(const bf16x8*)(pa + 16 * s), *(const bf16x8*)(pb + 16 * s), acc);
    const int c = (col0 + r) & 1023;
    const float bias = ct < 32 ? p.in[9][c] : p.in[11][c];
#pragma unroll
    for (int i = 0; i < 16; ++i) {
      const int row = row0 + crow(i, h);
      const size_t idx = hm_base(row) + (c >> 6) * hm_hstride(row) + (c & 63);
      const float v = bias + acc[i];
      if (ct < 32) {
        const float x = -v, sp = fmaxf(x, 0.f) + __logf(1.f + __expf(-fabsf(x)));
        ((float*)(p.ws + WS_SW))[idx] = __expf(-__expf(-sp - 0.5f));
      } else ((bf16_t*)(p.ws + WS_SB))[idx] = f2bf(sigmoidf_(v));
    }
  }
}

DI void phase1c(const Params& p) {
  const int tid = TIDX & 255, half = TIDX >> 8, c = tid * 4, hh = c >> 6;
  const bf16_t* PB = (const bf16_t*)(p.ws + WS_PB);
  const float* mu = p.in[8];
  const float4 kkw = *(const float4*)(p.in[13] + c), kaw = *(const float4*)(p.in[14] + c), rkw = *(const float4*)(p.in[15] + c);
  const float4 mur = *(const float4*)(mu + c), muk = *(const float4*)(mu + 1024 + c), muv = *(const float4*)(mu + 2048 + c), muz = *(const float4*)(mu + 3200 + c);
  const float kka[4] = {kkw.x, kkw.y, kkw.z, kkw.w}, kaa[4] = {kaw.x, kaw.y, kaw.z, kaw.w}, rka[4] = {rkw.x, rkw.y, rkw.z, rkw.w};
  const float mura[4] = {mur.x, mur.y, mur.z, mur.w}, muka[4] = {muk.x, muk.y, muk.z, muk.w}, muva[4] = {muv.x, muv.y, muv.z, muv.w}, muza[4] = {muz.x, muz.y, muz.z, muz.w};
  bf16_t* SR = (bf16_t*)(p.ws + WS_SR); bf16_t* SK = (bf16_t*)(p.ws + WS_SK); bf16_t* SV = (bf16_t*)(p.ws + WS_SV);
  bf16_t* SKK = (bf16_t*)(p.ws + WS_SKK); bf16_t* SB = (bf16_t*)(p.ws + WS_SB); bf16_t* SZB = (bf16_t*)(p.ws + WS_SZB);
  float* BONUS = (float*)(p.ws + WS_BONUS);
  for (int r4 = blockIdx.x * 2 + half; r4 < MT / 4; r4 += gridDim.x * 2) {
    const int row0 = r4 * 4;
    const bool prompt = row0 < MP;
    const int t0 = prompt ? (row0 & 4095) : ((row0 - MP) & 15);
    uint2 gr[5], gk[5], gv[5], gz[5], ga[4];
#pragma unroll
    for (int t = 0; t < 5; ++t) {
      const int rr_ = (t == 0 && t0 == 0) ? row0 : row0 + t - 1;
      const bf16_t* pc = PB + (size_t)rr_ * CSH;
      gr[t] = ntload2(pc + c); gk[t] = ntload2(pc + 1024 + c); gv[t] = ntload2(pc + 2048 + c); gz[t] = ntload2(pc + 3200 + c);
    }
    size_t idx[4];
#pragma unroll
    for (int t = 0; t < 4; ++t) { idx[t] = hm_base(row0 + t) + hh * hm_hstride(row0 + t) + (c & 63); ga[t] = *(const uint2*)(SB + idx[t]); }
    float pr[4], pk[4], pv[4], pz[4];
    if (t0 == 0) {
      if (prompt) {
#pragma unroll
        for (int x = 0; x < 4; ++x) { pr[x] = 0.f; pk[x] = 0.f; pv[x] = 0.f; pz[x] = 0.f; }
      } else {
        const float* s = p.in[4] + (size_t)((row0 - MP) >> 4) * CSH;
        const float4 a = *(const float4*)(s + c), b = *(const float4*)(s + 1024 + c), d = *(const float4*)(s + 2048 + c), e = *(const float4*)(s + 3200 + c);
        pr[0] = a.x; pr[1] = a.y; pr[2] = a.z; pr[3] = a.w; pk[0] = b.x; pk[1] = b.y; pk[2] = b.z; pk[3] = b.w;
        pv[0] = d.x; pv[1] = d.y; pv[2] = d.z; pv[3] = d.w; pz[0] = e.x; pz[1] = e.y; pz[2] = e.z; pz[3] = e.w;
      }
    } else {
      pr[0] = bflo(gr[0].x); pr[1] = bfhi(gr[0].x); pr[2] = bflo(gr[0].y); pr[3] = bfhi(gr[0].y);
      pk[0] = bflo(gk[0].x); pk[1] = bfhi(gk[0].x); pk[2] = bflo(gk[0].y); pk[3] = bfhi(gk[0].y);
      pv[0] = bflo(gv[0].x); pv[1] = bfhi(gv[0].x); pv[2] = bflo(gv[0].y); pv[3] = bfhi(gv[0].y);
      pz[0] = bflo(gz[0].x); pz[1] = bfhi(gz[0].x); pz[2] = bflo(gz[0].y); pz[3] = bfhi(gz[0].y);
    }
#pragma unroll
    for (int t = 0; t < 4; ++t) {
      const int row = row0 + t;
      const float curr[4] = {bflo(gr[t + 1].x), bfhi(gr[t + 1].x), bflo(gr[t + 1].y), bfhi(gr[t + 1].y)}, curk[4] = {bflo(gk[t + 1].x), bfhi(gk[t + 1].x), bflo(gk[t + 1].y), bfhi(gk[t + 1].y)};
      const float curv[4] = {bflo(gv[t + 1].x), bfhi(gv[t + 1].x), bflo(gv[t + 1].y), bfhi(gv[t + 1].y)}, curz[4] = {bflo(gz[t + 1].x), bfhi(gz[t + 1].x), bflo(gz[t + 1].y), bfhi(gz[t + 1].y)};
      const float av[4] = {bflo(ga[t].x), bfhi(ga[t].x), bflo(ga[t].y), bfhi(ga[t].y)};
      float rm[4], km[4], vm[4], kkv[4], bb[4], kmod[4], szb[4];
      float ssq = 0.f, bon = 0.f;
#pragma unroll
      for (int x = 0; x < 4; ++x) {
        rm[x] = curr[x] + mura[x] * (pr[x] - curr[x]);
        km[x] = curk[x] + muka[x] * (pk[x] - curk[x]);
        vm[x] = curv[x] + muva[x] * (pv[x] - curv[x]);
        const float zm = curz[x] + muza[x] * (pz[x] - curz[x]);
        szb[x] = zm * sigmoidf_(zm);
        kkv[x] = km[x] * kka[x];
        ssq += kkv[x] * kkv[x];
        kmod[x] = km[x] * (1.f + (av[x] - 1.f) * kaa[x]);
        bon += rm[x] * kmod[x] * rka[x];
        pr[x] = curr[x]; pk[x] = curk[x]; pv[x] = curv[x]; pz[x] = curz[x];
      }
      ssq = sum16(ssq); bon = sum16(bon);
      const float inv = 1.f / fmaxf(sqrtf(ssq), 1e-12f);
#pragma unroll
      for (int x = 0; x < 4; ++x) { kkv[x] *= inv; bb[x] = kkv[x] * av[x]; }
      ntstore2(SR + idx[t], make_uint2(cvtpk(rm[0], rm[1]), cvtpk(rm[2], rm[3])));
      ntstore2(SK + idx[t], make_uint2(cvtpk(kmod[0], kmod[1]), cvtpk(kmod[2], kmod[3])));
      ntstore2(SV + idx[t], make_uint2(cvtpk(vm[0], vm[1]), cvtpk(vm[2], vm[3])));
      ntstore2(SKK + idx[t], make_uint2(cvtpk(-kkv[0], -kkv[1]), cvtpk(-kkv[2], -kkv[3])));
      ntstore2(SB + idx[t], make_uint2(cvtpk(bb[0], bb[1]), cvtpk(bb[2], bb[3])));
      ntstore2(SZB + (size_t)row * 1024 + c, make_uint2(cvtpk(szb[0], szb[1]), cvtpk(szb[2], szb[3])));
      if ((tid & 15) == 0) BONUS[(size_t)row * 16 + hh] = bon;
    }
  }
}

template <bool SAMPLE>
DI void attn_wave(const Params& p, int sh, int qt) {
  const int lane = TIDX & 63, r = lane & 31, h = lane >> 5;
  const int hh = sh & 15, b = sh >> 4;
  bf16_t* QB = (bf16_t*)(p.ws + WS_QB);
  const int row0 = SAMPLE ? MP + b * 16 : b * 4096 + qt * 32;
  bf16_t* Qp = QB + (size_t)row0 * 1024 + hh * 64;
  const int qrow = SAMPLE ? (r < 15 ? r : 15) : r;
  bf16x8 qf[4];
#pragma unroll
  for (int s = 0; s < 4; ++s) qf[s] = *(const bf16x8*)(Qp + (size_t)qrow * 1024 + 16 * s + 8 * h);
  f32x16 z0, z1;
#pragma unroll
  for (int i = 0; i < 16; ++i) { z0[i] = 0.f; z1[i] = 0.f; }
  float carry = 1.f;
  const int ntiles = SAMPLE ? 33 : qt + 1;
  for (int it = 0; it < ntiles; ++it) {
    const bool diag = (it == 0);
    const int kt = SAMPLE ? 32 - it : qt - it;
    bf16x8 kf[4];
    {
      const float* Kp;
      if (!SAMPLE) Kp = p.out + OUT_KP + ((size_t)sh * 4096 + kt * 32 + r) * 64;
      else Kp = diag ? p.out + OUT_KS + ((size_t)sh * 16 + (r < 15 ? r : 15)) * 64 : p.in[2] + ((size_t)sh * 1024 + kt * 32 + r) * 64;
#pragma unroll
      for (int s = 0; s < 4; ++s) {
        const float4 a = *(const float4*)(Kp + 16 * s + 8 * h), bq = *(const float4*)(Kp + 16 * s + 8 * h + 4);
        u32x4 w; w[0] = cvtpk(a.x, a.y); w[1] = cvtpk(a.z, a.w); w[2] = cvtpk(bq.x, bq.y); w[3] = cvtpk(bq.z, bq.w);
        kf[s] = __builtin_bit_cast(bf16x8, w);
      }
    }
    f32x16 st;
#pragma unroll
    for (int i = 0; i < 16; ++i) st[i] = 0.f;
#pragma unroll
    for (int s = 0; s < 4; ++s) st = MFMA32(kf[s], qf[s], st);
    float keep[16], wgt[16];
#pragma unroll
    for (int i = 0; i < 16; ++i) {
      const float e = __builtin_amdgcn_exp2f(st[i]);
      const float kp = __builtin_amdgcn_rcpf(1.f + e);
      bool valid = true;
      if (diag) { const int kr = crow(i, h); valid = SAMPLE ? (kr < r && kr < 16) : (kr < r); }
      keep[i] = valid ? kp : 1.f;
      wgt[i] = valid ? 1.f - kp : 0.f;
    }
    float pp[4], hif[4];
#pragma unroll
    for (int g = 0; g < 4; ++g) {
      const float p4 = (keep[4 * g] * keep[4 * g + 1]) * (keep[4 * g + 2] * keep[4 * g + 3]);
      const auto sw = __builtin_amdgcn_permlane32_swap(__float_as_uint(p4), __float_as_uint(p4), false, false);
      const float lo = __uint_as_float(sw[0]), hi = __uint_as_float(sw[1]);
      pp[g] = lo * hi;
      hif[g] = h ? 1.f : hi;
    }
    float T[4];
    T[3] = carry; T[2] = T[3] * pp[3]; T[1] = T[2] * pp[2]; T[0] = T[1] * pp[1];
    carry = T[0] * pp[0];
#pragma unroll
    for (int g = 0; g < 4; ++g) {
      const float w3 = T[g] * hif[g], w2 = w3 * keep[4 * g + 3], w1 = w2 * keep[4 * g + 2], w0 = w1 * keep[4 * g + 1];
      wgt[4 * g + 3] *= w3; wgt[4 * g + 2] *= w2; wgt[4 * g + 1] *= w1; wgt[4 * g] *= w0;
    }
#pragma unroll
    for (int s = 0; s < 2; ++s) {
      u32x4 pw;
#pragma unroll
      for (int j = 0; j < 4; ++j) pw[j] = cvtpk(wgt[8 * s + 2 * j], wgt[8 * s + 2 * j + 1]);
      const bf16x8 pf = __builtin_bit_cast(bf16x8, pw);
#pragma unroll
      for (int db = 0; db < 2; ++db) {
        bf16x8 vf;
        {
          float vv[8];
#pragma unroll
          for (int j = 0; j < 8; ++j) {
            const int kr = 16 * s + 8 * (j >> 2) + 4 * h + (j & 3);
            const float* vp;
            if (!SAMPLE) vp = p.out + OUT_VP + ((size_t)sh * 4096 + kt * 32 + kr) * 64;
            else vp = diag ? p.out + OUT_VS + ((size_t)sh * 16 + (kr < 15 ? kr : 15)) * 64 : p.in[3] + ((size_t)sh * 1024 + kt * 32 + kr) * 64;
            vv[j] = vp[db * 32 + r];
          }
          u32x4 w; w[0] = cvtpk(vv[0], vv[1]); w[1] = cvtpk(vv[2], vv[3]); w[2] = cvtpk(vv[4], vv[5]); w[3] = cvtpk(vv[6], vv[7]);
          vf = __builtin_bit_cast(bf16x8, w);
        }
        if (db == 0) z0 = MFMA32(pf, vf, z0); else z1 = MFMA32(pf, vf, z1);
      }
    }
    if (__ballot(carry != 0.f) == 0ull) break;
  }
  const bf16_t* SZA = (const bf16_t*)(p.ws + WS_SZA);
#pragma unroll
  for (int i = 0; i < 16; ++i) {
    const int q = crow(i, h);
    if (SAMPLE && q >= 16) continue;
    const size_t o = (size_t)(row0 + q) * 1024 + hh * 64 + r;
    QB[o] = f2bf(z0[i] * bf2f(SZA[o]));
    QB[o + 32] = f2bf(z1[i] * bf2f(SZA[o + 32]));
  }
}

DI float row16_sum(float x) {
  x += dppf<0xB1>(x); x += dppf<0x4E>(x); x += dppf<0x124>(x); x += dppf<0x128>(x);
  return x;
}
DI void scan_wave(const Params& p, int shg, int slice, float* L) {
  const int lane = TIDX & 63, cc = lane & 15;
  const bool prompt = shg < 64;
  const int T = prompt ? 4096 : 16;
  const size_t base = prompt ? (size_t)shg * 4096 * 64 : (size_t)MP * 1024 + (size_t)(shg - 64) * 16 * 64;
  const int v = slice * 4 + (lane >> 4);
  const float* SW = (const float*)(p.ws + WS_SW) + base;
  const bf16_t* SARR = (const bf16_t*)(p.ws + WS_SR) + base;
  float* ORAW = (float*)(p.ws + WS_ORAW) + base;
  float4 S;
  float* wout;
  if (prompt) { S = make_float4(0.f, 0.f, 0.f, 0.f); wout = p.out + OUT_WP + ((size_t)shg * 64 + v) * 64 + 4 * cc; }
  else { S = *(const float4*)(p.in[5] + ((size_t)(shg - 64) * 64 + v) * 64 + 4 * cc); wout = p.out + OUT_WS + ((size_t)(shg - 64) * 64 + v) * 64 + 4 * cc; }
  const int nch = T / 8;
  const int dw0 = ((lane >> 4) * 6 + 2) * 64 + (lane & 15) * 4, dw1 = dw0 + 4 * 384;
  const int db = (lane >> 3) * 384 + (lane & 7) * 8;
  uint4 gw0, gw1, gr, gk, gv, gn, gb;
#define SCAN_GLOAD(ch) do { const float* w_ = SW + (size_t)(ch) * 512; gw0 = *(const uint4*)(w_ + lane * 4); gw1 = *(const uint4*)(w_ + 256 + lane * 4); \
    const bf16_t* a_ = SARR + (size_t)(ch) * 512 + lane * 8; gr = *(const uint4*)a_; gk = *(const uint4*)(a_ + SZ_ACT / 2); gv = *(const uint4*)(a_ + 2 * (SZ_ACT / 2)); \
    gn = *(const uint4*)(a_ + 3 * (SZ_ACT / 2)); gb = *(const uint4*)(a_ + 4 * (SZ_ACT / 2)); } while (0)
#define SCAN_PUT(slot, g) do { float* d_ = L + db + (slot) * 64; *(float4*)d_ = make_float4(bflo(g.x), bfhi(g.x), bflo(g.y), bfhi(g.y)); *(float4*)(d_ + 4) = make_float4(bflo(g.z), bfhi(g.z), bflo(g.w), bfhi(g.w)); } while (0)
#define SCAN_LSTORE() do { *(uint4*)(L + dw0) = gw0; *(uint4*)(L + dw1) = gw1; SCAN_PUT(4, gr); SCAN_PUT(3, gk); SCAN_PUT(5, gv); SCAN_PUT(0, gn); SCAN_PUT(1, gb); \
    asm volatile("s_waitcnt lgkmcnt(0)" ::: "memory"); } while (0)
  SCAN_GLOAD(0);
  asm volatile("s_waitcnt lgkmcnt(0)" ::: "memory");
  SCAN_LSTORE();
  for (int ch = 0; ch < nch; ++ch) {
    if (ch + 1 < nch) SCAN_GLOAD(ch + 1);
    float okeep = 0.f;
    const float* Lc = L + 4 * cc;
    float4 nk = *(const float4*)(Lc), bb = *(const float4*)(Lc + 64), ww = *(const float4*)(Lc + 128), kv = *(const float4*)(Lc + 192), rr = *(const float4*)(Lc + 256);
    float vt = L[320 + v];
#pragma unroll 4
    for (int st = 0; st < 8; ++st) {
      const int sn = ((st + 1) & 7) * 384;
      const float4 nk2 = *(const float4*)(Lc + sn), bb2 = *(const float4*)(Lc + sn + 64), ww2 = *(const float4*)(Lc + sn + 128);
      const float4 kv2 = *(const float4*)(Lc + sn + 192), rr2 = *(const float4*)(Lc + sn + 256);
      const float vt2 = L[sn + 320 + v];
      float d = (S.x * nk.x + S.y * nk.y) + (S.z * nk.z + S.w * nk.w);
      const float sa = row16_sum(d);
      S.x = S.x * ww.x + (sa * bb.x + vt * kv.x);
      S.y = S.y * ww.y + (sa * bb.y + vt * kv.y);
      S.z = S.z * ww.z + (sa * bb.z + vt * kv.z);
      S.w = S.w * ww.w + (sa * bb.w + vt * kv.w);
      float o = (S.x * rr.x + S.y * rr.y) + (S.z * rr.z + S.w * rr.w);
      o = row16_sum(o);
      okeep = (cc == st) ? o : okeep;
      nk = nk2; bb = bb2; ww = ww2; kv = kv2; rr = rr2; vt = vt2;
    }
    if (cc < 8) ORAW[(size_t)(ch * 8 + cc) * 64 + v] = okeep;
    asm volatile("s_waitcnt lgkmcnt(0)" ::: "memory");
    if (ch + 1 < nch) SCAN_LSTORE();
  }
  *(float4*)wout = S;
#undef SCAN_GLOAD
#undef SCAN_PUT
#undef SCAN_LSTORE
}

DI void sgroup_barrier(volatile LAS unsigned* cnt, unsigned target) {
  asm volatile("" ::: "memory");
  if ((TIDX & 63) == 0) __hip_atomic_fetch_add((LAS unsigned*)cnt, 1u, __ATOMIC_RELAXED, __HIP_MEMORY_SCOPE_WORKGROUP);
  while (*cnt < target) { }
  asm volatile("" ::: "memory");
}
DI void scan_group(const Params& p, int sh, int quarter, float* lds, volatile LAS unsigned* cnt, unsigned& nbar) {
  const int tid = TIDX & 255, lane = tid & 63, wid = tid >> 6, cc = lane & 15;
  const size_t base = (size_t)sh * 4096 * 64;
  const int v = quarter * 16 + wid * 4 + (lane >> 4);
  const float* SW = (const float*)(p.ws + WS_SW) + base;
  const bf16_t* SARR = (const bf16_t*)(p.ws + WS_SR) + base;
  float* ORAW = (float*)(p.ws + WS_ORAW) + base;
  f32x2 S01 = {0.f, 0.f}, S23 = {0.f, 0.f};
  const bool b0 = (lane & 1) != 0, b1 = (lane & 2) != 0;
  float4 gw0, gw1; uint4 gb0, gb1, gb2, gb3, gb4;
  const int dstw0 = ((tid >> 4) * 6 + 2) * 64 + (tid & 15) * 4, dstw1 = dstw0 + 16 * 384;
  const int dstb = (tid >> 3) * 384 + (tid & 7) * 8;
  const bf16_t* sbp = SARR + tid * 8;
#define SG_GLOAD(ch) do { const size_t o_ = (size_t)(ch) * 2048; gw0 = *(const float4*)(SW + o_ + tid * 4); gw1 = *(const float4*)(SW + o_ + 1024 + tid * 4); \
    gb0 = *(const uint4*)(sbp + o_); gb1 = *(const uint4*)(sbp + (SZ_ACT / 2) + o_); gb2 = *(const uint4*)(sbp + 2 * (SZ_ACT / 2) + o_); \
    gb3 = *(const uint4*)(sbp + 3 * (SZ_ACT / 2) + o_); gb4 = *(const uint4*)(sbp + 4 * (SZ_ACT / 2) + o_); } while (0)
#define SG_PUT(d_, g) do { *(float4*)(d_) = make_float4(bflo(g.x), bfhi(g.x), bflo(g.y), bfhi(g.y)); *(float4*)((d_) + 4) = make_float4(bflo(g.z), bfhi(g.z), bflo(g.w), bfhi(g.w)); } while (0)
#define SG_LSTORE(buf) do { float* L_ = lds + (buf) * (32 * 384); *(float4*)(L_ + dstw0) = gw0; *(float4*)(L_ + dstw1) = gw1; \
    SG_PUT(L_ + dstb + 4 * 64, gb0); SG_PUT(L_ + dstb + 3 * 64, gb1); SG_PUT(L_ + dstb + 5 * 64, gb2); SG_PUT(L_ + dstb + 0 * 64, gb3); SG_PUT(L_ + dstb + 1 * 64, gb4); } while (0)
  SG_GLOAD(0); SG_LSTORE(0); sgroup_barrier(cnt, 4u * (++nbar));
  for (int ch = 0; ch < 128; ++ch) {
    {
    const float* L = lds + (ch & 1) * (32 * 384);
    float okeep = 0.f;
    const float* Lc = L + 4 * cc;
    f32x4 nk = *(const f32x4*)(Lc), bb = *(const f32x4*)(Lc + 64), ww = *(const f32x4*)(Lc + 128), kv = *(const f32x4*)(Lc + 192), rr = *(const f32x4*)(Lc + 256);
    float vt = L[320 + v];
    if (ch + 1 < 128) SG_GLOAD(ch + 1);
    f32x4 rrp = rr;
    float po[4];
#pragma unroll
    for (int st = 0; st <= 32; ++st) {
      if (st > 0) { const f32x2 o2 = S01 * rrp.xy + S23 * rrp.zw; po[(st - 1) & 3] = o2.x + o2.y; }
      if (st > 0 && (st & 3) == 0) {
        const float u0 = (b0 ? po[1] : po[0]) + dppf<0xB1>(b0 ? po[0] : po[1]);
        const float u1 = (b0 ? po[3] : po[2]) + dppf<0xB1>(b0 ? po[2] : po[3]);
        float w = (b1 ? u1 : u0) + dppf<0x4E>(b1 ? u0 : u1);
        w += dppf<0x124>(w); w += dppf<0x128>(w);
        okeep = ((cc >> 2) == (((st >> 2) - 1) & 3)) ? w : okeep;
      }
      if (st == 16 || st == 32) ORAW[(size_t)(ch * 32 + (st - 16) + cc) * 64 + v] = okeep;
      if (st < 32) {
        const int sn = ((st + 1) & 31) * 384;
        const f32x2 d2 = S01 * nk.xy + S23 * nk.zw;
        float x = d2.x + d2.y;
        const f32x2 vt_2 = {vt, vt};
        const f32x2 t01 = vt_2 * kv.xy, t23 = vt_2 * kv.zw;
        __builtin_amdgcn_sched_barrier(0);
        x += dppf<0xB1>(x);
        const f32x4 nk2 = *(const f32x4*)(Lc + sn), bb2 = *(const f32x4*)(Lc + sn + 64);
        __builtin_amdgcn_sched_barrier(0);
        x += dppf<0x4E>(x);
        const f32x4 ww2 = *(const f32x4*)(Lc + sn + 128), kv2 = *(const f32x4*)(Lc + sn + 192);
        __builtin_amdgcn_sched_barrier(0);
        x += dppf<0x124>(x);
        const f32x4 rr2 = *(const f32x4*)(Lc + sn + 256);
        const float vt2 = L[sn + 320 + v];
        __builtin_amdgcn_sched_barrier(0);
        x += dppf<0x128>(x);
        __builtin_amdgcn_sched_barrier(0);
        const f32x2 sa2 = {x, x};
        S01 = S01 * ww.xy + (sa2 * bb.xy + t01);
        S23 = S23 * ww.zw + (sa2 * bb.zw + t23);
        rrp = rr;
        nk = nk2; bb = bb2; ww = ww2; kv = kv2; rr = rr2; vt = vt2;
      }
    }
    }
    if (ch + 1 < 128) SG_LSTORE((ch + 1) & 1);
    sgroup_barrier(cnt, 4u * (++nbar));
  }
  *(float4*)(p.out + OUT_WP + ((size_t)sh * 64 + v) * 64 + 4 * cc) = make_float4(S01.x, S01.y, S23.x, S23.y);
#undef SG_GLOAD
#undef SG_PUT
#undef SG_LSTORE
}

constexpr int NQ_ATT_P = 8192, NQ_ATT_S = 512, NQ_SCAN_S = 8192, NQ_DYN = NQ_ATT_P + NQ_ATT_S + NQ_SCAN_S;
DI int wave_grab(unsigned* ctr) { int v = 0; if ((TIDX & 63) == 0) v = (int)atomicAdd(ctr, 1u); return __builtin_amdgcn_readfirstlane(v); }
DI void phase2(const Params& p, char* smem) {
  __shared__ unsigned s_cnt;
  unsigned* ctl = (unsigned*)(p.ws + WS_CTL);
  const int wid = TIDX >> 6;
  if (TIDX == 0) s_cnt = 0u;
  __syncthreads();
  float* Lsh = (float*)smem + 4 * (8 * 384);
  float* L = wid >= 4 ? (float*)smem + (wid - 4) * (8 * 384) : Lsh + wid * (8 * 384);
  if (wid < 4) {
    unsigned nbar = 0;
    __builtin_amdgcn_s_setprio(3);
    for (int bu = blockIdx.x; bu < 256; bu += gridDim.x) {
      const int xs = bu & 7, slot = bu >> 3, head = xs * 8 + (slot >> 2), quarter = slot & 3;
      scan_group(p, head, quarter, Lsh, (volatile LAS unsigned*)&s_cnt, nbar);
    }
    __builtin_amdgcn_s_setprio(0);
  }
  for (;;) {
    int u = wave_grab(&ctl[0]);
    if (u >= NQ_DYN) break;
    if (u < NQ_ATT_P) { attn_wave<false>(p, u >> 7, u & 127); continue; }
    u -= NQ_ATT_P;
    if (u < NQ_ATT_S) { attn_wave<true>(p, u, 0); continue; }
    u -= NQ_ATT_S;
    scan_wave(p, 64 + (u >> 4), u & 15, L);
  }
}

DI void p2c_row(const Params& p, int row, int c, int hh, const float4& lg, const float4& lb, const float4& o, const uint2& vv, const uint2& zz, float bon) {
  const float mean = sum16((o.x + o.y) + (o.z + o.w)) * (1.f / 64.f);
  const float dx = o.x - mean, dy = o.y - mean, dz = o.z - mean, dw = o.w - mean;
  const float var = sum16((dx * dx + dy * dy) + (dz * dz + dw * dw)) * (1.f / 64.f);
  const float inv = rsqrtf(var + LNX_EPS);
  const float r0 = (dx * inv * lg.x + lb.x + bon * bflo(vv.x)) * bflo(zz.x);
  const float r1 = (dy * inv * lg.y + lb.y + bon * bfhi(vv.x)) * bfhi(zz.x);
  const float r2 = (dz * inv * lg.z + lb.z + bon * bflo(vv.y)) * bflo(zz.y);
  const float r3 = (dw * inv * lg.w + lb.w + bon * bfhi(vv.y)) * bfhi(zz.y);
  *(uint2*)((bf16_t*)(p.ws + WS_OB) + (size_t)row * 1024 + c) = make_uint2(cvtpk(r0, r1), cvtpk(r2, r3));
}
DI void phase2c(const Params& p) {
  const int tid = TIDX & 255, half = TIDX >> 8, c = tid * 4, hh = c >> 6;
  const float4 lg = *(const float4*)(p.in[16] + c), lb = *(const float4*)(p.in[17] + c);
  const float* ORAW = (const float*)(p.ws + WS_ORAW); const bf16_t* SV = (const bf16_t*)(p.ws + WS_SV);
  const bf16_t* SZB = (const bf16_t*)(p.ws + WS_SZB); const float* BONUS = (const float*)(p.ws + WS_BONUS);
  const int stride = gridDim.x * 2;
  for (int row = blockIdx.x * 2 + half; row < MT; row += 2 * stride) {
    const bool two = row + stride < MT;
    const int rowb = two ? row + stride : row;
    const size_t ia = hm_base(row) + hh * hm_hstride(row) + (c & 63), ib = hm_base(rowb) + hh * hm_hstride(rowb) + (c & 63);
    const float4 oa = *(const float4*)(ORAW + ia), ob = *(const float4*)(ORAW + ib);
    const uint2 va = *(const uint2*)(SV + ia), vb = *(const uint2*)(SV + ib);
    const uint2 za = *(const uint2*)(SZB + (size_t)row * 1024 + c), zb = *(const uint2*)(SZB + (size_t)rowb * 1024 + c);
    const float ba = BONUS[(size_t)row * 16 + hh], bb = BONUS[(size_t)rowb * 16 + hh];
    p2c_row(p, row, c, hh, lg, lb, oa, va, za, ba);
    if (two) p2c_row(p, rowb, c, hh, lg, lb, ob, vb, zb, bb);
  }
}

DI void phase4(const Params& p) {
  const int lane = TIDX & 63, wid = TIDX >> 6;
  const float* g = p.in[21];
  float4 gg[4];
#pragma unroll
  for (int i = 0; i < 4; ++i) gg[i] = *(const float4*)(g + i * 256 + lane * 4);
  const int stride = gridDim.x * 8;
  for (int row = blockIdx.x * 8 + wid; row < MT; row += 2 * stride) {
    const bool two = row + stride < MT;
    float* x0 = p.out + OUT_YP + (size_t)row * 1024;
    float* x1 = p.out + OUT_YP + (size_t)(two ? row + stride : row) * 1024;
    float4 v0[4], v1[4]; float s0 = 0.f, s1 = 0.f;
#pragma unroll
    for (int i = 0; i < 4; ++i) { v0[i] = *(const float4*)(x0 + i * 256 + lane * 4); v1[i] = *(const float4*)(x1 + i * 256 + lane * 4); }
#pragma unroll
    for (int i = 0; i < 4; ++i) {
      s0 += v0[i].x * v0[i].x + v0[i].y * v0[i].y + v0[i].z * v0[i].z + v0[i].w * v0[i].w;
      s1 += v1[i].x * v1[i].x + v1[i].y * v1[i].y + v1[i].z * v1[i].z + v1[i].w * v1[i].w;
    }
    s0 = wave_sum(s0); s1 = wave_sum(s1);
    const float i0 = rsqrtf(s0 * (1.f / DM) + EPS), i1 = rsqrtf(s1 * (1.f / DM) + EPS);
#pragma unroll
    for (int i = 0; i < 4; ++i) *(float4*)(x0 + i * 256 + lane * 4) = make_float4(v0[i].x * i0 * gg[i].x, v0[i].y * i0 * gg[i].y, v0[i].z * i0 * gg[i].z, v0[i].w * i0 * gg[i].w);
    if (two) {
#pragma unroll
      for (int i = 0; i < 4; ++i) *(float4*)(x1 + i * 256 + lane * 4) = make_float4(v1[i].x * i1 * gg[i].x, v1[i].y * i1 * gg[i].y, v1[i].z * i1 * gg[i].z, v1[i].w * i1 * gg[i].w);
    }
  }
}

#define XB_TMO      128
#define XB_XCNT(j)  (256  + 64 * (j))
#define XB_XSUB(j)  (1280 + 64 * (j))
#define XB_XGEN(j)  (2304 + 64 * (j))
#define XB_TOP      3328
#define XB_TOPGEN   3392
#define XCD_BAR_WORDS 3456
#define XB_SPIN_CAP (1u << 18)

__device__ __forceinline__ unsigned xb_ld(unsigned* p)              { return __hip_atomic_load(p, __ATOMIC_RELAXED, __HIP_MEMORY_SCOPE_AGENT); }
__device__ __forceinline__ unsigned xb_add(unsigned* p, unsigned v) { return __hip_atomic_fetch_add(p, v, __ATOMIC_RELAXED, __HIP_MEMORY_SCOPE_AGENT); }
__device__ __forceinline__ unsigned xb_xcc_id() { return (unsigned)__builtin_amdgcn_s_getreg((3 << 11) | 20) & 0xFu; }
#define XB_SPIN(cond, bar) do { unsigned _sp = 0; while (cond) { __builtin_amdgcn_s_sleep(1); \
    if ((++_sp & 255u) == 0u) { if (xb_ld(&(bar)[XB_TMO])) break; if (_sp > XB_SPIN_CAP) { atomicAdd(&(bar)[XB_TMO], 1u); break; } } } } while (0)

struct XcdBarrier {
    unsigned* bar; unsigned x;
    volatile LAS unsigned* st;
};

__device__ __forceinline__ XcdBarrier xcd_barrier_post(unsigned* bar, volatile LAS unsigned* st) {
    XcdBarrier b; b.bar = bar; b.x = xb_xcc_id(); b.st = st;
    if (TIDX == 0) (void)xb_add(&bar[XB_XCNT(b.x)], 1u);
    return b;
}
__device__ __forceinline__ void xcd_barrier_complete(unsigned* bar, unsigned x, unsigned& nloc, unsigned& nx) {
    const unsigned G = gridDim.x * gridDim.y * gridDim.z;
    unsigned sum, cnt, mine, sp = 0u;
    for (;;) {
        sum = 0u; cnt = 0u; mine = 0u;
#pragma unroll
        for (unsigned j = 0; j < 16; ++j) { const unsigned c = xb_ld(&bar[XB_XCNT(j)]); sum += c; cnt += (c > 0u) ? 1u : 0u; mine = (j == x) ? c : mine; }
        if (sum == G) break;
        __builtin_amdgcn_s_sleep(1);
        if ((++sp & 255u) == 0u) { if (xb_ld(&bar[XB_TMO])) break; if (sp > XB_SPIN_CAP) { atomicAdd(&bar[XB_TMO], 1u); break; } }
    }
    nloc = mine > 0u ? mine : 1u; nx = cnt > 0u ? cnt : 1u;
}

__device__ __forceinline__ void xcd_barrier(const XcdBarrier& b) {
    asm volatile("s_waitcnt vmcnt(0)" ::: "memory");
    __syncthreads();
    if (TIDX == 0) {
        unsigned* bar = b.bar;
        __builtin_amdgcn_s_waitcnt(0);
        unsigned nloc = b.st[0], nx = b.st[1];
        if (nloc == 0u) { xcd_barrier_complete(bar, b.x, nloc, nx); b.st[0] = nloc; b.st[1] = nx; }
        const unsigned old = xb_add(&bar[XB_XSUB(b.x)], 1u);
        const unsigned gen = old / nloc;
        if (old + 1u == (gen + 1u) * nloc) {
            __builtin_amdgcn_fence(__ATOMIC_RELEASE, "agent");
            asm volatile("s_waitcnt vmcnt(0)" ::: "memory");
            const unsigned og = xb_add(&bar[XB_TOP], 1u);
            const unsigned tg = og / nx;
            if (og + 1u == (tg + 1u) * nx) xb_add(&bar[XB_TOPGEN], 1u);
            else XB_SPIN(xb_ld(&bar[XB_TOPGEN]) == tg, bar);
            __builtin_amdgcn_fence(__ATOMIC_ACQUIRE, "agent");
            xb_add(&bar[XB_XGEN(b.x)], 1u);
            asm volatile("s_waitcnt vmcnt(0)" ::: "memory");
        } else {
            XB_SPIN(xb_ld(&bar[XB_XGEN(b.x)]) == gen, bar);
            __builtin_amdgcn_fence(__ATOMIC_ACQUIRE, "agent");
            asm volatile("s_waitcnt vmcnt(0)" ::: "memory");
        }
    }
    __syncthreads();
}

__global__ void __launch_bounds__(NT, 2) mega(Params p) {
  extern __shared__ __attribute__((aligned(16))) char smem[];
  cg::grid_group grid = cg::this_grid();
  if (blockIdx.x == 0) { unsigned* ctl = (unsigned*)(p.ws + WS_CTL); for (int i = TIDX; i < 16384; i += NT) ctl[i] = 0u; }
  grid.sync();
  __shared__ unsigned xb_st[2];
  if (TIDX == 0) { xb_st[0] = 0u; xb_st[1] = 0u; }
  __syncthreads();
  (void)xcd_barrier_post((unsigned*)(p.ws + WS_CTL) + 8192, (volatile LAS unsigned*)xb_st);
#define XBAR() do { XcdBarrier xb_; xb_.bar = (unsigned*)(p.ws + WS_CTL) + 8192; xb_.x = xb_xcc_id(); xb_.st = (volatile LAS unsigned*)xb_st; xcd_barrier(xb_); } while (0)
  phase0(p, smem);
  XBAR();
  { EpiP1 E; E.p = p; run_gemm(smem, (const bf16_t*)(p.ws + WS_H), (const bf16_t*)(p.ws + WS_WINT), MT, NINP, E); }
  XBAR();
  phase_x(p);
  XBAR();
  { EpiLora E; E.p = p; run_gemm(smem, (const bf16_t*)(p.ws + WS_X), (const bf16_t*)(p.ws + WS_BTL), MP, 2048, E, 256); }
  small_lora(p);
  XBAR();
  phase1c(p);
  XBAR();
  phase2(p, smem);
  XBAR();
  phase2c(p);
  XBAR();
  { EpiGate E; E.p = p; E.goff = 0; E.first = true; run_gemm(smem, (const bf16_t*)(p.ws + WS_QB), (const bf16_t*)(p.ws + WS_WT), MP, 1024, E); }
  small_gemm<0>(p, (const bf16_t*)(p.ws + WS_QB), (const bf16_t*)(p.ws + WS_WT));
  { EpiGate E; E.p = p; E.goff = 1024; E.first = false; run_gemm(smem, (const bf16_t*)(p.ws + WS_OB), (const bf16_t*)(p.ws + WS_WT) + (size_t)1024 * 1024, MP, 1024, E); }
  small_gemm<1>(p, (const bf16_t*)(p.ws + WS_OB), (const bf16_t*)(p.ws + WS_WT) + (size_t)1024 * 1024);
  XBAR();
  { EpiOut E; E.p = p; run_gemm(smem, (const bf16_t*)(p.ws + WS_MG), (const bf16_t*)(p.ws + WS_WT) + (size_t)2 * 1024 * 1024, MP, 1024, E); }
  small_gemm<2>(p, (const bf16_t*)(p.ws + WS_MG), (const bf16_t*)(p.ws + WS_WT) + (size_t)2 * 1024 * 1024);
  XBAR();
  phase4(p);
}

extern "C" void kernel_launch(void* const* d_in, const int* in_sizes, int n_in, void* d_out, int out_size, void* d_ws, size_t ws_size, hipStream_t stream) {
  static int grid_blocks = 0;
  if (grid_blocks == 0) {
    if (n_in != 22 || ws_size < WS_END) { fprintf(stderr, "kernel_launch: unexpected n_in %d / ws_size %zu (need %zu)\n", n_in, ws_size, (size_t)WS_END); grid_blocks = -1; return; }
    int dev = 0, cus = 0, per_cu = 0;
    (void)hipGetDevice(&dev);
    (void)hipDeviceGetAttribute(&cus, hipDeviceAttributeMultiprocessorCount, dev);
    (void)hipFuncSetAttribute((const void*)mega, hipFuncAttributeMaxDynamicSharedMemorySize, SMEM_BYTES);
    (void)hipOccupancyMaxActiveBlocksPerMultiprocessor(&per_cu, (const void*)mega, NT, SMEM_BYTES);
    (void)hipGetLastError();
    grid_blocks = cus;
  }
  if (grid_blocks < 0) return;
  Params p{};
  for (int i = 0; i < 22; ++i) p.in[i] = (const float*)d_in[i];
  p.out = (float*)d_out; p.ws = (unsigned char*)d_ws;
  void* args[] = {&p};
  hipError_t e = hipLaunchCooperativeKernel((const void*)mega, dim3(grid_blocks), dim3(NT), args, SMEM_BYTES, stream);
  if (e != hipSuccess) fprintf(stderr, "cooperative launch failed: %s (grid %d)\n", hipGetErrorString(e), grid_blocks);
}
```

```cpp
#include <hip/hip_runtime.h>
#include <hip/hip_cooperative_groups.h>
#include <cstdio>
#include <cstdint>
namespace cg = cooperative_groups;
__device__ __forceinline__ int lane_id_() { return (int)__builtin_amdgcn_mbcnt_hi(~0u, __builtin_amdgcn_mbcnt_lo(~0u, 0u)); }
#define TIDX (__builtin_amdgcn_readfirstlane((int)(threadIdx.x >> 6)) * 64 + lane_id_())

namespace pg8 {
#define PG8_LAS __attribute__((address_space(3)))
typedef unsigned short bf16_t;
typedef short bf16x8 __attribute__((ext_vector_type(8)));
typedef float f32x4 __attribute__((ext_vector_type(4)));
typedef unsigned u32x4 __attribute__((ext_vector_type(4)));
constexpr int BM = 256, BK = 64, HALF = 128, HTB = HALF * BK * 2  , STAGE_BYTES = 8 * HTB, NXCD = 8, WGM = 8;

__host__ __device__ __forceinline__ int lds_byte(int r, int c) { const int st = (r >> 4) * 2 + (c >> 5), rr = r & 15, cc = c & 31, ob = rr * 64 + cc * 2; return st * 1024 + (ob ^ (((ob >> 9) & 1) << 5)); }
__host__ __device__ __forceinline__ void stage_rc(int b, int& R, int& C) { const int st = b / 1024, sb = b % 1024, swz = sb ^ (((sb >> 9) & 1) << 5); R = (st >> 1) * 16 + swz / 64; C = (st & 1) * 32 + (swz % 64) / 2; }
__host__ __device__ __forceinline__ int perm32(int rho) { const int n = rho >> 4, i = rho & 15; return 8 * (i >> 2) + 4 * n + (i & 3); }

struct Unit { int pm, pn; };
struct Gemm { const bf16_t* A; const bf16_t* Bt; int M, N, K; };

struct StaticOrder {
    int nM, nN, nwg, G, c;
    __host__ __device__ void init(int M, int N, int G_, int c_) { nM = M / BM; nN = N / BM; nwg = nM * nN; G = G_; c = c_; }
    __host__ __device__ bool next(int i, Unit& u) const {
        const long L = (long)i * G + c; if (L >= nwg) return false;
        int wgid = (int)L; { const int q = nwg / NXCD, r = nwg % NXCD, xcd = wgid % NXCD, off = wgid / NXCD; wgid = (xcd < r ? xcd * (q + 1) : r * (q + 1) + (xcd - r) * q) + off; }
        const int nig = WGM * nN, gid = wgid / nig, fm = gid * WGM, gsz = (nM - fm) < WGM ? (nM - fm) : WGM;
        u.pm = fm + ((wgid % nig) % gsz); u.pn = (wgid % nig) / gsz; return true;
    }
    __device__ __forceinline__ void a_ready(const Unit&) const {}
    __device__ __forceinline__ void done(const Unit&) const {}
};


template <class Epi, class Sched, bool ALIGN_EPI = false, bool SP2 = false>
__device__ __forceinline__ void gemm_phase(PG8_LAS unsigned char* lds, const Gemm g, const Sched& S, const Epi& E) {
    int tid_ = TIDX; asm volatile("" : "+v"(tid_));
    const int tid = tid_, wid = __builtin_amdgcn_readfirstlane(tid >> 6), lane = tid & 63, wr = wid >> 2, wc = wid & 3, fr = lane & 15, fq = lane >> 4;
    const int K = g.K, nt = K / BK;
    unsigned voffA[2], voffB[2];
#pragma unroll
    for (int i = 0; i < 2; ++i) { int R, C; stage_rc(tid * 16 + i * 8192, R, C); const int Rb = Epi::PERM ? ((R & ~31) + perm32(R & 31)) : R;
        voffA[i] = (unsigned)(R * K + C) * 2u; voffB[i] = (unsigned)(Rb * K + C) * 2u; }
    const size_t kstep = (size_t)(BK * 2);
    const size_t hstep = (size_t)HALF * K * 2;
    const size_t tstep = 2 * hstep;
    const unsigned ldsw = (unsigned)wid * 1024u;
    const int aoff = lds_byte(wr * 64 + fr, fq * 8), boff = lds_byte(wc * 32 + fr, fq * 8);
#define PG8_SA(b, h) (((b) * 2 + (h)) * HTB)
#define PG8_SB(b, h) ((4 + (b) * 2 + (h)) * HTB)
#define PG8_STAGE(bufoff, gbase, voff) do { _Pragma("unroll") for (int _i = 0; _i < 2; ++_i) \
        __builtin_amdgcn_global_load_lds((const unsigned*)((const char*)(gbase) + (voff)[_i]), (PG8_LAS unsigned*)(lds + (bufoff) + ldsw + _i * 8192), 16, 0, 0); } while (0)
#define PG8_LDA(dst, b, h) do { _Pragma("unroll") for (int m = 0; m < 4; ++m) _Pragma("unroll") for (int k = 0; k < 2; ++k) dst[m][k] = *(const PG8_LAS bf16x8*)(lds + PG8_SA(b, h) + aoff + m * 2048 + k * 1024); } while (0)
#define PG8_LDB(dst, b, h) do { _Pragma("unroll") for (int n = 0; n < 2; ++n) _Pragma("unroll") for (int k = 0; k < 2; ++k) dst[n][k] = *(const PG8_LAS bf16x8*)(lds + PG8_SB(b, h) + boff + n * 2048 + k * 1024); } while (0)
#define PG8_MMA(ai, bj, At, Bt) do { __builtin_amdgcn_s_setprio(1); _Pragma("unroll") for (int m = 0; m < 4; ++m) _Pragma("unroll") for (int n = 0; n < 2; ++n) _Pragma("unroll") for (int k = 0; k < 2; ++k) \
        acc[ai][bj][m][n] = __builtin_amdgcn_mfma_f32_16x16x32_bf16(Bt[n][k], At[m][k], acc[ai][bj][m][n], 0, 0, 0); __builtin_amdgcn_s_setprio(0); } while (0)
#define PG8_WAIT_V(n) asm volatile("s_waitcnt vmcnt(" #n ")" ::: "memory")
#define PG8_WAIT_L(n) asm volatile("s_waitcnt lgkmcnt(" #n ")" ::: "memory")
#define PG8_BAR __builtin_amdgcn_s_barrier()
#define PG8_SCHED __builtin_amdgcn_sched_barrier(0)
    Unit cur, nxt; int ui = 0;
    if (!S.next(0, cur)) return;
    f32x4 acc[2][2][4][2];
#pragma unroll
    for (int a = 0; a < 2; ++a)
#pragma unroll
        for (int b = 0; b < 2; ++b)
#pragma unroll
            for (int m = 0; m < 4; ++m)
#pragma unroll
                for (int n = 0; n < 2; ++n) acc[a][b][m][n] = (f32x4){0.f, 0.f, 0.f, 0.f};
    bf16x8 At[4][2], B0[2][2], B1[2][2];
    const char* cA = (const char*)g.A + (size_t)cur.pm * tstep; const char* cB = (const char*)g.Bt + (size_t)cur.pn * tstep;
    S.a_ready(cur);
    if constexpr (SP2) {
        PG8_STAGE(PG8_SB(0, 0), cB, voffB); PG8_STAGE(PG8_SB(0, 1), cB + hstep, voffB); PG8_STAGE(PG8_SA(0, 0), cA, voffA); PG8_STAGE(PG8_SA(0, 1), cA + hstep, voffA);
        if (wr == 1) PG8_BAR;
        PG8_WAIT_V(2); PG8_BAR;
        PG8_STAGE(PG8_SB(1, 0), cB + kstep, voffB); PG8_STAGE(PG8_SA(1, 0), cA + kstep, voffA); PG8_STAGE(PG8_SB(1, 1), cB + hstep + kstep, voffB);
        PG8_WAIT_V(6); PG8_BAR;
    } else {
        PG8_STAGE(PG8_SB(0, 0), cB, voffB); PG8_STAGE(PG8_SA(0, 0), cA, voffA); PG8_STAGE(PG8_SB(0, 1), cB + hstep, voffB); PG8_STAGE(PG8_SA(0, 1), cA + hstep, voffA);
        if (wr == 1) PG8_BAR;
        PG8_WAIT_V(4); PG8_BAR;
        PG8_STAGE(PG8_SB(1, 0), cB + kstep, voffB); PG8_STAGE(PG8_SA(1, 0), cA + kstep, voffA); PG8_STAGE(PG8_SB(1, 1), cB + hstep + kstep, voffB);
        PG8_WAIT_V(6); PG8_BAR;
    }
    for (;;) {
        const bool has_next = S.next(ui + 1, nxt);
        const char* nA = has_next ? (const char*)g.A + (size_t)nxt.pm * tstep : cA; const char* nB = has_next ? (const char*)g.Bt + (size_t)nxt.pn * tstep : cB;
        for (int t = 0; t < nt; t += 2) {
            const bool last = (t == nt - 2);
            const char* a1 = cA + (size_t)(t + 1) * kstep;
            const char* a2 = last ? nA : cA + (size_t)(t + 2) * kstep; const char* b2 = last ? nB : cB + (size_t)(t + 2) * kstep;
            const char* a3 = a2 + kstep; const char* b3 = b2 + kstep;
            if (last && has_next) S.a_ready(nxt);
            if constexpr (SP2) {
            PG8_LDB(B0, 0, 0); PG8_LDB(B1, 0, 1); PG8_SCHED; PG8_LDA(At, 0, 0); PG8_STAGE(PG8_SA(1, 1), a1 + hstep, voffA);
            PG8_WAIT_V(8); PG8_WAIT_L(0); PG8_BAR; PG8_MMA(0, 0, At, B0); PG8_MMA(0, 1, At, B1); PG8_BAR; PG8_SCHED;
            PG8_LDA(At, 0, 1); PG8_STAGE(PG8_SB(0, 0), b2, voffB); PG8_STAGE(PG8_SB(0, 1), b2 + hstep, voffB); PG8_STAGE(PG8_SA(0, 0), a2, voffA);
            PG8_WAIT_V(8); PG8_WAIT_L(0); PG8_BAR; PG8_MMA(1, 0, At, B0); PG8_MMA(1, 1, At, B1); PG8_BAR; PG8_SCHED;
            PG8_LDB(B0, 1, 0); PG8_LDB(B1, 1, 1); PG8_SCHED; PG8_LDA(At, 1, 0); PG8_STAGE(PG8_SA(0, 1), a2 + hstep, voffA);
            PG8_WAIT_V(8); PG8_WAIT_L(0); PG8_BAR; PG8_MMA(0, 0, At, B0); PG8_MMA(0, 1, At, B1); PG8_BAR; PG8_SCHED;
            PG8_LDA(At, 1, 1); PG8_STAGE(PG8_SB(1, 0), b3, voffB); PG8_STAGE(PG8_SB(1, 1), b3 + hstep, voffB); PG8_STAGE(PG8_SA(1, 0), a3, voffA);
            PG8_WAIT_V(8); PG8_WAIT_L(0); PG8_BAR; PG8_MMA(1, 0, At, B0); PG8_MMA(1, 1, At, B1); PG8_BAR; PG8_SCHED;
            } else {
            PG8_LDB(B0, 0, 0); PG8_SCHED; PG8_LDA(At, 0, 0); PG8_STAGE(PG8_SA(1, 1), a1 + hstep, voffA);
            PG8_WAIT_L(8); PG8_BAR; PG8_WAIT_L(0); PG8_MMA(0, 0, At, B0); PG8_BAR; PG8_SCHED;
            PG8_LDB(B1, 0, 1); PG8_STAGE(PG8_SB(0, 0), b2, voffB);
            PG8_BAR; PG8_WAIT_L(0); PG8_MMA(0, 1, At, B1); PG8_BAR;
            PG8_LDA(At, 0, 1); PG8_STAGE(PG8_SA(0, 0), a2, voffA);
            PG8_BAR; PG8_WAIT_L(0); PG8_MMA(1, 0, At, B0); PG8_BAR; PG8_SCHED;
            PG8_STAGE(PG8_SB(0, 1), b2 + hstep, voffB);
            PG8_WAIT_V(6); PG8_BAR; PG8_MMA(1, 1, At, B1); PG8_BAR;
            PG8_LDB(B0, 1, 0); PG8_SCHED; PG8_LDA(At, 1, 0); PG8_STAGE(PG8_SA(0, 1), a2 + hstep, voffA);
            PG8_WAIT_L(8); PG8_BAR; PG8_WAIT_L(0); PG8_MMA(0, 0, At, B0); PG8_BAR; PG8_SCHED;
            PG8_LDB(B1, 1, 1); PG8_STAGE(PG8_SB(1, 0), b3, voffB);
            PG8_BAR; PG8_WAIT_L(0); PG8_MMA(0, 1, At, B1); PG8_BAR;
            PG8_LDA(At, 1, 1); PG8_STAGE(PG8_SA(1, 0), a3, voffA);
            PG8_BAR; PG8_WAIT_L(0); PG8_MMA(1, 0, At, B0); PG8_BAR; PG8_SCHED;
            PG8_STAGE(PG8_SB(1, 1), b3 + hstep, voffB);
            PG8_WAIT_V(6); PG8_BAR; PG8_MMA(1, 1, At, B1); PG8_BAR;
            }
        }
        if constexpr (ALIGN_EPI) { if (wr == 0) PG8_BAR; }
        if constexpr (!Epi::AFTER_DRAIN) { E(acc, cur, wr, wc, fr, fq); S.done(cur); }
        if (!has_next) break;
#pragma unroll
        for (int a = 0; a < 2; ++a)
#pragma unroll
            for (int b = 0; b < 2; ++b)
#pragma unroll
                for (int m = 0; m < 4; ++m)
#pragma unroll
                    for (int n = 0; n < 2; ++n) acc[a][b][m][n] = (f32x4){0.f, 0.f, 0.f, 0.f};
        cur = nxt; cA = nA; cB = nB; ++ui;
        if constexpr (ALIGN_EPI) { if (wr == 1) PG8_BAR; }
    }
    PG8_WAIT_V(0);
    if constexpr (!ALIGN_EPI) { if (wr == 0) PG8_BAR; }
    PG8_BAR;
    if constexpr (Epi::AFTER_DRAIN) { E.fused(acc, cur, wr, wc, fr, fq, lds, wid, lane); S.done(cur); }
#undef PG8_SA
#undef PG8_SB
#undef PG8_STAGE
#undef PG8_LDA
#undef PG8_LDB
#undef PG8_MMA
#undef PG8_WAIT_V
#undef PG8_WAIT_L
#undef PG8_BAR
#undef PG8_SCHED
}
}


#define DI __device__ __forceinline__
typedef unsigned short bf16_t;
typedef short bf16x8 __attribute__((ext_vector_type(8)));
typedef float f32x4 __attribute__((ext_vector_type(4)));
typedef float f32x2 __attribute__((ext_vector_type(2)));
typedef float f32x16 __attribute__((ext_vector_type(16)));
typedef unsigned u32x4 __attribute__((ext_vector_type(4)));
#define MFMA32(a, b, c) __builtin_amdgcn_mfma_f32_32x32x16_bf16((a), (b), (c), 0, 0, 0)
#define LAS __attribute__((address_space(3)))

constexpr int NT = 512;
constexpr int DM = 1024, MP = 16384, MT = 16896;
constexpr int NIN = 10368, NINP = 10496, CSH = 4224;
constexpr float EPS = 1e-6f, LNX_EPS = 64e-5f;
constexpr float QSCALE = 0.18033688011112042f;

constexpr size_t OUT_YP = 0, OUT_KP = 17301504, OUT_VP = 34078720, OUT_SHP = 50855936, OUT_WP = 50872832,
                 OUT_KS = 51134976, OUT_VS = 51659264, OUT_SHS = 52183552, OUT_WS = 52318720;

constexpr size_t SZ_ACT = (size_t)MT * 1024 * 2;
constexpr size_t WS_R1 = 0;
constexpr size_t WS_H = WS_R1, WS_WINT = WS_R1 + SZ_ACT, WS_SW = WS_R1;
constexpr size_t WS_R2 = (size_t)MT * 1024 * 4;
constexpr size_t WS_PB = WS_R2, WS_ORAW = WS_R2, WS_OB = WS_ORAW + (size_t)MT * 1024 * 4, WS_MG = WS_OB + SZ_ACT;
constexpr size_t WS_R3 = WS_R2 + (size_t)MT * CSH * 2;
constexpr size_t WS_QB = WS_R3, WS_X = WS_QB + SZ_ACT  , WS_BTL = WS_X + (size_t)MT * 256 * 2  , WS_SZA = WS_X + (size_t)MP * 1024 * 2;
static_assert(WS_BTL + (size_t)2048 * 256 * 2 <= WS_SZA, "LoRA buffers");
constexpr size_t WS_SR = WS_SZA + SZ_ACT, WS_SK = WS_SR + SZ_ACT, WS_SV = WS_SK + SZ_ACT, WS_SKK = WS_SV + SZ_ACT, WS_SB = WS_SKK + SZ_ACT;
constexpr size_t WS_SZB = WS_SB + SZ_ACT;
constexpr size_t WS_BONUS = WS_SZB + SZ_ACT;
constexpr size_t WS_WT = WS_BONUS + (size_t)MT * 16 * 4;
constexpr size_t WS_CTL = WS_WT + 3 * (size_t)1024 * 1024 * 2;
constexpr size_t WS_END = WS_CTL + 65536;
static_assert(WS_MG + SZ_ACT <= WS_R3, "R2 overflow");
static_assert(WS_WINT + (size_t)NINP * 1024 * 2 <= WS_R2, "R1 overflow");
static_assert(WS_END <= (size_t)512 * 1024 * 1024, "workspace");

constexpr int SMEM_BYTES = 147456;

struct Params { const float* in[22]; float* out; unsigned char* ws; };

DI float bf2f(bf16_t u) { return __uint_as_float((unsigned)u << 16); }
DI unsigned cvtpk(float lo, float hi) { unsigned r; asm volatile("v_cvt_pk_bf16_f32 %0, %1, %2" : "=v"(r) : "v"(lo), "v"(hi)); return r; }
DI bf16_t f2bf(float x) { return (bf16_t)(cvtpk(x, 0.f) & 0xffffu); }
DI float bflo(unsigned u) { return __uint_as_float(u << 16); }
DI float bfhi(unsigned u) { return __uint_as_float(u & 0xffff0000u); }
DI int crow(int i, int h) { return (i & 3) + 8 * (i >> 2) + 4 * h; }
DI float sigmoidf_(float x) { return fminf(__builtin_amdgcn_rcpf(1.f + __expf(-x)), 1.f); }
typedef unsigned u32x2 __attribute__((ext_vector_type(2)));
DI uint2 ntload2(const void* q) { const u32x2 v = __builtin_nontemporal_load((const u32x2*)q); return make_uint2(v.x, v.y); }
DI void ntstore2(void* q, uint2 v) { const u32x2 t = {v.x, v.y}; __builtin_nontemporal_store(t, (u32x2*)q); }
DI uint4 pack8(f32x4 a, f32x4 b) { return make_uint4(cvtpk(a[0], a[1]), cvtpk(a[2], a[3]), cvtpk(b[0], b[1]), cvtpk(b[2], b[3])); }
template <int CTRL> DI float dppf(float x) { return __builtin_bit_cast(float, __builtin_amdgcn_mov_dpp(__builtin_bit_cast(int, x), CTRL, 0xf, 0xf, true)); }
DI float sum16(float x) { x += dppf<0xB1>(x); x += dppf<0x4E>(x); x += dppf<0x124>(x); x += dppf<0x128>(x); return x; }
DI float wave_sum(float x) {
  x = sum16(x);
  const auto s = __builtin_amdgcn_permlane16_swap(__float_as_uint(x), __float_as_uint(x), false, false);
  x = __uint_as_float(s[0]) + __uint_as_float(s[1]);
  const auto t = __builtin_amdgcn_permlane32_swap(__float_as_uint(x), __float_as_uint(x), false, false);
  return __uint_as_float(t[0]) + __uint_as_float(t[1]);
}
DI float row32_sum(float x) {
  x += dppf<0xB1>(x);
  x += dppf<0x4E>(x);
  x += dppf<0x124>(x);
  x += dppf<0x128>(x);
  const auto s = __builtin_amdgcn_permlane16_swap(__float_as_uint(x), __float_as_uint(x), false, false);
  return __uint_as_float(s[0]) + __uint_as_float(s[1]);
}
DI size_t hm_base(int row) {
  if (row < MP) { const int b = row >> 12, t = row & 4095; return ((size_t)(b * 16) * 4096 + t) * 64; }
  const int rs = row - MP, b = rs >> 4, t = rs & 15; return (size_t)MP * 1024 + ((size_t)(b * 16) * 16 + t) * 64;
}
DI size_t hm_hstride(int row) { return row < MP ? (size_t)4096 * 64 : (size_t)16 * 64; }

DI void p0_rmsnorm_rows(const Params& p, int item) {
  const int lane = TIDX & 63, wid = TIDX >> 6;
  const int row = item * 8 + wid;
  const float* x = row < MP ? p.in[0] + (size_t)row * DM : p.in[1] + (size_t)(row - MP) * DM;
  const float* g = p.in[6];
  float4 v[4]; float ss = 0.f;
#pragma unroll
  for (int i = 0; i < 4; ++i) { v[i] = *(const float4*)(x + i * 256 + lane * 4); ss += v[i].x * v[i].x + v[i].y * v[i].y + v[i].z * v[i].z + v[i].w * v[i].w; }
  ss = wave_sum(ss);
  const float inv = rsqrtf(ss * (1.f / DM) + EPS);
  bf16_t* H = (bf16_t*)(p.ws + WS_H) + (size_t)row * DM;
#pragma unroll
  for (int i = 0; i < 4; ++i) {
    const float4 gg = *(const float4*)(g + i * 256 + lane * 4);
    uint2 o; o.x = cvtpk(v[i].x * inv * gg.x, v[i].y * inv * gg.y); o.y = cvtpk(v[i].z * inv * gg.z, v[i].w * inv * gg.w);
    *(uint2*)(H + i * 256 + lane * 4) = o;
  }
}
DI void p0_transpose_tile(const float* src, bf16_t* dst, int N, int kt, int nt, float* lds) {
  const int tid = TIDX & 255;
  const int k0 = kt * 64, n0 = nt * 64;
#pragma unroll
  for (int i = 0; i < 4; ++i) {
    const int row = (tid >> 4) + 16 * i, c4 = (tid & 15) * 4;
    const float4 v = *(const float4*)(src + (size_t)(k0 + row) * N + n0 + c4);
    lds[row * 65 + c4 + 0] = v.x; lds[row * 65 + c4 + 1] = v.y; lds[row * 65 + c4 + 2] = v.z; lds[row * 65 + c4 + 3] = v.w;
  }
  __syncthreads();
  const int n = tid >> 2, kc = (tid & 3) * 16;
  unsigned w[8];
#pragma unroll
  for (int j = 0; j < 8; ++j) w[j] = cvtpk(lds[(kc + 2 * j) * 65 + n], lds[(kc + 2 * j + 1) * 65 + n]);
  uint4* d = (uint4*)(dst + (size_t)(n0 + n) * 1024 + k0 + kc);
  d[0] = make_uint4(w[0], w[1], w[2], w[3]); d[1] = make_uint4(w[4], w[5], w[6], w[7]);
  __syncthreads();
}
DI void phase0(const Params& p, char* smem) {
  {
    bf16_t* BL = (bf16_t*)(p.ws + WS_BTL);
    for (int i = blockIdx.x * NT + TIDX; i < 2048 * 256; i += gridDim.x * NT) {
      const int n = i >> 8, k = i & 255;
      float v = 0.f;
      if (n < 1024) { if (k < 64) v = p.in[10][(size_t)k * 1024 + n]; }
      else if (k >= 64 && k < 128) v = p.in[12][(size_t)(k - 64) * 1024 + (n - 1024)];
      BL[i] = f2bf(v);
    }
  }
  constexpr int N_ROWS = MT / 8, N_TIN = 16 * 162 / 2, N_TSQ = 256 / 2;
  constexpr int N_ITEMS = N_ROWS + N_TIN + 3 * N_TSQ;
  const int half = TIDX >> 8;
  float* scr = (float*)smem + half * (64 * 65);
  for (int it = blockIdx.x; it < N_ITEMS; it += gridDim.x) {
    if (it < N_ROWS) { p0_rmsnorm_rows(p, it); continue; }
    int j = it - N_ROWS;
    if (j < N_TIN) { const int t = 2 * j + half; p0_transpose_tile(p.in[7], (bf16_t*)(p.ws + WS_WINT), NIN, t / 162, t % 162, scr); continue; }
    j -= N_TIN;
    const int w = j / N_TSQ; const int t = 2 * (j % N_TSQ) + half;
    p0_transpose_tile(p.in[18 + w], (bf16_t*)(p.ws + WS_WT) + (size_t)w * 1024 * 1024, 1024, t >> 4, t & 15, scr);
  }
}

struct EpiP1 {
  static constexpr bool PERM = true, AFTER_DRAIN = false;
  Params p;
  DI void operator()(const pg8::f32x4 (&acc)[2][2][4][2], const pg8::Unit& u, int wr, int wc, int fr, int fq) const {
    const int colt = u.pn * 256;
    const int region = colt >> 10;
#pragma unroll
    for (int ai = 0; ai < 2; ++ai)
#pragma unroll
      for (int m = 0; m < 4; ++m) {
        const int row = u.pm * 256 + ai * 128 + wr * 64 + m * 16 + fr;
        const bool prompt = row < MP;
        const int rs = row - MP;
#pragma unroll
        for (int bj = 0; bj < 2; ++bj) {
          const int col = colt + bj * 128 + wc * 32 + 8 * fq;
          const f32x4 v0 = acc[ai][bj][m][0], v1 = acc[ai][bj][m][1];
          if (region >= 6) {
            const int pc = col - 6144;
            if (pc < CSH) {
              *(uint4*)((bf16_t*)(p.ws + WS_PB) + (size_t)row * CSH + pc) = pack8(v0, v1);
              float* so = nullptr;
              if (prompt) { if ((row & 4095) == 4095) so = p.out + OUT_SHP + (size_t)(row >> 12) * CSH + pc; }
              else if ((rs & 15) == 15) so = p.out + OUT_SHS + (size_t)(rs >> 4) * CSH + pc;
              if (so) { *(f32x4*)so = v0; *(f32x4*)(so + 4) = v1; }
            }
          } else if (region == 0) {
            *(uint4*)((bf16_t*)(p.ws + WS_QB) + (size_t)row * 1024 + col) = pack8(v0 * QSCALE, v1 * QSCALE);
          } else if (region == 1) {
            const int c = col - 1024, hh = c >> 6, d = c & 63;
            float* o = prompt ? p.out + OUT_KP + (((size_t)(row >> 12) * 16 + hh) * 4096 + (row & 4095)) * 64 + d
                              : p.out + OUT_KS + (((size_t)(rs >> 4) * 16 + hh) * 16 + (rs & 15)) * 64 + d;
            __builtin_nontemporal_store(v0, (f32x4*)o); __builtin_nontemporal_store(v1, (f32x4*)(o + 4));
          } else if (region == 2) {
            const int c = col - 2048, hh = c >> 6, d = c & 63;
            float* o = prompt ? p.out + OUT_VP + (((size_t)(row >> 12) * 16 + hh) * 4096 + (row & 4095)) * 64 + d
                              : p.out + OUT_VS + (((size_t)(rs >> 4) * 16 + hh) * 16 + (rs & 15)) * 64 + d;
            __builtin_nontemporal_store(v0, (f32x4*)o); __builtin_nontemporal_store(v1, (f32x4*)(o + 4));
          } else if (region == 3) {
            f32x4 a, b;
#pragma unroll
            for (int j = 0; j < 4; ++j) { a[j] = v0[j] * sigmoidf_(v0[j]); b[j] = v1[j] * sigmoidf_(v1[j]); }
            *(uint4*)((bf16_t*)(p.ws + WS_SZA) + (size_t)row * 1024 + (col - 3072)) = pack8(a, b);
          } else {
            f32x4 a, b;
#pragma unroll
            for (int j = 0; j < 4; ++j) { a[j] = sigmoidf_(v0[j]); b[j] = sigmoidf_(v1[j]); }
            *(uint4*)((bf16_t*)p.out + (size_t)row * 2048 + (col - 4096)) = pack8(a, b);
          }
        }
      }
  }
};
struct EpiGate {
  static constexpr bool PERM = true, AFTER_DRAIN = false;
  Params p; int goff; bool first;
  DI void operator()(const pg8::f32x4 (&acc)[2][2][4][2], const pg8::Unit& u, int wr, int wc, int fr, int fq) const {
    const bf16_t* G = (const bf16_t*)p.out; bf16_t* MG = (bf16_t*)(p.ws + WS_MG);
#pragma unroll
    for (int ai = 0; ai < 2; ++ai)
#pragma unroll
      for (int m = 0; m < 4; ++m) {
        const size_t row = u.pm * 256 + ai * 128 + wr * 64 + m * 16 + fr;
#pragma unroll
        for (int bj = 0; bj < 2; ++bj) {
          const int col = u.pn * 256 + bj * 128 + wc * 32 + 8 * fq;
          const uint4 g = *(const uint4*)(G + row * 2048 + goff + col);
          f32x4 a = acc[ai][bj][m][0], b = acc[ai][bj][m][1];
          a[0] *= bflo(g.x); a[1] *= bfhi(g.x); a[2] *= bflo(g.y); a[3] *= bfhi(g.y);
          b[0] *= bflo(g.z); b[1] *= bfhi(g.z); b[2] *= bflo(g.w); b[3] *= bfhi(g.w);
          if (!first) {
            const uint4 o = *(const uint4*)(MG + row * 1024 + col);
            a[0] += bflo(o.x); a[1] += bfhi(o.x); a[2] += bflo(o.y); a[3] += bfhi(o.y);
            b[0] += bflo(o.z); b[1] += bfhi(o.z); b[2] += bflo(o.w); b[3] += bfhi(o.w);
          }
          *(uint4*)(MG + row * 1024 + col) = pack8(a, b);
        }
      }
  }
};
struct EpiOut {
  static constexpr bool PERM = true, AFTER_DRAIN = false;
  Params p;
  DI void operator()(const pg8::f32x4 (&acc)[2][2][4][2], const pg8::Unit& u, int wr, int wc, int fr, int fq) const {
#pragma unroll
    for (int ai = 0; ai < 2; ++ai)
#pragma unroll
      for (int m = 0; m < 4; ++m) {
        const int row = u.pm * 256 + ai * 128 + wr * 64 + m * 16 + fr;
        const float* xr = row < MP ? p.in[0] + (size_t)row * 1024 : p.in[1] + (size_t)(row - MP) * 1024;
        float* orow = p.out + OUT_YP + (size_t)row * 1024;
#pragma unroll
        for (int bj = 0; bj < 2; ++bj) {
          const int col = u.pn * 256 + bj * 128 + wc * 32 + 8 * fq;
          const f32x4 x0 = *(const f32x4*)(xr + col), x1 = *(const f32x4*)(xr + col + 4);
          *(f32x4*)(orow + col) = x0 + acc[ai][bj][m][0]; *(f32x4*)(orow + col + 4) = x1 + acc[ai][bj][m][1];
        }
      }
  }
};
template <class Epi>
DI void run_gemm(char* smem, const bf16_t* A, const bf16_t* Bt, int M, int N, const Epi& E, int K = 1024) {
  pg8::Gemm g; g.A = A; g.Bt = Bt; g.M = M; g.N = N; g.K = K;
  pg8::StaticOrder S; S.init(M, N, (int)gridDim.x, (int)blockIdx.x);
  pg8::gemm_phase<Epi, pg8::StaticOrder, true, true>((LAS unsigned char*)smem, g, S, E);
  __syncthreads();
}

template <int MODE>
DI void small_gemm(const Params& p, const bf16_t* A, const bf16_t* Bt) {
  int t_ = TIDX; asm volatile("" : "+v"(t_));
  const int lane = t_ & 63, wid = __builtin_amdgcn_readfirstlane(t_ >> 6), fr = lane & 15, fq = lane >> 4;
  for (int tile = wid * gridDim.x + blockIdx.x; tile < 2048; tile += 8 * gridDim.x) {
    const int row0 = MP + (tile >> 6) * 16, col0 = (tile & 63) * 16;
    const bf16_t* pa = A + (size_t)(row0 + fr) * 1024 + 8 * fq;
    const bf16_t* pb = Bt + (size_t)(col0 + fr) * 1024 + 8 * fq;
    f32x4 acc = {0.f, 0.f, 0.f, 0.f};
#pragma unroll 8
    for (int s = 0; s < 32; ++s) acc = __builtin_amdgcn_mfma_f32_16x16x32_bf16(*(const bf16x8*)(pa + 32 * s), *(const bf16x8*)(pb + 32 * s), acc, 0, 0, 0);
    const int col = col0 + fr;
#pragma unroll
    for (int j = 0; j < 4; ++j) {
      const size_t row = row0 + 4 * fq + j;
      if (MODE == 2) p.out[OUT_YP + row * 1024 + col] = p.in[1][(row - MP) * 1024 + col] + acc[j];
      else {
        bf16_t* mg = (bf16_t*)(p.ws + WS_MG) + row * 1024 + col;
        const float g = bf2f(((const bf16_t*)p.out)[row * 2048 + (MODE == 1 ? 1024 : 0) + col]);
        *mg = f2bf((MODE == 1 ? bf2f(*mg) : 0.f) + acc[j] * g);
      }
    }
  }
}

DI float tanh_fast(float x) { return 1.f - 2.f * __builtin_amdgcn_rcpf(1.f + __expf(2.f * x)); }
DI void phase_x(const Params& p) {
  const bf16_t* PB = (const bf16_t*)(p.ws + WS_PB);
  bf16_t* X = (bf16_t*)(p.ws + WS_X);
  const float* mu = p.in[8];
  for (int i = blockIdx.x * NT + TIDX; i < MT * 32; i += gridDim.x * NT) {
    const int row = i >> 5, g = i & 31;
    uint4 o = make_uint4(0u, 0u, 0u, 0u);
    if (g < 16) {
      const int col = 3072 + g * 8;
      const bool prompt = row < MP;
      const int t = prompt ? (row & 4095) : ((row - MP) & 15);
      const uint4 a = *(const uint4*)(PB + (size_t)row * CSH + col);
      float c[8] = {bflo(a.x), bfhi(a.x), bflo(a.y), bfhi(a.y), bflo(a.z), bfhi(a.z), bflo(a.w), bfhi(a.w)}, q[8];
      if (t != 0) { const uint4 b = *(const uint4*)(PB + (size_t)(row - 1) * CSH + col); q[0] = bflo(b.x); q[1] = bfhi(b.x); q[2] = bflo(b.y); q[3] = bfhi(b.y); q[4] = bflo(b.z); q[5] = bfhi(b.z); q[6] = bflo(b.w); q[7] = bfhi(b.w); }
      else if (prompt) {
#pragma unroll
        for (int j = 0; j < 8; ++j) q[j] = 0.f;
      } else { const float* s = p.in[4] + (size_t)((row - MP) >> 4) * CSH + col; const float4 b0 = *(const float4*)s, b1 = *(const float4*)(s + 4); q[0] = b0.x; q[1] = b0.y; q[2] = b0.z; q[3] = b0.w; q[4] = b1.x; q[5] = b1.y; q[6] = b1.z; q[7] = b1.w; }
      const float4 u0 = *(const float4*)(mu + col), u1 = *(const float4*)(mu + col + 4);
      const float u[8] = {u0.x, u0.y, u0.z, u0.w, u1.x, u1.y, u1.z, u1.w};
      float m[8];
#pragma unroll
      for (int j = 0; j < 8; ++j) { m[j] = c[j] + u[j] * (q[j] - c[j]); if (g < 8) m[j] = tanh_fast(m[j]); }
      o = make_uint4(cvtpk(m[0], m[1]), cvtpk(m[2], m[3]), cvtpk(m[4], m[5]), cvtpk(m[6], m[7]));
    }
    *(uint4*)(X + (size_t)row * 256 + g * 8) = o;
  }
}
struct EpiLora {
  static constexpr bool PERM = true, AFTER_DRAIN = false;
  Params p;
  DI void operator()(const pg8::f32x4 (&acc)[2][2][4][2], const pg8::Unit& u, int wr, int wc, int fr, int fq) const {
    const bool isw = u.pn < 4;
#pragma unroll
    for (int ai = 0; ai < 2; ++ai)
#pragma unroll
      for (int m = 0; m < 4; ++m) {
        const int row = u.pm * 256 + ai * 128 + wr * 64 + m * 16 + fr;
        const size_t hb = hm_base(row), hs = hm_hstride(row);
#pragma unroll
        for (int bj = 0; bj < 2; ++bj) {
          const int c = (u.pn & 3) * 256 + bj * 128 + wc * 32 + 8 * fq;
          const size_t idx = hb + (c >> 6) * hs + (c & 63);
          const f32x4 v0 = acc[ai][bj][m][0], v1 = acc[ai][bj][m][1];
          if (isw) {
            const f32x4 b0 = *(const f32x4*)(p.in[9] + c), b1 = *(const f32x4*)(p.in[9] + c + 4);
            f32x4 d0, d1;
#pragma unroll
            for (int j = 0; j < 4; ++j) {
              const float x0 = -(b0[j] + v0[j]), x1 = -(b1[j] + v1[j]);
              const float s0 = fmaxf(x0, 0.f) + __logf(1.f + __expf(-fabsf(x0))), s1 = fmaxf(x1, 0.f) + __logf(1.f + __expf(-fabsf(x1)));
              d0[j] = __expf(-__expf(-s0 - 0.5f)); d1[j] = __expf(-__expf(-s1 - 0.5f));
            }
            float* o = (float*)(p.ws + WS_SW) + idx; *(f32x4*)o = d0; *(f32x4*)(o + 4) = d1;
          } else {
            const f32x4 b0 = *(const f32x4*)(p.in[11] + c), b1 = *(const f32x4*)(p.in[11] + c + 4);
            f32x4 d0, d1;
#pragma unroll
            for (int j = 0; j < 4; ++j) { d0[j] = sigmoidf_(b0[j] + v0[j]); d1[j] = sigmoidf_(b1[j] + v1[j]); }
            *(uint4*)((bf16_t*)(p.ws + WS_SB) + idx) = pack8(d0, d1);
          }
        }
      }
  }
};
DI void small_lora(const Params& p) {
  const int lane = TIDX & 63, wid = TIDX >> 6, r = lane & 31, h = lane >> 5;
  const bf16_t* X = (const bf16_t*)(p.ws + WS_X); const bf16_t* BL = (const bf16_t*)(p.ws + WS_BTL);
  for (int tile = wid * gridDim.x + blockIdx.x; tile < 16 * 64; tile += 8 * gridDim.x) {
    const int row0 = MP + (tile >> 6) * 32, ct = tile & 63, col0 = ct * 32, k0 = ct < 32 ? 0 : 64;
    const bf16_t* pa = X + (size_t)(row0 + r) * 256 + k0 + 8 * h;
    const bf16_t* pb = BL + (size_t)(col0 + r) * 256 + k0 + 8 * h;
    f32x16 acc;
#pragma unroll
    for (int i = 0; i < 16; ++i) acc[i] = 0.f;
#pragma unroll
    for (int s = 0; s < 4; ++s) acc = MFMA32(*(const bf16x8*)(pa + 16 * s), *(const bf16x8*)(pb + 16 * s), acc);
    const int c = (col0 + r) & 1023;
    const float bias = ct < 32 ? p.in[9][c] : p.in[11][c];
#pragma unroll
    for (int i = 0; i < 16; ++i) {
      const int row = row0 + crow(i, h);
      const size_t idx = hm_base(row) + (c >> 6) * hm_hstride(row) + (c & 63);
      const float v = bias + acc[i];
      if (ct < 32) {
        const float x = -v, sp = fmaxf(x, 0.f) + __logf(1.f + __expf(-fabsf(x)));
        ((float*)(p.ws + WS_SW))[idx] = __expf(-__expf(-sp - 0.5f));
      } else ((bf16_t*)(p.ws + WS_SB))[idx] = f2bf(sigmoidf_(v));
    }
  }
}

DI void phase1c(const Params& p) {
  const int tid = TIDX & 255, half = TIDX >> 8, c = tid * 4, hh = c >> 6;
  const bf16_t* PB = (const bf16_t*)(p.ws + WS_PB);
  const float* mu = p.in[8];
  const float4 kkw = *(const float4*)(p.in[13] + c), kaw = *(const float4*)(p.in[14] + c), rkw = *(const float4*)(p.in[15] + c);
  const float4 mur = *(const float4*)(mu + c), muk = *(const float4*)(mu + 1024 + c), muv = *(const float4*)(mu + 2048 + c), muz = *(const float4*)(mu + 3200 + c);
  const float kka[4] = {kkw.x, kkw.y, kkw.z, kkw.w}, kaa[4] = {kaw.x, kaw.y, kaw.z, kaw.w}, rka[4] = {rkw.x, rkw.y, rkw.z, rkw.w};
  const float mura[4] = {mur.x, mur.y, mur.z, mur.w}, muka[4] = {muk.x, muk.y, muk.z, muk.w}, muva[4] = {muv.x, muv.y, muv.z, muv.w}, muza[4] = {muz.x, muz.y, muz.z, muz.w};
  bf16_t* SR = (bf16_t*)(p.ws + WS_SR); bf16_t* SK = (bf16_t*)(p.ws + WS_SK); bf16_t* SV = (bf16_t*)(p.ws + WS_SV);
  bf16_t* SKK = (bf16_t*)(p.ws + WS_SKK); bf16_t* SB = (bf16_t*)(p.ws + WS_SB); bf16_t* SZB = (bf16_t*)(p.ws + WS_SZB);
  float* BONUS = (float*)(p.ws + WS_BONUS);
  for (int r4 = blockIdx.x * 2 + half; r4 < MT / 4; r4 += gridDim.x * 2) {
    const int row0 = r4 * 4;
    const bool prompt = row0 < MP;
    const int t0 = prompt ? (row0 & 4095) : ((row0 - MP) & 15);
    uint2 gr[5], gk[5], gv[5], gz[5], ga[4];
#pragma unroll
    for (int t = 0; t < 5; ++t) {
      const int rr_ = (t == 0 && t0 == 0) ? row0 : row0 + t - 1;
      const bf16_t* pc = PB + (size_t)rr_ * CSH;
      gr[t] = ntload2(pc + c); gk[t] = ntload2(pc + 1024 + c); gv[t] = ntload2(pc + 2048 + c); gz[t] = ntload2(pc + 3200 + c);
    }
    size_t idx[4];
#pragma unroll
    for (int t = 0; t < 4; ++t) { idx[t] = hm_base(row0 + t) + hh * hm_hstride(row0 + t) + (c & 63); ga[t] = *(const uint2*)(SB + idx[t]); }
    float pr[4], pk[4], pv[4], pz[4];
    if (t0 == 0) {
      if (prompt) {
#pragma unroll
        for (int x = 0; x < 4; ++x) { pr[x] = 0.f; pk[x] = 0.f; pv[x] = 0.f; pz[x] = 0.f; }
      } else {
        const float* s = p.in[4] + (size_t)((row0 - MP) >> 4) * CSH;
        const float4 a = *(const float4*)(s + c), b = *(const float4*)(s + 1024 + c), d = *(const float4*)(s + 2048 + c), e = *(const float4*)(s + 3200 + c);
        pr[0] = a.x; pr[1] = a.y; pr[2] = a.z; pr[3] = a.w; pk[0] = b.x; pk[1] = b.y; pk[2] = b.z; pk[3] = b.w;
        pv[0] = d.x; pv[1] = d.y; pv[2] = d.z; pv[3] = d.w; pz[0] = e.x; pz[1] = e.y; pz[2] = e.z; pz[3] = e.w;
      }
    } else {
      pr[0] = bflo(gr[0].x); pr[1] = bfhi(gr[0].x); pr[2] = bflo(gr[0].y); pr[3] = bfhi(gr[0].y);
      pk[0] = bflo(gk[0].x); pk[1] = bfhi(gk[0].x); pk[2] = bflo(gk[0].y); pk[3] = bfhi(gk[0].y);
      pv[0] = bflo(gv[0].x); pv[1] = bfhi(gv[0].x); pv[2] = bflo(gv[0].y); pv[3] = bfhi(gv[0].y);
      pz[0] = bflo(gz[0].x); pz[1] = bfhi(gz[0].x); pz[2] = bflo(gz[0].y); pz[3] = bfhi(gz[0].y);
    }
#pragma unroll
    for (int t = 0; t < 4; ++t) {
      const int row = row0 + t;
      const float curr[4] = {bflo(gr[t + 1].x), bfhi(gr[t + 1].x), bflo(gr[t + 1].y), bfhi(gr[t + 1].y)}, curk[4] = {bflo(gk[t + 1].x), bfhi(gk[t + 1].x), bflo(gk[t + 1].y), bfhi(gk[t + 1].y)};
      const float curv[4] = {bflo(gv[t + 1].x), bfhi(gv[t + 1].x), bflo(gv[t + 1].y), bfhi(gv[t + 1].y)}, curz[4] = {bflo(gz[t + 1].x), bfhi(gz[t + 1].x), bflo(gz[t + 1].y), bfhi(gz[t + 1].y)};
      const float av[4] = {bflo(ga[t].x), bfhi(ga[t].x), bflo(ga[t].y), bfhi(ga[t].y)};
      float rm[4], km[4], vm[4], kkv[4], bb[4], kmod[4], szb[4];
      float ssq = 0.f, bon = 0.f;
#pragma unroll
      for (int x = 0; x < 4; ++x) {
        rm[x] = curr[x] + mura[x] * (pr[x] - curr[x]);
        km[x] = curk[x] + muka[x] * (pk[x] - curk[x]);
        vm[x] = curv[x] + muva[x] * (pv[x] - curv[x]);
        const float zm = curz[x] + muza[x] * (pz[x] - curz[x]);
        szb[x] = zm * sigmoidf_(zm);
        kkv[x] = km[x] * kka[x];
        ssq += kkv[x] * kkv[x];
        kmod[x] = km[x] * (1.f + (av[x] - 1.f) * kaa[x]);
        bon += rm[x] * kmod[x] * rka[x];
        pr[x] = curr[x]; pk[x] = curk[x]; pv[x] = curv[x]; pz[x] = curz[x];
      }
      ssq = sum16(ssq); bon = sum16(bon);
      const float inv = 1.f / fmaxf(sqrtf(ssq), 1e-12f);
#pragma unroll
      for (int x = 0; x < 4; ++x) { kkv[x] *= inv; bb[x] = kkv[x] * av[x]; }
      ntstore2(SR + idx[t], make_uint2(cvtpk(rm[0], rm[1]), cvtpk(rm[2], rm[3])));
      ntstore2(SK + idx[t], make_uint2(cvtpk(kmod[0], kmod[1]), cvtpk(kmod[2], kmod[3])));
      ntstore2(SV + idx[t], make_uint2(cvtpk(vm[0], vm[1]), cvtpk(vm[2], vm[3])));
      ntstore2(SKK + idx[t], make_uint2(cvtpk(-kkv[0], -kkv[1]), cvtpk(-kkv[2], -kkv[3])));
      ntstore2(SB + idx[t], make_uint2(cvtpk(bb[0], bb[1]), cvtpk(bb[2], bb[3])));
      ntstore2(SZB + (size_t)row * 1024 + c, make_uint2(cvtpk(szb[0], szb[1]), cvtpk(szb[2], szb[3])));
      if ((tid & 15) == 0) BONUS[(size_t)row * 16 + hh] = bon;
    }
  }
}

template <bool SAMPLE>
DI void attn_wave(const Params& p, int sh, int qt) {
  const int lane = TIDX & 63, r = lane & 31, h = lane >> 5;
  const int hh = sh & 15, b = sh >> 4;
  bf16_t* QB = (bf16_t*)(p.ws + WS_QB);
  const int row0 = SAMPLE ? MP + b * 16 : b * 4096 + qt * 32;
  bf16_t* Qp = QB + (size_t)row0 * 1024 + hh * 64;
  const int qrow = SAMPLE ? (r < 15 ? r : 15) : r;
  bf16x8 qf[4];
#pragma unroll
  for (int s = 0; s < 4; ++s) qf[s] = *(const bf16x8*)(Qp + (size_t)qrow * 1024 + 16 * s + 8 * h);
  f32x16 z0, z1;
#pragma unroll
  for (int i = 0; i < 16; ++i) { z0[i] = 0.f; z1[i] = 0.f; }
  float carry = 1.f;
  const int ntiles = SAMPLE ? 33 : qt + 1;
  for (int it = 0; it < ntiles; ++it) {
    const bool diag = (it == 0);
    const int kt = SAMPLE ? 32 - it : qt - it;
    bf16x8 kf[4];
    {
      const float* Kp;
      if (!SAMPLE) Kp = p.out + OUT_KP + ((size_t)sh * 4096 + kt * 32 + r) * 64;
      else Kp = diag ? p.out + OUT_KS + ((size_t)sh * 16 + (r < 15 ? r : 15)) * 64 : p.in[2] + ((size_t)sh * 1024 + kt * 32 + r) * 64;
#pragma unroll
      for (int s = 0; s < 4; ++s) {
        const float4 a = *(const float4*)(Kp + 16 * s + 8 * h), bq = *(const float4*)(Kp + 16 * s + 8 * h + 4);
        u32x4 w; w[0] = cvtpk(a.x, a.y); w[1] = cvtpk(a.z, a.w); w[2] = cvtpk(bq.x, bq.y); w[3] = cvtpk(bq.z, bq.w);
        kf[s] = __builtin_bit_cast(bf16x8, w);
      }
    }
    f32x16 st;
#pragma unroll
    for (int i = 0; i < 16; ++i) st[i] = 0.f;
#pragma unroll
    for (int s = 0; s < 4; ++s) st = MFMA32(kf[s], qf[s], st);
    float keep[16], wgt[16];
#pragma unroll
    for (int i = 0; i < 16; ++i) {
      const float e = __builtin_amdgcn_exp2f(st[i]);
      const float kp = __builtin_amdgcn_rcpf(1.f + e);
      bool valid = true;
      if (diag) { const int kr = crow(i, h); valid = SAMPLE ? (kr < r && kr < 16) : (kr < r); }
      keep[i] = valid ? kp : 1.f;
      wgt[i] = valid ? 1.f - kp : 0.f;
    }
    float pp[4], hif[4];
#pragma unroll
    for (int g = 0; g < 4; ++g) {
      const float p4 = (keep[4 * g] * keep[4 * g + 1]) * (keep[4 * g + 2] * keep[4 * g + 3]);
      const auto sw = __builtin_amdgcn_permlane32_swap(__float_as_uint(p4), __float_as_uint(p4), false, false);
      const float lo = __uint_as_float(sw[0]), hi = __uint_as_float(sw[1]);
      pp[g] = lo * hi;
      hif[g] = h ? 1.f : hi;
    }
    float T[4];
    T[3] = carry; T[2] = T[3] * pp[3]; T[1] = T[2] * pp[2]; T[0] = T[1] * pp[1];
    carry = T[0] * pp[0];
#pragma unroll
    for (int g = 0; g < 4; ++g) {
      const float w3 = T[g] * hif[g], w2 = w3 * keep[4 * g + 3], w1 = w2 * keep[4 * g + 2], w0 = w1 * keep[4 * g + 1];
      wgt[4 * g + 3] *= w3; wgt[4 * g + 2] *= w2; wgt[4 * g + 1] *= w1; wgt[4 * g] *= w0;
    }
#pragma unroll
    for (int s = 0; s < 2; ++s) {
      u32x4 pw;
#pragma unroll
      for (int j = 0; j < 4; ++j) pw[j] = cvtpk(wgt[8 * s + 2 * j], wgt[8 * s + 2 * j + 1]);
      const bf16x8 pf = __builtin_bit_cast(bf16x8, pw);
#pragma unroll
      for (int db = 0; db < 2; ++db) {
        bf16x8 vf;
        {
          float vv[8];
#pragma unroll
          for (int j = 0; j < 8; ++j) {
            const int kr = 16 * s + 8 * (j >> 2) + 4 * h + (j & 3);
            const float* vp;
            if (!SAMPLE) vp = p.out + OUT_VP + ((size_t)sh * 4096 + kt * 32 + kr) * 64;
            else vp = diag ? p.out + OUT_VS + ((size_t)sh * 16 + (kr < 15 ? kr : 15)) * 64 : p.in[3] + ((size_t)sh * 1024 + kt * 32 + kr) * 64;
            vv[j] = vp[db * 32 + r];
          }
          u32x4 w; w[0] = cvtpk(vv[0], vv[1]); w[1] = cvtpk(vv[2], vv[3]); w[2] = cvtpk(vv[4], vv[5]); w[3] = cvtpk(vv[6], vv[7]);
          vf = __builtin_bit_cast(bf16x8, w);
        }
        if (db == 0) z0 = MFMA32(pf, vf, z0); else z1 = MFMA32(pf, vf, z1);
      }
    }
    if (__ballot(carry != 0.f) == 0ull) break;
  }
  const bf16_t* SZA = (const bf16_t*)(p.ws + WS_SZA);
#pragma unroll
  for (int i = 0; i < 16; ++i) {
    const int q = crow(i, h);
    if (SAMPLE && q >= 16) continue;
    const size_t o = (size_t)(row0 + q) * 1024 + hh * 64 + r;
    QB[o] = f2bf(z0[i] * bf2f(SZA[o]));
    QB[o + 32] = f2bf(z1[i] * bf2f(SZA[o + 32]));
  }
}

DI float row16_sum(float x) {
  x += dppf<0xB1>(x); x += dppf<0x4E>(x); x += dppf<0x124>(x); x += dppf<0x128>(x);
  return x;
}
DI void scan_wave(const Params& p, int shg, int slice, float* L) {
  const int lane = TIDX & 63, cc = lane & 15;
  const bool prompt = shg < 64;
  const int T = prompt ? 4096 : 16;
  const size_t base = prompt ? (size_t)shg * 4096 * 64 : (size_t)MP * 1024 + (size_t)(shg - 64) * 16 * 64;
  const int v = slice * 4 + (lane >> 4);
  const float* SW = (const float*)(p.ws + WS_SW) + base;
  const bf16_t* SARR = (const bf16_t*)(p.ws + WS_SR) + base;
  float* ORAW = (float*)(p.ws + WS_ORAW) + base;
  float4 S;
  float* wout;
  if (prompt) { S = make_float4(0.f, 0.f, 0.f, 0.f); wout = p.out + OUT_WP + ((size_t)shg * 64 + v) * 64 + 4 * cc; }
  else { S = *(const float4*)(p.in[5] + ((size_t)(shg - 64) * 64 + v) * 64 + 4 * cc); wout = p.out + OUT_WS + ((size_t)(shg - 64) * 64 + v) * 64 + 4 * cc; }
  const int nch = T / 8;
  const int dw0 = ((lane >> 4) * 6 + 2) * 64 + (lane & 15) * 4, dw1 = dw0 + 4 * 384;
  const int db = (lane >> 3) * 384 + (lane & 7) * 8;
  uint4 gw0, gw1, gr, gk, gv, gn, gb;
#define SCAN_GLOAD(ch) do { const float* w_ = SW + (size_t)(ch) * 512; gw0 = *(const uint4*)(w_ + lane * 4); gw1 = *(const uint4*)(w_ + 256 + lane * 4); \
    const bf16_t* a_ = SARR + (size_t)(ch) * 512 + lane * 8; gr = *(const uint4*)a_; gk = *(const uint4*)(a_ + SZ_ACT / 2); gv = *(const uint4*)(a_ + 2 * (SZ_ACT / 2)); \
    gn = *(const uint4*)(a_ + 3 * (SZ_ACT / 2)); gb = *(const uint4*)(a_ + 4 * (SZ_ACT / 2)); } while (0)
#define SCAN_PUT(slot, g) do { float* d_ = L + db + (slot) * 64; *(float4*)d_ = make_float4(bflo(g.x), bfhi(g.x), bflo(g.y), bfhi(g.y)); *(float4*)(d_ + 4) = make_float4(bflo(g.z), bfhi(g.z), bflo(g.w), bfhi(g.w)); } while (0)
#define SCAN_LSTORE() do { *(uint4*)(L + dw0) = gw0; *(uint4*)(L + dw1) = gw1; SCAN_PUT(4, gr); SCAN_PUT(3, gk); SCAN_PUT(5, gv); SCAN_PUT(0, gn); SCAN_PUT(1, gb); \
    asm volatile("s_waitcnt lgkmcnt(0)" ::: "memory"); } while (0)
  SCAN_GLOAD(0);
  asm volatile("s_waitcnt lgkmcnt(0)" ::: "memory");
  SCAN_LSTORE();
  for (int ch = 0; ch < nch; ++ch) {
    if (ch + 1 < nch) SCAN_GLOAD(ch + 1);
    float okeep = 0.f;
    const float* Lc = L + 4 * cc;
    float4 nk = *(const float4*)(Lc), bb = *(const float4*)(Lc + 64), ww = *(const float4*)(Lc + 128), kv = *(const float4*)(Lc + 192), rr = *(const float4*)(Lc + 256);
    float vt = L[320 + v];
#pragma unroll 4
    for (int st = 0; st < 8; ++st) {
      const int sn = ((st + 1) & 7) * 384;
      const float4 nk2 = *(const float4*)(Lc + sn), bb2 = *(const float4*)(Lc + sn + 64), ww2 = *(const float4*)(Lc + sn + 128);
      const float4 kv2 = *(const float4*)(Lc + sn + 192), rr2 = *(const float4*)(Lc + sn + 256);
      const float vt2 = L[sn + 320 + v];
      float d = (S.x * nk.x + S.y * nk.y) + (S.z * nk.z + S.w * nk.w);
      const float sa = row16_sum(d);
      S.x = S.x * ww.x + (sa * bb.x + vt * kv.x);
      S.y = S.y * ww.y + (sa * bb.y + vt * kv.y);
      S.z = S.z * ww.z + (sa * bb.z + vt * kv.z);
      S.w = S.w * ww.w + (sa * bb.w + vt * kv.w);
      float o = (S.x * rr.x + S.y * rr.y) + (S.z * rr.z + S.w * rr.w);
      o = row16_sum(o);
      okeep = (cc == st) ? o : okeep;
      nk = nk2; bb = bb2; ww = ww2; kv = kv2; rr = rr2; vt = vt2;
    }
    if (cc < 8) ORAW[(size_t)(ch * 8 + cc) * 64 + v] = okeep;
    asm volatile("s_waitcnt lgkmcnt(0)" ::: "memory");
    if (ch + 1 < nch) SCAN_LSTORE();
  }
  *(float4*)wout = S;
#undef SCAN_GLOAD
#undef SCAN_PUT
#undef SCAN_LSTORE
}

DI void sgroup_arrive(volatile LAS unsigned* cnt) {
  asm volatile("" ::: "memory");
  if ((TIDX & 63) == 0) __hip_atomic_fetch_add((LAS unsigned*)cnt, 1u, __ATOMIC_RELAXED, __HIP_MEMORY_SCOPE_WORKGROUP);
}
DI void sgroup_wait(volatile LAS unsigned* cnt, unsigned target) { while (*cnt < target) { } asm volatile("" ::: "memory"); }
DI void sgroup_barrier(volatile LAS unsigned* cnt, unsigned target) {
  asm volatile("" ::: "memory");
  if ((TIDX & 63) == 0) __hip_atomic_fetch_add((LAS unsigned*)cnt, 1u, __ATOMIC_RELAXED, __HIP_MEMORY_SCOPE_WORKGROUP);
  while (*cnt < target) { }
  asm volatile("" ::: "memory");
}
DI void scan_group(const Params& p, int sh, int quarter, float* lds, volatile LAS unsigned* cnt, unsigned& nbar) {
  const int tid = TIDX & 255, lane = tid & 63, wid = tid >> 6, cc = lane & 15;
  const size_t base = (size_t)sh * 4096 * 64;
  const int v = quarter * 16 + wid * 4 + (lane >> 4);
  const float* SW = (const float*)(p.ws + WS_SW) + base;
  const bf16_t* SARR = (const bf16_t*)(p.ws + WS_SR) + base;
  float* ORAW = (float*)(p.ws + WS_ORAW) + base;
  f32x2 S01 = {0.f, 0.f}, S23 = {0.f, 0.f};
  const bool b0 = (lane & 1) != 0, b1 = (lane & 2) != 0;
  float4 gw0, gw1; uint4 gb0, gb1, gb2, gb3, gb4;
  const int dstw0 = ((tid >> 4) * 6 + 2) * 64 + (tid & 15) * 4, dstw1 = dstw0 + 16 * 384;
  const int dstb = (tid >> 3) * 384 + (tid & 7) * 8;
  const bf16_t* sbp = SARR + tid * 8;
#define SG_GLOAD(ch) do { const size_t o_ = (size_t)(ch) * 2048; gw0 = *(const float4*)(SW + o_ + tid * 4); gw1 = *(const float4*)(SW + o_ + 1024 + tid * 4); \
    gb0 = *(const uint4*)(sbp + o_); gb1 = *(const uint4*)(sbp + (SZ_ACT / 2) + o_); gb2 = *(const uint4*)(sbp + 2 * (SZ_ACT / 2) + o_); \
    gb3 = *(const uint4*)(sbp + 3 * (SZ_ACT / 2) + o_); gb4 = *(const uint4*)(sbp + 4 * (SZ_ACT / 2) + o_); } while (0)
#define SG_PUT(d_, g) do { *(float4*)(d_) = make_float4(bflo(g.x), bfhi(g.x), bflo(g.y), bfhi(g.y)); *(float4*)((d_) + 4) = make_float4(bflo(g.z), bfhi(g.z), bflo(g.w), bfhi(g.w)); } while (0)
#define SG_LSTORE(buf) do { float* L_ = lds + (buf) * (32 * 384); *(float4*)(L_ + dstw0) = gw0; *(float4*)(L_ + dstw1) = gw1; \
    SG_PUT(L_ + dstb + 4 * 64, gb0); SG_PUT(L_ + dstb + 3 * 64, gb1); SG_PUT(L_ + dstb + 5 * 64, gb2); SG_PUT(L_ + dstb + 0 * 64, gb3); SG_PUT(L_ + dstb + 1 * 64, gb4); } while (0)
  SG_GLOAD(0); SG_LSTORE(0); sgroup_barrier(cnt, 4u * (++nbar));
  for (int ch = 0; ch < 128; ++ch) {
    {
    const float* L = lds + (ch & 1) * (32 * 384);
    float okeep = 0.f;
    const float* Lc = L + 4 * cc;
    f32x4 nk = *(const f32x4*)(Lc), bb = *(const f32x4*)(Lc + 64), ww = *(const f32x4*)(Lc + 128), kv = *(const f32x4*)(Lc + 192), rr = *(const f32x4*)(Lc + 256);
    float vt = L[320 + v];
    if (ch + 1 < 128) SG_GLOAD(ch + 1);
    f32x4 rrp = rr;
    float po[4];
#pragma unroll
    for (int st = 0; st <= 31; ++st) {
      if (st > 0) { const f32x2 o2 = S01 * rrp.xy + S23 * rrp.zw; po[(st - 1) & 3] = o2.x + o2.y; }
      if (st > 0 && (st & 3) == 0) {
        const float u0 = (b0 ? po[1] : po[0]) + dppf<0xB1>(b0 ? po[0] : po[1]);
        const float u1 = (b0 ? po[3] : po[2]) + dppf<0xB1>(b0 ? po[2] : po[3]);
        float w = (b1 ? u1 : u0) + dppf<0x4E>(b1 ? u0 : u1);
        w += dppf<0x124>(w); w += dppf<0x128>(w);
        okeep = ((cc >> 2) == (((st >> 2) - 1) & 3)) ? w : okeep;
      }
      if (st == 16 || st == 32) ORAW[(size_t)(ch * 32 + (st - 16) + cc) * 64 + v] = okeep;
      if (st < 32) {
        const int sn = ((st + 1) & 31) * 384;
        const f32x2 d2 = S01 * nk.xy + S23 * nk.zw;
        float x = d2.x + d2.y;
        const f32x2 vt_2 = {vt, vt};
        const f32x2 t01 = vt_2 * kv.xy, t23 = vt_2 * kv.zw;
        __builtin_amdgcn_sched_barrier(0);
        x += dppf<0xB1>(x);
        const f32x4 nk2 = *(const f32x4*)(Lc + sn), bb2 = *(const f32x4*)(Lc + sn + 64);
        __builtin_amdgcn_sched_barrier(0);
        x += dppf<0x4E>(x);
        const f32x4 ww2 = *(const f32x4*)(Lc + sn + 128), kv2 = *(const f32x4*)(Lc + sn + 192);
        __builtin_amdgcn_sched_barrier(0);
        x += dppf<0x124>(x);
        const f32x4 rr2 = *(const f32x4*)(Lc + sn + 256);
        const float vt2 = L[sn + 320 + v];
        __builtin_amdgcn_sched_barrier(0);
        x += dppf<0x128>(x);
        __builtin_amdgcn_sched_barrier(0);
        const f32x2 sa2 = {x, x};
        S01 = S01 * ww.xy + (sa2 * bb.xy + t01);
        S23 = S23 * ww.zw + (sa2 * bb.zw + t23);
        rrp = rr;
        nk = nk2; bb = bb2; ww = ww2; kv = kv2; rr = rr2; vt = vt2;
      }
    }
    if (ch + 1 < 128) SG_LSTORE((ch + 1) & 1);
    sgroup_arrive(cnt);
    {
      const f32x2 o2 = S01 * rrp.xy + S23 * rrp.zw; po[3] = o2.x + o2.y;
      const float u0 = (b0 ? po[1] : po[0]) + dppf<0xB1>(b0 ? po[0] : po[1]);
      const float u1 = (b0 ? po[3] : po[2]) + dppf<0xB1>(b0 ? po[2] : po[3]);
      float w = (b1 ? u1 : u0) + dppf<0x4E>(b1 ? u0 : u1);
      w += dppf<0x124>(w); w += dppf<0x128>(w);
      okeep = ((cc >> 2) == 3) ? w : okeep;
      ORAW[(size_t)(ch * 32 + 16 + cc) * 64 + v] = okeep;
    }
    }
    sgroup_wait(cnt, 4u * (++nbar));
  }
  *(float4*)(p.out + OUT_WP + ((size_t)sh * 64 + v) * 64 + 4 * cc) = make_float4(S01.x, S01.y, S23.x, S23.y);
#undef SG_GLOAD
#undef SG_PUT
#undef SG_LSTORE
}

constexpr int NQ_ATT_P = 8192, NQ_ATT_S = 512, NQ_SCAN_S = 8192, NQ_DYN = NQ_ATT_P + NQ_ATT_S + NQ_SCAN_S;
DI int wave_grab(unsigned* ctr) { int v = 0; if ((TIDX & 63) == 0) v = (int)atomicAdd(ctr, 1u); return __builtin_amdgcn_readfirstlane(v); }
DI void phase2(const Params& p, char* smem) {
  __shared__ unsigned s_cnt;
  unsigned* ctl = (unsigned*)(p.ws + WS_CTL);
  const int wid = TIDX >> 6;
  if (TIDX == 0) s_cnt = 0u;
  __syncthreads();
  float* Lsh = (float*)smem + 4 * (8 * 384);
  float* L = wid >= 4 ? (float*)smem + (wid - 4) * (8 * 384) : Lsh + wid * (8 * 384);
  if (wid < 4) {
    unsigned nbar = 0;
    __builtin_amdgcn_s_setprio(3);
    for (int bu = blockIdx.x; bu < 256; bu += gridDim.x) {
      const int xs = bu & 7, slot = bu >> 3, head = xs * 8 + (slot >> 2), quarter = slot & 3;
      scan_group(p, head, quarter, Lsh, (volatile LAS unsigned*)&s_cnt, nbar);
    }
    __builtin_amdgcn_s_setprio(0);
  }
  for (;;) {
    int u = wave_grab(&ctl[0]);
    if (u >= NQ_DYN) break;
    if (u < NQ_ATT_P) { attn_wave<false>(p, u >> 7, u & 127); continue; }
    u -= NQ_ATT_P;
    if (u < NQ_ATT_S) { attn_wave<true>(p, u, 0); continue; }
    u -= NQ_ATT_S;
    scan_wave(p, 64 + (u >> 4), u & 15, L);
  }
}

DI void p2c_row(const Params& p, int row, int c, int hh, const float4& lg, const float4& lb, const float4& o, const uint2& vv, const uint2& zz, float bon) {
  const float mean = sum16((o.x + o.y) + (o.z + o.w)) * (1.f / 64.f);
  const float dx = o.x - mean, dy = o.y - mean, dz = o.z - mean, dw = o.w - mean;
  const float var = sum16((dx * dx + dy * dy) + (dz * dz + dw * dw)) * (1.f / 64.f);
  const float inv = rsqrtf(var + LNX_EPS);
  const float r0 = (dx * inv * lg.x + lb.x + bon * bflo(vv.x)) * bflo(zz.x);
  const float r1 = (dy * inv * lg.y + lb.y + bon * bfhi(vv.x)) * bfhi(zz.x);
  const float r2 = (dz * inv * lg.z + lb.z + bon * bflo(vv.y)) * bflo(zz.y);
  const float r3 = (dw * inv * lg.w + lb.w + bon * bfhi(vv.y)) * bfhi(zz.y);
  *(uint2*)((bf16_t*)(p.ws + WS_OB) + (size_t)row * 1024 + c) = make_uint2(cvtpk(r0, r1), cvtpk(r2, r3));
}
DI void phase2c(const Params& p) {
  const int tid = TIDX & 255, half = TIDX >> 8, c = tid * 4, hh = c >> 6;
  const float4 lg = *(const float4*)(p.in[16] + c), lb = *(const float4*)(p.in[17] + c);
  const float* ORAW = (const float*)(p.ws + WS_ORAW); const bf16_t* SV = (const bf16_t*)(p.ws + WS_SV);
  const bf16_t* SZB = (const bf16_t*)(p.ws + WS_SZB); const float* BONUS = (const float*)(p.ws + WS_BONUS);
  const int stride = gridDim.x * 2;
  for (int row = blockIdx.x * 2 + half; row < MT; row += 2 * stride) {
    const bool two = row + stride < MT;
    const int rowb = two ? row + stride : row;
    const size_t ia = hm_base(row) + hh * hm_hstride(row) + (c & 63), ib = hm_base(rowb) + hh * hm_hstride(rowb) + (c & 63);
    const float4 oa = *(const float4*)(ORAW + ia), ob = *(const float4*)(ORAW + ib);
    const uint2 va = *(const uint2*)(SV + ia), vb = *(const uint2*)(SV + ib);
    const uint2 za = *(const uint2*)(SZB + (size_t)row * 1024 + c), zb = *(const uint2*)(SZB + (size_t)rowb * 1024 + c);
    const float ba = BONUS[(size_t)row * 16 + hh], bb = BONUS[(size_t)rowb * 16 + hh];
    p2c_row(p, row, c, hh, lg, lb, oa, va, za, ba);
    if (two) p2c_row(p, rowb, c, hh, lg, lb, ob, vb, zb, bb);
  }
}

DI void phase4(const Params& p) {
  const int lane = TIDX & 63, wid = TIDX >> 6;
  const float* g = p.in[21];
  float4 gg[4];
#pragma unroll
  for (int i = 0; i < 4; ++i) gg[i] = *(const float4*)(g + i * 256 + lane * 4);
  const int stride = gridDim.x * 8;
  for (int row = blockIdx.x * 8 + wid; row < MT; row += 2 * stride) {
    const bool two = row + stride < MT;
    float* x0 = p.out + OUT_YP + (size_t)row * 1024;
    float* x1 = p.out + OUT_YP + (size_t)(two ? row + stride : row) * 1024;
    float4 v0[4], v1[4]; float s0 = 0.f, s1 = 0.f;
#pragma unroll
    for (int i = 0; i < 4; ++i) { v0[i] = *(const float4*)(x0 + i * 256 + lane * 4); v1[i] = *(const float4*)(x1 + i * 256 + lane * 4); }
#pragma unroll
    for (int i = 0; i < 4; ++i) {
      s0 += v0[i].x * v0[i].x + v0[i].y * v0[i].y + v0[i].z * v0[i].z + v0[i].w * v0[i].w;
      s1 += v1[i].x * v1[i].x + v1[i].y * v1[i].y + v1[i].z * v1[i].z + v1[i].w * v1[i].w;
    }
    s0 = wave_sum(s0); s1 = wave_sum(s1);
    const float i0 = rsqrtf(s0 * (1.f / DM) + EPS), i1 = rsqrtf(s1 * (1.f / DM) + EPS);
#pragma unroll
    for (int i = 0; i < 4; ++i) *(float4*)(x0 + i * 256 + lane * 4) = make_float4(v0[i].x * i0 * gg[i].x, v0[i].y * i0 * gg[i].y, v0[i].z * i0 * gg[i].z, v0[i].w * i0 * gg[i].w);
    if (two) {
#pragma unroll
      for (int i = 0; i < 4; ++i) *(float4*)(x1 + i * 256 + lane * 4) = make_float4(v1[i].x * i1 * gg[i].x, v1[i].y * i1 * gg[i].y, v1[i].z * i1 * gg[i].z, v1[i].w * i1 * gg[i].w);
    }
  }
}

#define XB_TMO      128
#define XB_XCNT(j)  (256  + 64 * (j))
#define XB_XSUB(j)  (1280 + 64 * (j))
#define XB_XGEN(j)  (2304 + 64 * (j))
#define XB_TOP      3328
#define XB_TOPGEN   3392
#define XCD_BAR_WORDS 3456
#define XB_SPIN_CAP (1u << 18)

__device__ __forceinline__ unsigned xb_ld(unsigned* p)              { return __hip_atomic_load(p, __ATOMIC_RELAXED, __HIP_MEMORY_SCOPE_AGENT); }
__device__ __forceinline__ unsigned xb_add(unsigned* p, unsigned v) { return __hip_atomic_fetch_add(p, v, __ATOMIC_RELAXED, __HIP_MEMORY_SCOPE_AGENT); }
__device__ __forceinline__ unsigned xb_xcc_id() { return (unsigned)__builtin_amdgcn_s_getreg((3 << 11) | 20) & 0xFu; }
#define XB_SPIN(cond, bar) do { unsigned _sp = 0; while (cond) { __builtin_amdgcn_s_sleep(1); \
    if ((++_sp & 255u) == 0u) { if (xb_ld(&(bar)[XB_TMO])) break; if (_sp > XB_SPIN_CAP) { atomicAdd(&(bar)[XB_TMO], 1u); break; } } } } while (0)

struct XcdBarrier {
    unsigned* bar; unsigned x;
    volatile LAS unsigned* st;
};

__device__ __forceinline__ XcdBarrier xcd_barrier_post(unsigned* bar, volatile LAS unsigned* st) {
    XcdBarrier b; b.bar = bar; b.x = xb_xcc_id(); b.st = st;
    if (TIDX == 0) (void)xb_add(&bar[XB_XCNT(b.x)], 1u);
    return b;
}
__device__ __forceinline__ void xcd_barrier_complete(unsigned* bar, unsigned x, unsigned& nloc, unsigned& nx) {
    const unsigned G = gridDim.x * gridDim.y * gridDim.z;
    unsigned sum, cnt, mine, sp = 0u;
    for (;;) {
        sum = 0u; cnt = 0u; mine = 0u;
#pragma unroll
        for (unsigned j = 0; j < 16; ++j) { const unsigned c = xb_ld(&bar[XB_XCNT(j)]); sum += c; cnt += (c > 0u) ? 1u : 0u; mine = (j == x) ? c : mine; }
        if (sum == G) break;
        __builtin_amdgcn_s_sleep(1);
        if ((++sp & 255u) == 0u) { if (xb_ld(&bar[XB_TMO])) break; if (sp > XB_SPIN_CAP) { atomicAdd(&bar[XB_TMO], 1u); break; } }
    }
    nloc = mine > 0u ? mine : 1u; nx = cnt > 0u ? cnt : 1u;
}

__device__ __forceinline__ void xcd_barrier(const XcdBarrier& b) {
    asm volatile("s_waitcnt vmcnt(0)" ::: "memory");
    __syncthreads();
    if (TIDX == 0) {
        unsigned* bar = b.bar;
        __builtin_amdgcn_s_waitcnt(0);
        unsigned nloc = b.st[0], nx = b.st[1];
        if (nloc == 0u) { xcd_barrier_complete(bar, b.x, nloc, nx); b.st[0] = nloc; b.st[1] = nx; }
        const unsigned old = xb_add(&bar[XB_XSUB(b.x)], 1u);
        const unsigned gen = old / nloc;
        if (old + 1u == (gen + 1u) * nloc) {
            __builtin_amdgcn_fence(__ATOMIC_RELEASE, "agent");
            asm volatile("s_waitcnt vmcnt(0)" ::: "memory");
            const unsigned og = xb_add(&bar[XB_TOP], 1u);
            const unsigned tg = og / nx;
            if (og + 1u == (tg + 1u) * nx) xb_add(&bar[XB_TOPGEN], 1u);
            else XB_SPIN(xb_ld(&bar[XB_TOPGEN]) == tg, bar);
            __builtin_amdgcn_fence(__ATOMIC_ACQUIRE, "agent");
            xb_add(&bar[XB_XGEN(b.x)], 1u);
            asm volatile("s_waitcnt vmcnt(0)" ::: "memory");
        } else {
            XB_SPIN(xb_ld(&bar[XB_XGEN(b.x)]) == gen, bar);
            __builtin_amdgcn_fence(__ATOMIC_ACQUIRE, "agent");
            asm volatile("s_waitcnt vmcnt(0)" ::: "memory");
        }
    }
    __syncthreads();
}

__global__ void __launch_bounds__(NT, 2) mega(Params p) {
  extern __shared__ __attribute__((aligned(16))) char smem[];
  cg::grid_group grid = cg::this_grid();
  if (blockIdx.x == 0) { unsigned* ctl = (unsigned*)(p.ws + WS_CTL); for (int i = TIDX; i < 16384; i += NT) ctl[i] = 0u; }
  grid.sync();
  __shared__ unsigned xb_st[2];
  if (TIDX == 0) { xb_st[0] = 0u; xb_st[1] = 0u; }
  __syncthreads();
  (void)xcd_barrier_post((unsigned*)(p.ws + WS_CTL) + 8192, (volatile LAS unsigned*)xb_st);
#define XBAR() do { XcdBarrier xb_; xb_.bar = (unsigned*)(p.ws + WS_CTL) + 8192; xb_.x = xb_xcc_id(); xb_.st = (volatile LAS unsigned*)xb_st; xcd_barrier(xb_); } while (0)
  phase0(p, smem);
  XBAR();
  { EpiP1 E; E.p = p; run_gemm(smem, (const bf16_t*)(p.ws + WS_H), (const bf16_t*)(p.ws + WS_WINT), MT, NINP, E); }
  XBAR();
  phase_x(p);
  XBAR();
  { EpiLora E; E.p = p; run_gemm(smem, (const bf16_t*)(p.ws + WS_X), (const bf16_t*)(p.ws + WS_BTL), MP, 2048, E, 256); }
  small_lora(p);
  XBAR();
  phase1c(p);
  XBAR();
  phase2(p, smem);
  XBAR();
  phase2c(p);
  XBAR();
  { EpiGate E; E.p = p; E.goff = 0; E.first = true; run_gemm(smem, (const bf16_t*)(p.ws + WS_QB), (const bf16_t*)(p.ws + WS_WT), MP, 1024, E); }
  small_gemm<0>(p, (const bf16_t*)(p.ws + WS_QB), (const bf16_t*)(p.ws + WS_WT));
  { EpiGate E; E.p = p; E.goff = 1024; E.first = false; run_gemm(smem, (const bf16_t*)(p.ws + WS_OB), (const bf16_t*)(p.ws + WS_WT) + (size_t)1024 * 1024, MP, 1024, E); }
  small_gemm<1>(p, (const bf16_t*)(p.ws + WS_OB), (const bf16_t*)(p.ws + WS_WT) + (size_t)1024 * 1024);
  XBAR();
  { EpiOut E; E.p = p; run_gemm(smem, (const bf16_t*)(p.ws + WS_MG), (const bf16_t*)(p.ws + WS_WT) + (size_t)2 * 1024 * 1024, MP, 1024, E); }
  small_gemm<2>(p, (const bf16_t*)(p.ws + WS_MG), (const bf16_t*)(p.ws + WS_WT) + (size_t)2 * 1024 * 1024);
  XBAR();
  phase4(p);
}

extern "C" void kernel_launch(void* const* d_in, const int* in_sizes, int n_in, void* d_out, int out_size, void* d_ws, size_t ws_size, hipStream_t stream) {
  static int grid_blocks = 0;
  if (grid_blocks == 0) {
    if (n_in != 22 || ws_size < WS_END) { fprintf(stderr, "kernel_launch: unexpected n_in %d / ws_size %zu (need %zu)\n", n_in, ws_size, (size_t)WS_END); grid_blocks = -1; return; }
    int dev = 0, cus = 0, per_cu = 0;
    (void)hipGetDevice(&dev);
    (void)hipDeviceGetAttribute(&cus, hipDeviceAttributeMultiprocessorCount, dev);
    (void)hipFuncSetAttribute((const void*)mega, hipFuncAttributeMaxDynamicSharedMemorySize, SMEM_BYTES);
    (void)hipOccupancyMaxActiveBlocksPerMultiprocessor(&per_cu, (const void*)mega, NT, SMEM_BYTES);
    (void)hipGetLastError();
    grid_blocks = cus;
  }
  if (grid_blocks < 0) return;
  Params p{};
  for (int i = 0; i < 22; ++i) p.in[i] = (const float*)d_in[i];
  p.out = (float*)d_out; p.ws = (unsigned char*)d_ws;
  void* args[] = {&p};
  hipError_t e = hipLaunchCooperativeKernel((const void*)mega, dim3(grid_blocks), dim3(NT), args, SMEM_BYTES, stream);
  if (e != hipSuccess) fprintf(stderr, "cooperative launch failed: %s (grid %d)\n", hipGetErrorString(e), grid_blocks);
}
```
